# Optimizing an MI355X kernel written in HIP

```python
import jax
import jax.numpy as jnp
from jax import lax
import numpy as np

D_MODEL = 1024
BATCH = 4
SEQ = 4096
DEPTH = 2

CTX_LEN = 256
GRID_W = 64
EPS = 1e-6
N_BRANCH = 3
N_MOD = 6

A_GROUPS = 8
A_GROUP_DIM = 128
A_WIDTH = A_GROUPS * A_GROUP_DIM
A_CHUNK = 128

B_HEADS = 4
B_DK = 128
B_DV = 256
B_GATE_RANK = 16
B_GATE_NORM = 16.0
B_CHUNK = 64

C_HEADS = 8
C_Q_RANK = 384
C_KV_RANK = 256
C_NOPE = 128
C_ROPE = 64
C_DV = 128
C_QBLOCK = 128
ROPE_BASE = 10000.0

N_EXPERTS = 16
CAPACITY_FACTOR = 2
D_EXPERT = 2048

IN_SPLITS = (A_WIDTH, A_WIDTH,
             B_HEADS * B_DK, B_HEADS * B_DK, B_HEADS * B_DV, B_HEADS * B_DV, 2 * B_GATE_RANK,
             C_Q_RANK, C_KV_RANK, C_ROPE,
             N_BRANCH * D_MODEL)
N_IN = sum(IN_SPLITS)

kernel_name = 'hybrid_gated_branch_dit_block'


def rms_norm(x, g):
    xf = x.astype(jnp.float32)
    y = xf * lax.rsqrt(jnp.mean(jnp.square(xf), axis=-1, keepdims=True) + EPS)
    return (y * g.astype(jnp.float32)).astype(x.dtype)


def layer_norm(x):
    xf = x.astype(jnp.float32)
    mu = jnp.mean(xf, axis=-1, keepdims=True)
    var = jnp.mean(jnp.square(xf - mu), axis=-1, keepdims=True)
    return ((xf - mu) * lax.rsqrt(var + EPS)).astype(x.dtype)


def modulate(x, g, shift, scale):
    return rms_norm(x, g) * (1 + scale) + shift


def split_cols(z):
    idx = np.cumsum(IN_SPLITS)[:-1].tolist()
    return jnp.split(z, idx, axis=-1)


def axial_rope_tables(n_tok):
    rows = n_tok // GRID_W
    row = jnp.broadcast_to(jnp.arange(rows, dtype=jnp.float32)[:, None], (rows, GRID_W)).reshape(-1)
    col = jnp.broadcast_to(jnp.arange(GRID_W, dtype=jnp.float32)[None, :], (rows, GRID_W)).reshape(-1)
    axis_dim = C_ROPE // 2
    inv_freq = ROPE_BASE ** (-jnp.arange(0, axis_dim, 2, dtype=jnp.float32) / axis_dim)
    ang = jnp.concatenate([row[:, None] * inv_freq, col[:, None] * inv_freq], axis=-1)
    return jnp.cos(ang), jnp.sin(ang)


def apply_axial_rope(x, cos, sin):
    n_freq = C_ROPE // 4
    xf = x.astype(jnp.float32).reshape(*x.shape[:-1], 2, 2, n_freq)
    x1, x2 = xf[..., 0, :], xf[..., 1, :]
    shape = (cos.shape[0],) + (1,) * (x.ndim - 3) + (2, n_freq)
    cs, sn = cos.reshape(shape), sin.reshape(shape)
    out = jnp.stack([x1 * cs - x2 * sn, x2 * cs + x1 * sn], axis=-2)
    return out.reshape(x.shape).astype(x.dtype)


def chunk_mlp(u, v, p):
    bsz, n_tok, _ = v.shape
    n_chunk = n_tok // A_CHUNK
    v = layer_norm(v.reshape(bsz, n_tok, A_GROUPS, A_GROUP_DIM))
    v = v.reshape(bsz, n_chunk, A_CHUNK, A_GROUPS, A_GROUP_DIM)
    mixed = jnp.einsum('gts,bnsgc->bntgc', p['w_s'], v) + p['b_s'].T[:, :, None]
    return u * mixed.reshape(bsz, n_tok, A_WIDTH)


def to_chunks(t):
    bsz, n_tok = t.shape[:2]
    return t.reshape(bsz, n_tok // B_CHUNK, B_CHUNK, *t.shape[2:])


def gla_inputs(q, k, v, dec, p):
    bsz, n_tok, _ = q.shape

    def heads(t, d):
        return t.astype(jnp.float32).reshape(bsz, n_tok, B_HEADS, d)

    dec_f, dec_b = jnp.split(dec, 2, axis=-1)

    def log_decay(z, j):
        pre = (z @ p['w_gla_decay'][j] + p['b_gla_decay'][j]).astype(jnp.float32)
        return jax.nn.log_sigmoid(pre) / B_GATE_NORM

    return (heads(q, B_DK) * B_DK ** -0.5, heads(k, B_DK), heads(v, B_DV),
            heads(log_decay(dec_f, 0), B_DK), heads(log_decay(dec_b, 1), B_DK))


def gla_state_scan(k, v, log_a, s0):
    k, v, log_a = to_chunks(k), to_chunks(v), to_chunks(log_a)
    b = jnp.cumsum(log_a, axis=2)
    b_last = b[:, :, -1]
    kv = jnp.einsum('bnjhd,bnjhv->bnhdv', k * jnp.exp(b_last[:, :, None] - b), v)

    def step(s, inp):
        decay, kv_n = inp
        return decay[..., None] * s + kv_n, s

    s_final, s_start = lax.scan(step, s0, (jnp.moveaxis(jnp.exp(b_last), 1, 0), jnp.moveaxis(kv, 1, 0)))
    return b, jnp.moveaxis(s_start, 0, 1), s_final


def gla_chunk_output(q, k, v, b, s_start):
    bsz, n_tok = q.shape[:2]
    q, k, v = to_chunks(q), to_chunks(k), to_chunks(v)
    q_dec = q * jnp.exp(b)
    k_inv = k * jnp.exp(-b)
    in_order = jnp.tril(jnp.ones((B_CHUNK, B_CHUNK), dtype=bool))
    scores = jnp.where(in_order, jnp.einsum('bnihd,bnjhd->bnhij', q_dec, k_inv), 0.0)
    o = (jnp.einsum('bnhij,bnjhv->bnihv', scores, v)
         + jnp.einsum('bnihd,bnhdv->bnihv', q_dec, s_start))
    return o.reshape(bsz, n_tok, B_HEADS, B_DV)


def gla_bidirectional(q, k, v, la_f, la_b, s0_f, s0_b, with_output):
    def flip(t):
        return jnp.flip(t, axis=1)

    b_f, st_f, sf_f = gla_state_scan(k, v, la_f, s0_f)
    b_b, st_b, sf_b = gla_state_scan(flip(k), flip(v), flip(la_b), s0_b)
    if not with_output:
        return None, sf_f, sf_b
    o = gla_chunk_output(q, k, v, b_f, st_f) + flip(gla_chunk_output(flip(q), flip(k), flip(v), b_b, st_b))
    return o, sf_f, sf_b


def gla_finish(o, r, p):
    bsz, n_tok, _ = r.shape
    o = rms_norm(o, p['g_gla_out']).astype(r.dtype)
    return o.reshape(bsz, n_tok, B_HEADS * B_DV) * jax.nn.silu(r)


def mla_keys(c_kv, k_rope, p, rope):
    bsz, n_tok, _ = c_kv.shape
    kv = (rms_norm(c_kv, p['g_ckv']) @ p['w_ukv']).reshape(bsz, n_tok, C_HEADS, C_NOPE + C_DV)
    k_nope = rms_norm(kv[..., :C_NOPE], p['g_kn'])
    k_rope = rms_norm(k_rope, p['g_kr'])
    if rope is not None:
        k_rope = apply_axial_rope(k_rope, *rope)
    return k_nope, k_rope, kv[..., C_NOPE:]


def mla_queries(c_q, p, rope):
    bsz, n_tok, _ = c_q.shape
    q = (rms_norm(c_q, p['g_cq']) @ p['w_uq']).reshape(bsz, n_tok, C_HEADS, C_NOPE + C_ROPE)
    q_nope = rms_norm(q[..., :C_NOPE], p['g_qn'])
    q_rope = rms_norm(q[..., C_NOPE:], p['g_qr'])
    if rope is not None:
        q_rope = apply_axial_rope(q_rope, *rope)
    return q_nope, q_rope


def mla_attend(q_nope, q_rope, k_nope, k_rope, v):
    scale = (C_NOPE + C_ROPE) ** -0.5
    s = (jnp.einsum('bqhd,bkhd->bhqk', q_nope, k_nope)
         + jnp.einsum('bqhr,bkr->bhqk', q_rope, k_rope)).astype(jnp.float32) * scale
    prob = jax.nn.softmax(s, axis=-1).astype(v.dtype)
    return jnp.einsum('bhqk,bkhd->bqhd', prob, v)


def mla_attend_blocked(q_nope, q_rope, k_nope, k_rope, v):
    bsz, n_tok = q_nope.shape[:2]
    nb = n_tok // C_QBLOCK

    def blocks(t):
        return jnp.moveaxis(t.reshape(bsz, nb, C_QBLOCK, *t.shape[2:]), 1, 0)

    o = lax.map(lambda qs: mla_attend(qs[0], qs[1], k_nope, k_rope, v), (blocks(q_nope), blocks(q_rope)))
    return jnp.moveaxis(o, 0, 1).reshape(bsz, n_tok, C_HEADS * C_DV)


def merge_branches(gate_cols, ya, yb, yc, p):
    lead = gate_cols.shape[:-1]
    gates = jax.nn.sigmoid((gate_cols + p['b_gate']).astype(jnp.float32)).astype(ya.dtype)
    gates = gates.reshape(*lead, N_BRANCH, D_MODEL)
    merged = (gates[..., 0, :] * (ya @ p['w_proj_a'])
              + gates[..., 1, :] * (yb @ p['w_proj_b'])
              + gates[..., 2, :] * (yc @ p['w_proj_c']))
    return merged @ p['w_out']


def token_mixer(h_ctx, h_lat, rope, p, need_ctx_out):
    bsz, n_ctx, _ = h_ctx.shape
    u_c, va_c, qb_c, kb_c, vb_c, rb_c, dec_c, cq_c, ckv_c, krope_c, gt_c = split_cols(h_ctx @ p['w_in'])
    u_l, va_l, qb_l, kb_l, vb_l, rb_l, dec_l, cq_l, ckv_l, krope_l, gt_l = split_cols(h_lat @ p['w_in'])

    zero_state = jnp.zeros((bsz, B_HEADS, B_DK, B_DV), jnp.float32)
    o_c, s_fwd, s_bwd = gla_bidirectional(*gla_inputs(qb_c, kb_c, vb_c, dec_c, p), zero_state, zero_state, need_ctx_out)
    o_l, _, _ = gla_bidirectional(*gla_inputs(qb_l, kb_l, vb_l, dec_l, p), s_fwd, s_bwd, True)

    kn_c, kr_c, v_c = mla_keys(ckv_c, krope_c, p, None)
    kn_l, kr_l, v_l = mla_keys(ckv_l, krope_l, p, rope)
    qn_l, qr_l = mla_queries(cq_l, p, rope)
    yc_l = mla_attend_blocked(qn_l, qr_l,
                              jnp.concatenate([kn_c, kn_l], axis=1),
                              jnp.concatenate([kr_c, kr_l], axis=1),
                              jnp.concatenate([v_c, v_l], axis=1))
    y_lat = merge_branches(gt_l, chunk_mlp(u_l, va_l, p), gla_finish(o_l, rb_l, p), yc_l, p)
    if not need_ctx_out:
        return None, y_lat
    qn_c, qr_c = mla_queries(cq_c, p, None)
    yc_c = mla_attend(qn_c, qr_c, kn_c, kr_c, v_c).reshape(bsz, n_ctx, C_HEADS * C_DV)
    y_ctx = merge_branches(gt_c, chunk_mlp(u_c, va_c, p), gla_finish(o_c, rb_c, p), yc_c, p)
    return y_ctx, y_lat


def expert_choice_ffn(h, p):
    bsz, n_tok, d = h.shape
    cap = CAPACITY_FACTOR * n_tok // N_EXPERTS
    aff = jax.nn.softmax((h @ p['w_router']).astype(jnp.float32), axis=-1)
    g, idx = lax.top_k(jnp.swapaxes(aff, 1, 2), cap)
    xs = jax.vmap(lambda hb, ib: hb[ib])(h, idx)
    hid = (jax.nn.silu(jnp.einsum('becd,edf->becf', xs, p['w_e_gate']))
           * jnp.einsum('becd,edf->becf', xs, p['w_e_up']))
    ys = jnp.einsum('becf,efd->becd', hid, p['w_e_down']) * g[..., None].astype(h.dtype)

    def scatter(yb, ib):
        return jnp.zeros((n_tok, d), yb.dtype).at[ib.reshape(-1)].add(yb.reshape(-1, d))

    return jax.vmap(scatter)(ys, idx)


def setup_inputs(seed: int = 0) -> dict:
    key = jax.random.key(seed)
    ks = iter(jax.random.split(key, 40))

    def nrm(shape, scale):
        return jax.random.normal(next(ks), shape, jnp.float32) * scale

    def gain(shape):
        return 1.0 + nrm(shape, 0.02)

    L = DEPTH
    return {
        'x': nrm((BATCH, SEQ, D_MODEL), 1.0),
        'c': nrm((BATCH, D_MODEL), 1.0),
        'ctx': nrm((BATCH, CTX_LEN, D_MODEL), 1.0),
        'c_ctx': nrm((D_MODEL,), 1.0),
        'w_mod': nrm((L, D_MODEL, N_MOD * D_MODEL), 0.5 * D_MODEL ** -0.5),
        'b_mod': nrm((L, N_MOD * D_MODEL), 0.01),
        'g_norm_mix': gain((L, D_MODEL)),
        'g_norm_ffn': gain((L, D_MODEL)),
        'w_in': nrm((L, D_MODEL, N_IN), D_MODEL ** -0.5),
        'b_gate': nrm((L, N_BRANCH * D_MODEL), 0.02),
        'w_s': nrm((L, A_GROUPS, A_CHUNK, A_CHUNK), A_CHUNK ** -0.5),
        'b_s': gain((L, A_GROUPS, A_CHUNK)),
        'w_gla_decay': nrm((L, 2, B_GATE_RANK, B_HEADS * B_DK), B_GATE_RANK ** -0.5),
        'b_gla_decay': nrm((L, 2, B_HEADS * B_DK), 0.1),
        'g_gla_out': gain((L, B_DV)),
        'g_cq': gain((L, C_Q_RANK)),
        'g_ckv': gain((L, C_KV_RANK)),
        'w_uq': nrm((L, C_Q_RANK, C_HEADS * (C_NOPE + C_ROPE)), C_Q_RANK ** -0.5),
        'w_ukv': nrm((L, C_KV_RANK, C_HEADS * (C_NOPE + C_DV)), C_KV_RANK ** -0.5),
        'g_qn': gain((L, C_NOPE)),
        'g_qr': gain((L, C_ROPE)),
        'g_kn': gain((L, C_NOPE)),
        'g_kr': gain((L, C_ROPE)),
        'w_proj_a': nrm((L, A_WIDTH, D_MODEL), A_WIDTH ** -0.5),
        'w_proj_b': nrm((L, B_HEADS * B_DV, D_MODEL), (B_HEADS * B_DV) ** -0.5),
        'w_proj_c': nrm((L, C_HEADS * C_DV, D_MODEL), (C_HEADS * C_DV) ** -0.5),
        'w_out': nrm((L, D_MODEL, D_MODEL), D_MODEL ** -0.5),
        'w_router': nrm((L, D_MODEL, N_EXPERTS), D_MODEL ** -0.5),
        'w_e_gate': nrm((L, N_EXPERTS, D_MODEL, D_EXPERT), D_MODEL ** -0.5),
        'w_e_up': nrm((L, N_EXPERTS, D_MODEL, D_EXPERT), D_MODEL ** -0.5),
        'w_e_down': nrm((L, N_EXPERTS, D_EXPERT, D_MODEL), D_EXPERT ** -0.5),
    }


def reference(x, c, ctx, c_ctx, w_mod, b_mod, g_norm_mix, g_norm_ffn, w_in, b_gate, w_s, b_s,
              w_gla_decay, b_gla_decay, g_gla_out, g_cq, g_ckv, w_uq, w_ukv, g_qn, g_qr, g_kn, g_kr,
              w_proj_a, w_proj_b, w_proj_c, w_out, w_router, w_e_gate, w_e_up, w_e_down):
    bsz = x.shape[0]
    rope = axial_rope_tables(x.shape[1])
    x_lat, x_ctx = x, ctx
    for i in range(DEPTH):
        p = {
            'w_in': w_in[i], 'b_gate': b_gate[i], 'w_s': w_s[i], 'b_s': b_s[i],
            'w_gla_decay': w_gla_decay[i], 'b_gla_decay': b_gla_decay[i], 'g_gla_out': g_gla_out[i],
            'g_cq': g_cq[i], 'g_ckv': g_ckv[i], 'w_uq': w_uq[i], 'w_ukv': w_ukv[i],
            'g_qn': g_qn[i], 'g_qr': g_qr[i], 'g_kn': g_kn[i], 'g_kr': g_kr[i],
            'w_proj_a': w_proj_a[i], 'w_proj_b': w_proj_b[i], 'w_proj_c': w_proj_c[i], 'w_out': w_out[i],
            'w_router': w_router[i], 'w_e_gate': w_e_gate[i], 'w_e_up': w_e_up[i], 'w_e_down': w_e_down[i],
        }
        need_ctx_out = i < DEPTH - 1
        mod_l = (jax.nn.silu(c) @ w_mod[i] + b_mod[i]).reshape(bsz, N_MOD, 1, D_MODEL)
        mod_c = (jax.nn.silu(c_ctx) @ w_mod[i] + b_mod[i]).reshape(N_MOD, 1, D_MODEL)
        h_l = modulate(x_lat, g_norm_mix[i], mod_l[:, 0], mod_l[:, 1])
        h_c = modulate(x_ctx, g_norm_mix[i], mod_c[0], mod_c[1])
        y_c, y_l = token_mixer(h_c, h_l, rope, p, need_ctx_out)
        x_lat = x_lat + mod_l[:, 2] * y_l
        x_lat = x_lat + mod_l[:, 5] * expert_choice_ffn(modulate(x_lat, g_norm_ffn[i], mod_l[:, 3], mod_l[:, 4]), p)
        if need_ctx_out:
            x_ctx = x_ctx + mod_c[2] * y_c
            x_ctx = x_ctx + mod_c[5] * expert_choice_ffn(modulate(x_ctx, g_norm_ffn[i], mod_c[3], mod_c[4]), p)
    return x_lat
```

```cpp
#define MK_FUSED 0
#include <hip/hip_runtime.h>
#include <cstdint>
#include <cstdio>

#define LAS __attribute__((address_space(3)))
#define GAS __attribute__((address_space(1)))
typedef unsigned short bf16_t;
typedef short bf16x8 __attribute__((ext_vector_type(8)));
typedef short bf16x4 __attribute__((ext_vector_type(4)));
typedef float f32x4 __attribute__((ext_vector_type(4)));
typedef float f32x2 __attribute__((ext_vector_type(2)));
typedef float f32x16 __attribute__((ext_vector_type(16)));
typedef unsigned u32x4 __attribute__((ext_vector_type(4)));
typedef unsigned u32x2 __attribute__((ext_vector_type(2)));

typedef __bf16 bf16v2_t __attribute__((ext_vector_type(2)));
__device__ __forceinline__ unsigned cvt_pk_bf16(float lo, float hi) { bf16v2_t v; v[0] = (__bf16)lo; v[1] = (__bf16)hi; return __builtin_bit_cast(unsigned, v); }
__device__ __forceinline__ bf16_t f2bf(float f) { return (bf16_t)(cvt_pk_bf16(f, 0.f) & 0xffffu); }
__device__ __forceinline__ float bf2f(bf16_t b) { return __uint_as_float(((unsigned)b) << 16); }
__device__ __forceinline__ float bflo(unsigned w) { return __uint_as_float(w << 16); }
__device__ __forceinline__ float bfhi(unsigned w) { return __uint_as_float(w & 0xffff0000u); }
__device__ __forceinline__ float wave_sum(float v) {
#pragma unroll
    for (int o = 1; o < 64; o <<= 1) v += __shfl_xor(v, o);
    return v;
}
__device__ __forceinline__ float fast_rcp(float x) { return __builtin_amdgcn_rcpf(x); }
__device__ __forceinline__ float fast_exp(float x) { return __builtin_amdgcn_exp2f(x * 1.4426950408889634f); }
__device__ __forceinline__ float sigmoidf_(float x) { return fast_rcp(1.f + fast_exp(-x)); }
__device__ __forceinline__ float siluf_(float x) { return x * sigmoidf_(x); }

namespace pg8 {
constexpr int BM = 256, BK = 64, HALF = 128, HTB = HALF * BK * 2, STAGE_BYTES = 8 * HTB, NXCD = 8, WGM = 8;
__host__ __device__ __forceinline__ int lds_byte(int r, int c) { const int st = (r >> 4) * 2 + (c >> 5), rr = r & 15, cc = c & 31, ob = rr * 64 + cc * 2; return st * 1024 + (ob ^ (((ob >> 9) & 1) << 5)); }
__host__ __device__ __forceinline__ void stage_rc(int b, int& R, int& C) { const int st = b / 1024, sb = b % 1024, swz = sb ^ (((sb >> 9) & 1) << 5); R = (st >> 1) * 16 + swz / 64; C = (st & 1) * 32 + (swz % 64) / 2; }
__host__ __device__ __forceinline__ int perm32(int rho) { const int n = rho >> 4, i = rho & 15; return 8 * (i >> 2) + 4 * n + (i & 3); }

struct Unit { int pm, pn, g; };
struct Gemm { const bf16_t* A; const bf16_t* Bt; int lda, ldb, K; size_t gstrideA, gstrideB; };

struct GOrder {
    int nM, nN, nG, nwg, G, c, pm0;
    __device__ void init(int nM_, int nN_, int nG_, int G_, int c_, int pm0_ = 0) { nM = nM_; nN = nN_; nG = nG_; nwg = nM * nN * nG; G = G_; c = c_; pm0 = pm0_; }
    __device__ bool next(int i, Unit& u) const {
        const long L = (long)i * G + c; if (L >= nwg) return false;
        int wgid = (int)L; { const int q = nwg / NXCD, r = nwg % NXCD, xcd = wgid % NXCD, off = wgid / NXCD; wgid = (xcd < r ? xcd * (q + 1) : r * (q + 1) + (xcd - r) * q) + off; }
        const int per = nM * nN; u.g = wgid / per; wgid -= u.g * per;
        const int nig = WGM * nN, gid = wgid / nig, fm = gid * WGM, gsz = (nM - fm) < WGM ? (nM - fm) : WGM;
        u.pm = pm0 + fm + ((wgid % nig) % gsz); u.pn = (wgid % nig) / gsz; return true;
    }
};

template <class Epi, class Sched>
__device__ __forceinline__ void gemm_phase(LAS unsigned char* lds, const int tid, const Gemm g, const Sched& S, const Epi& E) {
    const int wid = __builtin_amdgcn_readfirstlane(tid >> 6), lane = tid & 63, wr = wid >> 2, wc = wid & 3, fr = lane & 15, fq = lane >> 4;
    const int K = g.K, nt = K / BK;
    unsigned voffA[2], voffB[2];
#pragma unroll
    for (int i = 0; i < 2; ++i) { int R, C; stage_rc(tid * 16 + i * 8192, R, C); const int Rb = Epi::PERM ? ((R & ~31) + perm32(R & 31)) : R;
        voffA[i] = (unsigned)(R * g.lda + C) * 2u; voffB[i] = (unsigned)(Rb * g.ldb + C) * 2u; }
    const size_t kstep = (size_t)(BK * 2);
    const size_t hstepA = (size_t)HALF * g.lda * 2, hstepB = (size_t)HALF * g.ldb * 2;
    const size_t tstepA = 2 * hstepA, tstepB = 2 * hstepB;
    const unsigned ldsw = (unsigned)wid * 1024u;
    const int aoff = lds_byte(wr * 64 + fr, fq * 8), boff = lds_byte(wc * 32 + fr, fq * 8);
#define PG8_SA(b, h) (((b) * 2 + (h)) * HTB)
#define PG8_SB(b, h) ((4 + (b) * 2 + (h)) * HTB)
#define PG8_STAGE(bufoff, gbase, voff) do { _Pragma("unroll") for (int _i = 0; _i < 2; ++_i) \
        __builtin_amdgcn_global_load_lds((const unsigned*)((const char*)(gbase) + (voff)[_i]), (LAS unsigned*)(lds + (bufoff) + ldsw + _i * 8192), 16, 0, 0); } while (0)
#define PG8_LDA(dst, b, h) do { _Pragma("unroll") for (int m = 0; m < 4; ++m) _Pragma("unroll") for (int k = 0; k < 2; ++k) dst[m][k] = *(const LAS bf16x8*)(lds + PG8_SA(b, h) + aoff + m * 2048 + k * 1024); } while (0)
#define PG8_LDB(dst, b, h) do { _Pragma("unroll") for (int n = 0; n < 2; ++n) _Pragma("unroll") for (int k = 0; k < 2; ++k) dst[n][k] = *(const LAS bf16x8*)(lds + PG8_SB(b, h) + boff + n * 2048 + k * 1024); } while (0)
#define PG8_MMA(ai, bj, At, Bt) do { __builtin_amdgcn_s_setprio(1); _Pragma("unroll") for (int m = 0; m < 4; ++m) _Pragma("unroll") for (int n = 0; n < 2; ++n) _Pragma("unroll") for (int k = 0; k < 2; ++k) \
        acc[ai][bj][m][n] = __builtin_amdgcn_mfma_f32_16x16x32_bf16(Bt[n][k], At[m][k], acc[ai][bj][m][n], 0, 0, 0); __builtin_amdgcn_s_setprio(0); } while (0)
#define PG8_WAIT_V(n) asm volatile("s_waitcnt vmcnt(" #n ")" ::: "memory")
#define PG8_WAIT_L(n) asm volatile("s_waitcnt lgkmcnt(" #n ")" ::: "memory")
#define PG8_BAR __builtin_amdgcn_s_barrier()
#define PG8_SCHED __builtin_amdgcn_sched_barrier(0)
    Unit cur, nxt; int ui = 0;
    if (!S.next(0, cur)) return;
    f32x4 acc[2][2][4][2];
#pragma unroll
    for (int a = 0; a < 2; ++a)
#pragma unroll
        for (int b = 0; b < 2; ++b)
#pragma unroll
            for (int m = 0; m < 4; ++m)
#pragma unroll
                for (int n = 0; n < 2; ++n) acc[a][b][m][n] = (f32x4){0.f, 0.f, 0.f, 0.f};
    bf16x8 At[4][2], B0[2][2], B1[2][2];
    const char* cA = (const char*)(g.A + (size_t)cur.g * g.gstrideA) + (size_t)cur.pm * tstepA; const char* cB = (const char*)(g.Bt + (size_t)cur.g * g.gstrideB) + (size_t)cur.pn * tstepB;
    PG8_STAGE(PG8_SB(0, 0), cB, voffB); PG8_STAGE(PG8_SB(0, 1), cB + hstepB, voffB); PG8_STAGE(PG8_SA(0, 0), cA, voffA); PG8_STAGE(PG8_SA(0, 1), cA + hstepA, voffA);
    if (wr == 1) PG8_BAR;
    PG8_WAIT_V(2); PG8_BAR;
    PG8_STAGE(PG8_SB(1, 0), cB + kstep, voffB); PG8_STAGE(PG8_SA(1, 0), cA + kstep, voffA); PG8_STAGE(PG8_SB(1, 1), cB + hstepB + kstep, voffB);
    PG8_WAIT_V(6); PG8_BAR;
    for (;;) {
        const bool has_next = S.next(ui + 1, nxt);
        const char* nA = has_next ? (const char*)(g.A + (size_t)nxt.g * g.gstrideA) + (size_t)nxt.pm * tstepA : cA; const char* nB = has_next ? (const char*)(g.Bt + (size_t)nxt.g * g.gstrideB) + (size_t)nxt.pn * tstepB : cB;
        for (int t = 0; t < nt; t += 2) {
            const bool last = (t == nt - 2);
            const char* a1 = cA + (size_t)(t + 1) * kstep;
            const char* a2 = last ? nA : cA + (size_t)(t + 2) * kstep; const char* b2 = last ? nB : cB + (size_t)(t + 2) * kstep;
            const char* a3 = a2 + kstep; const char* b3 = b2 + kstep;
            if constexpr (Epi::MID) { if (t == 16 || t == 32) E.mid(acc, cur, t, wr, wc, fr, fq); }
            PG8_LDB(B0, 0, 0); PG8_LDB(B1, 0, 1); PG8_SCHED; PG8_LDA(At, 0, 0); PG8_STAGE(PG8_SA(1, 1), a1 + hstepA, voffA);
            PG8_WAIT_V(8); PG8_WAIT_L(0); PG8_BAR; PG8_MMA(0, 0, At, B0); PG8_MMA(0, 1, At, B1); PG8_BAR; PG8_SCHED;
            PG8_LDA(At, 0, 1); PG8_STAGE(PG8_SB(0, 0), b2, voffB); PG8_STAGE(PG8_SB(0, 1), b2 + hstepB, voffB); PG8_STAGE(PG8_SA(0, 0), a2, voffA);
            PG8_WAIT_V(8); PG8_WAIT_L(0); PG8_BAR; PG8_MMA(1, 0, At, B0); PG8_MMA(1, 1, At, B1); PG8_BAR; PG8_SCHED;
            PG8_LDB(B0, 1, 0); PG8_LDB(B1, 1, 1); PG8_SCHED; PG8_LDA(At, 1, 0); PG8_STAGE(PG8_SA(0, 1), a2 + hstepA, voffA);
            PG8_WAIT_V(8); PG8_WAIT_L(0); PG8_BAR; PG8_MMA(0, 0, At, B0); PG8_MMA(0, 1, At, B1); PG8_BAR; PG8_SCHED;
            PG8_LDA(At, 1, 1); PG8_STAGE(PG8_SB(1, 0), b3, voffB); PG8_STAGE(PG8_SB(1, 1), b3 + hstepB, voffB); PG8_STAGE(PG8_SA(1, 0), a3, voffA);
            PG8_WAIT_V(8); PG8_WAIT_L(0); PG8_BAR; PG8_MMA(1, 0, At, B0); PG8_MMA(1, 1, At, B1); PG8_BAR; PG8_SCHED;
        }
        if (wr == 0) PG8_BAR;
        E(acc, cur, wr, wc, fr, fq);
        if (!has_next) break;
#pragma unroll
        for (int a = 0; a < 2; ++a)
#pragma unroll
            for (int b = 0; b < 2; ++b)
#pragma unroll
                for (int m = 0; m < 4; ++m)
#pragma unroll
                    for (int n = 0; n < 2; ++n) acc[a][b][m][n] = (f32x4){0.f, 0.f, 0.f, 0.f};
        cur = nxt; cA = nA; cB = nB; ++ui;
        if (wr == 1) PG8_BAR;
    }
    PG8_WAIT_V(0);
    PG8_BAR;
#undef PG8_SA
#undef PG8_SB
#undef PG8_STAGE
#undef PG8_LDA
#undef PG8_LDB
#undef PG8_MMA
#undef PG8_WAIT_V
#undef PG8_WAIT_L
#undef PG8_BAR
#undef PG8_SCHED
}
}
#define XB_TMO      128
#define XB_XCNT(j)  (256  + 64 * (j))
#define XB_XSUB(j)  (1280 + 64 * (j))
#define XB_XGEN(j)  (2304 + 64 * (j))
#define XB_TOP      3328
#define XB_TOPGEN   3392
#define XCD_BAR_WORDS 3456
#define XB_SPIN_CAP (1u << 18)

__device__ __forceinline__ unsigned xb_ld(unsigned* p)              { return __hip_atomic_load(p, __ATOMIC_RELAXED, __HIP_MEMORY_SCOPE_AGENT); }
__device__ __forceinline__ unsigned xb_add(unsigned* p, unsigned v) { return __hip_atomic_fetch_add(p, v, __ATOMIC_RELAXED, __HIP_MEMORY_SCOPE_AGENT); }
__device__ __forceinline__ unsigned xb_xcc_id() { return (unsigned)__builtin_amdgcn_s_getreg((3 << 11) | 20) & 0xFu; }
#define XB_SPIN(cond, bar) do { unsigned _sp = 0; while (cond) { __builtin_amdgcn_s_sleep(1); \
    if ((++_sp & 255u) == 0u) { if (xb_ld(&(bar)[XB_TMO])) break; if (_sp > XB_SPIN_CAP) { atomicAdd(&(bar)[XB_TMO], 1u); break; } } } } while (0)

struct XcdBarrier {
    unsigned* bar; unsigned x;
    volatile LAS unsigned* st;
};

__device__ __forceinline__ XcdBarrier xcd_barrier_post(unsigned* bar, volatile LAS unsigned* st) {
    XcdBarrier b; b.bar = bar; b.x = xb_xcc_id(); b.st = st;
    if (threadIdx.x == 0) (void)xb_add(&bar[XB_XCNT(b.x)], 1u);
    return b;
}
__device__ __forceinline__ void xcd_barrier_complete(unsigned* bar, unsigned x, unsigned& nloc, unsigned& nx) {
    const unsigned G = gridDim.x * gridDim.y * gridDim.z;
    unsigned sum, cnt, mine, sp = 0u;
    for (;;) {
        sum = 0u; cnt = 0u; mine = 0u;
#pragma unroll
        for (unsigned j = 0; j < 16; ++j) { const unsigned c = xb_ld(&bar[XB_XCNT(j)]); sum += c; cnt += (c > 0u) ? 1u : 0u; mine = (j == x) ? c : mine; }
        if (sum == G) break;
        __builtin_amdgcn_s_sleep(1);
        if ((++sp & 255u) == 0u) { if (xb_ld(&bar[XB_TMO])) break; if (sp > XB_SPIN_CAP) { atomicAdd(&bar[XB_TMO], 1u); break; } }
    }
    nloc = mine > 0u ? mine : 1u; nx = cnt > 0u ? cnt : 1u;
}

__device__ __forceinline__ void xcd_barrier(const XcdBarrier& b) {
    asm volatile("s_waitcnt vmcnt(0)" ::: "memory");
    __syncthreads();
    if (threadIdx.x == 0) {
        unsigned* bar = b.bar;
        __builtin_amdgcn_s_waitcnt(0);
        unsigned nloc = b.st[0], nx = b.st[1];
        if (nloc == 0u) { xcd_barrier_complete(bar, b.x, nloc, nx); b.st[0] = nloc; b.st[1] = nx; }
        const unsigned old = xb_add(&bar[XB_XSUB(b.x)], 1u);
        const unsigned gen = old / nloc;
        if (old + 1u == (gen + 1u) * nloc) {
            __builtin_amdgcn_fence(__ATOMIC_RELEASE, "agent");
            asm volatile("s_waitcnt vmcnt(0)" ::: "memory");
            const unsigned og = xb_add(&bar[XB_TOP], 1u);
            const unsigned tg = og / nx;
            if (og + 1u == (tg + 1u) * nx) xb_add(&bar[XB_TOPGEN], 1u);
            else XB_SPIN(xb_ld(&bar[XB_TOPGEN]) == tg, bar);
            __builtin_amdgcn_fence(__ATOMIC_ACQUIRE, "agent");
            xb_add(&bar[XB_XGEN(b.x)], 1u);
            asm volatile("s_waitcnt vmcnt(0)" ::: "memory");
        } else {
            XB_SPIN(xb_ld(&bar[XB_XGEN(b.x)]) == gen, bar);
            __builtin_amdgcn_fence(__ATOMIC_ACQUIRE, "agent");
            asm volatile("s_waitcnt vmcnt(0)" ::: "memory");
        }
    }
    __syncthreads();
}

namespace cfg {
constexpr int D = 1024, NB = 4, SEQ = 4096, CTXL = 256, TL = NB * SEQ, TC = NB * CTXL, T = TL + TC;
constexpr int NZ = 8960;
constexpr int ZU = 0, ZVA = 1024, ZQB = 2048, ZKB = 2560, ZVB = 3072, ZRB = 4096, ZCQ = 5120, ZKR = 5504, ZDEC = 5568, ZCKV = 5632, ZGT = 5888;
constexpr int NKEY = CTXL + SEQ;
constexpr int NEXP = 16, DEXP = 2048, CAPL = 512, CAPC = 32, ESLOTS = 2304;
constexpr float EPS = 1e-6f;
constexpr int NWAVES = 8, NTHR = 512;
constexpr size_t MiB = 1u << 20;
constexpr size_t WS_CTL = 0, CTL_BYTES = 1 * MiB;
constexpr size_t WS_MOD = 1 * MiB;
constexpr size_t WS_GATEV = WS_MOD + 512 * 1024;
constexpr size_t WS_AFFT = 2 * MiB;
constexpr size_t WS_SEL = 4 * MiB;
constexpr size_t WS_XC = 6 * MiB;
constexpr size_t WS_H = 10 * MiB;
constexpr size_t WS_WT = 44 * MiB, WT_LAYER = 28 * MiB;
constexpr size_t WT_IN = 0, WT_UQ = 17 * MiB + 512 * 1024, WT_UKV = WT_UQ + 1152 * 1024, WT_M = WT_UKV + 1 * MiB, WT_OUT = WT_M + 6 * MiB, WT_S = WT_OUT + 2 * MiB;
static_assert(WT_S + 256 * 1024 <= WT_LAYER, "weights");
constexpr size_t WS_RA = 100 * MiB;
constexpr size_t RA_XS = 0, RA_HID = 72 * MiB, RA_YS = 216 * MiB;
constexpr size_t WS_RB = 398 * MiB;
constexpr size_t RB_YCAT = 0, RB_KVRAW = 102 * MiB, RB_MERGED = 102 * MiB, RB_QRAW = 170 * MiB, RB_KG = 221 * MiB, RB_VG = 272 * MiB, RB_QFL = 306 * MiB, RB_QFC = 354 * MiB,
                 RB_QDF = 357 * MiB, RB_KDT = 391 * MiB, RB_VTG = 425 * MiB, RB_DECAY = 459 * MiB, RB_OINTRA = 461 * MiB, RB_OF = 495 * MiB, RB_OB = 529 * MiB, RB_END = 563 * MiB;
constexpr size_t RB_WGU = 0, RB_WD = 128 * MiB;
constexpr size_t WS_END = WS_RB + RB_END;
constexpr int LDS_BYTES = 147456;
constexpr int LDS_MISC = 145408;
}
using namespace cfg;

enum { I_X = 0, I_C, I_CTX, I_CCTX, I_WMOD, I_BMOD, I_GMIX, I_GFFN, I_WIN, I_BGATE, I_WS, I_BS, I_WDEC, I_BDEC, I_GGLA, I_GCQ, I_GCKV, I_WUQ, I_WUKV,
       I_GQN, I_GQR, I_GKN, I_GKR, I_WPA, I_WPB, I_WPC, I_WOUT, I_WROUTER, I_WEG, I_WEU, I_WED, N_INPUTS };

struct Args { const float* in[N_INPUTS]; float* out; unsigned char* ws; int ph_lo, ph_hi; };

struct Ctx {
    const float* const* in; float* out; unsigned char* ws; LAS unsigned char* lds;
    int tid, lane, wave, G, bid;
};
__device__ __forceinline__ int row_modidx(int row) { return row < TL ? (row >> 12) : 4; }
__device__ __forceinline__ const float* modp(const Ctx& c, int l, int bi, int which) { return (const float*)(c.ws + WS_MOD) + ((size_t)(l * 5 + bi) * 6 + which) * D; }
__device__ __forceinline__ const float* xin_row(const Ctx& c, int l, int row) {
    if (row < TL) return (l == 0 ? c.in[I_X] : (const float*)c.out) + (size_t)row * D;
    return (l == 0 ? c.in[I_CTX] : (const float*)(c.ws + WS_XC)) + (size_t)(row - TL) * D;
}
__device__ __forceinline__ float* xout_row(const Ctx& c, int row) {
    if (row < TL) return c.out + (size_t)row * D;
    return (float*)(c.ws + WS_XC) + (size_t)(row - TL) * D;
}

#if defined(DEBUG_STAT)
__device__ __forceinline__ void dbg_max(const Ctx& c, int slot, float v) { v = fabsf(v); if (!(v < 1e30f)) v = 1e30f; atomicMax((unsigned*)(c.ws + WS_CTL + 512 * 1024) + 16 * slot, __float_as_uint(v)); }
#else
__device__ __forceinline__ void dbg_max(const Ctx&, int, float) {}
#endif
__device__ __forceinline__ void tconv_tile(const Ctx& c, const float* src, int ld_src, int k0, int c0, int nvalid, const float* kscale, bf16_t* dst, int ld_dst, int r0, int kd0) {
    LAS float* scr = (LAS float*)c.lds;
    const int tid = c.tid;
#pragma unroll
    for (int p = 0; p < 8; ++p) { const int k = p * 8 + (tid >> 6), n = tid & 63;
        float v = (n < nvalid) ? src[(size_t)(k0 + k) * ld_src + c0 + n] : 0.f; if (kscale) v *= kscale[k0 + k];
        scr[n * 65 + k] = v; }
    __syncthreads();
    { const int n = tid >> 3, kc = (tid & 7) * 8; const LAS float* s = scr + n * 65 + kc;
      u32x4 o; o.x = cvt_pk_bf16(s[0], s[1]); o.y = cvt_pk_bf16(s[2], s[3]); o.z = cvt_pk_bf16(s[4], s[5]); o.w = cvt_pk_bf16(s[6], s[7]);
      *(u32x4*)(dst + (size_t)(r0 + n) * ld_dst + kd0 + kc) = o; }
    __syncthreads();
}
__device__ __forceinline__ void win_map(int r0, int& src, int& nvalid) {
    nvalid = 64;
    if (r0 < 5120) src = r0; else if (r0 < 5504) src = 5152 + (r0 - 5120); else if (r0 == 5504) src = 5792;
    else if (r0 == 5568) { src = 5120; nvalid = 32; } else if (r0 < 5888) src = 5536 + (r0 - 5632); else src = 5856 + (r0 - 5888);
}
__device__ __forceinline__ void phase_pre_a(const Ctx& c) {
    constexpr int U_IN = 140 * 16, U_UQ = 6 * 24, U_UKV = 4 * 32, U_M = 3 * 256, U_OUT = 256, U_S = 32, U_LAYER = U_IN + U_UQ + U_UKV + U_M + U_OUT + U_S, U_MOD = 192;
    for (int u = c.bid; u < 2 * U_LAYER + U_MOD; u += c.G) {
        if (u >= 2 * U_LAYER) {
            const int cb = u - 2 * U_LAYER, l = cb / 96, n = (cb % 96) * 64 + c.lane;
            const float* wm = c.in[I_WMOD] + (size_t)l * D * 6144; float a[5] = {0.f, 0.f, 0.f, 0.f, 0.f};
            for (int kk = 0; kk < 128; ++kk) { const int k = c.wave * 128 + kk; const float w = wm[(size_t)k * 6144 + n];
#pragma unroll
                for (int i = 0; i < 5; ++i) { const float cv = (i < 4) ? c.in[I_C][i * D + k] : c.in[I_CCTX][k]; a[i] += siluf_(cv) * w; } }
            LAS float* red = (LAS float*)c.lds;
#pragma unroll
            for (int i = 0; i < 5; ++i) red[(c.wave * 5 + i) * 64 + c.lane] = a[i];
            __syncthreads();
            if (c.tid < 320) { const int i = c.tid >> 6, ln = c.tid & 63; float s = 0.f;
#pragma unroll
                for (int w = 0; w < 8; ++w) s += red[(w * 5 + i) * 64 + ln];
                const int nn = (cb % 96) * 64 + ln;
                ((float*)(c.ws + WS_MOD))[(size_t)(l * 5 + i) * 6144 + nn] = s + c.in[I_BMOD][l * 6144 + nn]; }
            __syncthreads();
            continue;
        }
        const int l = u / U_LAYER; int r = u % U_LAYER; unsigned char* wt = c.ws + WS_WT + (size_t)l * WT_LAYER;
        if (r < U_IN) { const int nb = r / 16, kb = r % 16; int src, nv; win_map(nb * 64, src, nv);
            tconv_tile(c, c.in[I_WIN] + (size_t)l * D * 8928, 8928, kb * 64, src, nv, nullptr, (bf16_t*)(wt + WT_IN), D, nb * 64, kb * 64); continue; } r -= U_IN;
        if (r < U_UQ) { const int nb = r / 6, kb = r % 6;
            tconv_tile(c, c.in[I_WUQ] + (size_t)l * 384 * 1536, 1536, kb * 64, nb * 64, 64, c.in[I_GCQ] + l * 384, (bf16_t*)(wt + WT_UQ), 384, nb * 64, kb * 64); continue; } r -= U_UQ;
        if (r < U_UKV) { const int nb = r / 4, kb = r % 4;
            tconv_tile(c, c.in[I_WUKV] + (size_t)l * 256 * 2048, 2048, kb * 64, nb * 64, 64, c.in[I_GCKV] + l * 256, (bf16_t*)(wt + WT_UKV), 256, nb * 64, kb * 64); continue; } r -= U_UKV;
        if (r < U_M) { const int which = r / 256, rr = r % 256, nb = rr / 16, kb = rr % 16;
            const float* src = c.in[which == 0 ? I_WPA : (which == 1 ? I_WPB : I_WPC)] + (size_t)l * D * D;
            tconv_tile(c, src, D, kb * 64, nb * 64, 64, nullptr, (bf16_t*)(wt + WT_M), 3 * D, nb * 64, which * D + kb * 64); continue; } r -= U_M;
        if (r < U_OUT) { const int nb = r / 16, kb = r % 16;
            tconv_tile(c, c.in[I_WOUT] + (size_t)l * D * D, D, kb * 64, nb * 64, 64, nullptr, (bf16_t*)(wt + WT_OUT), D, nb * 64, kb * 64); continue; } r -= U_OUT;
        { const float* s = c.in[I_WS] + (size_t)l * 131072 + (size_t)r * 4096 + c.tid * 8; bf16_t* d = (bf16_t*)(wt + WT_S) + (size_t)r * 4096 + c.tid * 8;
          const f32x4 a = *(const f32x4*)s, b = *(const f32x4*)(s + 4); u32x4 o; o.x = cvt_pk_bf16(a[0], a[1]); o.y = cvt_pk_bf16(a[2], a[3]); o.z = cvt_pk_bf16(b[0], b[1]); o.w = cvt_pk_bf16(b[2], b[3]);
          *(u32x4*)d = o; }
    }
}
__device__ __forceinline__ void modulate_row(const float* xrow, const float* g, const float* shift, const float* scale, bf16_t* hrow, int lane, f32x4 (&hv)[4]) {
    float ss = 0.f;
#pragma unroll
    for (int j = 0; j < 4; ++j) { hv[j] = *(const f32x4*)(xrow + 4 * lane + 256 * j); ss += (hv[j][0] * hv[j][0] + hv[j][1] * hv[j][1]) + (hv[j][2] * hv[j][2] + hv[j][3] * hv[j][3]); }
    const float rstd = 1.0f / sqrtf(wave_sum(ss) * (1.f / D) + EPS);
#pragma unroll
    for (int j = 0; j < 4; ++j) { const int cc = 4 * lane + 256 * j; const f32x4 gv = *(const f32x4*)(g + cc), sc = *(const f32x4*)(scale + cc), sh = *(const f32x4*)(shift + cc);
        hv[j] = hv[j] * rstd * gv * (sc + 1.0f) + sh;
        u32x2 o; o.x = cvt_pk_bf16(hv[j][0], hv[j][1]); o.y = cvt_pk_bf16(hv[j][2], hv[j][3]); *(u32x2*)(hrow + cc) = o; }
}
__device__ __forceinline__ void phase_modulate_mix(const Ctx& c, int l) {
    const int gw = c.bid * NWAVES + c.wave, NGW = c.G * NWAVES;
    for (int row = gw; row < T; row += NGW) { const int bi = row_modidx(row); f32x4 hv[4];
        modulate_row(xin_row(c, l, row), c.in[I_GMIX] + l * D, modp(c, l, bi, 0), modp(c, l, bi, 1), (bf16_t*)(c.ws + WS_H) + (size_t)row * D, c.lane, hv); }
}
struct EpiZ { static constexpr bool PERM = true, MID = false; bf16_t* Z; const float* bgate;
    __device__ __forceinline__ void operator()(const f32x4 (&acc)[2][2][4][2], const pg8::Unit& u, int wr, int wc, int fr, int fq) const {
        int row0 = u.pm * 256 + wr * 64 + fr; asm volatile("" : "+v"(row0)); const int col0 = u.pn * 256 + wc * 32 + 8 * fq;
        const int mode = (u.pn >= 23) ? 3 : ((u.pn >= 16 && u.pn < 20) ? 2 : ((u.pn == 8 || u.pn == 9) ? 1 : 0));
        f32x4 bv[2][2];
#pragma unroll
        for (int bj = 0; bj < 2; ++bj)
#pragma unroll
            for (int n = 0; n < 2; ++n) bv[bj][n] = (mode == 3) ? *(const f32x4*)(bgate + (col0 - ZGT) + bj * 128 + 4 * n) : (f32x4){0.f, 0.f, 0.f, 0.f};
#pragma unroll
        for (int ai = 0; ai < 2; ++ai)
#pragma unroll
            for (int m = 0; m < 4; ++m) { bf16_t* rowp = Z + (size_t)(row0 + ai * 128 + m * 16) * NZ + col0;
#pragma unroll
                for (int bj = 0; bj < 2; ++bj) { f32x4 v0 = acc[ai][bj][m][0], v1 = acc[ai][bj][m][1];
                    if (mode == 1) { v0 = v0 * 0.08838834764831845f; v1 = v1 * 0.08838834764831845f; }
                    else if (mode == 2) {
#pragma unroll
                        for (int e = 0; e < 4; ++e) { v0[e] = siluf_(v0[e]); v1[e] = siluf_(v1[e]); } }
                    else if (mode == 3) { v0 = v0 + bv[bj][0]; v1 = v1 + bv[bj][1];
#pragma unroll
                        for (int e = 0; e < 4; ++e) { v0[e] = fmaxf(sigmoidf_(v0[e]), 1e-20f); v1[e] = fmaxf(sigmoidf_(v1[e]), 1e-20f); } }
                    u32x4 w; w.x = cvt_pk_bf16(v0[0], v0[1]); w.y = cvt_pk_bf16(v0[2], v0[3]); w.z = cvt_pk_bf16(v1[0], v1[1]); w.w = cvt_pk_bf16(v1[2], v1[3]);
                    *(u32x4*)(rowp + bj * 128) = w; } }
    }
};
struct EpiPlain { static constexpr bool PERM = true, MID = false; bf16_t* O; int ldc;
    __device__ __forceinline__ void operator()(const f32x4 (&acc)[2][2][4][2], const pg8::Unit& u, int wr, int wc, int fr, int fq) const {
        int row0 = u.pm * 256 + wr * 64 + fr; asm volatile("" : "+v"(row0)); const int col0 = u.pn * 256 + wc * 32 + 8 * fq;
#pragma unroll
        for (int ai = 0; ai < 2; ++ai)
#pragma unroll
            for (int m = 0; m < 4; ++m) { bf16_t* rowp = O + (size_t)(row0 + ai * 128 + m * 16) * ldc + col0;
#pragma unroll
                for (int bj = 0; bj < 2; ++bj) { const f32x4 v0 = acc[ai][bj][m][0], v1 = acc[ai][bj][m][1];
                    u32x4 w; w.x = cvt_pk_bf16(v0[0], v0[1]); w.y = cvt_pk_bf16(v0[2], v0[3]); w.z = cvt_pk_bf16(v1[0], v1[1]); w.w = cvt_pk_bf16(v1[2], v1[3]);
                    *(u32x4*)(rowp + bj * 128) = w; } }
    }
};
struct EpiMerge { static constexpr bool PERM = true, MID = true; bf16_t* O; const bf16_t* Z;
    __device__ __forceinline__ void ld8(const bf16_t* p, float (&g)[8]) const { const u32x4 w = *(const u32x4*)p; g[0] = bflo(w.x); g[1] = bfhi(w.x); g[2] = bflo(w.y); g[3] = bfhi(w.y); g[4] = bflo(w.z); g[5] = bfhi(w.z); g[6] = bflo(w.w); g[7] = bfhi(w.w); }
    __device__ __forceinline__ void mid(f32x4 (&acc)[2][2][4][2], const pg8::Unit& u, int t, int wr, int wc, int fr, int fq) const {
        int row0 = u.pm * 256 + wr * 64 + fr; asm volatile("" : "+v"(row0)); const int col0 = u.pn * 256 + wc * 32 + 8 * fq; const int seg = (t == 16) ? 0 : 1;
#pragma unroll
        for (int ai = 0; ai < 2; ++ai)
#pragma unroll
            for (int m = 0; m < 4; ++m) { const bf16_t* gp = Z + (size_t)(row0 + ai * 128 + m * 16) * NZ + ZGT + seg * D + col0;
#pragma unroll
                for (int bj = 0; bj < 2; ++bj) { float ga[8], gb[8]; ld8(gp + bj * 128, ga); ld8(gp + D + bj * 128, gb);
#pragma unroll
                    for (int e = 0; e < 4; ++e) { acc[ai][bj][m][0][e] *= ga[e] * fast_rcp(gb[e]); acc[ai][bj][m][1][e] *= ga[4 + e] * fast_rcp(gb[4 + e]); } }
                __builtin_amdgcn_sched_barrier(0); }
    }
    __device__ __forceinline__ void operator()(const f32x4 (&acc)[2][2][4][2], const pg8::Unit& u, int wr, int wc, int fr, int fq) const {
        int row0 = u.pm * 256 + wr * 64 + fr; asm volatile("" : "+v"(row0)); const int col0 = u.pn * 256 + wc * 32 + 8 * fq;
#pragma unroll
        for (int ai = 0; ai < 2; ++ai)
#pragma unroll
            for (int m = 0; m < 4; ++m) { const size_t r = (size_t)(row0 + ai * 128 + m * 16); const bf16_t* gp = Z + r * NZ + ZGT + 2 * D + col0; bf16_t* rowp = O + r * D + col0;
#pragma unroll
                for (int bj = 0; bj < 2; ++bj) { float gc[8]; ld8(gp + bj * 128, gc); const f32x4 v0 = acc[ai][bj][m][0], v1 = acc[ai][bj][m][1];
                    u32x4 w; w.x = cvt_pk_bf16(v0[0] * gc[0], v0[1] * gc[1]); w.y = cvt_pk_bf16(v0[2] * gc[2], v0[3] * gc[3]); w.z = cvt_pk_bf16(v1[0] * gc[4], v1[1] * gc[5]); w.w = cvt_pk_bf16(v1[2] * gc[6], v1[3] * gc[7]);
                    *(u32x4*)(rowp + bj * 128) = w; }
                __builtin_amdgcn_sched_barrier(0); }
    }
};
struct EpiResid { static constexpr bool PERM = false, MID = false; const Ctx* c; int l;
    __device__ __forceinline__ void operator()(const f32x4 (&acc)[2][2][4][2], const pg8::Unit& u, int wr, int wc, int fr, int fq) const {
        int row0 = u.pm * 256 + wr * 64 + fr; asm volatile("" : "+v"(row0)); const int col0 = u.pn * 256 + wc * 32 + 4 * fq; const float* gate = modp(*c, l, row_modidx(u.pm * 256), 2);
        f32x4 gv[2][2];
#pragma unroll
        for (int bj = 0; bj < 2; ++bj)
#pragma unroll
            for (int n = 0; n < 2; ++n) gv[bj][n] = *(const f32x4*)(gate + col0 + bj * 128 + 16 * n);
#pragma unroll
        for (int ai = 0; ai < 2; ++ai)
#pragma unroll
            for (int m = 0; m < 4; ++m) { const int row = row0 + ai * 128 + m * 16; const float* xi = xin_row(*c, l, row) + col0; float* xo = xout_row(*c, row) + col0;
#pragma unroll
                for (int bj = 0; bj < 2; ++bj)
#pragma unroll
                    for (int n = 0; n < 2; ++n) { const f32x4 xv = *(const f32x4*)(xi + bj * 128 + 16 * n); *(f32x4*)(xo + bj * 128 + 16 * n) = xv + gv[bj][n] * acc[ai][bj][m][n]; } }
    }
};
struct EpiSwiGLU { static constexpr bool PERM = true, MID = false; bf16_t* HID;
    __device__ __forceinline__ void operator()(const f32x4 (&acc)[2][2][4][2], const pg8::Unit& u, int wr, int wc, int fr, int fq) const {
        int row0 = u.pm * 256 + wr * 64 + fr; asm volatile("" : "+v"(row0)); const int col0 = u.pn * 128 + wc * 32 + 8 * fq; bf16_t* base = HID + (size_t)u.g * ESLOTS * DEXP;
#pragma unroll
        for (int ai = 0; ai < 2; ++ai)
#pragma unroll
            for (int m = 0; m < 4; ++m) { float h[8];
#pragma unroll
                for (int n = 0; n < 2; ++n)
#pragma unroll
                    for (int e = 0; e < 4; ++e) h[4 * n + e] = siluf_(acc[ai][0][m][n][e]) * acc[ai][1][m][n][e];
                u32x4 w; w.x = cvt_pk_bf16(h[0], h[1]); w.y = cvt_pk_bf16(h[2], h[3]); w.z = cvt_pk_bf16(h[4], h[5]); w.w = cvt_pk_bf16(h[6], h[7]);
                *(u32x4*)(base + (size_t)(row0 + ai * 128 + m * 16) * DEXP + col0) = w; }
    }
};
struct EpiDown { static constexpr bool PERM = true, MID = false; bf16_t* YS; const float* gatev;
    __device__ __forceinline__ void operator()(const f32x4 (&acc)[2][2][4][2], const pg8::Unit& u, int wr, int wc, int fr, int fq) const {
        int row0 = u.pm * 256 + wr * 64 + fr; asm volatile("" : "+v"(row0)); const int col0 = u.pn * 256 + wc * 32 + 8 * fq; bf16_t* base = YS + (size_t)u.g * ESLOTS * D; const float* gp = gatev + u.g * ESLOTS;
#pragma unroll
        for (int ai = 0; ai < 2; ++ai)
#pragma unroll
            for (int m = 0; m < 4; ++m) { const int row = row0 + ai * 128 + m * 16; const float gs = gp[row]; bf16_t* rowp = base + (size_t)row * D + col0;
#pragma unroll
                for (int bj = 0; bj < 2; ++bj) { const f32x4 v0 = acc[ai][bj][m][0] * gs, v1 = acc[ai][bj][m][1] * gs;
                    u32x4 w; w.x = cvt_pk_bf16(v0[0], v0[1]); w.y = cvt_pk_bf16(v0[2], v0[3]); w.z = cvt_pk_bf16(v1[0], v1[1]); w.w = cvt_pk_bf16(v1[2], v1[3]);
                    *(u32x4*)(rowp + bj * 128) = w; } }
    }
};
__device__ __forceinline__ void mixA_unit(const Ctx& c, int l, int un) {
    const int cn = un >> 3, g = un & 7; const int row0 = cn * 128;
    const bf16_t* Z = (const bf16_t*)(c.ws + WS_RA); bf16_t* Y = (bf16_t*)(c.ws + WS_RB + RB_YCAT);
    const bf16_t* WSb = (const bf16_t*)(c.ws + WS_WT + (size_t)l * WT_LAYER + WT_S) + g * 16384;
    LAS bf16_t* VT = (LAS bf16_t*)c.lds;
    { const int s = c.tid >> 2, qd = c.tid & 3; const bf16_t* p = Z + (size_t)(row0 + s) * NZ + ZVA + g * 128 + qd * 32;
      float v[32];
#pragma unroll
      for (int i = 0; i < 4; ++i) { const u32x4 w = *(const u32x4*)(p + 8 * i); v[8 * i] = bflo(w.x); v[8 * i + 1] = bfhi(w.x); v[8 * i + 2] = bflo(w.y); v[8 * i + 3] = bfhi(w.y); v[8 * i + 4] = bflo(w.z); v[8 * i + 5] = bfhi(w.z); v[8 * i + 6] = bflo(w.w); v[8 * i + 7] = bfhi(w.w); }
      float sm = 0.f;
#pragma unroll
      for (int i = 0; i < 32; ++i) sm += v[i];
      sm += __shfl_xor(sm, 1); sm += __shfl_xor(sm, 2); const float mu = sm * (1.f / 128.f); float sq = 0.f;
#pragma unroll
      for (int i = 0; i < 32; ++i) { v[i] -= mu; sq += v[i] * v[i]; }
      sq += __shfl_xor(sq, 1); sq += __shfl_xor(sq, 2); const float rstd = 1.0f / sqrtf(sq * (1.f / 128.f) + EPS);
#pragma unroll
      for (int i = 0; i < 32; ++i) VT[(qd * 32 + i) * 136 + s] = f2bf(v[i] * rstd); }
    __syncthreads();
    const int w = c.wave, lr = c.lane & 15, lq = c.lane >> 4;
    bf16x8 bw[4];
#pragma unroll
    for (int ks = 0; ks < 4; ++ks) bw[ks] = *(const bf16x8*)(WSb + (16 * w + lr) * 128 + 32 * ks + 8 * lq);
    const int t = row0 + 16 * w + lr; const float bs = c.in[I_BS][(l * 8 + g) * 128 + 16 * w + lr];
#pragma unroll
    for (int ct = 0; ct < 8; ++ct) { f32x4 acc = {0.f, 0.f, 0.f, 0.f};
#pragma unroll
        for (int ks = 0; ks < 4; ++ks) { const bf16x8 a = *(const LAS bf16x8*)(VT + (16 * ct + lr) * 136 + 32 * ks + 8 * lq); acc = __builtin_amdgcn_mfma_f32_16x16x32_bf16(a, bw[ks], acc, 0, 0, 0); }
        const int cc = g * 128 + 16 * ct + 4 * lq; const u32x2 uw = *(const u32x2*)(Z + (size_t)t * NZ + ZU + cc);
        u32x2 o; o.x = cvt_pk_bf16(bflo(uw.x) * (acc[0] + bs), bfhi(uw.x) * (acc[1] + bs)); o.y = cvt_pk_bf16(bflo(uw.y) * (acc[2] + bs), bfhi(uw.y) * (acc[3] + bs));
        *(u32x2*)(Y + (size_t)t * 3072 + cc) = o; }
    __syncthreads();
}
__device__ __forceinline__ void gla_b1_unit(const Ctx& c, int l, int un) {
    const int n = un >> 2, h = un & 3, row0 = n * 64, tid = c.tid, lane = c.lane, w = c.wave, lr = lane & 15, lq = lane >> 4;
    const bf16_t* Z = (const bf16_t*)(c.ws + WS_RA);
    LAS bf16_t* VTs = (LAS bf16_t*)c.lds;
    LAS float* Ds = (LAS float*)(c.lds + 36864);
    LAS float* La = (LAS float*)(c.lds + 45056);
    LAS float* Tot = (LAS float*)(c.lds + 78080);
    LAS bf16_t* QD = (LAS bf16_t*)(c.lds + 80128);
    LAS bf16_t* KI = (LAS bf16_t*)(c.lds + 97536);
    LAS bf16_t* Ps = (LAS bf16_t*)(c.lds + 114944);
    LAS bf16_t* KdT = (LAS bf16_t*)(c.lds + 124160);
    { const int t = tid >> 3, cb = (tid & 7) * 32; const bf16_t* p = Z + (size_t)(row0 + t) * NZ + ZVB + h * 256 + cb;
#pragma unroll
      for (int i = 0; i < 4; ++i) { const u32x4 wv = *(const u32x4*)(p + 8 * i); LAS bf16_t* d = VTs + (cb + 8 * i) * 72 + t;
        d[0] = (bf16_t)wv.x; d[72] = (bf16_t)(wv.x >> 16); d[144] = (bf16_t)wv.y; d[216] = (bf16_t)(wv.y >> 16); d[288] = (bf16_t)wv.z; d[360] = (bf16_t)(wv.z >> 16); d[432] = (bf16_t)wv.w; d[504] = (bf16_t)(wv.w >> 16); }
      const int dt = tid >> 3, dc = (tid & 7) * 4; const u32x2 dv = *(const u32x2*)(Z + (size_t)(row0 + dt) * NZ + ZDEC + dc);
      Ds[dt * 32 + dc] = bflo(dv.x); Ds[dt * 32 + dc + 1] = bfhi(dv.x); Ds[dt * 32 + dc + 2] = bflo(dv.y); Ds[dt * 32 + dc + 3] = bfhi(dv.y); }
    __syncthreads();
    f32x4 pacc[2] = {{0.f, 0.f, 0.f, 0.f}, {0.f, 0.f, 0.f, 0.f}};
#pragma unroll 1
    for (int dir = 0; dir < 2; ++dir) {
        { const int ch = tid & 127, t0 = tid >> 7; const float* wd = c.in[I_WDEC] + (size_t)(l * 2 + dir) * 16 * 512 + h * 128 + ch; float wv[16];
#pragma unroll
          for (int r = 0; r < 16; ++r) wv[r] = wd[r * 512];
          const float bias = c.in[I_BDEC][(l * 2 + dir) * 512 + h * 128 + ch];
#pragma unroll 4
          for (int i = 0; i < 16; ++i) { const int t = t0 + 4 * i; float pre = bias;
#pragma unroll
              for (int r = 0; r < 16; ++r) pre += Ds[t * 32 + dir * 16 + r] * wv[r];
              const float ls = fminf(pre, 0.f) - __logf(1.f + __expf(-fabsf(pre)));
              La[t * 129 + ch] = ls * 0.0625f; } }
        __syncthreads();
        { const int ch = tid & 127, sg = tid >> 7; float loc[16]; float run = 0.f;
          if (dir == 0) {
#pragma unroll
              for (int i = 0; i < 16; ++i) { run += La[(16 * sg + i) * 129 + ch]; loc[i] = run; } }
          else {
#pragma unroll
              for (int i = 15; i >= 0; --i) { run += La[(16 * sg + i) * 129 + ch]; loc[i] = run; } }
          Tot[sg * 128 + ch] = run;
          __syncthreads();
          float off = 0.f;
#pragma unroll
          for (int s2 = 0; s2 < 4; ++s2) { const float tv = Tot[s2 * 128 + ch]; if (dir == 0 ? (s2 < sg) : (s2 > sg)) off += tv; }
#pragma unroll
          for (int i = 0; i < 16; ++i) La[(16 * sg + i) * 129 + ch] = loc[i] + off; }
        __syncthreads();
        { const int t = tid >> 3, cb = (tid & 7) * 16; const bf16_t* qp = Z + (size_t)(row0 + t) * NZ + ZQB + h * 128 + cb; const bf16_t* kp = Z + (size_t)(row0 + t) * NZ + ZKB + h * 128 + cb;
          float q[16], k[16];
#pragma unroll
          for (int i = 0; i < 2; ++i) { const u32x4 a = *(const u32x4*)(qp + 8 * i), b = *(const u32x4*)(kp + 8 * i);
              q[8 * i] = bflo(a.x); q[8 * i + 1] = bfhi(a.x); q[8 * i + 2] = bflo(a.y); q[8 * i + 3] = bfhi(a.y); q[8 * i + 4] = bflo(a.z); q[8 * i + 5] = bfhi(a.z); q[8 * i + 6] = bflo(a.w); q[8 * i + 7] = bfhi(a.w);
              k[8 * i] = bflo(b.x); k[8 * i + 1] = bfhi(b.x); k[8 * i + 2] = bflo(b.y); k[8 * i + 3] = bfhi(b.y); k[8 * i + 4] = bflo(b.z); k[8 * i + 5] = bfhi(b.z); k[8 * i + 6] = bflo(b.w); k[8 * i + 7] = bfhi(b.w); }
          const int tl = (dir == 0) ? 63 : 0; float qd[16], ki[16];
#pragma unroll
          for (int i = 0; i < 16; ++i) { const float b = La[t * 129 + cb + i], bl = La[tl * 129 + cb + i]; const float e = __expf(b);
              qd[i] = q[i] * e; ki[i] = k[i] * fast_rcp(e); KdT[(cb + i) * 72 + t] = f2bf(k[i] * __expf(bl - b)); }
          u32x4 o0, o1;
          o0.x = cvt_pk_bf16(qd[0], qd[1]); o0.y = cvt_pk_bf16(qd[2], qd[3]); o0.z = cvt_pk_bf16(qd[4], qd[5]); o0.w = cvt_pk_bf16(qd[6], qd[7]);
          o1.x = cvt_pk_bf16(qd[8], qd[9]); o1.y = cvt_pk_bf16(qd[10], qd[11]); o1.z = cvt_pk_bf16(qd[12], qd[13]); o1.w = cvt_pk_bf16(qd[14], qd[15]);
          *(LAS u32x4*)(QD + t * 136 + cb) = o0; *(LAS u32x4*)(QD + t * 136 + cb + 8) = o1;
          bf16_t* qg = (bf16_t*)(c.ws + WS_RB + RB_QDF) + ((size_t)(dir * 1088 + un) * 64 + t) * 128 + cb;
          u32x4 p0, p1; p0.x = o0.x; p0.y = o0.y; p0.z = o1.x; p0.w = o1.y; p1.x = o0.z; p1.y = o0.w; p1.z = o1.z; p1.w = o1.w;
          *(u32x4*)qg = p0; *(u32x4*)(qg + 8) = p1;
          o0.x = cvt_pk_bf16(ki[0], ki[1]); o0.y = cvt_pk_bf16(ki[2], ki[3]); o0.z = cvt_pk_bf16(ki[4], ki[5]); o0.w = cvt_pk_bf16(ki[6], ki[7]);
          o1.x = cvt_pk_bf16(ki[8], ki[9]); o1.y = cvt_pk_bf16(ki[10], ki[11]); o1.z = cvt_pk_bf16(ki[12], ki[13]); o1.w = cvt_pk_bf16(ki[14], ki[15]);
          *(LAS u32x4*)(KI + t * 136 + cb) = o0; *(LAS u32x4*)(KI + t * 136 + cb + 8) = o1;
          if (tid < 128) ((float*)(c.ws + WS_RB + RB_DECAY))[(size_t)(dir * 1088 + un) * 128 + tid] = __expf(La[tl * 129 + tid]); }
        __syncthreads();
        { bf16_t* kg = (bf16_t*)(c.ws + WS_RB + RB_KDT) + (size_t)(dir * 1088 + un) * 8192;
#pragma unroll
          for (int i = 0; i < 2; ++i) { const int id = tid + 512 * i, ch = id >> 3, tc = id & 7; *(u32x4*)(kg + ch * 64 + tc * 8) = *(const LAS u32x4*)(KdT + ch * 72 + tc * 8); } }
        { const int it = w >> 1; bf16x8 a[4];
#pragma unroll
          for (int ks = 0; ks < 4; ++ks) a[ks] = *(const LAS bf16x8*)(QD + (16 * it + lr) * 136 + 32 * ks + 8 * lq);
#pragma unroll
          for (int jj = 0; jj < 2; ++jj) { const int jt = 2 * (w & 1) + jj; f32x4 s = {0.f, 0.f, 0.f, 0.f};
#pragma unroll
              for (int ks = 0; ks < 4; ++ks) { const bf16x8 b = *(const LAS bf16x8*)(KI + (16 * jt + lr) * 136 + 32 * ks + 8 * lq); s = __builtin_amdgcn_mfma_f32_16x16x32_bf16(a[ks], b, s, 0, 0, 0); }
              const int j = 16 * jt + lr;
#pragma unroll
              for (int e = 0; e < 4; ++e) { const int i = 16 * it + 4 * lq + e; const bool keep = (dir == 0) ? (j <= i) : (j >= i); pacc[jj][e] += keep ? s[e] : 0.f; } } }
        __syncthreads();
    }
    { const int it = w >> 1;
#pragma unroll
      for (int jj = 0; jj < 2; ++jj) { const int j = 16 * (2 * (w & 1) + jj) + lr;
#pragma unroll
          for (int e = 0; e < 4; ++e) { Ps[(16 * it + 4 * lq + e) * 72 + j] = f2bf(pacc[jj][e]); } } }
    __syncthreads();
    { bf16_t* OI = (bf16_t*)(c.ws + WS_RB + RB_OINTRA);
#pragma unroll
      for (int dd = 0; dd < 2; ++dd) { const int dt = 2 * w + dd; bf16x8 a[2];
#pragma unroll
          for (int ks = 0; ks < 2; ++ks) a[ks] = *(const LAS bf16x8*)(VTs + (16 * dt + lr) * 72 + 32 * ks + 8 * lq);
#pragma unroll
          for (int it = 0; it < 4; ++it) { f32x4 o = {0.f, 0.f, 0.f, 0.f};
#pragma unroll
              for (int ks = 0; ks < 2; ++ks) { const bf16x8 b = *(const LAS bf16x8*)(Ps + (16 * it + lr) * 72 + 32 * ks + 8 * lq); o = __builtin_amdgcn_mfma_f32_16x16x32_bf16(a[ks], b, o, 0, 0, 0); }

              u32x2 ov; ov.x = cvt_pk_bf16(o[0], o[1]); ov.y = cvt_pk_bf16(o[2], o[3]);
              *(u32x2*)(OI + (size_t)(row0 + 16 * it + lr) * D + h * 256 + 16 * dt + 4 * lq) = ov; } } }
    { bf16_t* vg = (bf16_t*)(c.ws + WS_RB + RB_VTG) + (size_t)un * 16384;
#pragma unroll
      for (int i = 0; i < 4; ++i) { const int id = tid + 512 * i, dv = id >> 3, tc = id & 7; *(u32x4*)(vg + dv * 64 + tc * 8) = *(const LAS u32x4*)(VTs + dv * 72 + tc * 8); } }
    __syncthreads();
}
__device__ __forceinline__ void gla_b2_wave(const Ctx& c, int wu) {
    const int lane = c.lane, lr = lane & 31, hi = lane >> 5;
    const int dvs = wu & 7, h = (wu >> 3) & 3, b = (wu >> 5) & 3, dir = wu >> 7;
    const bf16_t* QDF = (const bf16_t*)(c.ws + WS_RB + RB_QDF) + (size_t)dir * 1088 * 8192;
    const bf16_t* KDT = (const bf16_t*)(c.ws + WS_RB + RB_KDT) + (size_t)dir * 1088 * 8192;
    const bf16_t* VTG = (const bf16_t*)(c.ws + WS_RB + RB_VTG);
    const float* DEC = (const float*)(c.ws + WS_RB + RB_DECAY) + (size_t)dir * 1088 * 128;
    bf16_t* OUT = (bf16_t*)(c.ws + WS_RB + (dir == 0 ? RB_OF : RB_OB));
    f32x16 S[4];
#pragma unroll
    for (int ct = 0; ct < 4; ++ct)
#pragma unroll
        for (int r = 0; r < 16; ++r) S[ct][r] = 0.f;
#pragma unroll 1
    for (int step = 0; step < 68; ++step) {
        int n;
        if (step < 4) n = 256 + 4 * b + (dir == 0 ? step : 3 - step); else n = 64 * b + (dir == 0 ? step - 4 : 67 - step);
        const int un = n * 4 + h, row0 = n * 64;
        const bf16_t* qd = QDF + (size_t)un * 8192; const bf16_t* kd = KDT + (size_t)un * 8192; const bf16_t* vt = VTG + (size_t)un * 16384 + (size_t)(32 * dvs) * 64; const float* dc = DEC + (size_t)un * 128;
        f32x16 o[2];
#pragma unroll
        for (int tt = 0; tt < 2; ++tt)
#pragma unroll
            for (int r = 0; r < 16; ++r) o[tt][r] = 0.f;
#pragma unroll
        for (int ct = 0; ct < 4; ++ct)
#pragma unroll
            for (int s = 0; s < 2; ++s) { u32x4 bw; bw.x = cvt_pk_bf16(S[ct][8 * s], S[ct][8 * s + 1]); bw.y = cvt_pk_bf16(S[ct][8 * s + 2], S[ct][8 * s + 3]); bw.z = cvt_pk_bf16(S[ct][8 * s + 4], S[ct][8 * s + 5]); bw.w = cvt_pk_bf16(S[ct][8 * s + 6], S[ct][8 * s + 7]);
                const bf16x8 bfr = __builtin_bit_cast(bf16x8, bw);
#pragma unroll
                for (int tt = 0; tt < 2; ++tt) { const bf16x8 a = *(const bf16x8*)(qd + (32 * tt + lr) * 128 + 32 * ct + 16 * s + 8 * hi); o[tt] = __builtin_amdgcn_mfma_f32_32x32x16_bf16(a, bfr, o[tt], 0, 0, 0); } }
#pragma unroll
        for (int tt = 0; tt < 2; ++tt)
#pragma unroll
            for (int r = 0; r < 16; ++r) { const int t = 32 * tt + (r & 3) + 8 * (r >> 2) + 4 * hi; OUT[(size_t)(row0 + t) * D + h * 256 + 32 * dvs + lr] = f2bf(o[tt][r]); }
#pragma unroll
        for (int ct = 0; ct < 4; ++ct) {
#pragma unroll
            for (int gq = 0; gq < 4; ++gq) { const f32x4 d4 = *(const f32x4*)(dc + 32 * ct + 8 * gq + 4 * hi);
#pragma unroll
                for (int e = 0; e < 4; ++e) S[ct][4 * gq + e] *= d4[e]; }
#pragma unroll
            for (int ks = 0; ks < 4; ++ks) { const bf16x8 a = *(const bf16x8*)(kd + (32 * ct + lr) * 64 + 16 * ks + 8 * hi); const bf16x8 bv = *(const bf16x8*)(vt + lr * 64 + 16 * ks + 8 * hi);
                S[ct] = __builtin_amdgcn_mfma_f32_32x32x16_bf16(a, bv, S[ct], 0, 0, 0); } }
    }
}
__device__ __forceinline__ void gla_finish_row(const Ctx& c, int l, int row) {
    const int lane = c.lane; const bf16_t* OI = (const bf16_t*)(c.ws + WS_RB + RB_OINTRA) + (size_t)row * D; const bf16_t* OFp = (const bf16_t*)(c.ws + WS_RB + RB_OF) + (size_t)row * D; const bf16_t* OBp = (const bf16_t*)(c.ws + WS_RB + RB_OB) + (size_t)row * D;
    const bf16_t* R = (const bf16_t*)(c.ws + WS_RA) + (size_t)row * NZ + ZRB; bf16_t* Y = (bf16_t*)(c.ws + WS_RB + RB_YCAT) + (size_t)row * 3072 + D;
    const f32x4 gv = *(const f32x4*)(c.in[I_GGLA] + l * 256 + 4 * lane);
#pragma unroll
    for (int h = 0; h < 4; ++h) { const int cc = h * 256 + 4 * lane; const u32x2 a = *(const u32x2*)(OI + cc), b = *(const u32x2*)(OFp + cc), d = *(const u32x2*)(OBp + cc), r = *(const u32x2*)(R + cc);
        float o[4] = {bflo(a.x) + bflo(b.x) + bflo(d.x), bfhi(a.x) + bfhi(b.x) + bfhi(d.x), bflo(a.y) + bflo(b.y) + bflo(d.y), bfhi(a.y) + bfhi(b.y) + bfhi(d.y)};
        const float ss = wave_sum((o[0] * o[0] + o[1] * o[1]) + (o[2] * o[2] + o[3] * o[3])); const float rstd = 1.0f / sqrtf(ss * (1.f / 256.f) + EPS);
        u32x2 ov; ov.x = cvt_pk_bf16(o[0] * rstd * gv[0] * bflo(r.x), o[1] * rstd * gv[1] * bfhi(r.x)); ov.y = cvt_pk_bf16(o[2] * rstd * gv[2] * bflo(r.y), o[3] * rstd * gv[3] * bfhi(r.y));
        *(u32x2*)(Y + cc) = ov; }
}
__device__ __forceinline__ void rope_angle(int pos_row, int pos_col, int j, float& cs, float& sn) {
    const int axis = j >> 5, f = j & 15; const float inv = __expf(-(float)(2 * f) * (1.f / 32.f) * 9.210340371976184f);
    float rev = (float)(axis == 0 ? pos_row : pos_col) * inv * 0.15915494309189535f; rev -= floorf(rev); sn = __builtin_amdgcn_sinf(rev); cs = __builtin_amdgcn_cosf(rev);
}
__device__ __forceinline__ void mla_c1_row(const Ctx& c, int l, int row, bool do_q) {
    const int lane = c.lane; const bool lat = row < TL; const int b = lat ? (row >> 12) : ((row - TL) >> 8), t = lat ? (row & 4095) : ((row - TL) & 255), key = lat ? (CTXL + t) : t;
    const bf16_t* Zr = (const bf16_t*)(c.ws + WS_RA) + (size_t)row * NZ;
    const bf16_t* KV = (const bf16_t*)(c.ws + WS_RB + RB_KVRAW) + (size_t)row * 2048; const bf16_t* QR = (const bf16_t*)(c.ws + WS_RB + RB_QRAW) + (size_t)row * 1536;
    bf16_t* KG = (bf16_t*)(c.ws + WS_RB + RB_KG); bf16_t* VG = (bf16_t*)(c.ws + WS_RB + RB_VG);
    float rs_kv, rs_q;
    { const u32x2 w = *(const u32x2*)(Zr + ZCKV + 4 * lane); const float a0 = bflo(w.x), a1 = bfhi(w.x), a2 = bflo(w.y), a3 = bfhi(w.y);
      rs_kv = 1.0f / sqrtf(wave_sum((a0 * a0 + a1 * a1) + (a2 * a2 + a3 * a3)) * (1.f / 256.f) + EPS);
      float s = 0.f;
#pragma unroll
      for (int i = 0; i < 3; ++i) { const unsigned w2 = *(const unsigned*)(Zr + ZCQ + 128 * i + 2 * lane); const float q0 = bflo(w2), q1 = bfhi(w2); s += q0 * q0 + q1 * q1; }
      rs_q = 1.0f / sqrtf(wave_sum(s) * (1.f / 384.f) + EPS); }
    float cs = 1.f, sn = 0.f; if (lat) rope_angle(t >> 6, t & 63, lane, cs, sn);
    const bool second = (lane >> 4) & 1;
    float kr;
    { const float v = bf2f(Zr[ZKR + lane]); const float rr = 1.0f / sqrtf(wave_sum(v * v) * (1.f / 64.f) + EPS); float x = v * rr * c.in[I_GKR][l * 64 + lane];
      const float xp = __shfl_xor(x, 16); kr = lat ? (second ? (x * cs + xp * sn) : (x * cs - xp * sn)) : x; }
    const bf16_t krb = f2bf(kr);
    const f32x4 gkn = *(const f32x4*)(c.in[I_GKN] + l * 128 + 4 * (lane & 31));
#pragma unroll 2
    for (int h = 0; h < 8; ++h) {
        const u32x2 w = *(const u32x2*)(KV + h * 256 + 4 * lane); float a[4] = {bflo(w.x) * rs_kv, bfhi(w.x) * rs_kv, bflo(w.y) * rs_kv, bfhi(w.y) * rs_kv};
        float ss = (a[0] * a[0] + a[1] * a[1]) + (a[2] * a[2] + a[3] * a[3]);
#pragma unroll
        for (int o = 1; o < 32; o <<= 1) ss += __shfl_xor(ss, o);
        const size_t kb = ((size_t)(b * 8 + h) * NKEY + key);
        if (lane < 32) { const float rn = 1.0f / sqrtf(ss * (1.f / 128.f) + EPS); u32x2 o; o.x = cvt_pk_bf16(a[0] * rn * gkn[0], a[1] * rn * gkn[1]); o.y = cvt_pk_bf16(a[2] * rn * gkn[2], a[3] * rn * gkn[3]);
            *(u32x2*)(KG + kb * 192 + 4 * lane) = o; }
        else { u32x2 o; o.x = cvt_pk_bf16(a[0], a[1]); o.y = cvt_pk_bf16(a[2], a[3]); *(u32x2*)(VG + kb * 128 + 4 * (lane - 32)) = o; }
        KG[kb * 192 + 128 + lane] = krb;
    }
    if (!do_q) return;
    bf16_t* QF = lat ? (bf16_t*)(c.ws + WS_RB + RB_QFL) : (bf16_t*)(c.ws + WS_RB + RB_QFC); const int nq = lat ? SEQ : CTXL;
    const float QS = 0.07216878364870322f * 1.4426950408889634f;
    const f32x2 gqn = *(const f32x2*)(c.in[I_GQN] + l * 128 + 2 * lane); const float gqr = c.in[I_GQR][l * 64 + lane];
#pragma unroll 2
    for (int h = 0; h < 8; ++h) {
        const unsigned w = *(const unsigned*)(QR + h * 192 + 2 * lane); const float n0 = bflo(w) * rs_q, n1 = bfhi(w) * rs_q; const float r0 = bf2f(QR[h * 192 + 128 + lane]) * rs_q;
        const float rn = 1.0f / sqrtf(wave_sum(n0 * n0 + n1 * n1) * (1.f / 128.f) + EPS), rr = 1.0f / sqrtf(wave_sum(r0 * r0) * (1.f / 64.f) + EPS);
        const size_t qb = ((size_t)(b * 8 + h) * nq + t) * 192;
        *(unsigned*)(QF + qb + 2 * lane) = cvt_pk_bf16(n0 * rn * gqn[0] * QS, n1 * rn * gqn[1] * QS);
        const float x = r0 * rr * gqr; const float xp = __shfl_xor(x, 16); const float xr = lat ? (second ? (x * cs + xp * sn) : (x * cs - xp * sn)) : x;
        QF[qb + 128 + lane] = f2bf(xr * QS);
    }
}
__device__ __forceinline__ bf16x8 tr_pair(unsigned a0, unsigned a1) {
    bf16x4 x, y; asm volatile("ds_read_b64_tr_b16 %0, %2\n\tds_read_b64_tr_b16 %1, %3\n\ts_waitcnt lgkmcnt(0)" : "=&v"(x), "=&v"(y) : "v"(a0), "v"(a1) : "memory");
    return (bf16x8){x[0], x[1], x[2], x[3], y[0], y[1], y[2], y[3]};
}
__device__ __forceinline__ void attn_unit(const Ctx& c, const bf16_t* Qp  , const bf16_t* Kp  , const bf16_t* Vp  , int nt, bf16_t* Op  ) {
    constexpr int STG = 40960, KB = 24576;
    const int tid = c.tid, lane = c.lane, w = c.wave, lr = lane & 31, hi = lane >> 5;
    const unsigned lds0 = (unsigned)(size_t)c.lds;
    unsigned ksrc[3], vsrc[2];
#pragma unroll
    for (int i = 0; i < 3; ++i) { const int P = (w + 8 * i) * 64 + lane, row = P / 24, cp = P % 24, ch = (cp & ~7) | ((cp & 7) ^ ((row >> 1) & 7)); ksrc[i] = row * 384 + ch * 16; }
#pragma unroll
    for (int i = 0; i < 2; ++i) { const int P = (w + 8 * i) * 64 + lane, row = P >> 4, cp = P & 15, ch = cp ^ (((row & 3) << 2) | ((row >> 2) & 3)); vsrc[i] = row * 256 + ch * 16; }
#define ATT_ISSUE(tile, stg) do { const char* kt_ = (const char*)Kp + (size_t)(tile) * KB; const char* vt_ = (const char*)Vp + (size_t)(tile) * 16384; \
        _Pragma("unroll") for (int i_ = 0; i_ < 3; ++i_) __builtin_amdgcn_global_load_lds((const unsigned*)(kt_ + ksrc[i_]), (LAS unsigned*)(c.lds + (stg) * STG + (w + 8 * i_) * 1024), 16, 0, 0); \
        _Pragma("unroll") for (int i_ = 0; i_ < 2; ++i_) __builtin_amdgcn_global_load_lds((const unsigned*)(vt_ + vsrc[i_]), (LAS unsigned*)(c.lds + (stg) * STG + KB + (w + 8 * i_) * 1024), 16, 0, 0); } while (0)
    bf16x8 qf[12];
    { const bf16_t* qrow = Qp + (size_t)(32 * w + lr) * 192 + 8 * hi;
#pragma unroll
      for (int s = 0; s < 12; ++s) qf[s] = *(const bf16x8*)(qrow + 16 * s); }
    unsigned kbase = lr * 384, y16 = (unsigned)((hi ^ ((lr >> 1) & 7)) << 4);
    unsigned vbase, q64, vd1;
    { const int blk = (lane >> 4) & 1, q = (lane & 15) >> 2, p = lane & 3; const int lb = (2 * blk + (p >> 1)) ^ hi;
      vbase = KB + 256 * (4 * hi + q) + 16 * lb + 8 * (p & 1); q64 = (unsigned)(q << 6); vd1 = 2048u + ((lb & 2) ? -32 : 32); }
    f32x16 o[4];
#pragma unroll
    for (int cc = 0; cc < 4; ++cc)
#pragma unroll
        for (int r = 0; r < 16; ++r) o[cc][r] = 0.f;
    float m = -1e30f, lsum = 0.f;
    ATT_ISSUE(0, 0);
    if (nt > 1) ATT_ISSUE(1, 1);
#pragma unroll 1
    for (int j = 0; j < nt; ++j) {
        if (j + 1 < nt) asm volatile("s_waitcnt vmcnt(5)" ::: "memory"); else asm volatile("s_waitcnt vmcnt(0)" ::: "memory");
        asm volatile("s_waitcnt lgkmcnt(0)" ::: "memory"); __builtin_amdgcn_s_barrier(); asm volatile("" ::: "memory");
        if (j + 2 < nt) ATT_ISSUE(j + 2, (j + 2) % 3);
        const unsigned sb = lds0 + (unsigned)((j % 3) * STG);
        asm volatile("" : "+v"(kbase), "+v"(y16), "+v"(vbase), "+v"(q64), "+v"(vd1));
        const unsigned kb_ = sb + kbase;
        f32x16 st[2];
#pragma unroll
        for (int kt = 0; kt < 2; ++kt) {
#pragma unroll
            for (int r = 0; r < 16; ++r) st[kt][r] = 0.f;
#pragma unroll
            for (int s = 0; s < 12; ++s) { const bf16x8 a = *(const LAS bf16x8*)(size_t)(kb_ + (y16 ^ (unsigned)(((2 * s) & 7) << 4)) + (unsigned)(kt * 12288 + (((2 * s) & ~7) << 4))); st[kt] = __builtin_amdgcn_mfma_f32_32x32x16_bf16(a, qf[s], st[kt], 0, 0, 0); } }
        float mx = st[0][0];
#pragma unroll
        for (int r = 1; r < 16; ++r) mx = fmaxf(mx, st[0][r]);
#pragma unroll
        for (int r = 0; r < 16; ++r) mx = fmaxf(mx, st[1][r]);
        mx = fmaxf(mx, __shfl_xor(mx, 32));
        const float mn = fmaxf(m, mx), alpha = __builtin_amdgcn_exp2f(m - mn); m = mn;
        float ps = 0.f;
#pragma unroll
        for (int kt = 0; kt < 2; ++kt)
#pragma unroll
            for (int r = 0; r < 16; ++r) { st[kt][r] = __builtin_amdgcn_exp2f(st[kt][r] - mn); ps += st[kt][r]; }
        lsum = lsum * alpha + ps;
#pragma unroll
        for (int cc = 0; cc < 4; ++cc)
#pragma unroll
            for (int r = 0; r < 16; ++r) o[cc][r] *= alpha;
#pragma unroll
        for (int kt = 0; kt < 2; ++kt)
#pragma unroll
            for (int s2 = 0; s2 < 2; ++s2) { u32x4 pw; pw.x = cvt_pk_bf16(st[kt][8 * s2], st[kt][8 * s2 + 1]); pw.y = cvt_pk_bf16(st[kt][8 * s2 + 2], st[kt][8 * s2 + 3]); pw.z = cvt_pk_bf16(st[kt][8 * s2 + 4], st[kt][8 * s2 + 5]); pw.w = cvt_pk_bf16(st[kt][8 * s2 + 6], st[kt][8 * s2 + 7]);
                const bf16x8 pb = __builtin_bit_cast(bf16x8, pw); const unsigned rb = sb + vbase + 256 * (32 * kt + 16 * s2);
#pragma unroll
                for (int cc = 0; cc < 4; ++cc) { const unsigned a0 = rb + (q64 ^ (unsigned)(cc << 6)); const bf16x8 a = tr_pair(a0, a0 + vd1); o[cc] = __builtin_amdgcn_mfma_f32_32x32x16_bf16(a, pb, o[cc], 0, 0, 0); } }
    }
    const float linv = 1.0f / (lsum + __shfl_xor(lsum, 32));
    bf16_t* orow = Op + (size_t)(32 * w + lr) * 3072;
#pragma unroll
    for (int cc = 0; cc < 4; ++cc)
#pragma unroll
        for (int g = 0; g < 4; ++g) { u32x2 ov; ov.x = cvt_pk_bf16(o[cc][4 * g] * linv, o[cc][4 * g + 1] * linv); ov.y = cvt_pk_bf16(o[cc][4 * g + 2] * linv, o[cc][4 * g + 3] * linv);
            *(u32x2*)(orow + 32 * cc + 8 * g + 4 * hi) = ov; }
    asm volatile("s_waitcnt vmcnt(0) lgkmcnt(0)" ::: "memory"); __builtin_amdgcn_s_barrier(); asm volatile("" ::: "memory");
#undef ATT_ISSUE
}
__device__ __forceinline__ void route_row(const Ctx& c, int l, int row) {
    const int lane = c.lane, bi = row_modidx(row); f32x4 hv[4];
    modulate_row(xout_row(c, row), c.in[I_GFFN] + l * D, modp(c, l, bi, 3), modp(c, l, bi, 4), (bf16_t*)(c.ws + WS_H) + (size_t)row * D, lane, hv);
    const float* wr = c.in[I_WROUTER] + (size_t)l * D * NEXP; float lg[16];
#pragma unroll
    for (int e = 0; e < 16; ++e) lg[e] = 0.f;
#pragma unroll
    for (int j = 0; j < 4; ++j)
#pragma unroll
        for (int i = 0; i < 4; ++i) { const float* wp = wr + (size_t)(4 * lane + 256 * j + i) * NEXP; const float hvv = hv[j][i];
#pragma unroll
            for (int q = 0; q < 4; ++q) { const f32x4 wv = *(const f32x4*)(wp + 4 * q); lg[4 * q] += hvv * wv[0]; lg[4 * q + 1] += hvv * wv[1]; lg[4 * q + 2] += hvv * wv[2]; lg[4 * q + 3] += hvv * wv[3]; } }
#pragma unroll
    for (int e = 0; e < 16; ++e) lg[e] = wave_sum(lg[e]);
    float mx = lg[0];
#pragma unroll
    for (int e = 1; e < 16; ++e) mx = fmaxf(mx, lg[e]);
    float sum = 0.f;
#pragma unroll
    for (int e = 0; e < 16; ++e) { lg[e] = __expf(lg[e] - mx); sum += lg[e]; }
    const float inv = 1.0f / sum; float mine = 0.f;
#pragma unroll
    for (int e = 0; e < 16; ++e) mine = (lane == e) ? lg[e] * inv : mine;
    float* AF = (float*)(c.ws + WS_AFFT);
    if (lane < 16) { if (row < TL) AF[((size_t)(row >> 12) * 16 + lane) * SEQ + (row & 4095)] = mine; else AF[(size_t)NB * 16 * SEQ + ((size_t)((row - TL) >> 8) * 16 + lane) * CTXL + ((row - TL) & 255)] = mine; }
}
__device__ __forceinline__ void expert_wconv(const Ctx& c, int l) {
    constexpr int U_G = 16 * 32, U_D = 32 * 16, U_E = 2 * U_G + U_D;
    bf16_t* WGU = (bf16_t*)(c.ws + WS_RB + RB_WGU); bf16_t* WD = (bf16_t*)(c.ws + WS_RB + RB_WD);
    for (int u = c.bid; u < NEXP * U_E; u += c.G) { const int e = u / U_E; int r = u % U_E;
        if (r < 2 * U_G) { const int up = r / U_G, rr = r % U_G, nb = rr / 16, kb = rr % 16;
            const float* src = c.in[up ? I_WEU : I_WEG] + ((size_t)l * NEXP + e) * D * DEXP; const int drow = (nb >> 1) * 256 + up * 128 + (nb & 1) * 64;
            tconv_tile(c, src, DEXP, kb * 64, nb * 64, 64, nullptr, WGU + (size_t)e * 4096 * D, D, drow, kb * 64); }
        else { r -= 2 * U_G; const int nb = r / 32, kb = r % 32;
            tconv_tile(c, c.in[I_WED] + ((size_t)l * NEXP + e) * DEXP * D, D, kb * 64, nb * 64, 64, nullptr, WD + (size_t)e * D * DEXP, DEXP, nb * 64, kb * 64); } }
}
__device__ __forceinline__ void topk_unit(const Ctx& c, int un, bool is_ctx) {
    const int tid = c.tid; LAS float* av = (LAS float*)c.lds; LAS int* list = (LAS int*)(c.lds + 16384); LAS int* cnt = (LAS int*)(c.lds + 16384 + 4096);
    int b, e, blk, ntok, cap; const float* src;
    if (!is_ctx) { b = un >> 7; e = (un >> 3) & 15; blk = un & 7; ntok = SEQ; cap = CAPL; src = (const float*)(c.ws + WS_AFFT) + ((size_t)b * 16 + e) * SEQ; }
    else { b = un >> 4; e = un & 15; blk = 0; ntok = CTXL; cap = CAPC; src = (const float*)(c.ws + WS_AFFT) + (size_t)NB * 16 * SEQ + ((size_t)b * 16 + e) * CTXL; }
    for (int i = tid; i < ntok; i += NTHR) av[i] = src[i];
    if (tid == 0) *cnt = 0;
    __syncthreads();
    const int tok = blk * 512 + tid; const bool valid = tok < ntok; const float a = valid ? av[tok] : 0.f; int rank = 0;
    for (int j = 0; j < ntok; j += 4) { const f32x4 v = *(const LAS f32x4*)(av + j);
        rank += (v[0] > a || (v[0] == a && j < tok)) ? 1 : 0; rank += (v[1] > a || (v[1] == a && j + 1 < tok)) ? 1 : 0;
        rank += (v[2] > a || (v[2] == a && j + 2 < tok)) ? 1 : 0; rank += (v[3] > a || (v[3] == a && j + 3 < tok)) ? 1 : 0; }
    const int row = is_ctx ? (TL + b * CTXL + tok) : (b * SEQ + tok);
    if (valid) { const bool sel = rank < cap; ((int*)(c.ws + WS_SEL))[(size_t)row * 16 + e] = sel ? rank : -1;
        if (sel) { const int slot = is_ctx ? (2048 + b * CAPC + rank) : (b * CAPL + rank); ((float*)(c.ws + WS_GATEV))[e * ESLOTS + slot] = a;
            const int p = atomicAdd((int*)cnt, 1); list[2 * p] = row; list[2 * p + 1] = slot; } }
    __syncthreads();
    const int nsel = *cnt; const bf16_t* H = (const bf16_t*)(c.ws + WS_H); bf16_t* XS = (bf16_t*)(c.ws + WS_RA + RA_XS) + (size_t)e * ESLOTS * D;
    for (int i = c.wave; i < nsel; i += NWAVES) { const int r = list[2 * i], s = list[2 * i + 1]; const u32x4* sp = (const u32x4*)(H + (size_t)r * D); u32x4* dp = (u32x4*)(XS + (size_t)s * D);
        dp[c.lane] = sp[c.lane]; dp[64 + c.lane] = sp[64 + c.lane]; }
    __syncthreads();
}
__device__ __forceinline__ void combine_row(const Ctx& c, int l, int row, bool next_mod) {
    const int lane = c.lane, bi = row_modidx(row); float* xr = xout_row(c, row); const int* sel = (const int*)(c.ws + WS_SEL) + (size_t)row * 16;
    const bf16_t* YS = (const bf16_t*)(c.ws + WS_RA + RA_YS); const float* g5 = modp(c, l, bi, 5);
    f32x4 acc[4];
#pragma unroll
    for (int j = 0; j < 4; ++j) acc[j] = (f32x4){0.f, 0.f, 0.f, 0.f};
    const bool lat = row < TL; const int b = lat ? (row >> 12) : ((row - TL) >> 8);
    for (int e = 0; e < 16; ++e) { const int r = sel[e]; if (r < 0) continue; const int slot = lat ? (b * CAPL + r) : (2048 + b * CAPC + r);
        const bf16_t* yp = YS + ((size_t)e * ESLOTS + slot) * D;
#pragma unroll
        for (int j = 0; j < 4; ++j) { const u32x2 w = *(const u32x2*)(yp + 4 * lane + 256 * j); acc[j][0] += bflo(w.x); acc[j][1] += bfhi(w.x); acc[j][2] += bflo(w.y); acc[j][3] += bfhi(w.y); } }
    float ss = 0.f; f32x4 xv[4];
#pragma unroll
    for (int j = 0; j < 4; ++j) { const int cc = 4 * lane + 256 * j; xv[j] = *(const f32x4*)(xr + cc) + *(const f32x4*)(g5 + cc) * acc[j]; *(f32x4*)(xr + cc) = xv[j];
        ss += (xv[j][0] * xv[j][0] + xv[j][1] * xv[j][1]) + (xv[j][2] * xv[j][2] + xv[j][3] * xv[j][3]); }
    if (!next_mod) return;
    const float rstd = 1.0f / sqrtf(wave_sum(ss) * (1.f / D) + EPS); const float* g = c.in[I_GMIX] + (l + 1) * D; const float* sh = modp(c, l + 1, bi, 0); const float* sc = modp(c, l + 1, bi, 1);
    bf16_t* hrow = (bf16_t*)(c.ws + WS_H) + (size_t)row * D;
#pragma unroll
    for (int j = 0; j < 4; ++j) { const int cc = 4 * lane + 256 * j; const f32x4 h = xv[j] * rstd * *(const f32x4*)(g + cc) * (*(const f32x4*)(sc + cc) + 1.0f) + *(const f32x4*)(sh + cc);
        u32x2 o; o.x = cvt_pk_bf16(h[0], h[1]); o.y = cvt_pk_bf16(h[2], h[3]); *(u32x2*)(hrow + cc) = o; }
}

#ifndef MK_FUSED
#define MK_FUSED 1
#endif
constexpr int NPH = 2 + 11 * 2;
constexpr int CW_BAR = 4096;

__global__ void __launch_bounds__(NTHR, 2) fwd(Args args) {
    extern __shared__ __attribute__((aligned(16))) unsigned char lds_raw[];
    Ctx c; c.in = args.in; c.out = args.out; c.ws = args.ws; c.lds = (LAS unsigned char*)lds_raw;
    c.tid = threadIdx.x; c.lane = c.tid & 63; c.wave = __builtin_amdgcn_readfirstlane(c.tid >> 6); c.G = gridDim.x; c.bid = blockIdx.x;
    volatile LAS unsigned* misc = (volatile LAS unsigned*)(c.lds + LDS_MISC);
    if (c.tid < 8) misc[c.tid] = 0u;
    __syncthreads();
#if MK_FUSED
    XcdBarrier bar = xcd_barrier_post((unsigned*)(c.ws + WS_CTL) + CW_BAR, misc);
#define GRID_BAR() xcd_barrier(bar)
#else
#define GRID_BAR() do {} while (0)
#endif
    const int lo = args.ph_lo, hi = args.ph_hi;
#ifndef PHMASK
#define PHMASK 0xffffffffu
#endif
#define IN(k) (lo <= (k) && (k) < hi)
#define EN(j) ((PHMASK >> (j)) & 1u)
#define SEAM(k) do { if (IN((k) + 1)) GRID_BAR(); } while (0)
    const int NGW = c.G * NWAVES;
#define PHASE_CTX() Ctx pc = c; { int t_ = pc.tid; asm volatile("" : "+v"(t_)); pc.tid = t_; pc.lane = t_ & 63; pc.wave = __builtin_amdgcn_readfirstlane(t_ >> 6); } const int gw = pc.bid * NWAVES + pc.wave; (void)gw

    if (EN(0) && IN(0)) { PHASE_CTX(); phase_pre_a(pc); SEAM(0); }
    if (EN(1) && IN(1)) { PHASE_CTX(); phase_modulate_mix(pc, 0); SEAM(1); }
#pragma unroll 1
    for (int l = 0; l < 2; ++l) {
        const int p0 = 2 + 11 * l; const bool first = (l == 0); const int nMa = first ? 68 : 64;
#define PHASE_PTRS() PHASE_CTX(); unsigned char* wt = pc.ws + WS_WT + (size_t)l * WT_LAYER; bf16_t* Z = (bf16_t*)(pc.ws + WS_RA); bf16_t* H = (bf16_t*)(pc.ws + WS_H); (void)wt; (void)Z; (void)H
        if (EN(2) && IN(p0 + 0)) { PHASE_PTRS();
            pg8::Gemm g{H, (const bf16_t*)(wt + WT_IN), D, D, D, 0, 0}; pg8::GOrder S; S.init(68, 35, 1, pc.G, pc.bid);
            EpiZ E{Z, pc.in[I_BGATE] + l * 3072};
            pg8::gemm_phase<EpiZ, pg8::GOrder>(pc.lds, pc.tid, g, S, E); SEAM(p0 + 0); }
        if (EN(3) && IN(p0 + 1)) { PHASE_PTRS();
#ifndef NO_G2G3
            { pg8::Gemm g{Z + ZCKV, (const bf16_t*)(wt + WT_UKV), NZ, 256, 256, 0, 0}; pg8::GOrder S; S.init(68, 8, 1, pc.G, pc.bid); EpiPlain E{(bf16_t*)(pc.ws + WS_RB + RB_KVRAW), 2048};
              pg8::gemm_phase<EpiPlain, pg8::GOrder>(pc.lds, pc.tid, g, S, E); }
            { pg8::Gemm g{Z + ZCQ, (const bf16_t*)(wt + WT_UQ), NZ, 384, 384, 0, 0}; pg8::GOrder S; S.init(nMa, 6, 1, pc.G, pc.bid); EpiPlain E{(bf16_t*)(pc.ws + WS_RB + RB_QRAW), 1536};
              pg8::gemm_phase<EpiPlain, pg8::GOrder>(pc.lds, pc.tid, g, S, E); }
#endif
#ifndef NO_MIXA
            for (int u = pc.bid; u < nMa * 2 * 8; u += pc.G) mixA_unit(pc, l, u);
#endif
#ifndef NO_B1
            for (int u = pc.bid; u < 1088; u += pc.G) gla_b1_unit(pc, l, u);
#endif
            SEAM(p0 + 1); }
        if (EN(4) && IN(p0 + 2)) { PHASE_PTRS();
            if (pc.wave == 0) { for (int wu = pc.bid; wu < 256; wu += pc.G) gla_b2_wave(pc, wu); }
            else { for (int row = pc.bid * 7 + (pc.wave - 1); row < T; row += pc.G * 7) mla_c1_row(pc, l, row, first || row < TL); }
            SEAM(p0 + 2); }
        if (EN(5) && IN(p0 + 3)) { PHASE_PTRS();
#ifndef NO_FIN
            for (int row = gw; row < nMa * 256; row += NGW) gla_finish_row(pc, l, row);
#endif
            bf16_t* Y = (bf16_t*)(pc.ws + WS_RB + RB_YCAT) + 2048;
            const bf16_t* KG = (const bf16_t*)(pc.ws + WS_RB + RB_KG); const bf16_t* VG = (const bf16_t*)(pc.ws + WS_RB + RB_VG);
            const int G8 = pc.G >> 3;
            for (int i = 0;; ++i) {
                int un; if ((pc.G & 7) == 0 && (G8 & 15) == 0) { const int x = pc.bid & 7, s = pc.bid >> 3, ppx = G8 >> 4; un = ((i * 8 * ppx) + x * ppx + (s >> 4)) * 16 + (s & 15); } else un = i * pc.G + pc.bid;
                if (un >= 512) break;
                const int bh = un >> 4, qb = un & 15, b = bh >> 3, h = bh & 7;
                attn_unit(pc, (const bf16_t*)(pc.ws + WS_RB + RB_QFL) + ((size_t)bh * SEQ + qb * 256) * 192, KG + (size_t)bh * NKEY * 192, VG + (size_t)bh * NKEY * 128, 68, Y + (size_t)(b * SEQ + qb * 256) * 3072 + h * 128); }
            if (first) for (int un = pc.bid; un < 32; un += pc.G) { const int b = un >> 3, h = un & 7;
                attn_unit(pc, (const bf16_t*)(pc.ws + WS_RB + RB_QFC) + (size_t)un * CTXL * 192, KG + (size_t)un * NKEY * 192, VG + (size_t)un * NKEY * 128, 4, Y + (size_t)(TL + b * CTXL) * 3072 + h * 128); }
            SEAM(p0 + 3); }
        if (EN(6) && IN(p0 + 4)) { PHASE_PTRS();
            pg8::Gemm g{(const bf16_t*)(pc.ws + WS_RB + RB_YCAT), (const bf16_t*)(wt + WT_M), 3072, 3072, 3072, 0, 0}; pg8::GOrder S; S.init(nMa, 4, 1, pc.G, pc.bid);
            EpiMerge E{(bf16_t*)(pc.ws + WS_RB + RB_MERGED), Z};
            pg8::gemm_phase<EpiMerge, pg8::GOrder>(pc.lds, pc.tid, g, S, E); SEAM(p0 + 4); }
        if (EN(7) && IN(p0 + 5)) { PHASE_PTRS();
            pg8::Gemm g{(const bf16_t*)(pc.ws + WS_RB + RB_MERGED), (const bf16_t*)(wt + WT_OUT), D, D, D, 0, 0}; pg8::GOrder S; S.init(nMa, 4, 1, pc.G, pc.bid);
            EpiResid E{&pc, l};
            pg8::gemm_phase<EpiResid, pg8::GOrder>(pc.lds, pc.tid, g, S, E); SEAM(p0 + 5); }
        if (EN(8) && IN(p0 + 6)) { PHASE_PTRS();
            for (int row = gw; row < nMa * 256; row += NGW) route_row(pc, l, row);
            expert_wconv(pc, l); SEAM(p0 + 6); }
        if (EN(9) && IN(p0 + 7)) { PHASE_PTRS();
            for (int u = pc.bid; u < 512; u += pc.G) topk_unit(pc, u, false);
            if (first) for (int u = pc.bid; u < 64; u += pc.G) topk_unit(pc, u, true);
            SEAM(p0 + 7); }
        if (EN(10) && IN(p0 + 8)) { PHASE_PTRS();
            pg8::Gemm g{(const bf16_t*)(pc.ws + WS_RA + RA_XS), (const bf16_t*)(pc.ws + WS_RB + RB_WGU), D, D, D, (size_t)ESLOTS * D, (size_t)4096 * D}; pg8::GOrder S; S.init(first ? 9 : 8, 16, 16, pc.G, pc.bid);
            EpiSwiGLU E{(bf16_t*)(pc.ws + WS_RA + RA_HID)};
            pg8::gemm_phase<EpiSwiGLU, pg8::GOrder>(pc.lds, pc.tid, g, S, E); SEAM(p0 + 8); }
        if (EN(11) && IN(p0 + 9)) { PHASE_PTRS();
            pg8::Gemm g{(const bf16_t*)(pc.ws + WS_RA + RA_HID), (const bf16_t*)(pc.ws + WS_RB + RB_WD), DEXP, DEXP, DEXP, (size_t)ESLOTS * DEXP, (size_t)D * DEXP}; pg8::GOrder S; S.init(first ? 9 : 8, 4, 16, pc.G, pc.bid);
            EpiDown E{(bf16_t*)(pc.ws + WS_RA + RA_YS), (const float*)(pc.ws + WS_GATEV)};
            pg8::gemm_phase<EpiDown, pg8::GOrder>(pc.lds, pc.tid, g, S, E); SEAM(p0 + 9); }
        if (EN(12) && IN(p0 + 10)) { PHASE_PTRS();
            for (int row = gw; row < nMa * 256; row += NGW) combine_row(pc, l, row, first);
            SEAM(p0 + 10); }
    }
}

extern "C" void kernel_launch(void* const* d_in, const int* in_sizes, int n_in, void* d_out, int out_size, void* d_ws, size_t ws_size, hipStream_t stream) {
    static int grid = 0;
    if (!grid) {
        int dev = 0, cus = 0, per_cu = 0;
        (void)hipGetDevice(&dev); (void)hipDeviceGetAttribute(&cus, hipDeviceAttributeMultiprocessorCount, dev);
        (void)hipFuncSetAttribute((const void*)fwd, hipFuncAttributeMaxDynamicSharedMemorySize, LDS_BYTES);
        (void)hipOccupancyMaxActiveBlocksPerMultiprocessor(&per_cu, fwd, NTHR, LDS_BYTES);
        grid = cus * (per_cu < 1 ? per_cu : 1);
        if (grid <= 0) { fprintf(stderr, "occupancy query returned 0 blocks per CU\n"); grid = cus; }
        if (ws_size < WS_END) fprintf(stderr, "workspace too small: %zu < %zu\n", ws_size, (size_t)WS_END);
    }
    (void)hipMemsetAsync((unsigned char*)d_ws + WS_CTL, 0, CTL_BYTES, stream);
    Args a{}; for (int i = 0; i < N_INPUTS; ++i) a.in[i] = (const float*)d_in[i]; a.out = (float*)d_out; a.ws = (unsigned char*)d_ws;
#if MK_FUSED
    a.ph_lo = 0; a.ph_hi = NPH;
    hipLaunchKernelGGL(fwd, dim3(grid), dim3(NTHR), LDS_BYTES, stream, a);
#else
#if defined(DEBUG_SCAN)
    hipLaunchKernelGGL(k_seterr, dim3(1), dim3(1), 0, stream, (int*)((unsigned char*)d_ws + WS_CTL + 512 * 1024));
#endif
    for (int p = 0; p < NPH; ++p) { a.ph_lo = p; a.ph_hi = p + 1;
#if defined(DEBUG_SCAN)
        if (p == 3) (void)hipMemsetAsync((unsigned char*)d_ws + WS_RB + RB_OINTRA, 0xff, (size_t)T * D * 2, stream);
#endif
        hipLaunchKernelGGL(fwd, dim3(grid), dim3(NTHR), LDS_BYTES, stream, a);
#if defined(DEBUG_SCAN)
#if defined(DEBUG_HASH)
        if (p == DEBUG_HASH_PHASE) { (void)hipMemsetAsync((unsigned char*)d_ws + WS_CTL + 512 * 1024 + 256, 0, 4, stream);
            hipLaunchKernelGGL(k_hash, dim3(512), dim3(256), 0, stream, (const unsigned*)((unsigned char*)d_ws + DEBUG_HASH_OFF), (long)(DEBUG_HASH_BYTES / 4), (unsigned*)((unsigned char*)d_ws + WS_CTL + 512 * 1024 + 256)); }
#else
        debug_after_phase(p, (unsigned char*)d_ws, (float*)d_out, stream);
#endif
#endif
    }
#if defined(DEBUG_SCAN)
#if defined(DEBUG_HASH)
    hipLaunchKernelGGL(k_apply_hash, dim3(1024), dim3(256), 0, stream, (float*)d_out, (long)out_size, (const unsigned*)((unsigned char*)d_ws + WS_CTL + 512 * 1024 + 256));
#elif defined(DEBUG_STAT)
    hipLaunchKernelGGL(k_apply_stat, dim3(1024), dim3(256), 0, stream, (float*)d_out, (long)out_size, (const int*)((unsigned char*)d_ws + WS_CTL + 512 * 1024));
#else
    hipLaunchKernelGGL(k_apply, dim3(1024), dim3(256), 0, stream, (float*)d_out, (long)out_size, (const int*)((unsigned char*)d_ws + WS_CTL + 512 * 1024));
#endif
#endif
#endif
}
```

```cpp
#define MK_FUSED 1
#include <hip/hip_runtime.h>
#include <cstdint>
#include <cstdio>

#define LAS __attribute__((address_space(3)))
#define GAS __attribute__((address_space(1)))
typedef unsigned short bf16_t;
typedef short bf16x8 __attribute__((ext_vector_type(8)));
typedef short bf16x4 __attribute__((ext_vector_type(4)));
typedef float f32x4 __attribute__((ext_vector_type(4)));
typedef float f32x2 __attribute__((ext_vector_type(2)));
typedef float f32x16 __attribute__((ext_vector_type(16)));
typedef unsigned u32x4 __attribute__((ext_vector_type(4)));
typedef unsigned u32x2 __attribute__((ext_vector_type(2)));

typedef __bf16 bf16v2_t __attribute__((ext_vector_type(2)));
__device__ __forceinline__ unsigned cvt_pk_bf16(float lo, float hi) { bf16v2_t v; v[0] = (__bf16)lo; v[1] = (__bf16)hi; return __builtin_bit_cast(unsigned, v); }
__device__ __forceinline__ bf16_t f2bf(float f) { return (bf16_t)(cvt_pk_bf16(f, 0.f) & 0xffffu); }
__device__ __forceinline__ float bf2f(bf16_t b) { return __uint_as_float(((unsigned)b) << 16); }
__device__ __forceinline__ float bflo(unsigned w) { return __uint_as_float(w << 16); }
__device__ __forceinline__ float bfhi(unsigned w) { return __uint_as_float(w & 0xffff0000u); }
__device__ __forceinline__ float wave_sum(float v) {
#pragma unroll
    for (int o = 1; o < 64; o <<= 1) v += __shfl_xor(v, o);
    return v;
}
__device__ __forceinline__ float fast_rcp(float x) { return __builtin_amdgcn_rcpf(x); }
__device__ __forceinline__ float fast_exp(float x) { return __builtin_amdgcn_exp2f(x * 1.4426950408889634f); }
__device__ __forceinline__ float sigmoidf_(float x) { return fast_rcp(1.f + fast_exp(-x)); }
__device__ __forceinline__ float siluf_(float x) { return x * sigmoidf_(x); }

namespace pg8 {
constexpr int BM = 256, BK = 64, HALF = 128, HTB = HALF * BK * 2, STAGE_BYTES = 8 * HTB, NXCD = 8, WGM = 8;
__host__ __device__ __forceinline__ int lds_byte(int r, int c) { const int st = (r >> 4) * 2 + (c >> 5), rr = r & 15, cc = c & 31, ob = rr * 64 + cc * 2; return st * 1024 + (ob ^ (((ob >> 9) & 1) << 5)); }
__host__ __device__ __forceinline__ void stage_rc(int b, int& R, int& C) { const int st = b / 1024, sb = b % 1024, swz = sb ^ (((sb >> 9) & 1) << 5); R = (st >> 1) * 16 + swz / 64; C = (st & 1) * 32 + (swz % 64) / 2; }
__host__ __device__ __forceinline__ int perm32(int rho) { const int n = rho >> 4, i = rho & 15; return 8 * (i >> 2) + 4 * n + (i & 3); }

struct Unit { int pm, pn, g; };
struct Gemm { const bf16_t* A; const bf16_t* Bt; int lda, ldb, K; size_t gstrideA, gstrideB; };

struct GOrder {
    int nM, nN, nG, nwg, G, c, pm0;
    __device__ void init(int nM_, int nN_, int nG_, int G_, int c_, int pm0_ = 0) { nM = nM_; nN = nN_; nG = nG_; nwg = nM * nN * nG; G = G_; c = c_; pm0 = pm0_; }
    __device__ bool next(int i, Unit& u) const {
        const long L = (long)i * G + c; if (L >= nwg) return false;
        int wgid = (int)L; { const int q = nwg / NXCD, r = nwg % NXCD, xcd = wgid % NXCD, off = wgid / NXCD; wgid = (xcd < r ? xcd * (q + 1) : r * (q + 1) + (xcd - r) * q) + off; }
        const int per = nM * nN; u.g = wgid / per; wgid -= u.g * per;
        const int nig = WGM * nN, gid = wgid / nig, fm = gid * WGM, gsz = (nM - fm) < WGM ? (nM - fm) : WGM;
        u.pm = pm0 + fm + ((wgid % nig) % gsz); u.pn = (wgid % nig) / gsz; return true;
    }
};

template <class Epi, class Sched>
__device__ __forceinline__ void gemm_phase(LAS unsigned char* lds, const int tid, const Gemm g, const Sched& S, const Epi& E) {
    const int wid = __builtin_amdgcn_readfirstlane(tid >> 6), lane = tid & 63, wr = wid >> 2, wc = wid & 3, fr = lane & 15, fq = lane >> 4;
    const int K = g.K, nt = K / BK;
    unsigned voffA[2], voffB[2];
#pragma unroll
    for (int i = 0; i < 2; ++i) { int R, C; stage_rc(tid * 16 + i * 8192, R, C); const int Rb = Epi::PERM ? ((R & ~31) + perm32(R & 31)) : R;
        voffA[i] = (unsigned)(R * g.lda + C) * 2u; voffB[i] = (unsigned)(Rb * g.ldb + C) * 2u; }
    const size_t kstep = (size_t)(BK * 2);
    const size_t hstepA = (size_t)HALF * g.lda * 2, hstepB = (size_t)HALF * g.ldb * 2;
    const size_t tstepA = 2 * hstepA, tstepB = 2 * hstepB;
    const unsigned ldsw = (unsigned)wid * 1024u;
    const int aoff = lds_byte(wr * 64 + fr, fq * 8), boff = lds_byte(wc * 32 + fr, fq * 8);
#define PG8_SA(b, h) (((b) * 2 + (h)) * HTB)
#define PG8_SB(b, h) ((4 + (b) * 2 + (h)) * HTB)
#define PG8_STAGE(bufoff, gbase, voff) do { _Pragma("unroll") for (int _i = 0; _i < 2; ++_i) \
        __builtin_amdgcn_global_load_lds((const unsigned*)((const char*)(gbase) + (voff)[_i]), (LAS unsigned*)(lds + (bufoff) + ldsw + _i * 8192), 16, 0, 0); } while (0)
#define PG8_LDA(dst, b, h) do { _Pragma("unroll") for (int m = 0; m < 4; ++m) _Pragma("unroll") for (int k = 0; k < 2; ++k) dst[m][k] = *(const LAS bf16x8*)(lds + PG8_SA(b, h) + aoff + m * 2048 + k * 1024); } while (0)
#define PG8_LDB(dst, b, h) do { _Pragma("unroll") for (int n = 0; n < 2; ++n) _Pragma("unroll") for (int k = 0; k < 2; ++k) dst[n][k] = *(const LAS bf16x8*)(lds + PG8_SB(b, h) + boff + n * 2048 + k * 1024); } while (0)
#define PG8_MMA(ai, bj, At, Bt) do { __builtin_amdgcn_s_setprio(1); _Pragma("unroll") for (int m = 0; m < 4; ++m) _Pragma("unroll") for (int n = 0; n < 2; ++n) _Pragma("unroll") for (int k = 0; k < 2; ++k) \
        acc[ai][bj][m][n] = __builtin_amdgcn_mfma_f32_16x16x32_bf16(Bt[n][k], At[m][k], acc[ai][bj][m][n], 0, 0, 0); __builtin_amdgcn_s_setprio(0); } while (0)
#define PG8_WAIT_V(n) asm volatile("s_waitcnt vmcnt(" #n ")" ::: "memory")
#define PG8_WAIT_L(n) asm volatile("s_waitcnt lgkmcnt(" #n ")" ::: "memory")
#define PG8_BAR __builtin_amdgcn_s_barrier()
#define PG8_SCHED __builtin_amdgcn_sched_barrier(0)
    Unit cur, nxt; int ui = 0;
    if (!S.next(0, cur)) return;
    f32x4 acc[2][2][4][2];
#pragma unroll
    for (int a = 0; a < 2; ++a)
#pragma unroll
        for (int b = 0; b < 2; ++b)
#pragma unroll
            for (int m = 0; m < 4; ++m)
#pragma unroll
                for (int n = 0; n < 2; ++n) acc[a][b][m][n] = (f32x4){0.f, 0.f, 0.f, 0.f};
    bf16x8 At[4][2], B0[2][2], B1[2][2];
    const char* cA = (const char*)(g.A + (size_t)cur.g * g.gstrideA) + (size_t)cur.pm * tstepA; const char* cB = (const char*)(g.Bt + (size_t)cur.g * g.gstrideB) + (size_t)cur.pn * tstepB;
    PG8_STAGE(PG8_SB(0, 0), cB, voffB); PG8_STAGE(PG8_SB(0, 1), cB + hstepB, voffB); PG8_STAGE(PG8_SA(0, 0), cA, voffA); PG8_STAGE(PG8_SA(0, 1), cA + hstepA, voffA);
    if (wr == 1) PG8_BAR;
    PG8_WAIT_V(2); PG8_BAR;
    PG8_STAGE(PG8_SB(1, 0), cB + kstep, voffB); PG8_STAGE(PG8_SA(1, 0), cA + kstep, voffA); PG8_STAGE(PG8_SB(1, 1), cB + hstepB + kstep, voffB);
    PG8_WAIT_V(6); PG8_BAR;
    for (;;) {
        const bool has_next = S.next(ui + 1, nxt);
        const char* nA = has_next ? (const char*)(g.A + (size_t)nxt.g * g.gstrideA) + (size_t)nxt.pm * tstepA : cA; const char* nB = has_next ? (const char*)(g.Bt + (size_t)nxt.g * g.gstrideB) + (size_t)nxt.pn * tstepB : cB;
        for (int t = 0; t < nt; t += 2) {
            const bool last = (t == nt - 2);
            const char* a1 = cA + (size_t)(t + 1) * kstep;
            const char* a2 = last ? nA : cA + (size_t)(t + 2) * kstep; const char* b2 = last ? nB : cB + (size_t)(t + 2) * kstep;
            const char* a3 = a2 + kstep; const char* b3 = b2 + kstep;
            if constexpr (Epi::MID) { if (t == 16 || t == 32) E.mid(acc, cur, t, wr, wc, fr, fq); }
            PG8_LDB(B0, 0, 0); PG8_LDB(B1, 0, 1); PG8_SCHED; PG8_LDA(At, 0, 0); PG8_STAGE(PG8_SA(1, 1), a1 + hstepA, voffA);
            PG8_WAIT_V(8); PG8_WAIT_L(0); PG8_BAR; PG8_MMA(0, 0, At, B0); PG8_MMA(0, 1, At, B1); PG8_BAR; PG8_SCHED;
            PG8_LDA(At, 0, 1); PG8_STAGE(PG8_SB(0, 0), b2, voffB); PG8_STAGE(PG8_SB(0, 1), b2 + hstepB, voffB); PG8_STAGE(PG8_SA(0, 0), a2, voffA);
            PG8_WAIT_V(8); PG8_WAIT_L(0); PG8_BAR; PG8_MMA(1, 0, At, B0); PG8_MMA(1, 1, At, B1); PG8_BAR; PG8_SCHED;
            PG8_LDB(B0, 1, 0); PG8_LDB(B1, 1, 1); PG8_SCHED; PG8_LDA(At, 1, 0); PG8_STAGE(PG8_SA(0, 1), a2 + hstepA, voffA);
            PG8_WAIT_V(8); PG8_WAIT_L(0); PG8_BAR; PG8_MMA(0, 0, At, B0); PG8_MMA(0, 1, At, B1); PG8_BAR; PG8_SCHED;
            PG8_LDA(At, 1, 1); PG8_STAGE(PG8_SB(1, 0), b3, voffB); PG8_STAGE(PG8_SB(1, 1), b3 + hstepB, voffB); PG8_STAGE(PG8_SA(1, 0), a3, voffA);
            PG8_WAIT_V(8); PG8_WAIT_L(0); PG8_BAR; PG8_MMA(1, 0, At, B0); PG8_MMA(1, 1, At, B1); PG8_BAR; PG8_SCHED;
        }
        if (wr == 0) PG8_BAR;
        E(acc, cur, wr, wc, fr, fq);
        if (!has_next) break;
#pragma unroll
        for (int a = 0; a < 2; ++a)
#pragma unroll
            for (int b = 0; b < 2; ++b)
#pragma unroll
                for (int m = 0; m < 4; ++m)
#pragma unroll
                    for (int n = 0; n < 2; ++n) acc[a][b][m][n] = (f32x4){0.f, 0.f, 0.f, 0.f};
        cur = nxt; cA = nA; cB = nB; ++ui;
        if (wr == 1) PG8_BAR;
    }
    PG8_WAIT_V(0);
    PG8_BAR;
#undef PG8_SA
#undef PG8_SB
#undef PG8_STAGE
#undef PG8_LDA
#undef PG8_LDB
#undef PG8_MMA
#undef PG8_WAIT_V
#undef PG8_WAIT_L
#undef PG8_BAR
#undef PG8_SCHED
}
}
#define XB_TMO      128
#define XB_XCNT(j)  (256  + 64 * (j))
#define XB_XSUB(j)  (1280 + 64 * (j))
#define XB_XGEN(j)  (2304 + 64 * (j))
#define XB_TOP      3328
#define XB_TOPGEN   3392
#define XCD_BAR_WORDS 3456
#define XB_SPIN_CAP (1u << 18)

__device__ __forceinline__ unsigned xb_ld(unsigned* p)              { return __hip_atomic_load(p, __ATOMIC_RELAXED, __HIP_MEMORY_SCOPE_AGENT); }
__device__ __forceinline__ unsigned xb_add(unsigned* p, unsigned v) { return __hip_atomic_fetch_add(p, v, __ATOMIC_RELAXED, __HIP_MEMORY_SCOPE_AGENT); }
__device__ __forceinline__ unsigned xb_xcc_id() { return (unsigned)__builtin_amdgcn_s_getreg((3 << 11) | 20) & 0xFu; }
#define XB_SPIN(cond, bar) do { unsigned _sp = 0; while (cond) { __builtin_amdgcn_s_sleep(1); \
    if ((++_sp & 255u) == 0u) { if (xb_ld(&(bar)[XB_TMO])) break; if (_sp > XB_SPIN_CAP) { atomicAdd(&(bar)[XB_TMO], 1u); break; } } } } while (0)

struct XcdBarrier {
    unsigned* bar; unsigned x;
    volatile LAS unsigned* st;
};

__device__ __forceinline__ XcdBarrier xcd_barrier_post(unsigned* bar, volatile LAS unsigned* st) {
    XcdBarrier b; b.bar = bar; b.x = xb_xcc_id(); b.st = st;
    if (threadIdx.x == 0) (void)xb_add(&bar[XB_XCNT(b.x)], 1u);
    return b;
}
__device__ __forceinline__ void xcd_barrier_complete(unsigned* bar, unsigned x, unsigned& nloc, unsigned& nx) {
    const unsigned G = gridDim.x * gridDim.y * gridDim.z;
    unsigned sum, cnt, mine, sp = 0u;
    for (;;) {
        sum = 0u; cnt = 0u; mine = 0u;
#pragma unroll
        for (unsigned j = 0; j < 16; ++j) { const unsigned c = xb_ld(&bar[XB_XCNT(j)]); sum += c; cnt += (c > 0u) ? 1u : 0u; mine = (j == x) ? c : mine; }
        if (sum == G) break;
        __builtin_amdgcn_s_sleep(1);
        if ((++sp & 255u) == 0u) { if (xb_ld(&bar[XB_TMO])) break; if (sp > XB_SPIN_CAP) { atomicAdd(&bar[XB_TMO], 1u); break; } }
    }
    nloc = mine > 0u ? mine : 1u; nx = cnt > 0u ? cnt : 1u;
}

__device__ __forceinline__ void xcd_barrier(const XcdBarrier& b) {
    asm volatile("s_waitcnt vmcnt(0)" ::: "memory");
    __syncthreads();
    if (threadIdx.x == 0) {
        unsigned* bar = b.bar;
        __builtin_amdgcn_s_waitcnt(0);
        unsigned nloc = b.st[0], nx = b.st[1];
        if (nloc == 0u) { xcd_barrier_complete(bar, b.x, nloc, nx); b.st[0] = nloc; b.st[1] = nx; }
        const unsigned old = xb_add(&bar[XB_XSUB(b.x)], 1u);
        const unsigned gen = old / nloc;
        if (old + 1u == (gen + 1u) * nloc) {
            __builtin_amdgcn_fence(__ATOMIC_RELEASE, "agent");
            asm volatile("s_waitcnt vmcnt(0)" ::: "memory");
            const unsigned og = xb_add(&bar[XB_TOP], 1u);
            const unsigned tg = og / nx;
            if (og + 1u == (tg + 1u) * nx) xb_add(&bar[XB_TOPGEN], 1u);
            else XB_SPIN(xb_ld(&bar[XB_TOPGEN]) == tg, bar);
            __builtin_amdgcn_fence(__ATOMIC_ACQUIRE, "agent");
            xb_add(&bar[XB_XGEN(b.x)], 1u);
            asm volatile("s_waitcnt vmcnt(0)" ::: "memory");
        } else {
            XB_SPIN(xb_ld(&bar[XB_XGEN(b.x)]) == gen, bar);
            __builtin_amdgcn_fence(__ATOMIC_ACQUIRE, "agent");
            asm volatile("s_waitcnt vmcnt(0)" ::: "memory");
        }
    }
    __syncthreads();
}

namespace cfg {
constexpr int D = 1024, NB = 4, SEQ = 4096, CTXL = 256, TL = NB * SEQ, TC = NB * CTXL, T = TL + TC;
constexpr int NZ = 8960;
constexpr int ZU = 0, ZVA = 1024, ZQB = 2048, ZKB = 2560, ZVB = 3072, ZRB = 4096, ZCQ = 5120, ZKR = 5504, ZDEC = 5568, ZCKV = 5632, ZGT = 5888;
constexpr int NKEY = CTXL + SEQ;
constexpr int NEXP = 16, DEXP = 2048, CAPL = 512, CAPC = 32, ESLOTS = 2304;
constexpr float EPS = 1e-6f;
constexpr int NWAVES = 8, NTHR = 512;
constexpr size_t MiB = 1u << 20;
constexpr size_t WS_CTL = 0, CTL_BYTES = 1 * MiB;
constexpr size_t WS_MOD = 1 * MiB;
constexpr size_t WS_GATEV = WS_MOD + 512 * 1024;
constexpr size_t WS_AFFT = 2 * MiB;
constexpr size_t WS_SEL = 4 * MiB;
constexpr size_t WS_XC = 6 * MiB;
constexpr size_t WS_H = 10 * MiB;
constexpr size_t WS_WT = 44 * MiB, WT_LAYER = 28 * MiB;
constexpr size_t WT_IN = 0, WT_UQ = 17 * MiB + 512 * 1024, WT_UKV = WT_UQ + 1152 * 1024, WT_M = WT_UKV + 1 * MiB, WT_OUT = WT_M + 6 * MiB, WT_S = WT_OUT + 2 * MiB;
static_assert(WT_S + 256 * 1024 <= WT_LAYER, "weights");
constexpr size_t WS_RA = 100 * MiB;
constexpr size_t RA_XS = 0, RA_HID = 72 * MiB, RA_YS = 216 * MiB;
constexpr size_t WS_RB = 398 * MiB;
constexpr size_t RB_YCAT = 0, RB_KVRAW = 102 * MiB, RB_MERGED = 102 * MiB, RB_QRAW = 170 * MiB, RB_KG = 221 * MiB, RB_VG = 272 * MiB, RB_QFL = 306 * MiB, RB_QFC = 354 * MiB,
                 RB_QDF = 357 * MiB, RB_KDT = 391 * MiB, RB_VTG = 425 * MiB, RB_DECAY = 459 * MiB, RB_OINTRA = 461 * MiB, RB_OF = 495 * MiB, RB_OB = 529 * MiB, RB_END = 563 * MiB;
constexpr size_t RB_WGU = 0, RB_WD = 128 * MiB;
constexpr size_t WS_END = WS_RB + RB_END;
constexpr int LDS_BYTES = 147456;
constexpr int LDS_MISC = 145408;
}
using namespace cfg;

enum { I_X = 0, I_C, I_CTX, I_CCTX, I_WMOD, I_BMOD, I_GMIX, I_GFFN, I_WIN, I_BGATE, I_WS, I_BS, I_WDEC, I_BDEC, I_GGLA, I_GCQ, I_GCKV, I_WUQ, I_WUKV,
       I_GQN, I_GQR, I_GKN, I_GKR, I_WPA, I_WPB, I_WPC, I_WOUT, I_WROUTER, I_WEG, I_WEU, I_WED, N_INPUTS };

struct Args { const float* in[N_INPUTS]; float* out; unsigned char* ws; int ph_lo, ph_hi; };

struct Ctx {
    const float* const* in; float* out; unsigned char* ws; LAS unsigned char* lds;
    int tid, lane, wave, G, bid;
};
__device__ __forceinline__ int row_modidx(int row) { return row < TL ? (row >> 12) : 4; }
__device__ __forceinline__ const float* modp(const Ctx& c, int l, int bi, int which) { return (const float*)(c.ws + WS_MOD) + ((size_t)(l * 5 + bi) * 6 + which) * D; }
__device__ __forceinline__ const float* xin_row(const Ctx& c, int l, int row) {
    if (row < TL) return (l == 0 ? c.in[I_X] : (const float*)c.out) + (size_t)row * D;
    return (l == 0 ? c.in[I_CTX] : (const float*)(c.ws + WS_XC)) + (size_t)(row - TL) * D;
}
__device__ __forceinline__ float* xout_row(const Ctx& c, int row) {
    if (row < TL) return c.out + (size_t)row * D;
    return (float*)(c.ws + WS_XC) + (size_t)(row - TL) * D;
}

#if defined(DEBUG_STAT)
__device__ __forceinline__ void dbg_max(const Ctx& c, int slot, float v) { v = fabsf(v); if (!(v < 1e30f)) v = 1e30f; atomicMax((unsigned*)(c.ws + WS_CTL + 512 * 1024) + 16 * slot, __float_as_uint(v)); }
#else
__device__ __forceinline__ void dbg_max(const Ctx&, int, float) {}
#endif
__device__ __forceinline__ void tconv_tile(const Ctx& c, const float* src, int ld_src, int k0, int c0, int nvalid, const float* kscale, bf16_t* dst, int ld_dst, int r0, int kd0) {
    LAS float* scr = (LAS float*)c.lds;
    const int tid = c.tid;
#pragma unroll
    for (int p = 0; p < 8; ++p) { const int k = p * 8 + (tid >> 6), n = tid & 63;
        float v = (n < nvalid) ? src[(size_t)(k0 + k) * ld_src + c0 + n] : 0.f; if (kscale) v *= kscale[k0 + k];
        scr[n * 65 + k] = v; }
    __syncthreads();
    { const int n = tid >> 3, kc = (tid & 7) * 8; const LAS float* s = scr + n * 65 + kc;
      u32x4 o; o.x = cvt_pk_bf16(s[0], s[1]); o.y = cvt_pk_bf16(s[2], s[3]); o.z = cvt_pk_bf16(s[4], s[5]); o.w = cvt_pk_bf16(s[6], s[7]);
      *(u32x4*)(dst + (size_t)(r0 + n) * ld_dst + kd0 + kc) = o; }
    __syncthreads();
}
__device__ __forceinline__ void win_map(int r0, int& src, int& nvalid) {
    nvalid = 64;
    if (r0 < 5120) src = r0; else if (r0 < 5504) src = 5152 + (r0 - 5120); else if (r0 == 5504) src = 5792;
    else if (r0 == 5568) { src = 5120; nvalid = 32; } else if (r0 < 5888) src = 5536 + (r0 - 5632); else src = 5856 + (r0 - 5888);
}
__device__ __forceinline__ void phase_pre_a(const Ctx& c) {
    constexpr int U_IN = 140 * 16, U_UQ = 6 * 24, U_UKV = 4 * 32, U_M = 3 * 256, U_OUT = 256, U_S = 32, U_LAYER = U_IN + U_UQ + U_UKV + U_M + U_OUT + U_S, U_MOD = 192;
    for (int u = c.bid; u < 2 * U_LAYER + U_MOD; u += c.G) {
        if (u >= 2 * U_LAYER) {
            const int cb = u - 2 * U_LAYER, l = cb / 96, n = (cb % 96) * 64 + c.lane;
            const float* wm = c.in[I_WMOD] + (size_t)l * D * 6144; float a[5] = {0.f, 0.f, 0.f, 0.f, 0.f};
            for (int kk = 0; kk < 128; ++kk) { const int k = c.wave * 128 + kk; const float w = wm[(size_t)k * 6144 + n];
#pragma unroll
                for (int i = 0; i < 5; ++i) { const float cv = (i < 4) ? c.in[I_C][i * D + k] : c.in[I_CCTX][k]; a[i] += siluf_(cv) * w; } }
            LAS float* red = (LAS float*)c.lds;
#pragma unroll
            for (int i = 0; i < 5; ++i) red[(c.wave * 5 + i) * 64 + c.lane] = a[i];
            __syncthreads();
            if (c.tid < 320) { const int i = c.tid >> 6, ln = c.tid & 63; float s = 0.f;
#pragma unroll
                for (int w = 0; w < 8; ++w) s += red[(w * 5 + i) * 64 + ln];
                const int nn = (cb % 96) * 64 + ln;
                ((float*)(c.ws + WS_MOD))[(size_t)(l * 5 + i) * 6144 + nn] = s + c.in[I_BMOD][l * 6144 + nn]; }
            __syncthreads();
            continue;
        }
        const int l = u / U_LAYER; int r = u % U_LAYER; unsigned char* wt = c.ws + WS_WT + (size_t)l * WT_LAYER;
        if (r < U_IN) { const int nb = r / 16, kb = r % 16; int src, nv; win_map(nb * 64, src, nv);
            tconv_tile(c, c.in[I_WIN] + (size_t)l * D * 8928, 8928, kb * 64, src, nv, nullptr, (bf16_t*)(wt + WT_IN), D, nb * 64, kb * 64); continue; } r -= U_IN;
        if (r < U_UQ) { const int nb = r / 6, kb = r % 6;
            tconv_tile(c, c.in[I_WUQ] + (size_t)l * 384 * 1536, 1536, kb * 64, nb * 64, 64, c.in[I_GCQ] + l * 384, (bf16_t*)(wt + WT_UQ), 384, nb * 64, kb * 64); continue; } r -= U_UQ;
        if (r < U_UKV) { const int nb = r / 4, kb = r % 4;
            tconv_tile(c, c.in[I_WUKV] + (size_t)l * 256 * 2048, 2048, kb * 64, nb * 64, 64, c.in[I_GCKV] + l * 256, (bf16_t*)(wt + WT_UKV), 256, nb * 64, kb * 64); continue; } r -= U_UKV;
        if (r < U_M) { const int which = r / 256, rr = r % 256, nb = rr / 16, kb = rr % 16;
            const float* src = c.in[which == 0 ? I_WPA : (which == 1 ? I_WPB : I_WPC)] + (size_t)l * D * D;
            tconv_tile(c, src, D, kb * 64, nb * 64, 64, nullptr, (bf16_t*)(wt + WT_M), 3 * D, nb * 64, which * D + kb * 64); continue; } r -= U_M;
        if (r < U_OUT) { const int nb = r / 16, kb = r % 16;
            tconv_tile(c, c.in[I_WOUT] + (size_t)l * D * D, D, kb * 64, nb * 64, 64, nullptr, (bf16_t*)(wt + WT_OUT), D, nb * 64, kb * 64); continue; } r -= U_OUT;
        { const float* s = c.in[I_WS] + (size_t)l * 131072 + (size_t)r * 4096 + c.tid * 8; bf16_t* d = (bf16_t*)(wt + WT_S) + (size_t)r * 4096 + c.tid * 8;
          const f32x4 a = *(const f32x4*)s, b = *(const f32x4*)(s + 4); u32x4 o; o.x = cvt_pk_bf16(a[0], a[1]); o.y = cvt_pk_bf16(a[2], a[3]); o.z = cvt_pk_bf16(b[0], b[1]); o.w = cvt_pk_bf16(b[2], b[3]);
          *(u32x4*)d = o; }
    }
}
__device__ __forceinline__ void modulate_row(const float* xrow, const float* g, const float* shift, const float* scale, bf16_t* hrow, int lane, f32x4 (&hv)[4]) {
    float ss = 0.f;
#pragma unroll
    for (int j = 0; j < 4; ++j) { hv[j] = *(const f32x4*)(xrow + 4 * lane + 256 * j); ss += (hv[j][0] * hv[j][0] + hv[j][1] * hv[j][1]) + (hv[j][2] * hv[j][2] + hv[j][3] * hv[j][3]); }
    const float rstd = 1.0f / sqrtf(wave_sum(ss) * (1.f / D) + EPS);
#pragma unroll
    for (int j = 0; j < 4; ++j) { const int cc = 4 * lane + 256 * j; const f32x4 gv = *(const f32x4*)(g + cc), sc = *(const f32x4*)(scale + cc), sh = *(const f32x4*)(shift + cc);
        hv[j] = hv[j] * rstd * gv * (sc + 1.0f) + sh;
        u32x2 o; o.x = cvt_pk_bf16(hv[j][0], hv[j][1]); o.y = cvt_pk_bf16(hv[j][2], hv[j][3]); *(u32x2*)(hrow + cc) = o; }
}
__device__ __forceinline__ void phase_modulate_mix(const Ctx& c, int l) {
    const int gw = c.bid * NWAVES + c.wave, NGW = c.G * NWAVES;
    for (int row = gw; row < T; row += NGW) { const int bi = row_modidx(row); f32x4 hv[4];
        modulate_row(xin_row(c, l, row), c.in[I_GMIX] + l * D, modp(c, l, bi, 0), modp(c, l, bi, 1), (bf16_t*)(c.ws + WS_H) + (size_t)row * D, c.lane, hv); }
}
struct EpiZ { static constexpr bool PERM = true, MID = false; bf16_t* Z; const float* bgate;
    __device__ __forceinline__ void operator()(const f32x4 (&acc)[2][2][4][2], const pg8::Unit& u, int wr, int wc, int fr, int fq) const {
        int row0 = u.pm * 256 + wr * 64 + fr; asm volatile("" : "+v"(row0)); const int col0 = u.pn * 256 + wc * 32 + 8 * fq;
        const int mode = (u.pn >= 23) ? 3 : ((u.pn >= 16 && u.pn < 20) ? 2 : ((u.pn == 8 || u.pn == 9) ? 1 : 0));
        f32x4 bv[2][2];
#pragma unroll
        for (int bj = 0; bj < 2; ++bj)
#pragma unroll
            for (int n = 0; n < 2; ++n) bv[bj][n] = (mode == 3) ? *(const f32x4*)(bgate + (col0 - ZGT) + bj * 128 + 4 * n) : (f32x4){0.f, 0.f, 0.f, 0.f};
#pragma unroll
        for (int ai = 0; ai < 2; ++ai)
#pragma unroll
            for (int m = 0; m < 4; ++m) { bf16_t* rowp = Z + (size_t)(row0 + ai * 128 + m * 16) * NZ + col0;
#pragma unroll
                for (int bj = 0; bj < 2; ++bj) { f32x4 v0 = acc[ai][bj][m][0], v1 = acc[ai][bj][m][1];
                    if (mode == 1) { v0 = v0 * 0.08838834764831845f; v1 = v1 * 0.08838834764831845f; }
                    else if (mode == 2) {
#pragma unroll
                        for (int e = 0; e < 4; ++e) { v0[e] = siluf_(v0[e]); v1[e] = siluf_(v1[e]); } }
                    else if (mode == 3) { v0 = v0 + bv[bj][0]; v1 = v1 + bv[bj][1];
#pragma unroll
                        for (int e = 0; e < 4; ++e) { v0[e] = fmaxf(sigmoidf_(v0[e]), 1e-20f); v1[e] = fmaxf(sigmoidf_(v1[e]), 1e-20f); } }
                    u32x4 w; w.x = cvt_pk_bf16(v0[0], v0[1]); w.y = cvt_pk_bf16(v0[2], v0[3]); w.z = cvt_pk_bf16(v1[0], v1[1]); w.w = cvt_pk_bf16(v1[2], v1[3]);
                    *(u32x4*)(rowp + bj * 128) = w; } }
    }
};
struct EpiPlain { static constexpr bool PERM = true, MID = false; bf16_t* O; int ldc;
    __device__ __forceinline__ void operator()(const f32x4 (&acc)[2][2][4][2], const pg8::Unit& u, int wr, int wc, int fr, int fq) const {
        int row0 = u.pm * 256 + wr * 64 + fr; asm volatile("" : "+v"(row0)); const int col0 = u.pn * 256 + wc * 32 + 8 * fq;
#pragma unroll
        for (int ai = 0; ai < 2; ++ai)
#pragma unroll
            for (int m = 0; m < 4; ++m) { bf16_t* rowp = O + (size_t)(row0 + ai * 128 + m * 16) * ldc + col0;
#pragma unroll
                for (int bj = 0; bj < 2; ++bj) { const f32x4 v0 = acc[ai][bj][m][0], v1 = acc[ai][bj][m][1];
                    u32x4 w; w.x = cvt_pk_bf16(v0[0], v0[1]); w.y = cvt_pk_bf16(v0[2], v0[3]); w.z = cvt_pk_bf16(v1[0], v1[1]); w.w = cvt_pk_bf16(v1[2], v1[3]);
                    *(u32x4*)(rowp + bj * 128) = w; } }
    }
};
struct EpiMerge { static constexpr bool PERM = true, MID = true; bf16_t* O; const bf16_t* Z;
    __device__ __forceinline__ void ld8(const bf16_t* p, float (&g)[8]) const { const u32x4 w = *(const u32x4*)p; g[0] = bflo(w.x); g[1] = bfhi(w.x); g[2] = bflo(w.y); g[3] = bfhi(w.y); g[4] = bflo(w.z); g[5] = bfhi(w.z); g[6] = bflo(w.w); g[7] = bfhi(w.w); }
    __device__ __forceinline__ void mid(f32x4 (&acc)[2][2][4][2], const pg8::Unit& u, int t, int wr, int wc, int fr, int fq) const {
        int row0 = u.pm * 256 + wr * 64 + fr; asm volatile("" : "+v"(row0)); const int col0 = u.pn * 256 + wc * 32 + 8 * fq; const int seg = (t == 16) ? 0 : 1;
#pragma unroll
        for (int ai = 0; ai < 2; ++ai)
#pragma unroll
            for (int m = 0; m < 4; ++m) { const bf16_t* gp = Z + (size_t)(row0 + ai * 128 + m * 16) * NZ + ZGT + seg * D + col0;
#pragma unroll
                for (int bj = 0; bj < 2; ++bj) { float ga[8], gb[8]; ld8(gp + bj * 128, ga); ld8(gp + D + bj * 128, gb);
#pragma unroll
                    for (int e = 0; e < 4; ++e) { acc[ai][bj][m][0][e] *= ga[e] * fast_rcp(gb[e]); acc[ai][bj][m][1][e] *= ga[4 + e] * fast_rcp(gb[4 + e]); } }
                __builtin_amdgcn_sched_barrier(0); }
    }
    __device__ __forceinline__ void operator()(const f32x4 (&acc)[2][2][4][2], const pg8::Unit& u, int wr, int wc, int fr, int fq) const {
        int row0 = u.pm * 256 + wr * 64 + fr; asm volatile("" : "+v"(row0)); const int col0 = u.pn * 256 + wc * 32 + 8 * fq;
#pragma unroll
        for (int ai = 0; ai < 2; ++ai)
#pragma unroll
            for (int m = 0; m < 4; ++m) { const size_t r = (size_t)(row0 + ai * 128 + m * 16); const bf16_t* gp = Z + r * NZ + ZGT + 2 * D + col0; bf16_t* rowp = O + r * D + col0;
#pragma unroll
                for (int bj = 0; bj < 2; ++bj) { float gc[8]; ld8(gp + bj * 128, gc); const f32x4 v0 = acc[ai][bj][m][0], v1 = acc[ai][bj][m][1];
                    u32x4 w; w.x = cvt_pk_bf16(v0[0] * gc[0], v0[1] * gc[1]); w.y = cvt_pk_bf16(v0[2] * gc[2], v0[3] * gc[3]); w.z = cvt_pk_bf16(v1[0] * gc[4], v1[1] * gc[5]); w.w = cvt_pk_bf16(v1[2] * gc[6], v1[3] * gc[7]);
                    *(u32x4*)(rowp + bj * 128) = w; }
                __builtin_amdgcn_sched_barrier(0); }
    }
};
struct EpiResid { static constexpr bool PERM = false, MID = false; const Ctx* c; int l;
    __device__ __forceinline__ void operator()(const f32x4 (&acc)[2][2][4][2], const pg8::Unit& u, int wr, int wc, int fr, int fq) const {
        int row0 = u.pm * 256 + wr * 64 + fr; asm volatile("" : "+v"(row0)); const int col0 = u.pn * 256 + wc * 32 + 4 * fq; const float* gate = modp(*c, l, row_modidx(u.pm * 256), 2);
        f32x4 gv[2][2];
#pragma unroll
        for (int bj = 0; bj < 2; ++bj)
#pragma unroll
            for (int n = 0; n < 2; ++n) gv[bj][n] = *(const f32x4*)(gate + col0 + bj * 128 + 16 * n);
#pragma unroll
        for (int ai = 0; ai < 2; ++ai)
#pragma unroll
            for (int m = 0; m < 4; ++m) { const int row = row0 + ai * 128 + m * 16; const float* xi = xin_row(*c, l, row) + col0; float* xo = xout_row(*c, row) + col0;
#pragma unroll
                for (int bj = 0; bj < 2; ++bj)
#pragma unroll
                    for (int n = 0; n < 2; ++n) { const f32x4 xv = *(const f32x4*)(xi + bj * 128 + 16 * n); *(f32x4*)(xo + bj * 128 + 16 * n) = xv + gv[bj][n] * acc[ai][bj][m][n]; } }
    }
};
struct EpiSwiGLU { static constexpr bool PERM = true, MID = false; bf16_t* HID;
    __device__ __forceinline__ void operator()(const f32x4 (&acc)[2][2][4][2], const pg8::Unit& u, int wr, int wc, int fr, int fq) const {
        int row0 = u.pm * 256 + wr * 64 + fr; asm volatile("" : "+v"(row0)); const int col0 = u.pn * 128 + wc * 32 + 8 * fq; bf16_t* base = HID + (size_t)u.g * ESLOTS * DEXP;
#pragma unroll
        for (int ai = 0; ai < 2; ++ai)
#pragma unroll
            for (int m = 0; m < 4; ++m) { float h[8];
#pragma unroll
                for (int n = 0; n < 2; ++n)
#pragma unroll
                    for (int e = 0; e < 4; ++e) h[4 * n + e] = siluf_(acc[ai][0][m][n][e]) * acc[ai][1][m][n][e];
                u32x4 w; w.x = cvt_pk_bf16(h[0], h[1]); w.y = cvt_pk_bf16(h[2], h[3]); w.z = cvt_pk_bf16(h[4], h[5]); w.w = cvt_pk_bf16(h[6], h[7]);
                *(u32x4*)(base + (size_t)(row0 + ai * 128 + m * 16) * DEXP + col0) = w; }
    }
};
struct EpiDown { static constexpr bool PERM = true, MID = false; bf16_t* YS; const float* gatev;
    __device__ __forceinline__ void operator()(const f32x4 (&acc)[2][2][4][2], const pg8::Unit& u, int wr, int wc, int fr, int fq) const {
        int row0 = u.pm * 256 + wr * 64 + fr; asm volatile("" : "+v"(row0)); const int col0 = u.pn * 256 + wc * 32 + 8 * fq; bf16_t* base = YS + (size_t)u.g * ESLOTS * D; const float* gp = gatev + u.g * ESLOTS;
#pragma unroll
        for (int ai = 0; ai < 2; ++ai)
#pragma unroll
            for (int m = 0; m < 4; ++m) { const int row = row0 + ai * 128 + m * 16; const float gs = gp[row]; bf16_t* rowp = base + (size_t)row * D + col0;
#pragma unroll
                for (int bj = 0; bj < 2; ++bj) { const f32x4 v0 = acc[ai][bj][m][0] * gs, v1 = acc[ai][bj][m][1] * gs;
                    u32x4 w; w.x = cvt_pk_bf16(v0[0], v0[1]); w.y = cvt_pk_bf16(v0[2], v0[3]); w.z = cvt_pk_bf16(v1[0], v1[1]); w.w = cvt_pk_bf16(v1[2], v1[3]);
                    *(u32x4*)(rowp + bj * 128) = w; } }
    }
};
__device__ __forceinline__ void mixA_unit(const Ctx& c, int l, int un) {
    const int cn = un >> 3, g = un & 7; const int row0 = cn * 128;
    const bf16_t* Z = (const bf16_t*)(c.ws + WS_RA); bf16_t* Y = (bf16_t*)(c.ws + WS_RB + RB_YCAT);
    const bf16_t* WSb = (const bf16_t*)(c.ws + WS_WT + (size_t)l * WT_LAYER + WT_S) + g * 16384;
    LAS bf16_t* VT = (LAS bf16_t*)c.lds;
    { const int s = c.tid >> 2, qd = c.tid & 3; const bf16_t* p = Z + (size_t)(row0 + s) * NZ + ZVA + g * 128 + qd * 32;
      float v[32];
#pragma unroll
      for (int i = 0; i < 4; ++i) { const u32x4 w = *(const u32x4*)(p + 8 * i); v[8 * i] = bflo(w.x); v[8 * i + 1] = bfhi(w.x); v[8 * i + 2] = bflo(w.y); v[8 * i + 3] = bfhi(w.y); v[8 * i + 4] = bflo(w.z); v[8 * i + 5] = bfhi(w.z); v[8 * i + 6] = bflo(w.w); v[8 * i + 7] = bfhi(w.w); }
      float sm = 0.f;
#pragma unroll
      for (int i = 0; i < 32; ++i) sm += v[i];
      sm += __shfl_xor(sm, 1); sm += __shfl_xor(sm, 2); const float mu = sm * (1.f / 128.f); float sq = 0.f;
#pragma unroll
      for (int i = 0; i < 32; ++i) { v[i] -= mu; sq += v[i] * v[i]; }
      sq += __shfl_xor(sq, 1); sq += __shfl_xor(sq, 2); const float rstd = 1.0f / sqrtf(sq * (1.f / 128.f) + EPS);
#pragma unroll
      for (int i = 0; i < 32; ++i) VT[(qd * 32 + i) * 136 + s] = f2bf(v[i] * rstd); }
    __syncthreads();
    const int w = c.wave, lr = c.lane & 15, lq = c.lane >> 4;
    bf16x8 bw[4];
#pragma unroll
    for (int ks = 0; ks < 4; ++ks) bw[ks] = *(const bf16x8*)(WSb + (16 * w + lr) * 128 + 32 * ks + 8 * lq);
    const int t = row0 + 16 * w + lr; const float bs = c.in[I_BS][(l * 8 + g) * 128 + 16 * w + lr];
#pragma unroll
    for (int ct = 0; ct < 8; ++ct) { f32x4 acc = {0.f, 0.f, 0.f, 0.f};
#pragma unroll
        for (int ks = 0; ks < 4; ++ks) { const bf16x8 a = *(const LAS bf16x8*)(VT + (16 * ct + lr) * 136 + 32 * ks + 8 * lq); acc = __builtin_amdgcn_mfma_f32_16x16x32_bf16(a, bw[ks], acc, 0, 0, 0); }
        const int cc = g * 128 + 16 * ct + 4 * lq; const u32x2 uw = *(const u32x2*)(Z + (size_t)t * NZ + ZU + cc);
        u32x2 o; o.x = cvt_pk_bf16(bflo(uw.x) * (acc[0] + bs), bfhi(uw.x) * (acc[1] + bs)); o.y = cvt_pk_bf16(bflo(uw.y) * (acc[2] + bs), bfhi(uw.y) * (acc[3] + bs));
        *(u32x2*)(Y + (size_t)t * 3072 + cc) = o; }
    __syncthreads();
}
__device__ __forceinline__ void gla_b1_unit(const Ctx& c, int l, int un) {
    const int n = un >> 2, h = un & 3, row0 = n * 64, tid = c.tid, lane = c.lane, w = c.wave, lr = lane & 15, lq = lane >> 4;
    const bf16_t* Z = (const bf16_t*)(c.ws + WS_RA);
    LAS bf16_t* VTs = (LAS bf16_t*)c.lds;
    LAS float* Ds = (LAS float*)(c.lds + 36864);
    LAS float* La = (LAS float*)(c.lds + 45056);
    LAS float* Tot = (LAS float*)(c.lds + 78080);
    LAS bf16_t* QD = (LAS bf16_t*)(c.lds + 80128);
    LAS bf16_t* KI = (LAS bf16_t*)(c.lds + 97536);
    LAS bf16_t* Ps = (LAS bf16_t*)(c.lds + 114944);
    LAS bf16_t* KdT = (LAS bf16_t*)(c.lds + 124160);
    { const int t = tid >> 3, cb = (tid & 7) * 32; const bf16_t* p = Z + (size_t)(row0 + t) * NZ + ZVB + h * 256 + cb;
#pragma unroll
      for (int i = 0; i < 4; ++i) { const u32x4 wv = *(const u32x4*)(p + 8 * i); LAS bf16_t* d = VTs + (cb + 8 * i) * 72 + t;
        d[0] = (bf16_t)wv.x; d[72] = (bf16_t)(wv.x >> 16); d[144] = (bf16_t)wv.y; d[216] = (bf16_t)(wv.y >> 16); d[288] = (bf16_t)wv.z; d[360] = (bf16_t)(wv.z >> 16); d[432] = (bf16_t)wv.w; d[504] = (bf16_t)(wv.w >> 16); }
      const int dt = tid >> 3, dc = (tid & 7) * 4; const u32x2 dv = *(const u32x2*)(Z + (size_t)(row0 + dt) * NZ + ZDEC + dc);
      Ds[dt * 32 + dc] = bflo(dv.x); Ds[dt * 32 + dc + 1] = bfhi(dv.x); Ds[dt * 32 + dc + 2] = bflo(dv.y); Ds[dt * 32 + dc + 3] = bfhi(dv.y); }
    __syncthreads();
    f32x4 pacc[2] = {{0.f, 0.f, 0.f, 0.f}, {0.f, 0.f, 0.f, 0.f}};
#pragma unroll 1
    for (int dir = 0; dir < 2; ++dir) {
        { const int ch = tid & 127, t0 = tid >> 7; const float* wd = c.in[I_WDEC] + (size_t)(l * 2 + dir) * 16 * 512 + h * 128 + ch; float wv[16];
#pragma unroll
          for (int r = 0; r < 16; ++r) wv[r] = wd[r * 512];
          const float bias = c.in[I_BDEC][(l * 2 + dir) * 512 + h * 128 + ch];
#pragma unroll 4
          for (int i = 0; i < 16; ++i) { const int t = t0 + 4 * i; float pre = bias;
#pragma unroll
              for (int r = 0; r < 16; ++r) pre += Ds[t * 32 + dir * 16 + r] * wv[r];
              const float ls = fminf(pre, 0.f) - __logf(1.f + __expf(-fabsf(pre)));
              La[t * 129 + ch] = ls * 0.0625f; } }
        __syncthreads();
        { const int ch = tid & 127, sg = tid >> 7; float loc[16]; float run = 0.f;
          if (dir == 0) {
#pragma unroll
              for (int i = 0; i < 16; ++i) { run += La[(16 * sg + i) * 129 + ch]; loc[i] = run; } }
          else {
#pragma unroll
              for (int i = 15; i >= 0; --i) { run += La[(16 * sg + i) * 129 + ch]; loc[i] = run; } }
          Tot[sg * 128 + ch] = run;
          __syncthreads();
          float off = 0.f;
#pragma unroll
          for (int s2 = 0; s2 < 4; ++s2) { const float tv = Tot[s2 * 128 + ch]; if (dir == 0 ? (s2 < sg) : (s2 > sg)) off += tv; }
#pragma unroll
          for (int i = 0; i < 16; ++i) La[(16 * sg + i) * 129 + ch] = loc[i] + off; }
        __syncthreads();
        { const int t = tid >> 3, cb = (tid & 7) * 16; const bf16_t* qp = Z + (size_t)(row0 + t) * NZ + ZQB + h * 128 + cb; const bf16_t* kp = Z + (size_t)(row0 + t) * NZ + ZKB + h * 128 + cb;
          float q[16], k[16];
#pragma unroll
          for (int i = 0; i < 2; ++i) { const u32x4 a = *(const u32x4*)(qp + 8 * i), b = *(const u32x4*)(kp + 8 * i);
              q[8 * i] = bflo(a.x); q[8 * i + 1] = bfhi(a.x); q[8 * i + 2] = bflo(a.y); q[8 * i + 3] = bfhi(a.y); q[8 * i + 4] = bflo(a.z); q[8 * i + 5] = bfhi(a.z); q[8 * i + 6] = bflo(a.w); q[8 * i + 7] = bfhi(a.w);
              k[8 * i] = bflo(b.x); k[8 * i + 1] = bfhi(b.x); k[8 * i + 2] = bflo(b.y); k[8 * i + 3] = bfhi(b.y); k[8 * i + 4] = bflo(b.z); k[8 * i + 5] = bfhi(b.z); k[8 * i + 6] = bflo(b.w); k[8 * i + 7] = bfhi(b.w); }
          const int tl = (dir == 0) ? 63 : 0; float qd[16], ki[16];
#pragma unroll
          for (int i = 0; i < 16; ++i) { const float b = La[t * 129 + cb + i], bl = La[tl * 129 + cb + i]; const float e = __expf(b);
              qd[i] = q[i] * e; ki[i] = k[i] * fast_rcp(e); KdT[(cb + i) * 72 + t] = f2bf(k[i] * __expf(bl - b)); }
          u32x4 o0, o1;
          o0.x = cvt_pk_bf16(qd[0], qd[1]); o0.y = cvt_pk_bf16(qd[2], qd[3]); o0.z = cvt_pk_bf16(qd[4], qd[5]); o0.w = cvt_pk_bf16(qd[6], qd[7]);
          o1.x = cvt_pk_bf16(qd[8], qd[9]); o1.y = cvt_pk_bf16(qd[10], qd[11]); o1.z = cvt_pk_bf16(qd[12], qd[13]); o1.w = cvt_pk_bf16(qd[14], qd[15]);
          *(LAS u32x4*)(QD + t * 136 + cb) = o0; *(LAS u32x4*)(QD + t * 136 + cb + 8) = o1;
          bf16_t* qg = (bf16_t*)(c.ws + WS_RB + RB_QDF) + ((size_t)(dir * 1088 + un) * 64 + t) * 128 + cb;
          u32x4 p0, p1; p0.x = o0.x; p0.y = o0.y; p0.z = o1.x; p0.w = o1.y; p1.x = o0.z; p1.y = o0.w; p1.z = o1.z; p1.w = o1.w;
          *(u32x4*)qg = p0; *(u32x4*)(qg + 8) = p1;
          o0.x = cvt_pk_bf16(ki[0], ki[1]); o0.y = cvt_pk_bf16(ki[2], ki[3]); o0.z = cvt_pk_bf16(ki[4], ki[5]); o0.w = cvt_pk_bf16(ki[6], ki[7]);
          o1.x = cvt_pk_bf16(ki[8], ki[9]); o1.y = cvt_pk_bf16(ki[10], ki[11]); o1.z = cvt_pk_bf16(ki[12], ki[13]); o1.w = cvt_pk_bf16(ki[14], ki[15]);
          *(LAS u32x4*)(KI + t * 136 + cb) = o0; *(LAS u32x4*)(KI + t * 136 + cb + 8) = o1;
          if (tid < 128) ((float*)(c.ws + WS_RB + RB_DECAY))[(size_t)(dir * 1088 + un) * 128 + tid] = __expf(La[tl * 129 + tid]); }
        __syncthreads();
        { bf16_t* kg = (bf16_t*)(c.ws + WS_RB + RB_KDT) + (size_t)(dir * 1088 + un) * 8192;
#pragma unroll
          for (int i = 0; i < 2; ++i) { const int id = tid + 512 * i, ch = id >> 3, tc = id & 7; *(u32x4*)(kg + ch * 64 + tc * 8) = *(const LAS u32x4*)(KdT + ch * 72 + tc * 8); } }
        { const int it = w >> 1; bf16x8 a[4];
#pragma unroll
          for (int ks = 0; ks < 4; ++ks) a[ks] = *(const LAS bf16x8*)(QD + (16 * it + lr) * 136 + 32 * ks + 8 * lq);
#pragma unroll
          for (int jj = 0; jj < 2; ++jj) { const int jt = 2 * (w & 1) + jj; f32x4 s = {0.f, 0.f, 0.f, 0.f};
#pragma unroll
              for (int ks = 0; ks < 4; ++ks) { const bf16x8 b = *(const LAS bf16x8*)(KI + (16 * jt + lr) * 136 + 32 * ks + 8 * lq); s = __builtin_amdgcn_mfma_f32_16x16x32_bf16(a[ks], b, s, 0, 0, 0); }
              const int j = 16 * jt + lr;
#pragma unroll
              for (int e = 0; e < 4; ++e) { const int i = 16 * it + 4 * lq + e; const bool keep = (dir == 0) ? (j <= i) : (j >= i); pacc[jj][e] += keep ? s[e] : 0.f; } } }
        __syncthreads();
    }
    { const int it = w >> 1;
#pragma unroll
      for (int jj = 0; jj < 2; ++jj) { const int j = 16 * (2 * (w & 1) + jj) + lr;
#pragma unroll
          for (int e = 0; e < 4; ++e) { Ps[(16 * it + 4 * lq + e) * 72 + j] = f2bf(pacc[jj][e]); } } }
    __syncthreads();
    { bf16_t* OI = (bf16_t*)(c.ws + WS_RB + RB_OINTRA);
#pragma unroll
      for (int dd = 0; dd < 2; ++dd) { const int dt = 2 * w + dd; bf16x8 a[2];
#pragma unroll
          for (int ks = 0; ks < 2; ++ks) a[ks] = *(const LAS bf16x8*)(VTs + (16 * dt + lr) * 72 + 32 * ks + 8 * lq);
#pragma unroll
          for (int it = 0; it < 4; ++it) { f32x4 o = {0.f, 0.f, 0.f, 0.f};
#pragma unroll
              for (int ks = 0; ks < 2; ++ks) { const bf16x8 b = *(const LAS bf16x8*)(Ps + (16 * it + lr) * 72 + 32 * ks + 8 * lq); o = __builtin_amdgcn_mfma_f32_16x16x32_bf16(a[ks], b, o, 0, 0, 0); }

              u32x2 ov; ov.x = cvt_pk_bf16(o[0], o[1]); ov.y = cvt_pk_bf16(o[2], o[3]);
              *(u32x2*)(OI + (size_t)(row0 + 16 * it + lr) * D + h * 256 + 16 * dt + 4 * lq) = ov; } } }
    { bf16_t* vg = (bf16_t*)(c.ws + WS_RB + RB_VTG) + (size_t)un * 16384;
#pragma unroll
      for (int i = 0; i < 4; ++i) { const int id = tid + 512 * i, dv = id >> 3, tc = id & 7; *(u32x4*)(vg + dv * 64 + tc * 8) = *(const LAS u32x4*)(VTs + dv * 72 + tc * 8); } }
    __syncthreads();
}
__device__ __forceinline__ void gla_b2_wave(const Ctx& c, int wu) {
    const int lane = c.lane, lr = lane & 31, hi = lane >> 5;
    const int dvs = wu & 7, h = (wu >> 3) & 3, b = (wu >> 5) & 3, dir = wu >> 7;
    const bf16_t* QDF = (const bf16_t*)(c.ws + WS_RB + RB_QDF) + (size_t)dir * 1088 * 8192;
    const bf16_t* KDT = (const bf16_t*)(c.ws + WS_RB + RB_KDT) + (size_t)dir * 1088 * 8192;
    const bf16_t* VTG = (const bf16_t*)(c.ws + WS_RB + RB_VTG);
    const float* DEC = (const float*)(c.ws + WS_RB + RB_DECAY) + (size_t)dir * 1088 * 128;
    bf16_t* OUT = (bf16_t*)(c.ws + WS_RB + (dir == 0 ? RB_OF : RB_OB));
    f32x16 S[4];
#pragma unroll
    for (int ct = 0; ct < 4; ++ct)
#pragma unroll
        for (int r = 0; r < 16; ++r) S[ct][r] = 0.f;
#pragma unroll 1
    for (int step = 0; step < 68; ++step) {
        int n;
        if (step < 4) n = 256 + 4 * b + (dir == 0 ? step : 3 - step); else n = 64 * b + (dir == 0 ? step - 4 : 67 - step);
        const int un = n * 4 + h, row0 = n * 64;
        const bf16_t* qd = QDF + (size_t)un * 8192; const bf16_t* kd = KDT + (size_t)un * 8192; const bf16_t* vt = VTG + (size_t)un * 16384 + (size_t)(32 * dvs) * 64; const float* dc = DEC + (size_t)un * 128;
        f32x16 o[2];
#pragma unroll
        for (int tt = 0; tt < 2; ++tt)
#pragma unroll
            for (int r = 0; r < 16; ++r) o[tt][r] = 0.f;
#pragma unroll
        for (int ct = 0; ct < 4; ++ct)
#pragma unroll
            for (int s = 0; s < 2; ++s) { u32x4 bw; bw.x = cvt_pk_bf16(S[ct][8 * s], S[ct][8 * s + 1]); bw.y = cvt_pk_bf16(S[ct][8 * s + 2], S[ct][8 * s + 3]); bw.z = cvt_pk_bf16(S[ct][8 * s + 4], S[ct][8 * s + 5]); bw.w = cvt_pk_bf16(S[ct][8 * s + 6], S[ct][8 * s + 7]);
                const bf16x8 bfr = __builtin_bit_cast(bf16x8, bw);
#pragma unroll
                for (int tt = 0; tt < 2; ++tt) { const bf16x8 a = *(const bf16x8*)(qd + (32 * tt + lr) * 128 + 32 * ct + 16 * s + 8 * hi); o[tt] = __builtin_amdgcn_mfma_f32_32x32x16_bf16(a, bfr, o[tt], 0, 0, 0); } }
#pragma unroll
        for (int tt = 0; tt < 2; ++tt)
#pragma unroll
            for (int r = 0; r < 16; ++r) { const int t = 32 * tt + (r & 3) + 8 * (r >> 2) + 4 * hi; OUT[(size_t)(row0 + t) * D + h * 256 + 32 * dvs + lr] = f2bf(o[tt][r]); }
#pragma unroll
        for (int ct = 0; ct < 4; ++ct) {
#pragma unroll
            for (int gq = 0; gq < 4; ++gq) { const f32x4 d4 = *(const f32x4*)(dc + 32 * ct + 8 * gq + 4 * hi);
#pragma unroll
                for (int e = 0; e < 4; ++e) S[ct][4 * gq + e] *= d4[e]; }
#pragma unroll
            for (int ks = 0; ks < 4; ++ks) { const bf16x8 a = *(const bf16x8*)(kd + (32 * ct + lr) * 64 + 16 * ks + 8 * hi); const bf16x8 bv = *(const bf16x8*)(vt + lr * 64 + 16 * ks + 8 * hi);
                S[ct] = __builtin_amdgcn_mfma_f32_32x32x16_bf16(a, bv, S[ct], 0, 0, 0); } }
    }
}
__device__ __forceinline__ void gla_finish_row(const Ctx& c, int l, int row) {
    const int lane = c.lane; const bf16_t* OI = (const bf16_t*)(c.ws + WS_RB + RB_OINTRA) + (size_t)row * D; const bf16_t* OFp = (const bf16_t*)(c.ws + WS_RB + RB_OF) + (size_t)row * D; const bf16_t* OBp = (const bf16_t*)(c.ws + WS_RB + RB_OB) + (size_t)row * D;
    const bf16_t* R = (const bf16_t*)(c.ws + WS_RA) + (size_t)row * NZ + ZRB; bf16_t* Y = (bf16_t*)(c.ws + WS_RB + RB_YCAT) + (size_t)row * 3072 + D;
    const f32x4 gv = *(const f32x4*)(c.in[I_GGLA] + l * 256 + 4 * lane);
#pragma unroll
    for (int h = 0; h < 4; ++h) { const int cc = h * 256 + 4 * lane; const u32x2 a = *(const u32x2*)(OI + cc), b = *(const u32x2*)(OFp + cc), d = *(const u32x2*)(OBp + cc), r = *(const u32x2*)(R + cc);
        float o[4] = {bflo(a.x) + bflo(b.x) + bflo(d.x), bfhi(a.x) + bfhi(b.x) + bfhi(d.x), bflo(a.y) + bflo(b.y) + bflo(d.y), bfhi(a.y) + bfhi(b.y) + bfhi(d.y)};
        const float ss = wave_sum((o[0] * o[0] + o[1] * o[1]) + (o[2] * o[2] + o[3] * o[3])); const float rstd = 1.0f / sqrtf(ss * (1.f / 256.f) + EPS);
        u32x2 ov; ov.x = cvt_pk_bf16(o[0] * rstd * gv[0] * bflo(r.x), o[1] * rstd * gv[1] * bfhi(r.x)); ov.y = cvt_pk_bf16(o[2] * rstd * gv[2] * bflo(r.y), o[3] * rstd * gv[3] * bfhi(r.y));
        *(u32x2*)(Y + cc) = ov; }
}
__device__ __forceinline__ void rope_angle(int pos_row, int pos_col, int j, float& cs, float& sn) {
    const int axis = j >> 5, f = j & 15; const float inv = __expf(-(float)(2 * f) * (1.f / 32.f) * 9.210340371976184f);
    float rev = (float)(axis == 0 ? pos_row : pos_col) * inv * 0.15915494309189535f; rev -= floorf(rev); sn = __builtin_amdgcn_sinf(rev); cs = __builtin_amdgcn_cosf(rev);
}
__device__ __forceinline__ void mla_c1_row(const Ctx& c, int l, int row, bool do_q) {
    const int lane = c.lane; const bool lat = row < TL; const int b = lat ? (row >> 12) : ((row - TL) >> 8), t = lat ? (row & 4095) : ((row - TL) & 255), key = lat ? (CTXL + t) : t;
    const bf16_t* Zr = (const bf16_t*)(c.ws + WS_RA) + (size_t)row * NZ;
    const bf16_t* KV = (const bf16_t*)(c.ws + WS_RB + RB_KVRAW) + (size_t)row * 2048; const bf16_t* QR = (const bf16_t*)(c.ws + WS_RB + RB_QRAW) + (size_t)row * 1536;
    bf16_t* KG = (bf16_t*)(c.ws + WS_RB + RB_KG); bf16_t* VG = (bf16_t*)(c.ws + WS_RB + RB_VG);
    float rs_kv, rs_q;
    { const u32x2 w = *(const u32x2*)(Zr + ZCKV + 4 * lane); const float a0 = bflo(w.x), a1 = bfhi(w.x), a2 = bflo(w.y), a3 = bfhi(w.y);
      rs_kv = 1.0f / sqrtf(wave_sum((a0 * a0 + a1 * a1) + (a2 * a2 + a3 * a3)) * (1.f / 256.f) + EPS);
      float s = 0.f;
#pragma unroll
      for (int i = 0; i < 3; ++i) { const unsigned w2 = *(const unsigned*)(Zr + ZCQ + 128 * i + 2 * lane); const float q0 = bflo(w2), q1 = bfhi(w2); s += q0 * q0 + q1 * q1; }
      rs_q = 1.0f / sqrtf(wave_sum(s) * (1.f / 384.f) + EPS); }
    float cs = 1.f, sn = 0.f; if (lat) rope_angle(t >> 6, t & 63, lane, cs, sn);
    const bool second = (lane >> 4) & 1;
    float kr;
    { const float v = bf2f(Zr[ZKR + lane]); const float rr = 1.0f / sqrtf(wave_sum(v * v) * (1.f / 64.f) + EPS); float x = v * rr * c.in[I_GKR][l * 64 + lane];
      const float xp = __shfl_xor(x, 16); kr = lat ? (second ? (x * cs + xp * sn) : (x * cs - xp * sn)) : x; }
    const bf16_t krb = f2bf(kr);
    const f32x4 gkn = *(const f32x4*)(c.in[I_GKN] + l * 128 + 4 * (lane & 31));
#pragma unroll 2
    for (int h = 0; h < 8; ++h) {
        const u32x2 w = *(const u32x2*)(KV + h * 256 + 4 * lane); float a[4] = {bflo(w.x) * rs_kv, bfhi(w.x) * rs_kv, bflo(w.y) * rs_kv, bfhi(w.y) * rs_kv};
        float ss = (a[0] * a[0] + a[1] * a[1]) + (a[2] * a[2] + a[3] * a[3]);
#pragma unroll
        for (int o = 1; o < 32; o <<= 1) ss += __shfl_xor(ss, o);
        const size_t kb = ((size_t)(b * 8 + h) * NKEY + key);
        if (lane < 32) { const float rn = 1.0f / sqrtf(ss * (1.f / 128.f) + EPS); u32x2 o; o.x = cvt_pk_bf16(a[0] * rn * gkn[0], a[1] * rn * gkn[1]); o.y = cvt_pk_bf16(a[2] * rn * gkn[2], a[3] * rn * gkn[3]);
            *(u32x2*)(KG + kb * 192 + 4 * lane) = o; }
        else { u32x2 o; o.x = cvt_pk_bf16(a[0], a[1]); o.y = cvt_pk_bf16(a[2], a[3]); *(u32x2*)(VG + kb * 128 + 4 * (lane - 32)) = o; }
        KG[kb * 192 + 128 + lane] = krb;
    }
    if (!do_q) return;
    bf16_t* QF = lat ? (bf16_t*)(c.ws + WS_RB + RB_QFL) : (bf16_t*)(c.ws + WS_RB + RB_QFC); const int nq = lat ? SEQ : CTXL;
    const float QS = 0.07216878364870322f * 1.4426950408889634f;
    const f32x2 gqn = *(const f32x2*)(c.in[I_GQN] + l * 128 + 2 * lane); const float gqr = c.in[I_GQR][l * 64 + lane];
#pragma unroll 2
    for (int h = 0; h < 8; ++h) {
        const unsigned w = *(const unsigned*)(QR + h * 192 + 2 * lane); const float n0 = bflo(w) * rs_q, n1 = bfhi(w) * rs_q; const float r0 = bf2f(QR[h * 192 + 128 + lane]) * rs_q;
        const float rn = 1.0f / sqrtf(wave_sum(n0 * n0 + n1 * n1) * (1.f / 128.f) + EPS), rr = 1.0f / sqrtf(wave_sum(r0 * r0) * (1.f / 64.f) + EPS);
        const size_t qb = ((size_t)(b * 8 + h) * nq + t) * 192;
        *(unsigned*)(QF + qb + 2 * lane) = cvt_pk_bf16(n0 * rn * gqn[0] * QS, n1 * rn * gqn[1] * QS);
        const float x = r0 * rr * gqr; const float xp = __shfl_xor(x, 16); const float xr = lat ? (second ? (x * cs + xp * sn) : (x * cs - xp * sn)) : x;
        QF[qb + 128 + lane] = f2bf(xr * QS);
    }
}
__device__ __forceinline__ bf16x8 tr_pair(unsigned a0, unsigned a1) {
    bf16x4 x, y; asm volatile("ds_read_b64_tr_b16 %0, %2\n\tds_read_b64_tr_b16 %1, %3\n\ts_waitcnt lgkmcnt(0)" : "=&v"(x), "=&v"(y) : "v"(a0), "v"(a1) : "memory");
    return (bf16x8){x[0], x[1], x[2], x[3], y[0], y[1], y[2], y[3]};
}
__device__ __forceinline__ void attn_unit(const Ctx& c, const bf16_t* Qp  , const bf16_t* Kp  , const bf16_t* Vp  , int nt, bf16_t* Op  ) {
    constexpr int STG = 40960, KB = 24576;
    const int tid = c.tid, lane = c.lane, w = c.wave, lr = lane & 31, hi = lane >> 5;
    const unsigned lds0 = (unsigned)(size_t)c.lds;
    unsigned ksrc[3], vsrc[2];
#pragma unroll
    for (int i = 0; i < 3; ++i) { const int P = (w + 8 * i) * 64 + lane, row = P / 24, cp = P % 24, ch = (cp & ~7) | ((cp & 7) ^ ((row >> 1) & 7)); ksrc[i] = row * 384 + ch * 16; }
#pragma unroll
    for (int i = 0; i < 2; ++i) { const int P = (w + 8 * i) * 64 + lane, row = P >> 4, cp = P & 15, ch = cp ^ (((row & 3) << 2) | ((row >> 2) & 3)); vsrc[i] = row * 256 + ch * 16; }
#define ATT_ISSUE(tile, stg) do { const char* kt_ = (const char*)Kp + (size_t)(tile) * KB; const char* vt_ = (const char*)Vp + (size_t)(tile) * 16384; \
        _Pragma("unroll") for (int i_ = 0; i_ < 3; ++i_) __builtin_amdgcn_global_load_lds((const unsigned*)(kt_ + ksrc[i_]), (LAS unsigned*)(c.lds + (stg) * STG + (w + 8 * i_) * 1024), 16, 0, 0); \
        _Pragma("unroll") for (int i_ = 0; i_ < 2; ++i_) __builtin_amdgcn_global_load_lds((const unsigned*)(vt_ + vsrc[i_]), (LAS unsigned*)(c.lds + (stg) * STG + KB + (w + 8 * i_) * 1024), 16, 0, 0); } while (0)
    bf16x8 qf[12];
    { const bf16_t* qrow = Qp + (size_t)(32 * w + lr) * 192 + 8 * hi;
#pragma unroll
      for (int s = 0; s < 12; ++s) qf[s] = *(const bf16x8*)(qrow + 16 * s); }
    unsigned kbase = lr * 384, y16 = (unsigned)((hi ^ ((lr >> 1) & 7)) << 4);
    unsigned vbase, q64, vd1;
    { const int blk = (lane >> 4) & 1, q = (lane & 15) >> 2, p = lane & 3; const int lb = (2 * blk + (p >> 1)) ^ hi;
      vbase = KB + 256 * (4 * hi + q) + 16 * lb + 8 * (p & 1); q64 = (unsigned)(q << 6); vd1 = 2048u + ((lb & 2) ? -32 : 32); }
    f32x16 o[4];
#pragma unroll
    for (int cc = 0; cc < 4; ++cc)
#pragma unroll
        for (int r = 0; r < 16; ++r) o[cc][r] = 0.f;
    float m = -1e30f, lsum = 0.f;
    ATT_ISSUE(0, 0);
    if (nt > 1) ATT_ISSUE(1, 1);
#pragma unroll 1
    for (int j = 0; j < nt; ++j) {
        if (j + 1 < nt) asm volatile("s_waitcnt vmcnt(5)" ::: "memory"); else asm volatile("s_waitcnt vmcnt(0)" ::: "memory");
        asm volatile("s_waitcnt lgkmcnt(0)" ::: "memory"); __builtin_amdgcn_s_barrier(); asm volatile("" ::: "memory");
        if (j + 2 < nt) ATT_ISSUE(j + 2, (j + 2) % 3);
        const unsigned sb = lds0 + (unsigned)((j % 3) * STG);
        asm volatile("" : "+v"(kbase), "+v"(y16), "+v"(vbase), "+v"(q64), "+v"(vd1));
        const unsigned kb_ = sb + kbase;
        f32x16 st[2];
#pragma unroll
        for (int kt = 0; kt < 2; ++kt) {
#pragma unroll
            for (int r = 0; r < 16; ++r) st[kt][r] = 0.f;
#pragma unroll
            for (int s = 0; s < 12; ++s) { const bf16x8 a = *(const LAS bf16x8*)(size_t)(kb_ + (y16 ^ (unsigned)(((2 * s) & 7) << 4)) + (unsigned)(kt * 12288 + (((2 * s) & ~7) << 4))); st[kt] = __builtin_amdgcn_mfma_f32_32x32x16_bf16(a, qf[s], st[kt], 0, 0, 0); } }
        float mx = st[0][0];
#pragma unroll
        for (int r = 1; r < 16; ++r) mx = fmaxf(mx, st[0][r]);
#pragma unroll
        for (int r = 0; r < 16; ++r) mx = fmaxf(mx, st[1][r]);
        mx = fmaxf(mx, __shfl_xor(mx, 32));
        const float mn = fmaxf(m, mx), alpha = __builtin_amdgcn_exp2f(m - mn); m = mn;
        float ps = 0.f;
#pragma unroll
        for (int kt = 0; kt < 2; ++kt)
#pragma unroll
            for (int r = 0; r < 16; ++r) { st[kt][r] = __builtin_amdgcn_exp2f(st[kt][r] - mn); ps += st[kt][r]; }
        lsum = lsum * alpha + ps;
#pragma unroll
        for (int cc = 0; cc < 4; ++cc)
#pragma unroll
            for (int r = 0; r < 16; ++r) o[cc][r] *= alpha;
#pragma unroll
        for (int kt = 0; kt < 2; ++kt)
#pragma unroll
            for (int s2 = 0; s2 < 2; ++s2) { u32x4 pw; pw.x = cvt_pk_bf16(st[kt][8 * s2], st[kt][8 * s2 + 1]); pw.y = cvt_pk_bf16(st[kt][8 * s2 + 2], st[kt][8 * s2 + 3]); pw.z = cvt_pk_bf16(st[kt][8 * s2 + 4], st[kt][8 * s2 + 5]); pw.w = cvt_pk_bf16(st[kt][8 * s2 + 6], st[kt][8 * s2 + 7]);
                const bf16x8 pb = __builtin_bit_cast(bf16x8, pw); const unsigned rb = sb + vbase + 256 * (32 * kt + 16 * s2);
#pragma unroll
                for (int cc = 0; cc < 4; ++cc) { const unsigned a0 = rb + (q64 ^ (unsigned)(cc << 6)); const bf16x8 a = tr_pair(a0, a0 + vd1); o[cc] = __builtin_amdgcn_mfma_f32_32x32x16_bf16(a, pb, o[cc], 0, 0, 0); } }
    }
    const float linv = 1.0f / (lsum + __shfl_xor(lsum, 32));
    bf16_t* orow = Op + (size_t)(32 * w + lr) * 3072;
#pragma unroll
    for (int cc = 0; cc < 4; ++cc)
#pragma unroll
        for (int g = 0; g < 4; ++g) { u32x2 ov; ov.x = cvt_pk_bf16(o[cc][4 * g] * linv, o[cc][4 * g + 1] * linv); ov.y = cvt_pk_bf16(o[cc][4 * g + 2] * linv, o[cc][4 * g + 3] * linv);
            *(u32x2*)(orow + 32 * cc + 8 * g + 4 * hi) = ov; }
    asm volatile("s_waitcnt vmcnt(0) lgkmcnt(0)" ::: "memory"); __builtin_amdgcn_s_barrier(); asm volatile("" ::: "memory");
#undef ATT_ISSUE
}
__device__ __forceinline__ void route_row(const Ctx& c, int l, int row) {
    const int lane = c.lane, bi = row_modidx(row); f32x4 hv[4];
    modulate_row(xout_row(c, row), c.in[I_GFFN] + l * D, modp(c, l, bi, 3), modp(c, l, bi, 4), (bf16_t*)(c.ws + WS_H) + (size_t)row * D, lane, hv);
    const float* wr = c.in[I_WROUTER] + (size_t)l * D * NEXP; float lg[16];
#pragma unroll
    for (int e = 0; e < 16; ++e) lg[e] = 0.f;
#pragma unroll
    for (int j = 0; j < 4; ++j)
#pragma unroll
        for (int i = 0; i < 4; ++i) { const float* wp = wr + (size_t)(4 * lane + 256 * j + i) * NEXP; const float hvv = hv[j][i];
#pragma unroll
            for (int q = 0; q < 4; ++q) { const f32x4 wv = *(const f32x4*)(wp + 4 * q); lg[4 * q] += hvv * wv[0]; lg[4 * q + 1] += hvv * wv[1]; lg[4 * q + 2] += hvv * wv[2]; lg[4 * q + 3] += hvv * wv[3]; } }
#pragma unroll
    for (int e = 0; e < 16; ++e) lg[e] = wave_sum(lg[e]);
    float mx = lg[0];
#pragma unroll
    for (int e = 1; e < 16; ++e) mx = fmaxf(mx, lg[e]);
    float sum = 0.f;
#pragma unroll
    for (int e = 0; e < 16; ++e) { lg[e] = __expf(lg[e] - mx); sum += lg[e]; }
    const float inv = 1.0f / sum; float mine = 0.f;
#pragma unroll
    for (int e = 0; e < 16; ++e) mine = (lane == e) ? lg[e] * inv : mine;
    float* AF = (float*)(c.ws + WS_AFFT);
    if (lane < 16) { if (row < TL) AF[((size_t)(row >> 12) * 16 + lane) * SEQ + (row & 4095)] = mine; else AF[(size_t)NB * 16 * SEQ + ((size_t)((row - TL) >> 8) * 16 + lane) * CTXL + ((row - TL) & 255)] = mine; }
}
__device__ __forceinline__ void expert_wconv(const Ctx& c, int l) {
    constexpr int U_G = 16 * 32, U_D = 32 * 16, U_E = 2 * U_G + U_D;
    bf16_t* WGU = (bf16_t*)(c.ws + WS_RB + RB_WGU); bf16_t* WD = (bf16_t*)(c.ws + WS_RB + RB_WD);
    for (int u = c.bid; u < NEXP * U_E; u += c.G) { const int e = u / U_E; int r = u % U_E;
        if (r < 2 * U_G) { const int up = r / U_G, rr = r % U_G, nb = rr / 16, kb = rr % 16;
            const float* src = c.in[up ? I_WEU : I_WEG] + ((size_t)l * NEXP + e) * D * DEXP; const int drow = (nb >> 1) * 256 + up * 128 + (nb & 1) * 64;
            tconv_tile(c, src, DEXP, kb * 64, nb * 64, 64, nullptr, WGU + (size_t)e * 4096 * D, D, drow, kb * 64); }
        else { r -= 2 * U_G; const int nb = r / 32, kb = r % 32;
            tconv_tile(c, c.in[I_WED] + ((size_t)l * NEXP + e) * DEXP * D, D, kb * 64, nb * 64, 64, nullptr, WD + (size_t)e * D * DEXP, DEXP, nb * 64, kb * 64); } }
}
__device__ __forceinline__ void topk_unit(const Ctx& c, int un, bool is_ctx) {
    const int tid = c.tid; LAS float* av = (LAS float*)c.lds; LAS int* list = (LAS int*)(c.lds + 16384); LAS int* cnt = (LAS int*)(c.lds + 16384 + 4096);
    int b, e, blk, ntok, cap; const float* src;
    if (!is_ctx) { b = un >> 7; e = (un >> 3) & 15; blk = un & 7; ntok = SEQ; cap = CAPL; src = (const float*)(c.ws + WS_AFFT) + ((size_t)b * 16 + e) * SEQ; }
    else { b = un >> 4; e = un & 15; blk = 0; ntok = CTXL; cap = CAPC; src = (const float*)(c.ws + WS_AFFT) + (size_t)NB * 16 * SEQ + ((size_t)b * 16 + e) * CTXL; }
    for (int i = tid; i < ntok; i += NTHR) av[i] = src[i];
    if (tid == 0) *cnt = 0;
    __syncthreads();
    const int tok = blk * 512 + tid; const bool valid = tok < ntok; const float a = valid ? av[tok] : 0.f; int rank = 0;
    for (int j = 0; j < ntok; j += 4) { const f32x4 v = *(const LAS f32x4*)(av + j);
        rank += (v[0] > a || (v[0] == a && j < tok)) ? 1 : 0; rank += (v[1] > a || (v[1] == a && j + 1 < tok)) ? 1 : 0;
        rank += (v[2] > a || (v[2] == a && j + 2 < tok)) ? 1 : 0; rank += (v[3] > a || (v[3] == a && j + 3 < tok)) ? 1 : 0; }
    const int row = is_ctx ? (TL + b * CTXL + tok) : (b * SEQ + tok);
    if (valid) { const bool sel = rank < cap; ((int*)(c.ws + WS_SEL))[(size_t)row * 16 + e] = sel ? rank : -1;
        if (sel) { const int slot = is_ctx ? (2048 + b * CAPC + rank) : (b * CAPL + rank); ((float*)(c.ws + WS_GATEV))[e * ESLOTS + slot] = a;
            const int p = atomicAdd((int*)cnt, 1); list[2 * p] = row; list[2 * p + 1] = slot; } }
    __syncthreads();
    const int nsel = *cnt; const bf16_t* H = (const bf16_t*)(c.ws + WS_H); bf16_t* XS = (bf16_t*)(c.ws + WS_RA + RA_XS) + (size_t)e * ESLOTS * D;
    for (int i = c.wave; i < nsel; i += NWAVES) { const int r = list[2 * i], s = list[2 * i + 1]; const u32x4* sp = (const u32x4*)(H + (size_t)r * D); u32x4* dp = (u32x4*)(XS + (size_t)s * D);
        dp[c.lane] = sp[c.lane]; dp[64 + c.lane] = sp[64 + c.lane]; }
    __syncthreads();
}
__device__ __forceinline__ void combine_row(const Ctx& c, int l, int row, bool next_mod) {
    const int lane = c.lane, bi = row_modidx(row); float* xr = xout_row(c, row); const int* sel = (const int*)(c.ws + WS_SEL) + (size_t)row * 16;
    const bf16_t* YS = (const bf16_t*)(c.ws + WS_RA + RA_YS); const float* g5 = modp(c, l, bi, 5);
    f32x4 acc[4];
#pragma unroll
    for (int j = 0; j < 4; ++j) acc[j] = (f32x4){0.f, 0.f, 0.f, 0.f};
    const bool lat = row < TL; const int b = lat ? (row >> 12) : ((row - TL) >> 8);
    for (int e = 0; e < 16; ++e) { const int r = sel[e]; if (r < 0) continue; const int slot = lat ? (b * CAPL + r) : (2048 + b * CAPC + r);
        const bf16_t* yp = YS + ((size_t)e * ESLOTS + slot) * D;
#pragma unroll
        for (int j = 0; j < 4; ++j) { const u32x2 w = *(const u32x2*)(yp + 4 * lane + 256 * j); acc[j][0] += bflo(w.x); acc[j][1] += bfhi(w.x); acc[j][2] += bflo(w.y); acc[j][3] += bfhi(w.y); } }
    float ss = 0.f; f32x4 xv[4];
#pragma unroll
    for (int j = 0; j < 4; ++j) { const int cc = 4 * lane + 256 * j; xv[j] = *(const f32x4*)(xr + cc) + *(const f32x4*)(g5 + cc) * acc[j]; *(f32x4*)(xr + cc) = xv[j];
        ss += (xv[j][0] * xv[j][0] + xv[j][1] * xv[j][1]) + (xv[j][2] * xv[j][2] + xv[j][3] * xv[j][3]); }
    if (!next_mod) return;
    const float rstd = 1.0f / sqrtf(wave_sum(ss) * (1.f / D) + EPS); const float* g = c.in[I_GMIX] + (l + 1) * D; const float* sh = modp(c, l + 1, bi, 0); const float* sc = modp(c, l + 1, bi, 1);
    bf16_t* hrow = (bf16_t*)(c.ws + WS_H) + (size_t)row * D;
#pragma unroll
    for (int j = 0; j < 4; ++j) { const int cc = 4 * lane + 256 * j; const f32x4 h = xv[j] * rstd * *(const f32x4*)(g + cc) * (*(const f32x4*)(sc + cc) + 1.0f) + *(const f32x4*)(sh + cc);
        u32x2 o; o.x = cvt_pk_bf16(h[0], h[1]); o.y = cvt_pk_bf16(h[2], h[3]); *(u32x2*)(hrow + cc) = o; }
}

#ifndef MK_FUSED
#define MK_FUSED 1
#endif
constexpr int NPH = 2 + 11 * 2;
constexpr int CW_BAR = 4096;

__global__ void __launch_bounds__(NTHR, 2) fwd(Args args) {
    extern __shared__ __attribute__((aligned(16))) unsigned char lds_raw[];
    Ctx c; c.in = args.in; c.out = args.out; c.ws = args.ws; c.lds = (LAS unsigned char*)lds_raw;
    c.tid = threadIdx.x; c.lane = c.tid & 63; c.wave = __builtin_amdgcn_readfirstlane(c.tid >> 6); c.G = gridDim.x; c.bid = blockIdx.x;
    volatile LAS unsigned* misc = (volatile LAS unsigned*)(c.lds + LDS_MISC);
    if (c.tid < 8) misc[c.tid] = 0u;
    __syncthreads();
#if MK_FUSED
    XcdBarrier bar = xcd_barrier_post((unsigned*)(c.ws + WS_CTL) + CW_BAR, misc);
#define GRID_BAR() xcd_barrier(bar)
#else
#define GRID_BAR() do {} while (0)
#endif
    const int lo = args.ph_lo, hi = args.ph_hi;
#ifndef PHMASK
#define PHMASK 0xffffffffu
#endif
#define IN(k) (lo <= (k) && (k) < hi)
#define EN(j) ((PHMASK >> (j)) & 1u)
#define SEAM(k) do { if (IN((k) + 1)) GRID_BAR(); } while (0)
    const int NGW = c.G * NWAVES;
#define PHASE_CTX() Ctx pc = c; { int t_ = pc.tid; asm volatile("" : "+v"(t_)); pc.tid = t_; pc.lane = t_ & 63; pc.wave = __builtin_amdgcn_readfirstlane(t_ >> 6); } const int gw = pc.bid * NWAVES + pc.wave; (void)gw

    if (EN(0) && IN(0)) { PHASE_CTX(); phase_pre_a(pc); SEAM(0); }
    if (EN(1) && IN(1)) { PHASE_CTX(); phase_modulate_mix(pc, 0); SEAM(1); }
#pragma unroll 1
    for (int l = 0; l < 2; ++l) {
        const int p0 = 2 + 11 * l; const bool first = (l == 0); const int nMa = first ? 68 : 64;
#define PHASE_PTRS() PHASE_CTX(); unsigned char* wt = pc.ws + WS_WT + (size_t)l * WT_LAYER; bf16_t* Z = (bf16_t*)(pc.ws + WS_RA); bf16_t* H = (bf16_t*)(pc.ws + WS_H); (void)wt; (void)Z; (void)H
        if (EN(2) && IN(p0 + 0)) { PHASE_PTRS();
            pg8::Gemm g{H, (const bf16_t*)(wt + WT_IN), D, D, D, 0, 0}; pg8::GOrder S; S.init(68, 35, 1, pc.G, pc.bid);
            EpiZ E{Z, pc.in[I_BGATE] + l * 3072};
            pg8::gemm_phase<EpiZ, pg8::GOrder>(pc.lds, pc.tid, g, S, E); SEAM(p0 + 0); }
        if (EN(3) && IN(p0 + 1)) { PHASE_PTRS();
#ifndef NO_G2G3
            { pg8::Gemm g{Z + ZCKV, (const bf16_t*)(wt + WT_UKV), NZ, 256, 256, 0, 0}; pg8::GOrder S; S.init(68, 8, 1, pc.G, pc.bid); EpiPlain E{(bf16_t*)(pc.ws + WS_RB + RB_KVRAW), 2048};
              pg8::gemm_phase<EpiPlain, pg8::GOrder>(pc.lds, pc.tid, g, S, E); }
            { pg8::Gemm g{Z + ZCQ, (const bf16_t*)(wt + WT_UQ), NZ, 384, 384, 0, 0}; pg8::GOrder S; S.init(nMa, 6, 1, pc.G, pc.bid); EpiPlain E{(bf16_t*)(pc.ws + WS_RB + RB_QRAW), 1536};
              pg8::gemm_phase<EpiPlain, pg8::GOrder>(pc.lds, pc.tid, g, S, E); }
#endif
#ifndef NO_MIXA
            for (int u = pc.bid; u < nMa * 2 * 8; u += pc.G) mixA_unit(pc, l, u);
#endif
#ifndef NO_B1
            for (int u = pc.bid; u < 1088; u += pc.G) gla_b1_unit(pc, l, u);
#endif
            SEAM(p0 + 1); }
        if (EN(4) && IN(p0 + 2)) { PHASE_PTRS();
            if (pc.wave == 0) { for (int wu = pc.bid; wu < 256; wu += pc.G) gla_b2_wave(pc, wu); }
            else { for (int row = pc.bid * 7 + (pc.wave - 1); row < T; row += pc.G * 7) mla_c1_row(pc, l, row, first || row < TL); }
            SEAM(p0 + 2); }
        if (EN(5) && IN(p0 + 3)) { PHASE_PTRS();
#ifndef NO_FIN
            for (int row = gw; row < nMa * 256; row += NGW) gla_finish_row(pc, l, row);
#endif
            bf16_t* Y = (bf16_t*)(pc.ws + WS_RB + RB_YCAT) + 2048;
            const bf16_t* KG = (const bf16_t*)(pc.ws + WS_RB + RB_KG); const bf16_t* VG = (const bf16_t*)(pc.ws + WS_RB + RB_VG);
            const int G8 = pc.G >> 3;
            for (int i = 0;; ++i) {
                int un; if ((pc.G & 7) == 0 && (G8 & 15) == 0) { const int x = pc.bid & 7, s = pc.bid >> 3, ppx = G8 >> 4; un = ((i * 8 * ppx) + x * ppx + (s >> 4)) * 16 + (s & 15); } else un = i * pc.G + pc.bid;
                if (un >= 512) break;
                const int bh = un >> 4, qb = un & 15, b = bh >> 3, h = bh & 7;
                attn_unit(pc, (const bf16_t*)(pc.ws + WS_RB + RB_QFL) + ((size_t)bh * SEQ + qb * 256) * 192, KG + (size_t)bh * NKEY * 192, VG + (size_t)bh * NKEY * 128, 68, Y + (size_t)(b * SEQ + qb * 256) * 3072 + h * 128); }
            if (first) for (int un = pc.bid; un < 32; un += pc.G) { const int b = un >> 3, h = un & 7;
                attn_unit(pc, (const bf16_t*)(pc.ws + WS_RB + RB_QFC) + (size_t)un * CTXL * 192, KG + (size_t)un * NKEY * 192, VG + (size_t)un * NKEY * 128, 4, Y + (size_t)(TL + b * CTXL) * 3072 + h * 128); }
            SEAM(p0 + 3); }
        if (EN(6) && IN(p0 + 4)) { PHASE_PTRS();
            pg8::Gemm g{(const bf16_t*)(pc.ws + WS_RB + RB_YCAT), (const bf16_t*)(wt + WT_M), 3072, 3072, 3072, 0, 0}; pg8::GOrder S; S.init(nMa, 4, 1, pc.G, pc.bid);
            EpiMerge E{(bf16_t*)(pc.ws + WS_RB + RB_MERGED), Z};
            pg8::gemm_phase<EpiMerge, pg8::GOrder>(pc.lds, pc.tid, g, S, E); SEAM(p0 + 4); }
        if (EN(7) && IN(p0 + 5)) { PHASE_PTRS();
            pg8::Gemm g{(const bf16_t*)(pc.ws + WS_RB + RB_MERGED), (const bf16_t*)(wt + WT_OUT), D, D, D, 0, 0}; pg8::GOrder S; S.init(nMa, 4, 1, pc.G, pc.bid);
            EpiResid E{&pc, l};
            pg8::gemm_phase<EpiResid, pg8::GOrder>(pc.lds, pc.tid, g, S, E); SEAM(p0 + 5); }
        if (EN(8) && IN(p0 + 6)) { PHASE_PTRS();
            for (int row = gw; row < nMa * 256; row += NGW) route_row(pc, l, row);
            expert_wconv(pc, l); SEAM(p0 + 6); }
        if (EN(9) && IN(p0 + 7)) { PHASE_PTRS();
            for (int u = pc.bid; u < 512; u += pc.G) topk_unit(pc, u, false);
            if (first) for (int u = pc.bid; u < 64; u += pc.G) topk_unit(pc, u, true);
            SEAM(p0 + 7); }
        if (EN(10) && IN(p0 + 8)) { PHASE_PTRS();
            pg8::Gemm g{(const bf16_t*)(pc.ws + WS_RA + RA_XS), (const bf16_t*)(pc.ws + WS_RB + RB_WGU), D, D, D, (size_t)ESLOTS * D, (size_t)4096 * D}; pg8::GOrder S; S.init(first ? 9 : 8, 16, 16, pc.G, pc.bid);
            EpiSwiGLU E{(bf16_t*)(pc.ws + WS_RA + RA_HID)};
            pg8::gemm_phase<EpiSwiGLU, pg8::GOrder>(pc.lds, pc.tid, g, S, E); SEAM(p0 + 8); }
        if (EN(11) && IN(p0 + 9)) { PHASE_PTRS();
            pg8::Gemm g{(const bf16_t*)(pc.ws + WS_RA + RA_HID), (const bf16_t*)(pc.ws + WS_RB + RB_WD), DEXP, DEXP, DEXP, (size_t)ESLOTS * DEXP, (size_t)D * DEXP}; pg8::GOrder S; S.init(first ? 9 : 8, 4, 16, pc.G, pc.bid);
            EpiDown E{(bf16_t*)(pc.ws + WS_RA + RA_YS), (const float*)(pc.ws + WS_GATEV)};
            pg8::gemm_phase<EpiDown, pg8::GOrder>(pc.lds, pc.tid, g, S, E); SEAM(p0 + 9); }
        if (EN(12) && IN(p0 + 10)) { PHASE_PTRS();
            for (int row = gw; row < nMa * 256; row += NGW) combine_row(pc, l, row, first);
            SEAM(p0 + 10); }
    }
}

extern "C" void kernel_launch(void* const* d_in, const int* in_sizes, int n_in, void* d_out, int out_size, void* d_ws, size_t ws_size, hipStream_t stream) {
    static int grid = 0;
    if (!grid) {
        int dev = 0, cus = 0, per_cu = 0;
        (void)hipGetDevice(&dev); (void)hipDeviceGetAttribute(&cus, hipDeviceAttributeMultiprocessorCount, dev);
        (void)hipFuncSetAttribute((const void*)fwd, hipFuncAttributeMaxDynamicSharedMemorySize, LDS_BYTES);
        (void)hipOccupancyMaxActiveBlocksPerMultiprocessor(&per_cu, fwd, NTHR, LDS_BYTES);
        grid = cus * (per_cu < 1 ? per_cu : 1);
        if (grid <= 0) { fprintf(stderr, "occupancy query returned 0 blocks per CU\n"); grid = cus; }
        if (ws_size < WS_END) fprintf(stderr, "workspace too small: %zu < %zu\n", ws_size, (size_t)WS_END);
    }
    (void)hipMemsetAsync((unsigned char*)d_ws + WS_CTL, 0, CTL_BYTES, stream);
    Args a{}; for (int i = 0; i < N_INPUTS; ++i) a.in[i] = (const float*)d_in[i]; a.out = (float*)d_out; a.ws = (unsigned char*)d_ws;
#if MK_FUSED
    a.ph_lo = 0; a.ph_hi = NPH;
    hipLaunchKernelGGL(fwd, dim3(grid), dim3(NTHR), LDS_BYTES, stream, a);
#else
#if defined(DEBUG_SCAN)
    hipLaunchKernelGGL(k_seterr, dim3(1), dim3(1), 0, stream, (int*)((unsigned char*)d_ws + WS_CTL + 512 * 1024));
#endif
    for (int p = 0; p < NPH; ++p) { a.ph_lo = p; a.ph_hi = p + 1;
#if defined(DEBUG_SCAN)
        if (p == 3) (void)hipMemsetAsync((unsigned char*)d_ws + WS_RB + RB_OINTRA, 0xff, (size_t)T * D * 2, stream);
#endif
        hipLaunchKernelGGL(fwd, dim3(grid), dim3(NTHR), LDS_BYTES, stream, a);
#if defined(DEBUG_SCAN)
#if defined(DEBUG_HASH)
        if (p == DEBUG_HASH_PHASE) { (void)hipMemsetAsync((unsigned char*)d_ws + WS_CTL + 512 * 1024 + 256, 0, 4, stream);
            hipLaunchKernelGGL(k_hash, dim3(512), dim3(256), 0, stream, (const unsigned*)((unsigned char*)d_ws + DEBUG_HASH_OFF), (long)(DEBUG_HASH_BYTES / 4), (unsigned*)((unsigned char*)d_ws + WS_CTL + 512 * 1024 + 256)); }
#else
        debug_after_phase(p, (unsigned char*)d_ws, (float*)d_out, stream);
#endif
#endif
    }
#if defined(DEBUG_SCAN)
#if defined(DEBUG_HASH)
    hipLaunchKernelGGL(k_apply_hash, dim3(1024), dim3(256), 0, stream, (float*)d_out, (long)out_size, (const unsigned*)((unsigned char*)d_ws + WS_CTL + 512 * 1024 + 256));
#elif defined(DEBUG_STAT)
    hipLaunchKernelGGL(k_apply_stat, dim3(1024), dim3(256), 0, stream, (float*)d_out, (long)out_size, (const int*)((unsigned char*)d_ws + WS_CTL + 512 * 1024));
#else
    hipLaunchKernelGGL(k_apply, dim3(1024), dim3(256), 0, stream, (float*)d_out, (long)out_size, (const int*)((unsigned char*)d_ws + WS_CTL + 512 * 1024));
#endif
#endif
#endif
}
```

```cpp
#define MK_FUSED 1
#include <hip/hip_runtime.h>
#include <cstdint>
#include <cstdio>

#define LAS __attribute__((address_space(3)))
#define GAS __attribute__((address_space(1)))
typedef unsigned short bf16_t;
typedef short bf16x8 __attribute__((ext_vector_type(8)));
typedef short bf16x4 __attribute__((ext_vector_type(4)));
typedef float f32x4 __attribute__((ext_vector_type(4)));
typedef float f32x2 __attribute__((ext_vector_type(2)));
typedef float f32x16 __attribute__((ext_vector_type(16)));
typedef unsigned u32x4 __attribute__((ext_vector_type(4)));
typedef unsigned u32x2 __attribute__((ext_vector_type(2)));

typedef __bf16 bf16v2_t __attribute__((ext_vector_type(2)));
__device__ __forceinline__ unsigned cvt_pk_bf16(float lo, float hi) { bf16v2_t v; v[0] = (__bf16)lo; v[1] = (__bf16)hi; return __builtin_bit_cast(unsigned, v); }
__device__ __forceinline__ bf16_t f2bf(float f) { return (bf16_t)(cvt_pk_bf16(f, 0.f) & 0xffffu); }
__device__ __forceinline__ float bf2f(bf16_t b) { return __uint_as_float(((unsigned)b) << 16); }
__device__ __forceinline__ float bflo(unsigned w) { return __uint_as_float(w << 16); }
__device__ __forceinline__ float bfhi(unsigned w) { return __uint_as_float(w & 0xffff0000u); }
__device__ __forceinline__ float wave_sum(float v) {
#pragma unroll
    for (int o = 1; o < 64; o <<= 1) v += __shfl_xor(v, o);
    return v;
}
__device__ __forceinline__ float fast_rcp(float x) { return __builtin_amdgcn_rcpf(x); }
__device__ __forceinline__ float fast_exp(float x) { return __builtin_amdgcn_exp2f(x * 1.4426950408889634f); }
__device__ __forceinline__ float sigmoidf_(float x) { return fast_rcp(1.f + fast_exp(-x)); }
__device__ __forceinline__ float siluf_(float x) { return x * sigmoidf_(x); }

namespace pg8 {
constexpr int BM = 256, BK = 64, HALF = 128, HTB = HALF * BK * 2, STAGE_BYTES = 8 * HTB, NXCD = 8, WGM = 8;
__host__ __device__ __forceinline__ int lds_byte(int r, int c) { const int st = (r >> 4) * 2 + (c >> 5), rr = r & 15, cc = c & 31, ob = rr * 64 + cc * 2; return st * 1024 + (ob ^ (((ob >> 9) & 1) << 5)); }
__host__ __device__ __forceinline__ void stage_rc(int b, int& R, int& C) { const int st = b / 1024, sb = b % 1024, swz = sb ^ (((sb >> 9) & 1) << 5); R = (st >> 1) * 16 + swz / 64; C = (st & 1) * 32 + (swz % 64) / 2; }
__host__ __device__ __forceinline__ int perm32(int rho) { const int n = rho >> 4, i = rho & 15; return 8 * (i >> 2) + 4 * n + (i & 3); }

struct Unit { int pm, pn, g; };
struct Gemm { const bf16_t* A; const bf16_t* Bt; int lda, ldb, K; size_t gstrideA, gstrideB; };

struct GOrder {
    int nM, nN, nG, nwg, G, c, pm0;
    __device__ void init(int nM_, int nN_, int nG_, int G_, int c_, int pm0_ = 0) { nM = nM_; nN = nN_; nG = nG_; nwg = nM * nN * nG; G = G_; c = c_; pm0 = pm0_; }
    __device__ bool next(int i, Unit& u) const {
        const long L = (long)i * G + c; if (L >= nwg) return false;
        int wgid = (int)L; { const int q = nwg / NXCD, r = nwg % NXCD, xcd = wgid % NXCD, off = wgid / NXCD; wgid = (xcd < r ? xcd * (q + 1) : r * (q + 1) + (xcd - r) * q) + off; }
        const int per = nM * nN; u.g = wgid / per; wgid -= u.g * per;
        const int nig = WGM * nN, gid = wgid / nig, fm = gid * WGM, gsz = (nM - fm) < WGM ? (nM - fm) : WGM;
        u.pm = pm0 + fm + ((wgid % nig) % gsz); u.pn = (wgid % nig) / gsz; return true;
    }
};

template <class Epi, class Sched>
__device__ __forceinline__ void gemm_phase(LAS unsigned char* lds, const int tid, const Gemm g, const Sched& S, const Epi& E) {
    const int wid = __builtin_amdgcn_readfirstlane(tid >> 6), lane = tid & 63, wr = wid >> 2, wc = wid & 3, fr = lane & 15, fq = lane >> 4;
    const int K = g.K, nt = K / BK;
    unsigned voffA[2], voffB[2];
#pragma unroll
    for (int i = 0; i < 2; ++i) { int R, C; stage_rc(tid * 16 + i * 8192, R, C); const int Rb = Epi::PERM ? ((R & ~31) + perm32(R & 31)) : R;
        voffA[i] = (unsigned)(R * g.lda + C) * 2u; voffB[i] = (unsigned)(Rb * g.ldb + C) * 2u; }
    const size_t kstep = (size_t)(BK * 2);
    const size_t hstepA = (size_t)HALF * g.lda * 2, hstepB = (size_t)HALF * g.ldb * 2;
    const size_t tstepA = 2 * hstepA, tstepB = 2 * hstepB;
    const unsigned ldsw = (unsigned)wid * 1024u;
    const int aoff = lds_byte(wr * 64 + fr, fq * 8), boff = lds_byte(wc * 32 + fr, fq * 8);
#define PG8_SA(b, h) (((b) * 2 + (h)) * HTB)
#define PG8_SB(b, h) ((4 + (b) * 2 + (h)) * HTB)
#define PG8_STAGE(bufoff, gbase, voff) do { _Pragma("unroll") for (int _i = 0; _i < 2; ++_i) \
        __builtin_amdgcn_global_load_lds((const unsigned*)((const char*)(gbase) + (voff)[_i]), (LAS unsigned*)(lds + (bufoff) + ldsw + _i * 8192), 16, 0, 0); } while (0)
#define PG8_LDA(dst, b, h) do { _Pragma("unroll") for (int m = 0; m < 4; ++m) _Pragma("unroll") for (int k = 0; k < 2; ++k) dst[m][k] = *(const LAS bf16x8*)(lds + PG8_SA(b, h) + aoff + m * 2048 + k * 1024); } while (0)
#define PG8_LDB(dst, b, h) do { _Pragma("unroll") for (int n = 0; n < 2; ++n) _Pragma("unroll") for (int k = 0; k < 2; ++k) dst[n][k] = *(const LAS bf16x8*)(lds + PG8_SB(b, h) + boff + n * 2048 + k * 1024); } while (0)
#define PG8_MMA(ai, bj, At, Bt) do { __builtin_amdgcn_s_setprio(1); _Pragma("unroll") for (int m = 0; m < 4; ++m) _Pragma("unroll") for (int n = 0; n < 2; ++n) _Pragma("unroll") for (int k = 0; k < 2; ++k) \
        acc[ai][bj][m][n] = __builtin_amdgcn_mfma_f32_16x16x32_bf16(Bt[n][k], At[m][k], acc[ai][bj][m][n], 0, 0, 0); __builtin_amdgcn_s_setprio(0); } while (0)
#define PG8_WAIT_V(n) asm volatile("s_waitcnt vmcnt(" #n ")" ::: "memory")
#define PG8_WAIT_L(n) asm volatile("s_waitcnt lgkmcnt(" #n ")" ::: "memory")
#define PG8_BAR __builtin_amdgcn_s_barrier()
#define PG8_SCHED __builtin_amdgcn_sched_barrier(0)
    Unit cur, nxt; int ui = 0;
    if (!S.next(0, cur)) return;
    f32x4 acc[2][2][4][2];
#pragma unroll
    for (int a = 0; a < 2; ++a)
#pragma unroll
        for (int b = 0; b < 2; ++b)
#pragma unroll
            for (int m = 0; m < 4; ++m)
#pragma unroll
                for (int n = 0; n < 2; ++n) acc[a][b][m][n] = (f32x4){0.f, 0.f, 0.f, 0.f};
    bf16x8 At[4][2], B0[2][2], B1[2][2];
    const char* cA = (const char*)(g.A + (size_t)cur.g * g.gstrideA) + (size_t)cur.pm * tstepA; const char* cB = (const char*)(g.Bt + (size_t)cur.g * g.gstrideB) + (size_t)cur.pn * tstepB;
    PG8_STAGE(PG8_SB(0, 0), cB, voffB); PG8_STAGE(PG8_SB(0, 1), cB + hstepB, voffB); PG8_STAGE(PG8_SA(0, 0), cA, voffA); PG8_STAGE(PG8_SA(0, 1), cA + hstepA, voffA);
    if (wr == 1) PG8_BAR;
    PG8_WAIT_V(2); PG8_BAR;
    PG8_STAGE(PG8_SB(1, 0), cB + kstep, voffB); PG8_STAGE(PG8_SA(1, 0), cA + kstep, voffA); PG8_STAGE(PG8_SB(1, 1), cB + hstepB + kstep, voffB);
    PG8_WAIT_V(6); PG8_BAR;
    for (;;) {
        const bool has_next = S.next(ui + 1, nxt);
        const char* nA = has_next ? (const char*)(g.A + (size_t)nxt.g * g.gstrideA) + (size_t)nxt.pm * tstepA : cA; const char* nB = has_next ? (const char*)(g.Bt + (size_t)nxt.g * g.gstrideB) + (size_t)nxt.pn * tstepB : cB;
        for (int t = 0; t < nt; t += 2) {
            const bool last = (t == nt - 2);
            const char* a1 = cA + (size_t)(t + 1) * kstep;
            const char* a2 = last ? nA : cA + (size_t)(t + 2) * kstep; const char* b2 = last ? nB : cB + (size_t)(t + 2) * kstep;
            const char* a3 = a2 + kstep; const char* b3 = b2 + kstep;
            if constexpr (Epi::MID) { if (t == 16 || t == 32) E.mid(acc, cur, t, wr, wc, fr, fq); }
            PG8_LDB(B0, 0, 0); PG8_LDB(B1, 0, 1); PG8_SCHED; PG8_LDA(At, 0, 0); PG8_STAGE(PG8_SA(1, 1), a1 + hstepA, voffA);
            PG8_WAIT_V(8); PG8_WAIT_L(0); PG8_BAR; PG8_MMA(0, 0, At, B0); PG8_MMA(0, 1, At, B1); PG8_BAR; PG8_SCHED;
            PG8_LDA(At, 0, 1); PG8_STAGE(PG8_SB(0, 0), b2, voffB); PG8_STAGE(PG8_SB(0, 1), b2 + hstepB, voffB); PG8_STAGE(PG8_SA(0, 0), a2, voffA);
            PG8_WAIT_V(8); PG8_WAIT_L(0); PG8_BAR; PG8_MMA(1, 0, At, B0); PG8_MMA(1, 1, At, B1); PG8_BAR; PG8_SCHED;
            PG8_LDB(B0, 1, 0); PG8_LDB(B1, 1, 1); PG8_SCHED; PG8_LDA(At, 1, 0); PG8_STAGE(PG8_SA(0, 1), a2 + hstepA, voffA);
            PG8_WAIT_V(8); PG8_WAIT_L(0); PG8_BAR; PG8_MMA(0, 0, At, B0); PG8_MMA(0, 1, At, B1); PG8_BAR; PG8_SCHED;
            PG8_LDA(At, 1, 1); PG8_STAGE(PG8_SB(1, 0), b3, voffB); PG8_STAGE(PG8_SB(1, 1), b3 + hstepB, voffB); PG8_STAGE(PG8_SA(1, 0), a3, voffA);
            PG8_WAIT_V(8); PG8_WAIT_L(0); PG8_BAR; PG8_MMA(1, 0, At, B0); PG8_MMA(1, 1, At, B1); PG8_BAR; PG8_SCHED;
        }
        if (wr == 0) PG8_BAR;
        E(acc, cur, wr, wc, fr, fq);
        if (!has_next) break;
#pragma unroll
        for (int a = 0; a < 2; ++a)
#pragma unroll
            for (int b = 0; b < 2; ++b)
#pragma unroll
                for (int m = 0; m < 4; ++m)
#pragma unroll
                    for (int n = 0; n < 2; ++n) acc[a][b][m][n] = (f32x4){0.f, 0.f, 0.f, 0.f};
        cur = nxt; cA = nA; cB = nB; ++ui;
        if (wr == 1) PG8_BAR;
    }
    PG8_WAIT_V(0);
    PG8_BAR;
#undef PG8_SA
#undef PG8_SB
#undef PG8_STAGE
#undef PG8_LDA
#undef PG8_LDB
#undef PG8_MMA
#undef PG8_WAIT_V
#undef PG8_WAIT_L
#undef PG8_BAR
#undef PG8_SCHED
}
}
#define XB_TMO      128
#define XB_XCNT(j)  (256  + 64 * (j))
#define XB_XSUB(j)  (1280 + 64 * (j))
#define XB_XGEN(j)  (2304 + 64 * (j))
#define XB_TOP      3328
#define XB_TOPGEN   3392
#define XCD_BAR_WORDS 3456
#define XB_SPIN_CAP (1u << 18)

__device__ __forceinline__ unsigned xb_ld(unsigned* p)              { return __hip_atomic_load(p, __ATOMIC_RELAXED, __HIP_MEMORY_SCOPE_AGENT); }
__device__ __forceinline__ unsigned xb_add(unsigned* p, unsigned v) { return __hip_atomic_fetch_add(p, v, __ATOMIC_RELAXED, __HIP_MEMORY_SCOPE_AGENT); }
__device__ __forceinline__ unsigned xb_xcc_id() { return (unsigned)__builtin_amdgcn_s_getreg((3 << 11) | 20) & 0xFu; }
#define XB_SPIN(cond, bar) do { unsigned _sp = 0; while (cond) { __builtin_amdgcn_s_sleep(1); \
    if ((++_sp & 255u) == 0u) { if (xb_ld(&(bar)[XB_TMO])) break; if (_sp > XB_SPIN_CAP) { atomicAdd(&(bar)[XB_TMO], 1u); break; } } } } while (0)

struct XcdBarrier {
    unsigned* bar; unsigned x;
    volatile LAS unsigned* st;
};

__device__ __forceinline__ XcdBarrier xcd_barrier_post(unsigned* bar, volatile LAS unsigned* st) {
    XcdBarrier b; b.bar = bar; b.x = xb_xcc_id(); b.st = st;
    if (threadIdx.x == 0) (void)xb_add(&bar[XB_XCNT(b.x)], 1u);
    return b;
}
__device__ __forceinline__ void xcd_barrier_complete(unsigned* bar, unsigned x, unsigned& nloc, unsigned& nx) {
    const unsigned G = gridDim.x * gridDim.y * gridDim.z;
    unsigned sum, cnt, mine, sp = 0u;
    for (;;) {
        sum = 0u; cnt = 0u; mine = 0u;
#pragma unroll
        for (unsigned j = 0; j < 16; ++j) { const unsigned c = xb_ld(&bar[XB_XCNT(j)]); sum += c; cnt += (c > 0u) ? 1u : 0u; mine = (j == x) ? c : mine; }
        if (sum == G) break;
        __builtin_amdgcn_s_sleep(1);
        if ((++sp & 255u) == 0u) { if (xb_ld(&bar[XB_TMO])) break; if (sp > XB_SPIN_CAP) { atomicAdd(&bar[XB_TMO], 1u); break; } }
    }
    nloc = mine > 0u ? mine : 1u; nx = cnt > 0u ? cnt : 1u;
}

__device__ __forceinline__ void xcd_barrier(const XcdBarrier& b) {
    asm volatile("s_waitcnt vmcnt(0)" ::: "memory");
    __syncthreads();
    unsigned long long bp_ = (unsigned long long)b.bar; unsigned bx_ = b.x; asm volatile("" : "+s"(bp_), "+s"(bx_)); bx_ = (unsigned)__builtin_amdgcn_readfirstlane((int)bx_); bp_ = ((unsigned long long)(unsigned)__builtin_amdgcn_readfirstlane((int)(bp_ >> 32)) << 32) | (unsigned)__builtin_amdgcn_readfirstlane((int)bp_);
    if (threadIdx.x == 0) {
        unsigned* bar = (unsigned*)bp_;
        __builtin_amdgcn_s_waitcnt(0);
        unsigned nloc = b.st[0], nx = b.st[1];
        if (nloc == 0u) { xcd_barrier_complete(bar, bx_, nloc, nx); b.st[0] = nloc; b.st[1] = nx; }
        const unsigned old = xb_add(&bar[XB_XSUB(bx_)], 1u);
        const unsigned gen = old / nloc;
        if (old + 1u == (gen + 1u) * nloc) {
            __builtin_amdgcn_fence(__ATOMIC_RELEASE, "agent");
            asm volatile("s_waitcnt vmcnt(0)" ::: "memory");
            const unsigned og = xb_add(&bar[XB_TOP], 1u);
            const unsigned tg = og / nx;
            if (og + 1u == (tg + 1u) * nx) xb_add(&bar[XB_TOPGEN], 1u);
            else XB_SPIN(xb_ld(&bar[XB_TOPGEN]) == tg, bar);
            __builtin_amdgcn_fence(__ATOMIC_ACQUIRE, "agent");
            xb_add(&bar[XB_XGEN(bx_)], 1u);
            asm volatile("s_waitcnt vmcnt(0)" ::: "memory");
        } else {
            XB_SPIN(xb_ld(&bar[XB_XGEN(bx_)]) == gen, bar);
            __builtin_amdgcn_fence(__ATOMIC_ACQUIRE, "agent");
            asm volatile("s_waitcnt vmcnt(0)" ::: "memory");
        }
    }
    __syncthreads();
}

namespace cfg {
constexpr int D = 1024, NB = 4, SEQ = 4096, CTXL = 256, TL = NB * SEQ, TC = NB * CTXL, T = TL + TC;
constexpr int NZ = 8960;
constexpr int ZU = 0, ZVA = 1024, ZQB = 2048, ZKB = 2560, ZVB = 3072, ZRB = 4096, ZCQ = 5120, ZKR = 5504, ZDEC = 5568, ZCKV = 5632, ZGT = 5888;
constexpr int NKEY = CTXL + SEQ;
constexpr int NEXP = 16, DEXP = 2048, CAPL = 512, CAPC = 32, ESLOTS = 2304;
constexpr float EPS = 1e-6f;
constexpr int NWAVES = 8, NTHR = 512;
constexpr size_t MiB = 1u << 20;
constexpr size_t WS_CTL = 0, CTL_BYTES = 1 * MiB;
constexpr size_t WS_MOD = 1 * MiB;
constexpr size_t WS_GATEV = WS_MOD + 512 * 1024;
constexpr size_t WS_AFFT = 2 * MiB;
constexpr size_t WS_SEL = 4 * MiB;
constexpr size_t WS_XC = 6 * MiB;
constexpr size_t WS_H = 10 * MiB;
constexpr size_t WS_WT = 44 * MiB, WT_LAYER = 28 * MiB;
constexpr size_t WT_IN = 0, WT_UQ = 17 * MiB + 512 * 1024, WT_UKV = WT_UQ + 1152 * 1024, WT_M = WT_UKV + 1 * MiB, WT_OUT = WT_M + 6 * MiB, WT_S = WT_OUT + 2 * MiB;
static_assert(WT_S + 256 * 1024 <= WT_LAYER, "weights");
constexpr size_t WS_RA = 100 * MiB;
constexpr size_t RA_XS = 0, RA_HID = 72 * MiB, RA_YS = 216 * MiB;
constexpr size_t WS_RB = 398 * MiB;
constexpr size_t RB_YCAT = 0, RB_KVRAW = 102 * MiB, RB_MERGED = 102 * MiB, RB_QRAW = 170 * MiB, RB_KG = 221 * MiB, RB_VG = 272 * MiB, RB_QFL = 306 * MiB, RB_QFC = 354 * MiB,
                 RB_QDF = 357 * MiB, RB_KDT = 391 * MiB, RB_VTG = 425 * MiB, RB_DECAY = 459 * MiB, RB_OINTRA = 461 * MiB, RB_OF = 495 * MiB, RB_OB = 529 * MiB, RB_END = 563 * MiB;
constexpr size_t RB_WGU = 0, RB_WD = 128 * MiB;
constexpr size_t WS_END = WS_RB + RB_END;
constexpr int LDS_BYTES = 147456;
constexpr int LDS_MISC = 145408;
}
using namespace cfg;

enum { I_X = 0, I_C, I_CTX, I_CCTX, I_WMOD, I_BMOD, I_GMIX, I_GFFN, I_WIN, I_BGATE, I_WS, I_BS, I_WDEC, I_BDEC, I_GGLA, I_GCQ, I_GCKV, I_WUQ, I_WUKV,
       I_GQN, I_GQR, I_GKN, I_GKR, I_WPA, I_WPB, I_WPC, I_WOUT, I_WROUTER, I_WEG, I_WEU, I_WED, N_INPUTS };

struct Args { const float* in[N_INPUTS]; float* out; unsigned char* ws; int ph_lo, ph_hi; };

struct Ctx {
    const float* const* in; float* out; unsigned char* ws; LAS unsigned char* lds;
    int tid, lane, wave, G, bid;
};
__device__ __forceinline__ int row_modidx(int row) { return row < TL ? (row >> 12) : 4; }
__device__ __forceinline__ const float* modp(const Ctx& c, int l, int bi, int which) { return (const float*)(c.ws + WS_MOD) + ((size_t)(l * 5 + bi) * 6 + which) * D; }
__device__ __forceinline__ const float* xin_row(const Ctx& c, int l, int row) {
    if (row < TL) return (l == 0 ? c.in[I_X] : (const float*)c.out) + (size_t)row * D;
    return (l == 0 ? c.in[I_CTX] : (const float*)(c.ws + WS_XC)) + (size_t)(row - TL) * D;
}
__device__ __forceinline__ float* xout_row(const Ctx& c, int row) {
    if (row < TL) return c.out + (size_t)row * D;
    return (float*)(c.ws + WS_XC) + (size_t)(row - TL) * D;
}

#if defined(DEBUG_STAT)
__device__ __forceinline__ void dbg_max(const Ctx& c, int slot, float v) { v = fabsf(v); if (!(v < 1e30f)) v = 1e30f; atomicMax((unsigned*)(c.ws + WS_CTL + 512 * 1024) + 16 * slot, __float_as_uint(v)); }
#else
__device__ __forceinline__ void dbg_max(const Ctx&, int, float) {}
#endif
__device__ __forceinline__ void tconv_tile(const Ctx& c, const float* src, int ld_src, int k0, int c0, int nvalid, const float* kscale, bf16_t* dst, int ld_dst, int r0, int kd0) {
    LAS float* scr = (LAS float*)c.lds;
    const int tid = c.tid;
#pragma unroll
    for (int p = 0; p < 8; ++p) { const int k = p * 8 + (tid >> 6), n = tid & 63;
        float v = (n < nvalid) ? src[(size_t)(k0 + k) * ld_src + c0 + n] : 0.f; if (kscale) v *= kscale[k0 + k];
        scr[n * 65 + k] = v; }
    __syncthreads();
    { const int n = tid >> 3, kc = (tid & 7) * 8; const LAS float* s = scr + n * 65 + kc;
      u32x4 o; o.x = cvt_pk_bf16(s[0], s[1]); o.y = cvt_pk_bf16(s[2], s[3]); o.z = cvt_pk_bf16(s[4], s[5]); o.w = cvt_pk_bf16(s[6], s[7]);
      *(u32x4*)(dst + (size_t)(r0 + n) * ld_dst + kd0 + kc) = o; }
    __syncthreads();
}
template <class RowMap>
__device__ __forceinline__ void tconv_tile4(const Ctx& c, const float* src, int ld_src, int k0, int n0, bf16_t* dst, int ld_dst, int kd0, const RowMap& rowmap) {
    LAS float* scr = (LAS float*)c.lds;
    const int tid = c.tid; float v[4][8];
#pragma unroll
    for (int q = 0; q < 4; ++q)
#pragma unroll
        for (int p = 0; p < 8; ++p) { const int k = p * 8 + (tid >> 6), n = tid & 63; v[q][p] = src[(size_t)(k0 + k) * ld_src + n0 + q * 64 + n]; }
#pragma unroll
    for (int q = 0; q < 4; ++q)
#pragma unroll
        for (int p = 0; p < 8; ++p) { const int k = p * 8 + (tid >> 6), n = tid & 63; scr[(q * 64 + n) * 65 + k] = v[q][p]; }
    __syncthreads();
#pragma unroll
    for (int q = 0; q < 4; ++q) { const int n = tid >> 3, kc = (tid & 7) * 8; const LAS float* s = scr + (q * 64 + n) * 65 + kc;
      u32x4 o; o.x = cvt_pk_bf16(s[0], s[1]); o.y = cvt_pk_bf16(s[2], s[3]); o.z = cvt_pk_bf16(s[4], s[5]); o.w = cvt_pk_bf16(s[6], s[7]);
      *(u32x4*)(dst + (size_t)rowmap(n0 + q * 64 + n) * ld_dst + kd0 + kc) = o; }
    __syncthreads();
}
__device__ __forceinline__ void win_map(int r0, int& src, int& nvalid) {
    nvalid = 64;
    if (r0 < 5120) src = r0; else if (r0 < 5504) src = 5152 + (r0 - 5120); else if (r0 == 5504) src = 5792;
    else if (r0 == 5568) { src = 5120; nvalid = 32; } else if (r0 < 5888) src = 5536 + (r0 - 5632); else src = 5856 + (r0 - 5888);
}
__device__ __forceinline__ void phase_pre_a(const Ctx& c) {
    constexpr int U_IN = 140 * 16, U_UQ = 6 * 24, U_UKV = 4 * 32, U_M = 3 * 256, U_OUT = 256, U_S = 32, U_LAYER = U_IN + U_UQ + U_UKV + U_M + U_OUT + U_S, U_MOD = 192;
    for (int u = c.bid; u < 2 * U_LAYER + U_MOD; u += c.G) {
        if (u >= 2 * U_LAYER) {
            const int cb = u - 2 * U_LAYER, l = cb / 96, n = (cb % 96) * 64 + c.lane;
            const float* wm = c.in[I_WMOD] + (size_t)l * D * 6144; float a[5] = {0.f, 0.f, 0.f, 0.f, 0.f};
            for (int kk = 0; kk < 128; ++kk) { const int k = c.wave * 128 + kk; const float w = wm[(size_t)k * 6144 + n];
#pragma unroll
                for (int i = 0; i < 5; ++i) { const float cv = (i < 4) ? c.in[I_C][i * D + k] : c.in[I_CCTX][k]; a[i] += siluf_(cv) * w; } }
            LAS float* red = (LAS float*)c.lds;
#pragma unroll
            for (int i = 0; i < 5; ++i) red[(c.wave * 5 + i) * 64 + c.lane] = a[i];
            __syncthreads();
            if (c.tid < 320) { const int i = c.tid >> 6, ln = c.tid & 63; float s = 0.f;
#pragma unroll
                for (int w = 0; w < 8; ++w) s += red[(w * 5 + i) * 64 + ln];
                const int nn = (cb % 96) * 64 + ln;
                ((float*)(c.ws + WS_MOD))[(size_t)(l * 5 + i) * 6144 + nn] = s + c.in[I_BMOD][l * 6144 + nn]; }
            __syncthreads();
            continue;
        }
        const int l = u / U_LAYER; int r = u % U_LAYER; unsigned char* wt = c.ws + WS_WT + (size_t)l * WT_LAYER;
        if (r < U_IN) { const int nb = r / 16, kb = r % 16; int src, nv; win_map(nb * 64, src, nv);
            tconv_tile(c, c.in[I_WIN] + (size_t)l * D * 8928, 8928, kb * 64, src, nv, nullptr, (bf16_t*)(wt + WT_IN), D, nb * 64, kb * 64); continue; } r -= U_IN;
        if (r < U_UQ) { const int nb = r / 6, kb = r % 6;
            tconv_tile(c, c.in[I_WUQ] + (size_t)l * 384 * 1536, 1536, kb * 64, nb * 64, 64, c.in[I_GCQ] + l * 384, (bf16_t*)(wt + WT_UQ), 384, nb * 64, kb * 64); continue; } r -= U_UQ;
        if (r < U_UKV) { const int nb = r / 4, kb = r % 4;
            tconv_tile(c, c.in[I_WUKV] + (size_t)l * 256 * 2048, 2048, kb * 64, nb * 64, 64, c.in[I_GCKV] + l * 256, (bf16_t*)(wt + WT_UKV), 256, nb * 64, kb * 64); continue; } r -= U_UKV;
        if (r < U_M) { const int which = r / 256, rr = r % 256, nb = rr / 16, kb = rr % 16;
            const float* src = c.in[which == 0 ? I_WPA : (which == 1 ? I_WPB : I_WPC)] + (size_t)l * D * D;
            tconv_tile(c, src, D, kb * 64, nb * 64, 64, nullptr, (bf16_t*)(wt + WT_M), 3 * D, nb * 64, which * D + kb * 64); continue; } r -= U_M;
        if (r < U_OUT) { const int nb = r / 16, kb = r % 16;
            tconv_tile(c, c.in[I_WOUT] + (size_t)l * D * D, D, kb * 64, nb * 64, 64, nullptr, (bf16_t*)(wt + WT_OUT), D, nb * 64, kb * 64); continue; } r -= U_OUT;
        { const float* s = c.in[I_WS] + (size_t)l * 131072 + (size_t)r * 4096 + c.tid * 8; bf16_t* d = (bf16_t*)(wt + WT_S) + (size_t)r * 4096 + c.tid * 8;
          const f32x4 a = *(const f32x4*)s, b = *(const f32x4*)(s + 4); u32x4 o; o.x = cvt_pk_bf16(a[0], a[1]); o.y = cvt_pk_bf16(a[2], a[3]); o.z = cvt_pk_bf16(b[0], b[1]); o.w = cvt_pk_bf16(b[2], b[3]);
          *(u32x4*)d = o; }
    }
}
__device__ __forceinline__ void modulate_row(const float* xrow, const float* g, const float* shift, const float* scale, bf16_t* hrow, int lane, f32x4 (&hv)[4]) {
    float ss = 0.f;
#pragma unroll
    for (int j = 0; j < 4; ++j) { hv[j] = *(const f32x4*)(xrow + 4 * lane + 256 * j); ss += (hv[j][0] * hv[j][0] + hv[j][1] * hv[j][1]) + (hv[j][2] * hv[j][2] + hv[j][3] * hv[j][3]); }
    const float rstd = 1.0f / sqrtf(wave_sum(ss) * (1.f / D) + EPS);
#pragma unroll
    for (int j = 0; j < 4; ++j) { const int cc = 4 * lane + 256 * j; const f32x4 gv = *(const f32x4*)(g + cc), sc = *(const f32x4*)(scale + cc), sh = *(const f32x4*)(shift + cc);
        hv[j] = hv[j] * rstd * gv * (sc + 1.0f) + sh;
        u32x2 o; o.x = cvt_pk_bf16(hv[j][0], hv[j][1]); o.y = cvt_pk_bf16(hv[j][2], hv[j][3]); *(u32x2*)(hrow + cc) = o; }
}
__device__ __forceinline__ void phase_modulate_mix(const Ctx& c, int l) {
    const int gw = c.bid * NWAVES + c.wave, NGW = c.G * NWAVES;
    for (int row = gw; row < T; row += NGW) { const int bi = row_modidx(row); f32x4 hv[4];
        modulate_row(xin_row(c, l, row), c.in[I_GMIX] + l * D, modp(c, l, bi, 0), modp(c, l, bi, 1), (bf16_t*)(c.ws + WS_H) + (size_t)row * D, c.lane, hv); }
}
struct EpiZ { static constexpr bool PERM = true, MID = false; bf16_t* Z; const float* bgate;
    __device__ __forceinline__ void operator()(const f32x4 (&acc)[2][2][4][2], const pg8::Unit& u, int wr, int wc, int fr, int fq) const {
        int row0 = u.pm * 256 + wr * 64 + fr; asm volatile("" : "+v"(row0)); const int col0 = u.pn * 256 + wc * 32 + 8 * fq;
        const int mode = (u.pn >= 23) ? 3 : ((u.pn >= 16 && u.pn < 20) ? 2 : ((u.pn == 8 || u.pn == 9) ? 1 : 0));
        const int gcol = (mode == 3) ? (col0 - ZGT) : 0; const float bm = (mode == 3) ? 1.f : 0.f;
        f32x4 bv[2][2];
#pragma unroll
        for (int bj = 0; bj < 2; ++bj)
#pragma unroll
            for (int n = 0; n < 2; ++n) bv[bj][n] = *(const f32x4*)(bgate + (gcol + bj * 128 + 4 * n)) * bm;
#pragma unroll
        for (int ai = 0; ai < 2; ++ai)
#pragma unroll
            for (int m = 0; m < 4; ++m) { bf16_t* rowp = Z + (size_t)(row0 + ai * 128 + m * 16) * NZ + col0;
#pragma unroll
                for (int bj = 0; bj < 2; ++bj) { f32x4 v0 = acc[ai][bj][m][0] + bv[bj][0], v1 = acc[ai][bj][m][1] + bv[bj][1];
                    if (mode == 1) { v0 = v0 * 0.08838834764831845f; v1 = v1 * 0.08838834764831845f; }
                    else if (mode == 2) {
#pragma unroll
                        for (int e = 0; e < 4; ++e) { v0[e] = siluf_(v0[e]); v1[e] = siluf_(v1[e]); } }
                    else if (mode == 3) {
#pragma unroll
                        for (int e = 0; e < 4; ++e) { v0[e] = fmaxf(sigmoidf_(v0[e]), 1e-20f); v1[e] = fmaxf(sigmoidf_(v1[e]), 1e-20f); } }
                    u32x4 w; w.x = cvt_pk_bf16(v0[0], v0[1]); w.y = cvt_pk_bf16(v0[2], v0[3]); w.z = cvt_pk_bf16(v1[0], v1[1]); w.w = cvt_pk_bf16(v1[2], v1[3]);
                    *(u32x4*)(rowp + bj * 128) = w; } }
    }
};
struct EpiPlain { static constexpr bool PERM = true, MID = false; bf16_t* O; int ldc;
    __device__ __forceinline__ void operator()(const f32x4 (&acc)[2][2][4][2], const pg8::Unit& u, int wr, int wc, int fr, int fq) const {
        int row0 = u.pm * 256 + wr * 64 + fr; asm volatile("" : "+v"(row0)); const int col0 = u.pn * 256 + wc * 32 + 8 * fq;
#pragma unroll
        for (int ai = 0; ai < 2; ++ai)
#pragma unroll
            for (int m = 0; m < 4; ++m) { bf16_t* rowp = O + (size_t)(row0 + ai * 128 + m * 16) * ldc + col0;
#pragma unroll
                for (int bj = 0; bj < 2; ++bj) { const f32x4 v0 = acc[ai][bj][m][0], v1 = acc[ai][bj][m][1];
                    u32x4 w; w.x = cvt_pk_bf16(v0[0], v0[1]); w.y = cvt_pk_bf16(v0[2], v0[3]); w.z = cvt_pk_bf16(v1[0], v1[1]); w.w = cvt_pk_bf16(v1[2], v1[3]);
                    *(u32x4*)(rowp + bj * 128) = w; } }
    }
};
struct EpiMerge { static constexpr bool PERM = true, MID = true; bf16_t* O; const bf16_t* Z;
    __device__ __forceinline__ void ld8(const bf16_t* p, float (&g)[8]) const { const u32x4 w = *(const u32x4*)p; g[0] = bflo(w.x); g[1] = bfhi(w.x); g[2] = bflo(w.y); g[3] = bfhi(w.y); g[4] = bflo(w.z); g[5] = bfhi(w.z); g[6] = bflo(w.w); g[7] = bfhi(w.w); }
    __device__ __forceinline__ void mid(f32x4 (&acc)[2][2][4][2], const pg8::Unit& u, int t, int wr, int wc, int fr, int fq) const {
        int row0 = u.pm * 256 + wr * 64 + fr; asm volatile("" : "+v"(row0)); const int col0 = u.pn * 256 + wc * 32 + 8 * fq; const int seg = (t == 16) ? 0 : 1;
#pragma unroll
        for (int ai = 0; ai < 2; ++ai)
#pragma unroll
            for (int m = 0; m < 4; ++m) { const bf16_t* gp = Z + (size_t)(row0 + ai * 128 + m * 16) * NZ + ZGT + seg * D + col0;
#pragma unroll
                for (int bj = 0; bj < 2; ++bj) { float ga[8], gb[8]; ld8(gp + bj * 128, ga); ld8(gp + D + bj * 128, gb);
#pragma unroll
                    for (int e = 0; e < 4; ++e) { acc[ai][bj][m][0][e] *= ga[e] * fast_rcp(gb[e]); acc[ai][bj][m][1][e] *= ga[4 + e] * fast_rcp(gb[4 + e]); } }
                __builtin_amdgcn_sched_barrier(0); }
    }
    __device__ __forceinline__ void operator()(const f32x4 (&acc)[2][2][4][2], const pg8::Unit& u, int wr, int wc, int fr, int fq) const {
        int row0 = u.pm * 256 + wr * 64 + fr; asm volatile("" : "+v"(row0)); const int col0 = u.pn * 256 + wc * 32 + 8 * fq;
#pragma unroll
        for (int ai = 0; ai < 2; ++ai)
#pragma unroll
            for (int m = 0; m < 4; ++m) { const size_t r = (size_t)(row0 + ai * 128 + m * 16); const bf16_t* gp = Z + r * NZ + ZGT + 2 * D + col0; bf16_t* rowp = O + r * D + col0;
#pragma unroll
                for (int bj = 0; bj < 2; ++bj) { float gc[8]; ld8(gp + bj * 128, gc); const f32x4 v0 = acc[ai][bj][m][0], v1 = acc[ai][bj][m][1];
                    u32x4 w; w.x = cvt_pk_bf16(v0[0] * gc[0], v0[1] * gc[1]); w.y = cvt_pk_bf16(v0[2] * gc[2], v0[3] * gc[3]); w.z = cvt_pk_bf16(v1[0] * gc[4], v1[1] * gc[5]); w.w = cvt_pk_bf16(v1[2] * gc[6], v1[3] * gc[7]);
                    *(u32x4*)(rowp + bj * 128) = w; }
                __builtin_amdgcn_sched_barrier(0); }
    }
};
struct EpiResid { static constexpr bool PERM = false, MID = false; const Ctx* c; int l; float* dummy;
    __device__ __forceinline__ void operator()(const f32x4 (&acc)[2][2][4][2], const pg8::Unit& u, int wr, int wc, int fr, int fq) const {
        int row0 = u.pm * 256 + wr * 64 + fr; asm volatile("" : "+v"(row0)); const int col0 = u.pn * 256 + wc * 32 + 4 * fq; const float* gate = modp(*c, l, row_modidx(u.pm * 256), 2);
        f32x4 gv[2][2];
#pragma unroll
        for (int bj = 0; bj < 2; ++bj)
#pragma unroll
            for (int n = 0; n < 2; ++n) gv[bj][n] = *(const f32x4*)(gate + col0 + bj * 128 + 16 * n);
#pragma unroll
        for (int ai = 0; ai < 2; ++ai)
#pragma unroll
            for (int m = 0; m < 4; ++m) { const int row = row0 + ai * 128 + m * 16; const float* xi = xin_row(*c, l, row) + col0; float* xo = (dummy ? dummy + (size_t)row * D : xout_row(*c, row)) + col0;
#pragma unroll
                for (int bj = 0; bj < 2; ++bj)
#pragma unroll
                    for (int n = 0; n < 2; ++n) { const f32x4 xv = *(const f32x4*)(xi + bj * 128 + 16 * n); *(f32x4*)(xo + bj * 128 + 16 * n) = xv + gv[bj][n] * acc[ai][bj][m][n]; } }
    }
};
struct EpiSwiGLU { static constexpr bool PERM = true, MID = false; bf16_t* HID;
    __device__ __forceinline__ void operator()(const f32x4 (&acc)[2][2][4][2], const pg8::Unit& u, int wr, int wc, int fr, int fq) const {
        int row0 = u.pm * 256 + wr * 64 + fr; asm volatile("" : "+v"(row0)); const int col0 = u.pn * 128 + wc * 32 + 8 * fq; bf16_t* base = HID + (size_t)u.g * ESLOTS * DEXP;
#pragma unroll
        for (int ai = 0; ai < 2; ++ai)
#pragma unroll
            for (int m = 0; m < 4; ++m) { float h[8];
#pragma unroll
                for (int n = 0; n < 2; ++n)
#pragma unroll
                    for (int e = 0; e < 4; ++e) h[4 * n + e] = siluf_(acc[ai][0][m][n][e]) * acc[ai][1][m][n][e];
                u32x4 w; w.x = cvt_pk_bf16(h[0], h[1]); w.y = cvt_pk_bf16(h[2], h[3]); w.z = cvt_pk_bf16(h[4], h[5]); w.w = cvt_pk_bf16(h[6], h[7]);
                *(u32x4*)(base + (size_t)(row0 + ai * 128 + m * 16) * DEXP + col0) = w; }
    }
};
struct EpiDown { static constexpr bool PERM = true, MID = false; bf16_t* YS; const float* gatev;
    __device__ __forceinline__ void operator()(const f32x4 (&acc)[2][2][4][2], const pg8::Unit& u, int wr, int wc, int fr, int fq) const {
        int row0 = u.pm * 256 + wr * 64 + fr; asm volatile("" : "+v"(row0)); const int col0 = u.pn * 256 + wc * 32 + 8 * fq; bf16_t* base = YS + (size_t)u.g * ESLOTS * D; const float* gp = gatev + u.g * ESLOTS;
#pragma unroll
        for (int ai = 0; ai < 2; ++ai)
#pragma unroll
            for (int m = 0; m < 4; ++m) { const int row = row0 + ai * 128 + m * 16; const float gs = gp[row]; bf16_t* rowp = base + (size_t)row * D + col0;
#pragma unroll
                for (int bj = 0; bj < 2; ++bj) { const f32x4 v0 = acc[ai][bj][m][0] * gs, v1 = acc[ai][bj][m][1] * gs;
                    u32x4 w; w.x = cvt_pk_bf16(v0[0], v0[1]); w.y = cvt_pk_bf16(v0[2], v0[3]); w.z = cvt_pk_bf16(v1[0], v1[1]); w.w = cvt_pk_bf16(v1[2], v1[3]);
                    *(u32x4*)(rowp + bj * 128) = w; } }
    }
};

__device__ __forceinline__ void sg_accum(const bf16_t* A, int lda, const bf16_t* Bt, int ldb, int K, int lane, f32x4 (&acc)[2]) {
    const int lr = lane & 15, lq = lane >> 4; const bf16_t* ap = A + (size_t)lr * lda + 8 * lq; const bf16_t* bp0 = Bt + (size_t)lr * ldb + 8 * lq; const bf16_t* bp1 = bp0 + (size_t)16 * ldb;
    bf16x8 a[2][4], b0[2][4], b1[2][4];
#pragma unroll
    for (int i = 0; i < 4; ++i) { a[0][i] = *(const bf16x8*)(ap + 32 * i); b0[0][i] = *(const bf16x8*)(bp0 + 32 * i); b1[0][i] = *(const bf16x8*)(bp1 + 32 * i); }
#pragma unroll 1
    for (int k = 0; k < K; k += 256) {
#pragma unroll
        for (int i = 0; i < 4; ++i) { a[1][i] = *(const bf16x8*)(ap + k + 128 + 32 * i); b0[1][i] = *(const bf16x8*)(bp0 + k + 128 + 32 * i); b1[1][i] = *(const bf16x8*)(bp1 + k + 128 + 32 * i); }
#pragma unroll
        for (int i = 0; i < 4; ++i) { acc[0] = __builtin_amdgcn_mfma_f32_16x16x32_bf16(a[0][i], b0[0][i], acc[0], 0, 0, 0); acc[1] = __builtin_amdgcn_mfma_f32_16x16x32_bf16(a[0][i], b1[0][i], acc[1], 0, 0, 0); }
        if (k + 256 < K) {
#pragma unroll
            for (int i = 0; i < 4; ++i) { a[0][i] = *(const bf16x8*)(ap + k + 256 + 32 * i); b0[0][i] = *(const bf16x8*)(bp0 + k + 256 + 32 * i); b1[0][i] = *(const bf16x8*)(bp1 + k + 256 + 32 * i); } }
#pragma unroll
        for (int i = 0; i < 4; ++i) { acc[0] = __builtin_amdgcn_mfma_f32_16x16x32_bf16(a[1][i], b0[1][i], acc[0], 0, 0, 0); acc[1] = __builtin_amdgcn_mfma_f32_16x16x32_bf16(a[1][i], b1[1][i], acc[1], 0, 0, 0); }
    }
}
__device__ __forceinline__ void ctx_merge_unit(const Ctx& c, int l, int u) {
    const int lane = c.lane, w = c.wave, lr = lane & 15, lq = lane >> 4; const int row0 = TL + 64 * (u >> 4) + 16 * (w >> 1), col0 = 64 * (u & 15) + 32 * (w & 1);
    const bf16_t* Y = (const bf16_t*)(c.ws + WS_RB + RB_YCAT) + (size_t)row0 * 3072; const bf16_t* WM = (const bf16_t*)(c.ws + WS_WT + (size_t)l * WT_LAYER + WT_M) + (size_t)col0 * 3072;
    const bf16_t* Zg = (const bf16_t*)(c.ws + WS_RA) + ZGT; bf16_t* O = (bf16_t*)(c.ws + WS_RB + RB_MERGED);
    f32x4 out[2] = {{0.f, 0.f, 0.f, 0.f}, {0.f, 0.f, 0.f, 0.f}};
#pragma unroll 1
    for (int seg = 0; seg < 3; ++seg) { f32x4 acc[2] = {{0.f, 0.f, 0.f, 0.f}, {0.f, 0.f, 0.f, 0.f}};
        sg_accum(Y + seg * D, 3072, WM + seg * D, 3072, D, lane, acc);
#pragma unroll
        for (int t = 0; t < 2; ++t)
#pragma unroll
            for (int e = 0; e < 4; ++e) out[t][e] += acc[t][e] * bf2f(Zg[(size_t)(row0 + 4 * lq + e) * NZ + seg * D + col0 + 16 * t + lr]); }
#pragma unroll
    for (int t = 0; t < 2; ++t)
#pragma unroll
        for (int e = 0; e < 4; ++e) O[(size_t)(row0 + 4 * lq + e) * D + col0 + 16 * t + lr] = f2bf(out[t][e]);
}
__device__ __forceinline__ void ctx_out_unit(const Ctx& c, int l, int u) {
    const int lane = c.lane, w = c.wave, lr = lane & 15, lq = lane >> 4; const int row0 = TL + 64 * (u >> 4) + 16 * (w >> 1), col0 = 64 * (u & 15) + 32 * (w & 1);
    const bf16_t* A = (const bf16_t*)(c.ws + WS_RB + RB_MERGED) + (size_t)row0 * D; const bf16_t* WO = (const bf16_t*)(c.ws + WS_WT + (size_t)l * WT_LAYER + WT_OUT) + (size_t)col0 * D;
    f32x4 acc[2] = {{0.f, 0.f, 0.f, 0.f}, {0.f, 0.f, 0.f, 0.f}};
    sg_accum(A, D, WO, D, D, lane, acc);
    const float* gate = modp(c, l, 4, 2);
#pragma unroll
    for (int t = 0; t < 2; ++t)
#pragma unroll
        for (int e = 0; e < 4; ++e) { const int row = row0 + 4 * lq + e, col = col0 + 16 * t + lr; xout_row(c, row)[col] = xin_row(c, l, row)[col] + gate[col] * acc[t][e]; }
}
__device__ __forceinline__ void mixA_unit(const Ctx& c, int l, int un) {
    const int cn = un >> 3, g = un & 7; const int row0 = cn * 128;
    const bf16_t* Z = (const bf16_t*)(c.ws + WS_RA); bf16_t* Y = (bf16_t*)(c.ws + WS_RB + RB_YCAT);
    const bf16_t* WSb = (const bf16_t*)(c.ws + WS_WT + (size_t)l * WT_LAYER + WT_S) + g * 16384;
    LAS bf16_t* VT = (LAS bf16_t*)c.lds;
    { const int s = c.tid >> 2, qd = c.tid & 3; const bf16_t* p = Z + (size_t)(row0 + s) * NZ + ZVA + g * 128 + qd * 32;
      float v[32];
#pragma unroll
      for (int i = 0; i < 4; ++i) { const u32x4 w = *(const u32x4*)(p + 8 * i); v[8 * i] = bflo(w.x); v[8 * i + 1] = bfhi(w.x); v[8 * i + 2] = bflo(w.y); v[8 * i + 3] = bfhi(w.y); v[8 * i + 4] = bflo(w.z); v[8 * i + 5] = bfhi(w.z); v[8 * i + 6] = bflo(w.w); v[8 * i + 7] = bfhi(w.w); }
      float sm = 0.f;
#pragma unroll
      for (int i = 0; i < 32; ++i) sm += v[i];
      sm += __shfl_xor(sm, 1); sm += __shfl_xor(sm, 2); const float mu = sm * (1.f / 128.f); float sq = 0.f;
#pragma unroll
      for (int i = 0; i < 32; ++i) { v[i] -= mu; sq += v[i] * v[i]; }
      sq += __shfl_xor(sq, 1); sq += __shfl_xor(sq, 2); const float rstd = 1.0f / sqrtf(sq * (1.f / 128.f) + EPS);
#pragma unroll
      for (int i = 0; i < 32; ++i) VT[(qd * 32 + i) * 136 + s] = f2bf(v[i] * rstd); }
    __syncthreads();
    const int w = c.wave, lr = c.lane & 15, lq = c.lane >> 4;
    bf16x8 bw[4];
#pragma unroll
    for (int ks = 0; ks < 4; ++ks) bw[ks] = *(const bf16x8*)(WSb + (16 * w + lr) * 128 + 32 * ks + 8 * lq);
    const int t = row0 + 16 * w + lr; const float bs = c.in[I_BS][(l * 8 + g) * 128 + 16 * w + lr];
#pragma unroll
    for (int ct = 0; ct < 8; ++ct) { f32x4 acc = {0.f, 0.f, 0.f, 0.f};
#pragma unroll
        for (int ks = 0; ks < 4; ++ks) { const bf16x8 a = *(const LAS bf16x8*)(VT + (16 * ct + lr) * 136 + 32 * ks + 8 * lq); acc = __builtin_amdgcn_mfma_f32_16x16x32_bf16(a, bw[ks], acc, 0, 0, 0); }
        const int cc = g * 128 + 16 * ct + 4 * lq; const u32x2 uw = *(const u32x2*)(Z + (size_t)t * NZ + ZU + cc);
        u32x2 o; o.x = cvt_pk_bf16(bflo(uw.x) * (acc[0] + bs), bfhi(uw.x) * (acc[1] + bs)); o.y = cvt_pk_bf16(bflo(uw.y) * (acc[2] + bs), bfhi(uw.y) * (acc[3] + bs));
        *(u32x2*)(Y + (size_t)t * 3072 + cc) = o; }
    __syncthreads();
}
__device__ __forceinline__ void gla_b1_unit(const Ctx& c, int l, int un) {
    const int n = un >> 2, h = un & 3, row0 = n * 64, tid = c.tid, lane = c.lane, w = c.wave, lr = lane & 15, lq = lane >> 4;
    const bf16_t* Z = (const bf16_t*)(c.ws + WS_RA);
    LAS bf16_t* VTs = (LAS bf16_t*)c.lds;
    LAS float* Ds = (LAS float*)(c.lds + 36864);
    LAS float* La = (LAS float*)(c.lds + 45056);
    LAS float* Tot = (LAS float*)(c.lds + 78080);
    LAS bf16_t* QD = (LAS bf16_t*)(c.lds + 80128);
    LAS bf16_t* KI = (LAS bf16_t*)(c.lds + 97536);
    LAS bf16_t* Ps = (LAS bf16_t*)(c.lds + 114944);
    LAS bf16_t* KdT = (LAS bf16_t*)(c.lds + 124160);
    { const int t = tid >> 3, cb = (tid & 7) * 32; const bf16_t* p = Z + (size_t)(row0 + t) * NZ + ZVB + h * 256 + cb;
#pragma unroll
      for (int i = 0; i < 4; ++i) { const u32x4 wv = *(const u32x4*)(p + 8 * i); LAS bf16_t* d = VTs + (cb + 8 * i) * 72 + t;
        d[0] = (bf16_t)wv.x; d[72] = (bf16_t)(wv.x >> 16); d[144] = (bf16_t)wv.y; d[216] = (bf16_t)(wv.y >> 16); d[288] = (bf16_t)wv.z; d[360] = (bf16_t)(wv.z >> 16); d[432] = (bf16_t)wv.w; d[504] = (bf16_t)(wv.w >> 16); }
      const int dt = tid >> 3, dc = (tid & 7) * 4; const u32x2 dv = *(const u32x2*)(Z + (size_t)(row0 + dt) * NZ + ZDEC + dc);
      Ds[dt * 32 + dc] = bflo(dv.x); Ds[dt * 32 + dc + 1] = bfhi(dv.x); Ds[dt * 32 + dc + 2] = bflo(dv.y); Ds[dt * 32 + dc + 3] = bfhi(dv.y); }
    __syncthreads();
    f32x4 pacc[2] = {{0.f, 0.f, 0.f, 0.f}, {0.f, 0.f, 0.f, 0.f}};
#pragma unroll 1
    for (int dir = 0; dir < 2; ++dir) {
        { const int cch = 16 * w + lr;
          bf16x8 bfr = {0, 0, 0, 0, 0, 0, 0, 0};
          if (lq < 2) { const float* wd = c.in[I_WDEC] + (size_t)(l * 2 + dir) * 16 * 512 + (size_t)(8 * lq) * 512 + h * 128 + cch; u32x4 pk;
              pk.x = cvt_pk_bf16(wd[0], wd[512]); pk.y = cvt_pk_bf16(wd[1024], wd[1536]); pk.z = cvt_pk_bf16(wd[2048], wd[2560]); pk.w = cvt_pk_bf16(wd[3072], wd[3584]); bfr = __builtin_bit_cast(bf16x8, pk); }
          const float bias = c.in[I_BDEC][(l * 2 + dir) * 512 + h * 128 + cch];
          f32x4 la[4];
#pragma unroll
          for (int tt = 0; tt < 4; ++tt) { bf16x8 afr = {0, 0, 0, 0, 0, 0, 0, 0};
              if (lq < 2) afr = *(const bf16x8*)(Z + (size_t)(row0 + 16 * tt + lr) * NZ + ZDEC + dir * 16 + 8 * lq);
              la[tt] = __builtin_amdgcn_mfma_f32_16x16x32_bf16(afr, bfr, (f32x4){0.f, 0.f, 0.f, 0.f}, 0, 0, 0); }
#pragma unroll
          for (int tt = 0; tt < 4; ++tt)
#pragma unroll
              for (int e = 0; e < 4; ++e) { const float pre = la[tt][e] + bias; la[tt][e] = (fminf(pre, 0.f) - __logf(1.f + __expf(-fabsf(pre)))) * 0.0625f; }
          float carry = 0.f;
          if (dir == 0) {
#pragma unroll
              for (int tt = 0; tt < 4; ++tt) { la[tt][1] += la[tt][0]; la[tt][2] += la[tt][1]; la[tt][3] += la[tt][2];
                  const float tot = la[tt][3]; float pre = 0.f; const float s16 = __shfl_up(tot, 16), s32 = __shfl_up(tot, 32), s48 = __shfl_up(tot, 48);
                  if (lq >= 1) pre += s16; if (lq >= 2) pre += s32; if (lq >= 3) pre += s48;
                  const float add = carry + pre;
#pragma unroll
                  for (int e = 0; e < 4; ++e) la[tt][e] += add;
                  carry = __shfl(la[tt][3], 48 + lr); }
          } else {
#pragma unroll
              for (int tt = 3; tt >= 0; --tt) { la[tt][2] += la[tt][3]; la[tt][1] += la[tt][2]; la[tt][0] += la[tt][1];
                  const float tot = la[tt][0]; float pre = 0.f; const float s16 = __shfl_down(tot, 16), s32 = __shfl_down(tot, 32), s48 = __shfl_down(tot, 48);
                  if (lq <= 2) pre += s16; if (lq <= 1) pre += s32; if (lq <= 0) pre += s48;
                  const float add = carry + pre;
#pragma unroll
                  for (int e = 0; e < 4; ++e) la[tt][e] += add;
                  carry = __shfl(la[tt][0], lr); }
          }
#pragma unroll
          for (int tt = 0; tt < 4; ++tt)
#pragma unroll
              for (int e = 0; e < 4; ++e) La[(16 * tt + 4 * lq + e) * 129 + cch] = la[tt][e]; }
        __syncthreads();
        { const int t = tid >> 3, cb = (tid & 7) * 16; const bf16_t* qp = Z + (size_t)(row0 + t) * NZ + ZQB + h * 128 + cb; const bf16_t* kp = Z + (size_t)(row0 + t) * NZ + ZKB + h * 128 + cb;
          float q[16], k[16];
#pragma unroll
          for (int i = 0; i < 2; ++i) { const u32x4 a = *(const u32x4*)(qp + 8 * i), b = *(const u32x4*)(kp + 8 * i);
              q[8 * i] = bflo(a.x); q[8 * i + 1] = bfhi(a.x); q[8 * i + 2] = bflo(a.y); q[8 * i + 3] = bfhi(a.y); q[8 * i + 4] = bflo(a.z); q[8 * i + 5] = bfhi(a.z); q[8 * i + 6] = bflo(a.w); q[8 * i + 7] = bfhi(a.w);
              k[8 * i] = bflo(b.x); k[8 * i + 1] = bfhi(b.x); k[8 * i + 2] = bflo(b.y); k[8 * i + 3] = bfhi(b.y); k[8 * i + 4] = bflo(b.z); k[8 * i + 5] = bfhi(b.z); k[8 * i + 6] = bflo(b.w); k[8 * i + 7] = bfhi(b.w); }
          const int tl = (dir == 0) ? 63 : 0; float qd[16], ki[16];
#pragma unroll
          for (int i = 0; i < 16; ++i) { const float b = La[t * 129 + cb + i], bl = La[tl * 129 + cb + i]; const float e = __expf(b);
              qd[i] = q[i] * e; ki[i] = k[i] * fast_rcp(e); KdT[(cb + i) * 72 + t] = f2bf(k[i] * __expf(bl - b)); }
          u32x4 o0, o1;
          o0.x = cvt_pk_bf16(qd[0], qd[1]); o0.y = cvt_pk_bf16(qd[2], qd[3]); o0.z = cvt_pk_bf16(qd[4], qd[5]); o0.w = cvt_pk_bf16(qd[6], qd[7]);
          o1.x = cvt_pk_bf16(qd[8], qd[9]); o1.y = cvt_pk_bf16(qd[10], qd[11]); o1.z = cvt_pk_bf16(qd[12], qd[13]); o1.w = cvt_pk_bf16(qd[14], qd[15]);
          *(LAS u32x4*)(QD + t * 136 + cb) = o0; *(LAS u32x4*)(QD + t * 136 + cb + 8) = o1;
          bf16_t* qg = (bf16_t*)(c.ws + WS_RB + RB_QDF) + (size_t)(dir * 1088 + un) * 8192 + (size_t)((((t >> 5) * 4 + (cb >> 5)) * 2 + ((cb >> 4) & 1)) * 512 + (t & 31) * 8);
          u32x4 p0, p1; p0.x = o0.x; p0.y = o0.y; p0.z = o1.x; p0.w = o1.y; p1.x = o0.z; p1.y = o0.w; p1.z = o1.z; p1.w = o1.w;
          *(u32x4*)qg = p0; *(u32x4*)(qg + 256) = p1;
          o0.x = cvt_pk_bf16(ki[0], ki[1]); o0.y = cvt_pk_bf16(ki[2], ki[3]); o0.z = cvt_pk_bf16(ki[4], ki[5]); o0.w = cvt_pk_bf16(ki[6], ki[7]);
          o1.x = cvt_pk_bf16(ki[8], ki[9]); o1.y = cvt_pk_bf16(ki[10], ki[11]); o1.z = cvt_pk_bf16(ki[12], ki[13]); o1.w = cvt_pk_bf16(ki[14], ki[15]);
          *(LAS u32x4*)(KI + t * 136 + cb) = o0; *(LAS u32x4*)(KI + t * 136 + cb + 8) = o1;
          if (tid < 128) ((float*)(c.ws + WS_RB + RB_DECAY))[(size_t)(dir * 1088 + un) * 128 + tid] = __expf(La[tl * 129 + tid]); }
        __syncthreads();
        { bf16_t* kg = (bf16_t*)(c.ws + WS_RB + RB_KDT) + (size_t)(dir * 1088 + un) * 8192;
#pragma unroll
          for (int i = 0; i < 2; ++i) { const int id = tid + 512 * i, ch = id >> 3, tc = id & 7;
              *(u32x4*)(kg + (((ch >> 5) * 4 + (tc >> 1)) * 64 + (tc & 1) * 32 + (ch & 31)) * 8) = *(const LAS u32x4*)(KdT + ch * 72 + tc * 8); } }
        { const int it = w >> 1; bf16x8 a[4];
#pragma unroll
          for (int ks = 0; ks < 4; ++ks) a[ks] = *(const LAS bf16x8*)(QD + (16 * it + lr) * 136 + 32 * ks + 8 * lq);
#pragma unroll
          for (int jj = 0; jj < 2; ++jj) { const int jt = 2 * (w & 1) + jj; f32x4 s = {0.f, 0.f, 0.f, 0.f};
#pragma unroll
              for (int ks = 0; ks < 4; ++ks) { const bf16x8 b = *(const LAS bf16x8*)(KI + (16 * jt + lr) * 136 + 32 * ks + 8 * lq); s = __builtin_amdgcn_mfma_f32_16x16x32_bf16(a[ks], b, s, 0, 0, 0); }
              const int j = 16 * jt + lr;
#pragma unroll
              for (int e = 0; e < 4; ++e) { const int i = 16 * it + 4 * lq + e; const bool keep = (dir == 0) ? (j <= i) : (j >= i); pacc[jj][e] += keep ? s[e] : 0.f; } } }
        __syncthreads();
    }
    { const int it = w >> 1;
#pragma unroll
      for (int jj = 0; jj < 2; ++jj) { const int j = 16 * (2 * (w & 1) + jj) + lr;
#pragma unroll
          for (int e = 0; e < 4; ++e) { Ps[(16 * it + 4 * lq + e) * 72 + j] = f2bf(pacc[jj][e]); } } }
    __syncthreads();
    { bf16_t* OI = (bf16_t*)(c.ws + WS_RB + RB_OINTRA);
#pragma unroll
      for (int dd = 0; dd < 2; ++dd) { const int dt = 2 * w + dd; bf16x8 a[2];
#pragma unroll
          for (int ks = 0; ks < 2; ++ks) a[ks] = *(const LAS bf16x8*)(VTs + (16 * dt + lr) * 72 + 32 * ks + 8 * lq);
#pragma unroll
          for (int it = 0; it < 4; ++it) { f32x4 o = {0.f, 0.f, 0.f, 0.f};
#pragma unroll
              for (int ks = 0; ks < 2; ++ks) { const bf16x8 b = *(const LAS bf16x8*)(Ps + (16 * it + lr) * 72 + 32 * ks + 8 * lq); o = __builtin_amdgcn_mfma_f32_16x16x32_bf16(a[ks], b, o, 0, 0, 0); }

              u32x2 ov; ov.x = cvt_pk_bf16(o[0], o[1]); ov.y = cvt_pk_bf16(o[2], o[3]);
              *(u32x2*)(OI + (size_t)(row0 + 16 * it + lr) * D + h * 256 + 16 * dt + 4 * lq) = ov; } } }
    { bf16_t* vg = (bf16_t*)(c.ws + WS_RB + RB_VTG) + (size_t)un * 16384;
#pragma unroll
      for (int i = 0; i < 4; ++i) { const int id = tid + 512 * i, dv = id >> 3, tc = id & 7;
          *(u32x4*)(vg + ((((dv >> 5) * 4 + (tc >> 1)) * 64) + (tc & 1) * 32 + (dv & 31)) * 8) = *(const LAS u32x4*)(VTs + dv * 72 + tc * 8); } }
    __syncthreads();
}
template <int N> __device__ __forceinline__ void vm_wait() { asm volatile("s_waitcnt vmcnt(%0)" :: "n"(N) : "memory"); }
__device__ __forceinline__ void gla_b2_unit(const Ctx& c, int un3) {
    const int lane = c.lane, lr = lane & 31, hi = lane >> 5, w = c.wave & 3, half = un3 & 1, un2 = un3 >> 1, dvs = half * 4 + w;
    const int h = un2 & 3, b = (un2 >> 2) & 3, dir = un2 >> 4;
    volatile LAS unsigned* cntF = (volatile LAS unsigned*)(c.lds + 3 * 33280 + 4 * 5120);
    volatile LAS unsigned* cntD = (volatile LAS unsigned*)(c.lds + 3 * 33280 + 4 * 5120 + 64);
    const char* QDF = (const char*)(c.ws + WS_RB + RB_QDF) + (size_t)dir * 1088 * 16384;
    const char* KDT = (const char*)(c.ws + WS_RB + RB_KDT) + (size_t)dir * 1088 * 16384;
    const char* VTG = (const char*)(c.ws + WS_RB + RB_VTG) + (size_t)dvs * 4096;
    const char* DEC = (const char*)(c.ws + WS_RB + RB_DECAY) + (size_t)dir * 1088 * 512;
    bf16_t* OUT = (bf16_t*)(c.ws + WS_RB + (dir == 0 ? RB_OF : RB_OB)) + h * 256 + 32 * dvs;
    constexpr int STG = 33280;
    LAS unsigned char* OT = c.lds + 3 * STG + w * 5120;
    const unsigned loff = (unsigned)lane * 16u;
#define B2_CHUNK(step) ((step) < 4 ? 256 + 4 * b + (dir == 0 ? (step) : 3 - (step)) : 64 * b + (dir == 0 ? (step) - 4 : 67 - (step)))
#define B2_ISSUE(step) do { const int un_ = B2_CHUNK(step) * 4 + h; LAS unsigned char* lb_ = c.lds + ((step) % 3) * STG; \
        const char* q_ = QDF + (size_t)un_ * 16384 + loff + w * 4096; const char* k_ = KDT + (size_t)un_ * 16384 + loff + w * 4096; \
        _Pragma("unroll") for (int i_ = 0; i_ < 4; ++i_) __builtin_amdgcn_global_load_lds((const unsigned*)(q_ + i_ * 1024), (LAS unsigned*)(lb_ + w * 4096 + i_ * 1024), 16, 0, 0); \
        _Pragma("unroll") for (int i_ = 0; i_ < 4; ++i_) __builtin_amdgcn_global_load_lds((const unsigned*)(k_ + i_ * 1024), (LAS unsigned*)(lb_ + 16384 + w * 4096 + i_ * 1024), 16, 0, 0); \
        if (lane < 8) __builtin_amdgcn_global_load_lds((const unsigned*)(DEC + (size_t)un_ * 512 + w * 128 + loff), (LAS unsigned*)(lb_ + 32768 + w * 128), 16, 0, 0); } while (0)
#define B2_SPIN(cnt, target) do { while (*(cnt) < (unsigned)(target)) __builtin_amdgcn_s_sleep(1); asm volatile("" ::: "memory"); } while (0)
#define B2_ARRIVE(cnt) do { if (lane == 0) __hip_atomic_fetch_add((LAS unsigned*)(cnt), 1u, __ATOMIC_RELAXED, __HIP_MEMORY_SCOPE_WORKGROUP); } while (0)
    if (c.wave >= 4) {
#pragma unroll 1
        for (int t = 0; t < 68; ++t) {
            if (t >= 3) B2_SPIN(cntD, 4 * (t - 2));
            B2_ISSUE(t);
            if (t >= 1) { vm_wait<9>(); B2_ARRIVE(cntF); }
        }
        vm_wait<0>(); B2_ARRIVE(cntF);
        return;
    }
#define B2_VT(step) do { const char* v_ = VTG + (size_t)(B2_CHUNK(step) * 4 + h) * 32768 + loff; \
        asm volatile("global_load_dwordx4 %0, %4, off\n\tglobal_load_dwordx4 %1, %4, off offset:1024\n\tglobal_load_dwordx4 %2, %4, off offset:2048\n\tglobal_load_dwordx4 %3, %4, off offset:3072" \
                     : "=&v"(vt[0]), "=&v"(vt[1]), "=&v"(vt[2]), "=&v"(vt[3]) : "v"(v_) : "memory"); } while (0)
#define B2_VT_WAIT(N) asm volatile("s_waitcnt vmcnt(%4)" : "+v"(vt[0]), "+v"(vt[1]), "+v"(vt[2]), "+v"(vt[3]) : "n"(N) : "memory")
    f32x16 S[4];
#pragma unroll
    for (int ct = 0; ct < 4; ++ct)
#pragma unroll
        for (int r = 0; r < 16; ++r) S[ct][r] = 0.f;
    bf16x8 vt[4];
    B2_VT(0);
#pragma unroll 1
    for (int step = 0; step < 68; ++step) {
        B2_SPIN(cntF, 4 * (step + 1));
        const int row0 = B2_CHUNK(step) * 64;
        const LAS unsigned char* lb = c.lds + (step % 3) * STG + loff;
        f32x16 o[2];
#pragma unroll
        for (int tt = 0; tt < 2; ++tt)
#pragma unroll
            for (int r = 0; r < 16; ++r) o[tt][r] = 0.f;
        { u32x4 bw[8];
#pragma unroll
          for (int ct = 0; ct < 4; ++ct)
#pragma unroll
            for (int s = 0; s < 2; ++s) { bw[ct * 2 + s].x = cvt_pk_bf16(S[ct][8 * s], S[ct][8 * s + 1]); bw[ct * 2 + s].y = cvt_pk_bf16(S[ct][8 * s + 2], S[ct][8 * s + 3]); bw[ct * 2 + s].z = cvt_pk_bf16(S[ct][8 * s + 4], S[ct][8 * s + 5]); bw[ct * 2 + s].w = cvt_pk_bf16(S[ct][8 * s + 6], S[ct][8 * s + 7]); }
#pragma unroll
          for (int tt = 0; tt < 2; ++tt) { bf16x8 qa[8];
#pragma unroll
            for (int i = 0; i < 8; ++i) qa[i] = *(const LAS bf16x8*)(lb + (tt * 8 + i) * 1024);
            __builtin_amdgcn_sched_barrier(0);
#pragma unroll
            for (int i = 0; i < 8; ++i) o[tt] = __builtin_amdgcn_mfma_f32_32x32x16_bf16(qa[i], __builtin_bit_cast(bf16x8, bw[i]), o[tt], 0, 0, 0);
            __builtin_amdgcn_sched_barrier(0); } }
#pragma unroll
        for (int tt = 0; tt < 2; ++tt)
#pragma unroll
            for (int r = 0; r < 16; ++r) { const int t = 32 * tt + (r & 3) + 8 * (r >> 2) + 4 * hi; *(LAS bf16_t*)(OT + t * 80 + lr * 2) = f2bf(o[tt][r]); }
        asm volatile("s_waitcnt lgkmcnt(0)" ::: "memory");
        { u32x4 ov[4];
#pragma unroll
          for (int i = 0; i < 4; ++i) ov[i] = *(const LAS u32x4*)(OT + lane * 80 + i * 16);
          bf16_t* op = OUT + (size_t)(row0 + lane) * D;
#pragma unroll
          for (int i = 0; i < 4; ++i) *(u32x4*)(op + 8 * i) = ov[i]; }
        B2_VT_WAIT(4);
        const LAS float* dcl = (const LAS float*)(c.lds + (step % 3) * STG + 32768);
#pragma unroll
        for (int cp = 0; cp < 2; ++cp) {
          bf16x8 ka[8]; f32x4 dq[8];
#pragma unroll
          for (int i = 0; i < 8; ++i) ka[i] = *(const LAS bf16x8*)(lb + 16384 + (cp * 8 + i) * 1024);
#pragma unroll
          for (int i = 0; i < 8; ++i) dq[i] = *(const LAS f32x4*)(dcl + 32 * (2 * cp + (i >> 2)) + 8 * (i & 3) + 4 * hi);
          __builtin_amdgcn_sched_barrier(0);
#pragma unroll
          for (int cc = 0; cc < 2; ++cc)
#pragma unroll
              for (int gq = 0; gq < 4; ++gq)
#pragma unroll
                  for (int e = 0; e < 4; ++e) S[2 * cp + cc][4 * gq + e] *= dq[cc * 4 + gq][e];
#pragma unroll
          for (int ks = 0; ks < 4; ++ks)
#pragma unroll
              for (int cc = 0; cc < 2; ++cc) S[2 * cp + cc] = __builtin_amdgcn_mfma_f32_32x32x16_bf16(ka[cc * 4 + ks], vt[ks], S[2 * cp + cc], 0, 0, 0);
          __builtin_amdgcn_sched_barrier(0);
        }
        asm volatile("s_waitcnt lgkmcnt(0)" ::: "memory"); B2_ARRIVE(cntD);
        if (step + 1 < 68) B2_VT(step + 1);
    }
    asm volatile("s_waitcnt vmcnt(0) lgkmcnt(0)" ::: "memory");
#undef B2_VT_WAIT
#undef B2_CHUNK
#undef B2_ISSUE
#undef B2_VT
#undef B2_SPIN
#undef B2_ARRIVE
}
struct FinRaw { u32x2 a[4], b[4], d[4], r[4]; };
__device__ __forceinline__ void gla_finish_load(const Ctx& c, int row, FinRaw& F) {
    const int lane = c.lane; const bf16_t* OI = (const bf16_t*)(c.ws + WS_RB + RB_OINTRA) + (size_t)row * D; const bf16_t* OFp = (const bf16_t*)(c.ws + WS_RB + RB_OF) + (size_t)row * D; const bf16_t* OBp = (const bf16_t*)(c.ws + WS_RB + RB_OB) + (size_t)row * D;
    const bf16_t* R = (const bf16_t*)(c.ws + WS_RA) + (size_t)row * NZ + ZRB;
#pragma unroll
    for (int h = 0; h < 4; ++h) { const int cc = h * 256 + 4 * lane; F.a[h] = *(const u32x2*)(OI + cc); F.b[h] = *(const u32x2*)(OFp + cc); F.d[h] = *(const u32x2*)(OBp + cc); F.r[h] = *(const u32x2*)(R + cc); }
}
__device__ __forceinline__ void gla_finish_row(const Ctx& c, int l, int row, const FinRaw& F) {
    const int lane = c.lane; bf16_t* Y = (bf16_t*)(c.ws + WS_RB + RB_YCAT) + (size_t)row * 3072 + D;
    const f32x4 gv = *(const f32x4*)(c.in[I_GGLA] + l * 256 + 4 * lane);
    float o[4][4], ss[4];
#pragma unroll
    for (int h = 0; h < 4; ++h) { const u32x2 a = F.a[h], b = F.b[h], d = F.d[h];
        o[h][0] = bflo(a.x) + bflo(b.x) + bflo(d.x); o[h][1] = bfhi(a.x) + bfhi(b.x) + bfhi(d.x); o[h][2] = bflo(a.y) + bflo(b.y) + bflo(d.y); o[h][3] = bfhi(a.y) + bfhi(b.y) + bfhi(d.y);
        ss[h] = (o[h][0] * o[h][0] + o[h][1] * o[h][1]) + (o[h][2] * o[h][2] + o[h][3] * o[h][3]); }
#pragma unroll
    for (int of = 1; of < 64; of <<= 1)
#pragma unroll
        for (int h = 0; h < 4; ++h) ss[h] += __shfl_xor(ss[h], of);
#pragma unroll
    for (int h = 0; h < 4; ++h) { const int cc = h * 256 + 4 * lane; const u32x2 r = F.r[h]; const float rstd = 1.0f / sqrtf(ss[h] * (1.f / 256.f) + EPS);
        u32x2 ov; ov.x = cvt_pk_bf16(o[h][0] * rstd * gv[0] * bflo(r.x), o[h][1] * rstd * gv[1] * bfhi(r.x)); ov.y = cvt_pk_bf16(o[h][2] * rstd * gv[2] * bflo(r.y), o[h][3] * rstd * gv[3] * bfhi(r.y));
        *(u32x2*)(Y + cc) = ov; }
}
__device__ __forceinline__ void rope_angle(int pos_row, int pos_col, int j, float& cs, float& sn) {
    const int axis = j >> 5, f = j & 15; const float inv = __expf(-(float)(2 * f) * (1.f / 32.f) * 9.210340371976184f);
    float rev = (float)(axis == 0 ? pos_row : pos_col) * inv * 0.15915494309189535f; rev -= floorf(rev); sn = __builtin_amdgcn_sinf(rev); cs = __builtin_amdgcn_cosf(rev);
}
struct C1Raw { u32x2 ckv; unsigned cq[3]; bf16_t kro; u32x2 kvw[8]; unsigned qnw[8]; bf16_t qrw[8]; };
__device__ __forceinline__ void mla_c1_load(const Ctx& c, int row, bool do_q, C1Raw& R) {
    const int lane = c.lane;
    const bf16_t* Zr = (const bf16_t*)(c.ws + WS_RA) + (size_t)row * NZ;
    const bf16_t* KV = (const bf16_t*)(c.ws + WS_RB + RB_KVRAW) + (size_t)row * 2048; const bf16_t* QR = (const bf16_t*)(c.ws + WS_RB + RB_QRAW) + (size_t)row * 1536;
    R.ckv = *(const u32x2*)(Zr + ZCKV + 4 * lane);
#pragma unroll
    for (int i = 0; i < 3; ++i) R.cq[i] = *(const unsigned*)(Zr + ZCQ + 128 * i + 2 * lane);
    R.kro = Zr[ZKR + lane];
#pragma unroll
    for (int h = 0; h < 8; ++h) R.kvw[h] = *(const u32x2*)(KV + h * 256 + 4 * lane);
    if (do_q) {
#pragma unroll
        for (int h = 0; h < 8; ++h) { R.qnw[h] = *(const unsigned*)(QR + h * 192 + 2 * lane); R.qrw[h] = QR[h * 192 + 128 + lane]; }
    }
}
__device__ __forceinline__ void mla_c1_row(const Ctx& c, int l, int row, bool do_q, const C1Raw& R) {
    const int lane = c.lane; const bool lat = row < TL; const int b = lat ? (row >> 12) : ((row - TL) >> 8), t = lat ? (row & 4095) : ((row - TL) & 255), key = lat ? (CTXL + t) : t;
    bf16_t* KG = (bf16_t*)(c.ws + WS_RB + RB_KG); bf16_t* VG = (bf16_t*)(c.ws + WS_RB + RB_VG);
    float rs_kv, rs_q;
    { const u32x2 w = R.ckv; const float a0 = bflo(w.x), a1 = bfhi(w.x), a2 = bflo(w.y), a3 = bfhi(w.y);
      rs_kv = 1.0f / sqrtf(wave_sum((a0 * a0 + a1 * a1) + (a2 * a2 + a3 * a3)) * (1.f / 256.f) + EPS);
      float s = 0.f;
#pragma unroll
      for (int i = 0; i < 3; ++i) { const unsigned w2 = R.cq[i]; const float q0 = bflo(w2), q1 = bfhi(w2); s += q0 * q0 + q1 * q1; }
      rs_q = 1.0f / sqrtf(wave_sum(s) * (1.f / 384.f) + EPS); }
    float cs = 1.f, sn = 0.f; if (lat) rope_angle(t >> 6, t & 63, lane, cs, sn);
    const bool second = (lane >> 4) & 1;
    float kr;
    { const float v = bf2f(R.kro); const float rr = 1.0f / sqrtf(wave_sum(v * v) * (1.f / 64.f) + EPS); float x = v * rr * c.in[I_GKR][l * 64 + lane];
      const float xp = __shfl_xor(x, 16); kr = lat ? (second ? (x * cs + xp * sn) : (x * cs - xp * sn)) : x; }
    const bf16_t krb = f2bf(kr);
    const f32x4 gkn = *(const f32x4*)(c.in[I_GKN] + l * 128 + 4 * (lane & 31));
    float ssk[8]; float ak[8][4];
#pragma unroll
    for (int h = 0; h < 8; ++h) { ak[h][0] = bflo(R.kvw[h].x) * rs_kv; ak[h][1] = bfhi(R.kvw[h].x) * rs_kv; ak[h][2] = bflo(R.kvw[h].y) * rs_kv; ak[h][3] = bfhi(R.kvw[h].y) * rs_kv;
        ssk[h] = (ak[h][0] * ak[h][0] + ak[h][1] * ak[h][1]) + (ak[h][2] * ak[h][2] + ak[h][3] * ak[h][3]); }
#pragma unroll
    for (int o = 1; o < 32; o <<= 1)
#pragma unroll
        for (int h = 0; h < 8; ++h) ssk[h] += __shfl_xor(ssk[h], o);
    { bf16_t* kgp = KG + (size_t)(b * NKEY + key) * (8 * 192); bf16_t* vgp = VG + (size_t)(b * NKEY + key) * (8 * 128);
#pragma unroll
      for (int h = 0; h < 8; ++h) {
        if (lane < 32) { const float rn = 1.0f / sqrtf(ssk[h] * (1.f / 128.f) + EPS); u32x2 o; o.x = cvt_pk_bf16(ak[h][0] * rn * gkn[0], ak[h][1] * rn * gkn[1]); o.y = cvt_pk_bf16(ak[h][2] * rn * gkn[2], ak[h][3] * rn * gkn[3]);
            *(u32x2*)(kgp + h * 192 + 4 * lane) = o; }
        else { u32x2 o; o.x = cvt_pk_bf16(ak[h][0], ak[h][1]); o.y = cvt_pk_bf16(ak[h][2], ak[h][3]); *(u32x2*)(vgp + h * 128 + 4 * (lane - 32)) = o; }
        kgp[h * 192 + 128 + lane] = krb;
      } }
    __builtin_amdgcn_sched_barrier(0);
    if (!do_q) return;
    bf16_t* QF = lat ? (bf16_t*)(c.ws + WS_RB + RB_QFL) : (bf16_t*)(c.ws + WS_RB + RB_QFC); const int nq = lat ? SEQ : CTXL;
    const float QS = 0.07216878364870322f * 1.4426950408889634f;
    const f32x2 gqn = *(const f32x2*)(c.in[I_GQN] + l * 128 + 2 * lane); const float gqr = c.in[I_GQR][l * 64 + lane];
    float n0[8], n1[8], r0[8], sn_[8], sr_[8];
#pragma unroll
    for (int h = 0; h < 8; ++h) { n0[h] = bflo(R.qnw[h]) * rs_q; n1[h] = bfhi(R.qnw[h]) * rs_q; r0[h] = bf2f(R.qrw[h]) * rs_q; sn_[h] = n0[h] * n0[h] + n1[h] * n1[h]; sr_[h] = r0[h] * r0[h]; }
#pragma unroll
    for (int o = 1; o < 64; o <<= 1)
#pragma unroll
        for (int h = 0; h < 8; ++h) { sn_[h] += __shfl_xor(sn_[h], o); sr_[h] += __shfl_xor(sr_[h], o); }
#pragma unroll
    for (int h = 0; h < 8; ++h) {
        const float rn = 1.0f / sqrtf(sn_[h] * (1.f / 128.f) + EPS), rr = 1.0f / sqrtf(sr_[h] * (1.f / 64.f) + EPS);
        bf16_t* qp = QF + (size_t)(b * nq + t) * (8 * 192) + h * 192;
        *(unsigned*)(qp + 2 * lane) = cvt_pk_bf16(n0[h] * rn * gqn[0] * QS, n1[h] * rn * gqn[1] * QS);
        const float x = r0[h] * rr * gqr; const float xp = __shfl_xor(x, 16); const float xr = lat ? (second ? (x * cs + xp * sn) : (x * cs - xp * sn)) : x;
        qp[128 + lane] = f2bf(xr * QS);
    }
}
__device__ __forceinline__ bf16x8 tr_pair(unsigned a0, unsigned a1) {
    bf16x4 x, y; asm volatile("ds_read_b64_tr_b16 %0, %2\n\tds_read_b64_tr_b16 %1, %3\n\ts_waitcnt lgkmcnt(0)" : "=&v"(x), "=&v"(y) : "v"(a0), "v"(a1) : "memory");
    return (bf16x8){x[0], x[1], x[2], x[3], y[0], y[1], y[2], y[3]};
}
__device__ __forceinline__ void k2_issue(bf16x8& a0, bf16x8& a1, unsigned addr) {
    asm volatile("ds_read_b128 %0, %2\n\tds_read_b128 %1, %2 offset:12288" : "=&v"(a0), "=&v"(a1) : "v"(addr) : "memory");
}
template <int N> __device__ __forceinline__ void k2_wait(bf16x8& a0, bf16x8& a1) { asm volatile("s_waitcnt lgkmcnt(%2)" : "+v"(a0), "+v"(a1) : "n"(N) : "memory"); }
template <int OFF>
__device__ __forceinline__ void tr8_issue(bf16x4 (&x)[8], unsigned a0, unsigned a1, unsigned a2, unsigned a3, unsigned d1) {
    asm volatile("ds_read_b64_tr_b16 %0, %8 offset:%13\n\tds_read_b64_tr_b16 %2, %9 offset:%13\n\tds_read_b64_tr_b16 %4, %10 offset:%13\n\tds_read_b64_tr_b16 %6, %11 offset:%13\n\t"
                 "v_add_u32 %8, %8, %12\n\tv_add_u32 %9, %9, %12\n\tv_add_u32 %10, %10, %12\n\tv_add_u32 %11, %11, %12\n\t"
                 "ds_read_b64_tr_b16 %1, %8 offset:%13\n\tds_read_b64_tr_b16 %3, %9 offset:%13\n\tds_read_b64_tr_b16 %5, %10 offset:%13\n\tds_read_b64_tr_b16 %7, %11 offset:%13"
                 : "=&v"(x[0]), "=&v"(x[1]), "=&v"(x[2]), "=&v"(x[3]), "=&v"(x[4]), "=&v"(x[5]), "=&v"(x[6]), "=&v"(x[7]), "+v"(a0), "+v"(a1), "+v"(a2), "+v"(a3)
                 : "v"(d1), "n"(OFF) : "memory");
}
__device__ __forceinline__ void tr8_wait(bf16x4 (&x)[8]) {
    asm volatile("s_waitcnt lgkmcnt(0)" : "+v"(x[0]), "+v"(x[1]), "+v"(x[2]), "+v"(x[3]), "+v"(x[4]), "+v"(x[5]), "+v"(x[6]), "+v"(x[7]) :: "memory");
}
__device__ __forceinline__ void attn_unit(const Ctx& c, const bf16_t* Qp  , const bf16_t* Kp  , const bf16_t* Vp  , int nt, bf16_t* Op  ) {
    constexpr int STG = 40960, KB = 24576;
    const int tid = c.tid, lane = c.lane, w = c.wave, lr = lane & 31, hi = lane >> 5;
    const unsigned lds0 = (unsigned)(size_t)c.lds;
    unsigned ksrc[3], vsrc[2];
#pragma unroll
    for (int i = 0; i < 3; ++i) { const int P = (w + 8 * i) * 64 + lane, row = P / 24, cp = P % 24, ch = (cp & ~7) | ((cp & 7) ^ ((row >> 1) & 7)); ksrc[i] = row * 3072 + ch * 16; }
#pragma unroll
    for (int i = 0; i < 2; ++i) { const int P = (w + 8 * i) * 64 + lane, row = P >> 4, cp = P & 15, ch = cp ^ (((row & 3) << 2) | ((row >> 2) & 3)); vsrc[i] = row * 2048 + ch * 16; }
#define ATT_ISSUE(tile, stg) do { const char* kt_ = (const char*)Kp + (size_t)(tile) * (64 * 3072); const char* vt_ = (const char*)Vp + (size_t)(tile) * (64 * 2048); \
        _Pragma("unroll") for (int i_ = 0; i_ < 3; ++i_) __builtin_amdgcn_global_load_lds((const unsigned*)(kt_ + ksrc[i_]), (LAS unsigned*)(c.lds + (stg) * STG + (w + 8 * i_) * 1024), 16, 0, 0); \
        _Pragma("unroll") for (int i_ = 0; i_ < 2; ++i_) __builtin_amdgcn_global_load_lds((const unsigned*)(vt_ + vsrc[i_]), (LAS unsigned*)(c.lds + (stg) * STG + KB + (w + 8 * i_) * 1024), 16, 0, 0); } while (0)
    bf16x8 qf[12];
    { const bf16_t* qrow = Qp + (size_t)(32 * w + lr) * 1536 + 8 * hi;
#pragma unroll
      for (int s = 0; s < 12; ++s) qf[s] = *(const bf16x8*)(qrow + 16 * s); }
    unsigned kbase = lr * 384, y16 = (unsigned)((hi ^ ((lr >> 1) & 7)) << 4);
    unsigned vbase, q64, vd1;
    { const int blk = (lane >> 4) & 1, q = (lane & 15) >> 2, p = lane & 3; const int lb = (2 * blk + (p >> 1)) ^ hi;
      vbase = KB + 256 * (4 * hi + q) + 16 * lb + 8 * (p & 1); q64 = (unsigned)(q << 6); vd1 = 2048u + ((lb & 2) ? -32 : 32); }
    f32x16 o[4];
#pragma unroll
    for (int cc = 0; cc < 4; ++cc)
#pragma unroll
        for (int r = 0; r < 16; ++r) o[cc][r] = 0.f;
    float m = -1e30f, lsum = 0.f;
    ATT_ISSUE(0, 0);
    if (nt > 1) ATT_ISSUE(1, 1);
    asm volatile("" :: "v"(qf[0]), "v"(qf[1]), "v"(qf[2]), "v"(qf[3]), "v"(qf[4]), "v"(qf[5]), "v"(qf[6]), "v"(qf[7]), "v"(qf[8]), "v"(qf[9]), "v"(qf[10]), "v"(qf[11]));
#pragma unroll 1
    for (int j = 0; j < nt; ++j) {
        if (j + 1 < nt) asm volatile("s_waitcnt vmcnt(5)" ::: "memory"); else asm volatile("s_waitcnt vmcnt(0)" ::: "memory");
        asm volatile("s_waitcnt lgkmcnt(0)" ::: "memory"); __builtin_amdgcn_s_barrier(); asm volatile("" ::: "memory");
        if (j + 2 < nt) ATT_ISSUE(j + 2, (j + 2) % 3);
        const unsigned sb = lds0 + (unsigned)((j % 3) * STG);
        asm volatile("" : "+v"(kbase), "+v"(y16), "+v"(vbase), "+v"(q64), "+v"(vd1));
        const unsigned kb_ = sb + kbase;
        f32x16 st[2];
#pragma unroll
        for (int kt = 0; kt < 2; ++kt)
#pragma unroll
            for (int r = 0; r < 16; ++r) st[kt][r] = 0.f;
        { bf16x8 ka[3][2];
#define KADDR(s_) (kb_ + (y16 ^ (unsigned)(((2 * (s_)) & 7) << 4)) + (unsigned)((((2 * (s_)) & ~7) << 4)))
          k2_issue(ka[0][0], ka[0][1], KADDR(0)); k2_issue(ka[1][0], ka[1][1], KADDR(1));
#pragma unroll
          for (int s = 0; s < 12; ++s) {
              if (s + 2 < 12) { k2_issue(ka[(s + 2) % 3][0], ka[(s + 2) % 3][1], KADDR(s + 2)); k2_wait<4>(ka[s % 3][0], ka[s % 3][1]); }
              else if (s + 1 < 12) k2_wait<2>(ka[s % 3][0], ka[s % 3][1]); else k2_wait<0>(ka[s % 3][0], ka[s % 3][1]);
              st[0] = __builtin_amdgcn_mfma_f32_32x32x16_bf16(ka[s % 3][0], qf[s], st[0], 0, 0, 0);
              st[1] = __builtin_amdgcn_mfma_f32_32x32x16_bf16(ka[s % 3][1], qf[s], st[1], 0, 0, 0); }
#undef KADDR
        }
        bf16x4 vx[8];
        tr8_issue<0>(vx, sb + vbase + (q64 ^ 0u), sb + vbase + (q64 ^ 64u), sb + vbase + (q64 ^ 128u), sb + vbase + (q64 ^ 192u), vd1);
        float mx = st[0][0];
#pragma unroll
        for (int r = 1; r < 16; ++r) mx = fmaxf(mx, st[0][r]);
#pragma unroll
        for (int r = 0; r < 16; ++r) mx = fmaxf(mx, st[1][r]);
        mx = fmaxf(mx, __shfl_xor(mx, 32));
        const float mn = fmaxf(m, mx), alpha = __builtin_amdgcn_exp2f(m - mn); m = mn;
        float ps = 0.f;
#pragma unroll
        for (int kt = 0; kt < 2; ++kt)
#pragma unroll
            for (int r = 0; r < 16; ++r) { st[kt][r] = __builtin_amdgcn_exp2f(st[kt][r] - mn); ps += st[kt][r]; }
        lsum = lsum * alpha + ps;
        if (__any(alpha != 1.0f)) {
#pragma unroll
            for (int cc = 0; cc < 4; ++cc)
#pragma unroll
                for (int r = 0; r < 16; ++r) o[cc][r] *= alpha; }
#define ATT_PV(KT, S2, NEXT_OFF, HAS_NEXT) do { u32x4 pw; pw.x = cvt_pk_bf16(st[KT][8 * S2], st[KT][8 * S2 + 1]); pw.y = cvt_pk_bf16(st[KT][8 * S2 + 2], st[KT][8 * S2 + 3]); pw.z = cvt_pk_bf16(st[KT][8 * S2 + 4], st[KT][8 * S2 + 5]); pw.w = cvt_pk_bf16(st[KT][8 * S2 + 6], st[KT][8 * S2 + 7]); \
            const bf16x8 pb = __builtin_bit_cast(bf16x8, pw); tr8_wait(vx); bf16x8 af[4]; \
            _Pragma("unroll") for (int cc = 0; cc < 4; ++cc) af[cc] = (bf16x8){vx[2 * cc][0], vx[2 * cc][1], vx[2 * cc][2], vx[2 * cc][3], vx[2 * cc + 1][0], vx[2 * cc + 1][1], vx[2 * cc + 1][2], vx[2 * cc + 1][3]}; \
            if (HAS_NEXT) tr8_issue<NEXT_OFF>(vx, sb + vbase + (q64 ^ 0u), sb + vbase + (q64 ^ 64u), sb + vbase + (q64 ^ 128u), sb + vbase + (q64 ^ 192u), vd1); \
            _Pragma("unroll") for (int cc = 0; cc < 4; ++cc) o[cc] = __builtin_amdgcn_mfma_f32_32x32x16_bf16(af[cc], pb, o[cc], 0, 0, 0); } while (0)
        ATT_PV(0, 0, 4096, true); ATT_PV(0, 1, 8192, true); ATT_PV(1, 0, 12288, true); ATT_PV(1, 1, 0, false);
#undef ATT_PV
    }
    const float linv = 1.0f / (lsum + __shfl_xor(lsum, 32));
    bf16_t* orow = Op + (size_t)(32 * w + lr) * 3072;
#pragma unroll
    for (int cc = 0; cc < 4; ++cc)
#pragma unroll
        for (int g = 0; g < 4; ++g) { u32x2 ov; ov.x = cvt_pk_bf16(o[cc][4 * g] * linv, o[cc][4 * g + 1] * linv); ov.y = cvt_pk_bf16(o[cc][4 * g + 2] * linv, o[cc][4 * g + 3] * linv);
            *(u32x2*)(orow + 32 * cc + 8 * g + 4 * hi) = ov; }
    asm volatile("s_waitcnt vmcnt(0) lgkmcnt(0)" ::: "memory"); __builtin_amdgcn_s_barrier(); asm volatile("" ::: "memory");
#undef ATT_ISSUE
}
__device__ __forceinline__ void route_stage_w(const Ctx& c, int l) {
    LAS float* WT = (LAS float*)c.lds; const float* wr = c.in[I_WROUTER] + (size_t)l * D * NEXP;
    for (int i = c.tid; i < D * NEXP; i += NTHR) WT[(i & 15) * 1028 + (i >> 4)] = wr[i];
    __syncthreads();
}
struct RouteRaw { f32x4 xv[4]; };
__device__ __forceinline__ void route_load(const Ctx& c, int row, RouteRaw& R) { const float* xr = xout_row(c, row);
#pragma unroll
    for (int j = 0; j < 4; ++j) R.xv[j] = *(const f32x4*)(xr + 4 * c.lane + 256 * j); }
__device__ __forceinline__ void route_row(const Ctx& c, int l, int row, const RouteRaw& R) {
    const int lane = c.lane, bi = row_modidx(row); f32x4 hv[4];
    { const float* g = c.in[I_GFFN] + l * D; const float* shift = modp(c, l, bi, 3); const float* scale = modp(c, l, bi, 4); bf16_t* hrow = (bf16_t*)(c.ws + WS_H) + (size_t)row * D; float ss = 0.f;
#pragma unroll
      for (int j = 0; j < 4; ++j) { hv[j] = R.xv[j]; ss += (hv[j][0] * hv[j][0] + hv[j][1] * hv[j][1]) + (hv[j][2] * hv[j][2] + hv[j][3] * hv[j][3]); }
      const float rstd = 1.0f / sqrtf(wave_sum(ss) * (1.f / D) + EPS);
#pragma unroll
      for (int j = 0; j < 4; ++j) { const int cc = 4 * lane + 256 * j; const f32x4 gv = *(const f32x4*)(g + cc), sc = *(const f32x4*)(scale + cc), sh = *(const f32x4*)(shift + cc);
          hv[j] = hv[j] * rstd * gv * (sc + 1.0f) + sh;
          u32x2 o; o.x = cvt_pk_bf16(hv[j][0], hv[j][1]); o.y = cvt_pk_bf16(hv[j][2], hv[j][3]); *(u32x2*)(hrow + cc) = o; } }
    const LAS float* WT = (const LAS float*)c.lds; float lg[16];
#pragma unroll
    for (int e = 0; e < 16; ++e) { float a = 0.f;
#pragma unroll
        for (int j = 0; j < 4; ++j) { const f32x4 wv = *(const LAS f32x4*)(WT + e * 1028 + 4 * lane + 256 * j); a += (hv[j][0] * wv[0] + hv[j][1] * wv[1]) + (hv[j][2] * wv[2] + hv[j][3] * wv[3]); }
        lg[e] = a; if ((e & 3) == 3) __builtin_amdgcn_sched_barrier(0); }
#pragma unroll
    for (int o = 1; o < 64; o <<= 1)
#pragma unroll
        for (int e = 0; e < 16; ++e) lg[e] += __shfl_xor(lg[e], o);
    float mx = lg[0];
#pragma unroll
    for (int e = 1; e < 16; ++e) mx = fmaxf(mx, lg[e]);
    float sum = 0.f;
#pragma unroll
    for (int e = 0; e < 16; ++e) { lg[e] = __expf(lg[e] - mx); sum += lg[e]; }
    const float inv = 1.0f / sum; float mine = 0.f;
#pragma unroll
    for (int e = 0; e < 16; ++e) mine = (lane == e) ? lg[e] * inv : mine;
    float* AF = (float*)(c.ws + WS_AFFT);
    if (lane < 16) { if (row < TL) AF[((size_t)(row >> 12) * 16 + lane) * SEQ + (row & 4095)] = mine; else AF[(size_t)NB * 16 * SEQ + ((size_t)((row - TL) >> 8) * 16 + lane) * CTXL + ((row - TL) & 255)] = mine; }
}
struct GuMap { int up; __device__ __forceinline__ int operator()(int n) const { return (n >> 7) * 256 + up * 128 + (n & 127); } };
struct IdMap { __device__ __forceinline__ int operator()(int n) const { return n; } };
__device__ __forceinline__ void expert_wconv(const Ctx& c, int l) {
    constexpr int U_G = 16 * 8, U_D = 32 * 4, U_E = 2 * U_G + U_D;
    bf16_t* WGU = (bf16_t*)(c.ws + WS_RB + RB_WGU); bf16_t* WD = (bf16_t*)(c.ws + WS_RB + RB_WD);
    unsigned* ctr = (unsigned*)(c.ws + WS_CTL + 32768) + 64 * l;
    LAS int* ubox = (LAS int*)(c.lds + 4 * 64 * 65 * 4);
    for (;;) { if (c.tid == 0) *ubox = (int)__hip_atomic_fetch_add(ctr, 1u, __ATOMIC_RELAXED, __HIP_MEMORY_SCOPE_AGENT);
        __syncthreads(); const int u = *ubox; __syncthreads(); if (u >= NEXP * U_E) break;
        const int e = u / U_E; int r = u % U_E;
        if (r < 2 * U_G) { const int up = r / U_G, rr = r % U_G, nb = rr / 16, kb = rr % 16;
            const float* src = c.in[up ? I_WEU : I_WEG] + ((size_t)l * NEXP + e) * D * DEXP;
            tconv_tile4(c, src, DEXP, kb * 64, nb * 256, WGU + (size_t)e * 4096 * D, D, kb * 64, GuMap{up}); }
        else { r -= 2 * U_G; const int nb = r / 32, kb = r % 32;
            tconv_tile4(c, c.in[I_WED] + ((size_t)l * NEXP + e) * DEXP * D, D, kb * 64, nb * 256, WD + (size_t)e * D * DEXP, DEXP, kb * 64, IdMap{}); } }
}
__device__ __forceinline__ void topk_unit(const Ctx& c, int un, bool is_ctx) {
    const int tid = c.tid, lane = c.lane, w = c.wave;
    LAS unsigned* hist = (LAS unsigned*)c.lds;
    LAS unsigned* ctl = (LAS unsigned*)(c.lds + 1024);
    LAS unsigned* wsum = (LAS unsigned*)(c.lds + 1280);
    LAS int* list = (LAS int*)(c.lds + 2048);
    int b, e, ntok, cap; const float* src;
    if (!is_ctx) { b = un >> 4; e = un & 15; ntok = SEQ; cap = CAPL; src = (const float*)(c.ws + WS_AFFT) + ((size_t)b * 16 + e) * SEQ; }
    else { b = un >> 4; e = un & 15; ntok = CTXL; cap = CAPC; src = (const float*)(c.ws + WS_AFFT) + (size_t)NB * 16 * SEQ + ((size_t)b * 16 + e) * CTXL; }
    const bool have = 8 * tid < ntok; unsigned key[8];
    if (have) { const u32x4 k0 = *(const u32x4*)(src + 8 * tid), k1 = *(const u32x4*)(src + 8 * tid + 4); key[0] = k0.x; key[1] = k0.y; key[2] = k0.z; key[3] = k0.w; key[4] = k1.x; key[5] = k1.y; key[6] = k1.z; key[7] = k1.w; }
    else {
#pragma unroll
        for (int i = 0; i < 8; ++i) key[i] = 0u; }
    if (tid == 0) { ctl[0] = 0u; ctl[1] = (unsigned)cap; }
#pragma unroll 1
    for (int pass = 0; pass < 4; ++pass) { const int shift = 24 - 8 * pass;
        if (tid < 256) hist[tid] = 0u;
        __syncthreads();
        const unsigned pref = ctl[0], need = ctl[1];
        if (have) {
#pragma unroll
            for (int i = 0; i < 8; ++i) { const bool m = (pass == 0) || ((key[i] >> (shift + 8)) == pref); if (m) atomicAdd((unsigned*)(hist + ((key[i] >> shift) & 255u)), 1u); } }
        __syncthreads();
        if (tid < 256) {
            const unsigned hv = hist[tid]; unsigned sfx = hv;
#pragma unroll
            for (int o = 1; o < 64; o <<= 1) { const unsigned tv = __shfl_down(sfx, o); if (lane + o < 64) sfx += tv; }
            if (lane == 0) wsum[w] = sfx;
            }
        __syncthreads();
        if (tid < 256) { const unsigned hv = hist[tid]; unsigned sfx = hv;
#pragma unroll
            for (int o = 1; o < 64; o <<= 1) { const unsigned tv = __shfl_down(sfx, o); if (lane + o < 64) sfx += tv; }
            unsigned gt = sfx - hv;
#pragma unroll
            for (int j = 1; j < 4; ++j) if (w + j < 4) gt += wsum[w + j];
            if (gt < need && need <= gt + hv) { ctl[2] = (pref << 8) | (unsigned)tid; ctl[3] = need - gt; } }
        __syncthreads();
        if (tid == 0) { ctl[0] = ctl[2]; ctl[1] = ctl[3]; }
        __syncthreads();
    }
    const unsigned thr = ctl[0], need = ctl[1];
    unsigned cg = 0u, ce = 0u;
#pragma unroll
    for (int i = 0; i < 8; ++i) { cg += (key[i] > thr) ? 1u : 0u; ce += (have && key[i] == thr) ? 1u : 0u; }
    unsigned sg = cg, se = ce;
#pragma unroll
    for (int o = 1; o < 64; o <<= 1) { const unsigned tg = __shfl_up(sg, o), te = __shfl_up(se, o); if (lane >= o) { sg += tg; se += te; } }
    if (lane == 63) { wsum[w] = sg; wsum[8 + w] = se; }
    __syncthreads();
    unsigned og = 0u, oe = 0u;
#pragma unroll
    for (int j = 0; j < 8; ++j) { if (j < w) { og += wsum[j]; oe += wsum[8 + j]; } }
    unsigned pg = og + sg - cg, pe = oe + se - ce;
    const int rowbase = is_ctx ? (TL + b * CTXL) : (b * SEQ);
    if (have) {
#pragma unroll
        for (int i = 0; i < 8; ++i) { const bool g = key[i] > thr, q = key[i] == thr; const bool sel = g || (q && pe < need);
            const int rank = (int)(pg + (pe < need ? pe : need)); const int row = rowbase + 8 * tid + i;
            ((int*)(c.ws + WS_SEL))[(size_t)row * 16 + e] = sel ? rank : -1;
            if (sel) { const int slot = is_ctx ? (2048 + b * CAPC + rank) : (b * CAPL + rank); ((float*)(c.ws + WS_GATEV))[e * ESLOTS + slot] = __uint_as_float(key[i]); list[2 * rank] = row; list[2 * rank + 1] = slot; }
            pg += g ? 1u : 0u; pe += q ? 1u : 0u; } }
    __syncthreads();
    const bf16_t* H = (const bf16_t*)(c.ws + WS_H); bf16_t* XS = (bf16_t*)(c.ws + WS_RA + RA_XS) + (size_t)e * ESLOTS * D;
    for (int i0 = w; i0 < cap; i0 += 8 * NWAVES) {
        u32x4 v0[8], v1[8];
#pragma unroll
        for (int k = 0; k < 8; ++k) { const int i = i0 + k * NWAVES; if (i < cap) { const u32x4* sp = (const u32x4*)(H + (size_t)list[2 * i] * D); v0[k] = sp[lane]; v1[k] = sp[64 + lane]; } }
#pragma unroll
        for (int k = 0; k < 8; ++k) { const int i = i0 + k * NWAVES; if (i < cap) { u32x4* dp = (u32x4*)(XS + (size_t)list[2 * i + 1] * D); dp[lane] = v0[k]; dp[64 + lane] = v1[k]; } }
    }
    __syncthreads();
}
struct CombRaw { int sel; f32x4 xv[4]; };
__device__ __forceinline__ void combine_load(const Ctx& c, int row, CombRaw& R) {
    const int lane = c.lane; const float* xr = xout_row(c, row);
    R.sel = ((const int*)(c.ws + WS_SEL))[(size_t)row * 16 + (lane & 15)];
#pragma unroll
    for (int j = 0; j < 4; ++j) R.xv[j] = *(const f32x4*)(xr + 4 * lane + 256 * j);
}
__device__ __forceinline__ void combine_row(const Ctx& c, int l, int row, bool next_mod, const CombRaw& R, float* dummy = nullptr) {
    const int lane = c.lane, bi = row_modidx(row); float* xr = xout_row(c, row); float* xw = dummy ? dummy + (size_t)row * D : xr;
    const bf16_t* YS = (const bf16_t*)(c.ws + WS_RA + RA_YS); const float* g5 = modp(c, l, bi, 5);
    f32x4 acc[4];
#pragma unroll
    for (int j = 0; j < 4; ++j) acc[j] = (f32x4){0.f, 0.f, 0.f, 0.f};
    const bool lat = row < TL; const int b = lat ? (row >> 12) : ((row - TL) >> 8);
    unsigned long long pick = __ballot(R.sel >= 0) & 0xffffull;
    while (pick) {
        const bf16_t* yp[4]; bool on[4];
#pragma unroll
        for (int k = 0; k < 4; ++k) { on[k] = pick != 0; const int e = on[k] ? __builtin_ctzll(pick) : 0; if (on[k]) pick &= pick - 1;
            const int r = __builtin_amdgcn_readlane(R.sel, e); const int slot = lat ? (b * CAPL + r) : (2048 + b * CAPC + r);
            yp[k] = YS + ((size_t)e * ESLOTS + (on[k] ? slot : 0)) * D; }
        u32x2 wv[4][4];
#pragma unroll
        for (int k = 0; k < 4; ++k)
#pragma unroll
            for (int j = 0; j < 4; ++j) wv[k][j] = on[k] ? *(const u32x2*)(yp[k] + 4 * lane + 256 * j) : (u32x2){0u, 0u};
#pragma unroll
        for (int k = 0; k < 4; ++k)
#pragma unroll
            for (int j = 0; j < 4; ++j) { acc[j][0] += bflo(wv[k][j].x); acc[j][1] += bfhi(wv[k][j].x); acc[j][2] += bflo(wv[k][j].y); acc[j][3] += bfhi(wv[k][j].y); }
    }
    float ss = 0.f; f32x4 xv[4];
#pragma unroll
    for (int j = 0; j < 4; ++j) { const int cc = 4 * lane + 256 * j; xv[j] = R.xv[j] + *(const f32x4*)(g5 + cc) * acc[j]; *(f32x4*)(xw + cc) = xv[j];
        ss += (xv[j][0] * xv[j][0] + xv[j][1] * xv[j][1]) + (xv[j][2] * xv[j][2] + xv[j][3] * xv[j][3]); }
    if (!next_mod) return;
    const float rstd = 1.0f / sqrtf(wave_sum(ss) * (1.f / D) + EPS); const float* g = c.in[I_GMIX] + (l + 1) * D; const float* sh = modp(c, l + 1, bi, 0); const float* sc = modp(c, l + 1, bi, 1);
    bf16_t* hrow = (bf16_t*)(c.ws + WS_H) + (size_t)row * D;
#pragma unroll
    for (int j = 0; j < 4; ++j) { const int cc = 4 * lane + 256 * j; const f32x4 h = xv[j] * rstd * *(const f32x4*)(g + cc) * (*(const f32x4*)(sc + cc) + 1.0f) + *(const f32x4*)(sh + cc);
        u32x2 o; o.x = cvt_pk_bf16(h[0], h[1]); o.y = cvt_pk_bf16(h[2], h[3]); *(u32x2*)(hrow + cc) = o; }
}

#ifndef MK_FUSED
#define MK_FUSED 1
#endif
constexpr int NPH = 2 + 11 * 2;
constexpr int CW_BAR = 4096;

__global__ void __launch_bounds__(NTHR, 2) fwd(Args args) {
    extern __shared__ __attribute__((aligned(16))) unsigned char lds_raw[];
    Ctx c; c.in = args.in; c.out = args.out; c.ws = args.ws; c.lds = (LAS unsigned char*)lds_raw;
    c.tid = threadIdx.x; c.lane = c.tid & 63; c.wave = __builtin_amdgcn_readfirstlane(c.tid >> 6); c.G = gridDim.x; c.bid = blockIdx.x;
    volatile LAS unsigned* misc = (volatile LAS unsigned*)(c.lds + LDS_MISC);
    if (c.tid < 8) misc[c.tid] = 0u;
    __syncthreads();
#if MK_FUSED
    XcdBarrier bar = xcd_barrier_post((unsigned*)(c.ws + WS_CTL) + CW_BAR, misc);
#define GRID_BAR() xcd_barrier(bar)
#else
#define GRID_BAR() do {} while (0)
#endif
    const int lo = args.ph_lo, hi = args.ph_hi;
#ifndef PHMASK
#define PHMASK 0xffffffffu
#endif
#define IN(k) (lo <= (k) && (k) < hi)
#define EN(j) ((PHMASK >> (j)) & 1u)
#ifndef REPEAT_ID
#define REPEAT_ID -1
#endif
#define REP(id) for (int rep_ = 0; rep_ < ((REPEAT_ID == (id)) ? 2 : 1); ++rep_)
#if defined(DEBUG_TS_A)
#ifndef DEBUG_TS_Q
#define DEBUG_TS_Q 4.0f
#endif
#ifndef DEBUG_TS_SHIFT
#define DEBUG_TS_SHIFT 0.0f
#endif
#define TS_STORE(k) do { if (c.bid == 0 && c.wave == 0) ((unsigned long long*)(c.ws + WS_CTL + 768 * 1024))[(k)] = __builtin_amdgcn_s_memrealtime(); } while (0)
#else
#define TS_STORE(k) do {} while (0)
#endif
#define SEAM(k) do { if (IN((k) + 1)) { GRID_BAR(); if (REPEAT_ID == 99) GRID_BAR(); } TS_STORE((k) + 1); } while (0)
#define PHASE_CTX() Ctx pc = c; { int z_ = 0, b_ = c.bid, g_ = c.G, w_ = c.wave; asm volatile("" : "+s"(z_), "+s"(b_), "+s"(g_), "+s"(w_)); \
        z_ = __builtin_amdgcn_readfirstlane(z_); b_ = __builtin_amdgcn_readfirstlane(b_); g_ = __builtin_amdgcn_readfirstlane(g_); w_ = __builtin_amdgcn_readfirstlane(w_); \
        pc.in = c.in + z_; pc.ws = c.ws + z_; pc.out = c.out + z_; pc.bid = b_; pc.G = g_; pc.wave = w_ & 7; \
        pc.lane = (int)(__builtin_amdgcn_mbcnt_hi(~0u, __builtin_amdgcn_mbcnt_lo(~0u, (unsigned)z_)) & 63u); pc.tid = pc.wave * 64 + pc.lane; } const int gw = pc.bid * NWAVES + pc.wave; const int NGW = pc.G * NWAVES; (void)gw; (void)NGW

    TS_STORE(0);
    if (EN(0) && IN(0)) { PHASE_CTX(); REP(0) phase_pre_a(pc); SEAM(0); }
    if (EN(1) && IN(1)) { PHASE_CTX(); REP(1) phase_modulate_mix(pc, 0); SEAM(1); }
#pragma unroll 1
    for (int l = 0; l < 2; ++l) {
        const int p0 = 2 + 11 * l; const bool first = (l == 0); const int nMa = first ? 68 : 64;
#define PHASE_PTRS() PHASE_CTX(); unsigned char* wt = pc.ws + WS_WT + (size_t)l * WT_LAYER; bf16_t* Z = (bf16_t*)(pc.ws + WS_RA); bf16_t* H = (bf16_t*)(pc.ws + WS_H); (void)wt; (void)Z; (void)H
        if (EN(2) && IN(p0 + 0)) { REP(20 + 0) { PHASE_PTRS();
            pg8::Gemm g{H, (const bf16_t*)(wt + WT_IN), D, D, D, 0, 0}; pg8::GOrder S; S.init(68, 35, 1, pc.G, pc.bid);
            EpiZ E{Z, pc.in[I_BGATE] + l * 3072};
            REP(2) pg8::gemm_phase<EpiZ, pg8::GOrder>(pc.lds, pc.tid, g, S, E); } SEAM(p0 + 0); }
        if (EN(3) && IN(p0 + 1)) { REP(20 + 1) { PHASE_PTRS();
#ifndef NO_G2G3
            REP(3) {
            { pg8::Gemm g{Z + ZCKV, (const bf16_t*)(wt + WT_UKV), NZ, 256, 256, 0, 0}; pg8::GOrder S; S.init(68, 8, 1, pc.G, pc.bid); EpiPlain E{(bf16_t*)(pc.ws + WS_RB + RB_KVRAW), 2048};
              pg8::gemm_phase<EpiPlain, pg8::GOrder>(pc.lds, pc.tid, g, S, E); }
            { pg8::Gemm g{Z + ZCQ, (const bf16_t*)(wt + WT_UQ), NZ, 384, 384, 0, 0}; pg8::GOrder S; S.init(nMa, 6, 1, pc.G, (pc.bid + pc.G - 32 % pc.G) % pc.G); EpiPlain E{(bf16_t*)(pc.ws + WS_RB + RB_QRAW), 1536};
              pg8::gemm_phase<EpiPlain, pg8::GOrder>(pc.lds, pc.tid, g, S, E); }
            }
#endif
#ifndef NO_MIXA
            REP(4) for (int u = (pc.bid + 8) % pc.G; u < nMa * 2 * 8; u += pc.G) mixA_unit(pc, l, u);
#endif
#ifndef NO_B1
            REP(5) for (int u = (pc.bid + pc.G - 184 % pc.G) % pc.G; u < 1088; u += pc.G) gla_b1_unit(pc, l, u);
#endif
            } SEAM(p0 + 1); }
        if (EN(4) && IN(p0 + 2)) { REP(20 + 2) { PHASE_PTRS();
            REP(6) {
                const bool b2wg = (pc.G >= 128) && pc.bid < 64;
                if (pc.tid < 32) *((volatile LAS unsigned*)(pc.lds + 3 * 33280 + 4 * 5120) + pc.tid) = 0u;
                __syncthreads();
                const bool role_b2 = (pc.G >= 128) ? b2wg : true;
                if (role_b2) {
#ifndef SKIP_B2
                    if (pc.G >= 128) gla_b2_unit(pc, pc.bid);
                    else { for (int u = pc.bid; u < 64; u += pc.G) { gla_b2_unit(pc, u); __syncthreads(); if (pc.tid < 32) *((volatile LAS unsigned*)(pc.lds + 3 * 33280 + 4 * 5120) + pc.tid) = 0u; __syncthreads(); } }
#endif
                }
                if (!role_b2 || pc.G < 128) {
#ifndef SKIP_C1
                  int wi, nwv;
                  if (pc.G >= 128) { nwv = (pc.G - 64) * NWAVES; wi = (pc.bid - 64) * NWAVES + pc.wave; }
                  else { nwv = pc.G * NWAVES; wi = pc.bid * NWAVES + pc.wave; }
                  if (wi < T) { C1Raw A = {}, B = {}; mla_c1_load(pc, wi, first || wi < TL, A);
                      for (int row = wi; row < T; row += 2 * nwv) { const int r1 = row + nwv, r2 = row + 2 * nwv;
                          if (r1 < T) mla_c1_load(pc, r1, first || r1 < TL, B);
                          mla_c1_row(pc, l, row, first || row < TL, A);
                          if (r2 < T) mla_c1_load(pc, r2, first || r2 < TL, A);
                          if (r1 < T) mla_c1_row(pc, l, r1, first || r1 < TL, B); } }
#endif
                }
            }
            } SEAM(p0 + 2); }
        if (EN(5) && IN(p0 + 3)) { REP(20 + 3) { PHASE_PTRS();
#ifndef NO_FIN
            REP(7) { const int nrow = nMa * 256; if (gw < nrow) { FinRaw A = {}, B = {}; gla_finish_load(pc, gw, A);
                for (int row = gw; row < nrow; row += 2 * NGW) { const int r1 = row + NGW, r2 = row + 2 * NGW;
                    if (r1 < nrow) gla_finish_load(pc, r1, B);
                    gla_finish_row(pc, l, row, A);
                    if (r2 < nrow) gla_finish_load(pc, r2, A);
                    if (r1 < nrow) gla_finish_row(pc, l, r1, B); } } }
#endif
            bf16_t* Y = (bf16_t*)(pc.ws + WS_RB + RB_YCAT) + 2048;
            const bf16_t* KG = (const bf16_t*)(pc.ws + WS_RB + RB_KG); const bf16_t* VG = (const bf16_t*)(pc.ws + WS_RB + RB_VG);
            const int G8 = pc.G >> 3;
            REP(8) for (int i = 0;; ++i) {
                int un; if ((pc.G & 7) == 0 && (G8 & 15) == 0) { const int x = pc.bid & 7, s = pc.bid >> 3, ppx = G8 >> 4; un = ((i * 8 * ppx) + x * ppx + (s >> 4)) * 16 + (s & 15); } else un = i * pc.G + pc.bid;
                if (un >= 512) break;
                const int bh = un >> 4, qb = un & 15, b = bh >> 3, h = bh & 7;
                attn_unit(pc, (const bf16_t*)(pc.ws + WS_RB + RB_QFL) + ((size_t)(b * SEQ + qb * 256) * 8 + h) * 192, KG + ((size_t)b * NKEY * 8 + h) * 192, VG + ((size_t)b * NKEY * 8 + h) * 128, 68, Y + (size_t)(b * SEQ + qb * 256) * 3072 + h * 128); }
            if (first) for (int un = pc.bid; un < 32; un += pc.G) { const int b = un >> 3, h = un & 7;
                attn_unit(pc, (const bf16_t*)(pc.ws + WS_RB + RB_QFC) + ((size_t)b * CTXL * 8 + h) * 192, KG + ((size_t)b * NKEY * 8 + h) * 192, VG + ((size_t)b * NKEY * 8 + h) * 128, 4, Y + (size_t)(TL + b * CTXL) * 3072 + h * 128); }
            } SEAM(p0 + 3); }
        if (EN(6) && IN(p0 + 4)) { REP(20 + 4) { PHASE_PTRS();
            pg8::Gemm g{(const bf16_t*)(pc.ws + WS_RB + RB_YCAT), (const bf16_t*)(wt + WT_M), 3072, 3072, 3072, 0, 0}; pg8::GOrder S; S.init(64, 4, 1, pc.G, pc.bid);
            EpiMerge E{(bf16_t*)(pc.ws + WS_RB + RB_MERGED), Z};
            REP(9) pg8::gemm_phase<EpiMerge, pg8::GOrder>(pc.lds, pc.tid, g, S, E);
            if (first) for (int u = pc.bid; u < 256; u += pc.G) ctx_merge_unit(pc, l, u); } SEAM(p0 + 4); }
        if (EN(7) && IN(p0 + 5)) { REP(20 + 5) { PHASE_PTRS();
            pg8::Gemm g{(const bf16_t*)(pc.ws + WS_RB + RB_MERGED), (const bf16_t*)(wt + WT_OUT), D, D, D, 0, 0}; pg8::GOrder S; S.init(64, 4, 1, pc.G, pc.bid);
            EpiResid E{&pc, l, (REPEAT_ID == 25 && rep_ == 0) ? (float*)(pc.ws + WS_RA) : nullptr};
            pg8::gemm_phase<EpiResid, pg8::GOrder>(pc.lds, pc.tid, g, S, E);
            if (first) for (int u = pc.bid; u < 256; u += pc.G) ctx_out_unit(pc, l, u); } SEAM(p0 + 5); }
        if (EN(8) && IN(p0 + 6)) { REP(20 + 6) { PHASE_PTRS();
            REP(11) { route_stage_w(pc, l); const int nrow = nMa * 256;
                if (gw < nrow) { RouteRaw A = {}, B = {}; route_load(pc, gw, A);
                    for (int row = gw; row < nrow; row += 2 * NGW) { const int r1 = row + NGW, r2 = row + 2 * NGW;
                        if (r1 < nrow) route_load(pc, r1, B);
                        route_row(pc, l, row, A);
                        if (r2 < nrow) route_load(pc, r2, A);
                        if (r1 < nrow) route_row(pc, l, r1, B); } }
                __syncthreads(); }
            } SEAM(p0 + 6); }
        if (EN(9) && IN(p0 + 7)) { REP(20 + 7) { PHASE_PTRS();
            REP(13) for (int u = pc.bid; u < 64; u += pc.G) topk_unit(pc, u, false);
            if (first) for (int u = pc.bid; u < 64; u += pc.G) topk_unit(pc, u, true);
            REP(12) expert_wconv(pc, l);
            } SEAM(p0 + 7); }
        if (EN(10) && IN(p0 + 8)) { REP(20 + 8) { PHASE_PTRS();
            pg8::Gemm g{(const bf16_t*)(pc.ws + WS_RA + RA_XS), (const bf16_t*)(pc.ws + WS_RB + RB_WGU), D, D, D, (size_t)ESLOTS * D, (size_t)4096 * D}; pg8::GOrder S; S.init(first ? 9 : 8, 16, 16, pc.G, pc.bid);
            EpiSwiGLU E{(bf16_t*)(pc.ws + WS_RA + RA_HID)};
            REP(14) pg8::gemm_phase<EpiSwiGLU, pg8::GOrder>(pc.lds, pc.tid, g, S, E); } SEAM(p0 + 8); }
        if (EN(11) && IN(p0 + 9)) { REP(20 + 9) { PHASE_PTRS();
            pg8::Gemm g{(const bf16_t*)(pc.ws + WS_RA + RA_HID), (const bf16_t*)(pc.ws + WS_RB + RB_WD), DEXP, DEXP, DEXP, (size_t)ESLOTS * DEXP, (size_t)D * DEXP}; pg8::GOrder S; S.init(first ? 9 : 8, 4, 16, pc.G, pc.bid);
            EpiDown E{(bf16_t*)(pc.ws + WS_RA + RA_YS), (const float*)(pc.ws + WS_GATEV)};
            REP(15) pg8::gemm_phase<EpiDown, pg8::GOrder>(pc.lds, pc.tid, g, S, E); } SEAM(p0 + 9); }
        if (EN(12) && IN(p0 + 10)) { REP(20 + 10) { PHASE_PTRS();
            { const int nrow = nMa * 256; float* dmy = (REPEAT_ID == 30 && rep_ == 0) ? (float*)(pc.ws + WS_RB) : nullptr;
              if (gw < nrow) { CombRaw A = {}, B = {}; combine_load(pc, gw, A);
                  for (int row = gw; row < nrow; row += 2 * NGW) { const int r1 = row + NGW, r2 = row + 2 * NGW;
                      if (r1 < nrow) combine_load(pc, r1, B);
                      combine_row(pc, l, row, first, A, dmy);
                      if (r2 < nrow) combine_load(pc, r2, A);
                      if (r1 < nrow) combine_row(pc, l, r1, first, B, dmy); } } }
            } SEAM(p0 + 10); }
    }
#if defined(DEBUG_TS_A)
    { GRID_BAR(); const unsigned long long* ts = (const unsigned long long*)(c.ws + WS_CTL + 768 * 1024);
      float a = (float)(__hip_atomic_load(ts + DEBUG_TS_A + 1, __ATOMIC_RELAXED, __HIP_MEMORY_SCOPE_AGENT) - __hip_atomic_load(ts + DEBUG_TS_A, __ATOMIC_RELAXED, __HIP_MEMORY_SCOPE_AGENT)) * 1e-2f;
      float b = (float)(__hip_atomic_load(ts + DEBUG_TS_B + 1, __ATOMIC_RELAXED, __HIP_MEMORY_SCOPE_AGENT) - __hip_atomic_load(ts + DEBUG_TS_B, __ATOMIC_RELAXED, __HIP_MEMORY_SCOPE_AGENT)) * 1e-2f;
      a = exp2f(rintf(log2f(fmaxf(a, 1.f)) * DEBUG_TS_Q + DEBUG_TS_SHIFT) / DEBUG_TS_Q) * 1e-2f; b = exp2f(rintf(log2f(fmaxf(b, 1.f)) * DEBUG_TS_Q + DEBUG_TS_SHIFT) / DEBUG_TS_Q) * 1e-2f;
      const int tid_ = c.wave * 64 + (int)__builtin_amdgcn_mbcnt_hi(~0u, __builtin_amdgcn_mbcnt_lo(~0u, 0u));
      for (long i = (long)c.bid * NTHR + tid_; i < (long)TL * D; i += (long)c.G * NTHR) c.out[i] = (i == 0) ? 131072.0f * b : 1024.0f * a; }
#endif
}

extern "C" void kernel_launch(void* const* d_in, const int* in_sizes, int n_in, void* d_out, int out_size, void* d_ws, size_t ws_size, hipStream_t stream) {
    static int grid = 0;
    if (!grid) {
        int dev = 0, cus = 0, per_cu = 0;
        (void)hipGetDevice(&dev); (void)hipDeviceGetAttribute(&cus, hipDeviceAttributeMultiprocessorCount, dev);
        (void)hipFuncSetAttribute((const void*)fwd, hipFuncAttributeMaxDynamicSharedMemorySize, LDS_BYTES);
        (void)hipOccupancyMaxActiveBlocksPerMultiprocessor(&per_cu, fwd, NTHR, LDS_BYTES);
        grid = cus * (per_cu < 1 ? per_cu : 1);
        if (grid <= 0) { fprintf(stderr, "occupancy query returned 0 blocks per CU\n"); grid = cus; }
        if (ws_size < WS_END) fprintf(stderr, "workspace too small: %zu < %zu\n", ws_size, (size_t)WS_END);
    }
    (void)hipMemsetAsync((unsigned char*)d_ws + WS_CTL, 0, CTL_BYTES, stream);
    Args a{}; for (int i = 0; i < N_INPUTS; ++i) a.in[i] = (const float*)d_in[i]; a.out = (float*)d_out; a.ws = (unsigned char*)d_ws;
#if MK_FUSED
    a.ph_lo = 0; a.ph_hi = NPH;
    hipLaunchKernelGGL(fwd, dim3(grid), dim3(NTHR), LDS_BYTES, stream, a);
#else
#if defined(DEBUG_SCAN)
    hipLaunchKernelGGL(k_seterr, dim3(1), dim3(1), 0, stream, (int*)((unsigned char*)d_ws + WS_CTL + 512 * 1024));
#endif
    for (int p = 0; p < NPH; ++p) { a.ph_lo = p; a.ph_hi = p + 1;
#if defined(DEBUG_SCAN)
        if (p == 3) (void)hipMemsetAsync((unsigned char*)d_ws + WS_RB + RB_OINTRA, 0xff, (size_t)T * D * 2, stream);
#endif
        hipLaunchKernelGGL(fwd, dim3(grid), dim3(NTHR), LDS_BYTES, stream, a);
#if defined(DEBUG_SCAN)
#if defined(DEBUG_HASH)
        if (p == DEBUG_HASH_PHASE) { (void)hipMemsetAsync((unsigned char*)d_ws + WS_CTL + 512 * 1024 + 256, 0, 4, stream);
            hipLaunchKernelGGL(k_hash, dim3(512), dim3(256), 0, stream, (const unsigned*)((unsigned char*)d_ws + DEBUG_HASH_OFF), (long)(DEBUG_HASH_BYTES / 4), (unsigned*)((unsigned char*)d_ws + WS_CTL + 512 * 1024 + 256)); }
#else
        debug_after_phase(p, (unsigned char*)d_ws, (float*)d_out, stream);
#endif
#endif
    }
#if defined(DEBUG_SCAN)
#if defined(DEBUG_HASH)
    hipLaunchKernelGGL(k_apply_hash, dim3(1024), dim3(256), 0, stream, (float*)d_out, (long)out_size, (const unsigned*)((unsigned char*)d_ws + WS_CTL + 512 * 1024 + 256));
#elif defined(DEBUG_STAT)
    hipLaunchKernelGGL(k_apply_stat, dim3(1024), dim3(256), 0, stream, (float*)d_out, (long)out_size, (const int*)((unsigned char*)d_ws + WS_CTL + 512 * 1024));
#else
    hipLaunchKernelGGL(k_apply, dim3(1024), dim3(256), 0, stream, (float*)d_out, (long)out_size, (const int*)((unsigned char*)d_ws + WS_CTL + 512 * 1024));
#endif
#endif
#endif
}
```

```cpp
#define MK_FUSED 1
#include <hip/hip_runtime.h>
#include <cstdint>
#include <cstdio>

#define LAS __attribute__((address_space(3)))
#define GAS __attribute__((address_space(1)))
typedef unsigned short bf16_t;
typedef short bf16x8 __attribute__((ext_vector_type(8)));
typedef short bf16x4 __attribute__((ext_vector_type(4)));
typedef float f32x4 __attribute__((ext_vector_type(4)));
typedef float f32x2 __attribute__((ext_vector_type(2)));
typedef float f32x16 __attribute__((ext_vector_type(16)));
typedef unsigned u32x4 __attribute__((ext_vector_type(4)));
typedef unsigned u32x2 __attribute__((ext_vector_type(2)));

typedef __bf16 bf16v2_t __attribute__((ext_vector_type(2)));
__device__ __forceinline__ unsigned cvt_pk_bf16(float lo, float hi) { bf16v2_t v; v[0] = (__bf16)lo; v[1] = (__bf16)hi; return __builtin_bit_cast(unsigned, v); }
__device__ __forceinline__ bf16_t f2bf(float f) { return (bf16_t)(cvt_pk_bf16(f, 0.f) & 0xffffu); }
__device__ __forceinline__ float bf2f(bf16_t b) { return __uint_as_float(((unsigned)b) << 16); }
__device__ __forceinline__ float bflo(unsigned w) { return __uint_as_float(w << 16); }
__device__ __forceinline__ float bfhi(unsigned w) { return __uint_as_float(w & 0xffff0000u); }
template <int K> __device__ __forceinline__ float sx(float v) { static_assert(K >= 1 && K < 32, "xor mask inside a 32-lane half"); return __int_as_float(__builtin_amdgcn_ds_swizzle(__float_as_int(v), (K << 10) | 0x1F)); }
__device__ __forceinline__ float sum32(float v) { auto rr = __builtin_amdgcn_permlane32_swap(__float_as_uint(v), __float_as_uint(v), false, false); return __uint_as_float(rr[0]) + __uint_as_float(rr[1]); }
__device__ __forceinline__ float max32(float v) { auto rr = __builtin_amdgcn_permlane32_swap(__float_as_uint(v), __float_as_uint(v), false, false); return fmaxf(__uint_as_float(rr[0]), __uint_as_float(rr[1])); }
__device__ __forceinline__ float half_sum(float v) { v += sx<1>(v); v += sx<2>(v); v += sx<4>(v); v += sx<8>(v); v += sx<16>(v); return v; }
__device__ __forceinline__ float wave_sum(float v) { return sum32(half_sum(v)); }
__device__ __forceinline__ float bperm(float v, int src) { return __int_as_float(__builtin_amdgcn_ds_bpermute(src << 2, __float_as_int(v))); }
__device__ __forceinline__ unsigned bperm(unsigned v, int src) { return (unsigned)__builtin_amdgcn_ds_bpermute(src << 2, (int)v); }
__device__ __forceinline__ float fast_rcp(float x) { return __builtin_amdgcn_rcpf(x); }
__device__ __forceinline__ float fast_exp(float x) { return __builtin_amdgcn_exp2f(x * 1.4426950408889634f); }
__device__ __forceinline__ float sigmoidf_(float x) { return fast_rcp(1.f + fast_exp(-x)); }
__device__ __forceinline__ float siluf_(float x) { return x * sigmoidf_(x); }

namespace pg8 {
constexpr int BM = 256, BK = 64, HALF = 128, HTB = HALF * BK * 2, STAGE_BYTES = 8 * HTB, NXCD = 8, WGM = 8;
__host__ __device__ __forceinline__ int lds_byte(int r, int c) { const int st = (r >> 4) * 2 + (c >> 5), rr = r & 15, cc = c & 31, ob = rr * 64 + cc * 2; return st * 1024 + (ob ^ (((ob >> 9) & 1) << 5)); }
__host__ __device__ __forceinline__ void stage_rc(int b, int& R, int& C) { const int st = b / 1024, sb = b % 1024, swz = sb ^ (((sb >> 9) & 1) << 5); R = (st >> 1) * 16 + swz / 64; C = (st & 1) * 32 + (swz % 64) / 2; }
__host__ __device__ __forceinline__ int perm32(int rho) { const int n = rho >> 4, i = rho & 15; return 8 * (i >> 2) + 4 * n + (i & 3); }

struct Unit { int pm, pn, g; };
struct Gemm { const bf16_t* A; const bf16_t* Bt; int lda, ldb, K; size_t gstrideA, gstrideB; };

struct GOrder {
    int nM, nN, nG, nwg, G, c, pm0;
    __device__ void init(int nM_, int nN_, int nG_, int G_, int c_, int pm0_ = 0) { nM = nM_; nN = nN_; nG = nG_; nwg = nM * nN * nG; G = G_; c = c_; pm0 = pm0_; }
    __device__ bool next(int i, Unit& u) const {
        const long L = (long)i * G + c; if (L >= nwg) return false;
        int wgid = (int)L; { const int q = nwg / NXCD, r = nwg % NXCD, xcd = wgid % NXCD, off = wgid / NXCD; wgid = (xcd < r ? xcd * (q + 1) : r * (q + 1) + (xcd - r) * q) + off; }
        const int per = nM * nN; u.g = wgid / per; wgid -= u.g * per;
        const int nig = WGM * nN, gid = wgid / nig, fm = gid * WGM, gsz = (nM - fm) < WGM ? (nM - fm) : WGM;
        u.pm = pm0 + fm + ((wgid % nig) % gsz); u.pn = (wgid % nig) / gsz; return true;
    }
};

template <class Epi, class Sched>
__device__ __forceinline__ void gemm_phase(LAS unsigned char* lds, const int tid, const Gemm g, const Sched& S, const Epi& E) {
    const int wid = __builtin_amdgcn_readfirstlane(tid >> 6), lane = tid & 63, wr = wid >> 2, wc = wid & 3, fr = lane & 15, fq = lane >> 4;
    const int K = g.K, nt = K / BK;
    unsigned voffA[2], voffB[2];
#pragma unroll
    for (int i = 0; i < 2; ++i) { int R, C; stage_rc(tid * 16 + i * 8192, R, C); const int Rb = Epi::PERM ? ((R & ~31) + perm32(R & 31)) : R;
        voffA[i] = (unsigned)(R * g.lda + C) * 2u; voffB[i] = (unsigned)(Rb * g.ldb + C) * 2u; }
    const size_t kstep = (size_t)(BK * 2);
    const size_t hstepA = (size_t)HALF * g.lda * 2, hstepB = (size_t)HALF * g.ldb * 2;
    const size_t tstepA = 2 * hstepA, tstepB = 2 * hstepB;
    const unsigned ldsw = (unsigned)wid * 1024u;
    const int aoff = lds_byte(wr * 64 + fr, fq * 8), boff = lds_byte(wc * 32 + fr, fq * 8);
#define PG8_SA(b, h) (((b) * 2 + (h)) * HTB)
#define PG8_SB(b, h) ((4 + (b) * 2 + (h)) * HTB)
#define PG8_STAGE(bufoff, gbase, voff) do { _Pragma("unroll") for (int _i = 0; _i < 2; ++_i) \
        __builtin_amdgcn_global_load_lds((const unsigned*)((const char*)(gbase) + (voff)[_i]), (LAS unsigned*)(lds + (bufoff) + ldsw + _i * 8192), 16, 0, 0); } while (0)
#define PG8_LDA(dst, b, h) do { _Pragma("unroll") for (int m = 0; m < 4; ++m) _Pragma("unroll") for (int k = 0; k < 2; ++k) dst[m][k] = *(const LAS bf16x8*)(lds + PG8_SA(b, h) + aoff + m * 2048 + k * 1024); } while (0)
#define PG8_LDB(dst, b, h) do { _Pragma("unroll") for (int n = 0; n < 2; ++n) _Pragma("unroll") for (int k = 0; k < 2; ++k) dst[n][k] = *(const LAS bf16x8*)(lds + PG8_SB(b, h) + boff + n * 2048 + k * 1024); } while (0)
#define PG8_MMA(ai, bj, At, Bt) do { __builtin_amdgcn_s_setprio(1); _Pragma("unroll") for (int m = 0; m < 4; ++m) _Pragma("unroll") for (int n = 0; n < 2; ++n) _Pragma("unroll") for (int k = 0; k < 2; ++k) \
        acc[ai][bj][m][n] = __builtin_amdgcn_mfma_f32_16x16x32_bf16(Bt[n][k], At[m][k], acc[ai][bj][m][n], 0, 0, 0); __builtin_amdgcn_s_setprio(0); } while (0)
#define PG8_WAIT_V(n) asm volatile("s_waitcnt vmcnt(" #n ")" ::: "memory")
#define PG8_WAIT_L(n) asm volatile("s_waitcnt lgkmcnt(" #n ")" ::: "memory")
#define PG8_BAR __builtin_amdgcn_s_barrier()
#define PG8_SCHED __builtin_amdgcn_sched_barrier(0)
    Unit cur, nxt; int ui = 0;
    if (!S.next(0, cur)) return;
    f32x4 acc[2][2][4][2];
#pragma unroll
    for (int a = 0; a < 2; ++a)
#pragma unroll
        for (int b = 0; b < 2; ++b)
#pragma unroll
            for (int m = 0; m < 4; ++m)
#pragma unroll
                for (int n = 0; n < 2; ++n) acc[a][b][m][n] = (f32x4){0.f, 0.f, 0.f, 0.f};
    bf16x8 At[4][2], B0[2][2], B1[2][2];
    const char* cA = (const char*)(g.A + (size_t)cur.g * g.gstrideA) + (size_t)cur.pm * tstepA; const char* cB = (const char*)(g.Bt + (size_t)cur.g * g.gstrideB) + (size_t)cur.pn * tstepB;
    PG8_STAGE(PG8_SB(0, 0), cB, voffB); PG8_STAGE(PG8_SB(0, 1), cB + hstepB, voffB); PG8_STAGE(PG8_SA(0, 0), cA, voffA); PG8_STAGE(PG8_SA(0, 1), cA + hstepA, voffA);
    if (wr == 1) PG8_BAR;
    PG8_WAIT_V(2); PG8_BAR;
    PG8_STAGE(PG8_SB(1, 0), cB + kstep, voffB); PG8_STAGE(PG8_SA(1, 0), cA + kstep, voffA); PG8_STAGE(PG8_SB(1, 1), cB + hstepB + kstep, voffB);
    PG8_WAIT_V(6); PG8_BAR;
    for (;;) {
        const bool has_next = S.next(ui + 1, nxt);
        const char* nA = has_next ? (const char*)(g.A + (size_t)nxt.g * g.gstrideA) + (size_t)nxt.pm * tstepA : cA; const char* nB = has_next ? (const char*)(g.Bt + (size_t)nxt.g * g.gstrideB) + (size_t)nxt.pn * tstepB : cB;
        for (int t = 0; t < nt; t += 2) {
            const bool last = (t == nt - 2);
            const char* a1 = cA + (size_t)(t + 1) * kstep;
            const char* a2 = last ? nA : cA + (size_t)(t + 2) * kstep; const char* b2 = last ? nB : cB + (size_t)(t + 2) * kstep;
            const char* a3 = a2 + kstep; const char* b3 = b2 + kstep;
            if constexpr (Epi::MID) { if (t == 16 || t == 32) E.mid(acc, cur, t, wr, wc, fr, fq); }
            PG8_LDB(B0, 0, 0); PG8_LDB(B1, 0, 1); PG8_SCHED; PG8_LDA(At, 0, 0); PG8_STAGE(PG8_SA(1, 1), a1 + hstepA, voffA);
            PG8_WAIT_V(8); PG8_WAIT_L(0); PG8_BAR; PG8_MMA(0, 0, At, B0); PG8_MMA(0, 1, At, B1); PG8_BAR; PG8_SCHED;
            PG8_LDA(At, 0, 1); PG8_STAGE(PG8_SB(0, 0), b2, voffB); PG8_STAGE(PG8_SB(0, 1), b2 + hstepB, voffB); PG8_STAGE(PG8_SA(0, 0), a2, voffA);
            PG8_WAIT_V(8); PG8_WAIT_L(0); PG8_BAR; PG8_MMA(1, 0, At, B0); PG8_MMA(1, 1, At, B1); PG8_BAR; PG8_SCHED;
            PG8_LDB(B0, 1, 0); PG8_LDB(B1, 1, 1); PG8_SCHED; PG8_LDA(At, 1, 0); PG8_STAGE(PG8_SA(0, 1), a2 + hstepA, voffA);
            PG8_WAIT_V(8); PG8_WAIT_L(0); PG8_BAR; PG8_MMA(0, 0, At, B0); PG8_MMA(0, 1, At, B1); PG8_BAR; PG8_SCHED;
            PG8_LDA(At, 1, 1); PG8_STAGE(PG8_SB(1, 0), b3, voffB); PG8_STAGE(PG8_SB(1, 1), b3 + hstepB, voffB); PG8_STAGE(PG8_SA(1, 0), a3, voffA);
            PG8_WAIT_V(8); PG8_WAIT_L(0); PG8_BAR; PG8_MMA(1, 0, At, B0); PG8_MMA(1, 1, At, B1); PG8_BAR; PG8_SCHED;
        }
        if (wr == 0) PG8_BAR;
        E(acc, cur, wr, wc, fr, fq);
        if (!has_next) break;
#pragma unroll
        for (int a = 0; a < 2; ++a)
#pragma unroll
            for (int b = 0; b < 2; ++b)
#pragma unroll
                for (int m = 0; m < 4; ++m)
#pragma unroll
                    for (int n = 0; n < 2; ++n) acc[a][b][m][n] = (f32x4){0.f, 0.f, 0.f, 0.f};
        cur = nxt; cA = nA; cB = nB; ++ui;
        if (wr == 1) PG8_BAR;
    }
    PG8_WAIT_V(0);
    PG8_BAR;
#undef PG8_SA
#undef PG8_SB
#undef PG8_STAGE
#undef PG8_LDA
#undef PG8_LDB
#undef PG8_MMA
#undef PG8_WAIT_V
#undef PG8_WAIT_L
#undef PG8_BAR
#undef PG8_SCHED
}
}
#define XB_TMO      128
#define XB_XCNT(j)  (256  + 64 * (j))
#define XB_XSUB(j)  (1280 + 64 * (j))
#define XB_XGEN(j)  (2304 + 64 * (j))
#define XB_TOP      3328
#define XB_TOPGEN   3392
#define XCD_BAR_WORDS 3456
#define XB_SPIN_CAP (1u << 18)

__device__ __forceinline__ unsigned xb_ld(unsigned* p)              { return __hip_atomic_load(p, __ATOMIC_RELAXED, __HIP_MEMORY_SCOPE_AGENT); }
__device__ __forceinline__ unsigned xb_add(unsigned* p, unsigned v) { return __hip_atomic_fetch_add(p, v, __ATOMIC_RELAXED, __HIP_MEMORY_SCOPE_AGENT); }
__device__ __forceinline__ unsigned xb_xcc_id() { return (unsigned)__builtin_amdgcn_s_getreg((3 << 11) | 20) & 0xFu; }
#define XB_SPIN(cond, bar) do { unsigned _sp = 0; while (cond) { __builtin_amdgcn_s_sleep(1); \
    if ((++_sp & 255u) == 0u) { if (xb_ld(&(bar)[XB_TMO])) break; if (_sp > XB_SPIN_CAP) { atomicAdd(&(bar)[XB_TMO], 1u); break; } } } } while (0)

struct XcdBarrier {
    unsigned* bar; unsigned x;
    volatile LAS unsigned* st;
};

__device__ __forceinline__ XcdBarrier xcd_barrier_post(unsigned* bar, volatile LAS unsigned* st) {
    XcdBarrier b; b.bar = bar; b.x = xb_xcc_id(); b.st = st;
    if (threadIdx.x == 0) (void)xb_add(&bar[XB_XCNT(b.x)], 1u);
    return b;
}
__device__ __forceinline__ void xcd_barrier_complete(unsigned* bar, unsigned x, unsigned& nloc, unsigned& nx) {
    const unsigned G = gridDim.x * gridDim.y * gridDim.z;
    unsigned sum, cnt, mine, sp = 0u;
    for (;;) {
        sum = 0u; cnt = 0u; mine = 0u;
#pragma unroll
        for (unsigned j = 0; j < 16; ++j) { const unsigned c = xb_ld(&bar[XB_XCNT(j)]); sum += c; cnt += (c > 0u) ? 1u : 0u; mine = (j == x) ? c : mine; }
        if (sum == G) break;
        __builtin_amdgcn_s_sleep(1);
        if ((++sp & 255u) == 0u) { if (xb_ld(&bar[XB_TMO])) break; if (sp > XB_SPIN_CAP) { atomicAdd(&bar[XB_TMO], 1u); break; } }
    }
    nloc = mine > 0u ? mine : 1u; nx = cnt > 0u ? cnt : 1u;
}

__device__ __forceinline__ void xcd_barrier(const XcdBarrier& b) {
    asm volatile("s_waitcnt vmcnt(0)" ::: "memory");
    __syncthreads();
    unsigned long long bp_ = (unsigned long long)b.bar; unsigned bx_ = b.x; asm volatile("" : "+s"(bp_), "+s"(bx_)); bx_ = (unsigned)__builtin_amdgcn_readfirstlane((int)bx_); bp_ = ((unsigned long long)(unsigned)__builtin_amdgcn_readfirstlane((int)(bp_ >> 32)) << 32) | (unsigned)__builtin_amdgcn_readfirstlane((int)bp_);
    if (threadIdx.x == 0) {
        unsigned* bar = (unsigned*)bp_;
        __builtin_amdgcn_s_waitcnt(0);
        unsigned nloc = b.st[0], nx = b.st[1];
        if (nloc == 0u) { xcd_barrier_complete(bar, bx_, nloc, nx); b.st[0] = nloc; b.st[1] = nx; }
        const unsigned old = xb_add(&bar[XB_XSUB(bx_)], 1u);
        const unsigned gen = old / nloc;
        if (old + 1u == (gen + 1u) * nloc) {
            __builtin_amdgcn_fence(__ATOMIC_RELEASE, "agent");
            asm volatile("s_waitcnt vmcnt(0)" ::: "memory");
            const unsigned og = xb_add(&bar[XB_TOP], 1u);
            const unsigned tg = og / nx;
            if (og + 1u == (tg + 1u) * nx) xb_add(&bar[XB_TOPGEN], 1u);
            else XB_SPIN(xb_ld(&bar[XB_TOPGEN]) == tg, bar);
            __builtin_amdgcn_fence(__ATOMIC_ACQUIRE, "agent");
            xb_add(&bar[XB_XGEN(bx_)], 1u);
            asm volatile("s_waitcnt vmcnt(0)" ::: "memory");
        } else {
            XB_SPIN(xb_ld(&bar[XB_XGEN(bx_)]) == gen, bar);
            __builtin_amdgcn_fence(__ATOMIC_ACQUIRE, "agent");
            asm volatile("s_waitcnt vmcnt(0)" ::: "memory");
        }
    }
    __syncthreads();
}

namespace cfg {
constexpr int D = 1024, NB = 4, SEQ = 4096, CTXL = 256, TL = NB * SEQ, TC = NB * CTXL, T = TL + TC;
constexpr int NZ = 8960;
constexpr int ZU = 0, ZVA = 1024, ZQB = 2048, ZKB = 2560, ZVB = 3072, ZRB = 4096, ZCQ = 5120, ZKR = 5504, ZDEC = 5568, ZCKV = 5632, ZGT = 5888;
constexpr int NKEY = CTXL + SEQ;
constexpr int NEXP = 16, DEXP = 2048, CAPL = 512, CAPC = 32, ESLOTS = 2304;
constexpr float EPS = 1e-6f;
constexpr int NWAVES = 8, NTHR = 512;
constexpr size_t MiB = 1u << 20;
constexpr size_t WS_CTL = 0, CTL_BYTES = 1 * MiB;
constexpr size_t WS_MOD = 1 * MiB;
constexpr size_t WS_GATEV = WS_MOD + 512 * 1024;
constexpr size_t WS_AFFT = 2 * MiB;
constexpr size_t WS_SEL = 4 * MiB;
constexpr size_t WS_RSQ = 4 * MiB + 1536 * 1024;
constexpr size_t WS_XC = 6 * MiB;
constexpr size_t WS_H = 10 * MiB;
constexpr size_t WS_WT = 44 * MiB, WT_LAYER = 28 * MiB;
constexpr size_t WT_IN = 0, WT_UQ = 17 * MiB + 512 * 1024, WT_UKV = WT_UQ + 1152 * 1024, WT_M = WT_UKV + 1 * MiB, WT_OUT = WT_M + 6 * MiB, WT_S = WT_OUT + 2 * MiB;
static_assert(WT_S + 256 * 1024 <= WT_LAYER, "weights");
constexpr size_t WS_RA = 100 * MiB;
constexpr size_t RA_XS = 0, RA_HID = 72 * MiB, RA_YS = 216 * MiB;
constexpr size_t WS_RB = 398 * MiB;
constexpr size_t RB_YCAT = 0, RB_KVRAW = 102 * MiB, RB_MERGED = 102 * MiB, RB_QRAW = 170 * MiB, RB_KG = 221 * MiB, RB_VG = 272 * MiB, RB_QFL = 306 * MiB, RB_QFC = 354 * MiB,
                 RB_QDF = 357 * MiB, RB_KDT = 391 * MiB, RB_VTG = 425 * MiB, RB_DECAY = 459 * MiB, RB_OINTRA = 461 * MiB, RB_OF = 495 * MiB, RB_OB = 529 * MiB, RB_END = 563 * MiB;
constexpr size_t RB_WGU = 0, RB_WD = 128 * MiB;
constexpr size_t WS_END = WS_RB + RB_END;
constexpr int LDS_BYTES = 147456;
constexpr int LDS_MISC = 145408;
}
using namespace cfg;

enum { I_X = 0, I_C, I_CTX, I_CCTX, I_WMOD, I_BMOD, I_GMIX, I_GFFN, I_WIN, I_BGATE, I_WS, I_BS, I_WDEC, I_BDEC, I_GGLA, I_GCQ, I_GCKV, I_WUQ, I_WUKV,
       I_GQN, I_GQR, I_GKN, I_GKR, I_WPA, I_WPB, I_WPC, I_WOUT, I_WROUTER, I_WEG, I_WEU, I_WED, N_INPUTS };

struct Args { const float* in[N_INPUTS]; float* out; unsigned char* ws; int ph_lo, ph_hi; };

struct Ctx {
    const float* const* in; float* out; unsigned char* ws; LAS unsigned char* lds;
    int tid, lane, wave, G, bid;
};
__device__ __forceinline__ int row_modidx(int row) { return row < TL ? (row >> 12) : 4; }
__device__ __forceinline__ const float* modp(const Ctx& c, int l, int bi, int which) { return (const float*)(c.ws + WS_MOD) + ((size_t)(l * 5 + bi) * 6 + which) * D; }
__device__ __forceinline__ const float* xin_row(const Ctx& c, int l, int row) {
    if (row < TL) return (l == 0 ? c.in[I_X] : (const float*)c.out) + (size_t)row * D;
    return (l == 0 ? c.in[I_CTX] : (const float*)(c.ws + WS_XC)) + (size_t)(row - TL) * D;
}
__device__ __forceinline__ float* xout_row(const Ctx& c, int row) {
    if (row < TL) return c.out + (size_t)row * D;
    return (float*)(c.ws + WS_XC) + (size_t)(row - TL) * D;
}

#if defined(DEBUG_STAT)
__device__ __forceinline__ void dbg_max(const Ctx& c, int slot, float v) { v = fabsf(v); if (!(v < 1e30f)) v = 1e30f; atomicMax((unsigned*)(c.ws + WS_CTL + 512 * 1024) + 16 * slot, __float_as_uint(v)); }
#else
__device__ __forceinline__ void dbg_max(const Ctx&, int, float) {}
#endif
__device__ __forceinline__ void tconv_tile(const Ctx& c, const float* src, int ld_src, int k0, int c0, int nvalid, const float* kscale, bf16_t* dst, int ld_dst, int r0, int kd0) {
    LAS float* scr = (LAS float*)c.lds;
    const int tid = c.tid;
#pragma unroll
    for (int p = 0; p < 8; ++p) { const int k = p * 8 + (tid >> 6), n = tid & 63;
        float v = (n < nvalid) ? src[(size_t)(k0 + k) * ld_src + c0 + n] : 0.f; if (kscale) v *= kscale[k0 + k];
        scr[n * 65 + k] = v; }
    __syncthreads();
    { const int n = tid >> 3, kc = (tid & 7) * 8; const LAS float* s = scr + n * 65 + kc;
      u32x4 o; o.x = cvt_pk_bf16(s[0], s[1]); o.y = cvt_pk_bf16(s[2], s[3]); o.z = cvt_pk_bf16(s[4], s[5]); o.w = cvt_pk_bf16(s[6], s[7]);
      *(u32x4*)(dst + (size_t)(r0 + n) * ld_dst + kd0 + kc) = o; }
    __syncthreads();
}
template <class RowMap>
__device__ __forceinline__ void tconv_tile4(const Ctx& c, const float* src, int ld_src, int k0, int n0, bf16_t* dst, int ld_dst, int kd0, const RowMap& rowmap) {
    LAS float* scr = (LAS float*)c.lds;
    const int tid = c.tid; float v[4][8];
#pragma unroll
    for (int q = 0; q < 4; ++q)
#pragma unroll
        for (int p = 0; p < 8; ++p) { const int k = p * 8 + (tid >> 6), n = tid & 63; v[q][p] = src[(size_t)(k0 + k) * ld_src + n0 + q * 64 + n]; }
#pragma unroll
    for (int q = 0; q < 4; ++q)
#pragma unroll
        for (int p = 0; p < 8; ++p) { const int k = p * 8 + (tid >> 6), n = tid & 63; scr[(q * 64 + n) * 65 + k] = v[q][p]; }
    __syncthreads();
#pragma unroll
    for (int q = 0; q < 4; ++q) { const int n = tid >> 3, kc = (tid & 7) * 8; const LAS float* s = scr + (q * 64 + n) * 65 + kc;
      u32x4 o; o.x = cvt_pk_bf16(s[0], s[1]); o.y = cvt_pk_bf16(s[2], s[3]); o.z = cvt_pk_bf16(s[4], s[5]); o.w = cvt_pk_bf16(s[6], s[7]);
      *(u32x4*)(dst + (size_t)rowmap(n0 + q * 64 + n) * ld_dst + kd0 + kc) = o; }
    __syncthreads();
}
__device__ __forceinline__ void win_map(int r0, int& src, int& nvalid) {
    nvalid = 64;
    if (r0 < 5120) src = r0; else if (r0 < 5504) src = 5152 + (r0 - 5120); else if (r0 == 5504) src = 5792;
    else if (r0 == 5568) { src = 5120; nvalid = 32; } else if (r0 < 5888) src = 5536 + (r0 - 5632); else src = 5856 + (r0 - 5888);
}
__device__ __forceinline__ void phase_pre_a(const Ctx& c) {
    constexpr int U_IN = 140 * 16, U_UQ = 6 * 24, U_UKV = 4 * 32, U_M = 3 * 256, U_OUT = 256, U_S = 32, U_LAYER = U_IN + U_UQ + U_UKV + U_M + U_OUT + U_S, U_MOD = 192;
    for (int u = c.bid; u < 2 * U_LAYER + U_MOD; u += c.G) {
        if (u >= 2 * U_LAYER) {
            const int cb = u - 2 * U_LAYER, l = cb / 96, n = (cb % 96) * 64 + c.lane;
            const float* wm = c.in[I_WMOD] + (size_t)l * D * 6144; float a[5] = {0.f, 0.f, 0.f, 0.f, 0.f};
            for (int kk = 0; kk < 128; ++kk) { const int k = c.wave * 128 + kk; const float w = wm[(size_t)k * 6144 + n];
#pragma unroll
                for (int i = 0; i < 5; ++i) { const float cv = (i < 4) ? c.in[I_C][i * D + k] : c.in[I_CCTX][k]; a[i] += siluf_(cv) * w; } }
            LAS float* red = (LAS float*)c.lds;
#pragma unroll
            for (int i = 0; i < 5; ++i) red[(c.wave * 5 + i) * 64 + c.lane] = a[i];
            __syncthreads();
            if (c.tid < 320) { const int i = c.tid >> 6, ln = c.tid & 63; float s = 0.f;
#pragma unroll
                for (int w = 0; w < 8; ++w) s += red[(w * 5 + i) * 64 + ln];
                const int nn = (cb % 96) * 64 + ln;
                ((float*)(c.ws + WS_MOD))[(size_t)(l * 5 + i) * 6144 + nn] = s + c.in[I_BMOD][l * 6144 + nn]; }
            __syncthreads();
            continue;
        }
        const int l = u / U_LAYER; int r = u % U_LAYER; unsigned char* wt = c.ws + WS_WT + (size_t)l * WT_LAYER;
        if (r < U_IN) { const int nb = r / 16, kb = r % 16; int src, nv; win_map(nb * 64, src, nv);
            tconv_tile(c, c.in[I_WIN] + (size_t)l * D * 8928, 8928, kb * 64, src, nv, nullptr, (bf16_t*)(wt + WT_IN), D, nb * 64, kb * 64); continue; } r -= U_IN;
        if (r < U_UQ) { const int nb = r / 6, kb = r % 6;
            tconv_tile(c, c.in[I_WUQ] + (size_t)l * 384 * 1536, 1536, kb * 64, nb * 64, 64, c.in[I_GCQ] + l * 384, (bf16_t*)(wt + WT_UQ), 384, nb * 64, kb * 64); continue; } r -= U_UQ;
        if (r < U_UKV) { const int nb = r / 4, kb = r % 4;
            tconv_tile(c, c.in[I_WUKV] + (size_t)l * 256 * 2048, 2048, kb * 64, nb * 64, 64, c.in[I_GCKV] + l * 256, (bf16_t*)(wt + WT_UKV), 256, nb * 64, kb * 64); continue; } r -= U_UKV;
        if (r < U_M) { const int which = r / 256, rr = r % 256, nb = rr / 16, kb = rr % 16;
            const float* src = c.in[which == 0 ? I_WPA : (which == 1 ? I_WPB : I_WPC)] + (size_t)l * D * D;
            tconv_tile(c, src, D, kb * 64, nb * 64, 64, nullptr, (bf16_t*)(wt + WT_M), 3 * D, nb * 64, which * D + kb * 64); continue; } r -= U_M;
        if (r < U_OUT) { const int nb = r / 16, kb = r % 16;
            tconv_tile(c, c.in[I_WOUT] + (size_t)l * D * D, D, kb * 64, nb * 64, 64, nullptr, (bf16_t*)(wt + WT_OUT), D, nb * 64, kb * 64); continue; } r -= U_OUT;
        { const float* s = c.in[I_WS] + (size_t)l * 131072 + (size_t)r * 4096 + c.tid * 8; bf16_t* d = (bf16_t*)(wt + WT_S) + (size_t)r * 4096 + c.tid * 8;
          const f32x4 a = *(const f32x4*)s, b = *(const f32x4*)(s + 4); u32x4 o; o.x = cvt_pk_bf16(a[0], a[1]); o.y = cvt_pk_bf16(a[2], a[3]); o.z = cvt_pk_bf16(b[0], b[1]); o.w = cvt_pk_bf16(b[2], b[3]);
          *(u32x4*)d = o; }
    }
}
__device__ __forceinline__ void modulate_row(const float* xrow, const float* g, const float* shift, const float* scale, bf16_t* hrow, int lane, f32x4 (&hv)[4]) {
    float ss = 0.f;
#pragma unroll
    for (int j = 0; j < 4; ++j) { hv[j] = *(const f32x4*)(xrow + 4 * lane + 256 * j); ss += (hv[j][0] * hv[j][0] + hv[j][1] * hv[j][1]) + (hv[j][2] * hv[j][2] + hv[j][3] * hv[j][3]); }
    const float rstd = 1.0f / sqrtf(wave_sum(ss) * (1.f / D) + EPS);
#pragma unroll
    for (int j = 0; j < 4; ++j) { const int cc = 4 * lane + 256 * j; const f32x4 gv = *(const f32x4*)(g + cc), sc = *(const f32x4*)(scale + cc), sh = *(const f32x4*)(shift + cc);
        hv[j] = hv[j] * rstd * gv * (sc + 1.0f) + sh;
        u32x2 o; o.x = cvt_pk_bf16(hv[j][0], hv[j][1]); o.y = cvt_pk_bf16(hv[j][2], hv[j][3]); *(u32x2*)(hrow + cc) = o; }
}
__device__ __forceinline__ void phase_modulate_mix(const Ctx& c, int l) {
    const int gw = c.bid * NWAVES + c.wave, NGW = c.G * NWAVES;
    for (int row = gw; row < T; row += NGW) { const int bi = row_modidx(row); f32x4 hv[4];
        modulate_row(xin_row(c, l, row), c.in[I_GMIX] + l * D, modp(c, l, bi, 0), modp(c, l, bi, 1), (bf16_t*)(c.ws + WS_H) + (size_t)row * D, c.lane, hv); }
}
struct EpiZ { static constexpr bool PERM = true, MID = false; bf16_t* Z; const float* bgate;
    __device__ __forceinline__ void operator()(const f32x4 (&acc)[2][2][4][2], const pg8::Unit& u, int wr, int wc, int fr, int fq) const {
        int row0 = u.pm * 256 + wr * 64 + fr; asm volatile("" : "+v"(row0)); const int col0 = u.pn * 256 + wc * 32 + 8 * fq;
        const int mode = (u.pn >= 23) ? 3 : ((u.pn >= 16 && u.pn < 20) ? 2 : ((u.pn == 8 || u.pn == 9) ? 1 : 0));
        const int gcol = (mode == 3) ? (col0 - ZGT) : 0; const float bm = (mode == 3) ? 1.f : 0.f;
        f32x4 bv[2][2];
#pragma unroll
        for (int bj = 0; bj < 2; ++bj)
#pragma unroll
            for (int n = 0; n < 2; ++n) bv[bj][n] = *(const f32x4*)(bgate + (gcol + bj * 128 + 4 * n)) * bm;
#pragma unroll
        for (int ai = 0; ai < 2; ++ai)
#pragma unroll
            for (int m = 0; m < 4; ++m) { bf16_t* rowp = Z + (size_t)(row0 + ai * 128 + m * 16) * NZ + col0;
#pragma unroll
                for (int bj = 0; bj < 2; ++bj) { f32x4 v0 = acc[ai][bj][m][0] + bv[bj][0], v1 = acc[ai][bj][m][1] + bv[bj][1];
                    if (mode == 1) { v0 = v0 * 0.08838834764831845f; v1 = v1 * 0.08838834764831845f; }
                    else if (mode == 2) {
#pragma unroll
                        for (int e = 0; e < 4; ++e) { v0[e] = siluf_(v0[e]); v1[e] = siluf_(v1[e]); } }
                    else if (mode == 3) {
#pragma unroll
                        for (int e = 0; e < 4; ++e) { v0[e] = fmaxf(sigmoidf_(v0[e]), 1e-20f); v1[e] = fmaxf(sigmoidf_(v1[e]), 1e-20f); } }
                    u32x4 w; w.x = cvt_pk_bf16(v0[0], v0[1]); w.y = cvt_pk_bf16(v0[2], v0[3]); w.z = cvt_pk_bf16(v1[0], v1[1]); w.w = cvt_pk_bf16(v1[2], v1[3]);
                    *(u32x4*)(rowp + bj * 128) = w; } }
    }
};
struct EpiPlain { static constexpr bool PERM = true, MID = false; bf16_t* O; int ldc;
    __device__ __forceinline__ void operator()(const f32x4 (&acc)[2][2][4][2], const pg8::Unit& u, int wr, int wc, int fr, int fq) const {
        int row0 = u.pm * 256 + wr * 64 + fr; asm volatile("" : "+v"(row0)); const int col0 = u.pn * 256 + wc * 32 + 8 * fq;
#pragma unroll
        for (int ai = 0; ai < 2; ++ai)
#pragma unroll
            for (int m = 0; m < 4; ++m) { bf16_t* rowp = O + (size_t)(row0 + ai * 128 + m * 16) * ldc + col0;
#pragma unroll
                for (int bj = 0; bj < 2; ++bj) { const f32x4 v0 = acc[ai][bj][m][0], v1 = acc[ai][bj][m][1];
                    u32x4 w; w.x = cvt_pk_bf16(v0[0], v0[1]); w.y = cvt_pk_bf16(v0[2], v0[3]); w.z = cvt_pk_bf16(v1[0], v1[1]); w.w = cvt_pk_bf16(v1[2], v1[3]);
                    *(u32x4*)(rowp + bj * 128) = w; } }
    }
};
struct EpiMerge { static constexpr bool PERM = true, MID = true; bf16_t* O; const bf16_t* Z;
    __device__ __forceinline__ void ld8(const bf16_t* p, float (&g)[8]) const { const u32x4 w = *(const u32x4*)p; g[0] = bflo(w.x); g[1] = bfhi(w.x); g[2] = bflo(w.y); g[3] = bfhi(w.y); g[4] = bflo(w.z); g[5] = bfhi(w.z); g[6] = bflo(w.w); g[7] = bfhi(w.w); }
    __device__ __forceinline__ void mid(f32x4 (&acc)[2][2][4][2], const pg8::Unit& u, int t, int wr, int wc, int fr, int fq) const {
        int row0 = u.pm * 256 + wr * 64 + fr; asm volatile("" : "+v"(row0)); const int col0 = u.pn * 256 + wc * 32 + 8 * fq; const int seg = (t == 16) ? 0 : 1;
#pragma unroll
        for (int ai = 0; ai < 2; ++ai)
#pragma unroll
            for (int m = 0; m < 4; ++m) { const bf16_t* gp = Z + (size_t)(row0 + ai * 128 + m * 16) * NZ + ZGT + seg * D + col0;
#pragma unroll
                for (int bj = 0; bj < 2; ++bj) { float ga[8], gb[8]; ld8(gp + bj * 128, ga); ld8(gp + D + bj * 128, gb);
#pragma unroll
                    for (int e = 0; e < 4; ++e) { acc[ai][bj][m][0][e] *= ga[e] * fast_rcp(gb[e]); acc[ai][bj][m][1][e] *= ga[4 + e] * fast_rcp(gb[4 + e]); } }
                __builtin_amdgcn_sched_barrier(0); }
    }
    __device__ __forceinline__ void operator()(const f32x4 (&acc)[2][2][4][2], const pg8::Unit& u, int wr, int wc, int fr, int fq) const {
        int row0 = u.pm * 256 + wr * 64 + fr; asm volatile("" : "+v"(row0)); const int col0 = u.pn * 256 + wc * 32 + 8 * fq;
#pragma unroll
        for (int ai = 0; ai < 2; ++ai)
#pragma unroll
            for (int m = 0; m < 4; ++m) { const size_t r = (size_t)(row0 + ai * 128 + m * 16); const bf16_t* gp = Z + r * NZ + ZGT + 2 * D + col0; bf16_t* rowp = O + r * D + col0;
#pragma unroll
                for (int bj = 0; bj < 2; ++bj) { float gc[8]; ld8(gp + bj * 128, gc); const f32x4 v0 = acc[ai][bj][m][0], v1 = acc[ai][bj][m][1];
                    u32x4 w; w.x = cvt_pk_bf16(v0[0] * gc[0], v0[1] * gc[1]); w.y = cvt_pk_bf16(v0[2] * gc[2], v0[3] * gc[3]); w.z = cvt_pk_bf16(v1[0] * gc[4], v1[1] * gc[5]); w.w = cvt_pk_bf16(v1[2] * gc[6], v1[3] * gc[7]);
                    *(u32x4*)(rowp + bj * 128) = w; }
                __builtin_amdgcn_sched_barrier(0); }
    }
};
struct EpiResid { static constexpr bool PERM = false, MID = false; const Ctx* c; int l; float* dummy;
    __device__ __forceinline__ void operator()(const f32x4 (&acc)[2][2][4][2], const pg8::Unit& u, int wr, int wc, int fr, int fq) const {
        int row0 = u.pm * 256 + wr * 64 + fr; asm volatile("" : "+v"(row0)); const int col0 = u.pn * 256 + wc * 32 + 4 * fq; const float* gate = modp(*c, l, row_modidx(u.pm * 256), 2);
        f32x4 gv[2][2];
#pragma unroll
        for (int bj = 0; bj < 2; ++bj)
#pragma unroll
            for (int n = 0; n < 2; ++n) gv[bj][n] = *(const f32x4*)(gate + col0 + bj * 128 + 16 * n);
#pragma unroll
        for (int ai = 0; ai < 2; ++ai)
#pragma unroll
            for (int m = 0; m < 4; ++m) { const int row = row0 + ai * 128 + m * 16; const float* xi = xin_row(*c, l, row) + col0; float* xo = (dummy ? dummy + (size_t)row * D : xout_row(*c, row)) + col0;
#pragma unroll
                for (int bj = 0; bj < 2; ++bj)
#pragma unroll
                    for (int n = 0; n < 2; ++n) { const f32x4 xv = *(const f32x4*)(xi + bj * 128 + 16 * n); *(f32x4*)(xo + bj * 128 + 16 * n) = xv + gv[bj][n] * acc[ai][bj][m][n]; } }
    }
};
struct EpiSwiGLU { static constexpr bool PERM = true, MID = false; bf16_t* HID;
    __device__ __forceinline__ void operator()(const f32x4 (&acc)[2][2][4][2], const pg8::Unit& u, int wr, int wc, int fr, int fq) const {
        int row0 = u.pm * 256 + wr * 64 + fr; asm volatile("" : "+v"(row0)); const int col0 = u.pn * 128 + wc * 32 + 8 * fq; bf16_t* base = HID + (size_t)u.g * ESLOTS * DEXP;
#pragma unroll
        for (int ai = 0; ai < 2; ++ai)
#pragma unroll
            for (int m = 0; m < 4; ++m) { float h[8];
#pragma unroll
                for (int n = 0; n < 2; ++n)
#pragma unroll
                    for (int e = 0; e < 4; ++e) h[4 * n + e] = siluf_(acc[ai][0][m][n][e]) * acc[ai][1][m][n][e];
                u32x4 w; w.x = cvt_pk_bf16(h[0], h[1]); w.y = cvt_pk_bf16(h[2], h[3]); w.z = cvt_pk_bf16(h[4], h[5]); w.w = cvt_pk_bf16(h[6], h[7]);
                *(u32x4*)(base + (size_t)(row0 + ai * 128 + m * 16) * DEXP + col0) = w; }
    }
};
struct EpiDown { static constexpr bool PERM = true, MID = false; bf16_t* YS; const float* gatev;
    __device__ __forceinline__ void operator()(const f32x4 (&acc)[2][2][4][2], const pg8::Unit& u, int wr, int wc, int fr, int fq) const {
        int row0 = u.pm * 256 + wr * 64 + fr; asm volatile("" : "+v"(row0)); const int col0 = u.pn * 256 + wc * 32 + 8 * fq; bf16_t* base = YS + (size_t)u.g * ESLOTS * D; const float* gp = gatev + u.g * ESLOTS;
#pragma unroll
        for (int ai = 0; ai < 2; ++ai)
#pragma unroll
            for (int m = 0; m < 4; ++m) { const int row = row0 + ai * 128 + m * 16; const float gs = gp[row]; bf16_t* rowp = base + (size_t)row * D + col0;
#pragma unroll
                for (int bj = 0; bj < 2; ++bj) { const f32x4 v0 = acc[ai][bj][m][0] * gs, v1 = acc[ai][bj][m][1] * gs;
                    u32x4 w; w.x = cvt_pk_bf16(v0[0], v0[1]); w.y = cvt_pk_bf16(v0[2], v0[3]); w.z = cvt_pk_bf16(v1[0], v1[1]); w.w = cvt_pk_bf16(v1[2], v1[3]);
                    *(u32x4*)(rowp + bj * 128) = w; } }
    }
};

__device__ __forceinline__ void sg_accum(const bf16_t* A, int lda, const bf16_t* Bt, int ldb, int K, int lane, f32x4 (&acc)[2]) {
    const int lr = lane & 15, lq = lane >> 4; const bf16_t* ap = A + (size_t)lr * lda + 8 * lq; const bf16_t* bp0 = Bt + (size_t)lr * ldb + 8 * lq; const bf16_t* bp1 = bp0 + (size_t)16 * ldb;
    bf16x8 a[2][4], b0[2][4], b1[2][4];
#pragma unroll
    for (int i = 0; i < 4; ++i) { a[0][i] = *(const bf16x8*)(ap + 32 * i); b0[0][i] = *(const bf16x8*)(bp0 + 32 * i); b1[0][i] = *(const bf16x8*)(bp1 + 32 * i); }
#pragma unroll 1
    for (int k = 0; k < K; k += 256) {
#pragma unroll
        for (int i = 0; i < 4; ++i) { a[1][i] = *(const bf16x8*)(ap + k + 128 + 32 * i); b0[1][i] = *(const bf16x8*)(bp0 + k + 128 + 32 * i); b1[1][i] = *(const bf16x8*)(bp1 + k + 128 + 32 * i); }
#pragma unroll
        for (int i = 0; i < 4; ++i) { acc[0] = __builtin_amdgcn_mfma_f32_16x16x32_bf16(a[0][i], b0[0][i], acc[0], 0, 0, 0); acc[1] = __builtin_amdgcn_mfma_f32_16x16x32_bf16(a[0][i], b1[0][i], acc[1], 0, 0, 0); }
        if (k + 256 < K) {
#pragma unroll
            for (int i = 0; i < 4; ++i) { a[0][i] = *(const bf16x8*)(ap + k + 256 + 32 * i); b0[0][i] = *(const bf16x8*)(bp0 + k + 256 + 32 * i); b1[0][i] = *(const bf16x8*)(bp1 + k + 256 + 32 * i); } }
#pragma unroll
        for (int i = 0; i < 4; ++i) { acc[0] = __builtin_amdgcn_mfma_f32_16x16x32_bf16(a[1][i], b0[1][i], acc[0], 0, 0, 0); acc[1] = __builtin_amdgcn_mfma_f32_16x16x32_bf16(a[1][i], b1[1][i], acc[1], 0, 0, 0); }
    }
}
__device__ __forceinline__ void ctx_merge_unit(const Ctx& c, int l, int u) {
    const int lane = c.lane, w = c.wave, lr = lane & 15, lq = lane >> 4; const int row0 = TL + 64 * (u >> 4) + 16 * (w >> 1), col0 = 64 * (u & 15) + 32 * (w & 1);
    const bf16_t* Y = (const bf16_t*)(c.ws + WS_RB + RB_YCAT) + (size_t)row0 * 3072; const bf16_t* WM = (const bf16_t*)(c.ws + WS_WT + (size_t)l * WT_LAYER + WT_M) + (size_t)col0 * 3072;
    const bf16_t* Zg = (const bf16_t*)(c.ws + WS_RA) + ZGT; bf16_t* O = (bf16_t*)(c.ws + WS_RB + RB_MERGED);
    f32x4 out[2] = {{0.f, 0.f, 0.f, 0.f}, {0.f, 0.f, 0.f, 0.f}};
#pragma unroll 1
    for (int seg = 0; seg < 3; ++seg) { f32x4 acc[2] = {{0.f, 0.f, 0.f, 0.f}, {0.f, 0.f, 0.f, 0.f}};
        sg_accum(Y + seg * D, 3072, WM + seg * D, 3072, D, lane, acc);
#pragma unroll
        for (int t = 0; t < 2; ++t)
#pragma unroll
            for (int e = 0; e < 4; ++e) out[t][e] += acc[t][e] * bf2f(Zg[(size_t)(row0 + 4 * lq + e) * NZ + seg * D + col0 + 16 * t + lr]); }
#pragma unroll
    for (int t = 0; t < 2; ++t)
#pragma unroll
        for (int e = 0; e < 4; ++e) O[(size_t)(row0 + 4 * lq + e) * D + col0 + 16 * t + lr] = f2bf(out[t][e]);
}
__device__ __forceinline__ void ctx_out_unit(const Ctx& c, int l, int u) {
    const int lane = c.lane, w = c.wave, lr = lane & 15, lq = lane >> 4; const int row0 = TL + 64 * (u >> 4) + 16 * (w >> 1), col0 = 64 * (u & 15) + 32 * (w & 1);
    const bf16_t* A = (const bf16_t*)(c.ws + WS_RB + RB_MERGED) + (size_t)row0 * D; const bf16_t* WO = (const bf16_t*)(c.ws + WS_WT + (size_t)l * WT_LAYER + WT_OUT) + (size_t)col0 * D;
    f32x4 acc[2] = {{0.f, 0.f, 0.f, 0.f}, {0.f, 0.f, 0.f, 0.f}};
    sg_accum(A, D, WO, D, D, lane, acc);
    const float* gate = modp(c, l, 4, 2);
#pragma unroll
    for (int t = 0; t < 2; ++t)
#pragma unroll
        for (int e = 0; e < 4; ++e) { const int row = row0 + 4 * lq + e, col = col0 + 16 * t + lr; xout_row(c, row)[col] = xin_row(c, l, row)[col] + gate[col] * acc[t][e]; }
}
__device__ __forceinline__ void mixA_unit(const Ctx& c, int l, int un) {
    const int cn = un >> 3, g = un & 7; const int row0 = cn * 128;
    const bf16_t* Z = (const bf16_t*)(c.ws + WS_RA); bf16_t* Y = (bf16_t*)(c.ws + WS_RB + RB_YCAT);
    const bf16_t* WSb = (const bf16_t*)(c.ws + WS_WT + (size_t)l * WT_LAYER + WT_S) + g * 16384;
    LAS bf16_t* VT = (LAS bf16_t*)c.lds;
    { const int s = c.tid >> 2, qd = c.tid & 3; const bf16_t* p = Z + (size_t)(row0 + s) * NZ + ZVA + g * 128 + qd * 32;
      float v[32];
#pragma unroll
      for (int i = 0; i < 4; ++i) { const u32x4 w = *(const u32x4*)(p + 8 * i); v[8 * i] = bflo(w.x); v[8 * i + 1] = bfhi(w.x); v[8 * i + 2] = bflo(w.y); v[8 * i + 3] = bfhi(w.y); v[8 * i + 4] = bflo(w.z); v[8 * i + 5] = bfhi(w.z); v[8 * i + 6] = bflo(w.w); v[8 * i + 7] = bfhi(w.w); }
      float sm = 0.f;
#pragma unroll
      for (int i = 0; i < 32; ++i) sm += v[i];
      sm += sx<1>(sm); sm += sx<2>(sm); const float mu = sm * (1.f / 128.f); float sq = 0.f;
#pragma unroll
      for (int i = 0; i < 32; ++i) { v[i] -= mu; sq += v[i] * v[i]; }
      sq += sx<1>(sq); sq += sx<2>(sq); const float rstd = 1.0f / sqrtf(sq * (1.f / 128.f) + EPS);
#pragma unroll
      for (int i = 0; i < 32; ++i) VT[(qd * 32 + i) * 136 + s] = f2bf(v[i] * rstd); }
    __syncthreads();
    const int w = c.wave, lr = c.lane & 15, lq = c.lane >> 4;
    bf16x8 bw[4];
#pragma unroll
    for (int ks = 0; ks < 4; ++ks) bw[ks] = *(const bf16x8*)(WSb + (16 * w + lr) * 128 + 32 * ks + 8 * lq);
    const int t = row0 + 16 * w + lr; const float bs = c.in[I_BS][(l * 8 + g) * 128 + 16 * w + lr];
#pragma unroll
    for (int ct = 0; ct < 8; ++ct) { f32x4 acc = {0.f, 0.f, 0.f, 0.f};
#pragma unroll
        for (int ks = 0; ks < 4; ++ks) { const bf16x8 a = *(const LAS bf16x8*)(VT + (16 * ct + lr) * 136 + 32 * ks + 8 * lq); acc = __builtin_amdgcn_mfma_f32_16x16x32_bf16(a, bw[ks], acc, 0, 0, 0); }
        const int cc = g * 128 + 16 * ct + 4 * lq; const u32x2 uw = *(const u32x2*)(Z + (size_t)t * NZ + ZU + cc);
        u32x2 o; o.x = cvt_pk_bf16(bflo(uw.x) * (acc[0] + bs), bfhi(uw.x) * (acc[1] + bs)); o.y = cvt_pk_bf16(bflo(uw.y) * (acc[2] + bs), bfhi(uw.y) * (acc[3] + bs));
        *(u32x2*)(Y + (size_t)t * 3072 + cc) = o; }
    __syncthreads();
}
__device__ __forceinline__ void gla_b1_unit(const Ctx& c, int l, int un) {
    const int n = un >> 2, h = un & 3, row0 = n * 64, tid = c.tid, lane = c.lane, w = c.wave, lr = lane & 15, lq = lane >> 4;
    const bf16_t* Z = (const bf16_t*)(c.ws + WS_RA);
    LAS bf16_t* VTs = (LAS bf16_t*)c.lds;
    LAS float* Ds = (LAS float*)(c.lds + 36864);
    LAS float* La = (LAS float*)(c.lds + 45056);
    LAS float* Tot = (LAS float*)(c.lds + 78080);
    LAS bf16_t* QD = (LAS bf16_t*)(c.lds + 80128);
    LAS bf16_t* KI = (LAS bf16_t*)(c.lds + 97536);
    LAS bf16_t* Ps = (LAS bf16_t*)(c.lds + 114944);
    LAS bf16_t* KdT = (LAS bf16_t*)(c.lds + 124160);
    { const int t = tid >> 3, cb = (tid & 7) * 32; const bf16_t* p = Z + (size_t)(row0 + t) * NZ + ZVB + h * 256 + cb;
#pragma unroll
      for (int i = 0; i < 4; ++i) { const u32x4 wv = *(const u32x4*)(p + 8 * i); LAS bf16_t* d = VTs + (cb + 8 * i) * 72 + t;
        d[0] = (bf16_t)wv.x; d[72] = (bf16_t)(wv.x >> 16); d[144] = (bf16_t)wv.y; d[216] = (bf16_t)(wv.y >> 16); d[288] = (bf16_t)wv.z; d[360] = (bf16_t)(wv.z >> 16); d[432] = (bf16_t)wv.w; d[504] = (bf16_t)(wv.w >> 16); }
      const int dt = tid >> 3, dc = (tid & 7) * 4; const u32x2 dv = *(const u32x2*)(Z + (size_t)(row0 + dt) * NZ + ZDEC + dc);
      Ds[dt * 32 + dc] = bflo(dv.x); Ds[dt * 32 + dc + 1] = bfhi(dv.x); Ds[dt * 32 + dc + 2] = bflo(dv.y); Ds[dt * 32 + dc + 3] = bfhi(dv.y); }
    __syncthreads();
    f32x4 pacc[2] = {{0.f, 0.f, 0.f, 0.f}, {0.f, 0.f, 0.f, 0.f}};
#pragma unroll 1
    for (int dir = 0; dir < 2; ++dir) {
        { const int cch = 16 * w + lr;
          bf16x8 bfr = {0, 0, 0, 0, 0, 0, 0, 0};
          if (lq < 2) { const float* wd = c.in[I_WDEC] + (size_t)(l * 2 + dir) * 16 * 512 + (size_t)(8 * lq) * 512 + h * 128 + cch; u32x4 pk;
              pk.x = cvt_pk_bf16(wd[0], wd[512]); pk.y = cvt_pk_bf16(wd[1024], wd[1536]); pk.z = cvt_pk_bf16(wd[2048], wd[2560]); pk.w = cvt_pk_bf16(wd[3072], wd[3584]); bfr = __builtin_bit_cast(bf16x8, pk); }
          const float bias = c.in[I_BDEC][(l * 2 + dir) * 512 + h * 128 + cch];
          f32x4 la[4];
#pragma unroll
          for (int tt = 0; tt < 4; ++tt) { bf16x8 afr = {0, 0, 0, 0, 0, 0, 0, 0};
              if (lq < 2) afr = *(const bf16x8*)(Z + (size_t)(row0 + 16 * tt + lr) * NZ + ZDEC + dir * 16 + 8 * lq);
              la[tt] = __builtin_amdgcn_mfma_f32_16x16x32_bf16(afr, bfr, (f32x4){0.f, 0.f, 0.f, 0.f}, 0, 0, 0); }
#pragma unroll
          for (int tt = 0; tt < 4; ++tt)
#pragma unroll
              for (int e = 0; e < 4; ++e) { const float pre = la[tt][e] + bias; la[tt][e] = (fminf(pre, 0.f) - __logf(1.f + __expf(-fabsf(pre)))) * 0.0625f; }
          float carry = 0.f;
          if (dir == 0) {
#pragma unroll
              for (int tt = 0; tt < 4; ++tt) { la[tt][1] += la[tt][0]; la[tt][2] += la[tt][1]; la[tt][3] += la[tt][2];
                  const float tot = la[tt][3]; float pre = 0.f; const float s16 = bperm(tot, lane - 16), s32 = bperm(tot, lane - 32), s48 = bperm(tot, lane - 48);
                  if (lq >= 1) pre += s16; if (lq >= 2) pre += s32; if (lq >= 3) pre += s48;
                  const float add = carry + pre;
#pragma unroll
                  for (int e = 0; e < 4; ++e) la[tt][e] += add;
                  carry = bperm(la[tt][3], 48 + lr); }
          } else {
#pragma unroll
              for (int tt = 3; tt >= 0; --tt) { la[tt][2] += la[tt][3]; la[tt][1] += la[tt][2]; la[tt][0] += la[tt][1];
                  const float tot = la[tt][0]; float pre = 0.f; const float s16 = bperm(tot, lane + 16), s32 = bperm(tot, lane + 32), s48 = bperm(tot, lane + 48);
                  if (lq <= 2) pre += s16; if (lq <= 1) pre += s32; if (lq <= 0) pre += s48;
                  const float add = carry + pre;
#pragma unroll
                  for (int e = 0; e < 4; ++e) la[tt][e] += add;
                  carry = bperm(la[tt][0], lr); }
          }
#pragma unroll
          for (int tt = 0; tt < 4; ++tt)
#pragma unroll
              for (int e = 0; e < 4; ++e) La[(16 * tt + 4 * lq + e) * 129 + cch] = la[tt][e]; }
        __syncthreads();
        { const int t = tid >> 3, cb = (tid & 7) * 16; const bf16_t* qp = Z + (size_t)(row0 + t) * NZ + ZQB + h * 128 + cb; const bf16_t* kp = Z + (size_t)(row0 + t) * NZ + ZKB + h * 128 + cb;
          float q[16], k[16];
#pragma unroll
          for (int i = 0; i < 2; ++i) { const u32x4 a = *(const u32x4*)(qp + 8 * i), b = *(const u32x4*)(kp + 8 * i);
              q[8 * i] = bflo(a.x); q[8 * i + 1] = bfhi(a.x); q[8 * i + 2] = bflo(a.y); q[8 * i + 3] = bfhi(a.y); q[8 * i + 4] = bflo(a.z); q[8 * i + 5] = bfhi(a.z); q[8 * i + 6] = bflo(a.w); q[8 * i + 7] = bfhi(a.w);
              k[8 * i] = bflo(b.x); k[8 * i + 1] = bfhi(b.x); k[8 * i + 2] = bflo(b.y); k[8 * i + 3] = bfhi(b.y); k[8 * i + 4] = bflo(b.z); k[8 * i + 5] = bfhi(b.z); k[8 * i + 6] = bflo(b.w); k[8 * i + 7] = bfhi(b.w); }
          const int tl = (dir == 0) ? 63 : 0; float qd[16], ki[16];
#pragma unroll
          for (int i = 0; i < 16; ++i) { const float b = La[t * 129 + cb + i], bl = La[tl * 129 + cb + i]; const float e = __expf(b);
              qd[i] = q[i] * e; ki[i] = k[i] * fast_rcp(e); KdT[(cb + i) * 72 + t] = f2bf(k[i] * __expf(bl - b)); }
          u32x4 o0, o1;
          o0.x = cvt_pk_bf16(qd[0], qd[1]); o0.y = cvt_pk_bf16(qd[2], qd[3]); o0.z = cvt_pk_bf16(qd[4], qd[5]); o0.w = cvt_pk_bf16(qd[6], qd[7]);
          o1.x = cvt_pk_bf16(qd[8], qd[9]); o1.y = cvt_pk_bf16(qd[10], qd[11]); o1.z = cvt_pk_bf16(qd[12], qd[13]); o1.w = cvt_pk_bf16(qd[14], qd[15]);
          *(LAS u32x4*)(QD + t * 136 + cb) = o0; *(LAS u32x4*)(QD + t * 136 + cb + 8) = o1;
          bf16_t* qg = (bf16_t*)(c.ws + WS_RB + RB_QDF) + (size_t)(dir * 1088 + un) * 8192 + (size_t)((((t >> 5) * 4 + (cb >> 5)) * 2 + ((cb >> 4) & 1)) * 512 + (t & 31) * 8);
          u32x4 p0, p1; p0.x = o0.x; p0.y = o0.y; p0.z = o1.x; p0.w = o1.y; p1.x = o0.z; p1.y = o0.w; p1.z = o1.z; p1.w = o1.w;
          *(u32x4*)qg = p0; *(u32x4*)(qg + 256) = p1;
          o0.x = cvt_pk_bf16(ki[0], ki[1]); o0.y = cvt_pk_bf16(ki[2], ki[3]); o0.z = cvt_pk_bf16(ki[4], ki[5]); o0.w = cvt_pk_bf16(ki[6], ki[7]);
          o1.x = cvt_pk_bf16(ki[8], ki[9]); o1.y = cvt_pk_bf16(ki[10], ki[11]); o1.z = cvt_pk_bf16(ki[12], ki[13]); o1.w = cvt_pk_bf16(ki[14], ki[15]);
          *(LAS u32x4*)(KI + t * 136 + cb) = o0; *(LAS u32x4*)(KI + t * 136 + cb + 8) = o1;
          if (tid < 128) ((float*)(c.ws + WS_RB + RB_DECAY))[(size_t)(dir * 1088 + un) * 128 + tid] = __expf(La[tl * 129 + tid]); }
        __syncthreads();
        { bf16_t* kg = (bf16_t*)(c.ws + WS_RB + RB_KDT) + (size_t)(dir * 1088 + un) * 8192;
#pragma unroll
          for (int i = 0; i < 2; ++i) { const int id = tid + 512 * i, ch = id >> 3, tc = id & 7;
              *(u32x4*)(kg + (((ch >> 5) * 4 + (tc >> 1)) * 64 + (tc & 1) * 32 + (ch & 31)) * 8) = *(const LAS u32x4*)(KdT + ch * 72 + tc * 8); } }
        { const int it = w >> 1; bf16x8 a[4];
#pragma unroll
          for (int ks = 0; ks < 4; ++ks) a[ks] = *(const LAS bf16x8*)(QD + (16 * it + lr) * 136 + 32 * ks + 8 * lq);
#pragma unroll
          for (int jj = 0; jj < 2; ++jj) { const int jt = 2 * (w & 1) + jj; f32x4 s = {0.f, 0.f, 0.f, 0.f};
#pragma unroll
              for (int ks = 0; ks < 4; ++ks) { const bf16x8 b = *(const LAS bf16x8*)(KI + (16 * jt + lr) * 136 + 32 * ks + 8 * lq); s = __builtin_amdgcn_mfma_f32_16x16x32_bf16(a[ks], b, s, 0, 0, 0); }
              const int j = 16 * jt + lr;
#pragma unroll
              for (int e = 0; e < 4; ++e) { const int i = 16 * it + 4 * lq + e; const bool keep = (dir == 0) ? (j <= i) : (j >= i); pacc[jj][e] += keep ? s[e] : 0.f; } } }
        __syncthreads();
    }
    { const int it = w >> 1;
#pragma unroll
      for (int jj = 0; jj < 2; ++jj) { const int j = 16 * (2 * (w & 1) + jj) + lr;
#pragma unroll
          for (int e = 0; e < 4; ++e) { Ps[(16 * it + 4 * lq + e) * 72 + j] = f2bf(pacc[jj][e]); } } }
    __syncthreads();
    { bf16_t* OI = (bf16_t*)(c.ws + WS_RB + RB_OINTRA);
#pragma unroll
      for (int dd = 0; dd < 2; ++dd) { const int dt = 2 * w + dd; bf16x8 a[2];
#pragma unroll
          for (int ks = 0; ks < 2; ++ks) a[ks] = *(const LAS bf16x8*)(VTs + (16 * dt + lr) * 72 + 32 * ks + 8 * lq);
#pragma unroll
          for (int it = 0; it < 4; ++it) { f32x4 o = {0.f, 0.f, 0.f, 0.f};
#pragma unroll
              for (int ks = 0; ks < 2; ++ks) { const bf16x8 b = *(const LAS bf16x8*)(Ps + (16 * it + lr) * 72 + 32 * ks + 8 * lq); o = __builtin_amdgcn_mfma_f32_16x16x32_bf16(a[ks], b, o, 0, 0, 0); }

              u32x2 ov; ov.x = cvt_pk_bf16(o[0], o[1]); ov.y = cvt_pk_bf16(o[2], o[3]);
              *(u32x2*)(OI + (size_t)(row0 + 16 * it + lr) * D + h * 256 + 16 * dt + 4 * lq) = ov; } } }
    { bf16_t* vg = (bf16_t*)(c.ws + WS_RB + RB_VTG) + (size_t)un * 16384;
#pragma unroll
      for (int i = 0; i < 4; ++i) { const int id = tid + 512 * i, dv = id >> 3, tc = id & 7;
          *(u32x4*)(vg + ((((dv >> 5) * 4 + (tc >> 1)) * 64) + (tc & 1) * 32 + (dv & 31)) * 8) = *(const LAS u32x4*)(VTs + dv * 72 + tc * 8); } }
    __syncthreads();
}
template <int N> __device__ __forceinline__ void vm_wait() { asm volatile("s_waitcnt vmcnt(%0)" :: "n"(N) : "memory"); }
__device__ __forceinline__ void gla_b2_unit(const Ctx& c, int un3) {
    const int lane = c.lane, lr = lane & 31, hi = lane >> 5, w = c.wave & 3, half = un3 & 1, un2 = un3 >> 1, dvs = half * 4 + w;
    const int h = un2 & 3, b = (un2 >> 2) & 3, dir = un2 >> 4;
    volatile LAS unsigned* cntF = (volatile LAS unsigned*)(c.lds + 3 * 33280 + 4 * 5120);
    volatile LAS unsigned* cntD = (volatile LAS unsigned*)(c.lds + 3 * 33280 + 4 * 5120 + 64);
    const char* QDF = (const char*)(c.ws + WS_RB + RB_QDF) + (size_t)dir * 1088 * 16384;
    const char* KDT = (const char*)(c.ws + WS_RB + RB_KDT) + (size_t)dir * 1088 * 16384;
    const char* VTG = (const char*)(c.ws + WS_RB + RB_VTG) + (size_t)dvs * 4096;
    const char* DEC = (const char*)(c.ws + WS_RB + RB_DECAY) + (size_t)dir * 1088 * 512;
    bf16_t* OUT = (bf16_t*)(c.ws + WS_RB + (dir == 0 ? RB_OF : RB_OB)) + (size_t)(((b * 4 + h) * 8 + dvs) * NKEY) * 32;
    constexpr int STG = 33280;
    LAS unsigned char* OT = c.lds + 3 * STG + w * 5120;
    const unsigned loff = (unsigned)lane * 16u;
#define B2_CHUNK(step) ((step) < 4 ? 256 + 4 * b + (dir == 0 ? (step) : 3 - (step)) : 64 * b + (dir == 0 ? (step) - 4 : 67 - (step)))
#define B2_ISSUE(step) do { const int un_ = B2_CHUNK(step) * 4 + h; LAS unsigned char* lb_ = c.lds + ((step) % 3) * STG; \
        const char* q_ = QDF + (size_t)un_ * 16384 + loff + w * 4096; const char* k_ = KDT + (size_t)un_ * 16384 + loff + w * 4096; \
        _Pragma("unroll") for (int i_ = 0; i_ < 4; ++i_) __builtin_amdgcn_global_load_lds((const unsigned*)(q_ + i_ * 1024), (LAS unsigned*)(lb_ + w * 4096 + i_ * 1024), 16, 0, 0); \
        _Pragma("unroll") for (int i_ = 0; i_ < 4; ++i_) __builtin_amdgcn_global_load_lds((const unsigned*)(k_ + i_ * 1024), (LAS unsigned*)(lb_ + 16384 + w * 4096 + i_ * 1024), 16, 0, 0); \
        if (lane < 8) __builtin_amdgcn_global_load_lds((const unsigned*)(DEC + (size_t)un_ * 512 + w * 128 + loff), (LAS unsigned*)(lb_ + 32768 + w * 128), 16, 0, 0); } while (0)
#define B2_SPIN(cnt, target) do { while (*(cnt) < (unsigned)(target)) __builtin_amdgcn_s_sleep(1); asm volatile("" ::: "memory"); } while (0)
#define B2_ARRIVE(cnt) do { if (lane == 0) { const unsigned one_ = 1u; asm volatile("ds_add_u32 %0, %1" :: "v"((unsigned)(size_t)(cnt)), "v"(one_) : "memory"); } } while (0)
    if (c.wave >= 4) {
#pragma unroll 1
        for (int t = 0; t < 68; ++t) {
            if (t >= 3) B2_SPIN(cntD, 4 * (t - 2));
            B2_ISSUE(t);
            if (t >= 1) { vm_wait<9>(); B2_ARRIVE(cntF); }
        }
        vm_wait<0>(); B2_ARRIVE(cntF);
        return;
    }
#define B2_VT(step, vt) do { const char* v_ = VTG + (size_t)(B2_CHUNK(step) * 4 + h) * 32768 + loff; \
        asm volatile("global_load_dwordx4 %0, %4, off\n\tglobal_load_dwordx4 %1, %4, off offset:1024\n\tglobal_load_dwordx4 %2, %4, off offset:2048\n\tglobal_load_dwordx4 %3, %4, off offset:3072" \
                     : "=&v"(vt[0]), "=&v"(vt[1]), "=&v"(vt[2]), "=&v"(vt[3]) : "v"(v_) : "memory"); } while (0)
#define B2_VT_WAIT(N, vt) asm volatile("s_waitcnt vmcnt(%4)" : "+v"(vt[0]), "+v"(vt[1]), "+v"(vt[2]), "+v"(vt[3]) : "n"(N) : "memory")
    f32x16 S[4];
#pragma unroll
    for (int ct = 0; ct < 4; ++ct)
#pragma unroll
        for (int r = 0; r < 16; ++r) S[ct][r] = 0.f;
    bf16x8 vtA[4], vtB[4];
    B2_VT(0, vtA);
#define B2_STEP(step, vt, vtn) do { \
        B2_SPIN(cntF, 4 * ((step) + 1));     \
        if ((step) + 1 < 68) B2_VT((step) + 1, vtn); \
        const int n_ = B2_CHUNK(step); const int key0 = (n_ < 256) ? CTXL + (n_ & 63) * 64 : (n_ - 256 - 4 * b) * 64; \
        const LAS unsigned char* lb = c.lds + ((step) % 3) * STG + loff; \
          \
        f32x16 o[2]; \
        _Pragma("unroll") for (int tt = 0; tt < 2; ++tt) { _Pragma("unroll") for (int r = 0; r < 16; ++r) o[tt][r] = 0.f; } \
        { u32x4 bw[8]; \
          _Pragma("unroll") for (int ct = 0; ct < 4; ++ct) { _Pragma("unroll") for (int s = 0; s < 2; ++s) { bw[ct * 2 + s].x = cvt_pk_bf16(S[ct][8 * s], S[ct][8 * s + 1]); bw[ct * 2 + s].y = cvt_pk_bf16(S[ct][8 * s + 2], S[ct][8 * s + 3]); bw[ct * 2 + s].z = cvt_pk_bf16(S[ct][8 * s + 4], S[ct][8 * s + 5]); bw[ct * 2 + s].w = cvt_pk_bf16(S[ct][8 * s + 6], S[ct][8 * s + 7]); } } \
          _Pragma("unroll") for (int tt = 0; tt < 2; ++tt) { bf16x8 qa[8]; \
            _Pragma("unroll") for (int i = 0; i < 8; ++i) qa[i] = *(const LAS bf16x8*)(lb + (tt * 8 + i) * 1024); \
            __builtin_amdgcn_sched_barrier(0); \
            _Pragma("unroll") for (int i = 0; i < 8; ++i) o[tt] = __builtin_amdgcn_mfma_f32_32x32x16_bf16(__builtin_bit_cast(bf16x8, bw[i]), qa[i], o[tt], 0, 0, 0); \
            __builtin_amdgcn_sched_barrier(0); } } \
          \
        _Pragma("unroll") for (int tt = 0; tt < 2; ++tt) { bf16_t* op = OUT + (size_t)(key0 + 32 * tt + lr) * 32 + 4 * hi; \
            _Pragma("unroll") for (int gq = 0; gq < 4; ++gq) { u32x2 ov; ov.x = cvt_pk_bf16(o[tt][4 * gq], o[tt][4 * gq + 1]); ov.y = cvt_pk_bf16(o[tt][4 * gq + 2], o[tt][4 * gq + 3]); *(u32x2*)(op + 8 * gq) = ov; } } \
          \
        if ((step) == 0) B2_VT_WAIT(12, vt); else if ((step) == 67) B2_VT_WAIT(16, vt); else B2_VT_WAIT(20, vt); \
        const LAS float* dcl = (const LAS float*)(c.lds + ((step) % 3) * STG + 32768); \
        _Pragma("unroll") for (int cp = 0; cp < 2; ++cp) { bf16x8 ka[8]; f32x4 dq[8]; \
          _Pragma("unroll") for (int i = 0; i < 8; ++i) ka[i] = *(const LAS bf16x8*)(lb + 16384 + (cp * 8 + i) * 1024); \
          _Pragma("unroll") for (int i = 0; i < 8; ++i) dq[i] = *(const LAS f32x4*)(dcl + 32 * (2 * cp + (i >> 2)) + 8 * (i & 3) + 4 * hi); \
          __builtin_amdgcn_sched_barrier(0); \
          _Pragma("unroll") for (int cc = 0; cc < 2; ++cc) { _Pragma("unroll") for (int gq = 0; gq < 4; ++gq) { _Pragma("unroll") for (int e = 0; e < 4; ++e) S[2 * cp + cc][4 * gq + e] *= dq[cc * 4 + gq][e]; } } \
          _Pragma("unroll") for (int ks = 0; ks < 4; ++ks) { _Pragma("unroll") for (int cc = 0; cc < 2; ++cc) S[2 * cp + cc] = __builtin_amdgcn_mfma_f32_32x32x16_bf16(ka[cc * 4 + ks], vt[ks], S[2 * cp + cc], 0, 0, 0); } \
          __builtin_amdgcn_sched_barrier(0); } \
        asm volatile("s_waitcnt lgkmcnt(0)" ::: "memory"); B2_ARRIVE(cntD);     \
    } while (0)
#pragma unroll 1
    for (int step = 0; step < 68; step += 2) { B2_STEP(step, vtA, vtB); B2_STEP(step + 1, vtB, vtA); }
    asm volatile("s_waitcnt vmcnt(0) lgkmcnt(0)" ::: "memory");
#undef B2_STEP
#undef B2_VT_WAIT
#undef B2_CHUNK
#undef B2_ISSUE
#undef B2_VT
#undef B2_SPIN
#undef B2_ARRIVE
}
struct FinRaw { u32x2 a[4], b[4], d[4], r[4]; };
__device__ __forceinline__ void gla_finish_load(const Ctx& c, int row, FinRaw& F) {
    const int lane = c.lane; const bf16_t* OI = (const bf16_t*)(c.ws + WS_RB + RB_OINTRA) + (size_t)row * D;
    const bool lat = row < TL; const int b = lat ? (row >> 12) : ((row - TL) >> 8), key = lat ? CTXL + (row & 4095) : ((row - TL) & 255);
    const bf16_t* OFp = (const bf16_t*)(c.ws + WS_RB + RB_OF) + ((size_t)((b * 4) * 8 + (lane >> 3)) * NKEY + key) * 32 + (lane & 7) * 4; const bf16_t* OBp = OFp + (size_t)(RB_OB - RB_OF) / 2;
    const bf16_t* R = (const bf16_t*)(c.ws + WS_RA) + (size_t)row * NZ + ZRB;
#pragma unroll
    for (int h = 0; h < 4; ++h) { const int cc = h * 256 + 4 * lane; const size_t ho = (size_t)h * 8 * NKEY * 32; F.a[h] = *(const u32x2*)(OI + cc); F.b[h] = *(const u32x2*)(OFp + ho); F.d[h] = *(const u32x2*)(OBp + ho); F.r[h] = *(const u32x2*)(R + cc); }
}
__device__ __forceinline__ void gla_finish_row(const Ctx& c, int l, int row, const FinRaw& F) {
    const int lane = c.lane; bf16_t* Y = (bf16_t*)(c.ws + WS_RB + RB_YCAT) + (size_t)row * 3072 + D;
    const f32x4 gv = *(const f32x4*)(c.in[I_GGLA] + l * 256 + 4 * lane);
    float o[4][4], ss[4];
#pragma unroll
    for (int h = 0; h < 4; ++h) { const u32x2 a = F.a[h], b = F.b[h], d = F.d[h];
        o[h][0] = bflo(a.x) + bflo(b.x) + bflo(d.x); o[h][1] = bfhi(a.x) + bfhi(b.x) + bfhi(d.x); o[h][2] = bflo(a.y) + bflo(b.y) + bflo(d.y); o[h][3] = bfhi(a.y) + bfhi(b.y) + bfhi(d.y);
        ss[h] = (o[h][0] * o[h][0] + o[h][1] * o[h][1]) + (o[h][2] * o[h][2] + o[h][3] * o[h][3]); }
#pragma unroll
    for (int h = 0; h < 4; ++h) ss[h] = wave_sum(ss[h]);
#pragma unroll
    for (int h = 0; h < 4; ++h) { const int cc = h * 256 + 4 * lane; const u32x2 r = F.r[h]; const float rstd = 1.0f / sqrtf(ss[h] * (1.f / 256.f) + EPS);
        u32x2 ov; ov.x = cvt_pk_bf16(o[h][0] * rstd * gv[0] * bflo(r.x), o[h][1] * rstd * gv[1] * bfhi(r.x)); ov.y = cvt_pk_bf16(o[h][2] * rstd * gv[2] * bflo(r.y), o[h][3] * rstd * gv[3] * bfhi(r.y));
        *(u32x2*)(Y + cc) = ov; }
}
__device__ __forceinline__ void rope_angle(int pos_row, int pos_col, int j, float& cs, float& sn) {
    const int axis = j >> 5, f = j & 15; const float inv = __expf(-(float)(2 * f) * (1.f / 32.f) * 9.210340371976184f);
    float rev = (float)(axis == 0 ? pos_row : pos_col) * inv * 0.15915494309189535f; rev -= floorf(rev); sn = __builtin_amdgcn_sinf(rev); cs = __builtin_amdgcn_cosf(rev);
}
struct C1Raw { u32x2 ckv; unsigned cq[3]; bf16_t kro; u32x2 kvw[8]; unsigned qnw[8]; bf16_t qrw[8]; };
__device__ __forceinline__ void mla_c1_load(const Ctx& c, int row, bool do_q, C1Raw& R) {
    const int lane = c.lane;
    const bf16_t* Zr = (const bf16_t*)(c.ws + WS_RA) + (size_t)row * NZ;
    const bf16_t* KV = (const bf16_t*)(c.ws + WS_RB + RB_KVRAW) + (size_t)row * 2048; const bf16_t* QR = (const bf16_t*)(c.ws + WS_RB + RB_QRAW) + (size_t)row * 1536;
    R.ckv = *(const u32x2*)(Zr + ZCKV + 4 * lane);
#pragma unroll
    for (int i = 0; i < 3; ++i) R.cq[i] = *(const unsigned*)(Zr + ZCQ + 128 * i + 2 * lane);
    R.kro = Zr[ZKR + lane];
#pragma unroll
    for (int h = 0; h < 8; ++h) R.kvw[h] = *(const u32x2*)(KV + h * 256 + 4 * lane);
    if (do_q) {
#pragma unroll
        for (int h = 0; h < 8; ++h) { R.qnw[h] = *(const unsigned*)(QR + h * 192 + 2 * lane); R.qrw[h] = QR[h * 192 + 128 + lane]; }
    }
}
__device__ __forceinline__ void mla_c1_row(const Ctx& c, int l, int row, bool do_q, const C1Raw& R) {
    const int lane = c.lane; const bool lat = row < TL; const int b = lat ? (row >> 12) : ((row - TL) >> 8), t = lat ? (row & 4095) : ((row - TL) & 255), key = lat ? (CTXL + t) : t;
    bf16_t* KG = (bf16_t*)(c.ws + WS_RB + RB_KG); bf16_t* VG = (bf16_t*)(c.ws + WS_RB + RB_VG);
    float rs_kv, rs_q;
    { const u32x2 w = R.ckv; const float a0 = bflo(w.x), a1 = bfhi(w.x), a2 = bflo(w.y), a3 = bfhi(w.y);
      rs_kv = 1.0f / sqrtf(wave_sum((a0 * a0 + a1 * a1) + (a2 * a2 + a3 * a3)) * (1.f / 256.f) + EPS);
      float s = 0.f;
#pragma unroll
      for (int i = 0; i < 3; ++i) { const unsigned w2 = R.cq[i]; const float q0 = bflo(w2), q1 = bfhi(w2); s += q0 * q0 + q1 * q1; }
      rs_q = 1.0f / sqrtf(wave_sum(s) * (1.f / 384.f) + EPS); }
    float cs = 1.f, sn = 0.f; if (lat) rope_angle(t >> 6, t & 63, lane, cs, sn);
    const bool second = (lane >> 4) & 1;
    float kr;
    { const float v = bf2f(R.kro); const float rr = 1.0f / sqrtf(wave_sum(v * v) * (1.f / 64.f) + EPS); float x = v * rr * c.in[I_GKR][l * 64 + lane];
      const float xp = sx<16>(x); kr = lat ? (second ? (x * cs + xp * sn) : (x * cs - xp * sn)) : x; }
    const bf16_t krb = f2bf(kr);
    const f32x4 gkn = *(const f32x4*)(c.in[I_GKN] + l * 128 + 4 * (lane & 31));
    float ssk[8]; float ak[8][4];
#pragma unroll
    for (int h = 0; h < 8; ++h) { ak[h][0] = bflo(R.kvw[h].x) * rs_kv; ak[h][1] = bfhi(R.kvw[h].x) * rs_kv; ak[h][2] = bflo(R.kvw[h].y) * rs_kv; ak[h][3] = bfhi(R.kvw[h].y) * rs_kv;
        ssk[h] = (ak[h][0] * ak[h][0] + ak[h][1] * ak[h][1]) + (ak[h][2] * ak[h][2] + ak[h][3] * ak[h][3]); }
#pragma unroll
    for (int h = 0; h < 8; ++h) ssk[h] = half_sum(ssk[h]);
    { bf16_t* kgp = KG + (size_t)(b * NKEY + key) * (8 * 192); bf16_t* vgp = VG + (size_t)(b * NKEY + key) * (8 * 128);
#pragma unroll
      for (int h = 0; h < 8; ++h) {
        if (lane < 32) { const float rn = 1.0f / sqrtf(ssk[h] * (1.f / 128.f) + EPS); u32x2 o; o.x = cvt_pk_bf16(ak[h][0] * rn * gkn[0], ak[h][1] * rn * gkn[1]); o.y = cvt_pk_bf16(ak[h][2] * rn * gkn[2], ak[h][3] * rn * gkn[3]);
            *(u32x2*)(kgp + h * 192 + 4 * lane) = o; }
        else { u32x2 o; o.x = cvt_pk_bf16(ak[h][0], ak[h][1]); o.y = cvt_pk_bf16(ak[h][2], ak[h][3]); *(u32x2*)(vgp + h * 128 + 4 * (lane - 32)) = o; }
        kgp[h * 192 + 128 + lane] = krb;
      } }
    __builtin_amdgcn_sched_barrier(0);
    if (lane == 0) ((float*)(c.ws + WS_RSQ))[row] = rs_q;
    if (!do_q) return;
    bf16_t* QF = lat ? (bf16_t*)(c.ws + WS_RB + RB_QFL) : (bf16_t*)(c.ws + WS_RB + RB_QFC); const int nq = lat ? SEQ : CTXL;
    const float QS = 0.07216878364870322f * 1.4426950408889634f;
    const f32x2 gqn = *(const f32x2*)(c.in[I_GQN] + l * 128 + 2 * lane); const float gqr = c.in[I_GQR][l * 64 + lane];
    float n0[8], n1[8], r0[8], sn_[8], sr_[8];
#pragma unroll
    for (int h = 0; h < 8; ++h) { n0[h] = bflo(R.qnw[h]) * rs_q; n1[h] = bfhi(R.qnw[h]) * rs_q; r0[h] = bf2f(R.qrw[h]) * rs_q; sn_[h] = n0[h] * n0[h] + n1[h] * n1[h]; sr_[h] = r0[h] * r0[h]; }
#pragma unroll
    for (int h = 0; h < 8; ++h) { sn_[h] = wave_sum(sn_[h]); sr_[h] = wave_sum(sr_[h]); }
#pragma unroll
    for (int h = 0; h < 8; ++h) {
        const float rn = 1.0f / sqrtf(sn_[h] * (1.f / 128.f) + EPS), rr = 1.0f / sqrtf(sr_[h] * (1.f / 64.f) + EPS);
        bf16_t* qp = QF + (size_t)(b * nq + t) * (8 * 192) + h * 192;
        *(unsigned*)(qp + 2 * lane) = cvt_pk_bf16(n0[h] * rn * gqn[0] * QS, n1[h] * rn * gqn[1] * QS);
        const float x = r0[h] * rr * gqr; const float xp = sx<16>(x); const float xr = lat ? (second ? (x * cs + xp * sn) : (x * cs - xp * sn)) : x;
        qp[128 + lane] = f2bf(xr * QS);
    }
}
__device__ __forceinline__ bf16x8 tr_pair(unsigned a0, unsigned a1) {
    bf16x4 x, y; asm volatile("ds_read_b64_tr_b16 %0, %2\n\tds_read_b64_tr_b16 %1, %3\n\ts_waitcnt lgkmcnt(0)" : "=&v"(x), "=&v"(y) : "v"(a0), "v"(a1) : "memory");
    return (bf16x8){x[0], x[1], x[2], x[3], y[0], y[1], y[2], y[3]};
}
__device__ __forceinline__ void k2_issue(bf16x8& a0, bf16x8& a1, unsigned addr) {
    asm volatile("ds_read_b128 %0, %2\n\tds_read_b128 %1, %2 offset:12288" : "=&v"(a0), "=&v"(a1) : "v"(addr) : "memory");
}
template <int N> __device__ __forceinline__ void k2_wait(bf16x8& a0, bf16x8& a1) { asm volatile("s_waitcnt lgkmcnt(%2)" : "+v"(a0), "+v"(a1) : "n"(N) : "memory"); }
template <int OFF>
__device__ __forceinline__ void tr8_issue(bf16x4 (&x)[8], unsigned a0, unsigned a1, unsigned a2, unsigned a3, unsigned d1) {
    asm volatile("ds_read_b64_tr_b16 %0, %8 offset:%13\n\tds_read_b64_tr_b16 %2, %9 offset:%13\n\tds_read_b64_tr_b16 %4, %10 offset:%13\n\tds_read_b64_tr_b16 %6, %11 offset:%13\n\t"
                 "v_add_u32 %8, %8, %12\n\tv_add_u32 %9, %9, %12\n\tv_add_u32 %10, %10, %12\n\tv_add_u32 %11, %11, %12\n\t"
                 "ds_read_b64_tr_b16 %1, %8 offset:%13\n\tds_read_b64_tr_b16 %3, %9 offset:%13\n\tds_read_b64_tr_b16 %5, %10 offset:%13\n\tds_read_b64_tr_b16 %7, %11 offset:%13"
                 : "=&v"(x[0]), "=&v"(x[1]), "=&v"(x[2]), "=&v"(x[3]), "=&v"(x[4]), "=&v"(x[5]), "=&v"(x[6]), "=&v"(x[7]), "+v"(a0), "+v"(a1), "+v"(a2), "+v"(a3)
                 : "v"(d1), "n"(OFF) : "memory");
}
__device__ __forceinline__ void tr8_wait(bf16x4 (&x)[8]) {
    asm volatile("s_waitcnt lgkmcnt(0)" : "+v"(x[0]), "+v"(x[1]), "+v"(x[2]), "+v"(x[3]), "+v"(x[4]), "+v"(x[5]), "+v"(x[6]), "+v"(x[7]) :: "memory");
}
__device__ __forceinline__ void attn_unit(const Ctx& c, int l, const bf16_t* Qraw  , const float* rsq  , int t0  ,
                                          const bf16_t* Kp  , const bf16_t* Vp  , int nt, bf16_t* Op  ) {
    constexpr int STG = 40960, KB = 24576;
    const int tid = c.tid, lane = c.lane, w = c.wave, lr = lane & 31, hi = lane >> 5;
    const unsigned lds0 = (unsigned)(size_t)c.lds;
    unsigned ksrc[3], vsrc[2];
#pragma unroll
    for (int i = 0; i < 3; ++i) { const int P = (w + 8 * i) * 64 + lane, row = P / 24, cp = P % 24, ch = (cp & ~7) | ((cp & 7) ^ ((row >> 1) & 7)); ksrc[i] = row * 3072 + ch * 16; }
#pragma unroll
    for (int i = 0; i < 2; ++i) { const int P = (w + 8 * i) * 64 + lane, row = P >> 4, cp = P & 15, ch = cp ^ (((row & 3) << 2) | ((row >> 2) & 3)); vsrc[i] = row * 2048 + ch * 16; }
#define ATT_ISSUE(tile, stg) do { const char* kt_ = (const char*)Kp + (size_t)(tile) * (64 * 3072); const char* vt_ = (const char*)Vp + (size_t)(tile) * (64 * 2048); \
        _Pragma("unroll") for (int i_ = 0; i_ < 3; ++i_) __builtin_amdgcn_global_load_lds((const unsigned*)(kt_ + ksrc[i_]), (LAS unsigned*)(c.lds + (stg) * STG + (w + 8 * i_) * 1024), 16, 0, 0); \
        _Pragma("unroll") for (int i_ = 0; i_ < 2; ++i_) __builtin_amdgcn_global_load_lds((const unsigned*)(vt_ + vsrc[i_]), (LAS unsigned*)(c.lds + (stg) * STG + KB + (w + 8 * i_) * 1024), 16, 0, 0); } while (0)
    bf16x8 qf[12];
    {
      const int qr = 32 * w + lr; const bf16_t* qrow = Qraw + (size_t)qr * 1536 + 8 * hi; const float rs = rsq[qr];
      u32x4 raw[12]; float sn = 0.f, sr = 0.f;
#pragma unroll
      for (int s = 0; s < 12; ++s) { raw[s] = *(const u32x4*)(qrow + 16 * s); const u32x4 wv = raw[s];
          const float q2 = (bflo(wv.x) * bflo(wv.x) + bfhi(wv.x) * bfhi(wv.x)) + (bflo(wv.y) * bflo(wv.y) + bfhi(wv.y) * bfhi(wv.y)) + (bflo(wv.z) * bflo(wv.z) + bfhi(wv.z) * bfhi(wv.z)) + (bflo(wv.w) * bflo(wv.w) + bfhi(wv.w) * bfhi(wv.w));
          if (s < 8) sn += q2; else sr += q2; }
      sn = sum32(sn) * rs * rs; sr = sum32(sr) * rs * rs;
      const float QS = 0.07216878364870322f * 1.4426950408889634f;
      const float rn = rs * QS / sqrtf(sn * (1.f / 128.f) + EPS), rr = rs * QS / sqrtf(sr * (1.f / 64.f) + EPS);
      const float* gqn = c.in[I_GQN] + l * 128 + 8 * hi; const float* gqr = c.in[I_GQR] + l * 64 + 8 * hi;
#pragma unroll
      for (int s = 0; s < 8; ++s) { const f32x4 g0 = *(const f32x4*)(gqn + 16 * s) * rn, g1 = *(const f32x4*)(gqn + 16 * s + 4) * rn; const u32x4 wv = raw[s]; u32x4 pk;
          pk.x = cvt_pk_bf16(bflo(wv.x) * g0[0], bfhi(wv.x) * g0[1]); pk.y = cvt_pk_bf16(bflo(wv.y) * g0[2], bfhi(wv.y) * g0[3]); pk.z = cvt_pk_bf16(bflo(wv.z) * g1[0], bfhi(wv.z) * g1[1]); pk.w = cvt_pk_bf16(bflo(wv.w) * g1[2], bfhi(wv.w) * g1[3]);
          qf[s] = __builtin_bit_cast(bf16x8, pk); }
      float x[4][8];
#pragma unroll
      for (int s = 0; s < 4; ++s) { const f32x4 g0 = *(const f32x4*)(gqr + 16 * s) * rr, g1 = *(const f32x4*)(gqr + 16 * s + 4) * rr; const u32x4 wv = raw[8 + s];
          x[s][0] = bflo(wv.x) * g0[0]; x[s][1] = bfhi(wv.x) * g0[1]; x[s][2] = bflo(wv.y) * g0[2]; x[s][3] = bfhi(wv.y) * g0[3]; x[s][4] = bflo(wv.z) * g1[0]; x[s][5] = bfhi(wv.z) * g1[1]; x[s][6] = bflo(wv.w) * g1[2]; x[s][7] = bfhi(wv.w) * g1[3]; }
      if (t0 >= 0) { const int t = t0 + qr; const float prow = (float)(t >> 6), pcol = (float)(t & 63);
#pragma unroll
          for (int i = 0; i < 8; ++i) { const float inv = __expf(-(float)(2 * (8 * hi + i)) * (1.f / 32.f) * 9.210340371976184f) * 0.15915494309189535f;
              float r0 = prow * inv; r0 -= floorf(r0); float r1 = pcol * inv; r1 -= floorf(r1);
              const float c0 = __builtin_amdgcn_cosf(r0), s0 = __builtin_amdgcn_sinf(r0), c1 = __builtin_amdgcn_cosf(r1), s1 = __builtin_amdgcn_sinf(r1);
              const float a0 = x[0][i], b0 = x[1][i], a1 = x[2][i], b1 = x[3][i];
              x[0][i] = a0 * c0 - b0 * s0; x[1][i] = b0 * c0 + a0 * s0; x[2][i] = a1 * c1 - b1 * s1; x[3][i] = b1 * c1 + a1 * s1; } }
#pragma unroll
      for (int s = 0; s < 4; ++s) { u32x4 pk; pk.x = cvt_pk_bf16(x[s][0], x[s][1]); pk.y = cvt_pk_bf16(x[s][2], x[s][3]); pk.z = cvt_pk_bf16(x[s][4], x[s][5]); pk.w = cvt_pk_bf16(x[s][6], x[s][7]); qf[8 + s] = __builtin_bit_cast(bf16x8, pk); }
      __builtin_amdgcn_sched_barrier(0); }
    unsigned kbase = lr * 384, y16 = (unsigned)((hi ^ ((lr >> 1) & 7)) << 4);
    unsigned vbase, q64, vd1;
    { const int blk = (lane >> 4) & 1, q = (lane & 15) >> 2, p = lane & 3; const int lb = (2 * blk + (p >> 1)) ^ hi;
      vbase = KB + 256 * (4 * hi + q) + 16 * lb + 8 * (p & 1); q64 = (unsigned)(q << 6); vd1 = 2048u + ((lb & 2) ? -32 : 32); }
    f32x16 o[4];
#pragma unroll
    for (int cc = 0; cc < 4; ++cc)
#pragma unroll
        for (int r = 0; r < 16; ++r) o[cc][r] = 0.f;
    float m = -1e30f, lsum = 0.f;
    ATT_ISSUE(0, 0);
    if (nt > 1) ATT_ISSUE(1, 1);
    asm volatile("" :: "v"(qf[0]), "v"(qf[1]), "v"(qf[2]), "v"(qf[3]), "v"(qf[4]), "v"(qf[5]), "v"(qf[6]), "v"(qf[7]), "v"(qf[8]), "v"(qf[9]), "v"(qf[10]), "v"(qf[11]));
#pragma unroll 1
    for (int j = 0; j < nt; ++j) {
        if (j + 1 < nt) asm volatile("s_waitcnt vmcnt(5)" ::: "memory"); else asm volatile("s_waitcnt vmcnt(0)" ::: "memory");
        asm volatile("s_waitcnt lgkmcnt(0)" ::: "memory"); __builtin_amdgcn_s_barrier(); asm volatile("" ::: "memory");
        if (j + 2 < nt) ATT_ISSUE(j + 2, (j + 2) % 3);
        const unsigned sb = lds0 + (unsigned)((j % 3) * STG);
        asm volatile("" : "+v"(kbase), "+v"(y16), "+v"(vbase), "+v"(q64), "+v"(vd1));
        const unsigned kb_ = sb + kbase;
        f32x16 st[2];
#pragma unroll
        for (int kt = 0; kt < 2; ++kt)
#pragma unroll
            for (int r = 0; r < 16; ++r) st[kt][r] = 0.f;
        { bf16x8 ka[2][2];
#define KADDR(s_) (kb_ + (y16 ^ (unsigned)(((2 * (s_)) & 7) << 4)) + (unsigned)((((2 * (s_)) & ~7) << 4)))
          k2_issue(ka[0][0], ka[0][1], KADDR(0));
#pragma unroll
          for (int s = 0; s < 12; ++s) {
              if (s + 1 < 12) { k2_issue(ka[(s + 1) & 1][0], ka[(s + 1) & 1][1], KADDR(s + 1)); k2_wait<2>(ka[s & 1][0], ka[s & 1][1]); }
              else k2_wait<0>(ka[s & 1][0], ka[s & 1][1]);
              st[0] = __builtin_amdgcn_mfma_f32_32x32x16_bf16(ka[s & 1][0], qf[s], st[0], 0, 0, 0);
              st[1] = __builtin_amdgcn_mfma_f32_32x32x16_bf16(ka[s & 1][1], qf[s], st[1], 0, 0, 0); }
#undef KADDR
        }
        bf16x4 vx[8];
        tr8_issue<0>(vx, sb + vbase + (q64 ^ 0u), sb + vbase + (q64 ^ 64u), sb + vbase + (q64 ^ 128u), sb + vbase + (q64 ^ 192u), vd1);
        float mx = st[0][0];
#pragma unroll
        for (int r = 1; r < 16; ++r) mx = fmaxf(mx, st[0][r]);
#pragma unroll
        for (int r = 0; r < 16; ++r) mx = fmaxf(mx, st[1][r]);
        mx = max32(mx);
        const float mn = fmaxf(m, mx), alpha = __builtin_amdgcn_exp2f(m - mn); m = mn;
        float ps = 0.f;
#pragma unroll
        for (int kt = 0; kt < 2; ++kt)
#pragma unroll
            for (int r = 0; r < 16; ++r) { st[kt][r] = __builtin_amdgcn_exp2f(st[kt][r] - mn); ps += st[kt][r]; }
        lsum = lsum * alpha + ps;
        if (__any(alpha != 1.0f)) {
#pragma unroll
            for (int cc = 0; cc < 4; ++cc)
#pragma unroll
                for (int r = 0; r < 16; ++r) o[cc][r] *= alpha; }
#define ATT_PV(KT, S2, NEXT_OFF, HAS_NEXT) do { u32x4 pw; pw.x = cvt_pk_bf16(st[KT][8 * S2], st[KT][8 * S2 + 1]); pw.y = cvt_pk_bf16(st[KT][8 * S2 + 2], st[KT][8 * S2 + 3]); pw.z = cvt_pk_bf16(st[KT][8 * S2 + 4], st[KT][8 * S2 + 5]); pw.w = cvt_pk_bf16(st[KT][8 * S2 + 6], st[KT][8 * S2 + 7]); \
            const bf16x8 pb = __builtin_bit_cast(bf16x8, pw); tr8_wait(vx); bf16x8 af[4]; \
            _Pragma("unroll") for (int cc = 0; cc < 4; ++cc) af[cc] = (bf16x8){vx[2 * cc][0], vx[2 * cc][1], vx[2 * cc][2], vx[2 * cc][3], vx[2 * cc + 1][0], vx[2 * cc + 1][1], vx[2 * cc + 1][2], vx[2 * cc + 1][3]}; \
            if (HAS_NEXT) tr8_issue<NEXT_OFF>(vx, sb + vbase + (q64 ^ 0u), sb + vbase + (q64 ^ 64u), sb + vbase + (q64 ^ 128u), sb + vbase + (q64 ^ 192u), vd1); \
            _Pragma("unroll") for (int cc = 0; cc < 4; ++cc) o[cc] = __builtin_amdgcn_mfma_f32_32x32x16_bf16(af[cc], pb, o[cc], 0, 0, 0); } while (0)
        ATT_PV(0, 0, 4096, true); ATT_PV(0, 1, 8192, true); ATT_PV(1, 0, 12288, true); ATT_PV(1, 1, 0, false);
#undef ATT_PV
    }
    const float linv = 1.0f / sum32(lsum);
    bf16_t* orow = Op + (size_t)(32 * w + lr) * 3072;
#pragma unroll
    for (int cc = 0; cc < 4; ++cc)
#pragma unroll
        for (int g = 0; g < 4; ++g) { u32x2 ov; ov.x = cvt_pk_bf16(o[cc][4 * g] * linv, o[cc][4 * g + 1] * linv); ov.y = cvt_pk_bf16(o[cc][4 * g + 2] * linv, o[cc][4 * g + 3] * linv);
            *(u32x2*)(orow + 32 * cc + 8 * g + 4 * hi) = ov; }
    asm volatile("s_waitcnt vmcnt(0) lgkmcnt(0)" ::: "memory"); __builtin_amdgcn_s_barrier(); asm volatile("" ::: "memory");
#undef ATT_ISSUE
}
__device__ __forceinline__ void route_stage_w(const Ctx& c, int l) {
    LAS float* WT = (LAS float*)c.lds; const float* wr = c.in[I_WROUTER] + (size_t)l * D * NEXP;
    for (int i = c.tid; i < D * NEXP; i += NTHR) WT[(i & 15) * 1028 + (i >> 4)] = wr[i];
    __syncthreads();
}
struct RouteRaw { f32x4 xv[4]; };
__device__ __forceinline__ void route_load(const Ctx& c, int row, RouteRaw& R) { const float* xr = xout_row(c, row);
#pragma unroll
    for (int j = 0; j < 4; ++j) R.xv[j] = *(const f32x4*)(xr + 4 * c.lane + 256 * j); }
__device__ __forceinline__ void route_row(const Ctx& c, int l, int row, const RouteRaw& R) {
    const int lane = c.lane, bi = row_modidx(row); f32x4 hv[4];
    { const float* g = c.in[I_GFFN] + l * D; const float* shift = modp(c, l, bi, 3); const float* scale = modp(c, l, bi, 4); bf16_t* hrow = (bf16_t*)(c.ws + WS_H) + (size_t)row * D; float ss = 0.f;
#pragma unroll
      for (int j = 0; j < 4; ++j) { hv[j] = R.xv[j]; ss += (hv[j][0] * hv[j][0] + hv[j][1] * hv[j][1]) + (hv[j][2] * hv[j][2] + hv[j][3] * hv[j][3]); }
      const float rstd = 1.0f / sqrtf(wave_sum(ss) * (1.f / D) + EPS);
#pragma unroll
      for (int j = 0; j < 4; ++j) { const int cc = 4 * lane + 256 * j; const f32x4 gv = *(const f32x4*)(g + cc), sc = *(const f32x4*)(scale + cc), sh = *(const f32x4*)(shift + cc);
          hv[j] = hv[j] * rstd * gv * (sc + 1.0f) + sh;
          u32x2 o; o.x = cvt_pk_bf16(hv[j][0], hv[j][1]); o.y = cvt_pk_bf16(hv[j][2], hv[j][3]); *(u32x2*)(hrow + cc) = o; } }
    const LAS float* WT = (const LAS float*)c.lds; float lg[16];
#pragma unroll
    for (int e = 0; e < 16; ++e) { float a = 0.f;
#pragma unroll
        for (int j = 0; j < 4; ++j) { const f32x4 wv = *(const LAS f32x4*)(WT + e * 1028 + 4 * lane + 256 * j); a += (hv[j][0] * wv[0] + hv[j][1] * wv[1]) + (hv[j][2] * wv[2] + hv[j][3] * wv[3]); }
        lg[e] = a; if ((e & 3) == 3) __builtin_amdgcn_sched_barrier(0); }
#pragma unroll
    for (int e = 0; e < 16; ++e) lg[e] = wave_sum(lg[e]);
    float mx = lg[0];
#pragma unroll
    for (int e = 1; e < 16; ++e) mx = fmaxf(mx, lg[e]);
    float sum = 0.f;
#pragma unroll
    for (int e = 0; e < 16; ++e) { lg[e] = __expf(lg[e] - mx); sum += lg[e]; }
    const float inv = 1.0f / sum; float mine = 0.f;
#pragma unroll
    for (int e = 0; e < 16; ++e) mine = (lane == e) ? lg[e] * inv : mine;
    float* AF = (float*)(c.ws + WS_AFFT);
    if (lane < 16) { if (row < TL) AF[((size_t)(row >> 12) * 16 + lane) * SEQ + (row & 4095)] = mine; else AF[(size_t)NB * 16 * SEQ + ((size_t)((row - TL) >> 8) * 16 + lane) * CTXL + ((row - TL) & 255)] = mine; }
}
struct GuMap { int up; __device__ __forceinline__ int operator()(int n) const { return (n >> 7) * 256 + up * 128 + (n & 127); } };
struct IdMap { __device__ __forceinline__ int operator()(int n) const { return n; } };
__device__ __forceinline__ void expert_wconv(const Ctx& c, int l) {
    constexpr int U_G = 16 * 8, U_D = 32 * 4, U_E = 2 * U_G + U_D;
    bf16_t* WGU = (bf16_t*)(c.ws + WS_RB + RB_WGU); bf16_t* WD = (bf16_t*)(c.ws + WS_RB + RB_WD);
    unsigned* ctr = (unsigned*)(c.ws + WS_CTL + 32768) + 64 * l;
    LAS int* ubox = (LAS int*)(c.lds + 4 * 64 * 65 * 4);
    for (;;) { if (c.tid == 0) *ubox = (int)__hip_atomic_fetch_add(ctr, 1u, __ATOMIC_RELAXED, __HIP_MEMORY_SCOPE_AGENT);
        __syncthreads(); const int u = *ubox; __syncthreads(); if (u >= NEXP * U_E) break;
        const int e = u / U_E; int r = u % U_E;
        if (r < 2 * U_G) { const int up = r / U_G, rr = r % U_G, nb = rr / 16, kb = rr % 16;
            const float* src = c.in[up ? I_WEU : I_WEG] + ((size_t)l * NEXP + e) * D * DEXP;
            tconv_tile4(c, src, DEXP, kb * 64, nb * 256, WGU + (size_t)e * 4096 * D, D, kb * 64, GuMap{up}); }
        else { r -= 2 * U_G; const int nb = r / 32, kb = r % 32;
            tconv_tile4(c, c.in[I_WED] + ((size_t)l * NEXP + e) * DEXP * D, D, kb * 64, nb * 256, WD + (size_t)e * D * DEXP, DEXP, kb * 64, IdMap{}); } }
}
__device__ __forceinline__ void topk_unit(const Ctx& c, int un, bool is_ctx) {
    const int tid = c.tid, lane = c.lane, w = c.wave;
    LAS unsigned* hist = (LAS unsigned*)c.lds;
    LAS unsigned* ctl = (LAS unsigned*)(c.lds + 1024);
    LAS unsigned* wsum = (LAS unsigned*)(c.lds + 1280);
    LAS int* list = (LAS int*)(c.lds + 2048);
    int b, e, ntok, cap; const float* src;
    if (!is_ctx) { b = un >> 4; e = un & 15; ntok = SEQ; cap = CAPL; src = (const float*)(c.ws + WS_AFFT) + ((size_t)b * 16 + e) * SEQ; }
    else { b = un >> 4; e = un & 15; ntok = CTXL; cap = CAPC; src = (const float*)(c.ws + WS_AFFT) + (size_t)NB * 16 * SEQ + ((size_t)b * 16 + e) * CTXL; }
    const bool have = 8 * tid < ntok; unsigned key[8];
    if (have) { const u32x4 k0 = *(const u32x4*)(src + 8 * tid), k1 = *(const u32x4*)(src + 8 * tid + 4); key[0] = k0.x; key[1] = k0.y; key[2] = k0.z; key[3] = k0.w; key[4] = k1.x; key[5] = k1.y; key[6] = k1.z; key[7] = k1.w; }
    else {
#pragma unroll
        for (int i = 0; i < 8; ++i) key[i] = 0u; }
    if (tid == 0) { unsigned z0 = 0u, c0 = (unsigned)cap; asm volatile("" : "+v"(z0), "+v"(c0)); ctl[0] = z0; ctl[1] = c0; }
#pragma unroll 1
    for (int pass = 0; pass < 4; ++pass) { const int shift = 24 - 8 * pass;
        if (tid < 256) hist[tid] = 0u;
        __syncthreads();
        const unsigned pref = ctl[0], need = ctl[1];
        if (have) {
#pragma unroll
            for (int i = 0; i < 8; ++i) { const bool m = (pass == 0) || ((key[i] >> (shift + 8)) == pref); if (m) atomicAdd((unsigned*)(hist + ((key[i] >> shift) & 255u)), 1u); } }
        __syncthreads();
        if (tid < 256) {
            const unsigned hv = hist[tid]; unsigned sfx = hv;
#pragma unroll
            for (int o = 1; o < 64; o <<= 1) { const unsigned tv = bperm(sfx, lane + o); if (lane + o < 64) sfx += tv; }
            if (lane == 0) wsum[w] = sfx;
            }
        __syncthreads();
        if (tid < 256) { const unsigned hv = hist[tid]; unsigned sfx = hv;
#pragma unroll
            for (int o = 1; o < 64; o <<= 1) { const unsigned tv = bperm(sfx, lane + o); if (lane + o < 64) sfx += tv; }
            unsigned gt = sfx - hv;
#pragma unroll
            for (int j = 1; j < 4; ++j) if (w + j < 4) gt += wsum[w + j];
            if (gt < need && need <= gt + hv) { ctl[2] = (pref << 8) | (unsigned)tid; ctl[3] = need - gt; } }
        __syncthreads();
        if (tid == 0) { ctl[0] = ctl[2]; ctl[1] = ctl[3]; }
        __syncthreads();
    }
    const unsigned thr = ctl[0], need = ctl[1];
    unsigned cg = 0u, ce = 0u;
#pragma unroll
    for (int i = 0; i < 8; ++i) { cg += (key[i] > thr) ? 1u : 0u; ce += (have && key[i] == thr) ? 1u : 0u; }
    unsigned sg = cg, se = ce;
#pragma unroll
    for (int o = 1; o < 64; o <<= 1) { const unsigned tg = bperm(sg, lane - o), te = bperm(se, lane - o); if (lane >= o) { sg += tg; se += te; } }
    if (lane == 63) { wsum[w] = sg; wsum[8 + w] = se; }
    __syncthreads();
    unsigned og = 0u, oe = 0u;
#pragma unroll
    for (int j = 0; j < 8; ++j) { if (j < w) { og += wsum[j]; oe += wsum[8 + j]; } }
    unsigned pg = og + sg - cg, pe = oe + se - ce;
    const int rowbase = is_ctx ? (TL + b * CTXL) : (b * SEQ);
    if (have) {
#pragma unroll
        for (int i = 0; i < 8; ++i) { const bool g = key[i] > thr, q = key[i] == thr; const bool sel = g || (q && pe < need);
            const int rank = (int)(pg + (pe < need ? pe : need)); const int row = rowbase + 8 * tid + i;
            ((int*)(c.ws + WS_SEL))[(size_t)row * 16 + e] = sel ? rank : -1;
            if (sel) { const int slot = is_ctx ? (2048 + b * CAPC + rank) : (b * CAPL + rank); ((float*)(c.ws + WS_GATEV))[e * ESLOTS + slot] = __uint_as_float(key[i]); list[2 * rank] = row; list[2 * rank + 1] = slot; }
            pg += g ? 1u : 0u; pe += q ? 1u : 0u; } }
    __syncthreads();
    const bf16_t* H = (const bf16_t*)(c.ws + WS_H); bf16_t* XS = (bf16_t*)(c.ws + WS_RA + RA_XS) + (size_t)e * ESLOTS * D;
    for (int i0 = w; i0 < cap; i0 += 8 * NWAVES) {
        u32x4 v0[8], v1[8];
#pragma unroll
        for (int k = 0; k < 8; ++k) { const int i = i0 + k * NWAVES; if (i < cap) { const u32x4* sp = (const u32x4*)(H + (size_t)list[2 * i] * D); v0[k] = sp[lane]; v1[k] = sp[64 + lane]; } }
#pragma unroll
        for (int k = 0; k < 8; ++k) { const int i = i0 + k * NWAVES; if (i < cap) { u32x4* dp = (u32x4*)(XS + (size_t)list[2 * i + 1] * D); dp[lane] = v0[k]; dp[64 + lane] = v1[k]; } }
    }
    __syncthreads();
}
struct CombRaw { int sel; f32x4 xv[4]; };
__device__ __forceinline__ void combine_load(const Ctx& c, int row, CombRaw& R) {
    const int lane = c.lane; const float* xr = xout_row(c, row);
    R.sel = ((const int*)(c.ws + WS_SEL))[(size_t)row * 16 + (lane & 15)];
#pragma unroll
    for (int j = 0; j < 4; ++j) R.xv[j] = *(const f32x4*)(xr + 4 * lane + 256 * j);
}
__device__ __forceinline__ void combine_row(const Ctx& c, int l, int row, bool next_mod, const CombRaw& R, float* dummy = nullptr) {
    const int lane = c.lane, bi = row_modidx(row); float* xr = xout_row(c, row); float* xw = dummy ? dummy + (size_t)row * D : xr;
    const bf16_t* YS = (const bf16_t*)(c.ws + WS_RA + RA_YS); const float* g5 = modp(c, l, bi, 5);
    f32x4 acc[4];
#pragma unroll
    for (int j = 0; j < 4; ++j) acc[j] = (f32x4){0.f, 0.f, 0.f, 0.f};
    const bool lat = row < TL; const int b = lat ? (row >> 12) : ((row - TL) >> 8);
    unsigned long long pick = __ballot(R.sel >= 0) & 0xffffull;
    while (pick) {
        const bf16_t* yp[4]; bool on[4];
#pragma unroll
        for (int k = 0; k < 4; ++k) { on[k] = pick != 0; const int e = on[k] ? __builtin_ctzll(pick) : 0; if (on[k]) pick &= pick - 1;
            const int r = __builtin_amdgcn_readlane(R.sel, e); const int slot = lat ? (b * CAPL + r) : (2048 + b * CAPC + r);
            yp[k] = YS + ((size_t)e * ESLOTS + (on[k] ? slot : 0)) * D; }
        u32x2 wv[4][4];
#pragma unroll
        for (int k = 0; k < 4; ++k)
#pragma unroll
            for (int j = 0; j < 4; ++j) wv[k][j] = on[k] ? *(const u32x2*)(yp[k] + 4 * lane + 256 * j) : (u32x2){0u, 0u};
#pragma unroll
        for (int k = 0; k < 4; ++k)
#pragma unroll
            for (int j = 0; j < 4; ++j) { acc[j][0] += bflo(wv[k][j].x); acc[j][1] += bfhi(wv[k][j].x); acc[j][2] += bflo(wv[k][j].y); acc[j][3] += bfhi(wv[k][j].y); }
    }
    float ss = 0.f; f32x4 xv[4];
#pragma unroll
    for (int j = 0; j < 4; ++j) { const int cc = 4 * lane + 256 * j; xv[j] = R.xv[j] + *(const f32x4*)(g5 + cc) * acc[j]; *(f32x4*)(xw + cc) = xv[j];
        ss += (xv[j][0] * xv[j][0] + xv[j][1] * xv[j][1]) + (xv[j][2] * xv[j][2] + xv[j][3] * xv[j][3]); }
    if (!next_mod) return;
    const float rstd = 1.0f / sqrtf(wave_sum(ss) * (1.f / D) + EPS); const float* g = c.in[I_GMIX] + (l + 1) * D; const float* sh = modp(c, l + 1, bi, 0); const float* sc = modp(c, l + 1, bi, 1);
    bf16_t* hrow = (bf16_t*)(c.ws + WS_H) + (size_t)row * D;
#pragma unroll
    for (int j = 0; j < 4; ++j) { const int cc = 4 * lane + 256 * j; const f32x4 h = xv[j] * rstd * *(const f32x4*)(g + cc) * (*(const f32x4*)(sc + cc) + 1.0f) + *(const f32x4*)(sh + cc);
        u32x2 o; o.x = cvt_pk_bf16(h[0], h[1]); o.y = cvt_pk_bf16(h[2], h[3]); *(u32x2*)(hrow + cc) = o; }
}

#ifndef MK_FUSED
#define MK_FUSED 1
#endif
constexpr int NPH = 2 + 11 * 2;
constexpr int CW_BAR = 4096;

__global__ void __launch_bounds__(NTHR, 2) fwd(Args args) {
    extern __shared__ __attribute__((aligned(16))) unsigned char lds_raw[];
    Ctx c; c.in = args.in; c.out = args.out; c.ws = args.ws; c.lds = (LAS unsigned char*)lds_raw;
    c.tid = threadIdx.x; c.lane = c.tid & 63; c.wave = __builtin_amdgcn_readfirstlane(c.tid >> 6); c.G = gridDim.x; c.bid = blockIdx.x;
    volatile LAS unsigned* misc = (volatile LAS unsigned*)(c.lds + LDS_MISC);
    if (c.tid < 8) misc[c.tid] = 0u;
    __syncthreads();
#if MK_FUSED
    XcdBarrier bar = xcd_barrier_post((unsigned*)(c.ws + WS_CTL) + CW_BAR, misc);
#define GRID_BAR() xcd_barrier(bar)
#else
#define GRID_BAR() do {} while (0)
#endif
    const int lo = args.ph_lo, hi = args.ph_hi;
#ifndef PHMASK
#define PHMASK 0xffffffffu
#endif
#define IN(k) (lo <= (k) && (k) < hi)
#define EN(j) ((PHMASK >> (j)) & 1u)
#ifndef REPEAT_ID
#define REPEAT_ID -1
#endif
#define REP(id) for (int rep_ = 0; rep_ < ((REPEAT_ID == (id)) ? 2 : 1); ++rep_)
#if defined(DEBUG_TS_A)
#ifndef DEBUG_TS_Q
#define DEBUG_TS_Q 4.0f
#endif
#ifndef DEBUG_TS_SHIFT
#define DEBUG_TS_SHIFT 0.0f
#endif
#define TS_STORE(k) do { if (c.bid == 0 && c.wave == 0) ((unsigned long long*)(c.ws + WS_CTL + 768 * 1024))[(k)] = __builtin_amdgcn_s_memrealtime(); } while (0)
#else
#define TS_STORE(k) do {} while (0)
#endif
#define SEAM(k) do { if (IN((k) + 1)) { GRID_BAR(); if (REPEAT_ID == 99) GRID_BAR(); } TS_STORE((k) + 1); } while (0)
#define PHASE_CTX() Ctx pc = c; { int z_ = 0, b_ = c.bid, g_ = c.G, w_ = c.wave; asm volatile("" : "+s"(z_), "+s"(b_), "+s"(g_), "+s"(w_)); \
        z_ = __builtin_amdgcn_readfirstlane(z_); b_ = __builtin_amdgcn_readfirstlane(b_); g_ = __builtin_amdgcn_readfirstlane(g_); w_ = __builtin_amdgcn_readfirstlane(w_); \
        pc.in = c.in + z_; pc.ws = c.ws + z_; pc.out = c.out + z_; pc.bid = b_; pc.G = g_; pc.wave = w_ & 7; \
        pc.lane = (int)(__builtin_amdgcn_mbcnt_hi(~0u, __builtin_amdgcn_mbcnt_lo(~0u, (unsigned)z_)) & 63u); pc.tid = pc.wave * 64 + pc.lane; } const int gw = pc.bid * NWAVES + pc.wave; const int NGW = pc.G * NWAVES; (void)gw; (void)NGW

    TS_STORE(0);
    if (EN(0) && IN(0)) { PHASE_CTX(); REP(0) phase_pre_a(pc); SEAM(0); }
    if (EN(1) && IN(1)) { PHASE_CTX(); REP(1) phase_modulate_mix(pc, 0); SEAM(1); }
#pragma unroll 1
    for (int l = 0; l < 2; ++l) {
        const int p0 = 2 + 11 * l; const bool first = (l == 0); const int nMa = first ? 68 : 64;
#define PHASE_PTRS() PHASE_CTX(); unsigned char* wt = pc.ws + WS_WT + (size_t)l * WT_LAYER; bf16_t* Z = (bf16_t*)(pc.ws + WS_RA); bf16_t* H = (bf16_t*)(pc.ws + WS_H); (void)wt; (void)Z; (void)H
        if (EN(2) && IN(p0 + 0)) { REP(20 + 0) { PHASE_PTRS();
            pg8::Gemm g{H, (const bf16_t*)(wt + WT_IN), D, D, D, 0, 0}; pg8::GOrder S; S.init(68, 35, 1, pc.G, pc.bid);
            EpiZ E{Z, pc.in[I_BGATE] + l * 3072};
            REP(2) pg8::gemm_phase<EpiZ, pg8::GOrder>(pc.lds, pc.tid, g, S, E); } SEAM(p0 + 0); }
        if (EN(3) && IN(p0 + 1)) { REP(20 + 1) { PHASE_PTRS();
#ifndef NO_G2G3
            REP(3) {
            { pg8::Gemm g{Z + ZCKV, (const bf16_t*)(wt + WT_UKV), NZ, 256, 256, 0, 0}; pg8::GOrder S; S.init(68, 8, 1, pc.G, pc.bid); EpiPlain E{(bf16_t*)(pc.ws + WS_RB + RB_KVRAW), 2048};
              pg8::gemm_phase<EpiPlain, pg8::GOrder>(pc.lds, pc.tid, g, S, E); }
            { pg8::Gemm g{Z + ZCQ, (const bf16_t*)(wt + WT_UQ), NZ, 384, 384, 0, 0}; pg8::GOrder S; S.init(nMa, 6, 1, pc.G, (pc.bid + pc.G - 32 % pc.G) % pc.G); EpiPlain E{(bf16_t*)(pc.ws + WS_RB + RB_QRAW), 1536};
              pg8::gemm_phase<EpiPlain, pg8::GOrder>(pc.lds, pc.tid, g, S, E); }
            }
#endif
#ifndef NO_MIXA
            REP(4) for (int u = (pc.bid + 8) % pc.G; u < nMa * 2 * 8; u += pc.G) mixA_unit(pc, l, u);
#endif
#ifndef NO_B1
            REP(5) for (int u = (pc.bid + pc.G - 184 % pc.G) % pc.G; u < 1088; u += pc.G) gla_b1_unit(pc, l, u);
#endif
            } SEAM(p0 + 1); }
        if (EN(4) && IN(p0 + 2)) { REP(20 + 2) { PHASE_PTRS();
            REP(6) {
                const bool b2wg = (pc.G >= 128) && pc.bid < 64;
                if (pc.tid < 32) *((volatile LAS unsigned*)(pc.lds + 3 * 33280 + 4 * 5120) + pc.tid) = 0u;
                __syncthreads();
                const bool role_b2 = (pc.G >= 128) ? b2wg : true;
                if (role_b2) {
#ifndef SKIP_B2
                    if (pc.G >= 128) gla_b2_unit(pc, pc.bid);
                    else { for (int u = pc.bid; u < 64; u += pc.G) { gla_b2_unit(pc, u); __syncthreads(); if (pc.tid < 32) *((volatile LAS unsigned*)(pc.lds + 3 * 33280 + 4 * 5120) + pc.tid) = 0u; __syncthreads(); } }
#endif
                }
                if (!role_b2 || pc.G < 128) {
#ifndef SKIP_C1
                  int wi, nwv;
                  if (pc.G >= 128) { nwv = (pc.G - 64) * NWAVES; wi = (pc.bid - 64) * NWAVES + pc.wave; }
                  else { nwv = pc.G * NWAVES; wi = pc.bid * NWAVES + pc.wave; }
                  if (wi < T) { C1Raw A = {}, B = {}; mla_c1_load(pc, wi, false, A);
                      for (int row = wi; row < T; row += 2 * nwv) { const int r1 = row + nwv, r2 = row + 2 * nwv;
                          if (r1 < T) mla_c1_load(pc, r1, false, B);
                          mla_c1_row(pc, l, row, false, A);
                          if (r2 < T) mla_c1_load(pc, r2, false, A);
                          if (r1 < T) mla_c1_row(pc, l, r1, false, B); } }
#endif
                }
            }
            } SEAM(p0 + 2); }
        if (EN(5) && IN(p0 + 3)) { REP(20 + 3) { PHASE_PTRS();
#ifndef NO_FIN
            REP(7) { const int nrow = nMa * 256; if (gw < nrow) { FinRaw A = {}, B = {}; gla_finish_load(pc, gw, A);
                for (int row = gw; row < nrow; row += 2 * NGW) { const int r1 = row + NGW, r2 = row + 2 * NGW;
                    if (r1 < nrow) gla_finish_load(pc, r1, B);
                    gla_finish_row(pc, l, row, A);
                    if (r2 < nrow) gla_finish_load(pc, r2, A);
                    if (r1 < nrow) gla_finish_row(pc, l, r1, B); } } }
#endif
            bf16_t* Y = (bf16_t*)(pc.ws + WS_RB + RB_YCAT) + 2048;
            const bf16_t* KG = (const bf16_t*)(pc.ws + WS_RB + RB_KG); const bf16_t* VG = (const bf16_t*)(pc.ws + WS_RB + RB_VG);
            const int G8 = pc.G >> 3;
            REP(8) for (int i = 0;; ++i) {
                int un; if ((pc.G & 7) == 0 && (G8 & 15) == 0) { const int x = pc.bid & 7, s = pc.bid >> 3, ppx = G8 >> 4; un = ((i * 8 * ppx) + x * ppx + (s >> 4)) * 16 + (s & 15); } else un = i * pc.G + pc.bid;
                if (un >= 512) break;
                const int bh = un >> 4, qb = un & 15, b = bh >> 3, h = bh & 7;
                attn_unit(pc, l, (const bf16_t*)(pc.ws + WS_RB + RB_QRAW) + (size_t)(b * SEQ + qb * 256) * 1536 + h * 192, (const float*)(pc.ws + WS_RSQ) + b * SEQ + qb * 256, qb * 256, KG + ((size_t)b * NKEY * 8 + h) * 192, VG + ((size_t)b * NKEY * 8 + h) * 128, 68, Y + (size_t)(b * SEQ + qb * 256) * 3072 + h * 128); }
            if (first) for (int un = pc.bid; un < 32; un += pc.G) { const int b = un >> 3, h = un & 7;
                attn_unit(pc, l, (const bf16_t*)(pc.ws + WS_RB + RB_QRAW) + (size_t)(TL + b * CTXL) * 1536 + h * 192, (const float*)(pc.ws + WS_RSQ) + TL + b * CTXL, -1, KG + ((size_t)b * NKEY * 8 + h) * 192, VG + ((size_t)b * NKEY * 8 + h) * 128, 4, Y + (size_t)(TL + b * CTXL) * 3072 + h * 128); }
            } SEAM(p0 + 3); }
        if (EN(6) && IN(p0 + 4)) { REP(20 + 4) { PHASE_PTRS();
            pg8::Gemm g{(const bf16_t*)(pc.ws + WS_RB + RB_YCAT), (const bf16_t*)(wt + WT_M), 3072, 3072, 3072, 0, 0}; pg8::GOrder S; S.init(64, 4, 1, pc.G, pc.bid);
            EpiMerge E{(bf16_t*)(pc.ws + WS_RB + RB_MERGED), Z};
            REP(9) pg8::gemm_phase<EpiMerge, pg8::GOrder>(pc.lds, pc.tid, g, S, E);
            if (first) for (int u = pc.bid; u < 256; u += pc.G) ctx_merge_unit(pc, l, u); } SEAM(p0 + 4); }
        if (EN(7) && IN(p0 + 5)) { REP(20 + 5) { PHASE_PTRS();
            pg8::Gemm g{(const bf16_t*)(pc.ws + WS_RB + RB_MERGED), (const bf16_t*)(wt + WT_OUT), D, D, D, 0, 0}; pg8::GOrder S; S.init(64, 4, 1, pc.G, pc.bid);
            EpiResid E{&pc, l, (REPEAT_ID == 25 && rep_ == 0) ? (float*)(pc.ws + WS_RA) : nullptr};
            pg8::gemm_phase<EpiResid, pg8::GOrder>(pc.lds, pc.tid, g, S, E);
            if (first) for (int u = pc.bid; u < 256; u += pc.G) ctx_out_unit(pc, l, u); } SEAM(p0 + 5); }
        if (EN(8) && IN(p0 + 6)) { REP(20 + 6) { PHASE_PTRS();
            REP(11) { route_stage_w(pc, l); const int nrow = nMa * 256;
                if (gw < nrow) { RouteRaw A = {}, B = {}; route_load(pc, gw, A);
                    for (int row = gw; row < nrow; row += 2 * NGW) { const int r1 = row + NGW, r2 = row + 2 * NGW;
                        if (r1 < nrow) route_load(pc, r1, B);
                        route_row(pc, l, row, A);
                        if (r2 < nrow) route_load(pc, r2, A);
                        if (r1 < nrow) route_row(pc, l, r1, B); } }
                __syncthreads(); }
            } SEAM(p0 + 6); }
        if (EN(9) && IN(p0 + 7)) { REP(20 + 7) { PHASE_PTRS();
            REP(13) for (int u = pc.bid; u < 64; u += pc.G) topk_unit(pc, u, false);
            if (first) for (int u = pc.bid; u < 64; u += pc.G) topk_unit(pc, u, true);
            REP(12) expert_wconv(pc, l);
            } SEAM(p0 + 7); }
        if (EN(10) && IN(p0 + 8)) { REP(20 + 8) { PHASE_PTRS();
            pg8::Gemm g{(const bf16_t*)(pc.ws + WS_RA + RA_XS), (const bf16_t*)(pc.ws + WS_RB + RB_WGU), D, D, D, (size_t)ESLOTS * D, (size_t)4096 * D}; pg8::GOrder S; S.init(first ? 9 : 8, 16, 16, pc.G, pc.bid);
            EpiSwiGLU E{(bf16_t*)(pc.ws + WS_RA + RA_HID)};
            REP(14) pg8::gemm_phase<EpiSwiGLU, pg8::GOrder>(pc.lds, pc.tid, g, S, E); } SEAM(p0 + 8); }
        if (EN(11) && IN(p0 + 9)) { REP(20 + 9) { PHASE_PTRS();
            pg8::Gemm g{(const bf16_t*)(pc.ws + WS_RA + RA_HID), (const bf16_t*)(pc.ws + WS_RB + RB_WD), DEXP, DEXP, DEXP, (size_t)ESLOTS * DEXP, (size_t)D * DEXP}; pg8::GOrder S; S.init(first ? 9 : 8, 4, 16, pc.G, pc.bid);
            EpiDown E{(bf16_t*)(pc.ws + WS_RA + RA_YS), (const float*)(pc.ws + WS_GATEV)};
            REP(15) pg8::gemm_phase<EpiDown, pg8::GOrder>(pc.lds, pc.tid, g, S, E); } SEAM(p0 + 9); }
        if (EN(12) && IN(p0 + 10)) { REP(20 + 10) { PHASE_PTRS();
            { const int nrow = nMa * 256; float* dmy = (REPEAT_ID == 30 && rep_ == 0) ? (float*)(pc.ws + WS_RB) : nullptr;
              if (gw < nrow) { CombRaw A = {}, B = {}; combine_load(pc, gw, A);
                  for (int row = gw; row < nrow; row += 2 * NGW) { const int r1 = row + NGW, r2 = row + 2 * NGW;
                      if (r1 < nrow) combine_load(pc, r1, B);
                      combine_row(pc, l, row, first, A, dmy);
                      if (r2 < nrow) combine_load(pc, r2, A);
                      if (r1 < nrow) combine_row(pc, l, r1, first, B, dmy); } } }
            } SEAM(p0 + 10); }
    }
#if defined(DEBUG_TS_A)
    { GRID_BAR(); const unsigned long long* ts = (const unsigned long long*)(c.ws + WS_CTL + 768 * 1024);
      float a = (float)(__hip_atomic_load(ts + DEBUG_TS_A + 1, __ATOMIC_RELAXED, __HIP_MEMORY_SCOPE_AGENT) - __hip_atomic_load(ts + DEBUG_TS_A, __ATOMIC_RELAXED, __HIP_MEMORY_SCOPE_AGENT)) * 1e-2f;
      float b = (float)(__hip_atomic_load(ts + DEBUG_TS_B + 1, __ATOMIC_RELAXED, __HIP_MEMORY_SCOPE_AGENT) - __hip_atomic_load(ts + DEBUG_TS_B, __ATOMIC_RELAXED, __HIP_MEMORY_SCOPE_AGENT)) * 1e-2f;
      a = exp2f(rintf(log2f(fmaxf(a, 1.f)) * DEBUG_TS_Q + DEBUG_TS_SHIFT) / DEBUG_TS_Q) * 1e-2f; b = exp2f(rintf(log2f(fmaxf(b, 1.f)) * DEBUG_TS_Q + DEBUG_TS_SHIFT) / DEBUG_TS_Q) * 1e-2f;
      const int tid_ = c.wave * 64 + (int)__builtin_amdgcn_mbcnt_hi(~0u, __builtin_amdgcn_mbcnt_lo(~0u, 0u));
      for (long i = (long)c.bid * NTHR + tid_; i < (long)TL * D; i += (long)c.G * NTHR) c.out[i] = (i == 0) ? 131072.0f * b : 1024.0f * a; }
#endif
}

extern "C" void kernel_launch(void* const* d_in, const int* in_sizes, int n_in, void* d_out, int out_size, void* d_ws, size_t ws_size, hipStream_t stream) {
    static int grid = 0;
    if (!grid) {
        int dev = 0, cus = 0, per_cu = 0;
        (void)hipGetDevice(&dev); (void)hipDeviceGetAttribute(&cus, hipDeviceAttributeMultiprocessorCount, dev);
        (void)hipFuncSetAttribute((const void*)fwd, hipFuncAttributeMaxDynamicSharedMemorySize, LDS_BYTES);
        (void)hipOccupancyMaxActiveBlocksPerMultiprocessor(&per_cu, fwd, NTHR, LDS_BYTES);
        grid = cus * (per_cu < 1 ? per_cu : 1);
        if (grid <= 0) { fprintf(stderr, "occupancy query returned 0 blocks per CU\n"); grid = cus; }
        if (ws_size < WS_END) fprintf(stderr, "workspace too small: %zu < %zu\n", ws_size, (size_t)WS_END);
    }
    (void)hipMemsetAsync((unsigned char*)d_ws + WS_CTL, 0, CTL_BYTES, stream);
    Args a{}; for (int i = 0; i < N_INPUTS; ++i) a.in[i] = (const float*)d_in[i]; a.out = (float*)d_out; a.ws = (unsigned char*)d_ws;
#if MK_FUSED
    a.ph_lo = 0; a.ph_hi = NPH;
    hipLaunchKernelGGL(fwd, dim3(grid), dim3(NTHR), LDS_BYTES, stream, a);
#else
#if defined(DEBUG_SCAN)
    hipLaunchKernelGGL(k_seterr, dim3(1), dim3(1), 0, stream, (int*)((unsigned char*)d_ws + WS_CTL + 512 * 1024));
#endif
    for (int p = 0; p < NPH; ++p) { a.ph_lo = p; a.ph_hi = p + 1;
#if defined(DEBUG_SCAN)
        if (p == 3) (void)hipMemsetAsync((unsigned char*)d_ws + WS_RB + RB_OINTRA, 0xff, (size_t)T * D * 2, stream);
#endif
        hipLaunchKernelGGL(fwd, dim3(grid), dim3(NTHR), LDS_BYTES, stream, a);
#if defined(DEBUG_SCAN)
#if defined(DEBUG_HASH)
        if (p == DEBUG_HASH_PHASE) { (void)hipMemsetAsync((unsigned char*)d_ws + WS_CTL + 512 * 1024 + 256, 0, 4, stream);
            hipLaunchKernelGGL(k_hash, dim3(512), dim3(256), 0, stream, (const unsigned*)((unsigned char*)d_ws + DEBUG_HASH_OFF), (long)(DEBUG_HASH_BYTES / 4), (unsigned*)((unsigned char*)d_ws + WS_CTL + 512 * 1024 + 256)); }
#else
        debug_after_phase(p, (unsigned char*)d_ws, (float*)d_out, stream);
#endif
#endif
    }
#if defined(DEBUG_SCAN)
#if defined(DEBUG_HASH)
    hipLaunchKernelGGL(k_apply_hash, dim3(1024), dim3(256), 0, stream, (float*)d_out, (long)out_size, (const unsigned*)((unsigned char*)d_ws + WS_CTL + 512 * 1024 + 256));
#elif defined(DEBUG_STAT)
    hipLaunchKernelGGL(k_apply_stat, dim3(1024), dim3(256), 0, stream, (float*)d_out, (long)out_size, (const int*)((unsigned char*)d_ws + WS_CTL + 512 * 1024));
#else
    hipLaunchKernelGGL(k_apply, dim3(1024), dim3(256), 0, stream, (float*)d_out, (long)out_size, (const int*)((unsigned char*)d_ws + WS_CTL + 512 * 1024));
#endif
#endif
#endif
}
```

```cpp
#define MK_FUSED 1
#include <hip/hip_runtime.h>
#include <cstdint>
#include <cstdio>

#define LAS __attribute__((address_space(3)))
#define GAS __attribute__((address_space(1)))
typedef unsigned short bf16_t;
typedef short bf16x8 __attribute__((ext_vector_type(8)));
typedef short bf16x4 __attribute__((ext_vector_type(4)));
typedef float f32x4 __attribute__((ext_vector_type(4)));
typedef float f32x2 __attribute__((ext_vector_type(2)));
typedef float f32x16 __attribute__((ext_vector_type(16)));
typedef unsigned u32x4 __attribute__((ext_vector_type(4)));
typedef unsigned u32x2 __attribute__((ext_vector_type(2)));

typedef __bf16 bf16v2_t __attribute__((ext_vector_type(2)));
__device__ __forceinline__ unsigned cvt_pk_bf16(float lo, float hi) { bf16v2_t v; v[0] = (__bf16)lo; v[1] = (__bf16)hi; return __builtin_bit_cast(unsigned, v); }
__device__ __forceinline__ bf16_t f2bf(float f) { return (bf16_t)(cvt_pk_bf16(f, 0.f) & 0xffffu); }
__device__ __forceinline__ float bf2f(bf16_t b) { return __uint_as_float(((unsigned)b) << 16); }
__device__ __forceinline__ float bflo(unsigned w) { return __uint_as_float(w << 16); }
__device__ __forceinline__ float bfhi(unsigned w) { return __uint_as_float(w & 0xffff0000u); }
template <int K> __device__ __forceinline__ float sx(float v) { static_assert(K >= 1 && K < 32, "xor mask inside a 32-lane half"); return __int_as_float(__builtin_amdgcn_ds_swizzle(__float_as_int(v), (K << 10) | 0x1F)); }
__device__ __forceinline__ float sum32(float v) { auto rr = __builtin_amdgcn_permlane32_swap(__float_as_uint(v), __float_as_uint(v), false, false); return __uint_as_float(rr[0]) + __uint_as_float(rr[1]); }
__device__ __forceinline__ float max32(float v) { auto rr = __builtin_amdgcn_permlane32_swap(__float_as_uint(v), __float_as_uint(v), false, false); return fmaxf(__uint_as_float(rr[0]), __uint_as_float(rr[1])); }
__device__ __forceinline__ float half_sum(float v) { v += sx<1>(v); v += sx<2>(v); v += sx<4>(v); v += sx<8>(v); v += sx<16>(v); return v; }
__device__ __forceinline__ float wave_sum(float v) { return sum32(half_sum(v)); }
__device__ __forceinline__ float bperm(float v, int src) { return __int_as_float(__builtin_amdgcn_ds_bpermute(src << 2, __float_as_int(v))); }
__device__ __forceinline__ unsigned bperm(unsigned v, int src) { return (unsigned)__builtin_amdgcn_ds_bpermute(src << 2, (int)v); }
__device__ __forceinline__ float fast_rcp(float x) { return __builtin_amdgcn_rcpf(x); }
__device__ __forceinline__ float fast_exp(float x) { return __builtin_amdgcn_exp2f(x * 1.4426950408889634f); }
__device__ __forceinline__ float sigmoidf_(float x) { return fast_rcp(1.f + fast_exp(-x)); }
__device__ __forceinline__ float siluf_(float x) { return x * sigmoidf_(x); }

namespace pg8 {
constexpr int BM = 256, BK = 64, HALF = 128, HTB = HALF * BK * 2, STAGE_BYTES = 8 * HTB, NXCD = 8, WGM = 8;
__host__ __device__ __forceinline__ int lds_byte(int r, int c) { const int st = (r >> 4) * 2 + (c >> 5), rr = r & 15, cc = c & 31, ob = rr * 64 + cc * 2; return st * 1024 + (ob ^ (((ob >> 9) & 1) << 5)); }
__host__ __device__ __forceinline__ void stage_rc(int b, int& R, int& C) { const int st = b / 1024, sb = b % 1024, swz = sb ^ (((sb >> 9) & 1) << 5); R = (st >> 1) * 16 + swz / 64; C = (st & 1) * 32 + (swz % 64) / 2; }
__host__ __device__ __forceinline__ int perm32(int rho) { const int n = rho >> 4, i = rho & 15; return 8 * (i >> 2) + 4 * n + (i & 3); }

struct Unit { int pm, pn, g, ko; };
struct Gemm { const bf16_t* A; const bf16_t* Bt; int lda, ldb, K; size_t gstrideA, gstrideB; };

struct GOrder {
    static constexpr bool KOFF = false;
    int nM, nN, nG, nwg, G, c, pm0;
    __device__ void init(int nM_, int nN_, int nG_, int G_, int c_, int pm0_ = 0) { nM = nM_; nN = nN_; nG = nG_; nwg = nM * nN * nG; G = G_; c = c_; pm0 = pm0_; }
    __device__ bool next(int i, Unit& u) const {
        const long L = (long)i * G + c; if (L >= nwg) return false;
        int wgid = (int)L; { const int q = nwg / NXCD, r = nwg % NXCD, xcd = wgid % NXCD, off = wgid / NXCD; wgid = (xcd < r ? xcd * (q + 1) : r * (q + 1) + (xcd - r) * q) + off; }
        const int per = nM * nN; u.g = wgid / per; wgid -= u.g * per;
        const int nig = WGM * nN, gid = wgid / nig, fm = gid * WGM, gsz = (nM - fm) < WGM ? (nM - fm) : WGM;
        u.pm = pm0 + fm + ((wgid % nig) % gsz); u.pn = (wgid % nig) / gsz; return true;
    }
};

struct GOrderCtxCols { static constexpr bool KOFF = false; GOrder o;
    __device__ bool next(int i, Unit& u) const { if (!o.next(i, u)) return false; u.pn = u.pn < 6 ? 10 + u.pn : 15 + u.pn; return true; } };

struct KSplitOrder { static constexpr bool KOFF = true; int G, c;
    __device__ bool next(int i, Unit& u) const { const int L = i * G + c; if (L >= 256) return false; u.g = L >> 4; u.pm = 8; u.pn = (L >> 2) & 3; u.ko = (L & 3) * 512; return true; } };

template <class Epi, class Sched>
__device__ __forceinline__ void gemm_phase(LAS unsigned char* lds, const int tid, const Gemm g, const Sched& S, const Epi& E) {
    const int wid = __builtin_amdgcn_readfirstlane(tid >> 6), lane = tid & 63, wr = wid >> 2, wc = wid & 3, fr = lane & 15, fq = lane >> 4;
    const int K = g.K, nt = K / BK;
    unsigned voffA[2], voffB[2];
#pragma unroll
    for (int i = 0; i < 2; ++i) { int R, C; stage_rc(tid * 16 + i * 8192, R, C); const int Rb = Epi::PERM ? ((R & ~31) + perm32(R & 31)) : R;
        voffA[i] = (unsigned)(R * g.lda + C) * 2u; voffB[i] = (unsigned)(Rb * g.ldb + C) * 2u; }
    const size_t kstep = (size_t)(BK * 2);
    const size_t hstepA = (size_t)HALF * g.lda * 2, hstepB = (size_t)HALF * g.ldb * 2;
    const size_t tstepA = 2 * hstepA, tstepB = 2 * hstepB;
    const unsigned ldsw = (unsigned)wid * 1024u;
    const int aoff = lds_byte(wr * 64 + fr, fq * 8), boff = lds_byte(wc * 32 + fr, fq * 8);
#define PG8_SA(b, h) (((b) * 2 + (h)) * HTB)
#define PG8_SB(b, h) ((4 + (b) * 2 + (h)) * HTB)
#define PG8_STAGE(bufoff, gbase, voff) do { _Pragma("unroll") for (int _i = 0; _i < 2; ++_i) \
        __builtin_amdgcn_global_load_lds((const unsigned*)((const char*)(gbase) + (voff)[_i]), (LAS unsigned*)(lds + (bufoff) + ldsw + _i * 8192), 16, 0, 0); } while (0)
#define PG8_LDA(dst, b, h) do { _Pragma("unroll") for (int m = 0; m < 4; ++m) _Pragma("unroll") for (int k = 0; k < 2; ++k) dst[m][k] = *(const LAS bf16x8*)(lds + PG8_SA(b, h) + aoff + m * 2048 + k * 1024); } while (0)
#define PG8_LDB(dst, b, h) do { _Pragma("unroll") for (int n = 0; n < 2; ++n) _Pragma("unroll") for (int k = 0; k < 2; ++k) dst[n][k] = *(const LAS bf16x8*)(lds + PG8_SB(b, h) + boff + n * 2048 + k * 1024); } while (0)
#define PG8_MMA(ai, bj, At, Bt) do { __builtin_amdgcn_s_setprio(1); _Pragma("unroll") for (int m = 0; m < 4; ++m) _Pragma("unroll") for (int n = 0; n < 2; ++n) _Pragma("unroll") for (int k = 0; k < 2; ++k) \
        acc[ai][bj][m][n] = __builtin_amdgcn_mfma_f32_16x16x32_bf16(Bt[n][k], At[m][k], acc[ai][bj][m][n], 0, 0, 0); __builtin_amdgcn_s_setprio(0); } while (0)
#define PG8_WAIT_V(n) asm volatile("s_waitcnt vmcnt(" #n ")" ::: "memory")
#define PG8_WAIT_L(n) asm volatile("s_waitcnt lgkmcnt(" #n ")" ::: "memory")
#define PG8_BAR __builtin_amdgcn_s_barrier()
#define PG8_SCHED __builtin_amdgcn_sched_barrier(0)
    Unit cur, nxt; int ui = 0;
    if (!S.next(0, cur)) return;
    f32x4 acc[2][2][4][2];
#pragma unroll
    for (int a = 0; a < 2; ++a)
#pragma unroll
        for (int b = 0; b < 2; ++b)
#pragma unroll
            for (int m = 0; m < 4; ++m)
#pragma unroll
                for (int n = 0; n < 2; ++n) acc[a][b][m][n] = (f32x4){0.f, 0.f, 0.f, 0.f};
    bf16x8 At[4][2], B0[2][2], B1[2][2];
    const char* cA = (const char*)(g.A + (size_t)cur.g * g.gstrideA) + (size_t)cur.pm * tstepA; const char* cB = (const char*)(g.Bt + (size_t)cur.g * g.gstrideB) + (size_t)cur.pn * tstepB;
    if constexpr (Sched::KOFF) { cA += (size_t)cur.ko * 2; cB += (size_t)cur.ko * 2; }
    PG8_STAGE(PG8_SB(0, 0), cB, voffB); PG8_STAGE(PG8_SB(0, 1), cB + hstepB, voffB); PG8_STAGE(PG8_SA(0, 0), cA, voffA); PG8_STAGE(PG8_SA(0, 1), cA + hstepA, voffA);
    if (wr == 1) PG8_BAR;
    PG8_WAIT_V(2); PG8_BAR;
    PG8_STAGE(PG8_SB(1, 0), cB + kstep, voffB); PG8_STAGE(PG8_SA(1, 0), cA + kstep, voffA); PG8_STAGE(PG8_SB(1, 1), cB + hstepB + kstep, voffB);
    PG8_WAIT_V(6); PG8_BAR;
    for (;;) {
        const bool has_next = S.next(ui + 1, nxt);
        const char* nA = has_next ? (const char*)(g.A + (size_t)nxt.g * g.gstrideA) + (size_t)nxt.pm * tstepA + (Sched::KOFF ? (size_t)nxt.ko * 2 : (size_t)0) : cA; const char* nB = has_next ? (const char*)(g.Bt + (size_t)nxt.g * g.gstrideB) + (size_t)nxt.pn * tstepB + (Sched::KOFF ? (size_t)nxt.ko * 2 : (size_t)0) : cB;
        for (int t = 0; t < nt; t += 2) {
            const bool last = (t == nt - 2);
            const char* a1 = cA + (size_t)(t + 1) * kstep;
            const char* a2 = last ? nA : cA + (size_t)(t + 2) * kstep; const char* b2 = last ? nB : cB + (size_t)(t + 2) * kstep;
            const char* a3 = a2 + kstep; const char* b3 = b2 + kstep;
            if constexpr (Epi::MID) { if (t == 16 || t == 32) E.mid(acc, cur, t, wr, wc, fr, fq); }
            PG8_LDB(B0, 0, 0); PG8_LDB(B1, 0, 1); PG8_SCHED; PG8_LDA(At, 0, 0); PG8_STAGE(PG8_SA(1, 1), a1 + hstepA, voffA);
            PG8_WAIT_V(8); PG8_WAIT_L(0); PG8_BAR; PG8_MMA(0, 0, At, B0); PG8_MMA(0, 1, At, B1); PG8_BAR; PG8_SCHED;
            PG8_LDA(At, 0, 1); PG8_STAGE(PG8_SB(0, 0), b2, voffB); PG8_STAGE(PG8_SB(0, 1), b2 + hstepB, voffB); PG8_STAGE(PG8_SA(0, 0), a2, voffA);
            PG8_WAIT_V(8); PG8_WAIT_L(0); PG8_BAR; PG8_MMA(1, 0, At, B0); PG8_MMA(1, 1, At, B1); PG8_BAR; PG8_SCHED;
            PG8_LDB(B0, 1, 0); PG8_LDB(B1, 1, 1); PG8_SCHED; PG8_LDA(At, 1, 0); PG8_STAGE(PG8_SA(0, 1), a2 + hstepA, voffA);
            PG8_WAIT_V(8); PG8_WAIT_L(0); PG8_BAR; PG8_MMA(0, 0, At, B0); PG8_MMA(0, 1, At, B1); PG8_BAR; PG8_SCHED;
            PG8_LDA(At, 1, 1); PG8_STAGE(PG8_SB(1, 0), b3, voffB); PG8_STAGE(PG8_SB(1, 1), b3 + hstepB, voffB); PG8_STAGE(PG8_SA(1, 0), a3, voffA);
            PG8_WAIT_V(8); PG8_WAIT_L(0); PG8_BAR; PG8_MMA(1, 0, At, B0); PG8_MMA(1, 1, At, B1); PG8_BAR; PG8_SCHED;
        }
        if (wr == 0) PG8_BAR;
        E(acc, cur, wr, wc, fr, fq);
        if (!has_next) break;
#pragma unroll
        for (int a = 0; a < 2; ++a)
#pragma unroll
            for (int b = 0; b < 2; ++b)
#pragma unroll
                for (int m = 0; m < 4; ++m)
#pragma unroll
                    for (int n = 0; n < 2; ++n) acc[a][b][m][n] = (f32x4){0.f, 0.f, 0.f, 0.f};
        cur = nxt; cA = nA; cB = nB; ++ui;
        if (wr == 1) PG8_BAR;
    }
    PG8_WAIT_V(0);
    PG8_BAR;
#undef PG8_SA
#undef PG8_SB
#undef PG8_STAGE
#undef PG8_LDA
#undef PG8_LDB
#undef PG8_MMA
#undef PG8_WAIT_V
#undef PG8_WAIT_L
#undef PG8_BAR
#undef PG8_SCHED
}
}
#define XB_TMO      128
#define XB_XCNT(j)  (256  + 64 * (j))
#define XB_XSUB(j)  (1280 + 64 * (j))
#define XB_XGEN(j)  (2304 + 64 * (j))
#define XB_TOP      3328
#define XB_TOPGEN   3392
#define XCD_BAR_WORDS 3456
#define XB_SPIN_CAP (1u << 18)

__device__ __forceinline__ unsigned xb_ld(unsigned* p)              { return __hip_atomic_load(p, __ATOMIC_RELAXED, __HIP_MEMORY_SCOPE_AGENT); }
__device__ __forceinline__ unsigned xb_add(unsigned* p, unsigned v) { return __hip_atomic_fetch_add(p, v, __ATOMIC_RELAXED, __HIP_MEMORY_SCOPE_AGENT); }
__device__ __forceinline__ unsigned xb_xcc_id() { return (unsigned)__builtin_amdgcn_s_getreg((3 << 11) | 20) & 0xFu; }
#define XB_SPIN(cond, bar) do { unsigned _sp = 0; while (cond) { __builtin_amdgcn_s_sleep(1); \
    if ((++_sp & 255u) == 0u) { if (xb_ld(&(bar)[XB_TMO])) break; if (_sp > XB_SPIN_CAP) { atomicAdd(&(bar)[XB_TMO], 1u); break; } } } } while (0)

struct XcdBarrier {
    unsigned* bar; unsigned x;
    volatile LAS unsigned* st;
};

__device__ __forceinline__ XcdBarrier xcd_barrier_post(unsigned* bar, volatile LAS unsigned* st) {
    XcdBarrier b; b.bar = bar; b.x = xb_xcc_id(); b.st = st;
    if (threadIdx.x == 0) (void)xb_add(&bar[XB_XCNT(b.x)], 1u);
    return b;
}
__device__ __forceinline__ void xcd_barrier_complete(unsigned* bar, unsigned x, unsigned& nloc, unsigned& nx) {
    const unsigned G = gridDim.x * gridDim.y * gridDim.z;
    unsigned sum, cnt, mine, sp = 0u;
    for (;;) {
        sum = 0u; cnt = 0u; mine = 0u;
#pragma unroll
        for (unsigned j = 0; j < 16; ++j) { const unsigned c = xb_ld(&bar[XB_XCNT(j)]); sum += c; cnt += (c > 0u) ? 1u : 0u; mine = (j == x) ? c : mine; }
        if (sum == G) break;
        __builtin_amdgcn_s_sleep(1);
        if ((++sp & 255u) == 0u) { if (xb_ld(&bar[XB_TMO])) break; if (sp > XB_SPIN_CAP) { atomicAdd(&bar[XB_TMO], 1u); break; } }
    }
    nloc = mine > 0u ? mine : 1u; nx = cnt > 0u ? cnt : 1u;
}

__device__ __forceinline__ void xcd_barrier(const XcdBarrier& b) {
    asm volatile("s_waitcnt vmcnt(0)" ::: "memory");
    __syncthreads();
    unsigned long long bp_ = (unsigned long long)b.bar; unsigned bx_ = b.x; asm volatile("" : "+s"(bp_), "+s"(bx_)); bx_ = (unsigned)__builtin_amdgcn_readfirstlane((int)bx_); bp_ = ((unsigned long long)(unsigned)__builtin_amdgcn_readfirstlane((int)(bp_ >> 32)) << 32) | (unsigned)__builtin_amdgcn_readfirstlane((int)bp_);
    if (threadIdx.x == 0) {
        unsigned* bar = (unsigned*)bp_;
        __builtin_amdgcn_s_waitcnt(0);
        unsigned nloc = b.st[0], nx = b.st[1];
        if (nloc == 0u) { xcd_barrier_complete(bar, bx_, nloc, nx); b.st[0] = nloc; b.st[1] = nx; }
        const unsigned old = xb_add(&bar[XB_XSUB(bx_)], 1u);
        const unsigned gen = old / nloc;
        if (old + 1u == (gen + 1u) * nloc) {
            __builtin_amdgcn_fence(__ATOMIC_RELEASE, "agent");
            asm volatile("s_waitcnt vmcnt(0)" ::: "memory");
            const unsigned og = xb_add(&bar[XB_TOP], 1u);
            const unsigned tg = og / nx;
            if (og + 1u == (tg + 1u) * nx) xb_add(&bar[XB_TOPGEN], 1u);
            else XB_SPIN(xb_ld(&bar[XB_TOPGEN]) == tg, bar);
            __builtin_amdgcn_fence(__ATOMIC_ACQUIRE, "agent");
            xb_add(&bar[XB_XGEN(bx_)], 1u);
            asm volatile("s_waitcnt vmcnt(0)" ::: "memory");
        } else {
            XB_SPIN(xb_ld(&bar[XB_XGEN(bx_)]) == gen, bar);
            __builtin_amdgcn_fence(__ATOMIC_ACQUIRE, "agent");
            asm volatile("s_waitcnt vmcnt(0)" ::: "memory");
        }
    }
    __syncthreads();
}

namespace cfg {
constexpr int D = 1024, NB = 4, SEQ = 4096, CTXL = 256, TL = NB * SEQ, TC = NB * CTXL, T = TL + TC;
constexpr int NZ = 8960;
constexpr int ZU = 0, ZVA = 1024, ZQB = 2048, ZKB = 2560, ZVB = 3072, ZRB = 4096, ZCQ = 5120, ZKR = 5504, ZDEC = 5568, ZCKV = 5632, ZGT = 5888;
constexpr int NKEY = CTXL + SEQ;
constexpr int NEXP = 16, DEXP = 2048, CAPL = 512, CAPC = 32, ESLOTS = 2304;
constexpr float EPS = 1e-6f;
constexpr int NWAVES = 8, NTHR = 512;
constexpr size_t MiB = 1u << 20;
constexpr size_t WS_CTL = 0, CTL_BYTES = 1 * MiB;
constexpr size_t WS_MOD = 1 * MiB;
constexpr size_t WS_GATEV = WS_MOD + 512 * 1024;
constexpr size_t WS_AFFT = 2 * MiB;
constexpr size_t WS_SEL = 4 * MiB;
constexpr size_t WS_RSQ = 4 * MiB + 1536 * 1024;
constexpr size_t WS_XC = 6 * MiB;
constexpr size_t WS_H = 10 * MiB;
constexpr size_t WS_WT = 44 * MiB, WT_LAYER = 28 * MiB;
constexpr size_t WT_IN = 0, WT_UQ = 17 * MiB + 512 * 1024, WT_UKV = WT_UQ + 1152 * 1024, WT_M = WT_UKV + 1 * MiB, WT_OUT = WT_M + 6 * MiB, WT_S = WT_OUT + 2 * MiB;
static_assert(WT_S + 256 * 1024 <= WT_LAYER, "weights");
constexpr size_t WS_RA = 100 * MiB;
constexpr size_t RA_XS = 0, RA_HID = 72 * MiB, RA_YS = 216 * MiB;
constexpr size_t WS_RB = 398 * MiB;
constexpr size_t RB_YCAT = 0, RB_KVRAW = 102 * MiB, RB_MERGED = 102 * MiB, RB_QRAW = 170 * MiB, RB_KG = 221 * MiB, RB_VG = 272 * MiB, RB_QFL = 306 * MiB, RB_QFC = 354 * MiB,
                 RB_QDF = 357 * MiB, RB_KDT = 391 * MiB, RB_VTG = 425 * MiB, RB_DECAY = 459 * MiB, RB_OINTRA = 461 * MiB, RB_OF = 495 * MiB, RB_OB = 529 * MiB, RB_END = 563 * MiB;
constexpr size_t RB_WGU = 0, RB_WD = 128 * MiB, RB_YSC = 200 * MiB;
constexpr size_t WS_END = WS_RB + RB_END;
constexpr int LDS_BYTES = 147456;
constexpr int LDS_MISC = 145408;
}
using namespace cfg;

enum { I_X = 0, I_C, I_CTX, I_CCTX, I_WMOD, I_BMOD, I_GMIX, I_GFFN, I_WIN, I_BGATE, I_WS, I_BS, I_WDEC, I_BDEC, I_GGLA, I_GCQ, I_GCKV, I_WUQ, I_WUKV,
       I_GQN, I_GQR, I_GKN, I_GKR, I_WPA, I_WPB, I_WPC, I_WOUT, I_WROUTER, I_WEG, I_WEU, I_WED, N_INPUTS };

struct Args { const float* in[N_INPUTS]; float* out; unsigned char* ws; int ph_lo, ph_hi; };

struct Ctx {
    const float* const* in; float* out; unsigned char* ws; LAS unsigned char* lds;
    int tid, lane, wave, G, bid;
};
__device__ __forceinline__ int row_modidx(int row) { return row < TL ? (row >> 12) : 4; }
__device__ __forceinline__ const float* modp(const Ctx& c, int l, int bi, int which) { return (const float*)(c.ws + WS_MOD) + ((size_t)(l * 5 + bi) * 6 + which) * D; }
__device__ __forceinline__ const float* xin_row(const Ctx& c, int l, int row) {
    if (row < TL) return (l == 0 ? c.in[I_X] : (const float*)c.out) + (size_t)row * D;
    return (l == 0 ? c.in[I_CTX] : (const float*)(c.ws + WS_XC)) + (size_t)(row - TL) * D;
}
__device__ __forceinline__ float* xout_row(const Ctx& c, int row) {
    if (row < TL) return c.out + (size_t)row * D;
    return (float*)(c.ws + WS_XC) + (size_t)(row - TL) * D;
}

#if defined(DEBUG_STAT)
__device__ __forceinline__ void dbg_max(const Ctx& c, int slot, float v) { v = fabsf(v); if (!(v < 1e30f)) v = 1e30f; atomicMax((unsigned*)(c.ws + WS_CTL + 512 * 1024) + 16 * slot, __float_as_uint(v)); }
#else
__device__ __forceinline__ void dbg_max(const Ctx&, int, float) {}
#endif
__device__ __forceinline__ void tconv_tile(const Ctx& c, const float* src, int ld_src, int k0, int c0, int nvalid, const float* kscale, bf16_t* dst, int ld_dst, int r0, int kd0) {
    LAS float* scr = (LAS float*)c.lds;
    const int tid = c.tid;
#pragma unroll
    for (int p = 0; p < 8; ++p) { const int k = p * 8 + (tid >> 6), n = tid & 63;
        float v = (n < nvalid) ? src[(size_t)(k0 + k) * ld_src + c0 + n] : 0.f; if (kscale) v *= kscale[k0 + k];
        scr[n * 65 + k] = v; }
    __syncthreads();
    { const int n = tid >> 3, kc = (tid & 7) * 8; const LAS float* s = scr + n * 65 + kc;
      u32x4 o; o.x = cvt_pk_bf16(s[0], s[1]); o.y = cvt_pk_bf16(s[2], s[3]); o.z = cvt_pk_bf16(s[4], s[5]); o.w = cvt_pk_bf16(s[6], s[7]);
      *(u32x4*)(dst + (size_t)(r0 + n) * ld_dst + kd0 + kc) = o; }
    __syncthreads();
}
template <int KQ>
__device__ __forceinline__ void tconv_kq(const Ctx& c, const float* src, int ld_src, int k0, int c0, int nvalid, const float* kscale, bf16_t* dst, int ld_dst, int r0, int kd0) {
    constexpr int LD = 64 * KQ + 1;
    LAS float* scr = (LAS float*)c.lds;
    const int tid = c.tid, n = tid & 63, kr = tid >> 6; float v[KQ][8];
    const bool ok = n < nvalid;
    const float* s0 = src + (size_t)(k0 + kr) * ld_src + c0 + n;
#pragma unroll
    for (int q = 0; q < KQ; ++q)
#pragma unroll
        for (int p = 0; p < 8; ++p) v[q][p] = ok ? s0[(size_t)(q * 64 + p * 8) * ld_src] : 0.f;
    if (kscale) {
#pragma unroll
        for (int q = 0; q < KQ; ++q)
#pragma unroll
            for (int p = 0; p < 8; ++p) v[q][p] *= kscale[k0 + q * 64 + p * 8 + kr]; }
#pragma unroll
    for (int q = 0; q < KQ; ++q)
#pragma unroll
        for (int p = 0; p < 8; ++p) scr[n * LD + q * 64 + p * 8 + kr] = v[q][p];
    __syncthreads();
    { const int nn = tid >> 3, kc = (tid & 7) * 8;
#pragma unroll
      for (int q = 0; q < KQ; ++q) { const LAS float* s = scr + nn * LD + q * 64 + kc;
          u32x4 o; o.x = cvt_pk_bf16(s[0], s[1]); o.y = cvt_pk_bf16(s[2], s[3]); o.z = cvt_pk_bf16(s[4], s[5]); o.w = cvt_pk_bf16(s[6], s[7]);
          *(u32x4*)(dst + (size_t)(r0 + nn) * ld_dst + kd0 + q * 64 + kc) = o; } }
    __syncthreads();
}
template <class RowMap>
__device__ __forceinline__ void tconv_tile4(const Ctx& c, const float* src, int ld_src, int k0, int n0, bf16_t* dst, int ld_dst, int kd0, const RowMap& rowmap) {
    LAS float* scr = (LAS float*)c.lds;
    const int tid = c.tid; float v[4][8];
#pragma unroll
    for (int q = 0; q < 4; ++q)
#pragma unroll
        for (int p = 0; p < 8; ++p) { const int k = p * 8 + (tid >> 6), n = tid & 63; v[q][p] = src[(size_t)(k0 + k) * ld_src + n0 + q * 64 + n]; }
#pragma unroll
    for (int q = 0; q < 4; ++q)
#pragma unroll
        for (int p = 0; p < 8; ++p) { const int k = p * 8 + (tid >> 6), n = tid & 63; scr[(q * 64 + n) * 65 + k] = v[q][p]; }
    __syncthreads();
#pragma unroll
    for (int q = 0; q < 4; ++q) { const int n = tid >> 3, kc = (tid & 7) * 8; const LAS float* s = scr + (q * 64 + n) * 65 + kc;
      u32x4 o; o.x = cvt_pk_bf16(s[0], s[1]); o.y = cvt_pk_bf16(s[2], s[3]); o.z = cvt_pk_bf16(s[4], s[5]); o.w = cvt_pk_bf16(s[6], s[7]);
      *(u32x4*)(dst + (size_t)rowmap(n0 + q * 64 + n) * ld_dst + kd0 + kc) = o; }
    __syncthreads();
}
__device__ __forceinline__ void win_map(int r0, int& src, int& nvalid) {
    nvalid = 64;
    if (r0 < 5120) src = r0; else if (r0 < 5504) src = 5152 + (r0 - 5120); else if (r0 == 5504) src = 5792;
    else if (r0 == 5568) { src = 5120; nvalid = 32; } else if (r0 < 5888) src = 5536 + (r0 - 5632); else src = 5856 + (r0 - 5888);
}
__device__ __forceinline__ void phase_pre_a(const Ctx& c) {
    constexpr int U_IN = 140 * 4, U_UQ = 24 * 2, U_UKV = 32, U_M = 3 * 16 * 4, U_OUT = 16 * 4, U_S = 32, U_LAYER = U_IN + U_UQ + U_UKV + U_M + U_OUT + U_S, U_MOD = 192;
    for (int u = c.bid; u < 2 * U_LAYER + U_MOD; u += c.G) {
        if (u < U_MOD) {
            const int cb = u, l = cb / 96, n = (cb % 96) * 64 + c.lane;
            LAS float* sl = (LAS float*)c.lds;
            LAS float* red = (LAS float*)(c.lds + 20480);
            for (int i = c.tid; i < 5 * D; i += NTHR) { const int vi = i >> 10, k = i & (D - 1); sl[i] = siluf_(vi < 4 ? c.in[I_C][vi * D + k] : c.in[I_CCTX][k]); }
            __syncthreads();
            const float* wp = c.in[I_WMOD] + (size_t)l * D * 6144 + (size_t)(c.wave * 128) * 6144 + n; const LAS float* sw = sl + c.wave * 128;
            float a[5] = {0.f, 0.f, 0.f, 0.f, 0.f};
#pragma unroll 1
            for (int kk = 0; kk < 128; kk += 16) { float w[16];
#pragma unroll
                for (int j = 0; j < 16; ++j) w[j] = wp[(size_t)(kk + j) * 6144];
#pragma unroll
                for (int j = 0; j < 16; ++j)
#pragma unroll
                    for (int i = 0; i < 5; ++i) a[i] += sw[i * D + kk + j] * w[j]; }
#pragma unroll
            for (int i = 0; i < 5; ++i) red[(c.wave * 5 + i) * 64 + c.lane] = a[i];
            __syncthreads();
            if (c.tid < 320) { const int i = c.tid >> 6, ln = c.tid & 63; float s = 0.f;
#pragma unroll
                for (int w = 0; w < 8; ++w) s += red[(w * 5 + i) * 64 + ln];
                const int nn = (cb % 96) * 64 + ln;
                ((float*)(c.ws + WS_MOD))[(size_t)(l * 5 + i) * 6144 + nn] = s + c.in[I_BMOD][l * 6144 + nn]; }
            __syncthreads();
            continue;
        }
        const int v = u - U_MOD, l = v / U_LAYER; int r = v % U_LAYER; unsigned char* wt = c.ws + WS_WT + (size_t)l * WT_LAYER;
        if (r < U_IN) { const int nb = r >> 2, kq = r & 3; int src, nv; win_map(nb * 64, src, nv);
            tconv_kq<4>(c, c.in[I_WIN] + (size_t)l * D * 8928, 8928, kq * 256, src, nv, nullptr, (bf16_t*)(wt + WT_IN), D, nb * 64, kq * 256); continue; } r -= U_IN;
        if (r < U_UQ) { const int nb = r >> 1, kh = r & 1;
            tconv_kq<3>(c, c.in[I_WUQ] + (size_t)l * 384 * 1536, 1536, kh * 192, nb * 64, 64, c.in[I_GCQ] + l * 384, (bf16_t*)(wt + WT_UQ), 384, nb * 64, kh * 192); continue; } r -= U_UQ;
        if (r < U_UKV) { const int nb = r;
            tconv_kq<4>(c, c.in[I_WUKV] + (size_t)l * 256 * 2048, 2048, 0, nb * 64, 64, c.in[I_GCKV] + l * 256, (bf16_t*)(wt + WT_UKV), 256, nb * 64, 0); continue; } r -= U_UKV;
        if (r < U_M) { const int which = r >> 6, rr = r & 63, nb = rr >> 2, kq = rr & 3;
            const float* src = c.in[which == 0 ? I_WPA : (which == 1 ? I_WPB : I_WPC)] + (size_t)l * D * D;
            tconv_kq<4>(c, src, D, kq * 256, nb * 64, 64, nullptr, (bf16_t*)(wt + WT_M), 3 * D, nb * 64, which * D + kq * 256); continue; } r -= U_M;
        if (r < U_OUT) { const int nb = r >> 2, kq = r & 3;
            tconv_kq<4>(c, c.in[I_WOUT] + (size_t)l * D * D, D, kq * 256, nb * 64, 64, nullptr, (bf16_t*)(wt + WT_OUT), D, nb * 64, kq * 256); continue; } r -= U_OUT;
        { const float* s = c.in[I_WS] + (size_t)l * 131072 + (size_t)r * 4096 + c.tid * 8; bf16_t* d = (bf16_t*)(wt + WT_S) + (size_t)r * 4096 + c.tid * 8;
          const f32x4 a = *(const f32x4*)s, b = *(const f32x4*)(s + 4); u32x4 o; o.x = cvt_pk_bf16(a[0], a[1]); o.y = cvt_pk_bf16(a[2], a[3]); o.z = cvt_pk_bf16(b[0], b[1]); o.w = cvt_pk_bf16(b[2], b[3]);
          *(u32x4*)d = o; }
    }
}
__device__ __forceinline__ void modulate_row(const float* xrow, const float* g, const float* shift, const float* scale, bf16_t* hrow, int lane, f32x4 (&hv)[4]) {
    float ss = 0.f;
#pragma unroll
    for (int j = 0; j < 4; ++j) { hv[j] = *(const f32x4*)(xrow + 4 * lane + 256 * j); ss += (hv[j][0] * hv[j][0] + hv[j][1] * hv[j][1]) + (hv[j][2] * hv[j][2] + hv[j][3] * hv[j][3]); }
    const float rstd = 1.0f / sqrtf(wave_sum(ss) * (1.f / D) + EPS);
#pragma unroll
    for (int j = 0; j < 4; ++j) { const int cc = 4 * lane + 256 * j; const f32x4 gv = *(const f32x4*)(g + cc), sc = *(const f32x4*)(scale + cc), sh = *(const f32x4*)(shift + cc);
        hv[j] = hv[j] * rstd * gv * (sc + 1.0f) + sh;
        u32x2 o; o.x = cvt_pk_bf16(hv[j][0], hv[j][1]); o.y = cvt_pk_bf16(hv[j][2], hv[j][3]); *(u32x2*)(hrow + cc) = o; }
}
__device__ __forceinline__ void phase_modulate_mix(const Ctx& c, int l) {
    const int gw = c.bid * NWAVES + c.wave, NGW = c.G * NWAVES;
    for (int row = gw; row < T; row += NGW) { const int bi = row_modidx(row); f32x4 hv[4];
        modulate_row(xin_row(c, l, row), c.in[I_GMIX] + l * D, modp(c, l, bi, 0), modp(c, l, bi, 1), (bf16_t*)(c.ws + WS_H) + (size_t)row * D, c.lane, hv); }
}
struct EpiZ { static constexpr bool PERM = true, MID = false; bf16_t* Z; const float* bgate;
    __device__ __forceinline__ void operator()(const f32x4 (&acc)[2][2][4][2], const pg8::Unit& u, int wr, int wc, int fr, int fq) const {
        int row0 = u.pm * 256 + wr * 64 + fr; asm volatile("" : "+v"(row0)); const int col0 = u.pn * 256 + wc * 32 + 8 * fq;
        const int mode = (u.pn >= 23) ? 3 : ((u.pn >= 16 && u.pn < 20) ? 2 : ((u.pn == 8 || u.pn == 9) ? 1 : 0));
        const int gcol = (mode == 3) ? (col0 - ZGT) : 0; const float bm = (mode == 3) ? 1.f : 0.f;
        f32x4 bv[2][2];
#pragma unroll
        for (int bj = 0; bj < 2; ++bj)
#pragma unroll
            for (int n = 0; n < 2; ++n) bv[bj][n] = *(const f32x4*)(bgate + (gcol + bj * 128 + 4 * n)) * bm;
#pragma unroll
        for (int ai = 0; ai < 2; ++ai)
#pragma unroll
            for (int m = 0; m < 4; ++m) { bf16_t* rowp = Z + (size_t)(row0 + ai * 128 + m * 16) * NZ + col0;
#pragma unroll
                for (int bj = 0; bj < 2; ++bj) { f32x4 v0 = acc[ai][bj][m][0] + bv[bj][0], v1 = acc[ai][bj][m][1] + bv[bj][1];
                    if (mode == 1) { v0 = v0 * 0.08838834764831845f; v1 = v1 * 0.08838834764831845f; }
                    else if (mode == 2) {
#pragma unroll
                        for (int e = 0; e < 4; ++e) { v0[e] = siluf_(v0[e]); v1[e] = siluf_(v1[e]); } }
                    else if (mode == 3) {
#pragma unroll
                        for (int e = 0; e < 4; ++e) { v0[e] = fmaxf(sigmoidf_(v0[e]), 1e-20f); v1[e] = fmaxf(sigmoidf_(v1[e]), 1e-20f); } }
                    u32x4 w; w.x = cvt_pk_bf16(v0[0], v0[1]); w.y = cvt_pk_bf16(v0[2], v0[3]); w.z = cvt_pk_bf16(v1[0], v1[1]); w.w = cvt_pk_bf16(v1[2], v1[3]);
                    *(u32x4*)(rowp + bj * 128) = w; } }
    }
};
struct EpiPlain { static constexpr bool PERM = true, MID = false; bf16_t* O; int ldc;
    __device__ __forceinline__ void operator()(const f32x4 (&acc)[2][2][4][2], const pg8::Unit& u, int wr, int wc, int fr, int fq) const {
        int row0 = u.pm * 256 + wr * 64 + fr; asm volatile("" : "+v"(row0)); const int col0 = u.pn * 256 + wc * 32 + 8 * fq;
#pragma unroll
        for (int ai = 0; ai < 2; ++ai)
#pragma unroll
            for (int m = 0; m < 4; ++m) { bf16_t* rowp = O + (size_t)(row0 + ai * 128 + m * 16) * ldc + col0;
#pragma unroll
                for (int bj = 0; bj < 2; ++bj) { const f32x4 v0 = acc[ai][bj][m][0], v1 = acc[ai][bj][m][1];
                    u32x4 w; w.x = cvt_pk_bf16(v0[0], v0[1]); w.y = cvt_pk_bf16(v0[2], v0[3]); w.z = cvt_pk_bf16(v1[0], v1[1]); w.w = cvt_pk_bf16(v1[2], v1[3]);
                    *(u32x4*)(rowp + bj * 128) = w; } }
    }
};
struct EpiMerge { static constexpr bool PERM = true, MID = true; bf16_t* O; const bf16_t* Z;
    __device__ __forceinline__ void ld8(const bf16_t* p, float (&g)[8]) const { const u32x4 w = *(const u32x4*)p; g[0] = bflo(w.x); g[1] = bfhi(w.x); g[2] = bflo(w.y); g[3] = bfhi(w.y); g[4] = bflo(w.z); g[5] = bfhi(w.z); g[6] = bflo(w.w); g[7] = bfhi(w.w); }
    __device__ __forceinline__ void mid(f32x4 (&acc)[2][2][4][2], const pg8::Unit& u, int t, int wr, int wc, int fr, int fq) const {
        int row0 = u.pm * 256 + wr * 64 + fr; asm volatile("" : "+v"(row0)); const int col0 = u.pn * 256 + wc * 32 + 8 * fq; const int seg = (t == 16) ? 0 : 1;
#pragma unroll
        for (int ai = 0; ai < 2; ++ai)
#pragma unroll
            for (int m = 0; m < 4; ++m) { const bf16_t* gp = Z + (size_t)(row0 + ai * 128 + m * 16) * NZ + ZGT + seg * D + col0;
#pragma unroll
                for (int bj = 0; bj < 2; ++bj) { float ga[8], gb[8]; ld8(gp + bj * 128, ga); ld8(gp + D + bj * 128, gb);
#pragma unroll
                    for (int e = 0; e < 4; ++e) { acc[ai][bj][m][0][e] *= ga[e] * fast_rcp(gb[e]); acc[ai][bj][m][1][e] *= ga[4 + e] * fast_rcp(gb[4 + e]); } }
                __builtin_amdgcn_sched_barrier(0); }
    }
    __device__ __forceinline__ void operator()(const f32x4 (&acc)[2][2][4][2], const pg8::Unit& u, int wr, int wc, int fr, int fq) const {
        int row0 = u.pm * 256 + wr * 64 + fr; asm volatile("" : "+v"(row0)); const int col0 = u.pn * 256 + wc * 32 + 8 * fq;
#pragma unroll
        for (int ai = 0; ai < 2; ++ai)
#pragma unroll
            for (int m = 0; m < 4; ++m) { const size_t r = (size_t)(row0 + ai * 128 + m * 16); const bf16_t* gp = Z + r * NZ + ZGT + 2 * D + col0; bf16_t* rowp = O + r * D + col0;
#pragma unroll
                for (int bj = 0; bj < 2; ++bj) { float gc[8]; ld8(gp + bj * 128, gc); const f32x4 v0 = acc[ai][bj][m][0], v1 = acc[ai][bj][m][1];
                    u32x4 w; w.x = cvt_pk_bf16(v0[0] * gc[0], v0[1] * gc[1]); w.y = cvt_pk_bf16(v0[2] * gc[2], v0[3] * gc[3]); w.z = cvt_pk_bf16(v1[0] * gc[4], v1[1] * gc[5]); w.w = cvt_pk_bf16(v1[2] * gc[6], v1[3] * gc[7]);
                    *(u32x4*)(rowp + bj * 128) = w; }
                __builtin_amdgcn_sched_barrier(0); }
    }
};
struct EpiResid { static constexpr bool PERM = false, MID = false; const Ctx* c; int l; float* dummy;
    __device__ __forceinline__ void operator()(const f32x4 (&acc)[2][2][4][2], const pg8::Unit& u, int wr, int wc, int fr, int fq) const {
        int row0 = u.pm * 256 + wr * 64 + fr; asm volatile("" : "+v"(row0)); const int col0 = u.pn * 256 + wc * 32 + 4 * fq; const float* gate = modp(*c, l, row_modidx(u.pm * 256), 2);
        f32x4 gv[2][2];
#pragma unroll
        for (int bj = 0; bj < 2; ++bj)
#pragma unroll
            for (int n = 0; n < 2; ++n) gv[bj][n] = *(const f32x4*)(gate + col0 + bj * 128 + 16 * n);
#pragma unroll
        for (int ai = 0; ai < 2; ++ai)
#pragma unroll
            for (int m = 0; m < 4; ++m) { const int row = row0 + ai * 128 + m * 16; const float* xi = xin_row(*c, l, row) + col0; float* xo = (dummy ? dummy + (size_t)row * D : xout_row(*c, row)) + col0;
#pragma unroll
                for (int bj = 0; bj < 2; ++bj)
#pragma unroll
                    for (int n = 0; n < 2; ++n) { const f32x4 xv = *(const f32x4*)(xi + bj * 128 + 16 * n); *(f32x4*)(xo + bj * 128 + 16 * n) = xv + gv[bj][n] * acc[ai][bj][m][n]; } }
    }
};
struct EpiSwiGLU { static constexpr bool PERM = true, MID = false; bf16_t* HID;
    __device__ __forceinline__ void operator()(const f32x4 (&acc)[2][2][4][2], const pg8::Unit& u, int wr, int wc, int fr, int fq) const {
        int row0 = u.pm * 256 + wr * 64 + fr; asm volatile("" : "+v"(row0)); const int col0 = u.pn * 128 + wc * 32 + 8 * fq; bf16_t* base = HID + (size_t)u.g * ESLOTS * DEXP;
#pragma unroll
        for (int ai = 0; ai < 2; ++ai)
#pragma unroll
            for (int m = 0; m < 4; ++m) { float h[8];
#pragma unroll
                for (int n = 0; n < 2; ++n)
#pragma unroll
                    for (int e = 0; e < 4; ++e) h[4 * n + e] = siluf_(acc[ai][0][m][n][e]) * acc[ai][1][m][n][e];
                u32x4 w; w.x = cvt_pk_bf16(h[0], h[1]); w.y = cvt_pk_bf16(h[2], h[3]); w.z = cvt_pk_bf16(h[4], h[5]); w.w = cvt_pk_bf16(h[6], h[7]);
                *(u32x4*)(base + (size_t)(row0 + ai * 128 + m * 16) * DEXP + col0) = w; }
    }
};
struct EpiDown { static constexpr bool PERM = true, MID = false; bf16_t* YS; const float* gatev;
    __device__ __forceinline__ void operator()(const f32x4 (&acc)[2][2][4][2], const pg8::Unit& u, int wr, int wc, int fr, int fq) const {
        int row0 = u.pm * 256 + wr * 64 + fr; asm volatile("" : "+v"(row0)); const int col0 = u.pn * 256 + wc * 32 + 8 * fq; bf16_t* base = YS + (size_t)u.g * ESLOTS * D; const float* gp = gatev + u.g * ESLOTS;
#pragma unroll
        for (int ai = 0; ai < 2; ++ai)
#pragma unroll
            for (int m = 0; m < 4; ++m) { const int row = row0 + ai * 128 + m * 16; const float gs = gp[row]; bf16_t* rowp = base + (size_t)row * D + col0;
#pragma unroll
                for (int bj = 0; bj < 2; ++bj) { const f32x4 v0 = acc[ai][bj][m][0] * gs, v1 = acc[ai][bj][m][1] * gs;
                    u32x4 w; w.x = cvt_pk_bf16(v0[0], v0[1]); w.y = cvt_pk_bf16(v0[2], v0[3]); w.z = cvt_pk_bf16(v1[0], v1[1]); w.w = cvt_pk_bf16(v1[2], v1[3]);
                    *(u32x4*)(rowp + bj * 128) = w; } }
    }
};

struct EpiDownPart { static constexpr bool PERM = true, MID = false; bf16_t* YSC; const float* gatev;
    __device__ __forceinline__ void operator()(const f32x4 (&acc)[2][2][4][2], const pg8::Unit& u, int wr, int wc, int fr, int fq) const {
        int r0 = wr * 64 + fr; asm volatile("" : "+v"(r0)); const int col0 = u.pn * 256 + wc * 32 + 8 * fq;
        bf16_t* base = YSC + ((size_t)((u.ko >> 9) * NEXP + u.g) * 128) * D; const float* gp = gatev + u.g * ESLOTS + 2048;
#pragma unroll
        for (int m = 0; m < 4; ++m) { const int r = r0 + m * 16; const float gs = gp[r]; bf16_t* rowp = base + (size_t)r * D + col0;
#pragma unroll
            for (int bj = 0; bj < 2; ++bj) { const f32x4 v0 = acc[0][bj][m][0] * gs, v1 = acc[0][bj][m][1] * gs;
                u32x4 w; w.x = cvt_pk_bf16(v0[0], v0[1]); w.y = cvt_pk_bf16(v0[2], v0[3]); w.z = cvt_pk_bf16(v1[0], v1[1]); w.w = cvt_pk_bf16(v1[2], v1[3]);
                *(u32x4*)(rowp + bj * 128) = w; } }
    }
};

__device__ __forceinline__ void sg_accum(const bf16_t* A, int lda, const bf16_t* Bt, int ldb, int K, int lane, f32x4 (&acc)[2]) {
    const int lr = lane & 15, lq = lane >> 4; const bf16_t* ap = A + (size_t)lr * lda + 8 * lq; const bf16_t* bp0 = Bt + (size_t)lr * ldb + 8 * lq; const bf16_t* bp1 = bp0 + (size_t)16 * ldb;
    bf16x8 a[2][4], b0[2][4], b1[2][4];
#pragma unroll
    for (int i = 0; i < 4; ++i) { a[0][i] = *(const bf16x8*)(ap + 32 * i); b0[0][i] = *(const bf16x8*)(bp0 + 32 * i); b1[0][i] = *(const bf16x8*)(bp1 + 32 * i); }
#pragma unroll 1
    for (int k = 0; k < K; k += 256) {
#pragma unroll
        for (int i = 0; i < 4; ++i) { a[1][i] = *(const bf16x8*)(ap + k + 128 + 32 * i); b0[1][i] = *(const bf16x8*)(bp0 + k + 128 + 32 * i); b1[1][i] = *(const bf16x8*)(bp1 + k + 128 + 32 * i); }
#pragma unroll
        for (int i = 0; i < 4; ++i) { acc[0] = __builtin_amdgcn_mfma_f32_16x16x32_bf16(a[0][i], b0[0][i], acc[0], 0, 0, 0); acc[1] = __builtin_amdgcn_mfma_f32_16x16x32_bf16(a[0][i], b1[0][i], acc[1], 0, 0, 0); }
        if (k + 256 < K) {
#pragma unroll
            for (int i = 0; i < 4; ++i) { a[0][i] = *(const bf16x8*)(ap + k + 256 + 32 * i); b0[0][i] = *(const bf16x8*)(bp0 + k + 256 + 32 * i); b1[0][i] = *(const bf16x8*)(bp1 + k + 256 + 32 * i); } }
#pragma unroll
        for (int i = 0; i < 4; ++i) { acc[0] = __builtin_amdgcn_mfma_f32_16x16x32_bf16(a[1][i], b0[1][i], acc[0], 0, 0, 0); acc[1] = __builtin_amdgcn_mfma_f32_16x16x32_bf16(a[1][i], b1[1][i], acc[1], 0, 0, 0); }
    }
}
__device__ __forceinline__ void ctx_merge_unit(const Ctx& c, int l, int u) {
    const int lane = c.lane, w = c.wave, lr = lane & 15, lq = lane >> 4; const int row0 = TL + 64 * (u >> 4) + 16 * (w >> 1), col0 = 64 * (u & 15) + 32 * (w & 1);
    const bf16_t* Y = (const bf16_t*)(c.ws + WS_RB + RB_YCAT) + (size_t)row0 * 3072; const bf16_t* WM = (const bf16_t*)(c.ws + WS_WT + (size_t)l * WT_LAYER + WT_M) + (size_t)col0 * 3072;
    const bf16_t* Zg = (const bf16_t*)(c.ws + WS_RA) + ZGT; bf16_t* O = (bf16_t*)(c.ws + WS_RB + RB_MERGED);
    f32x4 out[2] = {{0.f, 0.f, 0.f, 0.f}, {0.f, 0.f, 0.f, 0.f}};
#pragma unroll 1
    for (int seg = 0; seg < 3; ++seg) { f32x4 acc[2] = {{0.f, 0.f, 0.f, 0.f}, {0.f, 0.f, 0.f, 0.f}};
        sg_accum(Y + seg * D, 3072, WM + seg * D, 3072, D, lane, acc);
#pragma unroll
        for (int t = 0; t < 2; ++t)
#pragma unroll
            for (int e = 0; e < 4; ++e) out[t][e] += acc[t][e] * bf2f(Zg[(size_t)(row0 + 4 * lq + e) * NZ + seg * D + col0 + 16 * t + lr]); }
#pragma unroll
    for (int t = 0; t < 2; ++t)
#pragma unroll
        for (int e = 0; e < 4; ++e) O[(size_t)(row0 + 4 * lq + e) * D + col0 + 16 * t + lr] = f2bf(out[t][e]);
}
__device__ __forceinline__ void ctx_out_unit(const Ctx& c, int l, int u) {
    const int lane = c.lane, w = c.wave, lr = lane & 15, lq = lane >> 4; const int row0 = TL + 64 * (u >> 4) + 16 * (w >> 1), col0 = 64 * (u & 15) + 32 * (w & 1);
    const bf16_t* A = (const bf16_t*)(c.ws + WS_RB + RB_MERGED) + (size_t)row0 * D; const bf16_t* WO = (const bf16_t*)(c.ws + WS_WT + (size_t)l * WT_LAYER + WT_OUT) + (size_t)col0 * D;
    f32x4 acc[2] = {{0.f, 0.f, 0.f, 0.f}, {0.f, 0.f, 0.f, 0.f}};
    sg_accum(A, D, WO, D, D, lane, acc);
    const float* gate = modp(c, l, 4, 2);
#pragma unroll
    for (int t = 0; t < 2; ++t)
#pragma unroll
        for (int e = 0; e < 4; ++e) { const int row = row0 + 4 * lq + e, col = col0 + 16 * t + lr; xout_row(c, row)[col] = xin_row(c, l, row)[col] + gate[col] * acc[t][e]; }
}
__device__ __forceinline__ void mixA_unit(const Ctx& c, int l, int un) {
    const int cn = un >> 3, g = un & 7; const int row0 = cn * 128;
    const bf16_t* Z = (const bf16_t*)(c.ws + WS_RA); bf16_t* Y = (bf16_t*)(c.ws + WS_RB + RB_YCAT);
    const bf16_t* WSb = (const bf16_t*)(c.ws + WS_WT + (size_t)l * WT_LAYER + WT_S) + g * 16384;
    LAS bf16_t* VT = (LAS bf16_t*)c.lds;
    { const int s = c.tid >> 2, qd = c.tid & 3; const bf16_t* p = Z + (size_t)(row0 + s) * NZ + ZVA + g * 128 + qd * 32;
      float v[32];
#pragma unroll
      for (int i = 0; i < 4; ++i) { const u32x4 w = *(const u32x4*)(p + 8 * i); v[8 * i] = bflo(w.x); v[8 * i + 1] = bfhi(w.x); v[8 * i + 2] = bflo(w.y); v[8 * i + 3] = bfhi(w.y); v[8 * i + 4] = bflo(w.z); v[8 * i + 5] = bfhi(w.z); v[8 * i + 6] = bflo(w.w); v[8 * i + 7] = bfhi(w.w); }
      float sm = 0.f;
#pragma unroll
      for (int i = 0; i < 32; ++i) sm += v[i];
      sm += sx<1>(sm); sm += sx<2>(sm); const float mu = sm * (1.f / 128.f); float sq = 0.f;
#pragma unroll
      for (int i = 0; i < 32; ++i) { v[i] -= mu; sq += v[i] * v[i]; }
      sq += sx<1>(sq); sq += sx<2>(sq); const float rstd = 1.0f / sqrtf(sq * (1.f / 128.f) + EPS);
#pragma unroll
      for (int i = 0; i < 32; ++i) VT[(qd * 32 + i) * 136 + s] = f2bf(v[i] * rstd); }
    __syncthreads();
    const int w = c.wave, lr = c.lane & 15, lq = c.lane >> 4;
    bf16x8 bw[4];
#pragma unroll
    for (int ks = 0; ks < 4; ++ks) bw[ks] = *(const bf16x8*)(WSb + (16 * w + lr) * 128 + 32 * ks + 8 * lq);
    const int t = row0 + 16 * w + lr; const float bs = c.in[I_BS][(l * 8 + g) * 128 + 16 * w + lr];
#pragma unroll
    for (int ct = 0; ct < 8; ++ct) { f32x4 acc = {0.f, 0.f, 0.f, 0.f};
#pragma unroll
        for (int ks = 0; ks < 4; ++ks) { const bf16x8 a = *(const LAS bf16x8*)(VT + (16 * ct + lr) * 136 + 32 * ks + 8 * lq); acc = __builtin_amdgcn_mfma_f32_16x16x32_bf16(a, bw[ks], acc, 0, 0, 0); }
        const int cc = g * 128 + 16 * ct + 4 * lq; const u32x2 uw = *(const u32x2*)(Z + (size_t)t * NZ + ZU + cc);
        u32x2 o; o.x = cvt_pk_bf16(bflo(uw.x) * (acc[0] + bs), bfhi(uw.x) * (acc[1] + bs)); o.y = cvt_pk_bf16(bflo(uw.y) * (acc[2] + bs), bfhi(uw.y) * (acc[3] + bs));
        *(u32x2*)(Y + (size_t)t * 3072 + cc) = o; }
    __syncthreads();
}
__device__ __forceinline__ void gla_b1_unit(const Ctx& c, int l, int un) {
    const int n = un >> 2, h = un & 3, row0 = n * 64, tid = c.tid, lane = c.lane, w = c.wave, lr = lane & 15, lq = lane >> 4;
    const bf16_t* Z = (const bf16_t*)(c.ws + WS_RA);
    LAS bf16_t* VTs = (LAS bf16_t*)c.lds;
    LAS float* Ds = (LAS float*)(c.lds + 36864);
    LAS float* La = (LAS float*)(c.lds + 45056);
    LAS float* Tot = (LAS float*)(c.lds + 78080);
    LAS bf16_t* QD = (LAS bf16_t*)(c.lds + 80128);
    LAS bf16_t* KI = (LAS bf16_t*)(c.lds + 97536);
    LAS bf16_t* Ps = (LAS bf16_t*)(c.lds + 114944);
    LAS bf16_t* KdT = (LAS bf16_t*)(c.lds + 124160);
    { const int t = tid >> 3, cb = (tid & 7) * 32; const bf16_t* p = Z + (size_t)(row0 + t) * NZ + ZVB + h * 256 + cb;
#pragma unroll
      for (int i = 0; i < 4; ++i) { const u32x4 wv = *(const u32x4*)(p + 8 * i); LAS bf16_t* d = VTs + (cb + 8 * i) * 72 + t;
        d[0] = (bf16_t)wv.x; d[72] = (bf16_t)(wv.x >> 16); d[144] = (bf16_t)wv.y; d[216] = (bf16_t)(wv.y >> 16); d[288] = (bf16_t)wv.z; d[360] = (bf16_t)(wv.z >> 16); d[432] = (bf16_t)wv.w; d[504] = (bf16_t)(wv.w >> 16); }
      const int dt = tid >> 3, dc = (tid & 7) * 4; const u32x2 dv = *(const u32x2*)(Z + (size_t)(row0 + dt) * NZ + ZDEC + dc);
      Ds[dt * 32 + dc] = bflo(dv.x); Ds[dt * 32 + dc + 1] = bfhi(dv.x); Ds[dt * 32 + dc + 2] = bflo(dv.y); Ds[dt * 32 + dc + 3] = bfhi(dv.y); }
    __syncthreads();
    f32x4 pacc[2] = {{0.f, 0.f, 0.f, 0.f}, {0.f, 0.f, 0.f, 0.f}};
#pragma unroll 1
    for (int dir = 0; dir < 2; ++dir) {
        { const int cch = 16 * w + lr;
          bf16x8 bfr = {0, 0, 0, 0, 0, 0, 0, 0};
          if (lq < 2) { const float* wd = c.in[I_WDEC] + (size_t)(l * 2 + dir) * 16 * 512 + (size_t)(8 * lq) * 512 + h * 128 + cch; u32x4 pk;
              pk.x = cvt_pk_bf16(wd[0], wd[512]); pk.y = cvt_pk_bf16(wd[1024], wd[1536]); pk.z = cvt_pk_bf16(wd[2048], wd[2560]); pk.w = cvt_pk_bf16(wd[3072], wd[3584]); bfr = __builtin_bit_cast(bf16x8, pk); }
          const float bias = c.in[I_BDEC][(l * 2 + dir) * 512 + h * 128 + cch];
          f32x4 la[4];
#pragma unroll
          for (int tt = 0; tt < 4; ++tt) { bf16x8 afr = {0, 0, 0, 0, 0, 0, 0, 0};
              if (lq < 2) afr = *(const bf16x8*)(Z + (size_t)(row0 + 16 * tt + lr) * NZ + ZDEC + dir * 16 + 8 * lq);
              la[tt] = __builtin_amdgcn_mfma_f32_16x16x32_bf16(afr, bfr, (f32x4){0.f, 0.f, 0.f, 0.f}, 0, 0, 0); }
#pragma unroll
          for (int tt = 0; tt < 4; ++tt)
#pragma unroll
              for (int e = 0; e < 4; ++e) { const float pre = la[tt][e] + bias; la[tt][e] = (fminf(pre, 0.f) - __logf(1.f + __expf(-fabsf(pre)))) * 0.0625f; }
          float carry = 0.f;
          if (dir == 0) {
#pragma unroll
              for (int tt = 0; tt < 4; ++tt) { la[tt][1] += la[tt][0]; la[tt][2] += la[tt][1]; la[tt][3] += la[tt][2];
                  const float tot = la[tt][3]; float pre = 0.f; const float s16 = bperm(tot, lane - 16), s32 = bperm(tot, lane - 32), s48 = bperm(tot, lane - 48);
                  if (lq >= 1) pre += s16; if (lq >= 2) pre += s32; if (lq >= 3) pre += s48;
                  const float add = carry + pre;
#pragma unroll
                  for (int e = 0; e < 4; ++e) la[tt][e] += add;
                  carry = bperm(la[tt][3], 48 + lr); }
          } else {
#pragma unroll
              for (int tt = 3; tt >= 0; --tt) { la[tt][2] += la[tt][3]; la[tt][1] += la[tt][2]; la[tt][0] += la[tt][1];
                  const float tot = la[tt][0]; float pre = 0.f; const float s16 = bperm(tot, lane + 16), s32 = bperm(tot, lane + 32), s48 = bperm(tot, lane + 48);
                  if (lq <= 2) pre += s16; if (lq <= 1) pre += s32; if (lq <= 0) pre += s48;
                  const float add = carry + pre;
#pragma unroll
                  for (int e = 0; e < 4; ++e) la[tt][e] += add;
                  carry = bperm(la[tt][0], lr); }
          }
#pragma unroll
          for (int tt = 0; tt < 4; ++tt)
#pragma unroll
              for (int e = 0; e < 4; ++e) La[(16 * tt + 4 * lq + e) * 129 + cch] = la[tt][e]; }
        __syncthreads();
        { const int t = tid >> 3, cb = (tid & 7) * 16; const bf16_t* qp = Z + (size_t)(row0 + t) * NZ + ZQB + h * 128 + cb; const bf16_t* kp = Z + (size_t)(row0 + t) * NZ + ZKB + h * 128 + cb;
          float q[16], k[16];
#pragma unroll
          for (int i = 0; i < 2; ++i) { const u32x4 a = *(const u32x4*)(qp + 8 * i), b = *(const u32x4*)(kp + 8 * i);
              q[8 * i] = bflo(a.x); q[8 * i + 1] = bfhi(a.x); q[8 * i + 2] = bflo(a.y); q[8 * i + 3] = bfhi(a.y); q[8 * i + 4] = bflo(a.z); q[8 * i + 5] = bfhi(a.z); q[8 * i + 6] = bflo(a.w); q[8 * i + 7] = bfhi(a.w);
              k[8 * i] = bflo(b.x); k[8 * i + 1] = bfhi(b.x); k[8 * i + 2] = bflo(b.y); k[8 * i + 3] = bfhi(b.y); k[8 * i + 4] = bflo(b.z); k[8 * i + 5] = bfhi(b.z); k[8 * i + 6] = bflo(b.w); k[8 * i + 7] = bfhi(b.w); }
          const int tl = (dir == 0) ? 63 : 0; float qd[16], ki[16];
#pragma unroll
          for (int i = 0; i < 16; ++i) { const float b = La[t * 129 + cb + i], bl = La[tl * 129 + cb + i]; const float e = __expf(b);
              qd[i] = q[i] * e; ki[i] = k[i] * fast_rcp(e); KdT[(cb + i) * 72 + t] = f2bf(k[i] * __expf(bl - b)); }
          u32x4 o0, o1;
          o0.x = cvt_pk_bf16(qd[0], qd[1]); o0.y = cvt_pk_bf16(qd[2], qd[3]); o0.z = cvt_pk_bf16(qd[4], qd[5]); o0.w = cvt_pk_bf16(qd[6], qd[7]);
          o1.x = cvt_pk_bf16(qd[8], qd[9]); o1.y = cvt_pk_bf16(qd[10], qd[11]); o1.z = cvt_pk_bf16(qd[12], qd[13]); o1.w = cvt_pk_bf16(qd[14], qd[15]);
          *(LAS u32x4*)(QD + t * 136 + cb) = o0; *(LAS u32x4*)(QD + t * 136 + cb + 8) = o1;
          bf16_t* qg = (bf16_t*)(c.ws + WS_RB + RB_QDF) + (size_t)(dir * 1088 + un) * 8192 + (size_t)((((t >> 5) * 4 + (cb >> 5)) * 2 + ((cb >> 4) & 1)) * 512 + (t & 31) * 8);
          u32x4 p0, p1; p0.x = o0.x; p0.y = o0.y; p0.z = o1.x; p0.w = o1.y; p1.x = o0.z; p1.y = o0.w; p1.z = o1.z; p1.w = o1.w;
          *(u32x4*)qg = p0; *(u32x4*)(qg + 256) = p1;
          o0.x = cvt_pk_bf16(ki[0], ki[1]); o0.y = cvt_pk_bf16(ki[2], ki[3]); o0.z = cvt_pk_bf16(ki[4], ki[5]); o0.w = cvt_pk_bf16(ki[6], ki[7]);
          o1.x = cvt_pk_bf16(ki[8], ki[9]); o1.y = cvt_pk_bf16(ki[10], ki[11]); o1.z = cvt_pk_bf16(ki[12], ki[13]); o1.w = cvt_pk_bf16(ki[14], ki[15]);
          *(LAS u32x4*)(KI + t * 136 + cb) = o0; *(LAS u32x4*)(KI + t * 136 + cb + 8) = o1;
          if (tid < 128) ((float*)(c.ws + WS_RB + RB_DECAY))[(size_t)(dir * 1088 + un) * 128 + tid] = __expf(La[tl * 129 + tid]); }
        __syncthreads();
        { bf16_t* kg = (bf16_t*)(c.ws + WS_RB + RB_KDT) + (size_t)(dir * 1088 + un) * 8192;
#pragma unroll
          for (int i = 0; i < 2; ++i) { const int id = tid + 512 * i, ch = id >> 3, tc = id & 7;
              *(u32x4*)(kg + (((ch >> 5) * 4 + (tc >> 1)) * 64 + (tc & 1) * 32 + (ch & 31)) * 8) = *(const LAS u32x4*)(KdT + ch * 72 + tc * 8); } }
        { const int it = w >> 1; bf16x8 a[4];
#pragma unroll
          for (int ks = 0; ks < 4; ++ks) a[ks] = *(const LAS bf16x8*)(QD + (16 * it + lr) * 136 + 32 * ks + 8 * lq);
#pragma unroll
          for (int jj = 0; jj < 2; ++jj) { const int jt = 2 * (w & 1) + jj; f32x4 s = {0.f, 0.f, 0.f, 0.f};
#pragma unroll
              for (int ks = 0; ks < 4; ++ks) { const bf16x8 b = *(const LAS bf16x8*)(KI + (16 * jt + lr) * 136 + 32 * ks + 8 * lq); s = __builtin_amdgcn_mfma_f32_16x16x32_bf16(a[ks], b, s, 0, 0, 0); }
              const int j = 16 * jt + lr;
#pragma unroll
              for (int e = 0; e < 4; ++e) { const int i = 16 * it + 4 * lq + e; const bool keep = (dir == 0) ? (j <= i) : (j >= i); pacc[jj][e] += keep ? s[e] : 0.f; } } }
        __syncthreads();
    }
    { const int it = w >> 1;
#pragma unroll
      for (int jj = 0; jj < 2; ++jj) { const int j = 16 * (2 * (w & 1) + jj) + lr;
#pragma unroll
          for (int e = 0; e < 4; ++e) { Ps[(16 * it + 4 * lq + e) * 72 + j] = f2bf(pacc[jj][e]); } } }
    __syncthreads();
    { bf16_t* OI = (bf16_t*)(c.ws + WS_RB + RB_OINTRA);
#pragma unroll
      for (int dd = 0; dd < 2; ++dd) { const int dt = 2 * w + dd; bf16x8 a[2];
#pragma unroll
          for (int ks = 0; ks < 2; ++ks) a[ks] = *(const LAS bf16x8*)(VTs + (16 * dt + lr) * 72 + 32 * ks + 8 * lq);
#pragma unroll
          for (int it = 0; it < 4; ++it) { f32x4 o = {0.f, 0.f, 0.f, 0.f};
#pragma unroll
              for (int ks = 0; ks < 2; ++ks) { const bf16x8 b = *(const LAS bf16x8*)(Ps + (16 * it + lr) * 72 + 32 * ks + 8 * lq); o = __builtin_amdgcn_mfma_f32_16x16x32_bf16(a[ks], b, o, 0, 0, 0); }

              u32x2 ov; ov.x = cvt_pk_bf16(o[0], o[1]); ov.y = cvt_pk_bf16(o[2], o[3]);
              *(u32x2*)(OI + (size_t)(row0 + 16 * it + lr) * D + h * 256 + 16 * dt + 4 * lq) = ov; } } }
    { bf16_t* vg = (bf16_t*)(c.ws + WS_RB + RB_VTG) + (size_t)un * 16384;
#pragma unroll
      for (int i = 0; i < 4; ++i) { const int id = tid + 512 * i, dv = id >> 3, tc = id & 7;
          *(u32x4*)(vg + ((((dv >> 5) * 4 + (tc >> 1)) * 64) + (tc & 1) * 32 + (dv & 31)) * 8) = *(const LAS u32x4*)(VTs + dv * 72 + tc * 8); } }
    __syncthreads();
}
template <int N> __device__ __forceinline__ void vm_wait() { asm volatile("s_waitcnt vmcnt(%0)" :: "n"(N) : "memory"); }
__device__ __forceinline__ void gla_b2_unit(const Ctx& c, int un3) {
    const int lane = c.lane, lr = lane & 31, hi = lane >> 5, w = c.wave & 3, half = un3 & 1, un2 = un3 >> 1, dvs = half * 4 + w;
    const int h = un2 & 3, b = (un2 >> 2) & 3, dir = un2 >> 4;
    volatile LAS unsigned* cntF = (volatile LAS unsigned*)(c.lds + 3 * 33280 + 4 * 5120);
    volatile LAS unsigned* cntD = (volatile LAS unsigned*)(c.lds + 3 * 33280 + 4 * 5120 + 64);
    const char* QDF = (const char*)(c.ws + WS_RB + RB_QDF) + (size_t)dir * 1088 * 16384;
    const char* KDT = (const char*)(c.ws + WS_RB + RB_KDT) + (size_t)dir * 1088 * 16384;
    const char* VTG = (const char*)(c.ws + WS_RB + RB_VTG) + (size_t)dvs * 4096;
    const char* DEC = (const char*)(c.ws + WS_RB + RB_DECAY) + (size_t)dir * 1088 * 512;
    bf16_t* OUT = (bf16_t*)(c.ws + WS_RB + (dir == 0 ? RB_OF : RB_OB)) + (size_t)(((b * 4 + h) * 8 + dvs) * NKEY) * 32;
    constexpr int STG = 33280;
    LAS unsigned char* OT = c.lds + 3 * STG + w * 5120;
    const unsigned loff = (unsigned)lane * 16u;
#define B2_CHUNK(step) ((step) < 4 ? 256 + 4 * b + (dir == 0 ? (step) : 3 - (step)) : 64 * b + (dir == 0 ? (step) - 4 : 67 - (step)))
#define B2_ISSUE(step) do { const int un_ = B2_CHUNK(step) * 4 + h; LAS unsigned char* lb_ = c.lds + ((step) % 3) * STG; \
        const char* q_ = QDF + (size_t)un_ * 16384 + loff + w * 4096; const char* k_ = KDT + (size_t)un_ * 16384 + loff + w * 4096; \
        _Pragma("unroll") for (int i_ = 0; i_ < 4; ++i_) __builtin_amdgcn_global_load_lds((const unsigned*)(q_ + i_ * 1024), (LAS unsigned*)(lb_ + w * 4096 + i_ * 1024), 16, 0, 0); \
        _Pragma("unroll") for (int i_ = 0; i_ < 4; ++i_) __builtin_amdgcn_global_load_lds((const unsigned*)(k_ + i_ * 1024), (LAS unsigned*)(lb_ + 16384 + w * 4096 + i_ * 1024), 16, 0, 0); \
        if (lane < 8) __builtin_amdgcn_global_load_lds((const unsigned*)(DEC + (size_t)un_ * 512 + w * 128 + loff), (LAS unsigned*)(lb_ + 32768 + w * 128), 16, 0, 0); } while (0)
#define B2_SPIN(cnt, target) do { while (*(cnt) < (unsigned)(target)) __builtin_amdgcn_s_sleep(1); asm volatile("" ::: "memory"); } while (0)
#define B2_ARRIVE(cnt) do { if (lane == 0) { const unsigned one_ = 1u; asm volatile("ds_add_u32 %0, %1" :: "v"((unsigned)(size_t)(cnt)), "v"(one_) : "memory"); } } while (0)
    if (c.wave >= 4) {
#pragma unroll 1
        for (int t = 0; t < 68; ++t) {
            if (t >= 3) B2_SPIN(cntD, 4 * (t - 2));
            B2_ISSUE(t);
            if (t >= 1) { vm_wait<9>(); B2_ARRIVE(cntF); }
        }
        vm_wait<0>(); B2_ARRIVE(cntF);
        return;
    }
#define B2_VT(step, vt) do { const char* v_ = VTG + (size_t)(B2_CHUNK(step) * 4 + h) * 32768 + loff; \
        asm volatile("global_load_dwordx4 %0, %4, off\n\tglobal_load_dwordx4 %1, %4, off offset:1024\n\tglobal_load_dwordx4 %2, %4, off offset:2048\n\tglobal_load_dwordx4 %3, %4, off offset:3072" \
                     : "=&v"(vt[0]), "=&v"(vt[1]), "=&v"(vt[2]), "=&v"(vt[3]) : "v"(v_) : "memory"); } while (0)
#define B2_VT_WAIT(N, vt) asm volatile("s_waitcnt vmcnt(%4)" : "+v"(vt[0]), "+v"(vt[1]), "+v"(vt[2]), "+v"(vt[3]) : "n"(N) : "memory")
    f32x16 S[4];
#pragma unroll
    for (int ct = 0; ct < 4; ++ct)
#pragma unroll
        for (int r = 0; r < 16; ++r) S[ct][r] = 0.f;
    bf16x8 vtA[4], vtB[4];
    B2_VT(0, vtA);
#define B2_STEP(step, vt, vtn) do { \
        B2_SPIN(cntF, 4 * ((step) + 1));     \
        if ((step) + 1 < 68) B2_VT((step) + 1, vtn); \
        const int n_ = B2_CHUNK(step); const int key0 = (n_ < 256) ? CTXL + (n_ & 63) * 64 : (n_ - 256 - 4 * b) * 64; \
        const LAS unsigned char* lb = c.lds + ((step) % 3) * STG + loff; \
          \
        f32x16 o[2]; \
        _Pragma("unroll") for (int tt = 0; tt < 2; ++tt) { _Pragma("unroll") for (int r = 0; r < 16; ++r) o[tt][r] = 0.f; } \
        { u32x4 bw[8]; \
          _Pragma("unroll") for (int ct = 0; ct < 4; ++ct) { _Pragma("unroll") for (int s = 0; s < 2; ++s) { bw[ct * 2 + s].x = cvt_pk_bf16(S[ct][8 * s], S[ct][8 * s + 1]); bw[ct * 2 + s].y = cvt_pk_bf16(S[ct][8 * s + 2], S[ct][8 * s + 3]); bw[ct * 2 + s].z = cvt_pk_bf16(S[ct][8 * s + 4], S[ct][8 * s + 5]); bw[ct * 2 + s].w = cvt_pk_bf16(S[ct][8 * s + 6], S[ct][8 * s + 7]); } } \
          _Pragma("unroll") for (int tt = 0; tt < 2; ++tt) { bf16x8 qa[8]; \
            _Pragma("unroll") for (int i = 0; i < 8; ++i) qa[i] = *(const LAS bf16x8*)(lb + (tt * 8 + i) * 1024); \
            __builtin_amdgcn_sched_barrier(0); \
            _Pragma("unroll") for (int i = 0; i < 8; ++i) o[tt] = __builtin_amdgcn_mfma_f32_32x32x16_bf16(__builtin_bit_cast(bf16x8, bw[i]), qa[i], o[tt], 0, 0, 0); \
            __builtin_amdgcn_sched_barrier(0); } } \
          \
        _Pragma("unroll") for (int tt = 0; tt < 2; ++tt) { bf16_t* op = OUT + (size_t)(key0 + 32 * tt + lr) * 32 + 4 * hi; \
            _Pragma("unroll") for (int gq = 0; gq < 4; ++gq) { u32x2 ov; ov.x = cvt_pk_bf16(o[tt][4 * gq], o[tt][4 * gq + 1]); ov.y = cvt_pk_bf16(o[tt][4 * gq + 2], o[tt][4 * gq + 3]); *(u32x2*)(op + 8 * gq) = ov; } } \
          \
        if ((step) == 0) B2_VT_WAIT(12, vt); else if ((step) == 67) B2_VT_WAIT(16, vt); else B2_VT_WAIT(20, vt); \
        const LAS float* dcl = (const LAS float*)(c.lds + ((step) % 3) * STG + 32768); \
        _Pragma("unroll") for (int cp = 0; cp < 2; ++cp) { bf16x8 ka[8]; f32x4 dq[8]; \
          _Pragma("unroll") for (int i = 0; i < 8; ++i) ka[i] = *(const LAS bf16x8*)(lb + 16384 + (cp * 8 + i) * 1024); \
          _Pragma("unroll") for (int i = 0; i < 8; ++i) dq[i] = *(const LAS f32x4*)(dcl + 32 * (2 * cp + (i >> 2)) + 8 * (i & 3) + 4 * hi); \
          __builtin_amdgcn_sched_barrier(0); \
          _Pragma("unroll") for (int cc = 0; cc < 2; ++cc) { _Pragma("unroll") for (int gq = 0; gq < 4; ++gq) { _Pragma("unroll") for (int e = 0; e < 4; ++e) S[2 * cp + cc][4 * gq + e] *= dq[cc * 4 + gq][e]; } } \
          _Pragma("unroll") for (int ks = 0; ks < 4; ++ks) { _Pragma("unroll") for (int cc = 0; cc < 2; ++cc) S[2 * cp + cc] = __builtin_amdgcn_mfma_f32_32x32x16_bf16(ka[cc * 4 + ks], vt[ks], S[2 * cp + cc], 0, 0, 0); } \
          __builtin_amdgcn_sched_barrier(0); } \
        asm volatile("s_waitcnt lgkmcnt(0)" ::: "memory"); B2_ARRIVE(cntD);     \
    } while (0)
#pragma unroll 1
    for (int step = 0; step < 68; step += 2) { B2_STEP(step, vtA, vtB); B2_STEP(step + 1, vtB, vtA); }
    asm volatile("s_waitcnt vmcnt(0) lgkmcnt(0)" ::: "memory");
#undef B2_STEP
#undef B2_VT_WAIT
#undef B2_CHUNK
#undef B2_ISSUE
#undef B2_VT
#undef B2_SPIN
#undef B2_ARRIVE
}
struct FinRaw { u32x2 a[4], b[4], d[4], r[4]; };
__device__ __forceinline__ void gla_finish_load(const Ctx& c, int row, FinRaw& F) {
    const int lane = c.lane; const bf16_t* OI = (const bf16_t*)(c.ws + WS_RB + RB_OINTRA) + (size_t)row * D;
    const bool lat = row < TL; const int b = lat ? (row >> 12) : ((row - TL) >> 8), key = lat ? CTXL + (row & 4095) : ((row - TL) & 255);
    const bf16_t* OFp = (const bf16_t*)(c.ws + WS_RB + RB_OF) + ((size_t)((b * 4) * 8 + (lane >> 3)) * NKEY + key) * 32 + (lane & 7) * 4; const bf16_t* OBp = OFp + (size_t)(RB_OB - RB_OF) / 2;
    const bf16_t* R = (const bf16_t*)(c.ws + WS_RA) + (size_t)row * NZ + ZRB;
#pragma unroll
    for (int h = 0; h < 4; ++h) { const int cc = h * 256 + 4 * lane; const size_t ho = (size_t)h * 8 * NKEY * 32; F.a[h] = *(const u32x2*)(OI + cc); F.b[h] = *(const u32x2*)(OFp + ho); F.d[h] = *(const u32x2*)(OBp + ho); F.r[h] = *(const u32x2*)(R + cc); }
}
__device__ __forceinline__ void gla_finish_row(const Ctx& c, int l, int row, const FinRaw& F) {
    const int lane = c.lane; bf16_t* Y = (bf16_t*)(c.ws + WS_RB + RB_YCAT) + (size_t)row * 3072 + D;
    const f32x4 gv = *(const f32x4*)(c.in[I_GGLA] + l * 256 + 4 * lane);
    float o[4][4], ss[4];
#pragma unroll
    for (int h = 0; h < 4; ++h) { const u32x2 a = F.a[h], b = F.b[h], d = F.d[h];
        o[h][0] = bflo(a.x) + bflo(b.x) + bflo(d.x); o[h][1] = bfhi(a.x) + bfhi(b.x) + bfhi(d.x); o[h][2] = bflo(a.y) + bflo(b.y) + bflo(d.y); o[h][3] = bfhi(a.y) + bfhi(b.y) + bfhi(d.y);
        ss[h] = (o[h][0] * o[h][0] + o[h][1] * o[h][1]) + (o[h][2] * o[h][2] + o[h][3] * o[h][3]); }
#pragma unroll
    for (int h = 0; h < 4; ++h) ss[h] = wave_sum(ss[h]);
#pragma unroll
    for (int h = 0; h < 4; ++h) { const int cc = h * 256 + 4 * lane; const u32x2 r = F.r[h]; const float rstd = 1.0f / sqrtf(ss[h] * (1.f / 256.f) + EPS);
        u32x2 ov; ov.x = cvt_pk_bf16(o[h][0] * rstd * gv[0] * bflo(r.x), o[h][1] * rstd * gv[1] * bfhi(r.x)); ov.y = cvt_pk_bf16(o[h][2] * rstd * gv[2] * bflo(r.y), o[h][3] * rstd * gv[3] * bfhi(r.y));
        *(u32x2*)(Y + cc) = ov; }
}
__device__ __forceinline__ void rope_angle(int pos_row, int pos_col, int j, float& cs, float& sn) {
    const int axis = j >> 5, f = j & 15; const float inv = __expf(-(float)(2 * f) * (1.f / 32.f) * 9.210340371976184f);
    float rev = (float)(axis == 0 ? pos_row : pos_col) * inv * 0.15915494309189535f; rev -= floorf(rev); sn = __builtin_amdgcn_sinf(rev); cs = __builtin_amdgcn_cosf(rev);
}
struct C1Raw { u32x2 ckv; unsigned cq[3]; bf16_t kro; u32x2 kvw[8]; unsigned qnw[8]; bf16_t qrw[8]; };
__device__ __forceinline__ void mla_c1_load(const Ctx& c, int row, bool do_q, C1Raw& R) {
    const int lane = c.lane;
    const bf16_t* Zr = (const bf16_t*)(c.ws + WS_RA) + (size_t)row * NZ;
    const bf16_t* KV = (const bf16_t*)(c.ws + WS_RB + RB_KVRAW) + (size_t)row * 2048; const bf16_t* QR = (const bf16_t*)(c.ws + WS_RB + RB_QRAW) + (size_t)row * 1536;
    R.ckv = *(const u32x2*)(Zr + ZCKV + 4 * lane);
#pragma unroll
    for (int i = 0; i < 3; ++i) R.cq[i] = *(const unsigned*)(Zr + ZCQ + 128 * i + 2 * lane);
    R.kro = Zr[ZKR + lane];
#pragma unroll
    for (int h = 0; h < 8; ++h) R.kvw[h] = *(const u32x2*)(KV + h * 256 + 4 * lane);
    if (do_q) {
#pragma unroll
        for (int h = 0; h < 8; ++h) { R.qnw[h] = *(const unsigned*)(QR + h * 192 + 2 * lane); R.qrw[h] = QR[h * 192 + 128 + lane]; }
    }
}
__device__ __forceinline__ void mla_c1_row(const Ctx& c, int l, int row, bool do_q, const C1Raw& R) {
    const int lane = c.lane; const bool lat = row < TL; const int b = lat ? (row >> 12) : ((row - TL) >> 8), t = lat ? (row & 4095) : ((row - TL) & 255), key = lat ? (CTXL + t) : t;
    bf16_t* KG = (bf16_t*)(c.ws + WS_RB + RB_KG); bf16_t* VG = (bf16_t*)(c.ws + WS_RB + RB_VG);
    float rs_kv, rs_q;
    { const u32x2 w = R.ckv; const float a0 = bflo(w.x), a1 = bfhi(w.x), a2 = bflo(w.y), a3 = bfhi(w.y);
      rs_kv = 1.0f / sqrtf(wave_sum((a0 * a0 + a1 * a1) + (a2 * a2 + a3 * a3)) * (1.f / 256.f) + EPS);
      float s = 0.f;
#pragma unroll
      for (int i = 0; i < 3; ++i) { const unsigned w2 = R.cq[i]; const float q0 = bflo(w2), q1 = bfhi(w2); s += q0 * q0 + q1 * q1; }
      rs_q = 1.0f / sqrtf(wave_sum(s) * (1.f / 384.f) + EPS); }
    float cs = 1.f, sn = 0.f; if (lat) rope_angle(t >> 6, t & 63, lane, cs, sn);
    const bool second = (lane >> 4) & 1;
    float kr;
    { const float v = bf2f(R.kro); const float rr = 1.0f / sqrtf(wave_sum(v * v) * (1.f / 64.f) + EPS); float x = v * rr * c.in[I_GKR][l * 64 + lane];
      const float xp = sx<16>(x); kr = lat ? (second ? (x * cs + xp * sn) : (x * cs - xp * sn)) : x; }
    const bf16_t krb = f2bf(kr);
    const f32x4 gkn = *(const f32x4*)(c.in[I_GKN] + l * 128 + 4 * (lane & 31));
    float ssk[8]; float ak[8][4];
#pragma unroll
    for (int h = 0; h < 8; ++h) { ak[h][0] = bflo(R.kvw[h].x) * rs_kv; ak[h][1] = bfhi(R.kvw[h].x) * rs_kv; ak[h][2] = bflo(R.kvw[h].y) * rs_kv; ak[h][3] = bfhi(R.kvw[h].y) * rs_kv;
        ssk[h] = (ak[h][0] * ak[h][0] + ak[h][1] * ak[h][1]) + (ak[h][2] * ak[h][2] + ak[h][3] * ak[h][3]); }
#pragma unroll
    for (int h = 0; h < 8; ++h) ssk[h] = half_sum(ssk[h]);
    { bf16_t* kgp = KG + (size_t)(b * NKEY + key) * (8 * 192); bf16_t* vgp = VG + (size_t)(b * NKEY + key) * (8 * 128);
#pragma unroll
      for (int h = 0; h < 8; ++h) {
        if (lane < 32) { const float rn = 1.0f / sqrtf(ssk[h] * (1.f / 128.f) + EPS); u32x2 o; o.x = cvt_pk_bf16(ak[h][0] * rn * gkn[0], ak[h][1] * rn * gkn[1]); o.y = cvt_pk_bf16(ak[h][2] * rn * gkn[2], ak[h][3] * rn * gkn[3]);
            *(u32x2*)(kgp + h * 192 + 4 * lane) = o; }
        else { u32x2 o; o.x = cvt_pk_bf16(ak[h][0], ak[h][1]); o.y = cvt_pk_bf16(ak[h][2], ak[h][3]); *(u32x2*)(vgp + h * 128 + 4 * (lane - 32)) = o; }
        kgp[h * 192 + 128 + lane] = krb;
      } }
    __builtin_amdgcn_sched_barrier(0);
    if (lane == 0) ((float*)(c.ws + WS_RSQ))[row] = rs_q;
    if (!do_q) return;
    bf16_t* QF = lat ? (bf16_t*)(c.ws + WS_RB + RB_QFL) : (bf16_t*)(c.ws + WS_RB + RB_QFC); const int nq = lat ? SEQ : CTXL;
    const float QS = 0.07216878364870322f * 1.4426950408889634f;
    const f32x2 gqn = *(const f32x2*)(c.in[I_GQN] + l * 128 + 2 * lane); const float gqr = c.in[I_GQR][l * 64 + lane];
    float n0[8], n1[8], r0[8], sn_[8], sr_[8];
#pragma unroll
    for (int h = 0; h < 8; ++h) { n0[h] = bflo(R.qnw[h]) * rs_q; n1[h] = bfhi(R.qnw[h]) * rs_q; r0[h] = bf2f(R.qrw[h]) * rs_q; sn_[h] = n0[h] * n0[h] + n1[h] * n1[h]; sr_[h] = r0[h] * r0[h]; }
#pragma unroll
    for (int h = 0; h < 8; ++h) { sn_[h] = wave_sum(sn_[h]); sr_[h] = wave_sum(sr_[h]); }
#pragma unroll
    for (int h = 0; h < 8; ++h) {
        const float rn = 1.0f / sqrtf(sn_[h] * (1.f / 128.f) + EPS), rr = 1.0f / sqrtf(sr_[h] * (1.f / 64.f) + EPS);
        bf16_t* qp = QF + (size_t)(b * nq + t) * (8 * 192) + h * 192;
        *(unsigned*)(qp + 2 * lane) = cvt_pk_bf16(n0[h] * rn * gqn[0] * QS, n1[h] * rn * gqn[1] * QS);
        const float x = r0[h] * rr * gqr; const float xp = sx<16>(x); const float xr = lat ? (second ? (x * cs + xp * sn) : (x * cs - xp * sn)) : x;
        qp[128 + lane] = f2bf(xr * QS);
    }
}
__device__ __forceinline__ bf16x8 tr_pair(unsigned a0, unsigned a1) {
    bf16x4 x, y; asm volatile("ds_read_b64_tr_b16 %0, %2\n\tds_read_b64_tr_b16 %1, %3\n\ts_waitcnt lgkmcnt(0)" : "=&v"(x), "=&v"(y) : "v"(a0), "v"(a1) : "memory");
    return (bf16x8){x[0], x[1], x[2], x[3], y[0], y[1], y[2], y[3]};
}
__device__ __forceinline__ void k2_issue(bf16x8& a0, bf16x8& a1, unsigned addr) {
    asm volatile("ds_read_b128 %0, %2\n\tds_read_b128 %1, %2 offset:12288" : "=&v"(a0), "=&v"(a1) : "v"(addr) : "memory");
}
template <int N> __device__ __forceinline__ void k2_wait(bf16x8& a0, bf16x8& a1) { asm volatile("s_waitcnt lgkmcnt(%2)" : "+v"(a0), "+v"(a1) : "n"(N) : "memory"); }
template <int OFF>
__device__ __forceinline__ void tr8_issue(bf16x4 (&x)[8], unsigned a0, unsigned a1, unsigned a2, unsigned a3, unsigned d1) {
    asm volatile("ds_read_b64_tr_b16 %0, %8 offset:%13\n\tds_read_b64_tr_b16 %2, %9 offset:%13\n\tds_read_b64_tr_b16 %4, %10 offset:%13\n\tds_read_b64_tr_b16 %6, %11 offset:%13\n\t"
                 "v_add_u32 %8, %8, %12\n\tv_add_u32 %9, %9, %12\n\tv_add_u32 %10, %10, %12\n\tv_add_u32 %11, %11, %12\n\t"
                 "ds_read_b64_tr_b16 %1, %8 offset:%13\n\tds_read_b64_tr_b16 %3, %9 offset:%13\n\tds_read_b64_tr_b16 %5, %10 offset:%13\n\tds_read_b64_tr_b16 %7, %11 offset:%13"
                 : "=&v"(x[0]), "=&v"(x[1]), "=&v"(x[2]), "=&v"(x[3]), "=&v"(x[4]), "=&v"(x[5]), "=&v"(x[6]), "=&v"(x[7]), "+v"(a0), "+v"(a1), "+v"(a2), "+v"(a3)
                 : "v"(d1), "n"(OFF) : "memory");
}
__device__ __forceinline__ void tr8_wait(bf16x4 (&x)[8]) {
    asm volatile("s_waitcnt lgkmcnt(0)" : "+v"(x[0]), "+v"(x[1]), "+v"(x[2]), "+v"(x[3]), "+v"(x[4]), "+v"(x[5]), "+v"(x[6]), "+v"(x[7]) :: "memory");
}
__device__ __forceinline__ void attn_unit(const Ctx& c, int l, const bf16_t* Qraw  , const float* rsq  , int t0  ,
                                          const bf16_t* Kp  , const bf16_t* Vp  , int nt, bf16_t* Op  ) {
    constexpr int STG = 40960, KB = 24576;
    const int tid = c.tid, lane = c.lane, w = c.wave, lr = lane & 31, hi = lane >> 5;
    const unsigned lds0 = (unsigned)(size_t)c.lds;
    unsigned ksrc[3], vsrc[2];
#pragma unroll
    for (int i = 0; i < 3; ++i) { const int P = (w + 8 * i) * 64 + lane, row = P / 24, cp = P % 24, ch = (cp & ~7) | ((cp & 7) ^ ((row >> 1) & 7)); ksrc[i] = row * 3072 + ch * 16; }
#pragma unroll
    for (int i = 0; i < 2; ++i) { const int P = (w + 8 * i) * 64 + lane, row = P >> 4, cp = P & 15, ch = cp ^ (((row & 3) << 2) | ((row >> 2) & 3)); vsrc[i] = row * 2048 + ch * 16; }
#define ATT_ISSUE(tile, stg) do { const char* kt_ = (const char*)Kp + (size_t)(tile) * (64 * 3072); const char* vt_ = (const char*)Vp + (size_t)(tile) * (64 * 2048); \
        _Pragma("unroll") for (int i_ = 0; i_ < 3; ++i_) __builtin_amdgcn_global_load_lds((const unsigned*)(kt_ + ksrc[i_]), (LAS unsigned*)(c.lds + (stg) * STG + (w + 8 * i_) * 1024), 16, 0, 0); \
        _Pragma("unroll") for (int i_ = 0; i_ < 2; ++i_) __builtin_amdgcn_global_load_lds((const unsigned*)(vt_ + vsrc[i_]), (LAS unsigned*)(c.lds + (stg) * STG + KB + (w + 8 * i_) * 1024), 16, 0, 0); } while (0)
    bf16x8 qf[12];
    {
      const int qr = 32 * w + lr; const bf16_t* qrow = Qraw + (size_t)qr * 1536 + 8 * hi; const float rs = rsq[qr];
      u32x4 raw[12]; float sn = 0.f, sr = 0.f;
#pragma unroll
      for (int s = 0; s < 12; ++s) { raw[s] = *(const u32x4*)(qrow + 16 * s); const u32x4 wv = raw[s];
          const float q2 = (bflo(wv.x) * bflo(wv.x) + bfhi(wv.x) * bfhi(wv.x)) + (bflo(wv.y) * bflo(wv.y) + bfhi(wv.y) * bfhi(wv.y)) + (bflo(wv.z) * bflo(wv.z) + bfhi(wv.z) * bfhi(wv.z)) + (bflo(wv.w) * bflo(wv.w) + bfhi(wv.w) * bfhi(wv.w));
          if (s < 8) sn += q2; else sr += q2; }
      sn = sum32(sn) * rs * rs; sr = sum32(sr) * rs * rs;
      const float QS = 0.07216878364870322f * 1.4426950408889634f;
      const float rn = rs * QS / sqrtf(sn * (1.f / 128.f) + EPS), rr = rs * QS / sqrtf(sr * (1.f / 64.f) + EPS);
      const float* gqn = c.in[I_GQN] + l * 128 + 8 * hi; const float* gqr = c.in[I_GQR] + l * 64 + 8 * hi;
#pragma unroll
      for (int s = 0; s < 8; ++s) { const f32x4 g0 = *(const f32x4*)(gqn + 16 * s) * rn, g1 = *(const f32x4*)(gqn + 16 * s + 4) * rn; const u32x4 wv = raw[s]; u32x4 pk;
          pk.x = cvt_pk_bf16(bflo(wv.x) * g0[0], bfhi(wv.x) * g0[1]); pk.y = cvt_pk_bf16(bflo(wv.y) * g0[2], bfhi(wv.y) * g0[3]); pk.z = cvt_pk_bf16(bflo(wv.z) * g1[0], bfhi(wv.z) * g1[1]); pk.w = cvt_pk_bf16(bflo(wv.w) * g1[2], bfhi(wv.w) * g1[3]);
          qf[s] = __builtin_bit_cast(bf16x8, pk); }
      float x[4][8];
#pragma unroll
      for (int s = 0; s < 4; ++s) { const f32x4 g0 = *(const f32x4*)(gqr + 16 * s) * rr, g1 = *(const f32x4*)(gqr + 16 * s + 4) * rr; const u32x4 wv = raw[8 + s];
          x[s][0] = bflo(wv.x) * g0[0]; x[s][1] = bfhi(wv.x) * g0[1]; x[s][2] = bflo(wv.y) * g0[2]; x[s][3] = bfhi(wv.y) * g0[3]; x[s][4] = bflo(wv.z) * g1[0]; x[s][5] = bfhi(wv.z) * g1[1]; x[s][6] = bflo(wv.w) * g1[2]; x[s][7] = bfhi(wv.w) * g1[3]; }
      if (t0 >= 0) { const int t = t0 + qr; const float prow = (float)(t >> 6), pcol = (float)(t & 63);
#pragma unroll
          for (int i = 0; i < 8; ++i) { const float inv = __expf(-(float)(2 * (8 * hi + i)) * (1.f / 32.f) * 9.210340371976184f) * 0.15915494309189535f;
              float r0 = prow * inv; r0 -= floorf(r0); float r1 = pcol * inv; r1 -= floorf(r1);
              const float c0 = __builtin_amdgcn_cosf(r0), s0 = __builtin_amdgcn_sinf(r0), c1 = __builtin_amdgcn_cosf(r1), s1 = __builtin_amdgcn_sinf(r1);
              const float a0 = x[0][i], b0 = x[1][i], a1 = x[2][i], b1 = x[3][i];
              x[0][i] = a0 * c0 - b0 * s0; x[1][i] = b0 * c0 + a0 * s0; x[2][i] = a1 * c1 - b1 * s1; x[3][i] = b1 * c1 + a1 * s1; } }
#pragma unroll
      for (int s = 0; s < 4; ++s) { u32x4 pk; pk.x = cvt_pk_bf16(x[s][0], x[s][1]); pk.y = cvt_pk_bf16(x[s][2], x[s][3]); pk.z = cvt_pk_bf16(x[s][4], x[s][5]); pk.w = cvt_pk_bf16(x[s][6], x[s][7]); qf[8 + s] = __builtin_bit_cast(bf16x8, pk); }
      __builtin_amdgcn_sched_barrier(0); }
    unsigned kbase = lr * 384, y16 = (unsigned)((hi ^ ((lr >> 1) & 7)) << 4);
    unsigned vbase, q64, vd1;
    { const int blk = (lane >> 4) & 1, q = (lane & 15) >> 2, p = lane & 3; const int lb = (2 * blk + (p >> 1)) ^ hi;
      vbase = KB + 256 * (4 * hi + q) + 16 * lb + 8 * (p & 1); q64 = (unsigned)(q << 6); vd1 = 2048u + ((lb & 2) ? -32 : 32); }
    f32x16 o[4];
#pragma unroll
    for (int cc = 0; cc < 4; ++cc)
#pragma unroll
        for (int r = 0; r < 16; ++r) o[cc][r] = 0.f;
    float m = -1e30f, lsum = 0.f;
    ATT_ISSUE(0, 0);
    if (nt > 1) ATT_ISSUE(1, 1);
    asm volatile("" :: "v"(qf[0]), "v"(qf[1]), "v"(qf[2]), "v"(qf[3]), "v"(qf[4]), "v"(qf[5]), "v"(qf[6]), "v"(qf[7]), "v"(qf[8]), "v"(qf[9]), "v"(qf[10]), "v"(qf[11]));
#pragma unroll 1
    for (int j = 0; j < nt; ++j) {
        if (j + 1 < nt) asm volatile("s_waitcnt vmcnt(5)" ::: "memory"); else asm volatile("s_waitcnt vmcnt(0)" ::: "memory");
        asm volatile("s_waitcnt lgkmcnt(0)" ::: "memory"); __builtin_amdgcn_s_barrier(); asm volatile("" ::: "memory");
        if (j + 2 < nt) ATT_ISSUE(j + 2, (j + 2) % 3);
        const unsigned sb = lds0 + (unsigned)((j % 3) * STG);
        asm volatile("" : "+v"(kbase), "+v"(y16), "+v"(vbase), "+v"(q64), "+v"(vd1));
        const unsigned kb_ = sb + kbase;
        f32x16 st[2];
#pragma unroll
        for (int kt = 0; kt < 2; ++kt)
#pragma unroll
            for (int r = 0; r < 16; ++r) st[kt][r] = 0.f;
        { bf16x8 ka[2][2];
#define KADDR(s_) (kb_ + (y16 ^ (unsigned)(((2 * (s_)) & 7) << 4)) + (unsigned)((((2 * (s_)) & ~7) << 4)))
          k2_issue(ka[0][0], ka[0][1], KADDR(0));
#pragma unroll
          for (int s = 0; s < 12; ++s) {
              if (s + 1 < 12) { k2_issue(ka[(s + 1) & 1][0], ka[(s + 1) & 1][1], KADDR(s + 1)); k2_wait<2>(ka[s & 1][0], ka[s & 1][1]); }
              else k2_wait<0>(ka[s & 1][0], ka[s & 1][1]);
              st[0] = __builtin_amdgcn_mfma_f32_32x32x16_bf16(ka[s & 1][0], qf[s], st[0], 0, 0, 0);
              st[1] = __builtin_amdgcn_mfma_f32_32x32x16_bf16(ka[s & 1][1], qf[s], st[1], 0, 0, 0); }
#undef KADDR
        }
        bf16x4 vx[8];
        tr8_issue<0>(vx, sb + vbase + (q64 ^ 0u), sb + vbase + (q64 ^ 64u), sb + vbase + (q64 ^ 128u), sb + vbase + (q64 ^ 192u), vd1);
        float mx = st[0][0];
#pragma unroll
        for (int r = 1; r < 16; ++r) mx = fmaxf(mx, st[0][r]);
#pragma unroll
        for (int r = 0; r < 16; ++r) mx = fmaxf(mx, st[1][r]);
        mx = max32(mx);
        const float mn = fmaxf(m, mx), alpha = __builtin_amdgcn_exp2f(m - mn); m = mn;
        float ps = 0.f;
#pragma unroll
        for (int kt = 0; kt < 2; ++kt)
#pragma unroll
            for (int r = 0; r < 16; ++r) { st[kt][r] = __builtin_amdgcn_exp2f(st[kt][r] - mn); ps += st[kt][r]; }
        lsum = lsum * alpha + ps;
        if (__any(alpha != 1.0f)) {
#pragma unroll
            for (int cc = 0; cc < 4; ++cc)
#pragma unroll
                for (int r = 0; r < 16; ++r) o[cc][r] *= alpha; }
#define ATT_PV(KT, S2, NEXT_OFF, HAS_NEXT) do { u32x4 pw; pw.x = cvt_pk_bf16(st[KT][8 * S2], st[KT][8 * S2 + 1]); pw.y = cvt_pk_bf16(st[KT][8 * S2 + 2], st[KT][8 * S2 + 3]); pw.z = cvt_pk_bf16(st[KT][8 * S2 + 4], st[KT][8 * S2 + 5]); pw.w = cvt_pk_bf16(st[KT][8 * S2 + 6], st[KT][8 * S2 + 7]); \
            const bf16x8 pb = __builtin_bit_cast(bf16x8, pw); tr8_wait(vx); bf16x8 af[4]; \
            _Pragma("unroll") for (int cc = 0; cc < 4; ++cc) af[cc] = (bf16x8){vx[2 * cc][0], vx[2 * cc][1], vx[2 * cc][2], vx[2 * cc][3], vx[2 * cc + 1][0], vx[2 * cc + 1][1], vx[2 * cc + 1][2], vx[2 * cc + 1][3]}; \
            if (HAS_NEXT) tr8_issue<NEXT_OFF>(vx, sb + vbase + (q64 ^ 0u), sb + vbase + (q64 ^ 64u), sb + vbase + (q64 ^ 128u), sb + vbase + (q64 ^ 192u), vd1); \
            _Pragma("unroll") for (int cc = 0; cc < 4; ++cc) o[cc] = __builtin_amdgcn_mfma_f32_32x32x16_bf16(af[cc], pb, o[cc], 0, 0, 0); } while (0)
        ATT_PV(0, 0, 4096, true); ATT_PV(0, 1, 8192, true); ATT_PV(1, 0, 12288, true); ATT_PV(1, 1, 0, false);
#undef ATT_PV
    }
    const float linv = 1.0f / sum32(lsum);
    bf16_t* orow = Op + (size_t)(32 * w + lr) * 3072;
#pragma unroll
    for (int cc = 0; cc < 4; ++cc)
#pragma unroll
        for (int g = 0; g < 4; ++g) { u32x2 ov; ov.x = cvt_pk_bf16(o[cc][4 * g] * linv, o[cc][4 * g + 1] * linv); ov.y = cvt_pk_bf16(o[cc][4 * g + 2] * linv, o[cc][4 * g + 3] * linv);
            *(u32x2*)(orow + 32 * cc + 8 * g + 4 * hi) = ov; }
    asm volatile("s_waitcnt vmcnt(0) lgkmcnt(0)" ::: "memory"); __builtin_amdgcn_s_barrier(); asm volatile("" ::: "memory");
#undef ATT_ISSUE
}
__device__ __forceinline__ void route_stage_w(const Ctx& c, int l) {
    LAS float* WT = (LAS float*)c.lds; const float* wr = c.in[I_WROUTER] + (size_t)l * D * NEXP;
    for (int i = c.tid; i < D * NEXP; i += NTHR) WT[(i & 15) * 1028 + (i >> 4)] = wr[i];
    __syncthreads();
}
struct RouteRaw { f32x4 xv[4]; };
__device__ __forceinline__ void route_load(const Ctx& c, int row, RouteRaw& R) { const float* xr = xout_row(c, row);
#pragma unroll
    for (int j = 0; j < 4; ++j) R.xv[j] = *(const f32x4*)(xr + 4 * c.lane + 256 * j); }
__device__ __forceinline__ void route_row(const Ctx& c, int l, int row, const RouteRaw& R) {
    const int lane = c.lane, bi = row_modidx(row); f32x4 hv[4];
    { const float* g = c.in[I_GFFN] + l * D; const float* shift = modp(c, l, bi, 3); const float* scale = modp(c, l, bi, 4); bf16_t* hrow = (bf16_t*)(c.ws + WS_H) + (size_t)row * D; float ss = 0.f;
#pragma unroll
      for (int j = 0; j < 4; ++j) { hv[j] = R.xv[j]; ss += (hv[j][0] * hv[j][0] + hv[j][1] * hv[j][1]) + (hv[j][2] * hv[j][2] + hv[j][3] * hv[j][3]); }
      const float rstd = 1.0f / sqrtf(wave_sum(ss) * (1.f / D) + EPS);
#pragma unroll
      for (int j = 0; j < 4; ++j) { const int cc = 4 * lane + 256 * j; const f32x4 gv = *(const f32x4*)(g + cc), sc = *(const f32x4*)(scale + cc), sh = *(const f32x4*)(shift + cc);
          hv[j] = hv[j] * rstd * gv * (sc + 1.0f) + sh;
          u32x2 o; o.x = cvt_pk_bf16(hv[j][0], hv[j][1]); o.y = cvt_pk_bf16(hv[j][2], hv[j][3]); *(u32x2*)(hrow + cc) = o; } }
    const LAS float* WT = (const LAS float*)c.lds; float lg[16];
#pragma unroll
    for (int e = 0; e < 16; ++e) { float a = 0.f;
#pragma unroll
        for (int j = 0; j < 4; ++j) { const f32x4 wv = *(const LAS f32x4*)(WT + e * 1028 + 4 * lane + 256 * j); a += (hv[j][0] * wv[0] + hv[j][1] * wv[1]) + (hv[j][2] * wv[2] + hv[j][3] * wv[3]); }
        lg[e] = a; if ((e & 3) == 3) __builtin_amdgcn_sched_barrier(0); }
#pragma unroll
    for (int e = 0; e < 16; ++e) lg[e] = wave_sum(lg[e]);
    float mx = lg[0];
#pragma unroll
    for (int e = 1; e < 16; ++e) mx = fmaxf(mx, lg[e]);
    float sum = 0.f;
#pragma unroll
    for (int e = 0; e < 16; ++e) { lg[e] = __expf(lg[e] - mx); sum += lg[e]; }
    const float inv = 1.0f / sum; float mine = 0.f;
#pragma unroll
    for (int e = 0; e < 16; ++e) mine = (lane == e) ? lg[e] * inv : mine;
    float* AF = (float*)(c.ws + WS_AFFT);
    if (lane < 16) { if (row < TL) AF[((size_t)(row >> 12) * 16 + lane) * SEQ + (row & 4095)] = mine; else AF[(size_t)NB * 16 * SEQ + ((size_t)((row - TL) >> 8) * 16 + lane) * CTXL + ((row - TL) & 255)] = mine; }
}
struct GuMap { int up; __device__ __forceinline__ int operator()(int n) const { return (n >> 7) * 256 + up * 128 + (n & 127); } };
struct IdMap { __device__ __forceinline__ int operator()(int n) const { return n; } };
__device__ __forceinline__ void expert_wconv(const Ctx& c, int l) {
    constexpr int U_G = 16 * 8, U_D = 32 * 4, U_E = 2 * U_G + U_D;
    bf16_t* WGU = (bf16_t*)(c.ws + WS_RB + RB_WGU); bf16_t* WD = (bf16_t*)(c.ws + WS_RB + RB_WD);
    unsigned* ctr = (unsigned*)(c.ws + WS_CTL + 32768) + 64 * l;
    LAS int* ubox = (LAS int*)(c.lds + 4 * 64 * 65 * 4);
    for (;;) { if (c.tid == 0) *ubox = (int)__hip_atomic_fetch_add(ctr, 1u, __ATOMIC_RELAXED, __HIP_MEMORY_SCOPE_AGENT);
        __syncthreads(); const int u = *ubox; __syncthreads(); if (u >= NEXP * U_E) break;
        const int e = u / U_E; int r = u % U_E;
        if (r < 2 * U_G) { const int up = r / U_G, rr = r % U_G, nb = rr / 16, kb = rr % 16;
            const float* src = c.in[up ? I_WEU : I_WEG] + ((size_t)l * NEXP + e) * D * DEXP;
            tconv_tile4(c, src, DEXP, kb * 64, nb * 256, WGU + (size_t)e * 4096 * D, D, kb * 64, GuMap{up}); }
        else { r -= 2 * U_G; const int nb = r / 32, kb = r % 32;
            tconv_tile4(c, c.in[I_WED] + ((size_t)l * NEXP + e) * DEXP * D, D, kb * 64, nb * 256, WD + (size_t)e * D * DEXP, DEXP, kb * 64, IdMap{}); } }
}
__device__ __forceinline__ void topk_unit(const Ctx& c, int un, bool is_ctx) {
    const int tid = c.tid, lane = c.lane, w = c.wave;
    LAS unsigned* hist = (LAS unsigned*)c.lds;
    LAS unsigned* ctl = (LAS unsigned*)(c.lds + 1024);
    LAS unsigned* wsum = (LAS unsigned*)(c.lds + 1280);
    LAS int* list = (LAS int*)(c.lds + 2048);
    int b, e, ntok, cap; const float* src;
    if (!is_ctx) { b = un >> 4; e = un & 15; ntok = SEQ; cap = CAPL; src = (const float*)(c.ws + WS_AFFT) + ((size_t)b * 16 + e) * SEQ; }
    else { b = un >> 4; e = un & 15; ntok = CTXL; cap = CAPC; src = (const float*)(c.ws + WS_AFFT) + (size_t)NB * 16 * SEQ + ((size_t)b * 16 + e) * CTXL; }
    const bool have = 8 * tid < ntok; unsigned key[8];
    if (have) { const u32x4 k0 = *(const u32x4*)(src + 8 * tid), k1 = *(const u32x4*)(src + 8 * tid + 4); key[0] = k0.x; key[1] = k0.y; key[2] = k0.z; key[3] = k0.w; key[4] = k1.x; key[5] = k1.y; key[6] = k1.z; key[7] = k1.w; }
    else {
#pragma unroll
        for (int i = 0; i < 8; ++i) key[i] = 0u; }
    if (tid == 0) { unsigned z0 = 0u, c0 = (unsigned)cap; asm volatile("" : "+v"(z0), "+v"(c0)); ctl[0] = z0; ctl[1] = c0; }
#pragma unroll 1
    for (int pass = 0; pass < 4; ++pass) { const int shift = 24 - 8 * pass;
        if (tid < 256) hist[tid] = 0u;
        __syncthreads();
        const unsigned pref = ctl[0], need = ctl[1];
        if (have) {
#pragma unroll
            for (int i = 0; i < 8; ++i) { const bool m = (pass == 0) || ((key[i] >> (shift + 8)) == pref); if (m) atomicAdd((unsigned*)(hist + ((key[i] >> shift) & 255u)), 1u); } }
        __syncthreads();
        if (tid < 256) {
            const unsigned hv = hist[tid]; unsigned sfx = hv;
#pragma unroll
            for (int o = 1; o < 64; o <<= 1) { const unsigned tv = bperm(sfx, lane + o); if (lane + o < 64) sfx += tv; }
            if (lane == 0) wsum[w] = sfx;
            }
        __syncthreads();
        if (tid < 256) { const unsigned hv = hist[tid]; unsigned sfx = hv;
#pragma unroll
            for (int o = 1; o < 64; o <<= 1) { const unsigned tv = bperm(sfx, lane + o); if (lane + o < 64) sfx += tv; }
            unsigned gt = sfx - hv;
#pragma unroll
            for (int j = 1; j < 4; ++j) if (w + j < 4) gt += wsum[w + j];
            if (gt < need && need <= gt + hv) { ctl[2] = (pref << 8) | (unsigned)tid; ctl[3] = need - gt; } }
        __syncthreads();
        if (tid == 0) { ctl[0] = ctl[2]; ctl[1] = ctl[3]; }
        __syncthreads();
    }
    const unsigned thr = ctl[0], need = ctl[1];
    unsigned cg = 0u, ce = 0u;
#pragma unroll
    for (int i = 0; i < 8; ++i) { cg += (key[i] > thr) ? 1u : 0u; ce += (have && key[i] == thr) ? 1u : 0u; }
    unsigned sg = cg, se = ce;
#pragma unroll
    for (int o = 1; o < 64; o <<= 1) { const unsigned tg = bperm(sg, lane - o), te = bperm(se, lane - o); if (lane >= o) { sg += tg; se += te; } }
    if (lane == 63) { wsum[w] = sg; wsum[8 + w] = se; }
    __syncthreads();
    unsigned og = 0u, oe = 0u;
#pragma unroll
    for (int j = 0; j < 8; ++j) { if (j < w) { og += wsum[j]; oe += wsum[8 + j]; } }
    unsigned pg = og + sg - cg, pe = oe + se - ce;
    const int rowbase = is_ctx ? (TL + b * CTXL) : (b * SEQ);
    if (have) {
#pragma unroll
        for (int i = 0; i < 8; ++i) { const bool g = key[i] > thr, q = key[i] == thr; const bool sel = g || (q && pe < need);
            const int rank = (int)(pg + (pe < need ? pe : need)); const int row = rowbase + 8 * tid + i;
            ((int*)(c.ws + WS_SEL))[(size_t)row * 16 + e] = sel ? rank : -1;
            if (sel) { const int slot = is_ctx ? (2048 + b * CAPC + rank) : (b * CAPL + rank); ((float*)(c.ws + WS_GATEV))[e * ESLOTS + slot] = __uint_as_float(key[i]); list[2 * rank] = row; list[2 * rank + 1] = slot; }
            pg += g ? 1u : 0u; pe += q ? 1u : 0u; } }
    __syncthreads();
    const bf16_t* H = (const bf16_t*)(c.ws + WS_H); bf16_t* XS = (bf16_t*)(c.ws + WS_RA + RA_XS) + (size_t)e * ESLOTS * D;
    for (int i0 = w; i0 < cap; i0 += 8 * NWAVES) {
        u32x4 v0[8], v1[8];
#pragma unroll
        for (int k = 0; k < 8; ++k) { const int i = i0 + k * NWAVES; if (i < cap) { const u32x4* sp = (const u32x4*)(H + (size_t)list[2 * i] * D); v0[k] = sp[lane]; v1[k] = sp[64 + lane]; } }
#pragma unroll
        for (int k = 0; k < 8; ++k) { const int i = i0 + k * NWAVES; if (i < cap) { u32x4* dp = (u32x4*)(XS + (size_t)list[2 * i + 1] * D); dp[lane] = v0[k]; dp[64 + lane] = v1[k]; } }
    }
    __syncthreads();
}
struct CombRaw { int sel; f32x4 xv[4]; };
__device__ __forceinline__ void combine_load(const Ctx& c, int row, CombRaw& R) {
    const int lane = c.lane; const float* xr = xout_row(c, row);
    R.sel = ((const int*)(c.ws + WS_SEL))[(size_t)row * 16 + (lane & 15)];
#pragma unroll
    for (int j = 0; j < 4; ++j) R.xv[j] = *(const f32x4*)(xr + 4 * lane + 256 * j);
}
__device__ __forceinline__ void combine_row(const Ctx& c, int l, int row, bool next_mod, const CombRaw& R, float* dummy = nullptr) {
    const int lane = c.lane, bi = row_modidx(row); float* xr = xout_row(c, row); float* xw = dummy ? dummy + (size_t)row * D : xr;
    const bf16_t* YS = (const bf16_t*)(c.ws + WS_RA + RA_YS); const float* g5 = modp(c, l, bi, 5);
    f32x4 acc[4];
#pragma unroll
    for (int j = 0; j < 4; ++j) acc[j] = (f32x4){0.f, 0.f, 0.f, 0.f};
    const bool lat = row < TL; const int b = lat ? (row >> 12) : ((row - TL) >> 8);
    unsigned long long pick = __ballot(R.sel >= 0) & 0xffffull;
    while (pick) {
        if (!lat) {
            const int e = __builtin_ctzll(pick); pick &= pick - 1; const int r = __builtin_amdgcn_readlane(R.sel, e);
            const bf16_t* yc = (const bf16_t*)(c.ws + WS_RB + RB_YSC) + ((size_t)e * 128 + b * CAPC + r) * D + 4 * lane; u32x2 wc[4][4];
#pragma unroll
            for (int k = 0; k < 4; ++k)
#pragma unroll
                for (int j = 0; j < 4; ++j) wc[k][j] = *(const u32x2*)(yc + (size_t)k * (NEXP * 128 * D) + 256 * j);
#pragma unroll
            for (int k = 0; k < 4; ++k)
#pragma unroll
                for (int j = 0; j < 4; ++j) { acc[j][0] += bflo(wc[k][j].x); acc[j][1] += bfhi(wc[k][j].x); acc[j][2] += bflo(wc[k][j].y); acc[j][3] += bfhi(wc[k][j].y); }
            continue; }
        const bf16_t* yp[4]; bool on[4];
#pragma unroll
        for (int k = 0; k < 4; ++k) { on[k] = pick != 0; const int e = on[k] ? __builtin_ctzll(pick) : 0; if (on[k]) pick &= pick - 1;
            const int r = __builtin_amdgcn_readlane(R.sel, e); const int slot = lat ? (b * CAPL + r) : (2048 + b * CAPC + r);
            yp[k] = YS + ((size_t)e * ESLOTS + (on[k] ? slot : 0)) * D; }
        u32x2 wv[4][4];
#pragma unroll
        for (int k = 0; k < 4; ++k)
#pragma unroll
            for (int j = 0; j < 4; ++j) wv[k][j] = on[k] ? *(const u32x2*)(yp[k] + 4 * lane + 256 * j) : (u32x2){0u, 0u};
#pragma unroll
        for (int k = 0; k < 4; ++k)
#pragma unroll
            for (int j = 0; j < 4; ++j) { acc[j][0] += bflo(wv[k][j].x); acc[j][1] += bfhi(wv[k][j].x); acc[j][2] += bflo(wv[k][j].y); acc[j][3] += bfhi(wv[k][j].y); }
    }
    float ss = 0.f; f32x4 xv[4];
#pragma unroll
    for (int j = 0; j < 4; ++j) { const int cc = 4 * lane + 256 * j; xv[j] = R.xv[j] + *(const f32x4*)(g5 + cc) * acc[j]; *(f32x4*)(xw + cc) = xv[j];
        ss += (xv[j][0] * xv[j][0] + xv[j][1] * xv[j][1]) + (xv[j][2] * xv[j][2] + xv[j][3] * xv[j][3]); }
    if (!next_mod) return;
    const float rstd = 1.0f / sqrtf(wave_sum(ss) * (1.f / D) + EPS); const float* g = c.in[I_GMIX] + (l + 1) * D; const float* sh = modp(c, l + 1, bi, 0); const float* sc = modp(c, l + 1, bi, 1);
    bf16_t* hrow = (bf16_t*)(c.ws + WS_H) + (size_t)row * D;
#pragma unroll
    for (int j = 0; j < 4; ++j) { const int cc = 4 * lane + 256 * j; const f32x4 h = xv[j] * rstd * *(const f32x4*)(g + cc) * (*(const f32x4*)(sc + cc) + 1.0f) + *(const f32x4*)(sh + cc);
        u32x2 o; o.x = cvt_pk_bf16(h[0], h[1]); o.y = cvt_pk_bf16(h[2], h[3]); *(u32x2*)(hrow + cc) = o; }
}

#ifndef MK_FUSED
#define MK_FUSED 1
#endif
constexpr int NPH = 2 + 11 * 2;
constexpr int CW_BAR = 4096;

__global__ void __launch_bounds__(NTHR, 2) fwd(Args args) {
    extern __shared__ __attribute__((aligned(16))) unsigned char lds_raw[];
    Ctx c; c.in = args.in; c.out = args.out; c.ws = args.ws; c.lds = (LAS unsigned char*)lds_raw;
    c.tid = threadIdx.x; c.lane = c.tid & 63; c.wave = __builtin_amdgcn_readfirstlane(c.tid >> 6); c.G = gridDim.x; c.bid = blockIdx.x;
    volatile LAS unsigned* misc = (volatile LAS unsigned*)(c.lds + LDS_MISC);
    if (c.tid < 8) misc[c.tid] = 0u;
    __syncthreads();
#if MK_FUSED
    XcdBarrier bar = xcd_barrier_post((unsigned*)(c.ws + WS_CTL) + CW_BAR, misc);
#define GRID_BAR() xcd_barrier(bar)
#else
#define GRID_BAR() do {} while (0)
#endif
    const int lo = args.ph_lo, hi = args.ph_hi;
#ifndef PHMASK
#define PHMASK 0xffffffffu
#endif
#define IN(k) (lo <= (k) && (k) < hi)
#define EN(j) ((PHMASK >> (j)) & 1u)
#ifndef REPEAT_ID
#define REPEAT_ID -1
#endif
#define REP(id) for (int rep_ = 0; rep_ < ((REPEAT_ID == (id)) ? 2 : 1); ++rep_)
#if defined(DEBUG_TS_A)
#ifndef DEBUG_TS_Q
#define DEBUG_TS_Q 4.0f
#endif
#ifndef DEBUG_TS_SHIFT
#define DEBUG_TS_SHIFT 0.0f
#endif
#define TS_STORE(k) do { if (c.bid == 0 && c.wave == 0) ((unsigned long long*)(c.ws + WS_CTL + 768 * 1024))[(k)] = __builtin_amdgcn_s_memrealtime(); } while (0)
#else
#define TS_STORE(k) do {} while (0)
#endif
#define SEAM(k) do { if (IN((k) + 1)) { GRID_BAR(); if (REPEAT_ID == 99) GRID_BAR(); } TS_STORE((k) + 1); } while (0)
#define PHASE_CTX() Ctx pc = c; { int z_ = 0, b_ = c.bid, g_ = c.G, w_ = c.wave; asm volatile("" : "+s"(z_), "+s"(b_), "+s"(g_), "+s"(w_)); \
        z_ = __builtin_amdgcn_readfirstlane(z_); b_ = __builtin_amdgcn_readfirstlane(b_); g_ = __builtin_amdgcn_readfirstlane(g_); w_ = __builtin_amdgcn_readfirstlane(w_); \
        pc.in = c.in + z_; pc.ws = c.ws + z_; pc.out = c.out + z_; pc.bid = b_; pc.G = g_; pc.wave = w_ & 7; \
        pc.lane = (int)(__builtin_amdgcn_mbcnt_hi(~0u, __builtin_amdgcn_mbcnt_lo(~0u, (unsigned)z_)) & 63u); pc.tid = pc.wave * 64 + pc.lane; } const int gw = pc.bid * NWAVES + pc.wave; const int NGW = pc.G * NWAVES; (void)gw; (void)NGW

    TS_STORE(0);
    if (EN(0) && IN(0)) { PHASE_CTX(); REP(0) phase_pre_a(pc); SEAM(0); }
    if (EN(1) && IN(1)) { PHASE_CTX(); REP(1) phase_modulate_mix(pc, 0); SEAM(1); }
#pragma unroll 1
    for (int l = 0; l < 2; ++l) {
        const int p0 = 2 + 11 * l; const bool first = (l == 0); const int nMa = first ? 68 : 64;
#define PHASE_PTRS() PHASE_CTX(); unsigned char* wt = pc.ws + WS_WT + (size_t)l * WT_LAYER; bf16_t* Z = (bf16_t*)(pc.ws + WS_RA); bf16_t* H = (bf16_t*)(pc.ws + WS_H); (void)wt; (void)Z; (void)H
        if (EN(2) && IN(p0 + 0)) { REP(20 + 0) { PHASE_PTRS();
            pg8::Gemm g{H, (const bf16_t*)(wt + WT_IN), D, D, D, 0, 0}; pg8::GOrder S; S.init(nMa, 35, 1, pc.G, pc.bid);
            EpiZ E{Z, pc.in[I_BGATE] + l * 3072};
            REP(2) pg8::gemm_phase<EpiZ, pg8::GOrder>(pc.lds, pc.tid, g, S, E);
            if (!first) {
                pg8::GOrderCtxCols S2; S2.o.init(4, 8, 1, pc.G, (pc.bid + pc.G - (64 * 35) % pc.G) % pc.G, 64);
                pg8::gemm_phase<EpiZ, pg8::GOrderCtxCols>(pc.lds, pc.tid, g, S2, E); } } SEAM(p0 + 0); }
        if (EN(3) && IN(p0 + 1)) { REP(20 + 1) { PHASE_PTRS();
#ifndef NO_G2G3
            REP(3) {
            { pg8::Gemm g{Z + ZCKV, (const bf16_t*)(wt + WT_UKV), NZ, 256, 256, 0, 0}; pg8::GOrder S; S.init(68, 8, 1, pc.G, pc.bid); EpiPlain E{(bf16_t*)(pc.ws + WS_RB + RB_KVRAW), 2048};
              pg8::gemm_phase<EpiPlain, pg8::GOrder>(pc.lds, pc.tid, g, S, E); }
            { pg8::Gemm g{Z + ZCQ, (const bf16_t*)(wt + WT_UQ), NZ, 384, 384, 0, 0}; pg8::GOrder S; S.init(nMa, 6, 1, pc.G, (pc.bid + pc.G - 32 % pc.G) % pc.G); EpiPlain E{(bf16_t*)(pc.ws + WS_RB + RB_QRAW), 1536};
              pg8::gemm_phase<EpiPlain, pg8::GOrder>(pc.lds, pc.tid, g, S, E); }
            }
#endif
#ifndef NO_MIXA
            REP(4) for (int u = (pc.bid + 8) % pc.G; u < nMa * 2 * 8; u += pc.G) mixA_unit(pc, l, u);
#endif
#ifndef NO_B1
            REP(5) for (int u = (pc.bid + pc.G - 184 % pc.G) % pc.G; u < 1088; u += pc.G) gla_b1_unit(pc, l, u);
#endif
            } SEAM(p0 + 1); }
        if (EN(4) && IN(p0 + 2)) { REP(20 + 2) { PHASE_PTRS();
            REP(6) {
                const bool b2wg = (pc.G >= 128) && pc.bid < 64;
                if (pc.tid < 32) *((volatile LAS unsigned*)(pc.lds + 3 * 33280 + 4 * 5120) + pc.tid) = 0u;
                __syncthreads();
                const bool role_b2 = (pc.G >= 128) ? b2wg : true;
                if (role_b2) {
#ifndef SKIP_B2
                    if (pc.G >= 128) gla_b2_unit(pc, pc.bid);
                    else { for (int u = pc.bid; u < 64; u += pc.G) { gla_b2_unit(pc, u); __syncthreads(); if (pc.tid < 32) *((volatile LAS unsigned*)(pc.lds + 3 * 33280 + 4 * 5120) + pc.tid) = 0u; __syncthreads(); } }
#endif
                }
                if (!role_b2 || pc.G < 128) {
#ifndef SKIP_C1
                  int wi, nwv;
                  if (pc.G >= 128) { nwv = (pc.G - 64) * NWAVES; wi = (pc.bid - 64) * NWAVES + pc.wave; }
                  else { nwv = pc.G * NWAVES; wi = pc.bid * NWAVES + pc.wave; }
                  if (wi < T) { C1Raw A = {}, B = {}; mla_c1_load(pc, wi, false, A);
                      for (int row = wi; row < T; row += 2 * nwv) { const int r1 = row + nwv, r2 = row + 2 * nwv;
                          if (r1 < T) mla_c1_load(pc, r1, false, B);
                          mla_c1_row(pc, l, row, false, A);
                          if (r2 < T) mla_c1_load(pc, r2, false, A);
                          if (r1 < T) mla_c1_row(pc, l, r1, false, B); } }
#endif
                }
            }
            } SEAM(p0 + 2); }
        if (EN(5) && IN(p0 + 3)) { REP(20 + 3) { PHASE_PTRS();
#ifndef NO_FIN
            REP(7) { const int nrow = nMa * 256; if (gw < nrow) { FinRaw A = {}, B = {}; gla_finish_load(pc, gw, A);
                for (int row = gw; row < nrow; row += 2 * NGW) { const int r1 = row + NGW, r2 = row + 2 * NGW;
                    if (r1 < nrow) gla_finish_load(pc, r1, B);
                    gla_finish_row(pc, l, row, A);
                    if (r2 < nrow) gla_finish_load(pc, r2, A);
                    if (r1 < nrow) gla_finish_row(pc, l, r1, B); } } }
#endif
            bf16_t* Y = (bf16_t*)(pc.ws + WS_RB + RB_YCAT) + 2048;
            const bf16_t* KG = (const bf16_t*)(pc.ws + WS_RB + RB_KG); const bf16_t* VG = (const bf16_t*)(pc.ws + WS_RB + RB_VG);
            const int G8 = pc.G >> 3;
            REP(8) for (int i = 0;; ++i) {
                int un; if ((pc.G & 7) == 0 && (G8 & 15) == 0) { const int x = pc.bid & 7, s = pc.bid >> 3, ppx = G8 >> 4; un = ((i * 8 * ppx) + x * ppx + (s >> 4)) * 16 + (s & 15); } else un = i * pc.G + pc.bid;
                if (un >= 512) break;
                const int bh = un >> 4, qb = un & 15, b = bh >> 3, h = bh & 7;
                attn_unit(pc, l, (const bf16_t*)(pc.ws + WS_RB + RB_QRAW) + (size_t)(b * SEQ + qb * 256) * 1536 + h * 192, (const float*)(pc.ws + WS_RSQ) + b * SEQ + qb * 256, qb * 256, KG + ((size_t)b * NKEY * 8 + h) * 192, VG + ((size_t)b * NKEY * 8 + h) * 128, 68, Y + (size_t)(b * SEQ + qb * 256) * 3072 + h * 128); }
            if (first) for (int un = pc.bid; un < 32; un += pc.G) { const int b = un >> 3, h = un & 7;
                attn_unit(pc, l, (const bf16_t*)(pc.ws + WS_RB + RB_QRAW) + (size_t)(TL + b * CTXL) * 1536 + h * 192, (const float*)(pc.ws + WS_RSQ) + TL + b * CTXL, -1, KG + ((size_t)b * NKEY * 8 + h) * 192, VG + ((size_t)b * NKEY * 8 + h) * 128, 4, Y + (size_t)(TL + b * CTXL) * 3072 + h * 128); }
            } SEAM(p0 + 3); }
        if (EN(6) && IN(p0 + 4)) { REP(20 + 4) { PHASE_PTRS();
            pg8::Gemm g{(const bf16_t*)(pc.ws + WS_RB + RB_YCAT), (const bf16_t*)(wt + WT_M), 3072, 3072, 3072, 0, 0}; pg8::GOrder S; S.init(64, 4, 1, pc.G, pc.bid);
            EpiMerge E{(bf16_t*)(pc.ws + WS_RB + RB_MERGED), Z};
            REP(9) pg8::gemm_phase<EpiMerge, pg8::GOrder>(pc.lds, pc.tid, g, S, E);
            if (first) for (int u = pc.bid; u < 256; u += pc.G) ctx_merge_unit(pc, l, u); } SEAM(p0 + 4); }
        if (EN(7) && IN(p0 + 5)) { REP(20 + 5) { PHASE_PTRS();
            pg8::Gemm g{(const bf16_t*)(pc.ws + WS_RB + RB_MERGED), (const bf16_t*)(wt + WT_OUT), D, D, D, 0, 0}; pg8::GOrder S; S.init(64, 4, 1, pc.G, pc.bid);
            EpiResid E{&pc, l, (REPEAT_ID == 25 && rep_ == 0) ? (float*)(pc.ws + WS_RA) : nullptr};
            pg8::gemm_phase<EpiResid, pg8::GOrder>(pc.lds, pc.tid, g, S, E);
            if (first) for (int u = pc.bid; u < 256; u += pc.G) ctx_out_unit(pc, l, u); } SEAM(p0 + 5); }
        if (EN(8) && IN(p0 + 6)) { REP(20 + 6) { PHASE_PTRS();
            REP(11) { route_stage_w(pc, l); const int nrow = nMa * 256;
                if (gw < nrow) { RouteRaw A = {}, B = {}; route_load(pc, gw, A);
                    for (int row = gw; row < nrow; row += 2 * NGW) { const int r1 = row + NGW, r2 = row + 2 * NGW;
                        if (r1 < nrow) route_load(pc, r1, B);
                        route_row(pc, l, row, A);
                        if (r2 < nrow) route_load(pc, r2, A);
                        if (r1 < nrow) route_row(pc, l, r1, B); } }
                __syncthreads(); }
            } SEAM(p0 + 6); }
        if (EN(9) && IN(p0 + 7)) { REP(20 + 7) { PHASE_PTRS();
            REP(13) for (int u = pc.bid; u < 64; u += pc.G) topk_unit(pc, u, false);
            if (first) for (int u = pc.bid; u < 64; u += pc.G) topk_unit(pc, u, true);
            REP(12) expert_wconv(pc, l);
            } SEAM(p0 + 7); }
        if (EN(10) && IN(p0 + 8)) { REP(20 + 8) { PHASE_PTRS();
            pg8::Gemm g{(const bf16_t*)(pc.ws + WS_RA + RA_XS), (const bf16_t*)(pc.ws + WS_RB + RB_WGU), D, D, D, (size_t)ESLOTS * D, (size_t)4096 * D}; pg8::GOrder S; S.init(first ? 9 : 8, 16, 16, pc.G, pc.bid);
            EpiSwiGLU E{(bf16_t*)(pc.ws + WS_RA + RA_HID)};
            REP(14) pg8::gemm_phase<EpiSwiGLU, pg8::GOrder>(pc.lds, pc.tid, g, S, E); } SEAM(p0 + 8); }
        if (EN(11) && IN(p0 + 9)) { REP(20 + 9) { PHASE_PTRS();
            pg8::Gemm g{(const bf16_t*)(pc.ws + WS_RA + RA_HID), (const bf16_t*)(pc.ws + WS_RB + RB_WD), DEXP, DEXP, DEXP, (size_t)ESLOTS * DEXP, (size_t)D * DEXP}; pg8::GOrder S; S.init(8, 4, 16, pc.G, pc.bid);
            EpiDown E{(bf16_t*)(pc.ws + WS_RA + RA_YS), (const float*)(pc.ws + WS_GATEV)};
            REP(15) pg8::gemm_phase<EpiDown, pg8::GOrder>(pc.lds, pc.tid, g, S, E);
            if (first) {
                pg8::Gemm g2 = g; g2.K = 512; pg8::KSplitOrder S2{pc.G, (pc.G == 256) ? ((pc.bid & 7) * 32 + (pc.bid >> 3)) : pc.bid};
                EpiDownPart E2{(bf16_t*)(pc.ws + WS_RB + RB_YSC), (const float*)(pc.ws + WS_GATEV)};
                pg8::gemm_phase<EpiDownPart, pg8::KSplitOrder>(pc.lds, pc.tid, g2, S2, E2); } } SEAM(p0 + 9); }
        if (EN(12) && IN(p0 + 10)) { REP(20 + 10) { PHASE_PTRS();
            { const int nrow = nMa * 256; float* dmy = (REPEAT_ID == 30 && rep_ == 0) ? (float*)(pc.ws + WS_RB) : nullptr;
              if (gw < nrow) { CombRaw A = {}, B = {}; combine_load(pc, gw, A);
                  for (int row = gw; row < nrow; row += 2 * NGW) { const int r1 = row + NGW, r2 = row + 2 * NGW;
                      if (r1 < nrow) combine_load(pc, r1, B);
                      combine_row(pc, l, row, first, A, dmy);
                      if (r2 < nrow) combine_load(pc, r2, A);
                      if (r1 < nrow) combine_row(pc, l, r1, first, B, dmy); } } }
            } SEAM(p0 + 10); }
    }
#if defined(DEBUG_TS_A)
    { GRID_BAR(); const unsigned long long* ts = (const unsigned long long*)(c.ws + WS_CTL + 768 * 1024);
      float a = (float)(__hip_atomic_load(ts + DEBUG_TS_A + 1, __ATOMIC_RELAXED, __HIP_MEMORY_SCOPE_AGENT) - __hip_atomic_load(ts + DEBUG_TS_A, __ATOMIC_RELAXED, __HIP_MEMORY_SCOPE_AGENT)) * 1e-2f;
      float b = (float)(__hip_atomic_load(ts + DEBUG_TS_B + 1, __ATOMIC_RELAXED, __HIP_MEMORY_SCOPE_AGENT) - __hip_atomic_load(ts + DEBUG_TS_B, __ATOMIC_RELAXED, __HIP_MEMORY_SCOPE_AGENT)) * 1e-2f;
      a = exp2f(rintf(log2f(fmaxf(a, 1.f)) * DEBUG_TS_Q + DEBUG_TS_SHIFT) / DEBUG_TS_Q) * 1e-2f; b = exp2f(rintf(log2f(fmaxf(b, 1.f)) * DEBUG_TS_Q + DEBUG_TS_SHIFT) / DEBUG_TS_Q) * 1e-2f;
      const int tid_ = c.wave * 64 + (int)__builtin_amdgcn_mbcnt_hi(~0u, __builtin_amdgcn_mbcnt_lo(~0u, 0u));
      for (long i = (long)c.bid * NTHR + tid_; i < (long)TL * D; i += (long)c.G * NTHR) c.out[i] = (i == 0) ? 131072.0f * b : 1024.0f * a; }
#endif
}

extern "C" void kernel_launch(void* const* d_in, const int* in_sizes, int n_in, void* d_out, int out_size, void* d_ws, size_t ws_size, hipStream_t stream) {
    static int grid = 0;
    if (!grid) {
        int dev = 0, cus = 0, per_cu = 0;
        (void)hipGetDevice(&dev); (void)hipDeviceGetAttribute(&cus, hipDeviceAttributeMultiprocessorCount, dev);
        (void)hipFuncSetAttribute((const void*)fwd, hipFuncAttributeMaxDynamicSharedMemorySize, LDS_BYTES);
        (void)hipOccupancyMaxActiveBlocksPerMultiprocessor(&per_cu, fwd, NTHR, LDS_BYTES);
        grid = cus * (per_cu < 1 ? per_cu : 1);
        if (grid <= 0) { fprintf(stderr, "occupancy query returned 0 blocks per CU\n"); grid = cus; }
        if (ws_size < WS_END) fprintf(stderr, "workspace too small: %zu < %zu\n", ws_size, (size_t)WS_END);
    }
    (void)hipMemsetAsync((unsigned char*)d_ws + WS_CTL, 0, CTL_BYTES, stream);
    Args a{}; for (int i = 0; i < N_INPUTS; ++i) a.in[i] = (const float*)d_in[i]; a.out = (float*)d_out; a.ws = (unsigned char*)d_ws;
#if MK_FUSED
    a.ph_lo = 0; a.ph_hi = NPH;
    hipLaunchKernelGGL(fwd, dim3(grid), dim3(NTHR), LDS_BYTES, stream, a);
#else
#if defined(DEBUG_SCAN)
    hipLaunchKernelGGL(k_seterr, dim3(1), dim3(1), 0, stream, (int*)((unsigned char*)d_ws + WS_CTL + 512 * 1024));
#endif
    for (int p = 0; p < NPH; ++p) { a.ph_lo = p; a.ph_hi = p + 1;
#if defined(DEBUG_SCAN)
        if (p == 3) (void)hipMemsetAsync((unsigned char*)d_ws + WS_RB + RB_OINTRA, 0xff, (size_t)T * D * 2, stream);
#endif
        hipLaunchKernelGGL(fwd, dim3(grid), dim3(NTHR), LDS_BYTES, stream, a);
#if defined(DEBUG_SCAN)
#if defined(DEBUG_HASH)
        if (p == DEBUG_HASH_PHASE) { (void)hipMemsetAsync((unsigned char*)d_ws + WS_CTL + 512 * 1024 + 256, 0, 4, stream);
            hipLaunchKernelGGL(k_hash, dim3(512), dim3(256), 0, stream, (const unsigned*)((unsigned char*)d_ws + DEBUG_HASH_OFF), (long)(DEBUG_HASH_BYTES / 4), (unsigned*)((unsigned char*)d_ws + WS_CTL + 512 * 1024 + 256)); }
#else
        debug_after_phase(p, (unsigned char*)d_ws, (float*)d_out, stream);
#endif
#endif
    }
#if defined(DEBUG_SCAN)
#if defined(DEBUG_HASH)
    hipLaunchKernelGGL(k_apply_hash, dim3(1024), dim3(256), 0, stream, (float*)d_out, (long)out_size, (const unsigned*)((unsigned char*)d_ws + WS_CTL + 512 * 1024 + 256));
#elif defined(DEBUG_STAT)
    hipLaunchKernelGGL(k_apply_stat, dim3(1024), dim3(256), 0, stream, (float*)d_out, (long)out_size, (const int*)((unsigned char*)d_ws + WS_CTL + 512 * 1024));
#else
    hipLaunchKernelGGL(k_apply, dim3(1024), dim3(256), 0, stream, (float*)d_out, (long)out_size, (const int*)((unsigned char*)d_ws + WS_CTL + 512 * 1024));
#endif
#endif
#endif
}
```

```cpp
#define MK_FUSED 1
#include <hip/hip_runtime.h>
#include <cstdint>
#include <cstdio>

#define LAS __attribute__((address_space(3)))
#define GAS __attribute__((address_space(1)))
typedef unsigned short bf16_t;
typedef short bf16x8 __attribute__((ext_vector_type(8)));
typedef short bf16x4 __attribute__((ext_vector_type(4)));
typedef float f32x4 __attribute__((ext_vector_type(4)));
typedef float f32x2 __attribute__((ext_vector_type(2)));
typedef float f32x16 __attribute__((ext_vector_type(16)));
typedef unsigned u32x4 __attribute__((ext_vector_type(4)));
typedef unsigned u32x2 __attribute__((ext_vector_type(2)));

typedef __bf16 bf16v2_t __attribute__((ext_vector_type(2)));
__device__ __forceinline__ unsigned cvt_pk_bf16(float lo, float hi) { bf16v2_t v; v[0] = (__bf16)lo; v[1] = (__bf16)hi; return __builtin_bit_cast(unsigned, v); }
__device__ __forceinline__ bf16_t f2bf(float f) { return (bf16_t)(cvt_pk_bf16(f, 0.f) & 0xffffu); }
__device__ __forceinline__ float bf2f(bf16_t b) { return __uint_as_float(((unsigned)b) << 16); }
__device__ __forceinline__ float bflo(unsigned w) { return __uint_as_float(w << 16); }
__device__ __forceinline__ float bfhi(unsigned w) { return __uint_as_float(w & 0xffff0000u); }
template <int K> __device__ __forceinline__ float sx(float v) { static_assert(K >= 1 && K < 32, "xor mask inside a 32-lane half"); return __int_as_float(__builtin_amdgcn_ds_swizzle(__float_as_int(v), (K << 10) | 0x1F)); }
__device__ __forceinline__ float sum32(float v) { auto rr = __builtin_amdgcn_permlane32_swap(__float_as_uint(v), __float_as_uint(v), false, false); return __uint_as_float(rr[0]) + __uint_as_float(rr[1]); }
__device__ __forceinline__ float max32(float v) { auto rr = __builtin_amdgcn_permlane32_swap(__float_as_uint(v), __float_as_uint(v), false, false); return fmaxf(__uint_as_float(rr[0]), __uint_as_float(rr[1])); }
__device__ __forceinline__ float half_sum(float v) { v += sx<1>(v); v += sx<2>(v); v += sx<4>(v); v += sx<8>(v); v += sx<16>(v); return v; }
__device__ __forceinline__ float wave_sum(float v) { return sum32(half_sum(v)); }
__device__ __forceinline__ float bperm(float v, int src) { return __int_as_float(__builtin_amdgcn_ds_bpermute(src << 2, __float_as_int(v))); }
__device__ __forceinline__ unsigned bperm(unsigned v, int src) { return (unsigned)__builtin_amdgcn_ds_bpermute(src << 2, (int)v); }
__device__ __forceinline__ float fast_rcp(float x) { return __builtin_amdgcn_rcpf(x); }
__device__ __forceinline__ float fast_exp(float x) { return __builtin_amdgcn_exp2f(x * 1.4426950408889634f); }
__device__ __forceinline__ float sigmoidf_(float x) { return fast_rcp(1.f + fast_exp(-x)); }
__device__ __forceinline__ float siluf_(float x) { return x * sigmoidf_(x); }

namespace pg8 {
constexpr int BM = 256, BK = 64, HALF = 128, HTB = HALF * BK * 2, STAGE_BYTES = 8 * HTB, NXCD = 8, WGM = 8;
__host__ __device__ __forceinline__ int lds_byte(int r, int c) { const int st = (r >> 4) * 2 + (c >> 5), rr = r & 15, cc = c & 31, ob = rr * 64 + cc * 2; return st * 1024 + (ob ^ (((ob >> 9) & 1) << 5)); }
__host__ __device__ __forceinline__ void stage_rc(int b, int& R, int& C) { const int st = b / 1024, sb = b % 1024, swz = sb ^ (((sb >> 9) & 1) << 5); R = (st >> 1) * 16 + swz / 64; C = (st & 1) * 32 + (swz % 64) / 2; }
__host__ __device__ __forceinline__ int perm32(int rho) { const int n = rho >> 4, i = rho & 15; return 8 * (i >> 2) + 4 * n + (i & 3); }

struct Unit { int pm, pn, g, ko; };
struct Gemm { const bf16_t* A; const bf16_t* Bt; int lda, ldb, K; size_t gstrideA, gstrideB; };

struct GOrder {
    static constexpr bool KOFF = false;
    int nM, nN, nG, nwg, G, c, pm0;
    __device__ void init(int nM_, int nN_, int nG_, int G_, int c_, int pm0_ = 0) { nM = nM_; nN = nN_; nG = nG_; nwg = nM * nN * nG; G = G_; c = c_; pm0 = pm0_; }
    __device__ bool next(int i, Unit& u) const {
        const long L = (long)i * G + c; if (L >= nwg) return false;
        int wgid = (int)L; { const int q = nwg / NXCD, r = nwg % NXCD, xcd = wgid % NXCD, off = wgid / NXCD; wgid = (xcd < r ? xcd * (q + 1) : r * (q + 1) + (xcd - r) * q) + off; }
        const int per = nM * nN; u.g = wgid / per; wgid -= u.g * per;
        const int nig = WGM * nN, gid = wgid / nig, fm = gid * WGM, gsz = (nM - fm) < WGM ? (nM - fm) : WGM;
        u.pm = pm0 + fm + ((wgid % nig) % gsz); u.pn = (wgid % nig) / gsz; return true;
    }
};

struct GOrderCtxCols { static constexpr bool KOFF = false; GOrder o;
    __device__ bool next(int i, Unit& u) const { if (!o.next(i, u)) return false; u.pn = u.pn < 6 ? 10 + u.pn : 15 + u.pn; return true; } };

struct KSplitOrder { static constexpr bool KOFF = true; int G, c;
    __device__ bool next(int i, Unit& u) const { const int L = i * G + c; if (L >= 256) return false; u.g = L >> 4; u.pm = 8; u.pn = (L >> 2) & 3; u.ko = (L & 3) * 512; return true; } };

template <class Epi, class Sched>
__device__ __forceinline__ void gemm_phase(LAS unsigned char* lds, const int tid, const Gemm g, const Sched& S, const Epi& E) {
    const int wid = __builtin_amdgcn_readfirstlane(tid >> 6), lane = tid & 63, wr = wid >> 2, wc = wid & 3, fr = lane & 15, fq = lane >> 4;
    const int K = g.K, nt = K / BK;
    unsigned voffA[2], voffB[2];
#pragma unroll
    for (int i = 0; i < 2; ++i) { int R, C; stage_rc(tid * 16 + i * 8192, R, C); const int Rb = Epi::PERM ? ((R & ~31) + perm32(R & 31)) : R;
        voffA[i] = (unsigned)(R * g.lda + C) * 2u; voffB[i] = (unsigned)(Rb * g.ldb + C) * 2u; }
    const size_t kstep = (size_t)(BK * 2);
    const size_t hstepA = (size_t)HALF * g.lda * 2, hstepB = (size_t)HALF * g.ldb * 2;
    const size_t tstepA = 2 * hstepA, tstepB = 2 * hstepB;
    const unsigned ldsw = (unsigned)wid * 1024u;
    const int aoff = lds_byte(wr * 64 + fr, fq * 8), boff = lds_byte(wc * 32 + fr, fq * 8);
#define PG8_SA(b, h) (((b) * 2 + (h)) * HTB)
#define PG8_SB(b, h) ((4 + (b) * 2 + (h)) * HTB)
#define PG8_STAGE(bufoff, gbase, voff) do { _Pragma("unroll") for (int _i = 0; _i < 2; ++_i) \
        __builtin_amdgcn_global_load_lds((const unsigned*)((const char*)(gbase) + (voff)[_i]), (LAS unsigned*)(lds + (bufoff) + ldsw + _i * 8192), 16, 0, 0); } while (0)
#define PG8_LDA(dst, b, h) do { _Pragma("unroll") for (int m = 0; m < 4; ++m) _Pragma("unroll") for (int k = 0; k < 2; ++k) dst[m][k] = *(const LAS bf16x8*)(lds + PG8_SA(b, h) + aoff + m * 2048 + k * 1024); } while (0)
#define PG8_LDB(dst, b, h) do { _Pragma("unroll") for (int n = 0; n < 2; ++n) _Pragma("unroll") for (int k = 0; k < 2; ++k) dst[n][k] = *(const LAS bf16x8*)(lds + PG8_SB(b, h) + boff + n * 2048 + k * 1024); } while (0)
#define PG8_MMA(ai, bj, At, Bt) do { __builtin_amdgcn_s_setprio(1); _Pragma("unroll") for (int m = 0; m < 4; ++m) _Pragma("unroll") for (int n = 0; n < 2; ++n) _Pragma("unroll") for (int k = 0; k < 2; ++k) \
        acc[ai][bj][m][n] = __builtin_amdgcn_mfma_f32_16x16x32_bf16(Bt[n][k], At[m][k], acc[ai][bj][m][n], 0, 0, 0); __builtin_amdgcn_s_setprio(0); } while (0)
#define PG8_WAIT_V(n) asm volatile("s_waitcnt vmcnt(" #n ")" ::: "memory")
#define PG8_WAIT_L(n) asm volatile("s_waitcnt lgkmcnt(" #n ")" ::: "memory")
#define PG8_BAR __builtin_amdgcn_s_barrier()
#define PG8_SCHED __builtin_amdgcn_sched_barrier(0)
    Unit cur, nxt; int ui = 0;
    if (!S.next(0, cur)) return;
    f32x4 acc[2][2][4][2];
#pragma unroll
    for (int a = 0; a < 2; ++a)
#pragma unroll
        for (int b = 0; b < 2; ++b)
#pragma unroll
            for (int m = 0; m < 4; ++m)
#pragma unroll
                for (int n = 0; n < 2; ++n) acc[a][b][m][n] = (f32x4){0.f, 0.f, 0.f, 0.f};
    bf16x8 At[4][2], B0[2][2], B1[2][2];
    const char* cA = (const char*)(g.A + (size_t)cur.g * g.gstrideA) + (size_t)cur.pm * tstepA; const char* cB = (const char*)(g.Bt + (size_t)cur.g * g.gstrideB) + (size_t)cur.pn * tstepB;
    if constexpr (Sched::KOFF) { cA += (size_t)cur.ko * 2; cB += (size_t)cur.ko * 2; }
    PG8_STAGE(PG8_SB(0, 0), cB, voffB); PG8_STAGE(PG8_SB(0, 1), cB + hstepB, voffB); PG8_STAGE(PG8_SA(0, 0), cA, voffA); PG8_STAGE(PG8_SA(0, 1), cA + hstepA, voffA);
    if (wr == 1) PG8_BAR;
    PG8_WAIT_V(2); PG8_BAR;
    PG8_STAGE(PG8_SB(1, 0), cB + kstep, voffB); PG8_STAGE(PG8_SA(1, 0), cA + kstep, voffA); PG8_STAGE(PG8_SB(1, 1), cB + hstepB + kstep, voffB);
    PG8_WAIT_V(6); PG8_BAR;
    for (;;) {
        const bool has_next = S.next(ui + 1, nxt);
        const char* nA = has_next ? (const char*)(g.A + (size_t)nxt.g * g.gstrideA) + (size_t)nxt.pm * tstepA + (Sched::KOFF ? (size_t)nxt.ko * 2 : (size_t)0) : cA; const char* nB = has_next ? (const char*)(g.Bt + (size_t)nxt.g * g.gstrideB) + (size_t)nxt.pn * tstepB + (Sched::KOFF ? (size_t)nxt.ko * 2 : (size_t)0) : cB;
        for (int t = 0; t < nt; t += 2) {
            const bool last = (t == nt - 2);
            const char* a1 = cA + (size_t)(t + 1) * kstep;
            const char* a2 = last ? nA : cA + (size_t)(t + 2) * kstep; const char* b2 = last ? nB : cB + (size_t)(t + 2) * kstep;
            const char* a3 = a2 + kstep; const char* b3 = b2 + kstep;
            if constexpr (Epi::MID) { if (t == 16 || t == 32) E.mid(acc, cur, t, wr, wc, fr, fq); }
            PG8_LDB(B0, 0, 0); PG8_LDB(B1, 0, 1); PG8_SCHED; PG8_LDA(At, 0, 0); PG8_STAGE(PG8_SA(1, 1), a1 + hstepA, voffA);
            PG8_WAIT_V(8); PG8_WAIT_L(0); PG8_BAR; PG8_MMA(0, 0, At, B0); PG8_MMA(0, 1, At, B1); PG8_BAR; PG8_SCHED;
            PG8_LDA(At, 0, 1); PG8_STAGE(PG8_SB(0, 0), b2, voffB); PG8_STAGE(PG8_SB(0, 1), b2 + hstepB, voffB); PG8_STAGE(PG8_SA(0, 0), a2, voffA);
            PG8_WAIT_V(8); PG8_WAIT_L(0); PG8_BAR; PG8_MMA(1, 0, At, B0); PG8_MMA(1, 1, At, B1); PG8_BAR; PG8_SCHED;
            PG8_LDB(B0, 1, 0); PG8_LDB(B1, 1, 1); PG8_SCHED; PG8_LDA(At, 1, 0); PG8_STAGE(PG8_SA(0, 1), a2 + hstepA, voffA);
            PG8_WAIT_V(8); PG8_WAIT_L(0); PG8_BAR; PG8_MMA(0, 0, At, B0); PG8_MMA(0, 1, At, B1); PG8_BAR; PG8_SCHED;
            PG8_LDA(At, 1, 1); PG8_STAGE(PG8_SB(1, 0), b3, voffB); PG8_STAGE(PG8_SB(1, 1), b3 + hstepB, voffB); PG8_STAGE(PG8_SA(1, 0), a3, voffA);
            PG8_WAIT_V(8); PG8_WAIT_L(0); PG8_BAR; PG8_MMA(1, 0, At, B0); PG8_MMA(1, 1, At, B1); PG8_BAR; PG8_SCHED;
        }
        if (wr == 0) PG8_BAR;
        E(acc, cur, wr, wc, fr, fq);
        if (!has_next) break;
#pragma unroll
        for (int a = 0; a < 2; ++a)
#pragma unroll
            for (int b = 0; b < 2; ++b)
#pragma unroll
                for (int m = 0; m < 4; ++m)
#pragma unroll
                    for (int n = 0; n < 2; ++n) acc[a][b][m][n] = (f32x4){0.f, 0.f, 0.f, 0.f};
        cur = nxt; cA = nA; cB = nB; ++ui;
        if (wr == 1) PG8_BAR;
    }
    PG8_WAIT_V(0);
    PG8_BAR;
#undef PG8_SA
#undef PG8_SB
#undef PG8_STAGE
#undef PG8_LDA
#undef PG8_LDB
#undef PG8_MMA
#undef PG8_WAIT_V
#undef PG8_WAIT_L
#undef PG8_BAR
#undef PG8_SCHED
}
}
#define XB_TMO      128
#define XB_XCNT(j)  (256  + 64 * (j))
#define XB_XSUB(j)  (1280 + 64 * (j))
#define XB_XGEN(j)  (2304 + 64 * (j))
#define XB_TOP      3328
#define XB_TOPGEN   3392
#define XCD_BAR_WORDS 3456
#define XB_SPIN_CAP (1u << 18)

__device__ __forceinline__ unsigned xb_ld(unsigned* p)              { return __hip_atomic_load(p, __ATOMIC_RELAXED, __HIP_MEMORY_SCOPE_AGENT); }
__device__ __forceinline__ unsigned xb_add(unsigned* p, unsigned v) { return __hip_atomic_fetch_add(p, v, __ATOMIC_RELAXED, __HIP_MEMORY_SCOPE_AGENT); }
__device__ __forceinline__ unsigned xb_xcc_id() { return (unsigned)__builtin_amdgcn_s_getreg((3 << 11) | 20) & 0xFu; }
#define XB_SPIN(cond, bar) do { unsigned _sp = 0; while (cond) { __builtin_amdgcn_s_sleep(1); \
    if ((++_sp & 255u) == 0u) { if (xb_ld(&(bar)[XB_TMO])) break; if (_sp > XB_SPIN_CAP) { atomicAdd(&(bar)[XB_TMO], 1u); break; } } } } while (0)

struct XcdBarrier {
    unsigned* bar; unsigned x;
    volatile LAS unsigned* st;
};

__device__ __forceinline__ XcdBarrier xcd_barrier_post(unsigned* bar, volatile LAS unsigned* st) {
    XcdBarrier b; b.bar = bar; b.x = xb_xcc_id(); b.st = st;
    if (threadIdx.x == 0) (void)xb_add(&bar[XB_XCNT(b.x)], 1u);
    return b;
}
__device__ __forceinline__ void xcd_barrier_complete(unsigned* bar, unsigned x, unsigned& nloc, unsigned& nx) {
    const unsigned G = gridDim.x * gridDim.y * gridDim.z;
    unsigned sum, cnt, mine, sp = 0u;
    for (;;) {
        sum = 0u; cnt = 0u; mine = 0u;
#pragma unroll
        for (unsigned j = 0; j < 16; ++j) { const unsigned c = xb_ld(&bar[XB_XCNT(j)]); sum += c; cnt += (c > 0u) ? 1u : 0u; mine = (j == x) ? c : mine; }
        if (sum == G) break;
        __builtin_amdgcn_s_sleep(1);
        if ((++sp & 255u) == 0u) { if (xb_ld(&bar[XB_TMO])) break; if (sp > XB_SPIN_CAP) { atomicAdd(&bar[XB_TMO], 1u); break; } }
    }
    nloc = mine > 0u ? mine : 1u; nx = cnt > 0u ? cnt : 1u;
}

__device__ __forceinline__ void xcd_barrier(const XcdBarrier& b) {
    asm volatile("s_waitcnt vmcnt(0)" ::: "memory");
    __syncthreads();
    unsigned long long bp_ = (unsigned long long)b.bar; unsigned bx_ = b.x; asm volatile("" : "+s"(bp_), "+s"(bx_)); bx_ = (unsigned)__builtin_amdgcn_readfirstlane((int)bx_); bp_ = ((unsigned long long)(unsigned)__builtin_amdgcn_readfirstlane((int)(bp_ >> 32)) << 32) | (unsigned)__builtin_amdgcn_readfirstlane((int)bp_);
    if (threadIdx.x == 0) {
        unsigned* bar = (unsigned*)bp_;
        __builtin_amdgcn_s_waitcnt(0);
        unsigned nloc = b.st[0], nx = b.st[1];
        if (nloc == 0u) { xcd_barrier_complete(bar, bx_, nloc, nx); b.st[0] = nloc; b.st[1] = nx; }
        const unsigned old = xb_add(&bar[XB_XSUB(bx_)], 1u);
        const unsigned gen = old / nloc;
        if (old + 1u == (gen + 1u) * nloc) {
            __builtin_amdgcn_fence(__ATOMIC_RELEASE, "agent");
            asm volatile("s_waitcnt vmcnt(0)" ::: "memory");
            const unsigned og = xb_add(&bar[XB_TOP], 1u);
            const unsigned tg = og / nx;
            if (og + 1u == (tg + 1u) * nx) xb_add(&bar[XB_TOPGEN], 1u);
            else XB_SPIN(xb_ld(&bar[XB_TOPGEN]) == tg, bar);
            __builtin_amdgcn_fence(__ATOMIC_ACQUIRE, "agent");
            xb_add(&bar[XB_XGEN(bx_)], 1u);
            asm volatile("s_waitcnt vmcnt(0)" ::: "memory");
        } else {
            XB_SPIN(xb_ld(&bar[XB_XGEN(bx_)]) == gen, bar);
            __builtin_amdgcn_fence(__ATOMIC_ACQUIRE, "agent");
            asm volatile("s_waitcnt vmcnt(0)" ::: "memory");
        }
    }
    __syncthreads();
}

namespace cfg {
constexpr int D = 1024, NB = 4, SEQ = 4096, CTXL = 256, TL = NB * SEQ, TC = NB * CTXL, T = TL + TC;
constexpr int NZ = 8960;
constexpr int ZU = 0, ZVA = 1024, ZQB = 2048, ZKB = 2560, ZVB = 3072, ZRB = 4096, ZCQ = 5120, ZKR = 5504, ZDEC = 5568, ZCKV = 5632, ZGT = 5888;
constexpr int NKEY = CTXL + SEQ;
constexpr int NEXP = 16, DEXP = 2048, CAPL = 512, CAPC = 32, ESLOTS = 2304;
constexpr float EPS = 1e-6f;
constexpr int NWAVES = 8, NTHR = 512;
constexpr size_t MiB = 1u << 20;
constexpr size_t WS_CTL = 0, CTL_BYTES = 1 * MiB;
constexpr size_t WS_MOD = 1 * MiB;
constexpr size_t WS_GATEV = WS_MOD + 512 * 1024;
constexpr size_t WS_AFFT = 2 * MiB;
constexpr size_t WS_SEL = 4 * MiB;
constexpr size_t WS_RSQ = 4 * MiB + 1536 * 1024;
constexpr size_t WS_XC = 6 * MiB;
constexpr size_t WS_H = 10 * MiB;
constexpr size_t WS_WT = 44 * MiB, WT_LAYER = 28 * MiB;
constexpr size_t WT_IN = 0, WT_UQ = 17 * MiB + 512 * 1024, WT_UKV = WT_UQ + 1152 * 1024, WT_M = WT_UKV + 1 * MiB, WT_OUT = WT_M + 6 * MiB, WT_S = WT_OUT + 2 * MiB;
static_assert(WT_S + 256 * 1024 <= WT_LAYER, "weights");
constexpr size_t WS_RA = 100 * MiB;
constexpr size_t RA_XS = 0, RA_HID = 72 * MiB, RA_YS = 216 * MiB;
constexpr size_t WS_RB = 398 * MiB;
constexpr size_t RB_YCAT = 0, RB_KVRAW = 102 * MiB, RB_MERGED = 102 * MiB, RB_QRAW = 170 * MiB, RB_KG = 221 * MiB, RB_VG = 272 * MiB, RB_QFL = 306 * MiB, RB_QFC = 354 * MiB,
                 RB_QDF = 357 * MiB, RB_KDT = 391 * MiB, RB_VTG = 425 * MiB, RB_DECAY = 459 * MiB, RB_OINTRA = 461 * MiB, RB_OF = 495 * MiB, RB_OB = 529 * MiB, RB_END = 563 * MiB;
constexpr size_t RB_WGU = 0, RB_WD = 128 * MiB, RB_YSC = 200 * MiB;
constexpr size_t WS_END = WS_RB + RB_END;
constexpr int LDS_BYTES = 147456;
constexpr int LDS_MISC = 145408;
}
using namespace cfg;

enum { I_X = 0, I_C, I_CTX, I_CCTX, I_WMOD, I_BMOD, I_GMIX, I_GFFN, I_WIN, I_BGATE, I_WS, I_BS, I_WDEC, I_BDEC, I_GGLA, I_GCQ, I_GCKV, I_WUQ, I_WUKV,
       I_GQN, I_GQR, I_GKN, I_GKR, I_WPA, I_WPB, I_WPC, I_WOUT, I_WROUTER, I_WEG, I_WEU, I_WED, N_INPUTS };

struct Args { const float* in[N_INPUTS]; float* out; unsigned char* ws; int ph_lo, ph_hi; };

struct Ctx {
    const float* const* in; float* out; unsigned char* ws; LAS unsigned char* lds;
    int tid, lane, wave, G, bid;
};
__device__ __forceinline__ int row_modidx(int row) { return row < TL ? (row >> 12) : 4; }
__device__ __forceinline__ const float* modp(const Ctx& c, int l, int bi, int which) { return (const float*)(c.ws + WS_MOD) + ((size_t)(l * 5 + bi) * 6 + which) * D; }
__device__ __forceinline__ const float* xin_row(const Ctx& c, int l, int row) {
    if (row < TL) return (l == 0 ? c.in[I_X] : (const float*)c.out) + (size_t)row * D;
    return (l == 0 ? c.in[I_CTX] : (const float*)(c.ws + WS_XC)) + (size_t)(row - TL) * D;
}
__device__ __forceinline__ float* xout_row(const Ctx& c, int row) {
    if (row < TL) return c.out + (size_t)row * D;
    return (float*)(c.ws + WS_XC) + (size_t)(row - TL) * D;
}

#if defined(DEBUG_STAT)
__device__ __forceinline__ void dbg_max(const Ctx& c, int slot, float v) { v = fabsf(v); if (!(v < 1e30f)) v = 1e30f; atomicMax((unsigned*)(c.ws + WS_CTL + 512 * 1024) + 16 * slot, __float_as_uint(v)); }
#else
__device__ __forceinline__ void dbg_max(const Ctx&, int, float) {}
#endif
__device__ __forceinline__ void tconv_tile(const Ctx& c, const float* src, int ld_src, int k0, int c0, int nvalid, const float* kscale, bf16_t* dst, int ld_dst, int r0, int kd0) {
    LAS float* scr = (LAS float*)c.lds;
    const int tid = c.tid;
#pragma unroll
    for (int p = 0; p < 8; ++p) { const int k = p * 8 + (tid >> 6), n = tid & 63;
        float v = (n < nvalid) ? src[(size_t)(k0 + k) * ld_src + c0 + n] : 0.f; if (kscale) v *= kscale[k0 + k];
        scr[n * 65 + k] = v; }
    __syncthreads();
    { const int n = tid >> 3, kc = (tid & 7) * 8; const LAS float* s = scr + n * 65 + kc;
      u32x4 o; o.x = cvt_pk_bf16(s[0], s[1]); o.y = cvt_pk_bf16(s[2], s[3]); o.z = cvt_pk_bf16(s[4], s[5]); o.w = cvt_pk_bf16(s[6], s[7]);
      *(u32x4*)(dst + (size_t)(r0 + n) * ld_dst + kd0 + kc) = o; }
    __syncthreads();
}
template <int KQ>
__device__ __forceinline__ void tconv_kq(const Ctx& c, const float* src, int ld_src, int k0, int c0, int nvalid, const float* kscale, bf16_t* dst, int ld_dst, int r0, int kd0) {
    constexpr int LD = 64 * KQ + 1;
    LAS float* scr = (LAS float*)c.lds;
    const int tid = c.tid, n = tid & 63, kr = tid >> 6; float v[KQ][8];
    const bool ok = n < nvalid;
    const float* s0 = src + (size_t)(k0 + kr) * ld_src + c0 + n;
#pragma unroll
    for (int q = 0; q < KQ; ++q)
#pragma unroll
        for (int p = 0; p < 8; ++p) v[q][p] = ok ? s0[(size_t)(q * 64 + p * 8) * ld_src] : 0.f;
    if (kscale) {
#pragma unroll
        for (int q = 0; q < KQ; ++q)
#pragma unroll
            for (int p = 0; p < 8; ++p) v[q][p] *= kscale[k0 + q * 64 + p * 8 + kr]; }
#pragma unroll
    for (int q = 0; q < KQ; ++q)
#pragma unroll
        for (int p = 0; p < 8; ++p) scr[n * LD + q * 64 + p * 8 + kr] = v[q][p];
    __syncthreads();
    { const int nn = tid >> 3, kc = (tid & 7) * 8;
#pragma unroll
      for (int q = 0; q < KQ; ++q) { const LAS float* s = scr + nn * LD + q * 64 + kc;
          u32x4 o; o.x = cvt_pk_bf16(s[0], s[1]); o.y = cvt_pk_bf16(s[2], s[3]); o.z = cvt_pk_bf16(s[4], s[5]); o.w = cvt_pk_bf16(s[6], s[7]);
          *(u32x4*)(dst + (size_t)(r0 + nn) * ld_dst + kd0 + q * 64 + kc) = o; } }
    __syncthreads();
}
template <class RowMap>
__device__ __forceinline__ void tconv_tile4(const Ctx& c, const float* src, int ld_src, int k0, int n0, bf16_t* dst, int ld_dst, int kd0, const RowMap& rowmap) {
    LAS float* scr = (LAS float*)c.lds;
    const int tid = c.tid; float v[4][8];
#pragma unroll
    for (int q = 0; q < 4; ++q)
#pragma unroll
        for (int p = 0; p < 8; ++p) { const int k = p * 8 + (tid >> 6), n = tid & 63; v[q][p] = src[(size_t)(k0 + k) * ld_src + n0 + q * 64 + n]; }
#pragma unroll
    for (int q = 0; q < 4; ++q)
#pragma unroll
        for (int p = 0; p < 8; ++p) { const int k = p * 8 + (tid >> 6), n = tid & 63; scr[(q * 64 + n) * 65 + k] = v[q][p]; }
    __syncthreads();
#pragma unroll
    for (int q = 0; q < 4; ++q) { const int n = tid >> 3, kc = (tid & 7) * 8; const LAS float* s = scr + (q * 64 + n) * 65 + kc;
      u32x4 o; o.x = cvt_pk_bf16(s[0], s[1]); o.y = cvt_pk_bf16(s[2], s[3]); o.z = cvt_pk_bf16(s[4], s[5]); o.w = cvt_pk_bf16(s[6], s[7]);
      *(u32x4*)(dst + (size_t)rowmap(n0 + q * 64 + n) * ld_dst + kd0 + kc) = o; }
    __syncthreads();
}
__device__ __forceinline__ void win_map(int r0, int& src, int& nvalid) {
    nvalid = 64;
    if (r0 < 5120) src = r0; else if (r0 < 5504) src = 5152 + (r0 - 5120); else if (r0 == 5504) src = 5792;
    else if (r0 == 5568) { src = 5120; nvalid = 32; } else if (r0 < 5888) src = 5536 + (r0 - 5632); else src = 5856 + (r0 - 5888);
}
__device__ __forceinline__ void phase_pre_a(const Ctx& c) {
    constexpr int U_IN = 140 * 4, U_UQ = 24 * 2, U_UKV = 32, U_M = 3 * 16 * 4, U_OUT = 16 * 4, U_S = 32, U_LAYER = U_IN + U_UQ + U_UKV + U_M + U_OUT + U_S, U_MOD = 192;
    for (int u = c.bid; u < 2 * U_LAYER + U_MOD; u += c.G) {
        if (u < U_MOD) {
            const int cb = u, l = cb / 96, n = (cb % 96) * 64 + c.lane;
            LAS float* sl = (LAS float*)c.lds;
            LAS float* red = (LAS float*)(c.lds + 20480);
            for (int i = c.tid; i < 5 * D; i += NTHR) { const int vi = i >> 10, k = i & (D - 1); sl[i] = siluf_(vi < 4 ? c.in[I_C][vi * D + k] : c.in[I_CCTX][k]); }
            __syncthreads();
            const float* wp = c.in[I_WMOD] + (size_t)l * D * 6144 + (size_t)(c.wave * 128) * 6144 + n; const LAS float* sw = sl + c.wave * 128;
            float a[5] = {0.f, 0.f, 0.f, 0.f, 0.f};
#pragma unroll 1
            for (int kk = 0; kk < 128; kk += 16) { float w[16];
#pragma unroll
                for (int j = 0; j < 16; ++j) w[j] = wp[(size_t)(kk + j) * 6144];
#pragma unroll
                for (int j = 0; j < 16; ++j)
#pragma unroll
                    for (int i = 0; i < 5; ++i) a[i] += sw[i * D + kk + j] * w[j]; }
#pragma unroll
            for (int i = 0; i < 5; ++i) red[(c.wave * 5 + i) * 64 + c.lane] = a[i];
            __syncthreads();
            if (c.tid < 320) { const int i = c.tid >> 6, ln = c.tid & 63; float s = 0.f;
#pragma unroll
                for (int w = 0; w < 8; ++w) s += red[(w * 5 + i) * 64 + ln];
                const int nn = (cb % 96) * 64 + ln;
                ((float*)(c.ws + WS_MOD))[(size_t)(l * 5 + i) * 6144 + nn] = s + c.in[I_BMOD][l * 6144 + nn]; }
            __syncthreads();
            continue;
        }
        const int v = u - U_MOD, l = v / U_LAYER; int r = v % U_LAYER; unsigned char* wt = c.ws + WS_WT + (size_t)l * WT_LAYER;
        if (r < U_IN) { const int nb = r >> 2, kq = r & 3; int src, nv; win_map(nb * 64, src, nv);
            tconv_kq<4>(c, c.in[I_WIN] + (size_t)l * D * 8928, 8928, kq * 256, src, nv, nullptr, (bf16_t*)(wt + WT_IN), D, nb * 64, kq * 256); continue; } r -= U_IN;
        if (r < U_UQ) { const int nb = r >> 1, kh = r & 1;
            tconv_kq<3>(c, c.in[I_WUQ] + (size_t)l * 384 * 1536, 1536, kh * 192, nb * 64, 64, c.in[I_GCQ] + l * 384, (bf16_t*)(wt + WT_UQ), 384, nb * 64, kh * 192); continue; } r -= U_UQ;
        if (r < U_UKV) { const int nb = r;
            tconv_kq<4>(c, c.in[I_WUKV] + (size_t)l * 256 * 2048, 2048, 0, nb * 64, 64, c.in[I_GCKV] + l * 256, (bf16_t*)(wt + WT_UKV), 256, nb * 64, 0); continue; } r -= U_UKV;
        if (r < U_M) { const int which = r >> 6, rr = r & 63, nb = rr >> 2, kq = rr & 3;
            const float* src = c.in[which == 0 ? I_WPA : (which == 1 ? I_WPB : I_WPC)] + (size_t)l * D * D;
            tconv_kq<4>(c, src, D, kq * 256, nb * 64, 64, nullptr, (bf16_t*)(wt + WT_M), 3 * D, nb * 64, which * D + kq * 256); continue; } r -= U_M;
        if (r < U_OUT) { const int nb = r >> 2, kq = r & 3;
            tconv_kq<4>(c, c.in[I_WOUT] + (size_t)l * D * D, D, kq * 256, nb * 64, 64, nullptr, (bf16_t*)(wt + WT_OUT), D, nb * 64, kq * 256); continue; } r -= U_OUT;
        { const float* s = c.in[I_WS] + (size_t)l * 131072 + (size_t)r * 4096 + c.tid * 8; bf16_t* d = (bf16_t*)(wt + WT_S) + (size_t)r * 4096 + c.tid * 8;
          const f32x4 a = *(const f32x4*)s, b = *(const f32x4*)(s + 4); u32x4 o; o.x = cvt_pk_bf16(a[0], a[1]); o.y = cvt_pk_bf16(a[2], a[3]); o.z = cvt_pk_bf16(b[0], b[1]); o.w = cvt_pk_bf16(b[2], b[3]);
          *(u32x4*)d = o; }
    }
}
__device__ __forceinline__ void modulate_row(const float* xrow, const float* g, const float* shift, const float* scale, bf16_t* hrow, int lane, f32x4 (&hv)[4]) {
    float ss = 0.f;
#pragma unroll
    for (int j = 0; j < 4; ++j) { hv[j] = *(const f32x4*)(xrow + 4 * lane + 256 * j); ss += (hv[j][0] * hv[j][0] + hv[j][1] * hv[j][1]) + (hv[j][2] * hv[j][2] + hv[j][3] * hv[j][3]); }
    const float rstd = 1.0f / sqrtf(wave_sum(ss) * (1.f / D) + EPS);
#pragma unroll
    for (int j = 0; j < 4; ++j) { const int cc = 4 * lane + 256 * j; const f32x4 gv = *(const f32x4*)(g + cc), sc = *(const f32x4*)(scale + cc), sh = *(const f32x4*)(shift + cc);
        hv[j] = hv[j] * rstd * gv * (sc + 1.0f) + sh;
        u32x2 o; o.x = cvt_pk_bf16(hv[j][0], hv[j][1]); o.y = cvt_pk_bf16(hv[j][2], hv[j][3]); *(u32x2*)(hrow + cc) = o; }
}
__device__ __forceinline__ void phase_modulate_mix(const Ctx& c, int l) {
    const int gw = c.bid * NWAVES + c.wave, NGW = c.G * NWAVES;
    for (int row = gw; row < T; row += NGW) { const int bi = row_modidx(row); f32x4 hv[4];
        modulate_row(xin_row(c, l, row), c.in[I_GMIX] + l * D, modp(c, l, bi, 0), modp(c, l, bi, 1), (bf16_t*)(c.ws + WS_H) + (size_t)row * D, c.lane, hv); }
}
struct EpiZ { static constexpr bool PERM = true, MID = false; bf16_t* Z; const float* bgate;
    __device__ __forceinline__ void operator()(const f32x4 (&acc)[2][2][4][2], const pg8::Unit& u, int wr, int wc, int fr, int fq) const {
        int row0 = u.pm * 256 + wr * 64 + fr; asm volatile("" : "+v"(row0)); const int col0 = u.pn * 256 + wc * 32 + 8 * fq;
        const int mode = (u.pn >= 23) ? 3 : ((u.pn >= 16 && u.pn < 20) ? 2 : ((u.pn == 8 || u.pn == 9) ? 1 : 0));
        const int gcol = (mode == 3) ? (col0 - ZGT) : 0; const float bm = (mode == 3) ? 1.f : 0.f;
        f32x4 bv[2][2];
#pragma unroll
        for (int bj = 0; bj < 2; ++bj)
#pragma unroll
            for (int n = 0; n < 2; ++n) bv[bj][n] = *(const f32x4*)(bgate + (gcol + bj * 128 + 4 * n)) * bm;
#pragma unroll
        for (int ai = 0; ai < 2; ++ai)
#pragma unroll
            for (int m = 0; m < 4; ++m) { bf16_t* rowp = Z + (size_t)(row0 + ai * 128 + m * 16) * NZ + col0;
#pragma unroll
                for (int bj = 0; bj < 2; ++bj) { f32x4 v0 = acc[ai][bj][m][0] + bv[bj][0], v1 = acc[ai][bj][m][1] + bv[bj][1];
                    if (mode == 1) { v0 = v0 * 0.08838834764831845f; v1 = v1 * 0.08838834764831845f; }
                    else if (mode == 2) {
#pragma unroll
                        for (int e = 0; e < 4; ++e) { v0[e] = siluf_(v0[e]); v1[e] = siluf_(v1[e]); } }
                    else if (mode == 3) {
#pragma unroll
                        for (int e = 0; e < 4; ++e) { v0[e] = fmaxf(sigmoidf_(v0[e]), 1e-20f); v1[e] = fmaxf(sigmoidf_(v1[e]), 1e-20f); } }
                    u32x4 w; w.x = cvt_pk_bf16(v0[0], v0[1]); w.y = cvt_pk_bf16(v0[2], v0[3]); w.z = cvt_pk_bf16(v1[0], v1[1]); w.w = cvt_pk_bf16(v1[2], v1[3]);
                    *(u32x4*)(rowp + bj * 128) = w; } }
    }
};
struct EpiPlain { static constexpr bool PERM = true, MID = false; bf16_t* O; int ldc;
    __device__ __forceinline__ void operator()(const f32x4 (&acc)[2][2][4][2], const pg8::Unit& u, int wr, int wc, int fr, int fq) const {
        int row0 = u.pm * 256 + wr * 64 + fr; asm volatile("" : "+v"(row0)); const int col0 = u.pn * 256 + wc * 32 + 8 * fq;
#pragma unroll
        for (int ai = 0; ai < 2; ++ai)
#pragma unroll
            for (int m = 0; m < 4; ++m) { bf16_t* rowp = O + (size_t)(row0 + ai * 128 + m * 16) * ldc + col0;
#pragma unroll
                for (int bj = 0; bj < 2; ++bj) { const f32x4 v0 = acc[ai][bj][m][0], v1 = acc[ai][bj][m][1];
                    u32x4 w; w.x = cvt_pk_bf16(v0[0], v0[1]); w.y = cvt_pk_bf16(v0[2], v0[3]); w.z = cvt_pk_bf16(v1[0], v1[1]); w.w = cvt_pk_bf16(v1[2], v1[3]);
                    *(u32x4*)(rowp + bj * 128) = w; } }
    }
};
struct EpiMerge { static constexpr bool PERM = true, MID = true; bf16_t* O; const bf16_t* Z;
    __device__ __forceinline__ void ld8(const bf16_t* p, float (&g)[8]) const { const u32x4 w = *(const u32x4*)p; g[0] = bflo(w.x); g[1] = bfhi(w.x); g[2] = bflo(w.y); g[3] = bfhi(w.y); g[4] = bflo(w.z); g[5] = bfhi(w.z); g[6] = bflo(w.w); g[7] = bfhi(w.w); }
    __device__ __forceinline__ void mid(f32x4 (&acc)[2][2][4][2], const pg8::Unit& u, int t, int wr, int wc, int fr, int fq) const {
        int row0 = u.pm * 256 + wr * 64 + fr; asm volatile("" : "+v"(row0)); const int col0 = u.pn * 256 + wc * 32 + 8 * fq; const int seg = (t == 16) ? 0 : 1;
#pragma unroll
        for (int ai = 0; ai < 2; ++ai)
#pragma unroll
            for (int m = 0; m < 4; ++m) { const bf16_t* gp = Z + (size_t)(row0 + ai * 128 + m * 16) * NZ + ZGT + seg * D + col0;
#pragma unroll
                for (int bj = 0; bj < 2; ++bj) { float ga[8], gb[8]; ld8(gp + bj * 128, ga); ld8(gp + D + bj * 128, gb);
#pragma unroll
                    for (int e = 0; e < 4; ++e) { acc[ai][bj][m][0][e] *= ga[e] * fast_rcp(gb[e]); acc[ai][bj][m][1][e] *= ga[4 + e] * fast_rcp(gb[4 + e]); } }
                __builtin_amdgcn_sched_barrier(0); }
    }
    __device__ __forceinline__ void operator()(const f32x4 (&acc)[2][2][4][2], const pg8::Unit& u, int wr, int wc, int fr, int fq) const {
        int row0 = u.pm * 256 + wr * 64 + fr; asm volatile("" : "+v"(row0)); const int col0 = u.pn * 256 + wc * 32 + 8 * fq;
#pragma unroll
        for (int ai = 0; ai < 2; ++ai)
#pragma unroll
            for (int m = 0; m < 4; ++m) { const size_t r = (size_t)(row0 + ai * 128 + m * 16); const bf16_t* gp = Z + r * NZ + ZGT + 2 * D + col0; bf16_t* rowp = O + r * D + col0;
#pragma unroll
                for (int bj = 0; bj < 2; ++bj) { float gc[8]; ld8(gp + bj * 128, gc); const f32x4 v0 = acc[ai][bj][m][0], v1 = acc[ai][bj][m][1];
                    u32x4 w; w.x = cvt_pk_bf16(v0[0] * gc[0], v0[1] * gc[1]); w.y = cvt_pk_bf16(v0[2] * gc[2], v0[3] * gc[3]); w.z = cvt_pk_bf16(v1[0] * gc[4], v1[1] * gc[5]); w.w = cvt_pk_bf16(v1[2] * gc[6], v1[3] * gc[7]);
                    *(u32x4*)(rowp + bj * 128) = w; }
                __builtin_amdgcn_sched_barrier(0); }
    }
};
struct EpiResid { static constexpr bool PERM = false, MID = false; const Ctx* c; int l; float* dummy;
    __device__ __forceinline__ void operator()(const f32x4 (&acc)[2][2][4][2], const pg8::Unit& u, int wr, int wc, int fr, int fq) const {
        int row0 = u.pm * 256 + wr * 64 + fr; asm volatile("" : "+v"(row0)); const int col0 = u.pn * 256 + wc * 32 + 4 * fq; const float* gate = modp(*c, l, row_modidx(u.pm * 256), 2);
        f32x4 gv[2][2];
#pragma unroll
        for (int bj = 0; bj < 2; ++bj)
#pragma unroll
            for (int n = 0; n < 2; ++n) gv[bj][n] = *(const f32x4*)(gate + col0 + bj * 128 + 16 * n);
#pragma unroll
        for (int ai = 0; ai < 2; ++ai)
#pragma unroll
            for (int m = 0; m < 4; ++m) { const int row = row0 + ai * 128 + m * 16; const float* xi = xin_row(*c, l, row) + col0; float* xo = (dummy ? dummy + (size_t)row * D : xout_row(*c, row)) + col0;
#pragma unroll
                for (int bj = 0; bj < 2; ++bj)
#pragma unroll
                    for (int n = 0; n < 2; ++n) { const f32x4 xv = *(const f32x4*)(xi + bj * 128 + 16 * n); *(f32x4*)(xo + bj * 128 + 16 * n) = xv + gv[bj][n] * acc[ai][bj][m][n]; } }
    }
};
struct EpiSwiGLU { static constexpr bool PERM = true, MID = false; bf16_t* HID;
    __device__ __forceinline__ void operator()(const f32x4 (&acc)[2][2][4][2], const pg8::Unit& u, int wr, int wc, int fr, int fq) const {
        int row0 = u.pm * 256 + wr * 64 + fr; asm volatile("" : "+v"(row0)); const int col0 = u.pn * 128 + wc * 32 + 8 * fq; bf16_t* base = HID + (size_t)u.g * ESLOTS * DEXP;
#pragma unroll
        for (int ai = 0; ai < 2; ++ai)
#pragma unroll
            for (int m = 0; m < 4; ++m) { float h[8];
#pragma unroll
                for (int n = 0; n < 2; ++n)
#pragma unroll
                    for (int e = 0; e < 4; ++e) h[4 * n + e] = siluf_(acc[ai][0][m][n][e]) * acc[ai][1][m][n][e];
                u32x4 w; w.x = cvt_pk_bf16(h[0], h[1]); w.y = cvt_pk_bf16(h[2], h[3]); w.z = cvt_pk_bf16(h[4], h[5]); w.w = cvt_pk_bf16(h[6], h[7]);
                *(u32x4*)(base + (size_t)(row0 + ai * 128 + m * 16) * DEXP + col0) = w; }
    }
};
struct EpiDown { static constexpr bool PERM = true, MID = false; bf16_t* YS; const float* gatev;
    __device__ __forceinline__ void operator()(const f32x4 (&acc)[2][2][4][2], const pg8::Unit& u, int wr, int wc, int fr, int fq) const {
        int row0 = u.pm * 256 + wr * 64 + fr; asm volatile("" : "+v"(row0)); const int col0 = u.pn * 256 + wc * 32 + 8 * fq; bf16_t* base = YS + (size_t)u.g * ESLOTS * D; const float* gp = gatev + u.g * ESLOTS;
#pragma unroll
        for (int ai = 0; ai < 2; ++ai)
#pragma unroll
            for (int m = 0; m < 4; ++m) { const int row = row0 + ai * 128 + m * 16; const float gs = gp[row]; bf16_t* rowp = base + (size_t)row * D + col0;
#pragma unroll
                for (int bj = 0; bj < 2; ++bj) { const f32x4 v0 = acc[ai][bj][m][0] * gs, v1 = acc[ai][bj][m][1] * gs;
                    u32x4 w; w.x = cvt_pk_bf16(v0[0], v0[1]); w.y = cvt_pk_bf16(v0[2], v0[3]); w.z = cvt_pk_bf16(v1[0], v1[1]); w.w = cvt_pk_bf16(v1[2], v1[3]);
                    *(u32x4*)(rowp + bj * 128) = w; } }
    }
};

struct EpiDownPart { static constexpr bool PERM = true, MID = false; bf16_t* YSC; const float* gatev;
    __device__ __forceinline__ void operator()(const f32x4 (&acc)[2][2][4][2], const pg8::Unit& u, int wr, int wc, int fr, int fq) const {
        int r0 = wr * 64 + fr; asm volatile("" : "+v"(r0)); const int col0 = u.pn * 256 + wc * 32 + 8 * fq;
        bf16_t* base = YSC + ((size_t)((u.ko >> 9) * NEXP + u.g) * 128) * D; const float* gp = gatev + u.g * ESLOTS + 2048;
#pragma unroll
        for (int m = 0; m < 4; ++m) { const int r = r0 + m * 16; const float gs = gp[r]; bf16_t* rowp = base + (size_t)r * D + col0;
#pragma unroll
            for (int bj = 0; bj < 2; ++bj) { const f32x4 v0 = acc[0][bj][m][0] * gs, v1 = acc[0][bj][m][1] * gs;
                u32x4 w; w.x = cvt_pk_bf16(v0[0], v0[1]); w.y = cvt_pk_bf16(v0[2], v0[3]); w.z = cvt_pk_bf16(v1[0], v1[1]); w.w = cvt_pk_bf16(v1[2], v1[3]);
                *(u32x4*)(rowp + bj * 128) = w; } }
    }
};

__device__ __forceinline__ void sg_accum(const bf16_t* A, int lda, const bf16_t* Bt, int ldb, int K, int lane, f32x4 (&acc)[2]) {
    const int lr = lane & 15, lq = lane >> 4; const bf16_t* ap = A + (size_t)lr * lda + 8 * lq; const bf16_t* bp0 = Bt + (size_t)lr * ldb + 8 * lq; const bf16_t* bp1 = bp0 + (size_t)16 * ldb;
    bf16x8 a[2][4], b0[2][4], b1[2][4];
#pragma unroll
    for (int i = 0; i < 4; ++i) { a[0][i] = *(const bf16x8*)(ap + 32 * i); b0[0][i] = *(const bf16x8*)(bp0 + 32 * i); b1[0][i] = *(const bf16x8*)(bp1 + 32 * i); }
#pragma unroll 1
    for (int k = 0; k < K; k += 256) {
#pragma unroll
        for (int i = 0; i < 4; ++i) { a[1][i] = *(const bf16x8*)(ap + k + 128 + 32 * i); b0[1][i] = *(const bf16x8*)(bp0 + k + 128 + 32 * i); b1[1][i] = *(const bf16x8*)(bp1 + k + 128 + 32 * i); }
#pragma unroll
        for (int i = 0; i < 4; ++i) { acc[0] = __builtin_amdgcn_mfma_f32_16x16x32_bf16(a[0][i], b0[0][i], acc[0], 0, 0, 0); acc[1] = __builtin_amdgcn_mfma_f32_16x16x32_bf16(a[0][i], b1[0][i], acc[1], 0, 0, 0); }
        if (k + 256 < K) {
#pragma unroll
            for (int i = 0; i < 4; ++i) { a[0][i] = *(const bf16x8*)(ap + k + 256 + 32 * i); b0[0][i] = *(const bf16x8*)(bp0 + k + 256 + 32 * i); b1[0][i] = *(const bf16x8*)(bp1 + k + 256 + 32 * i); } }
#pragma unroll
        for (int i = 0; i < 4; ++i) { acc[0] = __builtin_amdgcn_mfma_f32_16x16x32_bf16(a[1][i], b0[1][i], acc[0], 0, 0, 0); acc[1] = __builtin_amdgcn_mfma_f32_16x16x32_bf16(a[1][i], b1[1][i], acc[1], 0, 0, 0); }
    }
}
__device__ __forceinline__ void ctx_merge_unit(const Ctx& c, int l, int u) {
    const int lane = c.lane, w = c.wave, lr = lane & 15, lq = lane >> 4, tid = c.tid; const int row0 = TL + 64 * (u >> 4), col0 = 64 * (u & 15); const int rh = w & 1, kw = w >> 1;
    const char* yb = (const char*)(c.ws + WS_RB + RB_YCAT) + ((size_t)(row0 + 32 * rh) * 3072 + 256 * kw) * 2;
    const char* wb = (const char*)(c.ws + WS_WT + (size_t)l * WT_LAYER + WT_M) + ((size_t)col0 * 3072 + 256 * kw) * 2;
    const __amdgpu_buffer_rsrc_t ra = __builtin_amdgcn_make_buffer_rsrc((void*)yb, 0, 1 << 30, 0x00020000), rb = __builtin_amdgcn_make_buffer_rsrc((void*)wb, 0, 1 << 30, 0x00020000);
    const int voff = (lr * 3072 + 8 * lq) * 2;
    LAS float* part = (LAS float*)c.lds;
    const int T = tid >> 5, lp = 2 * (tid & 31), RT = T >> 2, CT = T & 3; const int orow = row0 + 16 * RT + 4 * (lp >> 4), ocol = col0 + 16 * CT + (lp & 15);
    const bf16_t* Zg = (const bf16_t*)(c.ws + WS_RA) + ZGT + (size_t)orow * NZ + ocol;
    float out[8] = {0.f, 0.f, 0.f, 0.f, 0.f, 0.f, 0.f, 0.f};
    bf16x8 a[2][2][2], b[2][2][4];
#define CM_LOAD(slot, P) do { const int o_ = ((P) >> 2) * (D * 2) + ((P) & 3) * 128; \
        _Pragma("unroll") for (int t_ = 0; t_ < 2; ++t_) _Pragma("unroll") for (int h_ = 0; h_ < 2; ++h_) a[slot][h_][t_] = __builtin_bit_cast(bf16x8, __builtin_amdgcn_raw_buffer_load_b128(ra, voff, t_ * (16 * 3072 * 2) + o_ + h_ * 64, 0)); \
        _Pragma("unroll") for (int t_ = 0; t_ < 4; ++t_) _Pragma("unroll") for (int h_ = 0; h_ < 2; ++h_) b[slot][h_][t_] = __builtin_bit_cast(bf16x8, __builtin_amdgcn_raw_buffer_load_b128(rb, voff, t_ * (16 * 3072 * 2) + o_ + h_ * 64, 0)); } while (0)
#define CM_MMA(slot) do { _Pragma("unroll") for (int h_ = 0; h_ < 2; ++h_) _Pragma("unroll") for (int rt_ = 0; rt_ < 2; ++rt_) _Pragma("unroll") for (int ct_ = 0; ct_ < 4; ++ct_) \
        acc[rt_][ct_] = __builtin_amdgcn_mfma_f32_16x16x32_bf16(a[slot][h_][rt_], b[slot][h_][ct_], acc[rt_][ct_], 0, 0, 0); } while (0)
    CM_LOAD(0, 0); __builtin_amdgcn_sched_barrier(0);
#pragma unroll 1
    for (int seg = 0; seg < 3; ++seg) { f32x4 acc[2][4];
#pragma unroll
        for (int rt = 0; rt < 2; ++rt)
#pragma unroll
            for (int ct = 0; ct < 4; ++ct) acc[rt][ct] = (f32x4){0.f, 0.f, 0.f, 0.f};
#pragma unroll
        for (int jp = 0; jp < 4; ++jp) { const int P = seg * 4 + jp; __builtin_amdgcn_sched_barrier(0); if (P + 1 < 12) CM_LOAD((jp + 1) & 1, P + 1); __builtin_amdgcn_sched_barrier(0); CM_MMA(jp & 1); __builtin_amdgcn_sched_barrier(0); }
        unsigned gz[4];
#pragma unroll
        for (int e = 0; e < 4; ++e) gz[e] = *(const unsigned*)(Zg + (size_t)e * NZ + seg * D);
        { LAS float* wp = part + (size_t)(w * 8 * 64 + lane) * 4;
#pragma unroll
          for (int rt = 0; rt < 2; ++rt)
#pragma unroll
            for (int ct = 0; ct < 4; ++ct) *(LAS f32x4*)(wp + (rt * 4 + ct) * 256) = acc[rt][ct]; }
        __syncthreads();
        float s[8] = {0.f, 0.f, 0.f, 0.f, 0.f, 0.f, 0.f, 0.f};
        { const LAS float* pl = part + (size_t)((((RT >> 1) * 8 + (RT & 1) * 4 + CT) * 64) + lp) * 4;
#pragma unroll
          for (int p = 0; p < 4; ++p) { const f32x4 v0 = *(const LAS f32x4*)(pl + p * 4096), v1 = *(const LAS f32x4*)(pl + p * 4096 + 4);
#pragma unroll
              for (int e = 0; e < 4; ++e) { s[e] += v0[e]; s[4 + e] += v1[e]; } } }
#pragma unroll
        for (int e = 0; e < 4; ++e) { out[e] += s[e] * bflo(gz[e]); out[4 + e] += s[4 + e] * bfhi(gz[e]); }
        __syncthreads();
    }
#undef CM_LOAD
#undef CM_MMA
    bf16_t* O = (bf16_t*)(c.ws + WS_RB + RB_MERGED) + (size_t)orow * D + ocol;
#pragma unroll
    for (int e = 0; e < 4; ++e) *(unsigned*)(O + (size_t)e * D) = cvt_pk_bf16(out[e], out[4 + e]);
}
__device__ __forceinline__ void ctx_out_unit(const Ctx& c, int l, int u) {
    const int lane = c.lane, w = c.wave, lr = lane & 15, lq = lane >> 4; const int row0 = TL + 64 * (u >> 4) + 16 * (w >> 1), col0 = 64 * (u & 15) + 32 * (w & 1);
    const bf16_t* A = (const bf16_t*)(c.ws + WS_RB + RB_MERGED) + (size_t)row0 * D; const bf16_t* WO = (const bf16_t*)(c.ws + WS_WT + (size_t)l * WT_LAYER + WT_OUT) + (size_t)col0 * D;
    f32x4 acc[2] = {{0.f, 0.f, 0.f, 0.f}, {0.f, 0.f, 0.f, 0.f}};
    sg_accum(A, D, WO, D, D, lane, acc);
    const float* gate = modp(c, l, 4, 2);
#pragma unroll
    for (int t = 0; t < 2; ++t)
#pragma unroll
        for (int e = 0; e < 4; ++e) { const int row = row0 + 4 * lq + e, col = col0 + 16 * t + lr; xout_row(c, row)[col] = xin_row(c, l, row)[col] + gate[col] * acc[t][e]; }
}
__device__ __forceinline__ void mixA_unit(const Ctx& c, int l, int un) {
    const int cn = un >> 3, g = un & 7; const int row0 = cn * 128;
    const bf16_t* Z = (const bf16_t*)(c.ws + WS_RA); bf16_t* Y = (bf16_t*)(c.ws + WS_RB + RB_YCAT);
    const bf16_t* WSb = (const bf16_t*)(c.ws + WS_WT + (size_t)l * WT_LAYER + WT_S) + g * 16384;
    LAS bf16_t* VT = (LAS bf16_t*)c.lds;
    { const int s = c.tid >> 2, qd = c.tid & 3; const bf16_t* p = Z + (size_t)(row0 + s) * NZ + ZVA + g * 128 + qd * 32;
      float v[32];
#pragma unroll
      for (int i = 0; i < 4; ++i) { const u32x4 w = *(const u32x4*)(p + 8 * i); v[8 * i] = bflo(w.x); v[8 * i + 1] = bfhi(w.x); v[8 * i + 2] = bflo(w.y); v[8 * i + 3] = bfhi(w.y); v[8 * i + 4] = bflo(w.z); v[8 * i + 5] = bfhi(w.z); v[8 * i + 6] = bflo(w.w); v[8 * i + 7] = bfhi(w.w); }
      float sm = 0.f;
#pragma unroll
      for (int i = 0; i < 32; ++i) sm += v[i];
      sm += sx<1>(sm); sm += sx<2>(sm); const float mu = sm * (1.f / 128.f); float sq = 0.f;
#pragma unroll
      for (int i = 0; i < 32; ++i) { v[i] -= mu; sq += v[i] * v[i]; }
      sq += sx<1>(sq); sq += sx<2>(sq); const float rstd = 1.0f / sqrtf(sq * (1.f / 128.f) + EPS);
#pragma unroll
      for (int i = 0; i < 32; ++i) VT[(qd * 32 + i) * 136 + s] = f2bf(v[i] * rstd); }
    __syncthreads();
    const int w = c.wave, lr = c.lane & 15, lq = c.lane >> 4;
    bf16x8 bw[4];
#pragma unroll
    for (int ks = 0; ks < 4; ++ks) bw[ks] = *(const bf16x8*)(WSb + (16 * w + lr) * 128 + 32 * ks + 8 * lq);
    const int t = row0 + 16 * w + lr; const float bs = c.in[I_BS][(l * 8 + g) * 128 + 16 * w + lr];
#pragma unroll
    for (int ct = 0; ct < 8; ++ct) { f32x4 acc = {0.f, 0.f, 0.f, 0.f};
#pragma unroll
        for (int ks = 0; ks < 4; ++ks) { const bf16x8 a = *(const LAS bf16x8*)(VT + (16 * ct + lr) * 136 + 32 * ks + 8 * lq); acc = __builtin_amdgcn_mfma_f32_16x16x32_bf16(a, bw[ks], acc, 0, 0, 0); }
        const int cc = g * 128 + 16 * ct + 4 * lq; const u32x2 uw = *(const u32x2*)(Z + (size_t)t * NZ + ZU + cc);
        u32x2 o; o.x = cvt_pk_bf16(bflo(uw.x) * (acc[0] + bs), bfhi(uw.x) * (acc[1] + bs)); o.y = cvt_pk_bf16(bflo(uw.y) * (acc[2] + bs), bfhi(uw.y) * (acc[3] + bs));
        *(u32x2*)(Y + (size_t)t * 3072 + cc) = o; }
    __syncthreads();
}
__device__ __forceinline__ void gla_b1_unit(const Ctx& c, int l, int un) {
    const int n = un >> 2, h = un & 3, row0 = n * 64, tid = c.tid, lane = c.lane, w = c.wave, lr = lane & 15, lq = lane >> 4;
    const bf16_t* Z = (const bf16_t*)(c.ws + WS_RA);
    LAS bf16_t* VTs = (LAS bf16_t*)c.lds;
    LAS float* Ds = (LAS float*)(c.lds + 36864);
    LAS float* La = (LAS float*)(c.lds + 45056);
    LAS float* Tot = (LAS float*)(c.lds + 78080);
    LAS bf16_t* QD = (LAS bf16_t*)(c.lds + 80128);
    LAS bf16_t* KI = (LAS bf16_t*)(c.lds + 97536);
    LAS bf16_t* Ps = (LAS bf16_t*)(c.lds + 114944);
    LAS bf16_t* KdT = (LAS bf16_t*)(c.lds + 124160);
    { const int t = tid >> 3, cb = (tid & 7) * 32; const bf16_t* p = Z + (size_t)(row0 + t) * NZ + ZVB + h * 256 + cb;
#pragma unroll
      for (int i = 0; i < 4; ++i) { const u32x4 wv = *(const u32x4*)(p + 8 * i); LAS bf16_t* d = VTs + (cb + 8 * i) * 72 + t;
        d[0] = (bf16_t)wv.x; d[72] = (bf16_t)(wv.x >> 16); d[144] = (bf16_t)wv.y; d[216] = (bf16_t)(wv.y >> 16); d[288] = (bf16_t)wv.z; d[360] = (bf16_t)(wv.z >> 16); d[432] = (bf16_t)wv.w; d[504] = (bf16_t)(wv.w >> 16); }
      const int dt = tid >> 3, dc = (tid & 7) * 4; const u32x2 dv = *(const u32x2*)(Z + (size_t)(row0 + dt) * NZ + ZDEC + dc);
      Ds[dt * 32 + dc] = bflo(dv.x); Ds[dt * 32 + dc + 1] = bfhi(dv.x); Ds[dt * 32 + dc + 2] = bflo(dv.y); Ds[dt * 32 + dc + 3] = bfhi(dv.y); }
    __syncthreads();
    f32x4 pacc[2] = {{0.f, 0.f, 0.f, 0.f}, {0.f, 0.f, 0.f, 0.f}};
#pragma unroll 1
    for (int dir = 0; dir < 2; ++dir) {
        { const int cch = 16 * w + lr;
          bf16x8 bfr = {0, 0, 0, 0, 0, 0, 0, 0};
          if (lq < 2) { const float* wd = c.in[I_WDEC] + (size_t)(l * 2 + dir) * 16 * 512 + (size_t)(8 * lq) * 512 + h * 128 + cch; u32x4 pk;
              pk.x = cvt_pk_bf16(wd[0], wd[512]); pk.y = cvt_pk_bf16(wd[1024], wd[1536]); pk.z = cvt_pk_bf16(wd[2048], wd[2560]); pk.w = cvt_pk_bf16(wd[3072], wd[3584]); bfr = __builtin_bit_cast(bf16x8, pk); }
          const float bias = c.in[I_BDEC][(l * 2 + dir) * 512 + h * 128 + cch];
          f32x4 la[4];
#pragma unroll
          for (int tt = 0; tt < 4; ++tt) { bf16x8 afr = {0, 0, 0, 0, 0, 0, 0, 0};
              if (lq < 2) afr = *(const bf16x8*)(Z + (size_t)(row0 + 16 * tt + lr) * NZ + ZDEC + dir * 16 + 8 * lq);
              la[tt] = __builtin_amdgcn_mfma_f32_16x16x32_bf16(afr, bfr, (f32x4){0.f, 0.f, 0.f, 0.f}, 0, 0, 0); }
#pragma unroll
          for (int tt = 0; tt < 4; ++tt)
#pragma unroll
              for (int e = 0; e < 4; ++e) { const float pre = la[tt][e] + bias; la[tt][e] = (fminf(pre, 0.f) - __logf(1.f + __expf(-fabsf(pre)))) * 0.0625f; }
          float carry = 0.f;
          if (dir == 0) {
#pragma unroll
              for (int tt = 0; tt < 4; ++tt) { la[tt][1] += la[tt][0]; la[tt][2] += la[tt][1]; la[tt][3] += la[tt][2];
                  const float tot = la[tt][3]; float pre = 0.f; const float s16 = bperm(tot, lane - 16), s32 = bperm(tot, lane - 32), s48 = bperm(tot, lane - 48);
                  if (lq >= 1) pre += s16; if (lq >= 2) pre += s32; if (lq >= 3) pre += s48;
                  const float add = carry + pre;
#pragma unroll
                  for (int e = 0; e < 4; ++e) la[tt][e] += add;
                  carry = bperm(la[tt][3], 48 + lr); }
          } else {
#pragma unroll
              for (int tt = 3; tt >= 0; --tt) { la[tt][2] += la[tt][3]; la[tt][1] += la[tt][2]; la[tt][0] += la[tt][1];
                  const float tot = la[tt][0]; float pre = 0.f; const float s16 = bperm(tot, lane + 16), s32 = bperm(tot, lane + 32), s48 = bperm(tot, lane + 48);
                  if (lq <= 2) pre += s16; if (lq <= 1) pre += s32; if (lq <= 0) pre += s48;
                  const float add = carry + pre;
#pragma unroll
                  for (int e = 0; e < 4; ++e) la[tt][e] += add;
                  carry = bperm(la[tt][0], lr); }
          }
#pragma unroll
          for (int tt = 0; tt < 4; ++tt)
#pragma unroll
              for (int e = 0; e < 4; ++e) La[(16 * tt + 4 * lq + e) * 129 + cch] = la[tt][e]; }
        __syncthreads();
        { const int t = tid >> 3, cb = (tid & 7) * 16; const bf16_t* qp = Z + (size_t)(row0 + t) * NZ + ZQB + h * 128 + cb; const bf16_t* kp = Z + (size_t)(row0 + t) * NZ + ZKB + h * 128 + cb;
          float q[16], k[16];
#pragma unroll
          for (int i = 0; i < 2; ++i) { const u32x4 a = *(const u32x4*)(qp + 8 * i), b = *(const u32x4*)(kp + 8 * i);
              q[8 * i] = bflo(a.x); q[8 * i + 1] = bfhi(a.x); q[8 * i + 2] = bflo(a.y); q[8 * i + 3] = bfhi(a.y); q[8 * i + 4] = bflo(a.z); q[8 * i + 5] = bfhi(a.z); q[8 * i + 6] = bflo(a.w); q[8 * i + 7] = bfhi(a.w);
              k[8 * i] = bflo(b.x); k[8 * i + 1] = bfhi(b.x); k[8 * i + 2] = bflo(b.y); k[8 * i + 3] = bfhi(b.y); k[8 * i + 4] = bflo(b.z); k[8 * i + 5] = bfhi(b.z); k[8 * i + 6] = bflo(b.w); k[8 * i + 7] = bfhi(b.w); }
          const int tl = (dir == 0) ? 63 : 0; float qd[16], ki[16];
#pragma unroll
          for (int i = 0; i < 16; ++i) { const float b = La[t * 129 + cb + i], bl = La[tl * 129 + cb + i]; const float e = __expf(b);
              qd[i] = q[i] * e; ki[i] = k[i] * fast_rcp(e); KdT[(cb + i) * 72 + t] = f2bf(k[i] * __expf(bl - b)); }
          u32x4 o0, o1;
          o0.x = cvt_pk_bf16(qd[0], qd[1]); o0.y = cvt_pk_bf16(qd[2], qd[3]); o0.z = cvt_pk_bf16(qd[4], qd[5]); o0.w = cvt_pk_bf16(qd[6], qd[7]);
          o1.x = cvt_pk_bf16(qd[8], qd[9]); o1.y = cvt_pk_bf16(qd[10], qd[11]); o1.z = cvt_pk_bf16(qd[12], qd[13]); o1.w = cvt_pk_bf16(qd[14], qd[15]);
          *(LAS u32x4*)(QD + t * 136 + cb) = o0; *(LAS u32x4*)(QD + t * 136 + cb + 8) = o1;
          bf16_t* qg = (bf16_t*)(c.ws + WS_RB + RB_QDF) + (size_t)(dir * 1088 + un) * 8192 + (size_t)((((t >> 5) * 4 + (cb >> 5)) * 2 + ((cb >> 4) & 1)) * 512 + (t & 31) * 8);
          u32x4 p0, p1; p0.x = o0.x; p0.y = o0.y; p0.z = o1.x; p0.w = o1.y; p1.x = o0.z; p1.y = o0.w; p1.z = o1.z; p1.w = o1.w;
          *(u32x4*)qg = p0; *(u32x4*)(qg + 256) = p1;
          o0.x = cvt_pk_bf16(ki[0], ki[1]); o0.y = cvt_pk_bf16(ki[2], ki[3]); o0.z = cvt_pk_bf16(ki[4], ki[5]); o0.w = cvt_pk_bf16(ki[6], ki[7]);
          o1.x = cvt_pk_bf16(ki[8], ki[9]); o1.y = cvt_pk_bf16(ki[10], ki[11]); o1.z = cvt_pk_bf16(ki[12], ki[13]); o1.w = cvt_pk_bf16(ki[14], ki[15]);
          *(LAS u32x4*)(KI + t * 136 + cb) = o0; *(LAS u32x4*)(KI + t * 136 + cb + 8) = o1;
          if (tid < 128) ((float*)(c.ws + WS_RB + RB_DECAY))[(size_t)(dir * 1088 + un) * 128 + tid] = __expf(La[tl * 129 + tid]); }
        __syncthreads();
        { bf16_t* kg = (bf16_t*)(c.ws + WS_RB + RB_KDT) + (size_t)(dir * 1088 + un) * 8192;
#pragma unroll
          for (int i = 0; i < 2; ++i) { const int id = tid + 512 * i, ch = id >> 3, tc = id & 7;
              *(u32x4*)(kg + (((ch >> 5) * 4 + (tc >> 1)) * 64 + (tc & 1) * 32 + (ch & 31)) * 8) = *(const LAS u32x4*)(KdT + ch * 72 + tc * 8); } }
        { const int it = w >> 1; bf16x8 a[4];
#pragma unroll
          for (int ks = 0; ks < 4; ++ks) a[ks] = *(const LAS bf16x8*)(QD + (16 * it + lr) * 136 + 32 * ks + 8 * lq);
#pragma unroll
          for (int jj = 0; jj < 2; ++jj) { const int jt = 2 * (w & 1) + jj; f32x4 s = {0.f, 0.f, 0.f, 0.f};
#pragma unroll
              for (int ks = 0; ks < 4; ++ks) { const bf16x8 b = *(const LAS bf16x8*)(KI + (16 * jt + lr) * 136 + 32 * ks + 8 * lq); s = __builtin_amdgcn_mfma_f32_16x16x32_bf16(a[ks], b, s, 0, 0, 0); }
              const int j = 16 * jt + lr;
#pragma unroll
              for (int e = 0; e < 4; ++e) { const int i = 16 * it + 4 * lq + e; const bool keep = (dir == 0) ? (j <= i) : (j >= i); pacc[jj][e] += keep ? s[e] : 0.f; } } }
        __syncthreads();
    }
    { const int it = w >> 1;
#pragma unroll
      for (int jj = 0; jj < 2; ++jj) { const int j = 16 * (2 * (w & 1) + jj) + lr;
#pragma unroll
          for (int e = 0; e < 4; ++e) { Ps[(16 * it + 4 * lq + e) * 72 + j] = f2bf(pacc[jj][e]); } } }
    __syncthreads();
    { bf16_t* OI = (bf16_t*)(c.ws + WS_RB + RB_OINTRA);
#pragma unroll
      for (int dd = 0; dd < 2; ++dd) { const int dt = 2 * w + dd; bf16x8 a[2];
#pragma unroll
          for (int ks = 0; ks < 2; ++ks) a[ks] = *(const LAS bf16x8*)(VTs + (16 * dt + lr) * 72 + 32 * ks + 8 * lq);
#pragma unroll
          for (int it = 0; it < 4; ++it) { f32x4 o = {0.f, 0.f, 0.f, 0.f};
#pragma unroll
              for (int ks = 0; ks < 2; ++ks) { const bf16x8 b = *(const LAS bf16x8*)(Ps + (16 * it + lr) * 72 + 32 * ks + 8 * lq); o = __builtin_amdgcn_mfma_f32_16x16x32_bf16(a[ks], b, o, 0, 0, 0); }

              u32x2 ov; ov.x = cvt_pk_bf16(o[0], o[1]); ov.y = cvt_pk_bf16(o[2], o[3]);
              *(u32x2*)(OI + (size_t)(row0 + 16 * it + lr) * D + h * 256 + 16 * dt + 4 * lq) = ov; } } }
    { bf16_t* vg = (bf16_t*)(c.ws + WS_RB + RB_VTG) + (size_t)un * 16384;
#pragma unroll
      for (int i = 0; i < 4; ++i) { const int id = tid + 512 * i, dv = id >> 3, tc = id & 7;
          *(u32x4*)(vg + ((((dv >> 5) * 4 + (tc >> 1)) * 64) + (tc & 1) * 32 + (dv & 31)) * 8) = *(const LAS u32x4*)(VTs + dv * 72 + tc * 8); } }
    __syncthreads();
}
template <int N> __device__ __forceinline__ void vm_wait() { asm volatile("s_waitcnt vmcnt(%0)" :: "n"(N) : "memory"); }
__device__ __forceinline__ void gla_b2_unit(const Ctx& c, int un3) {
    const int lane = c.lane, lr = lane & 31, hi = lane >> 5, w = c.wave & 3, half = un3 & 1, un2 = un3 >> 1, dvs = half * 4 + w;
    const int h = un2 & 3, b = (un2 >> 2) & 3, dir = un2 >> 4;
    volatile LAS unsigned* cntF = (volatile LAS unsigned*)(c.lds + 3 * 33280 + 4 * 5120);
    volatile LAS unsigned* cntD = (volatile LAS unsigned*)(c.lds + 3 * 33280 + 4 * 5120 + 64);
    const char* QDF = (const char*)(c.ws + WS_RB + RB_QDF) + (size_t)dir * 1088 * 16384;
    const char* KDT = (const char*)(c.ws + WS_RB + RB_KDT) + (size_t)dir * 1088 * 16384;
    const char* VTG = (const char*)(c.ws + WS_RB + RB_VTG) + (size_t)dvs * 4096;
    const char* DEC = (const char*)(c.ws + WS_RB + RB_DECAY) + (size_t)dir * 1088 * 512;
    bf16_t* OUT = (bf16_t*)(c.ws + WS_RB + (dir == 0 ? RB_OF : RB_OB)) + (size_t)(((b * 4 + h) * 8 + dvs) * NKEY) * 32;
    constexpr int STG = 33280;
    LAS unsigned char* OT = c.lds + 3 * STG + w * 5120;
    const unsigned loff = (unsigned)lane * 16u;
#define B2_CHUNK(step) ((step) < 4 ? 256 + 4 * b + (dir == 0 ? (step) : 3 - (step)) : 64 * b + (dir == 0 ? (step) - 4 : 67 - (step)))
#define B2_ISSUE(step) do { const int un_ = B2_CHUNK(step) * 4 + h; LAS unsigned char* lb_ = c.lds + ((step) % 3) * STG; \
        const char* q_ = QDF + (size_t)un_ * 16384 + loff + w * 4096; const char* k_ = KDT + (size_t)un_ * 16384 + loff + w * 4096; \
        _Pragma("unroll") for (int i_ = 0; i_ < 4; ++i_) __builtin_amdgcn_global_load_lds((const unsigned*)(q_ + i_ * 1024), (LAS unsigned*)(lb_ + w * 4096 + i_ * 1024), 16, 0, 0); \
        _Pragma("unroll") for (int i_ = 0; i_ < 4; ++i_) __builtin_amdgcn_global_load_lds((const unsigned*)(k_ + i_ * 1024), (LAS unsigned*)(lb_ + 16384 + w * 4096 + i_ * 1024), 16, 0, 0); \
        if (lane < 8) __builtin_amdgcn_global_load_lds((const unsigned*)(DEC + (size_t)un_ * 512 + w * 128 + loff), (LAS unsigned*)(lb_ + 32768 + w * 128), 16, 0, 0); } while (0)
#define B2_SPIN(cnt, target) do { while (*(cnt) < (unsigned)(target)) __builtin_amdgcn_s_sleep(1); asm volatile("" ::: "memory"); } while (0)
#define B2_ARRIVE(cnt) do { if (lane == 0) { const unsigned one_ = 1u; asm volatile("ds_add_u32 %0, %1" :: "v"((unsigned)(size_t)(cnt)), "v"(one_) : "memory"); } } while (0)
    if (c.wave >= 4) {
#pragma unroll 1
        for (int t = 0; t < 68; ++t) {
            if (t >= 3) B2_SPIN(cntD, 4 * (t - 2));
            B2_ISSUE(t);
            if (t >= 1) { vm_wait<9>(); B2_ARRIVE(cntF); }
        }
        vm_wait<0>(); B2_ARRIVE(cntF);
        return;
    }
#define B2_VT(step, vt) do { const char* v_ = VTG + (size_t)(B2_CHUNK(step) * 4 + h) * 32768 + loff; \
        asm volatile("global_load_dwordx4 %0, %4, off\n\tglobal_load_dwordx4 %1, %4, off offset:1024\n\tglobal_load_dwordx4 %2, %4, off offset:2048\n\tglobal_load_dwordx4 %3, %4, off offset:3072" \
                     : "=&v"(vt[0]), "=&v"(vt[1]), "=&v"(vt[2]), "=&v"(vt[3]) : "v"(v_) : "memory"); } while (0)
#define B2_VT_WAIT(N, vt) asm volatile("s_waitcnt vmcnt(%4)" : "+v"(vt[0]), "+v"(vt[1]), "+v"(vt[2]), "+v"(vt[3]) : "n"(N) : "memory")
    f32x16 S[4];
#pragma unroll
    for (int ct = 0; ct < 4; ++ct)
#pragma unroll
        for (int r = 0; r < 16; ++r) S[ct][r] = 0.f;
    bf16x8 vtA[4], vtB[4];
    B2_VT(0, vtA);
#define B2_STEP(step, vt, vtn) do { \
        B2_SPIN(cntF, 4 * ((step) + 1));     \
        if ((step) + 1 < 68) B2_VT((step) + 1, vtn); \
        const int n_ = B2_CHUNK(step); const int key0 = (n_ < 256) ? CTXL + (n_ & 63) * 64 : (n_ - 256 - 4 * b) * 64; \
        const LAS unsigned char* lb = c.lds + ((step) % 3) * STG + loff; \
          \
        f32x16 o[2]; \
        _Pragma("unroll") for (int tt = 0; tt < 2; ++tt) { _Pragma("unroll") for (int r = 0; r < 16; ++r) o[tt][r] = 0.f; } \
        { u32x4 bw[8]; \
          _Pragma("unroll") for (int ct = 0; ct < 4; ++ct) { _Pragma("unroll") for (int s = 0; s < 2; ++s) { bw[ct * 2 + s].x = cvt_pk_bf16(S[ct][8 * s], S[ct][8 * s + 1]); bw[ct * 2 + s].y = cvt_pk_bf16(S[ct][8 * s + 2], S[ct][8 * s + 3]); bw[ct * 2 + s].z = cvt_pk_bf16(S[ct][8 * s + 4], S[ct][8 * s + 5]); bw[ct * 2 + s].w = cvt_pk_bf16(S[ct][8 * s + 6], S[ct][8 * s + 7]); } } \
          _Pragma("unroll") for (int tt = 0; tt < 2; ++tt) { bf16x8 qa[8]; \
            _Pragma("unroll") for (int i = 0; i < 8; ++i) qa[i] = *(const LAS bf16x8*)(lb + (tt * 8 + i) * 1024); \
            __builtin_amdgcn_sched_barrier(0); \
            _Pragma("unroll") for (int i = 0; i < 8; ++i) o[tt] = __builtin_amdgcn_mfma_f32_32x32x16_bf16(__builtin_bit_cast(bf16x8, bw[i]), qa[i], o[tt], 0, 0, 0); \
            __builtin_amdgcn_sched_barrier(0); } } \
          \
        _Pragma("unroll") for (int tt = 0; tt < 2; ++tt) { bf16_t* op = OUT + (size_t)(key0 + 32 * tt + lr) * 32 + 4 * hi; \
            _Pragma("unroll") for (int gq = 0; gq < 4; ++gq) { u32x2 ov; ov.x = cvt_pk_bf16(o[tt][4 * gq], o[tt][4 * gq + 1]); ov.y = cvt_pk_bf16(o[tt][4 * gq + 2], o[tt][4 * gq + 3]); *(u32x2*)(op + 8 * gq) = ov; } } \
          \
        if ((step) == 0) B2_VT_WAIT(12, vt); else if ((step) == 67) B2_VT_WAIT(16, vt); else B2_VT_WAIT(20, vt); \
        const LAS float* dcl = (const LAS float*)(c.lds + ((step) % 3) * STG + 32768); \
        _Pragma("unroll") for (int cp = 0; cp < 2; ++cp) { bf16x8 ka[8]; f32x4 dq[8]; \
          _Pragma("unroll") for (int i = 0; i < 8; ++i) ka[i] = *(const LAS bf16x8*)(lb + 16384 + (cp * 8 + i) * 1024); \
          _Pragma("unroll") for (int i = 0; i < 8; ++i) dq[i] = *(const LAS f32x4*)(dcl + 32 * (2 * cp + (i >> 2)) + 8 * (i & 3) + 4 * hi); \
          __builtin_amdgcn_sched_barrier(0); \
          _Pragma("unroll") for (int cc = 0; cc < 2; ++cc) { _Pragma("unroll") for (int gq = 0; gq < 4; ++gq) { _Pragma("unroll") for (int e = 0; e < 4; ++e) S[2 * cp + cc][4 * gq + e] *= dq[cc * 4 + gq][e]; } } \
          _Pragma("unroll") for (int ks = 0; ks < 4; ++ks) { _Pragma("unroll") for (int cc = 0; cc < 2; ++cc) S[2 * cp + cc] = __builtin_amdgcn_mfma_f32_32x32x16_bf16(ka[cc * 4 + ks], vt[ks], S[2 * cp + cc], 0, 0, 0); } \
          __builtin_amdgcn_sched_barrier(0); } \
        asm volatile("s_waitcnt lgkmcnt(0)" ::: "memory"); B2_ARRIVE(cntD);     \
    } while (0)
#pragma unroll 1
    for (int step = 0; step < 68; step += 2) { B2_STEP(step, vtA, vtB); B2_STEP(step + 1, vtB, vtA); }
    asm volatile("s_waitcnt vmcnt(0) lgkmcnt(0)" ::: "memory");
#undef B2_STEP
#undef B2_VT_WAIT
#undef B2_CHUNK
#undef B2_ISSUE
#undef B2_VT
#undef B2_SPIN
#undef B2_ARRIVE
}
struct FinRaw { u32x2 a[4], b[4], d[4], r[4]; };
__device__ __forceinline__ void gla_finish_load(const Ctx& c, int row, FinRaw& F) {
    const int lane = c.lane; const bf16_t* OI = (const bf16_t*)(c.ws + WS_RB + RB_OINTRA) + (size_t)row * D;
    const bool lat = row < TL; const int b = lat ? (row >> 12) : ((row - TL) >> 8), key = lat ? CTXL + (row & 4095) : ((row - TL) & 255);
    const bf16_t* OFp = (const bf16_t*)(c.ws + WS_RB + RB_OF) + ((size_t)((b * 4) * 8 + (lane >> 3)) * NKEY + key) * 32 + (lane & 7) * 4; const bf16_t* OBp = OFp + (size_t)(RB_OB - RB_OF) / 2;
    const bf16_t* R = (const bf16_t*)(c.ws + WS_RA) + (size_t)row * NZ + ZRB;
#pragma unroll
    for (int h = 0; h < 4; ++h) { const int cc = h * 256 + 4 * lane; const size_t ho = (size_t)h * 8 * NKEY * 32; F.a[h] = *(const u32x2*)(OI + cc); F.b[h] = *(const u32x2*)(OFp + ho); F.d[h] = *(const u32x2*)(OBp + ho); F.r[h] = *(const u32x2*)(R + cc); }
}
__device__ __forceinline__ void gla_finish_row(const Ctx& c, int l, int row, const FinRaw& F) {
    const int lane = c.lane; bf16_t* Y = (bf16_t*)(c.ws + WS_RB + RB_YCAT) + (size_t)row * 3072 + D;
    const f32x4 gv = *(const f32x4*)(c.in[I_GGLA] + l * 256 + 4 * lane);
    float o[4][4], ss[4];
#pragma unroll
    for (int h = 0; h < 4; ++h) { const u32x2 a = F.a[h], b = F.b[h], d = F.d[h];
        o[h][0] = bflo(a.x) + bflo(b.x) + bflo(d.x); o[h][1] = bfhi(a.x) + bfhi(b.x) + bfhi(d.x); o[h][2] = bflo(a.y) + bflo(b.y) + bflo(d.y); o[h][3] = bfhi(a.y) + bfhi(b.y) + bfhi(d.y);
        ss[h] = (o[h][0] * o[h][0] + o[h][1] * o[h][1]) + (o[h][2] * o[h][2] + o[h][3] * o[h][3]); }
#pragma unroll
    for (int h = 0; h < 4; ++h) ss[h] = wave_sum(ss[h]);
#pragma unroll
    for (int h = 0; h < 4; ++h) { const int cc = h * 256 + 4 * lane; const u32x2 r = F.r[h]; const float rstd = 1.0f / sqrtf(ss[h] * (1.f / 256.f) + EPS);
        u32x2 ov; ov.x = cvt_pk_bf16(o[h][0] * rstd * gv[0] * bflo(r.x), o[h][1] * rstd * gv[1] * bfhi(r.x)); ov.y = cvt_pk_bf16(o[h][2] * rstd * gv[2] * bflo(r.y), o[h][3] * rstd * gv[3] * bfhi(r.y));
        *(u32x2*)(Y + cc) = ov; }
}
__device__ __forceinline__ void rope_angle(int pos_row, int pos_col, int j, float& cs, float& sn) {
    const int axis = j >> 5, f = j & 15; const float inv = __expf(-(float)(2 * f) * (1.f / 32.f) * 9.210340371976184f);
    float rev = (float)(axis == 0 ? pos_row : pos_col) * inv * 0.15915494309189535f; rev -= floorf(rev); sn = __builtin_amdgcn_sinf(rev); cs = __builtin_amdgcn_cosf(rev);
}
struct C1Raw { u32x2 ckv; unsigned cq[3]; bf16_t kro; u32x2 kvw[8]; unsigned qnw[8]; bf16_t qrw[8]; };
__device__ __forceinline__ void mla_c1_load(const Ctx& c, int row, bool do_q, C1Raw& R) {
    const int lane = c.lane;
    const bf16_t* Zr = (const bf16_t*)(c.ws + WS_RA) + (size_t)row * NZ;
    const bf16_t* KV = (const bf16_t*)(c.ws + WS_RB + RB_KVRAW) + (size_t)row * 2048; const bf16_t* QR = (const bf16_t*)(c.ws + WS_RB + RB_QRAW) + (size_t)row * 1536;
    R.ckv = *(const u32x2*)(Zr + ZCKV + 4 * lane);
#pragma unroll
    for (int i = 0; i < 3; ++i) R.cq[i] = *(const unsigned*)(Zr + ZCQ + 128 * i + 2 * lane);
    R.kro = Zr[ZKR + lane];
#pragma unroll
    for (int h = 0; h < 8; ++h) R.kvw[h] = *(const u32x2*)(KV + h * 256 + 4 * lane);
    if (do_q) {
#pragma unroll
        for (int h = 0; h < 8; ++h) { R.qnw[h] = *(const unsigned*)(QR + h * 192 + 2 * lane); R.qrw[h] = QR[h * 192 + 128 + lane]; }
    }
}
__device__ __forceinline__ void mla_c1_row(const Ctx& c, int l, int row, bool do_q, const C1Raw& R) {
    const int lane = c.lane; const bool lat = row < TL; const int b = lat ? (row >> 12) : ((row - TL) >> 8), t = lat ? (row & 4095) : ((row - TL) & 255), key = lat ? (CTXL + t) : t;
    bf16_t* KG = (bf16_t*)(c.ws + WS_RB + RB_KG); bf16_t* VG = (bf16_t*)(c.ws + WS_RB + RB_VG);
    float rs_kv, rs_q;
    { const u32x2 w = R.ckv; const float a0 = bflo(w.x), a1 = bfhi(w.x), a2 = bflo(w.y), a3 = bfhi(w.y);
      rs_kv = 1.0f / sqrtf(wave_sum((a0 * a0 + a1 * a1) + (a2 * a2 + a3 * a3)) * (1.f / 256.f) + EPS);
      float s = 0.f;
#pragma unroll
      for (int i = 0; i < 3; ++i) { const unsigned w2 = R.cq[i]; const float q0 = bflo(w2), q1 = bfhi(w2); s += q0 * q0 + q1 * q1; }
      rs_q = 1.0f / sqrtf(wave_sum(s) * (1.f / 384.f) + EPS); }
    float cs = 1.f, sn = 0.f; if (lat) rope_angle(t >> 6, t & 63, lane, cs, sn);
    const bool second = (lane >> 4) & 1;
    float kr;
    { const float v = bf2f(R.kro); const float rr = 1.0f / sqrtf(wave_sum(v * v) * (1.f / 64.f) + EPS); float x = v * rr * c.in[I_GKR][l * 64 + lane];
      const float xp = sx<16>(x); kr = lat ? (second ? (x * cs + xp * sn) : (x * cs - xp * sn)) : x; }
    const bf16_t krb = f2bf(kr);
    const f32x4 gkn = *(const f32x4*)(c.in[I_GKN] + l * 128 + 4 * (lane & 31));
    float ssk[8]; float ak[8][4];
#pragma unroll
    for (int h = 0; h < 8; ++h) { ak[h][0] = bflo(R.kvw[h].x) * rs_kv; ak[h][1] = bfhi(R.kvw[h].x) * rs_kv; ak[h][2] = bflo(R.kvw[h].y) * rs_kv; ak[h][3] = bfhi(R.kvw[h].y) * rs_kv;
        ssk[h] = (ak[h][0] * ak[h][0] + ak[h][1] * ak[h][1]) + (ak[h][2] * ak[h][2] + ak[h][3] * ak[h][3]); }
#pragma unroll
    for (int h = 0; h < 8; ++h) ssk[h] = half_sum(ssk[h]);
    { bf16_t* kgp = KG + (size_t)(b * NKEY + key) * (8 * 192); bf16_t* vgp = VG + (size_t)(b * NKEY + key) * (8 * 128);
#pragma unroll
      for (int h = 0; h < 8; ++h) {
        if (lane < 32) { const float rn = 1.0f / sqrtf(ssk[h] * (1.f / 128.f) + EPS); u32x2 o; o.x = cvt_pk_bf16(ak[h][0] * rn * gkn[0], ak[h][1] * rn * gkn[1]); o.y = cvt_pk_bf16(ak[h][2] * rn * gkn[2], ak[h][3] * rn * gkn[3]);
            *(u32x2*)(kgp + h * 192 + 4 * lane) = o; }
        else { u32x2 o; o.x = cvt_pk_bf16(ak[h][0], ak[h][1]); o.y = cvt_pk_bf16(ak[h][2], ak[h][3]); *(u32x2*)(vgp + h * 128 + 4 * (lane - 32)) = o; }
        kgp[h * 192 + 128 + lane] = krb;
      } }
    __builtin_amdgcn_sched_barrier(0);
    if (lane == 0) ((float*)(c.ws + WS_RSQ))[row] = rs_q;
    if (!do_q) return;
    bf16_t* QF = lat ? (bf16_t*)(c.ws + WS_RB + RB_QFL) : (bf16_t*)(c.ws + WS_RB + RB_QFC); const int nq = lat ? SEQ : CTXL;
    const float QS = 0.07216878364870322f * 1.4426950408889634f;
    const f32x2 gqn = *(const f32x2*)(c.in[I_GQN] + l * 128 + 2 * lane); const float gqr = c.in[I_GQR][l * 64 + lane];
    float n0[8], n1[8], r0[8], sn_[8], sr_[8];
#pragma unroll
    for (int h = 0; h < 8; ++h) { n0[h] = bflo(R.qnw[h]) * rs_q; n1[h] = bfhi(R.qnw[h]) * rs_q; r0[h] = bf2f(R.qrw[h]) * rs_q; sn_[h] = n0[h] * n0[h] + n1[h] * n1[h]; sr_[h] = r0[h] * r0[h]; }
#pragma unroll
    for (int h = 0; h < 8; ++h) { sn_[h] = wave_sum(sn_[h]); sr_[h] = wave_sum(sr_[h]); }
#pragma unroll
    for (int h = 0; h < 8; ++h) {
        const float rn = 1.0f / sqrtf(sn_[h] * (1.f / 128.f) + EPS), rr = 1.0f / sqrtf(sr_[h] * (1.f / 64.f) + EPS);
        bf16_t* qp = QF + (size_t)(b * nq + t) * (8 * 192) + h * 192;
        *(unsigned*)(qp + 2 * lane) = cvt_pk_bf16(n0[h] * rn * gqn[0] * QS, n1[h] * rn * gqn[1] * QS);
        const float x = r0[h] * rr * gqr; const float xp = sx<16>(x); const float xr = lat ? (second ? (x * cs + xp * sn) : (x * cs - xp * sn)) : x;
        qp[128 + lane] = f2bf(xr * QS);
    }
}
__device__ __forceinline__ bf16x8 tr_pair(unsigned a0, unsigned a1) {
    bf16x4 x, y; asm volatile("ds_read_b64_tr_b16 %0, %2\n\tds_read_b64_tr_b16 %1, %3\n\ts_waitcnt lgkmcnt(0)" : "=&v"(x), "=&v"(y) : "v"(a0), "v"(a1) : "memory");
    return (bf16x8){x[0], x[1], x[2], x[3], y[0], y[1], y[2], y[3]};
}
__device__ __forceinline__ void k2_issue(bf16x8& a0, bf16x8& a1, unsigned addr) {
    asm volatile("ds_read_b128 %0, %2\n\tds_read_b128 %1, %2 offset:12288" : "=&v"(a0), "=&v"(a1) : "v"(addr) : "memory");
}
template <int N> __device__ __forceinline__ void k2_wait(bf16x8& a0, bf16x8& a1) { asm volatile("s_waitcnt lgkmcnt(%2)" : "+v"(a0), "+v"(a1) : "n"(N) : "memory"); }
template <int OFF>
__device__ __forceinline__ void tr8_issue(bf16x4 (&x)[8], unsigned a0, unsigned a1, unsigned a2, unsigned a3, unsigned d1) {
    asm volatile("ds_read_b64_tr_b16 %0, %8 offset:%13\n\tds_read_b64_tr_b16 %2, %9 offset:%13\n\tds_read_b64_tr_b16 %4, %10 offset:%13\n\tds_read_b64_tr_b16 %6, %11 offset:%13\n\t"
                 "v_add_u32 %8, %8, %12\n\tv_add_u32 %9, %9, %12\n\tv_add_u32 %10, %10, %12\n\tv_add_u32 %11, %11, %12\n\t"
                 "ds_read_b64_tr_b16 %1, %8 offset:%13\n\tds_read_b64_tr_b16 %3, %9 offset:%13\n\tds_read_b64_tr_b16 %5, %10 offset:%13\n\tds_read_b64_tr_b16 %7, %11 offset:%13"
                 : "=&v"(x[0]), "=&v"(x[1]), "=&v"(x[2]), "=&v"(x[3]), "=&v"(x[4]), "=&v"(x[5]), "=&v"(x[6]), "=&v"(x[7]), "+v"(a0), "+v"(a1), "+v"(a2), "+v"(a3)
                 : "v"(d1), "n"(OFF) : "memory");
}
__device__ __forceinline__ void tr8_wait(bf16x4 (&x)[8]) {
    asm volatile("s_waitcnt lgkmcnt(0)" : "+v"(x[0]), "+v"(x[1]), "+v"(x[2]), "+v"(x[3]), "+v"(x[4]), "+v"(x[5]), "+v"(x[6]), "+v"(x[7]) :: "memory");
}
__device__ __forceinline__ void attn_unit(const Ctx& c, int l, const bf16_t* Qraw  , const float* rsq  , int t0  ,
                                          const bf16_t* Kp  , const bf16_t* Vp  , int nt, bf16_t* Op  ) {
    constexpr int STG = 40960, KB = 24576;
    const int tid = c.tid, lane = c.lane, w = c.wave, lr = lane & 31, hi = lane >> 5;
    const unsigned lds0 = (unsigned)(size_t)c.lds;
    unsigned ksrc[3], vsrc[2];
#pragma unroll
    for (int i = 0; i < 3; ++i) { const int P = (w + 8 * i) * 64 + lane, row = P / 24, cp = P % 24, ch = (cp & ~7) | ((cp & 7) ^ ((row >> 1) & 7)); ksrc[i] = row * 3072 + ch * 16; }
#pragma unroll
    for (int i = 0; i < 2; ++i) { const int P = (w + 8 * i) * 64 + lane, row = P >> 4, cp = P & 15, ch = cp ^ (((row & 3) << 2) | ((row >> 2) & 3)); vsrc[i] = row * 2048 + ch * 16; }
#define ATT_ISSUE(tile, stg) do { const char* kt_ = (const char*)Kp + (size_t)(tile) * (64 * 3072); const char* vt_ = (const char*)Vp + (size_t)(tile) * (64 * 2048); \
        _Pragma("unroll") for (int i_ = 0; i_ < 3; ++i_) __builtin_amdgcn_global_load_lds((const unsigned*)(kt_ + ksrc[i_]), (LAS unsigned*)(c.lds + (stg) * STG + (w + 8 * i_) * 1024), 16, 0, 0); \
        _Pragma("unroll") for (int i_ = 0; i_ < 2; ++i_) __builtin_amdgcn_global_load_lds((const unsigned*)(vt_ + vsrc[i_]), (LAS unsigned*)(c.lds + (stg) * STG + KB + (w + 8 * i_) * 1024), 16, 0, 0); } while (0)
    bf16x8 qf[12];
    {
      const int qr = 32 * w + lr; const bf16_t* qrow = Qraw + (size_t)qr * 1536 + 8 * hi; const float rs = rsq[qr];
      u32x4 raw[12]; float sn = 0.f, sr = 0.f;
#pragma unroll
      for (int s = 0; s < 12; ++s) { raw[s] = *(const u32x4*)(qrow + 16 * s); const u32x4 wv = raw[s];
          const float q2 = (bflo(wv.x) * bflo(wv.x) + bfhi(wv.x) * bfhi(wv.x)) + (bflo(wv.y) * bflo(wv.y) + bfhi(wv.y) * bfhi(wv.y)) + (bflo(wv.z) * bflo(wv.z) + bfhi(wv.z) * bfhi(wv.z)) + (bflo(wv.w) * bflo(wv.w) + bfhi(wv.w) * bfhi(wv.w));
          if (s < 8) sn += q2; else sr += q2; }
      sn = sum32(sn) * rs * rs; sr = sum32(sr) * rs * rs;
      const float QS = 0.07216878364870322f * 1.4426950408889634f;
      const float rn = rs * QS / sqrtf(sn * (1.f / 128.f) + EPS), rr = rs * QS / sqrtf(sr * (1.f / 64.f) + EPS);
      const float* gqn = c.in[I_GQN] + l * 128 + 8 * hi; const float* gqr = c.in[I_GQR] + l * 64 + 8 * hi;
#pragma unroll
      for (int s = 0; s < 8; ++s) { const f32x4 g0 = *(const f32x4*)(gqn + 16 * s) * rn, g1 = *(const f32x4*)(gqn + 16 * s + 4) * rn; const u32x4 wv = raw[s]; u32x4 pk;
          pk.x = cvt_pk_bf16(bflo(wv.x) * g0[0], bfhi(wv.x) * g0[1]); pk.y = cvt_pk_bf16(bflo(wv.y) * g0[2], bfhi(wv.y) * g0[3]); pk.z = cvt_pk_bf16(bflo(wv.z) * g1[0], bfhi(wv.z) * g1[1]); pk.w = cvt_pk_bf16(bflo(wv.w) * g1[2], bfhi(wv.w) * g1[3]);
          qf[s] = __builtin_bit_cast(bf16x8, pk); }
      float x[4][8];
#pragma unroll
      for (int s = 0; s < 4; ++s) { const f32x4 g0 = *(const f32x4*)(gqr + 16 * s) * rr, g1 = *(const f32x4*)(gqr + 16 * s + 4) * rr; const u32x4 wv = raw[8 + s];
          x[s][0] = bflo(wv.x) * g0[0]; x[s][1] = bfhi(wv.x) * g0[1]; x[s][2] = bflo(wv.y) * g0[2]; x[s][3] = bfhi(wv.y) * g0[3]; x[s][4] = bflo(wv.z) * g1[0]; x[s][5] = bfhi(wv.z) * g1[1]; x[s][6] = bflo(wv.w) * g1[2]; x[s][7] = bfhi(wv.w) * g1[3]; }
      if (t0 >= 0) { const int t = t0 + qr; const float prow = (float)(t >> 6), pcol = (float)(t & 63);
#pragma unroll
          for (int i = 0; i < 8; ++i) { const float inv = __expf(-(float)(2 * (8 * hi + i)) * (1.f / 32.f) * 9.210340371976184f) * 0.15915494309189535f;
              float r0 = prow * inv; r0 -= floorf(r0); float r1 = pcol * inv; r1 -= floorf(r1);
              const float c0 = __builtin_amdgcn_cosf(r0), s0 = __builtin_amdgcn_sinf(r0), c1 = __builtin_amdgcn_cosf(r1), s1 = __builtin_amdgcn_sinf(r1);
              const float a0 = x[0][i], b0 = x[1][i], a1 = x[2][i], b1 = x[3][i];
              x[0][i] = a0 * c0 - b0 * s0; x[1][i] = b0 * c0 + a0 * s0; x[2][i] = a1 * c1 - b1 * s1; x[3][i] = b1 * c1 + a1 * s1; } }
#pragma unroll
      for (int s = 0; s < 4; ++s) { u32x4 pk; pk.x = cvt_pk_bf16(x[s][0], x[s][1]); pk.y = cvt_pk_bf16(x[s][2], x[s][3]); pk.z = cvt_pk_bf16(x[s][4], x[s][5]); pk.w = cvt_pk_bf16(x[s][6], x[s][7]); qf[8 + s] = __builtin_bit_cast(bf16x8, pk); }
      __builtin_amdgcn_sched_barrier(0); }
    unsigned kbase = lr * 384, y16 = (unsigned)((hi ^ ((lr >> 1) & 7)) << 4);
    unsigned vbase, q64, vd1;
    { const int blk = (lane >> 4) & 1, q = (lane & 15) >> 2, p = lane & 3; const int lb = (2 * blk + (p >> 1)) ^ hi;
      vbase = KB + 256 * (4 * hi + q) + 16 * lb + 8 * (p & 1); q64 = (unsigned)(q << 6); vd1 = 2048u + ((lb & 2) ? -32 : 32); }
    f32x16 o[4];
#pragma unroll
    for (int cc = 0; cc < 4; ++cc)
#pragma unroll
        for (int r = 0; r < 16; ++r) o[cc][r] = 0.f;
    float m = -1e30f, lsum = 0.f;
    ATT_ISSUE(0, 0);
    if (nt > 1) ATT_ISSUE(1, 1);
    asm volatile("" :: "v"(qf[0]), "v"(qf[1]), "v"(qf[2]), "v"(qf[3]), "v"(qf[4]), "v"(qf[5]), "v"(qf[6]), "v"(qf[7]), "v"(qf[8]), "v"(qf[9]), "v"(qf[10]), "v"(qf[11]));
#pragma unroll 1
    for (int j = 0; j < nt; ++j) {
        if (j + 1 < nt) asm volatile("s_waitcnt vmcnt(5)" ::: "memory"); else asm volatile("s_waitcnt vmcnt(0)" ::: "memory");
        asm volatile("s_waitcnt lgkmcnt(0)" ::: "memory"); __builtin_amdgcn_s_barrier(); asm volatile("" ::: "memory");
        if (j + 2 < nt) ATT_ISSUE(j + 2, (j + 2) % 3);
        const unsigned sb = lds0 + (unsigned)((j % 3) * STG);
        asm volatile("" : "+v"(kbase), "+v"(y16), "+v"(vbase), "+v"(q64), "+v"(vd1));
        const unsigned kb_ = sb + kbase;
        f32x16 st[2];
#pragma unroll
        for (int kt = 0; kt < 2; ++kt)
#pragma unroll
            for (int r = 0; r < 16; ++r) st[kt][r] = 0.f;
        { bf16x8 ka[2][2];
#define KADDR(s_) (kb_ + (y16 ^ (unsigned)(((2 * (s_)) & 7) << 4)) + (unsigned)((((2 * (s_)) & ~7) << 4)))
          k2_issue(ka[0][0], ka[0][1], KADDR(0));
#pragma unroll
          for (int s = 0; s < 12; ++s) {
              if (s + 1 < 12) { k2_issue(ka[(s + 1) & 1][0], ka[(s + 1) & 1][1], KADDR(s + 1)); k2_wait<2>(ka[s & 1][0], ka[s & 1][1]); }
              else k2_wait<0>(ka[s & 1][0], ka[s & 1][1]);
              st[0] = __builtin_amdgcn_mfma_f32_32x32x16_bf16(ka[s & 1][0], qf[s], st[0], 0, 0, 0);
              st[1] = __builtin_amdgcn_mfma_f32_32x32x16_bf16(ka[s & 1][1], qf[s], st[1], 0, 0, 0); }
#undef KADDR
        }
        bf16x4 vx[8];
        tr8_issue<0>(vx, sb + vbase + (q64 ^ 0u), sb + vbase + (q64 ^ 64u), sb + vbase + (q64 ^ 128u), sb + vbase + (q64 ^ 192u), vd1);
        float mx = st[0][0];
#pragma unroll
        for (int r = 1; r < 16; ++r) mx = fmaxf(mx, st[0][r]);
#pragma unroll
        for (int r = 0; r < 16; ++r) mx = fmaxf(mx, st[1][r]);
        mx = max32(mx);
        const float mn = fmaxf(m, mx), alpha = __builtin_amdgcn_exp2f(m - mn); m = mn;
        float ps = 0.f;
#pragma unroll
        for (int kt = 0; kt < 2; ++kt)
#pragma unroll
            for (int r = 0; r < 16; ++r) { st[kt][r] = __builtin_amdgcn_exp2f(st[kt][r] - mn); ps += st[kt][r]; }
        lsum = lsum * alpha + ps;
        if (__any(alpha != 1.0f)) {
#pragma unroll
            for (int cc = 0; cc < 4; ++cc)
#pragma unroll
                for (int r = 0; r < 16; ++r) o[cc][r] *= alpha; }
#define ATT_PV(KT, S2, NEXT_OFF, HAS_NEXT) do { u32x4 pw; pw.x = cvt_pk_bf16(st[KT][8 * S2], st[KT][8 * S2 + 1]); pw.y = cvt_pk_bf16(st[KT][8 * S2 + 2], st[KT][8 * S2 + 3]); pw.z = cvt_pk_bf16(st[KT][8 * S2 + 4], st[KT][8 * S2 + 5]); pw.w = cvt_pk_bf16(st[KT][8 * S2 + 6], st[KT][8 * S2 + 7]); \
            const bf16x8 pb = __builtin_bit_cast(bf16x8, pw); tr8_wait(vx); bf16x8 af[4]; \
            _Pragma("unroll") for (int cc = 0; cc < 4; ++cc) af[cc] = (bf16x8){vx[2 * cc][0], vx[2 * cc][1], vx[2 * cc][2], vx[2 * cc][3], vx[2 * cc + 1][0], vx[2 * cc + 1][1], vx[2 * cc + 1][2], vx[2 * cc + 1][3]}; \
            if (HAS_NEXT) tr8_issue<NEXT_OFF>(vx, sb + vbase + (q64 ^ 0u), sb + vbase + (q64 ^ 64u), sb + vbase + (q64 ^ 128u), sb + vbase + (q64 ^ 192u), vd1); \
            _Pragma("unroll") for (int cc = 0; cc < 4; ++cc) o[cc] = __builtin_amdgcn_mfma_f32_32x32x16_bf16(af[cc], pb, o[cc], 0, 0, 0); } while (0)
        ATT_PV(0, 0, 4096, true); ATT_PV(0, 1, 8192, true); ATT_PV(1, 0, 12288, true); ATT_PV(1, 1, 0, false);
#undef ATT_PV
    }
    const float linv = 1.0f / sum32(lsum);
    bf16_t* orow = Op + (size_t)(32 * w + lr) * 3072;
#pragma unroll
    for (int cc = 0; cc < 4; ++cc)
#pragma unroll
        for (int g = 0; g < 4; ++g) { u32x2 ov; ov.x = cvt_pk_bf16(o[cc][4 * g] * linv, o[cc][4 * g + 1] * linv); ov.y = cvt_pk_bf16(o[cc][4 * g + 2] * linv, o[cc][4 * g + 3] * linv);
            *(u32x2*)(orow + 32 * cc + 8 * g + 4 * hi) = ov; }
    asm volatile("s_waitcnt vmcnt(0) lgkmcnt(0)" ::: "memory"); __builtin_amdgcn_s_barrier(); asm volatile("" ::: "memory");
#undef ATT_ISSUE
}
__device__ __forceinline__ void route_stage_w(const Ctx& c, int l) {
    LAS float* WT = (LAS float*)c.lds; const float* wr = c.in[I_WROUTER] + (size_t)l * D * NEXP;
    for (int i = c.tid; i < D * NEXP; i += NTHR) WT[(i & 15) * 1028 + (i >> 4)] = wr[i];
    __syncthreads();
}
struct RouteRaw { f32x4 xv[4]; };
__device__ __forceinline__ void route_load(const Ctx& c, int row, RouteRaw& R) { const float* xr = xout_row(c, row);
#pragma unroll
    for (int j = 0; j < 4; ++j) R.xv[j] = *(const f32x4*)(xr + 4 * c.lane + 256 * j); }
__device__ __forceinline__ void route_row(const Ctx& c, int l, int row, const RouteRaw& R) {
    const int lane = c.lane, bi = row_modidx(row); f32x4 hv[4];
    { const float* g = c.in[I_GFFN] + l * D; const float* shift = modp(c, l, bi, 3); const float* scale = modp(c, l, bi, 4); bf16_t* hrow = (bf16_t*)(c.ws + WS_H) + (size_t)row * D; float ss = 0.f;
#pragma unroll
      for (int j = 0; j < 4; ++j) { hv[j] = R.xv[j]; ss += (hv[j][0] * hv[j][0] + hv[j][1] * hv[j][1]) + (hv[j][2] * hv[j][2] + hv[j][3] * hv[j][3]); }
      const float rstd = 1.0f / sqrtf(wave_sum(ss) * (1.f / D) + EPS);
#pragma unroll
      for (int j = 0; j < 4; ++j) { const int cc = 4 * lane + 256 * j; const f32x4 gv = *(const f32x4*)(g + cc), sc = *(const f32x4*)(scale + cc), sh = *(const f32x4*)(shift + cc);
          hv[j] = hv[j] * rstd * gv * (sc + 1.0f) + sh;
          u32x2 o; o.x = cvt_pk_bf16(hv[j][0], hv[j][1]); o.y = cvt_pk_bf16(hv[j][2], hv[j][3]); *(u32x2*)(hrow + cc) = o; } }
    const LAS float* WT = (const LAS float*)c.lds; float lg[16];
#pragma unroll
    for (int e = 0; e < 16; ++e) { float a = 0.f;
#pragma unroll
        for (int j = 0; j < 4; ++j) { const f32x4 wv = *(const LAS f32x4*)(WT + e * 1028 + 4 * lane + 256 * j); a += (hv[j][0] * wv[0] + hv[j][1] * wv[1]) + (hv[j][2] * wv[2] + hv[j][3] * wv[3]); }
        lg[e] = a; if ((e & 3) == 3) __builtin_amdgcn_sched_barrier(0); }
#pragma unroll
    for (int e = 0; e < 16; ++e) lg[e] = wave_sum(lg[e]);
    float mx = lg[0];
#pragma unroll
    for (int e = 1; e < 16; ++e) mx = fmaxf(mx, lg[e]);
    float sum = 0.f;
#pragma unroll
    for (int e = 0; e < 16; ++e) { lg[e] = __expf(lg[e] - mx); sum += lg[e]; }
    const float inv = 1.0f / sum; float mine = 0.f;
#pragma unroll
    for (int e = 0; e < 16; ++e) mine = (lane == e) ? lg[e] * inv : mine;
    float* AF = (float*)(c.ws + WS_AFFT);
    if (lane < 16) { if (row < TL) AF[((size_t)(row >> 12) * 16 + lane) * SEQ + (row & 4095)] = mine; else AF[(size_t)NB * 16 * SEQ + ((size_t)((row - TL) >> 8) * 16 + lane) * CTXL + ((row - TL) & 255)] = mine; }
}
struct GuMap { int up; __device__ __forceinline__ int operator()(int n) const { return (n >> 7) * 256 + up * 128 + (n & 127); } };
struct IdMap { __device__ __forceinline__ int operator()(int n) const { return n; } };
__device__ __forceinline__ void expert_wconv(const Ctx& c, int l) {
    constexpr int U_G = 16 * 8, U_D = 32 * 4, U_E = 2 * U_G + U_D;
    bf16_t* WGU = (bf16_t*)(c.ws + WS_RB + RB_WGU); bf16_t* WD = (bf16_t*)(c.ws + WS_RB + RB_WD);
    unsigned* ctr = (unsigned*)(c.ws + WS_CTL + 32768) + 64 * l;
    LAS int* ubox = (LAS int*)(c.lds + 4 * 64 * 65 * 4);
    for (;;) { if (c.tid == 0) *ubox = (int)__hip_atomic_fetch_add(ctr, 1u, __ATOMIC_RELAXED, __HIP_MEMORY_SCOPE_AGENT);
        __syncthreads(); const int u = *ubox; __syncthreads(); if (u >= NEXP * U_E) break;
        const int e = u / U_E; int r = u % U_E;
        if (r < 2 * U_G) { const int up = r / U_G, rr = r % U_G, nb = rr / 16, kb = rr % 16;
            const float* src = c.in[up ? I_WEU : I_WEG] + ((size_t)l * NEXP + e) * D * DEXP;
            tconv_tile4(c, src, DEXP, kb * 64, nb * 256, WGU + (size_t)e * 4096 * D, D, kb * 64, GuMap{up}); }
        else { r -= 2 * U_G; const int nb = r / 32, kb = r % 32;
            tconv_tile4(c, c.in[I_WED] + ((size_t)l * NEXP + e) * DEXP * D, D, kb * 64, nb * 256, WD + (size_t)e * D * DEXP, DEXP, kb * 64, IdMap{}); } }
}
__device__ __forceinline__ void topk_unit(const Ctx& c, int un, bool is_ctx) {
    const int tid = c.tid, lane = c.lane, w = c.wave;
    LAS unsigned* hist = (LAS unsigned*)c.lds;
    LAS unsigned* ctl = (LAS unsigned*)(c.lds + 1024);
    LAS unsigned* wsum = (LAS unsigned*)(c.lds + 1280);
    LAS int* list = (LAS int*)(c.lds + 2048);
    int b, e, ntok, cap; const float* src;
    if (!is_ctx) { b = un >> 4; e = un & 15; ntok = SEQ; cap = CAPL; src = (const float*)(c.ws + WS_AFFT) + ((size_t)b * 16 + e) * SEQ; }
    else { b = un >> 4; e = un & 15; ntok = CTXL; cap = CAPC; src = (const float*)(c.ws + WS_AFFT) + (size_t)NB * 16 * SEQ + ((size_t)b * 16 + e) * CTXL; }
    const bool have = 8 * tid < ntok; unsigned key[8];
    if (have) { const u32x4 k0 = *(const u32x4*)(src + 8 * tid), k1 = *(const u32x4*)(src + 8 * tid + 4); key[0] = k0.x; key[1] = k0.y; key[2] = k0.z; key[3] = k0.w; key[4] = k1.x; key[5] = k1.y; key[6] = k1.z; key[7] = k1.w; }
    else {
#pragma unroll
        for (int i = 0; i < 8; ++i) key[i] = 0u; }
    if (tid == 0) { unsigned z0 = 0u, c0 = (unsigned)cap; asm volatile("" : "+v"(z0), "+v"(c0)); ctl[0] = z0; ctl[1] = c0; }
#pragma unroll 1
    for (int pass = 0; pass < 4; ++pass) { const int shift = 24 - 8 * pass;
        if (tid < 256) hist[tid] = 0u;
        __syncthreads();
        const unsigned pref = ctl[0], need = ctl[1];
        if (have) {
#pragma unroll
            for (int i = 0; i < 8; ++i) { const bool m = (pass == 0) || ((key[i] >> (shift + 8)) == pref); if (m) atomicAdd((unsigned*)(hist + ((key[i] >> shift) & 255u)), 1u); } }
        __syncthreads();
        if (tid < 256) {
            const unsigned hv = hist[tid]; unsigned sfx = hv;
#pragma unroll
            for (int o = 1; o < 64; o <<= 1) { const unsigned tv = bperm(sfx, lane + o); if (lane + o < 64) sfx += tv; }
            if (lane == 0) wsum[w] = sfx;
            }
        __syncthreads();
        if (tid < 256) { const unsigned hv = hist[tid]; unsigned sfx = hv;
#pragma unroll
            for (int o = 1; o < 64; o <<= 1) { const unsigned tv = bperm(sfx, lane + o); if (lane + o < 64) sfx += tv; }
            unsigned gt = sfx - hv;
#pragma unroll
            for (int j = 1; j < 4; ++j) if (w + j < 4) gt += wsum[w + j];
            if (gt < need && need <= gt + hv) { ctl[2] = (pref << 8) | (unsigned)tid; ctl[3] = need - gt; } }
        __syncthreads();
        if (tid == 0) { ctl[0] = ctl[2]; ctl[1] = ctl[3]; }
        __syncthreads();
    }
    const unsigned thr = ctl[0], need = ctl[1];
    unsigned cg = 0u, ce = 0u;
#pragma unroll
    for (int i = 0; i < 8; ++i) { cg += (key[i] > thr) ? 1u : 0u; ce += (have && key[i] == thr) ? 1u : 0u; }
    unsigned sg = cg, se = ce;
#pragma unroll
    for (int o = 1; o < 64; o <<= 1) { const unsigned tg = bperm(sg, lane - o), te = bperm(se, lane - o); if (lane >= o) { sg += tg; se += te; } }
    if (lane == 63) { wsum[w] = sg; wsum[8 + w] = se; }
    __syncthreads();
    unsigned og = 0u, oe = 0u;
#pragma unroll
    for (int j = 0; j < 8; ++j) { if (j < w) { og += wsum[j]; oe += wsum[8 + j]; } }
    unsigned pg = og + sg - cg, pe = oe + se - ce;
    const int rowbase = is_ctx ? (TL + b * CTXL) : (b * SEQ);
    if (have) {
#pragma unroll
        for (int i = 0; i < 8; ++i) { const bool g = key[i] > thr, q = key[i] == thr; const bool sel = g || (q && pe < need);
            const int rank = (int)(pg + (pe < need ? pe : need)); const int row = rowbase + 8 * tid + i;
            ((int*)(c.ws + WS_SEL))[(size_t)row * 16 + e] = sel ? rank : -1;
            if (sel) { const int slot = is_ctx ? (2048 + b * CAPC + rank) : (b * CAPL + rank); ((float*)(c.ws + WS_GATEV))[e * ESLOTS + slot] = __uint_as_float(key[i]); list[2 * rank] = row; list[2 * rank + 1] = slot; }
            pg += g ? 1u : 0u; pe += q ? 1u : 0u; } }
    __syncthreads();
    const bf16_t* H = (const bf16_t*)(c.ws + WS_H); bf16_t* XS = (bf16_t*)(c.ws + WS_RA + RA_XS) + (size_t)e * ESLOTS * D;
    for (int i0 = w; i0 < cap; i0 += 8 * NWAVES) {
        u32x4 v0[8], v1[8];
#pragma unroll
        for (int k = 0; k < 8; ++k) { const int i = i0 + k * NWAVES; if (i < cap) { const u32x4* sp = (const u32x4*)(H + (size_t)list[2 * i] * D); v0[k] = sp[lane]; v1[k] = sp[64 + lane]; } }
#pragma unroll
        for (int k = 0; k < 8; ++k) { const int i = i0 + k * NWAVES; if (i < cap) { u32x4* dp = (u32x4*)(XS + (size_t)list[2 * i + 1] * D); dp[lane] = v0[k]; dp[64 + lane] = v1[k]; } }
    }
    __syncthreads();
}
struct CombRaw { int sel; f32x4 xv[4]; };
__device__ __forceinline__ void combine_load(const Ctx& c, int row, CombRaw& R) {
    const int lane = c.lane; const float* xr = xout_row(c, row);
    R.sel = ((const int*)(c.ws + WS_SEL))[(size_t)row * 16 + (lane & 15)];
#pragma unroll
    for (int j = 0; j < 4; ++j) R.xv[j] = *(const f32x4*)(xr + 4 * lane + 256 * j);
}
__device__ __forceinline__ void combine_row(const Ctx& c, int l, int row, bool next_mod, const CombRaw& R, float* dummy = nullptr) {
    const int lane = c.lane, bi = row_modidx(row); float* xr = xout_row(c, row); float* xw = dummy ? dummy + (size_t)row * D : xr;
    const bf16_t* YS = (const bf16_t*)(c.ws + WS_RA + RA_YS); const float* g5 = modp(c, l, bi, 5);
    f32x4 acc[4];
#pragma unroll
    for (int j = 0; j < 4; ++j) acc[j] = (f32x4){0.f, 0.f, 0.f, 0.f};
    const bool lat = row < TL; const int b = lat ? (row >> 12) : ((row - TL) >> 8);
    unsigned long long pick = __ballot(R.sel >= 0) & 0xffffull;
    while (pick) {
        if (!lat) {
            const int e = __builtin_ctzll(pick); pick &= pick - 1; const int r = __builtin_amdgcn_readlane(R.sel, e);
            const bf16_t* yc = (const bf16_t*)(c.ws + WS_RB + RB_YSC) + ((size_t)e * 128 + b * CAPC + r) * D + 4 * lane; u32x2 wc[4][4];
#pragma unroll
            for (int k = 0; k < 4; ++k)
#pragma unroll
                for (int j = 0; j < 4; ++j) wc[k][j] = *(const u32x2*)(yc + (size_t)k * (NEXP * 128 * D) + 256 * j);
#pragma unroll
            for (int k = 0; k < 4; ++k)
#pragma unroll
                for (int j = 0; j < 4; ++j) { acc[j][0] += bflo(wc[k][j].x); acc[j][1] += bfhi(wc[k][j].x); acc[j][2] += bflo(wc[k][j].y); acc[j][3] += bfhi(wc[k][j].y); }
            continue; }
        const bf16_t* yp[4]; bool on[4];
#pragma unroll
        for (int k = 0; k < 4; ++k) { on[k] = pick != 0; const int e = on[k] ? __builtin_ctzll(pick) : 0; if (on[k]) pick &= pick - 1;
            const int r = __builtin_amdgcn_readlane(R.sel, e); const int slot = lat ? (b * CAPL + r) : (2048 + b * CAPC + r);
            yp[k] = YS + ((size_t)e * ESLOTS + (on[k] ? slot : 0)) * D; }
        u32x2 wv[4][4];
#pragma unroll
        for (int k = 0; k < 4; ++k)
#pragma unroll
            for (int j = 0; j < 4; ++j) wv[k][j] = on[k] ? *(const u32x2*)(yp[k] + 4 * lane + 256 * j) : (u32x2){0u, 0u};
#pragma unroll
        for (int k = 0; k < 4; ++k)
#pragma unroll
            for (int j = 0; j < 4; ++j) { acc[j][0] += bflo(wv[k][j].x); acc[j][1] += bfhi(wv[k][j].x); acc[j][2] += bflo(wv[k][j].y); acc[j][3] += bfhi(wv[k][j].y); }
    }
    float ss = 0.f; f32x4 xv[4];
#pragma unroll
    for (int j = 0; j < 4; ++j) { const int cc = 4 * lane + 256 * j; xv[j] = R.xv[j] + *(const f32x4*)(g5 + cc) * acc[j]; *(f32x4*)(xw + cc) = xv[j];
        ss += (xv[j][0] * xv[j][0] + xv[j][1] * xv[j][1]) + (xv[j][2] * xv[j][2] + xv[j][3] * xv[j][3]); }
    if (!next_mod) return;
    const float rstd = 1.0f / sqrtf(wave_sum(ss) * (1.f / D) + EPS); const float* g = c.in[I_GMIX] + (l + 1) * D; const float* sh = modp(c, l + 1, bi, 0); const float* sc = modp(c, l + 1, bi, 1);
    bf16_t* hrow = (bf16_t*)(c.ws + WS_H) + (size_t)row * D;
#pragma unroll
    for (int j = 0; j < 4; ++j) { const int cc = 4 * lane + 256 * j; const f32x4 h = xv[j] * rstd * *(const f32x4*)(g + cc) * (*(const f32x4*)(sc + cc) + 1.0f) + *(const f32x4*)(sh + cc);
        u32x2 o; o.x = cvt_pk_bf16(h[0], h[1]); o.y = cvt_pk_bf16(h[2], h[3]); *(u32x2*)(hrow + cc) = o; }
}

#ifndef MK_FUSED
#define MK_FUSED 1
#endif
constexpr int NPH = 2 + 11 * 2;
constexpr int CW_BAR = 4096;

__global__ void __launch_bounds__(NTHR, 2) fwd(Args args) {
    extern __shared__ __attribute__((aligned(16))) unsigned char lds_raw[];
    Ctx c; c.in = args.in; c.out = args.out; c.ws = args.ws; c.lds = (LAS unsigned char*)lds_raw;
    c.tid = threadIdx.x; c.lane = c.tid & 63; c.wave = __builtin_amdgcn_readfirstlane(c.tid >> 6); c.G = gridDim.x; c.bid = blockIdx.x;
    volatile LAS unsigned* misc = (volatile LAS unsigned*)(c.lds + LDS_MISC);
    if (c.tid < 8) misc[c.tid] = 0u;
    __syncthreads();
#if MK_FUSED
    XcdBarrier bar = xcd_barrier_post((unsigned*)(c.ws + WS_CTL) + CW_BAR, misc);
#define GRID_BAR() xcd_barrier(bar)
#else
#define GRID_BAR() do {} while (0)
#endif
    const int lo = args.ph_lo, hi = args.ph_hi;
#ifndef PHMASK
#define PHMASK 0xffffffffu
#endif
#define IN(k) (lo <= (k) && (k) < hi)
#define EN(j) ((PHMASK >> (j)) & 1u)
#ifndef REPEAT_ID
#define REPEAT_ID -1
#endif
#define REP(id) for (int rep_ = 0; rep_ < ((REPEAT_ID == (id)) ? 2 : 1); ++rep_)
#if defined(DEBUG_TS_A)
#ifndef DEBUG_TS_Q
#define DEBUG_TS_Q 4.0f
#endif
#ifndef DEBUG_TS_SHIFT
#define DEBUG_TS_SHIFT 0.0f
#endif
#define TS_STORE(k) do { if (c.bid == 0 && c.wave == 0) ((unsigned long long*)(c.ws + WS_CTL + 768 * 1024))[(k)] = __builtin_amdgcn_s_memrealtime(); } while (0)
#else
#define TS_STORE(k) do {} while (0)
#endif
#define SEAM(k) do { if (IN((k) + 1)) { GRID_BAR(); if (REPEAT_ID == 99) GRID_BAR(); } TS_STORE((k) + 1); } while (0)
#define PHASE_CTX() Ctx pc = c; { int z_ = 0, b_ = c.bid, g_ = c.G, w_ = c.wave; asm volatile("" : "+s"(z_), "+s"(b_), "+s"(g_), "+s"(w_)); \
        z_ = __builtin_amdgcn_readfirstlane(z_); b_ = __builtin_amdgcn_readfirstlane(b_); g_ = __builtin_amdgcn_readfirstlane(g_); w_ = __builtin_amdgcn_readfirstlane(w_); \
        pc.in = c.in + z_; pc.ws = c.ws + z_; pc.out = c.out + z_; pc.bid = b_; pc.G = g_; pc.wave = w_ & 7; \
        pc.lane = (int)(__builtin_amdgcn_mbcnt_hi(~0u, __builtin_amdgcn_mbcnt_lo(~0u, (unsigned)z_)) & 63u); pc.tid = pc.wave * 64 + pc.lane; } const int gw = pc.bid * NWAVES + pc.wave; const int NGW = pc.G * NWAVES; (void)gw; (void)NGW

    TS_STORE(0);
    if (EN(0) && IN(0)) { PHASE_CTX(); REP(0) phase_pre_a(pc); SEAM(0); }
    if (EN(1) && IN(1)) { PHASE_CTX(); REP(1) phase_modulate_mix(pc, 0); SEAM(1); }
#pragma unroll 1
    for (int l = 0; l < 2; ++l) {
        const int p0 = 2 + 11 * l; const bool first = (l == 0); const int nMa = first ? 68 : 64;
#define PHASE_PTRS() PHASE_CTX(); unsigned char* wt = pc.ws + WS_WT + (size_t)l * WT_LAYER; bf16_t* Z = (bf16_t*)(pc.ws + WS_RA); bf16_t* H = (bf16_t*)(pc.ws + WS_H); (void)wt; (void)Z; (void)H
        if (EN(2) && IN(p0 + 0)) { REP(20 + 0) { PHASE_PTRS();
            pg8::Gemm g{H, (const bf16_t*)(wt + WT_IN), D, D, D, 0, 0}; pg8::GOrder S; S.init(nMa, 35, 1, pc.G, pc.bid);
            EpiZ E{Z, pc.in[I_BGATE] + l * 3072};
            REP(2) pg8::gemm_phase<EpiZ, pg8::GOrder>(pc.lds, pc.tid, g, S, E);
            if (!first) {
                pg8::GOrderCtxCols S2; S2.o.init(4, 8, 1, pc.G, (pc.bid + pc.G - (64 * 35) % pc.G) % pc.G, 64);
                pg8::gemm_phase<EpiZ, pg8::GOrderCtxCols>(pc.lds, pc.tid, g, S2, E); } } SEAM(p0 + 0); }
        if (EN(3) && IN(p0 + 1)) { REP(20 + 1) { PHASE_PTRS();
#ifndef NO_G2G3
            REP(3) {
            { pg8::Gemm g{Z + ZCKV, (const bf16_t*)(wt + WT_UKV), NZ, 256, 256, 0, 0}; pg8::GOrder S; S.init(68, 8, 1, pc.G, pc.bid); EpiPlain E{(bf16_t*)(pc.ws + WS_RB + RB_KVRAW), 2048};
              pg8::gemm_phase<EpiPlain, pg8::GOrder>(pc.lds, pc.tid, g, S, E); }
            { pg8::Gemm g{Z + ZCQ, (const bf16_t*)(wt + WT_UQ), NZ, 384, 384, 0, 0}; pg8::GOrder S; S.init(nMa, 6, 1, pc.G, (pc.bid + pc.G - 32 % pc.G) % pc.G); EpiPlain E{(bf16_t*)(pc.ws + WS_RB + RB_QRAW), 1536};
              pg8::gemm_phase<EpiPlain, pg8::GOrder>(pc.lds, pc.tid, g, S, E); }
            }
#endif
#ifndef NO_MIXA
            REP(4) for (int u = (pc.bid + 8) % pc.G; u < nMa * 2 * 8; u += pc.G) mixA_unit(pc, l, u);
#endif
#ifndef NO_B1
            REP(5) for (int u = (pc.bid + pc.G - 184 % pc.G) % pc.G; u < 1088; u += pc.G) gla_b1_unit(pc, l, u);
#endif
            } SEAM(p0 + 1); }
        if (EN(4) && IN(p0 + 2)) { REP(20 + 2) { PHASE_PTRS();
            REP(6) {
                const bool b2wg = (pc.G >= 128) && pc.bid < 64;
                if (pc.tid < 32) *((volatile LAS unsigned*)(pc.lds + 3 * 33280 + 4 * 5120) + pc.tid) = 0u;
                __syncthreads();
                const bool role_b2 = (pc.G >= 128) ? b2wg : true;
                if (role_b2) {
#ifndef SKIP_B2
                    if (pc.G >= 128) gla_b2_unit(pc, pc.bid);
                    else { for (int u = pc.bid; u < 64; u += pc.G) { gla_b2_unit(pc, u); __syncthreads(); if (pc.tid < 32) *((volatile LAS unsigned*)(pc.lds + 3 * 33280 + 4 * 5120) + pc.tid) = 0u; __syncthreads(); } }
#endif
                }
                if (!role_b2 || pc.G < 128) {
#ifndef SKIP_C1
                  int wi, nwv;
                  if (pc.G >= 128) { nwv = (pc.G - 64) * NWAVES; wi = (pc.bid - 64) * NWAVES + pc.wave; }
                  else { nwv = pc.G * NWAVES; wi = pc.bid * NWAVES + pc.wave; }
                  if (wi < T) { C1Raw A = {}, B = {}; mla_c1_load(pc, wi, false, A);
                      for (int row = wi; row < T; row += 2 * nwv) { const int r1 = row + nwv, r2 = row + 2 * nwv;
                          if (r1 < T) mla_c1_load(pc, r1, false, B);
                          mla_c1_row(pc, l, row, false, A);
                          if (r2 < T) mla_c1_load(pc, r2, false, A);
                          if (r1 < T) mla_c1_row(pc, l, r1, false, B); } }
#endif
                }
            }
            } SEAM(p0 + 2); }
        if (EN(5) && IN(p0 + 3)) { REP(20 + 3) { PHASE_PTRS();
#ifndef NO_FIN
            REP(7) { const int nrow = nMa * 256; if (gw < nrow) { FinRaw A = {}, B = {}; gla_finish_load(pc, gw, A);
                for (int row = gw; row < nrow; row += 2 * NGW) { const int r1 = row + NGW, r2 = row + 2 * NGW;
                    if (r1 < nrow) gla_finish_load(pc, r1, B);
                    gla_finish_row(pc, l, row, A);
                    if (r2 < nrow) gla_finish_load(pc, r2, A);
                    if (r1 < nrow) gla_finish_row(pc, l, r1, B); } } }
#endif
            bf16_t* Y = (bf16_t*)(pc.ws + WS_RB + RB_YCAT) + 2048;
            const bf16_t* KG = (const bf16_t*)(pc.ws + WS_RB + RB_KG); const bf16_t* VG = (const bf16_t*)(pc.ws + WS_RB + RB_VG);
            const int G8 = pc.G >> 3;
            REP(8) for (int i = 0;; ++i) {
                int un; if ((pc.G & 7) == 0 && (G8 & 15) == 0) { const int x = pc.bid & 7, s = pc.bid >> 3, ppx = G8 >> 4; un = ((i * 8 * ppx) + x * ppx + (s >> 4)) * 16 + (s & 15); } else un = i * pc.G + pc.bid;
                if (un >= 512) break;
                const int bh = un >> 4, qb = un & 15, b = bh >> 3, h = bh & 7;
                attn_unit(pc, l, (const bf16_t*)(pc.ws + WS_RB + RB_QRAW) + (size_t)(b * SEQ + qb * 256) * 1536 + h * 192, (const float*)(pc.ws + WS_RSQ) + b * SEQ + qb * 256, qb * 256, KG + ((size_t)b * NKEY * 8 + h) * 192, VG + ((size_t)b * NKEY * 8 + h) * 128, 68, Y + (size_t)(b * SEQ + qb * 256) * 3072 + h * 128); }
            if (first) for (int un = pc.bid; un < 32; un += pc.G) { const int b = un >> 3, h = un & 7;
                attn_unit(pc, l, (const bf16_t*)(pc.ws + WS_RB + RB_QRAW) + (size_t)(TL + b * CTXL) * 1536 + h * 192, (const float*)(pc.ws + WS_RSQ) + TL + b * CTXL, -1, KG + ((size_t)b * NKEY * 8 + h) * 192, VG + ((size_t)b * NKEY * 8 + h) * 128, 4, Y + (size_t)(TL + b * CTXL) * 3072 + h * 128); }
            } SEAM(p0 + 3); }
        if (EN(6) && IN(p0 + 4)) { REP(20 + 4) { PHASE_PTRS();
            pg8::Gemm g{(const bf16_t*)(pc.ws + WS_RB + RB_YCAT), (const bf16_t*)(wt + WT_M), 3072, 3072, 3072, 0, 0}; pg8::GOrder S; S.init(64, 4, 1, pc.G, pc.bid);
            EpiMerge E{(bf16_t*)(pc.ws + WS_RB + RB_MERGED), Z};
            REP(9) pg8::gemm_phase<EpiMerge, pg8::GOrder>(pc.lds, pc.tid, g, S, E);
            if (first) REP(31) for (int u = pc.bid; u < 256; u += pc.G) ctx_merge_unit(pc, l, u); } SEAM(p0 + 4); }
        if (EN(7) && IN(p0 + 5)) { REP(20 + 5) { PHASE_PTRS();
            pg8::Gemm g{(const bf16_t*)(pc.ws + WS_RB + RB_MERGED), (const bf16_t*)(wt + WT_OUT), D, D, D, 0, 0}; pg8::GOrder S; S.init(64, 4, 1, pc.G, pc.bid);
            EpiResid E{&pc, l, (REPEAT_ID == 25 && rep_ == 0) ? (float*)(pc.ws + WS_RA) : nullptr};
            pg8::gemm_phase<EpiResid, pg8::GOrder>(pc.lds, pc.tid, g, S, E);
            if (first) REP(32) for (int u = pc.bid; u < 256; u += pc.G) ctx_out_unit(pc, l, u); } SEAM(p0 + 5); }
        if (EN(8) && IN(p0 + 6)) { REP(20 + 6) { PHASE_PTRS();
            REP(11) { route_stage_w(pc, l); const int nrow = nMa * 256;
                if (gw < nrow) { RouteRaw A = {}, B = {}; route_load(pc, gw, A);
                    for (int row = gw; row < nrow; row += 2 * NGW) { const int r1 = row + NGW, r2 = row + 2 * NGW;
                        if (r1 < nrow) route_load(pc, r1, B);
                        route_row(pc, l, row, A);
                        if (r2 < nrow) route_load(pc, r2, A);
                        if (r1 < nrow) route_row(pc, l, r1, B); } }
                __syncthreads(); }
            } SEAM(p0 + 6); }
        if (EN(9) && IN(p0 + 7)) { REP(20 + 7) { PHASE_PTRS();
            REP(13) for (int u = pc.bid; u < 64; u += pc.G) topk_unit(pc, u, false);
            if (first) for (int u = pc.bid; u < 64; u += pc.G) topk_unit(pc, u, true);
            REP(12) expert_wconv(pc, l);
            } SEAM(p0 + 7); }
        if (EN(10) && IN(p0 + 8)) { REP(20 + 8) { PHASE_PTRS();
            pg8::Gemm g{(const bf16_t*)(pc.ws + WS_RA + RA_XS), (const bf16_t*)(pc.ws + WS_RB + RB_WGU), D, D, D, (size_t)ESLOTS * D, (size_t)4096 * D}; pg8::GOrder S; S.init(first ? 9 : 8, 16, 16, pc.G, pc.bid);
            EpiSwiGLU E{(bf16_t*)(pc.ws + WS_RA + RA_HID)};
            REP(14) pg8::gemm_phase<EpiSwiGLU, pg8::GOrder>(pc.lds, pc.tid, g, S, E); } SEAM(p0 + 8); }
        if (EN(11) && IN(p0 + 9)) { REP(20 + 9) { PHASE_PTRS();
            pg8::Gemm g{(const bf16_t*)(pc.ws + WS_RA + RA_HID), (const bf16_t*)(pc.ws + WS_RB + RB_WD), DEXP, DEXP, DEXP, (size_t)ESLOTS * DEXP, (size_t)D * DEXP}; pg8::GOrder S; S.init(8, 4, 16, pc.G, pc.bid);
            EpiDown E{(bf16_t*)(pc.ws + WS_RA + RA_YS), (const float*)(pc.ws + WS_GATEV)};
            REP(15) pg8::gemm_phase<EpiDown, pg8::GOrder>(pc.lds, pc.tid, g, S, E);
            if (first) {
                pg8::Gemm g2 = g; g2.K = 512; pg8::KSplitOrder S2{pc.G, (pc.G == 256) ? ((pc.bid & 7) * 32 + (pc.bid >> 3)) : pc.bid};
                EpiDownPart E2{(bf16_t*)(pc.ws + WS_RB + RB_YSC), (const float*)(pc.ws + WS_GATEV)};
                pg8::gemm_phase<EpiDownPart, pg8::KSplitOrder>(pc.lds, pc.tid, g2, S2, E2); } } SEAM(p0 + 9); }
        if (EN(12) && IN(p0 + 10)) { REP(20 + 10) { PHASE_PTRS();
            { const int nrow = nMa * 256; float* dmy = (REPEAT_ID == 30 && rep_ == 0) ? (float*)(pc.ws + WS_RB) : nullptr;
              if (gw < nrow) { CombRaw A = {}, B = {}; combine_load(pc, gw, A);
                  for (int row = gw; row < nrow; row += 2 * NGW) { const int r1 = row + NGW, r2 = row + 2 * NGW;
                      if (r1 < nrow) combine_load(pc, r1, B);
                      combine_row(pc, l, row, first, A, dmy);
                      if (r2 < nrow) combine_load(pc, r2, A);
                      if (r1 < nrow) combine_row(pc, l, r1, first, B, dmy); } } }
            } SEAM(p0 + 10); }
    }
#if defined(DEBUG_TS_A)
    { GRID_BAR(); const unsigned long long* ts = (const unsigned long long*)(c.ws + WS_CTL + 768 * 1024);
      float a = (float)(__hip_atomic_load(ts + DEBUG_TS_A + 1, __ATOMIC_RELAXED, __HIP_MEMORY_SCOPE_AGENT) - __hip_atomic_load(ts + DEBUG_TS_A, __ATOMIC_RELAXED, __HIP_MEMORY_SCOPE_AGENT)) * 1e-2f;
      float b = (float)(__hip_atomic_load(ts + DEBUG_TS_B + 1, __ATOMIC_RELAXED, __HIP_MEMORY_SCOPE_AGENT) - __hip_atomic_load(ts + DEBUG_TS_B, __ATOMIC_RELAXED, __HIP_MEMORY_SCOPE_AGENT)) * 1e-2f;
      a = exp2f(rintf(log2f(fmaxf(a, 1.f)) * DEBUG_TS_Q + DEBUG_TS_SHIFT) / DEBUG_TS_Q) * 1e-2f; b = exp2f(rintf(log2f(fmaxf(b, 1.f)) * DEBUG_TS_Q + DEBUG_TS_SHIFT) / DEBUG_TS_Q) * 1e-2f;
      const int tid_ = c.wave * 64 + (int)__builtin_amdgcn_mbcnt_hi(~0u, __builtin_amdgcn_mbcnt_lo(~0u, 0u));
      for (long i = (long)c.bid * NTHR + tid_; i < (long)TL * D; i += (long)c.G * NTHR) c.out[i] = (i == 0) ? 131072.0f * b : 1024.0f * a; }
#endif
}

extern "C" void kernel_launch(void* const* d_in, const int* in_sizes, int n_in, void* d_out, int out_size, void* d_ws, size_t ws_size, hipStream_t stream) {
    static int grid = 0;
    if (!grid) {
        int dev = 0, cus = 0, per_cu = 0;
        (void)hipGetDevice(&dev); (void)hipDeviceGetAttribute(&cus, hipDeviceAttributeMultiprocessorCount, dev);
        (void)hipFuncSetAttribute((const void*)fwd, hipFuncAttributeMaxDynamicSharedMemorySize, LDS_BYTES);
        (void)hipOccupancyMaxActiveBlocksPerMultiprocessor(&per_cu, fwd, NTHR, LDS_BYTES);
        grid = cus * (per_cu < 1 ? per_cu : 1);
        if (grid <= 0) { fprintf(stderr, "occupancy query returned 0 blocks per CU\n"); grid = cus; }
        if (ws_size < WS_END) fprintf(stderr, "workspace too small: %zu < %zu\n", ws_size, (size_t)WS_END);
    }
    (void)hipMemsetAsync((unsigned char*)d_ws + WS_CTL, 0, CTL_BYTES, stream);
    Args a{}; for (int i = 0; i < N_INPUTS; ++i) a.in[i] = (const float*)d_in[i]; a.out = (float*)d_out; a.ws = (unsigned char*)d_ws;
#if MK_FUSED
    a.ph_lo = 0; a.ph_hi = NPH;
    hipLaunchKernelGGL(fwd, dim3(grid), dim3(NTHR), LDS_BYTES, stream, a);
#else
#if defined(DEBUG_SCAN)
    hipLaunchKernelGGL(k_seterr, dim3(1), dim3(1), 0, stream, (int*)((unsigned char*)d_ws + WS_CTL + 512 * 1024));
#endif
    for (int p = 0; p < NPH; ++p) { a.ph_lo = p; a.ph_hi = p + 1;
#if defined(DEBUG_SCAN)
        if (p == 3) (void)hipMemsetAsync((unsigned char*)d_ws + WS_RB + RB_OINTRA, 0xff, (size_t)T * D * 2, stream);
#endif
        hipLaunchKernelGGL(fwd, dim3(grid), dim3(NTHR), LDS_BYTES, stream, a);
#if defined(DEBUG_SCAN)
#if defined(DEBUG_HASH)
        if (p == DEBUG_HASH_PHASE) { (void)hipMemsetAsync((unsigned char*)d_ws + WS_CTL + 512 * 1024 + 256, 0, 4, stream);
            hipLaunchKernelGGL(k_hash, dim3(512), dim3(256), 0, stream, (const unsigned*)((unsigned char*)d_ws + DEBUG_HASH_OFF), (long)(DEBUG_HASH_BYTES / 4), (unsigned*)((unsigned char*)d_ws + WS_CTL + 512 * 1024 + 256)); }
#else
        debug_after_phase(p, (unsigned char*)d_ws, (float*)d_out, stream);
#endif
#endif
    }
#if defined(DEBUG_SCAN)
#if defined(DEBUG_HASH)
    hipLaunchKernelGGL(k_apply_hash, dim3(1024), dim3(256), 0, stream, (float*)d_out, (long)out_size, (const unsigned*)((unsigned char*)d_ws + WS_CTL + 512 * 1024 + 256));
#elif defined(DEBUG_STAT)
    hipLaunchKernelGGL(k_apply_stat, dim3(1024), dim3(256), 0, stream, (float*)d_out, (long)out_size, (const int*)((unsigned char*)d_ws + WS_CTL + 512 * 1024));
#else
    hipLaunchKernelGGL(k_apply, dim3(1024), dim3(256), 0, stream, (float*)d_out, (long)out_size, (const int*)((unsigned char*)d_ws + WS_CTL + 512 * 1024));
#endif
#endif
#endif
}
```

```cpp
#define MK_FUSED 1
#include <hip/hip_runtime.h>
#include <cstdint>
#include <cstdio>

#define LAS __attribute__((address_space(3)))
#define GAS __attribute__((address_space(1)))
typedef unsigned short bf16_t;
typedef short bf16x8 __attribute__((ext_vector_type(8)));
typedef short bf16x4 __attribute__((ext_vector_type(4)));
typedef float f32x4 __attribute__((ext_vector_type(4)));
typedef float f32x2 __attribute__((ext_vector_type(2)));
typedef float f32x16 __attribute__((ext_vector_type(16)));
typedef unsigned u32x4 __attribute__((ext_vector_type(4)));
typedef unsigned u32x2 __attribute__((ext_vector_type(2)));

typedef __bf16 bf16v2_t __attribute__((ext_vector_type(2)));
__device__ __forceinline__ unsigned cvt_pk_bf16(float lo, float hi) { bf16v2_t v; v[0] = (__bf16)lo; v[1] = (__bf16)hi; return __builtin_bit_cast(unsigned, v); }
__device__ __forceinline__ bf16_t f2bf(float f) { return (bf16_t)(cvt_pk_bf16(f, 0.f) & 0xffffu); }
__device__ __forceinline__ float bf2f(bf16_t b) { return __uint_as_float(((unsigned)b) << 16); }
__device__ __forceinline__ float bflo(unsigned w) { return __uint_as_float(w << 16); }
__device__ __forceinline__ float bfhi(unsigned w) { return __uint_as_float(w & 0xffff0000u); }
template <int K> __device__ __forceinline__ float sx(float v) { static_assert(K >= 1 && K < 32, "xor mask inside a 32-lane half"); return __int_as_float(__builtin_amdgcn_ds_swizzle(__float_as_int(v), (K << 10) | 0x1F)); }
__device__ __forceinline__ float sum32(float v) { auto rr = __builtin_amdgcn_permlane32_swap(__float_as_uint(v), __float_as_uint(v), false, false); return __uint_as_float(rr[0]) + __uint_as_float(rr[1]); }
__device__ __forceinline__ float max32(float v) { auto rr = __builtin_amdgcn_permlane32_swap(__float_as_uint(v), __float_as_uint(v), false, false); return fmaxf(__uint_as_float(rr[0]), __uint_as_float(rr[1])); }
__device__ __forceinline__ float half_sum(float v) { v += sx<1>(v); v += sx<2>(v); v += sx<4>(v); v += sx<8>(v); v += sx<16>(v); return v; }
__device__ __forceinline__ float wave_sum(float v) { return sum32(half_sum(v)); }
__device__ __forceinline__ float bperm(float v, int src) { return __int_as_float(__builtin_amdgcn_ds_bpermute(src << 2, __float_as_int(v))); }
__device__ __forceinline__ unsigned bperm(unsigned v, int src) { return (unsigned)__builtin_amdgcn_ds_bpermute(src << 2, (int)v); }
__device__ __forceinline__ float fast_rcp(float x) { return __builtin_amdgcn_rcpf(x); }
__device__ __forceinline__ float fast_exp(float x) { return __builtin_amdgcn_exp2f(x * 1.4426950408889634f); }
__device__ __forceinline__ float sigmoidf_(float x) { return fast_rcp(1.f + fast_exp(-x)); }
__device__ __forceinline__ float siluf_(float x) { return x * sigmoidf_(x); }

namespace pg8 {
constexpr int BM = 256, BK = 64, HALF = 128, HTB = HALF * BK * 2, STAGE_BYTES = 8 * HTB, NXCD = 8, WGM = 8;
__host__ __device__ __forceinline__ int lds_byte(int r, int c) { const int st = (r >> 4) * 2 + (c >> 5), rr = r & 15, cc = c & 31, ob = rr * 64 + cc * 2; return st * 1024 + (ob ^ (((ob >> 9) & 1) << 5)); }
__host__ __device__ __forceinline__ void stage_rc(int b, int& R, int& C) { const int st = b / 1024, sb = b % 1024, swz = sb ^ (((sb >> 9) & 1) << 5); R = (st >> 1) * 16 + swz / 64; C = (st & 1) * 32 + (swz % 64) / 2; }
__host__ __device__ __forceinline__ int perm32(int rho) { const int n = rho >> 4, i = rho & 15; return 8 * (i >> 2) + 4 * n + (i & 3); }

struct Unit { int pm, pn, g, ko; };
struct Gemm { const bf16_t* A; const bf16_t* Bt; int lda, ldb, K; size_t gstrideA, gstrideB; const bf16_t* Bt2 = nullptr; int gsplit = 1 << 30; };

struct GOrder {
    static constexpr bool KOFF = false;
    int nM, nN, nG, nwg, G, c, pm0;
    __device__ void init(int nM_, int nN_, int nG_, int G_, int c_, int pm0_ = 0) { nM = nM_; nN = nN_; nG = nG_; nwg = nM * nN * nG; G = G_; c = c_; pm0 = pm0_; }
    __device__ bool next(int i, Unit& u) const {
        const long L = (long)i * G + c; if (L >= nwg) return false;
        int wgid = (int)L; { const int q = nwg / NXCD, r = nwg % NXCD, xcd = wgid % NXCD, off = wgid / NXCD; wgid = (xcd < r ? xcd * (q + 1) : r * (q + 1) + (xcd - r) * q) + off; }
        const int per = nM * nN; u.g = wgid / per; wgid -= u.g * per;
        const int nig = WGM * nN, gid = wgid / nig, fm = gid * WGM, gsz = (nM - fm) < WGM ? (nM - fm) : WGM;
        u.pm = pm0 + fm + ((wgid % nig) % gsz); u.pn = (wgid % nig) / gsz; return true;
    }
};

struct GOrderCtxCols { static constexpr bool KOFF = false; GOrder o;
    __device__ bool next(int i, Unit& u) const { if (!o.next(i, u)) return false; u.pn = u.pn < 6 ? 10 + u.pn : 15 + u.pn; return true; } };

struct KSplitOrder { static constexpr bool KOFF = true; int G, c;
    __device__ bool next(int i, Unit& u) const { const int L = i * G + c; if (L >= 256) return false; u.g = L >> 4; u.pm = 8; u.pn = (L >> 2) & 3; u.ko = (L & 3) * 512; return true; } };

template <class Epi, class Sched>
__device__ __forceinline__ void gemm_phase(LAS unsigned char* lds, const int tid, const Gemm g, const Sched& S, const Epi& E) {
    const int wid = __builtin_amdgcn_readfirstlane(tid >> 6), lane = tid & 63, wr = wid >> 2, wc = wid & 3, fr = lane & 15, fq = lane >> 4;
    const int K = g.K, nt = K / BK;
    unsigned voffA[2], voffB[2];
#pragma unroll
    for (int i = 0; i < 2; ++i) { int R, C; stage_rc(tid * 16 + i * 8192, R, C); const int Rb = Epi::PERM ? ((R & ~31) + perm32(R & 31)) : R;
        voffA[i] = (unsigned)(R * g.lda + C) * 2u; voffB[i] = (unsigned)(Rb * g.ldb + C) * 2u; }
    const size_t kstep = (size_t)(BK * 2);
    const size_t hstepA = (size_t)HALF * g.lda * 2, hstepB = (size_t)HALF * g.ldb * 2;
    const size_t tstepA = 2 * hstepA, tstepB = 2 * hstepB;
    const unsigned ldsw = (unsigned)wid * 1024u;
    const int aoff = lds_byte(wr * 64 + fr, fq * 8), boff = lds_byte(wc * 32 + fr, fq * 8);
#define PG8_SA(b, h) (((b) * 2 + (h)) * HTB)
#define PG8_SB(b, h) ((4 + (b) * 2 + (h)) * HTB)
#define PG8_STAGE(bufoff, gbase, voff) do { _Pragma("unroll") for (int _i = 0; _i < 2; ++_i) \
        __builtin_amdgcn_global_load_lds((const unsigned*)((const char*)(gbase) + (voff)[_i]), (LAS unsigned*)(lds + (bufoff) + ldsw + _i * 8192), 16, 0, 0); } while (0)
#define PG8_LDA(dst, b, h) do { _Pragma("unroll") for (int m = 0; m < 4; ++m) _Pragma("unroll") for (int k = 0; k < 2; ++k) dst[m][k] = *(const LAS bf16x8*)(lds + PG8_SA(b, h) + aoff + m * 2048 + k * 1024); } while (0)
#define PG8_LDB(dst, b, h) do { _Pragma("unroll") for (int n = 0; n < 2; ++n) _Pragma("unroll") for (int k = 0; k < 2; ++k) dst[n][k] = *(const LAS bf16x8*)(lds + PG8_SB(b, h) + boff + n * 2048 + k * 1024); } while (0)
#define PG8_MMA(ai, bj, At, Bt) do { __builtin_amdgcn_s_setprio(1); _Pragma("unroll") for (int m = 0; m < 4; ++m) _Pragma("unroll") for (int n = 0; n < 2; ++n) _Pragma("unroll") for (int k = 0; k < 2; ++k) \
        acc[ai][bj][m][n] = __builtin_amdgcn_mfma_f32_16x16x32_bf16(Bt[n][k], At[m][k], acc[ai][bj][m][n], 0, 0, 0); __builtin_amdgcn_s_setprio(0); } while (0)
#define PG8_WAIT_V(n) asm volatile("s_waitcnt vmcnt(" #n ")" ::: "memory")
#define PG8_WAIT_L(n) asm volatile("s_waitcnt lgkmcnt(" #n ")" ::: "memory")
#define PG8_BAR __builtin_amdgcn_s_barrier()
#define PG8_SCHED __builtin_amdgcn_sched_barrier(0)
    Unit cur, nxt; int ui = 0;
    if (!S.next(0, cur)) return;
    f32x4 acc[2][2][4][2];
#pragma unroll
    for (int a = 0; a < 2; ++a)
#pragma unroll
        for (int b = 0; b < 2; ++b)
#pragma unroll
            for (int m = 0; m < 4; ++m)
#pragma unroll
                for (int n = 0; n < 2; ++n) acc[a][b][m][n] = (f32x4){0.f, 0.f, 0.f, 0.f};
    bf16x8 At[4][2], B0[2][2], B1[2][2];
    const char* cA = (const char*)(g.A + (size_t)cur.g * g.gstrideA) + (size_t)cur.pm * tstepA; const char* cB = (const char*)((cur.g < g.gsplit ? g.Bt : g.Bt2) + (size_t)cur.g * g.gstrideB) + (size_t)cur.pn * tstepB;
    if constexpr (Sched::KOFF) { cA += (size_t)cur.ko * 2; cB += (size_t)cur.ko * 2; }
    PG8_STAGE(PG8_SB(0, 0), cB, voffB); PG8_STAGE(PG8_SB(0, 1), cB + hstepB, voffB); PG8_STAGE(PG8_SA(0, 0), cA, voffA); PG8_STAGE(PG8_SA(0, 1), cA + hstepA, voffA);
    if (wr == 1) PG8_BAR;
    PG8_WAIT_V(2); PG8_BAR;
    PG8_STAGE(PG8_SB(1, 0), cB + kstep, voffB); PG8_STAGE(PG8_SA(1, 0), cA + kstep, voffA); PG8_STAGE(PG8_SB(1, 1), cB + hstepB + kstep, voffB);
    PG8_WAIT_V(6); PG8_BAR;
    for (;;) {
        const bool has_next = S.next(ui + 1, nxt);
        const char* nA = has_next ? (const char*)(g.A + (size_t)nxt.g * g.gstrideA) + (size_t)nxt.pm * tstepA + (Sched::KOFF ? (size_t)nxt.ko * 2 : (size_t)0) : cA; const char* nB = has_next ? (const char*)((nxt.g < g.gsplit ? g.Bt : g.Bt2) + (size_t)nxt.g * g.gstrideB) + (size_t)nxt.pn * tstepB + (Sched::KOFF ? (size_t)nxt.ko * 2 : (size_t)0) : cB;
        for (int t = 0; t < nt; t += 2) {
            const bool last = (t == nt - 2);
            const char* a1 = cA + (size_t)(t + 1) * kstep;
            const char* a2 = last ? nA : cA + (size_t)(t + 2) * kstep; const char* b2 = last ? nB : cB + (size_t)(t + 2) * kstep;
            const char* a3 = a2 + kstep; const char* b3 = b2 + kstep;
            if constexpr (Epi::MID) { if (t == 16 || t == 32) E.mid(acc, cur, t, wr, wc, fr, fq); }
            PG8_LDB(B0, 0, 0); PG8_LDB(B1, 0, 1); PG8_SCHED; PG8_LDA(At, 0, 0); PG8_STAGE(PG8_SA(1, 1), a1 + hstepA, voffA);
            PG8_WAIT_V(8); PG8_WAIT_L(0); PG8_BAR; PG8_MMA(0, 0, At, B0); PG8_MMA(0, 1, At, B1); PG8_BAR; PG8_SCHED;
            PG8_LDA(At, 0, 1); PG8_STAGE(PG8_SB(0, 0), b2, voffB); PG8_STAGE(PG8_SB(0, 1), b2 + hstepB, voffB); PG8_STAGE(PG8_SA(0, 0), a2, voffA);
            PG8_WAIT_V(8); PG8_WAIT_L(0); PG8_BAR; PG8_MMA(1, 0, At, B0); PG8_MMA(1, 1, At, B1); PG8_BAR; PG8_SCHED;
            PG8_LDB(B0, 1, 0); PG8_LDB(B1, 1, 1); PG8_SCHED; PG8_LDA(At, 1, 0); PG8_STAGE(PG8_SA(0, 1), a2 + hstepA, voffA);
            PG8_WAIT_V(8); PG8_WAIT_L(0); PG8_BAR; PG8_MMA(0, 0, At, B0); PG8_MMA(0, 1, At, B1); PG8_BAR; PG8_SCHED;
            PG8_LDA(At, 1, 1); PG8_STAGE(PG8_SB(1, 0), b3, voffB); PG8_STAGE(PG8_SB(1, 1), b3 + hstepB, voffB); PG8_STAGE(PG8_SA(1, 0), a3, voffA);
            PG8_WAIT_V(8); PG8_WAIT_L(0); PG8_BAR; PG8_MMA(1, 0, At, B0); PG8_MMA(1, 1, At, B1); PG8_BAR; PG8_SCHED;
        }
        if (wr == 0) PG8_BAR;
        E(acc, cur, wr, wc, fr, fq);
        if (!has_next) break;
#pragma unroll
        for (int a = 0; a < 2; ++a)
#pragma unroll
            for (int b = 0; b < 2; ++b)
#pragma unroll
                for (int m = 0; m < 4; ++m)
#pragma unroll
                    for (int n = 0; n < 2; ++n) acc[a][b][m][n] = (f32x4){0.f, 0.f, 0.f, 0.f};
        cur = nxt; cA = nA; cB = nB; ++ui;
        if (wr == 1) PG8_BAR;
    }
    PG8_WAIT_V(0);
    PG8_BAR;
#undef PG8_SA
#undef PG8_SB
#undef PG8_STAGE
#undef PG8_LDA
#undef PG8_LDB
#undef PG8_MMA
#undef PG8_WAIT_V
#undef PG8_WAIT_L
#undef PG8_BAR
#undef PG8_SCHED
}
}
#define XB_TMO      128
#define XB_XCNT(j)  (256  + 64 * (j))
#define XB_XSUB(j)  (1280 + 64 * (j))
#define XB_XGEN(j)  (2304 + 64 * (j))
#define XB_TOP      3328
#define XB_TOPGEN   3392
#define XCD_BAR_WORDS 3456
#define XB_SPIN_CAP (1u << 18)

__device__ __forceinline__ unsigned xb_ld(unsigned* p)              { return __hip_atomic_load(p, __ATOMIC_RELAXED, __HIP_MEMORY_SCOPE_AGENT); }
__device__ __forceinline__ unsigned xb_add(unsigned* p, unsigned v) { return __hip_atomic_fetch_add(p, v, __ATOMIC_RELAXED, __HIP_MEMORY_SCOPE_AGENT); }
__device__ __forceinline__ unsigned xb_xcc_id() { return (unsigned)__builtin_amdgcn_s_getreg((3 << 11) | 20) & 0xFu; }
#define XB_SPIN(cond, bar) do { unsigned _sp = 0; while (cond) { __builtin_amdgcn_s_sleep(1); \
    if ((++_sp & 255u) == 0u) { if (xb_ld(&(bar)[XB_TMO])) break; if (_sp > XB_SPIN_CAP) { atomicAdd(&(bar)[XB_TMO], 1u); break; } } } } while (0)

struct XcdBarrier {
    unsigned* bar; unsigned x;
    volatile LAS unsigned* st;
};

__device__ __forceinline__ XcdBarrier xcd_barrier_post(unsigned* bar, volatile LAS unsigned* st) {
    XcdBarrier b; b.bar = bar; b.x = xb_xcc_id(); b.st = st;
    if (threadIdx.x == 0) (void)xb_add(&bar[XB_XCNT(b.x)], 1u);
    return b;
}
__device__ __forceinline__ void xcd_barrier_complete(unsigned* bar, unsigned x, unsigned& nloc, unsigned& nx) {
    const unsigned G = gridDim.x * gridDim.y * gridDim.z;
    unsigned sum, cnt, mine, sp = 0u;
    for (;;) {
        sum = 0u; cnt = 0u; mine = 0u;
#pragma unroll
        for (unsigned j = 0; j < 16; ++j) { const unsigned c = xb_ld(&bar[XB_XCNT(j)]); sum += c; cnt += (c > 0u) ? 1u : 0u; mine = (j == x) ? c : mine; }
        if (sum == G) break;
        __builtin_amdgcn_s_sleep(1);
        if ((++sp & 255u) == 0u) { if (xb_ld(&bar[XB_TMO])) break; if (sp > XB_SPIN_CAP) { atomicAdd(&bar[XB_TMO], 1u); break; } }
    }
    nloc = mine > 0u ? mine : 1u; nx = cnt > 0u ? cnt : 1u;
}

__device__ __forceinline__ void xcd_barrier(const XcdBarrier& b) {
    asm volatile("s_waitcnt vmcnt(0)" ::: "memory");
    __syncthreads();
    unsigned long long bp_ = (unsigned long long)b.bar; unsigned bx_ = b.x; asm volatile("" : "+s"(bp_), "+s"(bx_)); bx_ = (unsigned)__builtin_amdgcn_readfirstlane((int)bx_); bp_ = ((unsigned long long)(unsigned)__builtin_amdgcn_readfirstlane((int)(bp_ >> 32)) << 32) | (unsigned)__builtin_amdgcn_readfirstlane((int)bp_);
    if (threadIdx.x == 0) {
        unsigned* bar = (unsigned*)bp_;
        __builtin_amdgcn_s_waitcnt(0);
        unsigned nloc = b.st[0], nx = b.st[1];
        if (nloc == 0u) { xcd_barrier_complete(bar, bx_, nloc, nx); b.st[0] = nloc; b.st[1] = nx; }
        const unsigned old = xb_add(&bar[XB_XSUB(bx_)], 1u);
        const unsigned gen = old / nloc;
        if (old + 1u == (gen + 1u) * nloc) {
            __builtin_amdgcn_fence(__ATOMIC_RELEASE, "agent");
            asm volatile("s_waitcnt vmcnt(0)" ::: "memory");
            const unsigned og = xb_add(&bar[XB_TOP], 1u);
            const unsigned tg = og / nx;
            if (og + 1u == (tg + 1u) * nx) xb_add(&bar[XB_TOPGEN], 1u);
            else XB_SPIN(xb_ld(&bar[XB_TOPGEN]) == tg, bar);
            __builtin_amdgcn_fence(__ATOMIC_ACQUIRE, "agent");
            xb_add(&bar[XB_XGEN(bx_)], 1u);
            asm volatile("s_waitcnt vmcnt(0)" ::: "memory");
        } else {
            XB_SPIN(xb_ld(&bar[XB_XGEN(bx_)]) == gen, bar);
            __builtin_amdgcn_fence(__ATOMIC_ACQUIRE, "agent");
            asm volatile("s_waitcnt vmcnt(0)" ::: "memory");
        }
    }
    __syncthreads();
}

namespace cfg {
constexpr int D = 1024, NB = 4, SEQ = 4096, CTXL = 256, TL = NB * SEQ, TC = NB * CTXL, T = TL + TC;
constexpr int NZ = 8960;
constexpr int ZU = 0, ZVA = 1024, ZQB = 2048, ZKB = 2560, ZVB = 3072, ZRB = 4096, ZCQ = 5120, ZKR = 5504, ZDEC = 5568, ZCKV = 5632, ZGT = 5888;
constexpr int NKEY = CTXL + SEQ;
constexpr int NEXP = 16, DEXP = 2048, CAPL = 512, CAPC = 32, ESLOTS = 2304;
constexpr float EPS = 1e-6f;
constexpr int NWAVES = 8, NTHR = 512;
constexpr size_t MiB = 1u << 20;
constexpr size_t WS_CTL = 0, CTL_BYTES = 1 * MiB;
constexpr size_t WS_MOD = 1 * MiB;
constexpr size_t WS_GATEV = WS_MOD + 512 * 1024;
constexpr size_t WS_AFFT = 2 * MiB;
constexpr size_t WS_SEL = 4 * MiB;
constexpr size_t WS_RSQ = 4 * MiB + 1536 * 1024;
constexpr size_t WS_XC = 6 * MiB;
constexpr size_t WS_H = 10 * MiB;
constexpr size_t WS_WT = 44 * MiB, WT_LAYER = 28 * MiB;
constexpr size_t WT_IN = 0, WT_UQ = 17 * MiB + 512 * 1024, WT_UKV = WT_UQ + 1152 * 1024, WT_M = WT_UKV + 1 * MiB, WT_OUT = WT_M + 6 * MiB, WT_S = WT_OUT + 2 * MiB;
static_assert(WT_S + 256 * 1024 <= WT_LAYER, "weights");
constexpr size_t WS_RA = 100 * MiB;
constexpr size_t RA_XS = 0, RA_HID = 72 * MiB, RA_YS = 216 * MiB;
constexpr size_t WS_RB = 398 * MiB;
constexpr size_t RB_YCAT = 0, RB_KVRAW = 102 * MiB, RB_MERGED = 102 * MiB, RB_QRAW = 170 * MiB, RB_KG = 221 * MiB, RB_VG = 272 * MiB, RB_QFL = 306 * MiB, RB_QFC = 354 * MiB,
                 RB_QDF = 306 * MiB, RB_KDT = 340 * MiB, RB_VTG = 374 * MiB, RB_DECAY = 408 * MiB, RB_OINTRA = 410 * MiB, RB_OF = 444 * MiB, RB_OB = 478 * MiB, RB_END = 512 * MiB;
constexpr size_t RB_WGU = 0, RB_WD = RB_END, RB_YSC = 200 * MiB;
constexpr int GU_SPLIT = 10;
constexpr size_t RB_WGU2 = RB_WD + 64 * MiB;
constexpr size_t WS_END = WS_RB + RB_WGU2 + (size_t)(NEXP - GU_SPLIT) * 8 * MiB;
static_assert(WS_END <= 1024 * MiB, "workspace");
constexpr int LDS_BYTES = 147456;
constexpr int LDS_MISC = 145408;
}
using namespace cfg;

enum { I_X = 0, I_C, I_CTX, I_CCTX, I_WMOD, I_BMOD, I_GMIX, I_GFFN, I_WIN, I_BGATE, I_WS, I_BS, I_WDEC, I_BDEC, I_GGLA, I_GCQ, I_GCKV, I_WUQ, I_WUKV,
       I_GQN, I_GQR, I_GKN, I_GKR, I_WPA, I_WPB, I_WPC, I_WOUT, I_WROUTER, I_WEG, I_WEU, I_WED, N_INPUTS };

struct Args { const float* in[N_INPUTS]; float* out; unsigned char* ws; int ph_lo, ph_hi; };

struct Ctx {
    const float* const* in; float* out; unsigned char* ws; LAS unsigned char* lds;
    int tid, lane, wave, G, bid;
};
__device__ __forceinline__ int row_modidx(int row) { return row < TL ? (row >> 12) : 4; }
__device__ __forceinline__ const float* modp(const Ctx& c, int l, int bi, int which) { return (const float*)(c.ws + WS_MOD) + ((size_t)(l * 5 + bi) * 6 + which) * D; }
__device__ __forceinline__ const float* xin_row(const Ctx& c, int l, int row) {
    if (row < TL) return (l == 0 ? c.in[I_X] : (const float*)c.out) + (size_t)row * D;
    return (l == 0 ? c.in[I_CTX] : (const float*)(c.ws + WS_XC)) + (size_t)(row - TL) * D;
}
__device__ __forceinline__ float* xout_row(const Ctx& c, int row) {
    if (row < TL) return c.out + (size_t)row * D;
    return (float*)(c.ws + WS_XC) + (size_t)(row - TL) * D;
}

#if defined(DEBUG_STAT)
__device__ __forceinline__ void dbg_max(const Ctx& c, int slot, float v) { v = fabsf(v); if (!(v < 1e30f)) v = 1e30f; atomicMax((unsigned*)(c.ws + WS_CTL + 512 * 1024) + 16 * slot, __float_as_uint(v)); }
#else
__device__ __forceinline__ void dbg_max(const Ctx&, int, float) {}
#endif
__device__ __forceinline__ void tconv_tile(const Ctx& c, const float* src, int ld_src, int k0, int c0, int nvalid, const float* kscale, bf16_t* dst, int ld_dst, int r0, int kd0) {
    LAS float* scr = (LAS float*)c.lds;
    const int tid = c.tid;
#pragma unroll
    for (int p = 0; p < 8; ++p) { const int k = p * 8 + (tid >> 6), n = tid & 63;
        float v = (n < nvalid) ? src[(size_t)(k0 + k) * ld_src + c0 + n] : 0.f; if (kscale) v *= kscale[k0 + k];
        scr[n * 65 + k] = v; }
    __syncthreads();
    { const int n = tid >> 3, kc = (tid & 7) * 8; const LAS float* s = scr + n * 65 + kc;
      u32x4 o; o.x = cvt_pk_bf16(s[0], s[1]); o.y = cvt_pk_bf16(s[2], s[3]); o.z = cvt_pk_bf16(s[4], s[5]); o.w = cvt_pk_bf16(s[6], s[7]);
      *(u32x4*)(dst + (size_t)(r0 + n) * ld_dst + kd0 + kc) = o; }
    __syncthreads();
}
template <int KQ>
__device__ __forceinline__ void tconv_kq(const Ctx& c, const float* src, int ld_src, int k0, int c0, int nvalid, const float* kscale, bf16_t* dst, int ld_dst, int r0, int kd0) {
    constexpr int LD = 64 * KQ + 1;
    LAS float* scr = (LAS float*)c.lds;
    const int tid = c.tid, n = tid & 63, kr = tid >> 6; float v[KQ][8];
    const bool ok = n < nvalid;
    const float* s0 = src + (size_t)(k0 + kr) * ld_src + c0 + n;
#pragma unroll
    for (int q = 0; q < KQ; ++q)
#pragma unroll
        for (int p = 0; p < 8; ++p) v[q][p] = ok ? s0[(size_t)(q * 64 + p * 8) * ld_src] : 0.f;
    if (kscale) {
#pragma unroll
        for (int q = 0; q < KQ; ++q)
#pragma unroll
            for (int p = 0; p < 8; ++p) v[q][p] *= kscale[k0 + q * 64 + p * 8 + kr]; }
#pragma unroll
    for (int q = 0; q < KQ; ++q)
#pragma unroll
        for (int p = 0; p < 8; ++p) scr[n * LD + q * 64 + p * 8 + kr] = v[q][p];
    __syncthreads();
    { const int nn = tid >> 3, kc = (tid & 7) * 8;
#pragma unroll
      for (int q = 0; q < KQ; ++q) { const LAS float* s = scr + nn * LD + q * 64 + kc;
          u32x4 o; o.x = cvt_pk_bf16(s[0], s[1]); o.y = cvt_pk_bf16(s[2], s[3]); o.z = cvt_pk_bf16(s[4], s[5]); o.w = cvt_pk_bf16(s[6], s[7]);
          *(u32x4*)(dst + (size_t)(r0 + nn) * ld_dst + kd0 + q * 64 + kc) = o; } }
    __syncthreads();
}
template <class RowMap>
__device__ __forceinline__ void tconv_tile4(const Ctx& c, const float* src, int ld_src, int k0, int n0, bf16_t* dst, int ld_dst, int kd0, const RowMap& rowmap) {
    LAS float* scr = (LAS float*)c.lds;
    const int tid = c.tid; float v[4][8];
#pragma unroll
    for (int q = 0; q < 4; ++q)
#pragma unroll
        for (int p = 0; p < 8; ++p) { const int k = p * 8 + (tid >> 6), n = tid & 63; v[q][p] = src[(size_t)(k0 + k) * ld_src + n0 + q * 64 + n]; }
#pragma unroll
    for (int q = 0; q < 4; ++q)
#pragma unroll
        for (int p = 0; p < 8; ++p) { const int k = p * 8 + (tid >> 6), n = tid & 63; scr[(q * 64 + n) * 65 + k] = v[q][p]; }
    __syncthreads();
#pragma unroll
    for (int q = 0; q < 4; ++q) { const int n = tid >> 3, kc = (tid & 7) * 8; const LAS float* s = scr + (q * 64 + n) * 65 + kc;
      u32x4 o; o.x = cvt_pk_bf16(s[0], s[1]); o.y = cvt_pk_bf16(s[2], s[3]); o.z = cvt_pk_bf16(s[4], s[5]); o.w = cvt_pk_bf16(s[6], s[7]);
      *(u32x4*)(dst + (size_t)rowmap(n0 + q * 64 + n) * ld_dst + kd0 + kc) = o; }
    __syncthreads();
}
__device__ __forceinline__ void win_map(int r0, int& src, int& nvalid) {
    nvalid = 64;
    if (r0 < 5120) src = r0; else if (r0 < 5504) src = 5152 + (r0 - 5120); else if (r0 == 5504) src = 5792;
    else if (r0 == 5568) { src = 5120; nvalid = 32; } else if (r0 < 5888) src = 5536 + (r0 - 5632); else src = 5856 + (r0 - 5888);
}
__device__ __forceinline__ void phase_pre_a(const Ctx& c) {
    constexpr int U_IN = 140 * 4, U_UQ = 24 * 2, U_UKV = 32, U_M = 3 * 16 * 4, U_OUT = 16 * 4, U_S = 32, U_LAYER = U_IN + U_UQ + U_UKV + U_M + U_OUT + U_S, U_MOD = 192;
    for (int u = c.bid; u < 2 * U_LAYER + U_MOD; u += c.G) {
        if (u < U_MOD) {
            const int cb = u, l = cb / 96, n = (cb % 96) * 64 + c.lane;
            LAS float* sl = (LAS float*)c.lds;
            LAS float* red = (LAS float*)(c.lds + 20480);
            for (int i = c.tid; i < 5 * D; i += NTHR) { const int vi = i >> 10, k = i & (D - 1); sl[i] = siluf_(vi < 4 ? c.in[I_C][vi * D + k] : c.in[I_CCTX][k]); }
            __syncthreads();
            const float* wp = c.in[I_WMOD] + (size_t)l * D * 6144 + (size_t)(c.wave * 128) * 6144 + n; const LAS float* sw = sl + c.wave * 128;
            float a[5] = {0.f, 0.f, 0.f, 0.f, 0.f};
#pragma unroll 1
            for (int kk = 0; kk < 128; kk += 16) { float w[16];
#pragma unroll
                for (int j = 0; j < 16; ++j) w[j] = wp[(size_t)(kk + j) * 6144];
#pragma unroll
                for (int j = 0; j < 16; ++j)
#pragma unroll
                    for (int i = 0; i < 5; ++i) a[i] += sw[i * D + kk + j] * w[j]; }
#pragma unroll
            for (int i = 0; i < 5; ++i) red[(c.wave * 5 + i) * 64 + c.lane] = a[i];
            __syncthreads();
            if (c.tid < 320) { const int i = c.tid >> 6, ln = c.tid & 63; float s = 0.f;
#pragma unroll
                for (int w = 0; w < 8; ++w) s += red[(w * 5 + i) * 64 + ln];
                const int nn = (cb % 96) * 64 + ln;
                ((float*)(c.ws + WS_MOD))[(size_t)(l * 5 + i) * 6144 + nn] = s + c.in[I_BMOD][l * 6144 + nn]; }
            __syncthreads();
            continue;
        }
        const int v = u - U_MOD, l = v / U_LAYER; int r = v % U_LAYER; unsigned char* wt = c.ws + WS_WT + (size_t)l * WT_LAYER;
        if (r < U_IN) { const int nb = r >> 2, kq = r & 3; int src, nv; win_map(nb * 64, src, nv);
            tconv_kq<4>(c, c.in[I_WIN] + (size_t)l * D * 8928, 8928, kq * 256, src, nv, nullptr, (bf16_t*)(wt + WT_IN), D, nb * 64, kq * 256); continue; } r -= U_IN;
        if (r < U_UQ) { const int nb = r >> 1, kh = r & 1;
            tconv_kq<3>(c, c.in[I_WUQ] + (size_t)l * 384 * 1536, 1536, kh * 192, nb * 64, 64, c.in[I_GCQ] + l * 384, (bf16_t*)(wt + WT_UQ), 384, nb * 64, kh * 192); continue; } r -= U_UQ;
        if (r < U_UKV) { const int nb = r;
            tconv_kq<4>(c, c.in[I_WUKV] + (size_t)l * 256 * 2048, 2048, 0, nb * 64, 64, c.in[I_GCKV] + l * 256, (bf16_t*)(wt + WT_UKV), 256, nb * 64, 0); continue; } r -= U_UKV;
        if (r < U_M) { const int which = r >> 6, rr = r & 63, nb = rr >> 2, kq = rr & 3;
            const float* src = c.in[which == 0 ? I_WPA : (which == 1 ? I_WPB : I_WPC)] + (size_t)l * D * D;
            tconv_kq<4>(c, src, D, kq * 256, nb * 64, 64, nullptr, (bf16_t*)(wt + WT_M), 3 * D, nb * 64, which * D + kq * 256); continue; } r -= U_M;
        if (r < U_OUT) { const int nb = r >> 2, kq = r & 3;
            tconv_kq<4>(c, c.in[I_WOUT] + (size_t)l * D * D, D, kq * 256, nb * 64, 64, nullptr, (bf16_t*)(wt + WT_OUT), D, nb * 64, kq * 256); continue; } r -= U_OUT;
        { const float* s = c.in[I_WS] + (size_t)l * 131072 + (size_t)r * 4096 + c.tid * 8; bf16_t* d = (bf16_t*)(wt + WT_S) + (size_t)r * 4096 + c.tid * 8;
          const f32x4 a = *(const f32x4*)s, b = *(const f32x4*)(s + 4); u32x4 o; o.x = cvt_pk_bf16(a[0], a[1]); o.y = cvt_pk_bf16(a[2], a[3]); o.z = cvt_pk_bf16(b[0], b[1]); o.w = cvt_pk_bf16(b[2], b[3]);
          *(u32x4*)d = o; }
    }
}
__device__ __forceinline__ void modulate_row(const float* xrow, const float* g, const float* shift, const float* scale, bf16_t* hrow, int lane, f32x4 (&hv)[4]) {
    float ss = 0.f;
#pragma unroll
    for (int j = 0; j < 4; ++j) { hv[j] = *(const f32x4*)(xrow + 4 * lane + 256 * j); ss += (hv[j][0] * hv[j][0] + hv[j][1] * hv[j][1]) + (hv[j][2] * hv[j][2] + hv[j][3] * hv[j][3]); }
    const float rstd = 1.0f / sqrtf(wave_sum(ss) * (1.f / D) + EPS);
#pragma unroll
    for (int j = 0; j < 4; ++j) { const int cc = 4 * lane + 256 * j; const f32x4 gv = *(const f32x4*)(g + cc), sc = *(const f32x4*)(scale + cc), sh = *(const f32x4*)(shift + cc);
        hv[j] = hv[j] * rstd * gv * (sc + 1.0f) + sh;
        u32x2 o; o.x = cvt_pk_bf16(hv[j][0], hv[j][1]); o.y = cvt_pk_bf16(hv[j][2], hv[j][3]); *(u32x2*)(hrow + cc) = o; }
}
__device__ __forceinline__ void phase_modulate_mix(const Ctx& c, int l) {
    const int gw = c.bid * NWAVES + c.wave, NGW = c.G * NWAVES;
    for (int row = gw; row < T; row += NGW) { const int bi = row_modidx(row); f32x4 hv[4];
        modulate_row(xin_row(c, l, row), c.in[I_GMIX] + l * D, modp(c, l, bi, 0), modp(c, l, bi, 1), (bf16_t*)(c.ws + WS_H) + (size_t)row * D, c.lane, hv); }
}
struct EpiZ { static constexpr bool PERM = true, MID = false; bf16_t* Z; const float* bgate;
    __device__ __forceinline__ void operator()(const f32x4 (&acc)[2][2][4][2], const pg8::Unit& u, int wr, int wc, int fr, int fq) const {
        int row0 = u.pm * 256 + wr * 64 + fr; asm volatile("" : "+v"(row0)); const int col0 = u.pn * 256 + wc * 32 + 8 * fq;
        const int mode = (u.pn >= 23) ? 3 : ((u.pn >= 16 && u.pn < 20) ? 2 : ((u.pn == 8 || u.pn == 9) ? 1 : 0));
        const int gcol = (mode == 3) ? (col0 - ZGT) : 0; const float bm = (mode == 3) ? 1.f : 0.f;
        f32x4 bv[2][2];
#pragma unroll
        for (int bj = 0; bj < 2; ++bj)
#pragma unroll
            for (int n = 0; n < 2; ++n) bv[bj][n] = *(const f32x4*)(bgate + (gcol + bj * 128 + 4 * n)) * bm;
#pragma unroll
        for (int ai = 0; ai < 2; ++ai)
#pragma unroll
            for (int m = 0; m < 4; ++m) { bf16_t* rowp = Z + (size_t)(row0 + ai * 128 + m * 16) * NZ + col0;
#pragma unroll
                for (int bj = 0; bj < 2; ++bj) { f32x4 v0 = acc[ai][bj][m][0] + bv[bj][0], v1 = acc[ai][bj][m][1] + bv[bj][1];
                    if (mode == 1) { v0 = v0 * 0.08838834764831845f; v1 = v1 * 0.08838834764831845f; }
                    else if (mode == 2) {
#pragma unroll
                        for (int e = 0; e < 4; ++e) { v0[e] = siluf_(v0[e]); v1[e] = siluf_(v1[e]); } }
                    else if (mode == 3) {
#pragma unroll
                        for (int e = 0; e < 4; ++e) { v0[e] = fmaxf(sigmoidf_(v0[e]), 1e-20f); v1[e] = fmaxf(sigmoidf_(v1[e]), 1e-20f); } }
                    u32x4 w; w.x = cvt_pk_bf16(v0[0], v0[1]); w.y = cvt_pk_bf16(v0[2], v0[3]); w.z = cvt_pk_bf16(v1[0], v1[1]); w.w = cvt_pk_bf16(v1[2], v1[3]);
                    *(u32x4*)(rowp + bj * 128) = w; } }
    }
};
struct EpiPlain { static constexpr bool PERM = true, MID = false; bf16_t* O; int ldc;
    __device__ __forceinline__ void operator()(const f32x4 (&acc)[2][2][4][2], const pg8::Unit& u, int wr, int wc, int fr, int fq) const {
        int row0 = u.pm * 256 + wr * 64 + fr; asm volatile("" : "+v"(row0)); const int col0 = u.pn * 256 + wc * 32 + 8 * fq;
#pragma unroll
        for (int ai = 0; ai < 2; ++ai)
#pragma unroll
            for (int m = 0; m < 4; ++m) { bf16_t* rowp = O + (size_t)(row0 + ai * 128 + m * 16) * ldc + col0;
#pragma unroll
                for (int bj = 0; bj < 2; ++bj) { const f32x4 v0 = acc[ai][bj][m][0], v1 = acc[ai][bj][m][1];
                    u32x4 w; w.x = cvt_pk_bf16(v0[0], v0[1]); w.y = cvt_pk_bf16(v0[2], v0[3]); w.z = cvt_pk_bf16(v1[0], v1[1]); w.w = cvt_pk_bf16(v1[2], v1[3]);
                    *(u32x4*)(rowp + bj * 128) = w; } }
    }
};
struct EpiMerge { static constexpr bool PERM = true, MID = true; bf16_t* O; const bf16_t* Z;
    __device__ __forceinline__ void ld8(const bf16_t* p, float (&g)[8]) const { const u32x4 w = *(const u32x4*)p; g[0] = bflo(w.x); g[1] = bfhi(w.x); g[2] = bflo(w.y); g[3] = bfhi(w.y); g[4] = bflo(w.z); g[5] = bfhi(w.z); g[6] = bflo(w.w); g[7] = bfhi(w.w); }
    __device__ __forceinline__ void mid(f32x4 (&acc)[2][2][4][2], const pg8::Unit& u, int t, int wr, int wc, int fr, int fq) const {
        int row0 = u.pm * 256 + wr * 64 + fr; asm volatile("" : "+v"(row0)); const int col0 = u.pn * 256 + wc * 32 + 8 * fq; const int seg = (t == 16) ? 0 : 1;
#pragma unroll
        for (int ai = 0; ai < 2; ++ai)
#pragma unroll
            for (int m = 0; m < 4; ++m) { const bf16_t* gp = Z + (size_t)(row0 + ai * 128 + m * 16) * NZ + ZGT + seg * D + col0;
#pragma unroll
                for (int bj = 0; bj < 2; ++bj) { float ga[8], gb[8]; ld8(gp + bj * 128, ga); ld8(gp + D + bj * 128, gb);
#pragma unroll
                    for (int e = 0; e < 4; ++e) { acc[ai][bj][m][0][e] *= ga[e] * fast_rcp(gb[e]); acc[ai][bj][m][1][e] *= ga[4 + e] * fast_rcp(gb[4 + e]); } }
                __builtin_amdgcn_sched_barrier(0); }
    }
    __device__ __forceinline__ void operator()(const f32x4 (&acc)[2][2][4][2], const pg8::Unit& u, int wr, int wc, int fr, int fq) const {
        int row0 = u.pm * 256 + wr * 64 + fr; asm volatile("" : "+v"(row0)); const int col0 = u.pn * 256 + wc * 32 + 8 * fq;
#pragma unroll
        for (int ai = 0; ai < 2; ++ai)
#pragma unroll
            for (int m = 0; m < 4; ++m) { const size_t r = (size_t)(row0 + ai * 128 + m * 16); const bf16_t* gp = Z + r * NZ + ZGT + 2 * D + col0; bf16_t* rowp = O + r * D + col0;
#pragma unroll
                for (int bj = 0; bj < 2; ++bj) { float gc[8]; ld8(gp + bj * 128, gc); const f32x4 v0 = acc[ai][bj][m][0], v1 = acc[ai][bj][m][1];
                    u32x4 w; w.x = cvt_pk_bf16(v0[0] * gc[0], v0[1] * gc[1]); w.y = cvt_pk_bf16(v0[2] * gc[2], v0[3] * gc[3]); w.z = cvt_pk_bf16(v1[0] * gc[4], v1[1] * gc[5]); w.w = cvt_pk_bf16(v1[2] * gc[6], v1[3] * gc[7]);
                    *(u32x4*)(rowp + bj * 128) = w; }
                __builtin_amdgcn_sched_barrier(0); }
    }
};
struct EpiResid { static constexpr bool PERM = false, MID = false; const Ctx* c; int l; float* dummy;
    __device__ __forceinline__ void operator()(const f32x4 (&acc)[2][2][4][2], const pg8::Unit& u, int wr, int wc, int fr, int fq) const {
        int row0 = u.pm * 256 + wr * 64 + fr; asm volatile("" : "+v"(row0)); const int col0 = u.pn * 256 + wc * 32 + 4 * fq; const float* gate = modp(*c, l, row_modidx(u.pm * 256), 2);
        f32x4 gv[2][2];
#pragma unroll
        for (int bj = 0; bj < 2; ++bj)
#pragma unroll
            for (int n = 0; n < 2; ++n) gv[bj][n] = *(const f32x4*)(gate + col0 + bj * 128 + 16 * n);
#pragma unroll
        for (int ai = 0; ai < 2; ++ai)
#pragma unroll
            for (int m = 0; m < 4; ++m) { const int row = row0 + ai * 128 + m * 16; const float* xi = xin_row(*c, l, row) + col0; float* xo = (dummy ? dummy + (size_t)row * D : xout_row(*c, row)) + col0;
#pragma unroll
                for (int bj = 0; bj < 2; ++bj)
#pragma unroll
                    for (int n = 0; n < 2; ++n) { const f32x4 xv = *(const f32x4*)(xi + bj * 128 + 16 * n); *(f32x4*)(xo + bj * 128 + 16 * n) = xv + gv[bj][n] * acc[ai][bj][m][n]; } }
    }
};
struct EpiSwiGLU { static constexpr bool PERM = true, MID = false; bf16_t* HID;
    __device__ __forceinline__ void operator()(const f32x4 (&acc)[2][2][4][2], const pg8::Unit& u, int wr, int wc, int fr, int fq) const {
        int row0 = u.pm * 256 + wr * 64 + fr; asm volatile("" : "+v"(row0)); const int col0 = u.pn * 128 + wc * 32 + 8 * fq; bf16_t* base = HID + (size_t)u.g * ESLOTS * DEXP;
#pragma unroll
        for (int ai = 0; ai < 2; ++ai)
#pragma unroll
            for (int m = 0; m < 4; ++m) { float h[8];
#pragma unroll
                for (int n = 0; n < 2; ++n)
#pragma unroll
                    for (int e = 0; e < 4; ++e) h[4 * n + e] = siluf_(acc[ai][0][m][n][e]) * acc[ai][1][m][n][e];
                u32x4 w; w.x = cvt_pk_bf16(h[0], h[1]); w.y = cvt_pk_bf16(h[2], h[3]); w.z = cvt_pk_bf16(h[4], h[5]); w.w = cvt_pk_bf16(h[6], h[7]);
                *(u32x4*)(base + (size_t)(row0 + ai * 128 + m * 16) * DEXP + col0) = w; }
    }
};
struct EpiDown { static constexpr bool PERM = true, MID = false; bf16_t* YS; const float* gatev;
    __device__ __forceinline__ void operator()(const f32x4 (&acc)[2][2][4][2], const pg8::Unit& u, int wr, int wc, int fr, int fq) const {
        int row0 = u.pm * 256 + wr * 64 + fr; asm volatile("" : "+v"(row0)); const int col0 = u.pn * 256 + wc * 32 + 8 * fq; bf16_t* base = YS + (size_t)u.g * ESLOTS * D; const float* gp = gatev + u.g * ESLOTS;
#pragma unroll
        for (int ai = 0; ai < 2; ++ai)
#pragma unroll
            for (int m = 0; m < 4; ++m) { const int row = row0 + ai * 128 + m * 16; const float gs = gp[row]; bf16_t* rowp = base + (size_t)row * D + col0;
#pragma unroll
                for (int bj = 0; bj < 2; ++bj) { const f32x4 v0 = acc[ai][bj][m][0] * gs, v1 = acc[ai][bj][m][1] * gs;
                    u32x4 w; w.x = cvt_pk_bf16(v0[0], v0[1]); w.y = cvt_pk_bf16(v0[2], v0[3]); w.z = cvt_pk_bf16(v1[0], v1[1]); w.w = cvt_pk_bf16(v1[2], v1[3]);
                    *(u32x4*)(rowp + bj * 128) = w; } }
    }
};

struct EpiDownPart { static constexpr bool PERM = true, MID = false; bf16_t* YSC; const float* gatev;
    __device__ __forceinline__ void operator()(const f32x4 (&acc)[2][2][4][2], const pg8::Unit& u, int wr, int wc, int fr, int fq) const {
        int r0 = wr * 64 + fr; asm volatile("" : "+v"(r0)); const int col0 = u.pn * 256 + wc * 32 + 8 * fq;
        bf16_t* base = YSC + ((size_t)((u.ko >> 9) * NEXP + u.g) * 128) * D; const float* gp = gatev + u.g * ESLOTS + 2048;
#pragma unroll
        for (int m = 0; m < 4; ++m) { const int r = r0 + m * 16; const float gs = gp[r]; bf16_t* rowp = base + (size_t)r * D + col0;
#pragma unroll
            for (int bj = 0; bj < 2; ++bj) { const f32x4 v0 = acc[0][bj][m][0] * gs, v1 = acc[0][bj][m][1] * gs;
                u32x4 w; w.x = cvt_pk_bf16(v0[0], v0[1]); w.y = cvt_pk_bf16(v0[2], v0[3]); w.z = cvt_pk_bf16(v1[0], v1[1]); w.w = cvt_pk_bf16(v1[2], v1[3]);
                *(u32x4*)(rowp + bj * 128) = w; } }
    }
};

__device__ __forceinline__ void sg_accum(const bf16_t* A, int lda, const bf16_t* Bt, int ldb, int K, int lane, f32x4 (&acc)[2]) {
    const int lr = lane & 15, lq = lane >> 4; const bf16_t* ap = A + (size_t)lr * lda + 8 * lq; const bf16_t* bp0 = Bt + (size_t)lr * ldb + 8 * lq; const bf16_t* bp1 = bp0 + (size_t)16 * ldb;
    bf16x8 a[2][4], b0[2][4], b1[2][4];
#pragma unroll
    for (int i = 0; i < 4; ++i) { a[0][i] = *(const bf16x8*)(ap + 32 * i); b0[0][i] = *(const bf16x8*)(bp0 + 32 * i); b1[0][i] = *(const bf16x8*)(bp1 + 32 * i); }
#pragma unroll 1
    for (int k = 0; k < K; k += 256) {
#pragma unroll
        for (int i = 0; i < 4; ++i) { a[1][i] = *(const bf16x8*)(ap + k + 128 + 32 * i); b0[1][i] = *(const bf16x8*)(bp0 + k + 128 + 32 * i); b1[1][i] = *(const bf16x8*)(bp1 + k + 128 + 32 * i); }
#pragma unroll
        for (int i = 0; i < 4; ++i) { acc[0] = __builtin_amdgcn_mfma_f32_16x16x32_bf16(a[0][i], b0[0][i], acc[0], 0, 0, 0); acc[1] = __builtin_amdgcn_mfma_f32_16x16x32_bf16(a[0][i], b1[0][i], acc[1], 0, 0, 0); }
        if (k + 256 < K) {
#pragma unroll
            for (int i = 0; i < 4; ++i) { a[0][i] = *(const bf16x8*)(ap + k + 256 + 32 * i); b0[0][i] = *(const bf16x8*)(bp0 + k + 256 + 32 * i); b1[0][i] = *(const bf16x8*)(bp1 + k + 256 + 32 * i); } }
#pragma unroll
        for (int i = 0; i < 4; ++i) { acc[0] = __builtin_amdgcn_mfma_f32_16x16x32_bf16(a[1][i], b0[1][i], acc[0], 0, 0, 0); acc[1] = __builtin_amdgcn_mfma_f32_16x16x32_bf16(a[1][i], b1[1][i], acc[1], 0, 0, 0); }
    }
}
__device__ __forceinline__ void ctx_merge_unit(const Ctx& c, int l, int u) {
    const int lane = c.lane, w = c.wave, lr = lane & 15, lq = lane >> 4, tid = c.tid; const int row0 = TL + 64 * (u >> 4), col0 = 64 * (u & 15); const int rh = w & 1, kw = w >> 1;
    const char* yb = (const char*)(c.ws + WS_RB + RB_YCAT) + ((size_t)(row0 + 32 * rh) * 3072 + 256 * kw) * 2;
    const char* wb = (const char*)(c.ws + WS_WT + (size_t)l * WT_LAYER + WT_M) + ((size_t)col0 * 3072 + 256 * kw) * 2;
    const __amdgpu_buffer_rsrc_t ra = __builtin_amdgcn_make_buffer_rsrc((void*)yb, 0, 1 << 30, 0x00020000), rb = __builtin_amdgcn_make_buffer_rsrc((void*)wb, 0, 1 << 30, 0x00020000);
    const int voff = (lr * 3072 + 8 * lq) * 2;
    LAS float* part = (LAS float*)c.lds;
    const int T = tid >> 5, lp = 2 * (tid & 31), RT = T >> 2, CT = T & 3; const int orow = row0 + 16 * RT + 4 * (lp >> 4), ocol = col0 + 16 * CT + (lp & 15);
    const bf16_t* Zg = (const bf16_t*)(c.ws + WS_RA) + ZGT + (size_t)orow * NZ + ocol;
    float out[8] = {0.f, 0.f, 0.f, 0.f, 0.f, 0.f, 0.f, 0.f};
    bf16x8 a[2][2][2], b[2][2][4];
#define CM_LOAD(slot, P) do { const int o_ = ((P) >> 2) * (D * 2) + ((P) & 3) * 128; \
        _Pragma("unroll") for (int t_ = 0; t_ < 2; ++t_) _Pragma("unroll") for (int h_ = 0; h_ < 2; ++h_) a[slot][h_][t_] = __builtin_bit_cast(bf16x8, __builtin_amdgcn_raw_buffer_load_b128(ra, voff, t_ * (16 * 3072 * 2) + o_ + h_ * 64, 0)); \
        _Pragma("unroll") for (int t_ = 0; t_ < 4; ++t_) _Pragma("unroll") for (int h_ = 0; h_ < 2; ++h_) b[slot][h_][t_] = __builtin_bit_cast(bf16x8, __builtin_amdgcn_raw_buffer_load_b128(rb, voff, t_ * (16 * 3072 * 2) + o_ + h_ * 64, 0)); } while (0)
#define CM_MMA(slot) do { _Pragma("unroll") for (int h_ = 0; h_ < 2; ++h_) _Pragma("unroll") for (int rt_ = 0; rt_ < 2; ++rt_) _Pragma("unroll") for (int ct_ = 0; ct_ < 4; ++ct_) \
        acc[rt_][ct_] = __builtin_amdgcn_mfma_f32_16x16x32_bf16(a[slot][h_][rt_], b[slot][h_][ct_], acc[rt_][ct_], 0, 0, 0); } while (0)
    CM_LOAD(0, 0); __builtin_amdgcn_sched_barrier(0);
#pragma unroll 1
    for (int seg = 0; seg < 3; ++seg) { f32x4 acc[2][4];
#pragma unroll
        for (int rt = 0; rt < 2; ++rt)
#pragma unroll
            for (int ct = 0; ct < 4; ++ct) acc[rt][ct] = (f32x4){0.f, 0.f, 0.f, 0.f};
#pragma unroll
        for (int jp = 0; jp < 4; ++jp) { const int P = seg * 4 + jp; __builtin_amdgcn_sched_barrier(0); if (P + 1 < 12) CM_LOAD((jp + 1) & 1, P + 1); __builtin_amdgcn_sched_barrier(0); CM_MMA(jp & 1); __builtin_amdgcn_sched_barrier(0); }
        unsigned gz[4];
#pragma unroll
        for (int e = 0; e < 4; ++e) gz[e] = *(const unsigned*)(Zg + (size_t)e * NZ + seg * D);
        { LAS float* wp = part + (size_t)(w * 8 * 64 + lane) * 4;
#pragma unroll
          for (int rt = 0; rt < 2; ++rt)
#pragma unroll
            for (int ct = 0; ct < 4; ++ct) *(LAS f32x4*)(wp + (rt * 4 + ct) * 256) = acc[rt][ct]; }
        __syncthreads();
        float s[8] = {0.f, 0.f, 0.f, 0.f, 0.f, 0.f, 0.f, 0.f};
        { const LAS float* pl = part + (size_t)((((RT >> 1) * 8 + (RT & 1) * 4 + CT) * 64) + lp) * 4;
#pragma unroll
          for (int p = 0; p < 4; ++p) { const f32x4 v0 = *(const LAS f32x4*)(pl + p * 4096), v1 = *(const LAS f32x4*)(pl + p * 4096 + 4);
#pragma unroll
              for (int e = 0; e < 4; ++e) { s[e] += v0[e]; s[4 + e] += v1[e]; } } }
#pragma unroll
        for (int e = 0; e < 4; ++e) { out[e] += s[e] * bflo(gz[e]); out[4 + e] += s[4 + e] * bfhi(gz[e]); }
        __syncthreads();
    }
#undef CM_LOAD
#undef CM_MMA
    bf16_t* O = (bf16_t*)(c.ws + WS_RB + RB_MERGED) + (size_t)orow * D + ocol;
#pragma unroll
    for (int e = 0; e < 4; ++e) *(unsigned*)(O + (size_t)e * D) = cvt_pk_bf16(out[e], out[4 + e]);
}
__device__ __forceinline__ void ctx_out_unit(const Ctx& c, int l, int u) {
    const int lane = c.lane, w = c.wave, lr = lane & 15, lq = lane >> 4; const int row0 = TL + 64 * (u >> 4) + 16 * (w >> 1), col0 = 64 * (u & 15) + 32 * (w & 1);
    const bf16_t* A = (const bf16_t*)(c.ws + WS_RB + RB_MERGED) + (size_t)row0 * D; const bf16_t* WO = (const bf16_t*)(c.ws + WS_WT + (size_t)l * WT_LAYER + WT_OUT) + (size_t)col0 * D;
    f32x4 acc[2] = {{0.f, 0.f, 0.f, 0.f}, {0.f, 0.f, 0.f, 0.f}};
    sg_accum(A, D, WO, D, D, lane, acc);
    const float* gate = modp(c, l, 4, 2);
#pragma unroll
    for (int t = 0; t < 2; ++t)
#pragma unroll
        for (int e = 0; e < 4; ++e) { const int row = row0 + 4 * lq + e, col = col0 + 16 * t + lr; xout_row(c, row)[col] = xin_row(c, l, row)[col] + gate[col] * acc[t][e]; }
}
__device__ __forceinline__ void mixA_unit(const Ctx& c, int l, int un) {
    const int cn = un >> 3, g = un & 7; const int row0 = cn * 128;
    const bf16_t* Z = (const bf16_t*)(c.ws + WS_RA); bf16_t* Y = (bf16_t*)(c.ws + WS_RB + RB_YCAT);
    const bf16_t* WSb = (const bf16_t*)(c.ws + WS_WT + (size_t)l * WT_LAYER + WT_S) + g * 16384;
    LAS bf16_t* VT = (LAS bf16_t*)c.lds;
    { const int s = c.tid >> 2, qd = c.tid & 3; const bf16_t* p = Z + (size_t)(row0 + s) * NZ + ZVA + g * 128 + qd * 32;
      float v[32];
#pragma unroll
      for (int i = 0; i < 4; ++i) { const u32x4 w = *(const u32x4*)(p + 8 * i); v[8 * i] = bflo(w.x); v[8 * i + 1] = bfhi(w.x); v[8 * i + 2] = bflo(w.y); v[8 * i + 3] = bfhi(w.y); v[8 * i + 4] = bflo(w.z); v[8 * i + 5] = bfhi(w.z); v[8 * i + 6] = bflo(w.w); v[8 * i + 7] = bfhi(w.w); }
      float sm = 0.f;
#pragma unroll
      for (int i = 0; i < 32; ++i) sm += v[i];
      sm += sx<1>(sm); sm += sx<2>(sm); const float mu = sm * (1.f / 128.f); float sq = 0.f;
#pragma unroll
      for (int i = 0; i < 32; ++i) { v[i] -= mu; sq += v[i] * v[i]; }
      sq += sx<1>(sq); sq += sx<2>(sq); const float rstd = 1.0f / sqrtf(sq * (1.f / 128.f) + EPS);
#pragma unroll
      for (int i = 0; i < 32; ++i) VT[(qd * 32 + i) * 136 + s] = f2bf(v[i] * rstd); }
    __syncthreads();
    const int w = c.wave, lr = c.lane & 15, lq = c.lane >> 4;
    bf16x8 bw[4];
#pragma unroll
    for (int ks = 0; ks < 4; ++ks) bw[ks] = *(const bf16x8*)(WSb + (16 * w + lr) * 128 + 32 * ks + 8 * lq);
    const int t = row0 + 16 * w + lr; const float bs = c.in[I_BS][(l * 8 + g) * 128 + 16 * w + lr];
#pragma unroll
    for (int ct = 0; ct < 8; ++ct) { f32x4 acc = {0.f, 0.f, 0.f, 0.f};
#pragma unroll
        for (int ks = 0; ks < 4; ++ks) { const bf16x8 a = *(const LAS bf16x8*)(VT + (16 * ct + lr) * 136 + 32 * ks + 8 * lq); acc = __builtin_amdgcn_mfma_f32_16x16x32_bf16(a, bw[ks], acc, 0, 0, 0); }
        const int cc = g * 128 + 16 * ct + 4 * lq; const u32x2 uw = *(const u32x2*)(Z + (size_t)t * NZ + ZU + cc);
        u32x2 o; o.x = cvt_pk_bf16(bflo(uw.x) * (acc[0] + bs), bfhi(uw.x) * (acc[1] + bs)); o.y = cvt_pk_bf16(bflo(uw.y) * (acc[2] + bs), bfhi(uw.y) * (acc[3] + bs));
        *(u32x2*)(Y + (size_t)t * 3072 + cc) = o; }
    __syncthreads();
}
__device__ __forceinline__ void gla_b1_unit(const Ctx& c, int l, int un) {
    const int n = un >> 2, h = un & 3, row0 = n * 64, tid = c.tid, lane = c.lane, w = c.wave, lr = lane & 15, lq = lane >> 4;
    const bf16_t* Z = (const bf16_t*)(c.ws + WS_RA);
    LAS bf16_t* VTs = (LAS bf16_t*)c.lds;
    LAS float* Ds = (LAS float*)(c.lds + 36864);
    LAS float* La = (LAS float*)(c.lds + 45056);
    LAS float* Tot = (LAS float*)(c.lds + 78080);
    LAS bf16_t* QD = (LAS bf16_t*)(c.lds + 80128);
    LAS bf16_t* KI = (LAS bf16_t*)(c.lds + 97536);
    LAS bf16_t* Ps = (LAS bf16_t*)(c.lds + 114944);
    LAS bf16_t* KdT = (LAS bf16_t*)(c.lds + 124160);
    { const int t = tid >> 3, cb = (tid & 7) * 32; const bf16_t* p = Z + (size_t)(row0 + t) * NZ + ZVB + h * 256 + cb;
#pragma unroll
      for (int i = 0; i < 4; ++i) { const u32x4 wv = *(const u32x4*)(p + 8 * i); LAS bf16_t* d = VTs + (cb + 8 * i) * 72 + t;
        d[0] = (bf16_t)wv.x; d[72] = (bf16_t)(wv.x >> 16); d[144] = (bf16_t)wv.y; d[216] = (bf16_t)(wv.y >> 16); d[288] = (bf16_t)wv.z; d[360] = (bf16_t)(wv.z >> 16); d[432] = (bf16_t)wv.w; d[504] = (bf16_t)(wv.w >> 16); }
      const int dt = tid >> 3, dc = (tid & 7) * 4; const u32x2 dv = *(const u32x2*)(Z + (size_t)(row0 + dt) * NZ + ZDEC + dc);
      Ds[dt * 32 + dc] = bflo(dv.x); Ds[dt * 32 + dc + 1] = bfhi(dv.x); Ds[dt * 32 + dc + 2] = bflo(dv.y); Ds[dt * 32 + dc + 3] = bfhi(dv.y); }
    __syncthreads();
    f32x4 pacc[2] = {{0.f, 0.f, 0.f, 0.f}, {0.f, 0.f, 0.f, 0.f}};
#pragma unroll 1
    for (int dir = 0; dir < 2; ++dir) {
        { const int cch = 16 * w + lr;
          bf16x8 bfr = {0, 0, 0, 0, 0, 0, 0, 0};
          if (lq < 2) { const float* wd = c.in[I_WDEC] + (size_t)(l * 2 + dir) * 16 * 512 + (size_t)(8 * lq) * 512 + h * 128 + cch; u32x4 pk;
              pk.x = cvt_pk_bf16(wd[0], wd[512]); pk.y = cvt_pk_bf16(wd[1024], wd[1536]); pk.z = cvt_pk_bf16(wd[2048], wd[2560]); pk.w = cvt_pk_bf16(wd[3072], wd[3584]); bfr = __builtin_bit_cast(bf16x8, pk); }
          const float bias = c.in[I_BDEC][(l * 2 + dir) * 512 + h * 128 + cch];
          f32x4 la[4];
#pragma unroll
          for (int tt = 0; tt < 4; ++tt) { bf16x8 afr = {0, 0, 0, 0, 0, 0, 0, 0};
              if (lq < 2) afr = *(const bf16x8*)(Z + (size_t)(row0 + 16 * tt + lr) * NZ + ZDEC + dir * 16 + 8 * lq);
              la[tt] = __builtin_amdgcn_mfma_f32_16x16x32_bf16(afr, bfr, (f32x4){0.f, 0.f, 0.f, 0.f}, 0, 0, 0); }
#pragma unroll
          for (int tt = 0; tt < 4; ++tt)
#pragma unroll
              for (int e = 0; e < 4; ++e) { const float pre = la[tt][e] + bias; la[tt][e] = (fminf(pre, 0.f) - __logf(1.f + __expf(-fabsf(pre)))) * 0.0625f; }
          float carry = 0.f;
          if (dir == 0) {
#pragma unroll
              for (int tt = 0; tt < 4; ++tt) { la[tt][1] += la[tt][0]; la[tt][2] += la[tt][1]; la[tt][3] += la[tt][2];
                  const float tot = la[tt][3]; float pre = 0.f; const float s16 = bperm(tot, lane - 16), s32 = bperm(tot, lane - 32), s48 = bperm(tot, lane - 48);
                  if (lq >= 1) pre += s16; if (lq >= 2) pre += s32; if (lq >= 3) pre += s48;
                  const float add = carry + pre;
#pragma unroll
                  for (int e = 0; e < 4; ++e) la[tt][e] += add;
                  carry = bperm(la[tt][3], 48 + lr); }
          } else {
#pragma unroll
              for (int tt = 3; tt >= 0; --tt) { la[tt][2] += la[tt][3]; la[tt][1] += la[tt][2]; la[tt][0] += la[tt][1];
                  const float tot = la[tt][0]; float pre = 0.f; const float s16 = bperm(tot, lane + 16), s32 = bperm(tot, lane + 32), s48 = bperm(tot, lane + 48);
                  if (lq <= 2) pre += s16; if (lq <= 1) pre += s32; if (lq <= 0) pre += s48;
                  const float add = carry + pre;
#pragma unroll
                  for (int e = 0; e < 4; ++e) la[tt][e] += add;
                  carry = bperm(la[tt][0], lr); }
          }
#pragma unroll
          for (int tt = 0; tt < 4; ++tt)
#pragma unroll
              for (int e = 0; e < 4; ++e) La[(16 * tt + 4 * lq + e) * 129 + cch] = la[tt][e]; }
        __syncthreads();
        { const int t = tid >> 3, cb = (tid & 7) * 16; const bf16_t* qp = Z + (size_t)(row0 + t) * NZ + ZQB + h * 128 + cb; const bf16_t* kp = Z + (size_t)(row0 + t) * NZ + ZKB + h * 128 + cb;
          float q[16], k[16];
#pragma unroll
          for (int i = 0; i < 2; ++i) { const u32x4 a = *(const u32x4*)(qp + 8 * i), b = *(const u32x4*)(kp + 8 * i);
              q[8 * i] = bflo(a.x); q[8 * i + 1] = bfhi(a.x); q[8 * i + 2] = bflo(a.y); q[8 * i + 3] = bfhi(a.y); q[8 * i + 4] = bflo(a.z); q[8 * i + 5] = bfhi(a.z); q[8 * i + 6] = bflo(a.w); q[8 * i + 7] = bfhi(a.w);
              k[8 * i] = bflo(b.x); k[8 * i + 1] = bfhi(b.x); k[8 * i + 2] = bflo(b.y); k[8 * i + 3] = bfhi(b.y); k[8 * i + 4] = bflo(b.z); k[8 * i + 5] = bfhi(b.z); k[8 * i + 6] = bflo(b.w); k[8 * i + 7] = bfhi(b.w); }
          const int tl = (dir == 0) ? 63 : 0; float qd[16], ki[16];
#pragma unroll
          for (int i = 0; i < 16; ++i) { const float b = La[t * 129 + cb + i], bl = La[tl * 129 + cb + i]; const float e = __expf(b);
              qd[i] = q[i] * e; ki[i] = k[i] * fast_rcp(e); KdT[(cb + i) * 72 + t] = f2bf(k[i] * __expf(bl - b)); }
          u32x4 o0, o1;
          o0.x = cvt_pk_bf16(qd[0], qd[1]); o0.y = cvt_pk_bf16(qd[2], qd[3]); o0.z = cvt_pk_bf16(qd[4], qd[5]); o0.w = cvt_pk_bf16(qd[6], qd[7]);
          o1.x = cvt_pk_bf16(qd[8], qd[9]); o1.y = cvt_pk_bf16(qd[10], qd[11]); o1.z = cvt_pk_bf16(qd[12], qd[13]); o1.w = cvt_pk_bf16(qd[14], qd[15]);
          *(LAS u32x4*)(QD + t * 136 + cb) = o0; *(LAS u32x4*)(QD + t * 136 + cb + 8) = o1;
          bf16_t* qg = (bf16_t*)(c.ws + WS_RB + RB_QDF) + (size_t)(dir * 1088 + un) * 8192 + (size_t)((((t >> 5) * 4 + (cb >> 5)) * 2 + ((cb >> 4) & 1)) * 512 + (t & 31) * 8);
          u32x4 p0, p1; p0.x = o0.x; p0.y = o0.y; p0.z = o1.x; p0.w = o1.y; p1.x = o0.z; p1.y = o0.w; p1.z = o1.z; p1.w = o1.w;
          *(u32x4*)qg = p0; *(u32x4*)(qg + 256) = p1;
          o0.x = cvt_pk_bf16(ki[0], ki[1]); o0.y = cvt_pk_bf16(ki[2], ki[3]); o0.z = cvt_pk_bf16(ki[4], ki[5]); o0.w = cvt_pk_bf16(ki[6], ki[7]);
          o1.x = cvt_pk_bf16(ki[8], ki[9]); o1.y = cvt_pk_bf16(ki[10], ki[11]); o1.z = cvt_pk_bf16(ki[12], ki[13]); o1.w = cvt_pk_bf16(ki[14], ki[15]);
          *(LAS u32x4*)(KI + t * 136 + cb) = o0; *(LAS u32x4*)(KI + t * 136 + cb + 8) = o1;
          if (tid < 128) ((float*)(c.ws + WS_RB + RB_DECAY))[(size_t)(dir * 1088 + un) * 128 + tid] = __expf(La[tl * 129 + tid]); }
        __syncthreads();
        { bf16_t* kg = (bf16_t*)(c.ws + WS_RB + RB_KDT) + (size_t)(dir * 1088 + un) * 8192;
#pragma unroll
          for (int i = 0; i < 2; ++i) { const int id = tid + 512 * i, ch = id >> 3, tc = id & 7;
              *(u32x4*)(kg + (((ch >> 5) * 4 + (tc >> 1)) * 64 + (tc & 1) * 32 + (ch & 31)) * 8) = *(const LAS u32x4*)(KdT + ch * 72 + tc * 8); } }
        { const int it = w >> 1; bf16x8 a[4];
#pragma unroll
          for (int ks = 0; ks < 4; ++ks) a[ks] = *(const LAS bf16x8*)(QD + (16 * it + lr) * 136 + 32 * ks + 8 * lq);
#pragma unroll
          for (int jj = 0; jj < 2; ++jj) { const int jt = 2 * (w & 1) + jj; f32x4 s = {0.f, 0.f, 0.f, 0.f};
#pragma unroll
              for (int ks = 0; ks < 4; ++ks) { const bf16x8 b = *(const LAS bf16x8*)(KI + (16 * jt + lr) * 136 + 32 * ks + 8 * lq); s = __builtin_amdgcn_mfma_f32_16x16x32_bf16(a[ks], b, s, 0, 0, 0); }
              const int j = 16 * jt + lr;
#pragma unroll
              for (int e = 0; e < 4; ++e) { const int i = 16 * it + 4 * lq + e; const bool keep = (dir == 0) ? (j <= i) : (j >= i); pacc[jj][e] += keep ? s[e] : 0.f; } } }
        __syncthreads();
    }
    { const int it = w >> 1;
#pragma unroll
      for (int jj = 0; jj < 2; ++jj) { const int j = 16 * (2 * (w & 1) + jj) + lr;
#pragma unroll
          for (int e = 0; e < 4; ++e) { Ps[(16 * it + 4 * lq + e) * 72 + j] = f2bf(pacc[jj][e]); } } }
    __syncthreads();
    { bf16_t* OI = (bf16_t*)(c.ws + WS_RB + RB_OINTRA);
#pragma unroll
      for (int dd = 0; dd < 2; ++dd) { const int dt = 2 * w + dd; bf16x8 a[2];
#pragma unroll
          for (int ks = 0; ks < 2; ++ks) a[ks] = *(const LAS bf16x8*)(VTs + (16 * dt + lr) * 72 + 32 * ks + 8 * lq);
#pragma unroll
          for (int it = 0; it < 4; ++it) { f32x4 o = {0.f, 0.f, 0.f, 0.f};
#pragma unroll
              for (int ks = 0; ks < 2; ++ks) { const bf16x8 b = *(const LAS bf16x8*)(Ps + (16 * it + lr) * 72 + 32 * ks + 8 * lq); o = __builtin_amdgcn_mfma_f32_16x16x32_bf16(a[ks], b, o, 0, 0, 0); }

              u32x2 ov; ov.x = cvt_pk_bf16(o[0], o[1]); ov.y = cvt_pk_bf16(o[2], o[3]);
              *(u32x2*)(OI + (size_t)(row0 + 16 * it + lr) * D + h * 256 + 16 * dt + 4 * lq) = ov; } } }
    { bf16_t* vg = (bf16_t*)(c.ws + WS_RB + RB_VTG) + (size_t)un * 16384;
#pragma unroll
      for (int i = 0; i < 4; ++i) { const int id = tid + 512 * i, dv = id >> 3, tc = id & 7;
          *(u32x4*)(vg + ((((dv >> 5) * 4 + (tc >> 1)) * 64) + (tc & 1) * 32 + (dv & 31)) * 8) = *(const LAS u32x4*)(VTs + dv * 72 + tc * 8); } }
    __syncthreads();
}
template <int N> __device__ __forceinline__ void vm_wait() { asm volatile("s_waitcnt vmcnt(%0)" :: "n"(N) : "memory"); }
__device__ __forceinline__ void gla_b2_unit(const Ctx& c, int un3) {
    const int lane = c.lane, lr = lane & 31, hi = lane >> 5, w = c.wave & 3, half = un3 & 1, un2 = un3 >> 1, dvs = half * 4 + w;
    const int h = un2 & 3, b = (un2 >> 2) & 3, dir = un2 >> 4;
    volatile LAS unsigned* cntF = (volatile LAS unsigned*)(c.lds + 3 * 33280 + 4 * 5120);
    volatile LAS unsigned* cntD = (volatile LAS unsigned*)(c.lds + 3 * 33280 + 4 * 5120 + 64);
    const char* QDF = (const char*)(c.ws + WS_RB + RB_QDF) + (size_t)dir * 1088 * 16384;
    const char* KDT = (const char*)(c.ws + WS_RB + RB_KDT) + (size_t)dir * 1088 * 16384;
    const char* VTG = (const char*)(c.ws + WS_RB + RB_VTG) + (size_t)dvs * 4096;
    const char* DEC = (const char*)(c.ws + WS_RB + RB_DECAY) + (size_t)dir * 1088 * 512;
    bf16_t* OUT = (bf16_t*)(c.ws + WS_RB + (dir == 0 ? RB_OF : RB_OB)) + (size_t)(((b * 4 + h) * 8 + dvs) * NKEY) * 32;
    constexpr int STG = 33280;
    LAS unsigned char* OT = c.lds + 3 * STG + w * 5120;
    const unsigned loff = (unsigned)lane * 16u;
#define B2_CHUNK(step) ((step) < 4 ? 256 + 4 * b + (dir == 0 ? (step) : 3 - (step)) : 64 * b + (dir == 0 ? (step) - 4 : 67 - (step)))
#define B2_ISSUE(step) do { const int un_ = B2_CHUNK(step) * 4 + h; LAS unsigned char* lb_ = c.lds + ((step) % 3) * STG; \
        const char* q_ = QDF + (size_t)un_ * 16384 + loff + w * 4096; const char* k_ = KDT + (size_t)un_ * 16384 + loff + w * 4096; \
        _Pragma("unroll") for (int i_ = 0; i_ < 4; ++i_) __builtin_amdgcn_global_load_lds((const unsigned*)(q_ + i_ * 1024), (LAS unsigned*)(lb_ + w * 4096 + i_ * 1024), 16, 0, 0); \
        _Pragma("unroll") for (int i_ = 0; i_ < 4; ++i_) __builtin_amdgcn_global_load_lds((const unsigned*)(k_ + i_ * 1024), (LAS unsigned*)(lb_ + 16384 + w * 4096 + i_ * 1024), 16, 0, 0); \
        if (lane < 8) __builtin_amdgcn_global_load_lds((const unsigned*)(DEC + (size_t)un_ * 512 + w * 128 + loff), (LAS unsigned*)(lb_ + 32768 + w * 128), 16, 0, 0); } while (0)
#define B2_SPIN(cnt, target) do { while (*(cnt) < (unsigned)(target)) __builtin_amdgcn_s_sleep(1); asm volatile("" ::: "memory"); } while (0)
#define B2_ARRIVE(cnt) do { if (lane == 0) { const unsigned one_ = 1u; asm volatile("ds_add_u32 %0, %1" :: "v"((unsigned)(size_t)(cnt)), "v"(one_) : "memory"); } } while (0)
    if (c.wave >= 4) {
#pragma unroll 1
        for (int t = 0; t < 68; ++t) {
            if (t >= 3) B2_SPIN(cntD, 4 * (t - 2));
            B2_ISSUE(t);
            if (t >= 1) { vm_wait<9>(); B2_ARRIVE(cntF); }
        }
        vm_wait<0>(); B2_ARRIVE(cntF);
        return;
    }
#define B2_VT(step, vt) do { const char* v_ = VTG + (size_t)(B2_CHUNK(step) * 4 + h) * 32768 + loff; \
        asm volatile("global_load_dwordx4 %0, %4, off\n\tglobal_load_dwordx4 %1, %4, off offset:1024\n\tglobal_load_dwordx4 %2, %4, off offset:2048\n\tglobal_load_dwordx4 %3, %4, off offset:3072" \
                     : "=&v"(vt[0]), "=&v"(vt[1]), "=&v"(vt[2]), "=&v"(vt[3]) : "v"(v_) : "memory"); } while (0)
#define B2_VT_WAIT(N, vt) asm volatile("s_waitcnt vmcnt(%4)" : "+v"(vt[0]), "+v"(vt[1]), "+v"(vt[2]), "+v"(vt[3]) : "n"(N) : "memory")
    f32x16 S[4];
#pragma unroll
    for (int ct = 0; ct < 4; ++ct)
#pragma unroll
        for (int r = 0; r < 16; ++r) S[ct][r] = 0.f;
    bf16x8 vtA[4], vtB[4];
    B2_VT(0, vtA);
#define B2_STEP(step, vt, vtn) do { \
        B2_SPIN(cntF, 4 * ((step) + 1));     \
        if ((step) + 1 < 68) B2_VT((step) + 1, vtn); \
        const int n_ = B2_CHUNK(step); const int key0 = (n_ < 256) ? CTXL + (n_ & 63) * 64 : (n_ - 256 - 4 * b) * 64; \
        const LAS unsigned char* lb = c.lds + ((step) % 3) * STG + loff; \
          \
        f32x16 o[2]; \
        _Pragma("unroll") for (int tt = 0; tt < 2; ++tt) { _Pragma("unroll") for (int r = 0; r < 16; ++r) o[tt][r] = 0.f; } \
        { u32x4 bw[8]; \
          _Pragma("unroll") for (int ct = 0; ct < 4; ++ct) { _Pragma("unroll") for (int s = 0; s < 2; ++s) { bw[ct * 2 + s].x = cvt_pk_bf16(S[ct][8 * s], S[ct][8 * s + 1]); bw[ct * 2 + s].y = cvt_pk_bf16(S[ct][8 * s + 2], S[ct][8 * s + 3]); bw[ct * 2 + s].z = cvt_pk_bf16(S[ct][8 * s + 4], S[ct][8 * s + 5]); bw[ct * 2 + s].w = cvt_pk_bf16(S[ct][8 * s + 6], S[ct][8 * s + 7]); } } \
          _Pragma("unroll") for (int tt = 0; tt < 2; ++tt) { bf16x8 qa[8]; \
            _Pragma("unroll") for (int i = 0; i < 8; ++i) qa[i] = *(const LAS bf16x8*)(lb + (tt * 8 + i) * 1024); \
            __builtin_amdgcn_sched_barrier(0); \
            _Pragma("unroll") for (int i = 0; i < 8; ++i) o[tt] = __builtin_amdgcn_mfma_f32_32x32x16_bf16(__builtin_bit_cast(bf16x8, bw[i]), qa[i], o[tt], 0, 0, 0); \
            __builtin_amdgcn_sched_barrier(0); } } \
          \
        _Pragma("unroll") for (int tt = 0; tt < 2; ++tt) { bf16_t* op = OUT + (size_t)(key0 + 32 * tt + lr) * 32 + 4 * hi; \
            _Pragma("unroll") for (int gq = 0; gq < 4; ++gq) { u32x2 ov; ov.x = cvt_pk_bf16(o[tt][4 * gq], o[tt][4 * gq + 1]); ov.y = cvt_pk_bf16(o[tt][4 * gq + 2], o[tt][4 * gq + 3]); *(u32x2*)(op + 8 * gq) = ov; } } \
          \
        if ((step) == 0) B2_VT_WAIT(12, vt); else if ((step) == 67) B2_VT_WAIT(16, vt); else B2_VT_WAIT(20, vt); \
        const LAS float* dcl = (const LAS float*)(c.lds + ((step) % 3) * STG + 32768); \
        _Pragma("unroll") for (int cp = 0; cp < 2; ++cp) { bf16x8 ka[8]; f32x4 dq[8]; \
          _Pragma("unroll") for (int i = 0; i < 8; ++i) ka[i] = *(const LAS bf16x8*)(lb + 16384 + (cp * 8 + i) * 1024); \
          _Pragma("unroll") for (int i = 0; i < 8; ++i) dq[i] = *(const LAS f32x4*)(dcl + 32 * (2 * cp + (i >> 2)) + 8 * (i & 3) + 4 * hi); \
          __builtin_amdgcn_sched_barrier(0); \
          _Pragma("unroll") for (int cc = 0; cc < 2; ++cc) { _Pragma("unroll") for (int gq = 0; gq < 4; ++gq) { _Pragma("unroll") for (int e = 0; e < 4; ++e) S[2 * cp + cc][4 * gq + e] *= dq[cc * 4 + gq][e]; } } \
          _Pragma("unroll") for (int ks = 0; ks < 4; ++ks) { _Pragma("unroll") for (int cc = 0; cc < 2; ++cc) S[2 * cp + cc] = __builtin_amdgcn_mfma_f32_32x32x16_bf16(ka[cc * 4 + ks], vt[ks], S[2 * cp + cc], 0, 0, 0); } \
          __builtin_amdgcn_sched_barrier(0); } \
        asm volatile("s_waitcnt lgkmcnt(0)" ::: "memory"); B2_ARRIVE(cntD);     \
    } while (0)
#pragma unroll 1
    for (int step = 0; step < 68; step += 2) { B2_STEP(step, vtA, vtB); B2_STEP(step + 1, vtB, vtA); }
    asm volatile("s_waitcnt vmcnt(0) lgkmcnt(0)" ::: "memory");
#undef B2_STEP
#undef B2_VT_WAIT
#undef B2_CHUNK
#undef B2_ISSUE
#undef B2_VT
#undef B2_SPIN
#undef B2_ARRIVE
}
struct FinRaw { u32x2 a[4], b[4], d[4], r[4]; };
__device__ __forceinline__ void gla_finish_load(const Ctx& c, int row, FinRaw& F) {
    const int lane = c.lane; const bf16_t* OI = (const bf16_t*)(c.ws + WS_RB + RB_OINTRA) + (size_t)row * D;
    const bool lat = row < TL; const int b = lat ? (row >> 12) : ((row - TL) >> 8), key = lat ? CTXL + (row & 4095) : ((row - TL) & 255);
    const bf16_t* OFp = (const bf16_t*)(c.ws + WS_RB + RB_OF) + ((size_t)((b * 4) * 8 + (lane >> 3)) * NKEY + key) * 32 + (lane & 7) * 4; const bf16_t* OBp = OFp + (size_t)(RB_OB - RB_OF) / 2;
    const bf16_t* R = (const bf16_t*)(c.ws + WS_RA) + (size_t)row * NZ + ZRB;
#pragma unroll
    for (int h = 0; h < 4; ++h) { const int cc = h * 256 + 4 * lane; const size_t ho = (size_t)h * 8 * NKEY * 32; F.a[h] = *(const u32x2*)(OI + cc); F.b[h] = *(const u32x2*)(OFp + ho); F.d[h] = *(const u32x2*)(OBp + ho); F.r[h] = *(const u32x2*)(R + cc); }
}
__device__ __forceinline__ void gla_finish_row(const Ctx& c, int l, int row, const FinRaw& F) {
    const int lane = c.lane; bf16_t* Y = (bf16_t*)(c.ws + WS_RB + RB_YCAT) + (size_t)row * 3072 + D;
    const f32x4 gv = *(const f32x4*)(c.in[I_GGLA] + l * 256 + 4 * lane);
    float o[4][4], ss[4];
#pragma unroll
    for (int h = 0; h < 4; ++h) { const u32x2 a = F.a[h], b = F.b[h], d = F.d[h];
        o[h][0] = bflo(a.x) + bflo(b.x) + bflo(d.x); o[h][1] = bfhi(a.x) + bfhi(b.x) + bfhi(d.x); o[h][2] = bflo(a.y) + bflo(b.y) + bflo(d.y); o[h][3] = bfhi(a.y) + bfhi(b.y) + bfhi(d.y);
        ss[h] = (o[h][0] * o[h][0] + o[h][1] * o[h][1]) + (o[h][2] * o[h][2] + o[h][3] * o[h][3]); }
#pragma unroll
    for (int h = 0; h < 4; ++h) ss[h] = wave_sum(ss[h]);
#pragma unroll
    for (int h = 0; h < 4; ++h) { const int cc = h * 256 + 4 * lane; const u32x2 r = F.r[h]; const float rstd = 1.0f / sqrtf(ss[h] * (1.f / 256.f) + EPS);
        u32x2 ov; ov.x = cvt_pk_bf16(o[h][0] * rstd * gv[0] * bflo(r.x), o[h][1] * rstd * gv[1] * bfhi(r.x)); ov.y = cvt_pk_bf16(o[h][2] * rstd * gv[2] * bflo(r.y), o[h][3] * rstd * gv[3] * bfhi(r.y));
        *(u32x2*)(Y + cc) = ov; }
}
__device__ __forceinline__ void rope_angle(int pos_row, int pos_col, int j, float& cs, float& sn) {
    const int axis = j >> 5, f = j & 15; const float inv = __expf(-(float)(2 * f) * (1.f / 32.f) * 9.210340371976184f);
    float rev = (float)(axis == 0 ? pos_row : pos_col) * inv * 0.15915494309189535f; rev -= floorf(rev); sn = __builtin_amdgcn_sinf(rev); cs = __builtin_amdgcn_cosf(rev);
}
struct C1Raw { u32x2 ckv; unsigned cq[3]; bf16_t kro; u32x2 kvw[8]; unsigned qnw[8]; bf16_t qrw[8]; };
__device__ __forceinline__ void mla_c1_load(const Ctx& c, int row, bool do_q, C1Raw& R) {
    const int lane = c.lane;
    const bf16_t* Zr = (const bf16_t*)(c.ws + WS_RA) + (size_t)row * NZ;
    const bf16_t* KV = (const bf16_t*)(c.ws + WS_RB + RB_KVRAW) + (size_t)row * 2048; const bf16_t* QR = (const bf16_t*)(c.ws + WS_RB + RB_QRAW) + (size_t)row * 1536;
    R.ckv = *(const u32x2*)(Zr + ZCKV + 4 * lane);
#pragma unroll
    for (int i = 0; i < 3; ++i) R.cq[i] = *(const unsigned*)(Zr + ZCQ + 128 * i + 2 * lane);
    R.kro = Zr[ZKR + lane];
#pragma unroll
    for (int h = 0; h < 8; ++h) R.kvw[h] = *(const u32x2*)(KV + h * 256 + 4 * lane);
    if (do_q) {
#pragma unroll
        for (int h = 0; h < 8; ++h) { R.qnw[h] = *(const unsigned*)(QR + h * 192 + 2 * lane); R.qrw[h] = QR[h * 192 + 128 + lane]; }
    }
}
__device__ __forceinline__ void mla_c1_row(const Ctx& c, int l, int row, bool do_q, const C1Raw& R) {
    const int lane = c.lane; const bool lat = row < TL; const int b = lat ? (row >> 12) : ((row - TL) >> 8), t = lat ? (row & 4095) : ((row - TL) & 255), key = lat ? (CTXL + t) : t;
    bf16_t* KG = (bf16_t*)(c.ws + WS_RB + RB_KG); bf16_t* VG = (bf16_t*)(c.ws + WS_RB + RB_VG);
    float rs_kv, rs_q;
    { const u32x2 w = R.ckv; const float a0 = bflo(w.x), a1 = bfhi(w.x), a2 = bflo(w.y), a3 = bfhi(w.y);
      rs_kv = 1.0f / sqrtf(wave_sum((a0 * a0 + a1 * a1) + (a2 * a2 + a3 * a3)) * (1.f / 256.f) + EPS);
      float s = 0.f;
#pragma unroll
      for (int i = 0; i < 3; ++i) { const unsigned w2 = R.cq[i]; const float q0 = bflo(w2), q1 = bfhi(w2); s += q0 * q0 + q1 * q1; }
      rs_q = 1.0f / sqrtf(wave_sum(s) * (1.f / 384.f) + EPS); }
    float cs = 1.f, sn = 0.f; if (lat) rope_angle(t >> 6, t & 63, lane, cs, sn);
    const bool second = (lane >> 4) & 1;
    float kr;
    { const float v = bf2f(R.kro); const float rr = 1.0f / sqrtf(wave_sum(v * v) * (1.f / 64.f) + EPS); float x = v * rr * c.in[I_GKR][l * 64 + lane];
      const float xp = sx<16>(x); kr = lat ? (second ? (x * cs + xp * sn) : (x * cs - xp * sn)) : x; }
    const bf16_t krb = f2bf(kr);
    const f32x4 gkn = *(const f32x4*)(c.in[I_GKN] + l * 128 + 4 * (lane & 31));
    float ssk[8]; float ak[8][4];
#pragma unroll
    for (int h = 0; h < 8; ++h) { ak[h][0] = bflo(R.kvw[h].x) * rs_kv; ak[h][1] = bfhi(R.kvw[h].x) * rs_kv; ak[h][2] = bflo(R.kvw[h].y) * rs_kv; ak[h][3] = bfhi(R.kvw[h].y) * rs_kv;
        ssk[h] = (ak[h][0] * ak[h][0] + ak[h][1] * ak[h][1]) + (ak[h][2] * ak[h][2] + ak[h][3] * ak[h][3]); }
#pragma unroll
    for (int h = 0; h < 8; ++h) ssk[h] = half_sum(ssk[h]);
    { bf16_t* kgp = KG + (size_t)(b * NKEY + key) * (8 * 192); bf16_t* vgp = VG + (size_t)(b * NKEY + key) * (8 * 128);
#pragma unroll
      for (int h = 0; h < 8; ++h) {
        if (lane < 32) { const float rn = 1.0f / sqrtf(ssk[h] * (1.f / 128.f) + EPS); u32x2 o; o.x = cvt_pk_bf16(ak[h][0] * rn * gkn[0], ak[h][1] * rn * gkn[1]); o.y = cvt_pk_bf16(ak[h][2] * rn * gkn[2], ak[h][3] * rn * gkn[3]);
            *(u32x2*)(kgp + h * 192 + 4 * lane) = o; }
        else { u32x2 o; o.x = cvt_pk_bf16(ak[h][0], ak[h][1]); o.y = cvt_pk_bf16(ak[h][2], ak[h][3]); *(u32x2*)(vgp + h * 128 + 4 * (lane - 32)) = o; }
        kgp[h * 192 + 128 + lane] = krb;
      } }
    __builtin_amdgcn_sched_barrier(0);
    if (lane == 0) ((float*)(c.ws + WS_RSQ))[row] = rs_q;
    if (!do_q) return;
    bf16_t* QF = lat ? (bf16_t*)(c.ws + WS_RB + RB_QFL) : (bf16_t*)(c.ws + WS_RB + RB_QFC); const int nq = lat ? SEQ : CTXL;
    const float QS = 0.07216878364870322f * 1.4426950408889634f;
    const f32x2 gqn = *(const f32x2*)(c.in[I_GQN] + l * 128 + 2 * lane); const float gqr = c.in[I_GQR][l * 64 + lane];
    float n0[8], n1[8], r0[8], sn_[8], sr_[8];
#pragma unroll
    for (int h = 0; h < 8; ++h) { n0[h] = bflo(R.qnw[h]) * rs_q; n1[h] = bfhi(R.qnw[h]) * rs_q; r0[h] = bf2f(R.qrw[h]) * rs_q; sn_[h] = n0[h] * n0[h] + n1[h] * n1[h]; sr_[h] = r0[h] * r0[h]; }
#pragma unroll
    for (int h = 0; h < 8; ++h) { sn_[h] = wave_sum(sn_[h]); sr_[h] = wave_sum(sr_[h]); }
#pragma unroll
    for (int h = 0; h < 8; ++h) {
        const float rn = 1.0f / sqrtf(sn_[h] * (1.f / 128.f) + EPS), rr = 1.0f / sqrtf(sr_[h] * (1.f / 64.f) + EPS);
        bf16_t* qp = QF + (size_t)(b * nq + t) * (8 * 192) + h * 192;
        *(unsigned*)(qp + 2 * lane) = cvt_pk_bf16(n0[h] * rn * gqn[0] * QS, n1[h] * rn * gqn[1] * QS);
        const float x = r0[h] * rr * gqr; const float xp = sx<16>(x); const float xr = lat ? (second ? (x * cs + xp * sn) : (x * cs - xp * sn)) : x;
        qp[128 + lane] = f2bf(xr * QS);
    }
}
__device__ __forceinline__ bf16x8 tr_pair(unsigned a0, unsigned a1) {
    bf16x4 x, y; asm volatile("ds_read_b64_tr_b16 %0, %2\n\tds_read_b64_tr_b16 %1, %3\n\ts_waitcnt lgkmcnt(0)" : "=&v"(x), "=&v"(y) : "v"(a0), "v"(a1) : "memory");
    return (bf16x8){x[0], x[1], x[2], x[3], y[0], y[1], y[2], y[3]};
}
__device__ __forceinline__ void k2_issue(bf16x8& a0, bf16x8& a1, unsigned addr) {
    asm volatile("ds_read_b128 %0, %2\n\tds_read_b128 %1, %2 offset:12288" : "=&v"(a0), "=&v"(a1) : "v"(addr) : "memory");
}
template <int N> __device__ __forceinline__ void k2_wait(bf16x8& a0, bf16x8& a1) { asm volatile("s_waitcnt lgkmcnt(%2)" : "+v"(a0), "+v"(a1) : "n"(N) : "memory"); }
template <int OFF>
__device__ __forceinline__ void tr8_issue(bf16x4 (&x)[8], unsigned a0, unsigned a1, unsigned a2, unsigned a3, unsigned d1) {
    asm volatile("ds_read_b64_tr_b16 %0, %8 offset:%13\n\tds_read_b64_tr_b16 %2, %9 offset:%13\n\tds_read_b64_tr_b16 %4, %10 offset:%13\n\tds_read_b64_tr_b16 %6, %11 offset:%13\n\t"
                 "v_add_u32 %8, %8, %12\n\tv_add_u32 %9, %9, %12\n\tv_add_u32 %10, %10, %12\n\tv_add_u32 %11, %11, %12\n\t"
                 "ds_read_b64_tr_b16 %1, %8 offset:%13\n\tds_read_b64_tr_b16 %3, %9 offset:%13\n\tds_read_b64_tr_b16 %5, %10 offset:%13\n\tds_read_b64_tr_b16 %7, %11 offset:%13"
                 : "=&v"(x[0]), "=&v"(x[1]), "=&v"(x[2]), "=&v"(x[3]), "=&v"(x[4]), "=&v"(x[5]), "=&v"(x[6]), "=&v"(x[7]), "+v"(a0), "+v"(a1), "+v"(a2), "+v"(a3)
                 : "v"(d1), "n"(OFF) : "memory");
}
__device__ __forceinline__ void tr8_wait(bf16x4 (&x)[8]) {
    asm volatile("s_waitcnt lgkmcnt(0)" : "+v"(x[0]), "+v"(x[1]), "+v"(x[2]), "+v"(x[3]), "+v"(x[4]), "+v"(x[5]), "+v"(x[6]), "+v"(x[7]) :: "memory");
}
__device__ __forceinline__ void attn_unit(const Ctx& c, int l, const bf16_t* Qraw  , const float* rsq  , int t0  ,
                                          const bf16_t* Kp  , const bf16_t* Vp  , int nt, bf16_t* Op  ) {
    constexpr int STG = 40960, KB = 24576;
    const int tid = c.tid, lane = c.lane, w = c.wave, lr = lane & 31, hi = lane >> 5;
    const unsigned lds0 = (unsigned)(size_t)c.lds;
    unsigned ksrc[3], vsrc[2];
#pragma unroll
    for (int i = 0; i < 3; ++i) { const int P = (w + 8 * i) * 64 + lane, row = P / 24, cp = P % 24, ch = (cp & ~7) | ((cp & 7) ^ ((row >> 1) & 7)); ksrc[i] = row * 3072 + ch * 16; }
#pragma unroll
    for (int i = 0; i < 2; ++i) { const int P = (w + 8 * i) * 64 + lane, row = P >> 4, cp = P & 15, ch = cp ^ (((row & 3) << 2) | ((row >> 2) & 3)); vsrc[i] = row * 2048 + ch * 16; }
#define ATT_ISSUE(tile, stg) do { const char* kt_ = (const char*)Kp + (size_t)(tile) * (64 * 3072); const char* vt_ = (const char*)Vp + (size_t)(tile) * (64 * 2048); \
        _Pragma("unroll") for (int i_ = 0; i_ < 3; ++i_) __builtin_amdgcn_global_load_lds((const unsigned*)(kt_ + ksrc[i_]), (LAS unsigned*)(c.lds + (stg) * STG + (w + 8 * i_) * 1024), 16, 0, 0); \
        _Pragma("unroll") for (int i_ = 0; i_ < 2; ++i_) __builtin_amdgcn_global_load_lds((const unsigned*)(vt_ + vsrc[i_]), (LAS unsigned*)(c.lds + (stg) * STG + KB + (w + 8 * i_) * 1024), 16, 0, 0); } while (0)
    bf16x8 qf[12];
    {
      const int qr = 32 * w + lr; const bf16_t* qrow = Qraw + (size_t)qr * 1536 + 8 * hi; const float rs = rsq[qr];
      u32x4 raw[12]; float sn = 0.f, sr = 0.f;
#pragma unroll
      for (int s = 0; s < 12; ++s) { raw[s] = *(const u32x4*)(qrow + 16 * s); const u32x4 wv = raw[s];
          const float q2 = (bflo(wv.x) * bflo(wv.x) + bfhi(wv.x) * bfhi(wv.x)) + (bflo(wv.y) * bflo(wv.y) + bfhi(wv.y) * bfhi(wv.y)) + (bflo(wv.z) * bflo(wv.z) + bfhi(wv.z) * bfhi(wv.z)) + (bflo(wv.w) * bflo(wv.w) + bfhi(wv.w) * bfhi(wv.w));
          if (s < 8) sn += q2; else sr += q2; }
      sn = sum32(sn) * rs * rs; sr = sum32(sr) * rs * rs;
      const float QS = 0.07216878364870322f * 1.4426950408889634f;
      const float rn = rs * QS / sqrtf(sn * (1.f / 128.f) + EPS), rr = rs * QS / sqrtf(sr * (1.f / 64.f) + EPS);
      const float* gqn = c.in[I_GQN] + l * 128 + 8 * hi; const float* gqr = c.in[I_GQR] + l * 64 + 8 * hi;
#pragma unroll
      for (int s = 0; s < 8; ++s) { const f32x4 g0 = *(const f32x4*)(gqn + 16 * s) * rn, g1 = *(const f32x4*)(gqn + 16 * s + 4) * rn; const u32x4 wv = raw[s]; u32x4 pk;
          pk.x = cvt_pk_bf16(bflo(wv.x) * g0[0], bfhi(wv.x) * g0[1]); pk.y = cvt_pk_bf16(bflo(wv.y) * g0[2], bfhi(wv.y) * g0[3]); pk.z = cvt_pk_bf16(bflo(wv.z) * g1[0], bfhi(wv.z) * g1[1]); pk.w = cvt_pk_bf16(bflo(wv.w) * g1[2], bfhi(wv.w) * g1[3]);
          qf[s] = __builtin_bit_cast(bf16x8, pk); }
      float x[4][8];
#pragma unroll
      for (int s = 0; s < 4; ++s) { const f32x4 g0 = *(const f32x4*)(gqr + 16 * s) * rr, g1 = *(const f32x4*)(gqr + 16 * s + 4) * rr; const u32x4 wv = raw[8 + s];
          x[s][0] = bflo(wv.x) * g0[0]; x[s][1] = bfhi(wv.x) * g0[1]; x[s][2] = bflo(wv.y) * g0[2]; x[s][3] = bfhi(wv.y) * g0[3]; x[s][4] = bflo(wv.z) * g1[0]; x[s][5] = bfhi(wv.z) * g1[1]; x[s][6] = bflo(wv.w) * g1[2]; x[s][7] = bfhi(wv.w) * g1[3]; }
      if (t0 >= 0) { const int t = t0 + qr; const float prow = (float)(t >> 6), pcol = (float)(t & 63);
#pragma unroll
          for (int i = 0; i < 8; ++i) { const float inv = __expf(-(float)(2 * (8 * hi + i)) * (1.f / 32.f) * 9.210340371976184f) * 0.15915494309189535f;
              float r0 = prow * inv; r0 -= floorf(r0); float r1 = pcol * inv; r1 -= floorf(r1);
              const float c0 = __builtin_amdgcn_cosf(r0), s0 = __builtin_amdgcn_sinf(r0), c1 = __builtin_amdgcn_cosf(r1), s1 = __builtin_amdgcn_sinf(r1);
              const float a0 = x[0][i], b0 = x[1][i], a1 = x[2][i], b1 = x[3][i];
              x[0][i] = a0 * c0 - b0 * s0; x[1][i] = b0 * c0 + a0 * s0; x[2][i] = a1 * c1 - b1 * s1; x[3][i] = b1 * c1 + a1 * s1; } }
#pragma unroll
      for (int s = 0; s < 4; ++s) { u32x4 pk; pk.x = cvt_pk_bf16(x[s][0], x[s][1]); pk.y = cvt_pk_bf16(x[s][2], x[s][3]); pk.z = cvt_pk_bf16(x[s][4], x[s][5]); pk.w = cvt_pk_bf16(x[s][6], x[s][7]); qf[8 + s] = __builtin_bit_cast(bf16x8, pk); }
      __builtin_amdgcn_sched_barrier(0); }
    unsigned kbase = lr * 384, y16 = (unsigned)((hi ^ ((lr >> 1) & 7)) << 4);
    unsigned vbase, q64, vd1;
    { const int blk = (lane >> 4) & 1, q = (lane & 15) >> 2, p = lane & 3; const int lb = (2 * blk + (p >> 1)) ^ hi;
      vbase = KB + 256 * (4 * hi + q) + 16 * lb + 8 * (p & 1); q64 = (unsigned)(q << 6); vd1 = 2048u + ((lb & 2) ? -32 : 32); }
    f32x16 o[4];
#pragma unroll
    for (int cc = 0; cc < 4; ++cc)
#pragma unroll
        for (int r = 0; r < 16; ++r) o[cc][r] = 0.f;
    float m = -1e30f, lsum = 0.f;
    ATT_ISSUE(0, 0);
    if (nt > 1) ATT_ISSUE(1, 1);
    asm volatile("" :: "v"(qf[0]), "v"(qf[1]), "v"(qf[2]), "v"(qf[3]), "v"(qf[4]), "v"(qf[5]), "v"(qf[6]), "v"(qf[7]), "v"(qf[8]), "v"(qf[9]), "v"(qf[10]), "v"(qf[11]));
#pragma unroll 1
    for (int j = 0; j < nt; ++j) {
        if (j + 1 < nt) asm volatile("s_waitcnt vmcnt(5)" ::: "memory"); else asm volatile("s_waitcnt vmcnt(0)" ::: "memory");
        asm volatile("s_waitcnt lgkmcnt(0)" ::: "memory"); __builtin_amdgcn_s_barrier(); asm volatile("" ::: "memory");
        if (j + 2 < nt) ATT_ISSUE(j + 2, (j + 2) % 3);
        const unsigned sb = lds0 + (unsigned)((j % 3) * STG);
        asm volatile("" : "+v"(kbase), "+v"(y16), "+v"(vbase), "+v"(q64), "+v"(vd1));
        const unsigned kb_ = sb + kbase;
        f32x16 st[2];
#pragma unroll
        for (int kt = 0; kt < 2; ++kt)
#pragma unroll
            for (int r = 0; r < 16; ++r) st[kt][r] = 0.f;
        { bf16x8 ka[2][2];
#define KADDR(s_) (kb_ + (y16 ^ (unsigned)(((2 * (s_)) & 7) << 4)) + (unsigned)((((2 * (s_)) & ~7) << 4)))
          k2_issue(ka[0][0], ka[0][1], KADDR(0));
#pragma unroll
          for (int s = 0; s < 12; ++s) {
              if (s + 1 < 12) { k2_issue(ka[(s + 1) & 1][0], ka[(s + 1) & 1][1], KADDR(s + 1)); k2_wait<2>(ka[s & 1][0], ka[s & 1][1]); }
              else k2_wait<0>(ka[s & 1][0], ka[s & 1][1]);
              st[0] = __builtin_amdgcn_mfma_f32_32x32x16_bf16(ka[s & 1][0], qf[s], st[0], 0, 0, 0);
              st[1] = __builtin_amdgcn_mfma_f32_32x32x16_bf16(ka[s & 1][1], qf[s], st[1], 0, 0, 0); }
#undef KADDR
        }
        bf16x4 vx[8];
        tr8_issue<0>(vx, sb + vbase + (q64 ^ 0u), sb + vbase + (q64 ^ 64u), sb + vbase + (q64 ^ 128u), sb + vbase + (q64 ^ 192u), vd1);
        float mx = st[0][0];
#pragma unroll
        for (int r = 1; r < 16; ++r) mx = fmaxf(mx, st[0][r]);
#pragma unroll
        for (int r = 0; r < 16; ++r) mx = fmaxf(mx, st[1][r]);
        mx = max32(mx);
        const float mn = fmaxf(m, mx), alpha = __builtin_amdgcn_exp2f(m - mn); m = mn;
        float ps = 0.f;
#pragma unroll
        for (int kt = 0; kt < 2; ++kt)
#pragma unroll
            for (int r = 0; r < 16; ++r) { st[kt][r] = __builtin_amdgcn_exp2f(st[kt][r] - mn); ps += st[kt][r]; }
        lsum = lsum * alpha + ps;
        if (__any(alpha != 1.0f)) {
#pragma unroll
            for (int cc = 0; cc < 4; ++cc)
#pragma unroll
                for (int r = 0; r < 16; ++r) o[cc][r] *= alpha; }
#define ATT_PV(KT, S2, NEXT_OFF, HAS_NEXT) do { u32x4 pw; pw.x = cvt_pk_bf16(st[KT][8 * S2], st[KT][8 * S2 + 1]); pw.y = cvt_pk_bf16(st[KT][8 * S2 + 2], st[KT][8 * S2 + 3]); pw.z = cvt_pk_bf16(st[KT][8 * S2 + 4], st[KT][8 * S2 + 5]); pw.w = cvt_pk_bf16(st[KT][8 * S2 + 6], st[KT][8 * S2 + 7]); \
            const bf16x8 pb = __builtin_bit_cast(bf16x8, pw); tr8_wait(vx); bf16x8 af[4]; \
            _Pragma("unroll") for (int cc = 0; cc < 4; ++cc) af[cc] = (bf16x8){vx[2 * cc][0], vx[2 * cc][1], vx[2 * cc][2], vx[2 * cc][3], vx[2 * cc + 1][0], vx[2 * cc + 1][1], vx[2 * cc + 1][2], vx[2 * cc + 1][3]}; \
            if (HAS_NEXT) tr8_issue<NEXT_OFF>(vx, sb + vbase + (q64 ^ 0u), sb + vbase + (q64 ^ 64u), sb + vbase + (q64 ^ 128u), sb + vbase + (q64 ^ 192u), vd1); \
            _Pragma("unroll") for (int cc = 0; cc < 4; ++cc) o[cc] = __builtin_amdgcn_mfma_f32_32x32x16_bf16(af[cc], pb, o[cc], 0, 0, 0); } while (0)
        ATT_PV(0, 0, 4096, true); ATT_PV(0, 1, 8192, true); ATT_PV(1, 0, 12288, true); ATT_PV(1, 1, 0, false);
#undef ATT_PV
    }
    const float linv = 1.0f / sum32(lsum);
    bf16_t* orow = Op + (size_t)(32 * w + lr) * 3072;
#pragma unroll
    for (int cc = 0; cc < 4; ++cc)
#pragma unroll
        for (int g = 0; g < 4; ++g) { u32x2 ov; ov.x = cvt_pk_bf16(o[cc][4 * g] * linv, o[cc][4 * g + 1] * linv); ov.y = cvt_pk_bf16(o[cc][4 * g + 2] * linv, o[cc][4 * g + 3] * linv);
            *(u32x2*)(orow + 32 * cc + 8 * g + 4 * hi) = ov; }
    asm volatile("s_waitcnt vmcnt(0) lgkmcnt(0)" ::: "memory"); __builtin_amdgcn_s_barrier(); asm volatile("" ::: "memory");
#undef ATT_ISSUE
}
__device__ __forceinline__ void route_stage_w(const Ctx& c, int l) {
    LAS float* WT = (LAS float*)c.lds; const float* wr = c.in[I_WROUTER] + (size_t)l * D * NEXP;
    for (int i = c.tid; i < D * NEXP; i += NTHR) WT[(i & 15) * 1028 + (i >> 4)] = wr[i];
    __syncthreads();
}
struct RouteRaw { f32x4 xv[4]; };
__device__ __forceinline__ void route_load(const Ctx& c, int row, RouteRaw& R) { const float* xr = xout_row(c, row);
#pragma unroll
    for (int j = 0; j < 4; ++j) R.xv[j] = *(const f32x4*)(xr + 4 * c.lane + 256 * j); }
__device__ __forceinline__ void route_row(const Ctx& c, int l, int row, const RouteRaw& R) {
    const int lane = c.lane, bi = row_modidx(row); f32x4 hv[4];
    { const float* g = c.in[I_GFFN] + l * D; const float* shift = modp(c, l, bi, 3); const float* scale = modp(c, l, bi, 4); bf16_t* hrow = (bf16_t*)(c.ws + WS_H) + (size_t)row * D; float ss = 0.f;
#pragma unroll
      for (int j = 0; j < 4; ++j) { hv[j] = R.xv[j]; ss += (hv[j][0] * hv[j][0] + hv[j][1] * hv[j][1]) + (hv[j][2] * hv[j][2] + hv[j][3] * hv[j][3]); }
      const float rstd = 1.0f / sqrtf(wave_sum(ss) * (1.f / D) + EPS);
#pragma unroll
      for (int j = 0; j < 4; ++j) { const int cc = 4 * lane + 256 * j; const f32x4 gv = *(const f32x4*)(g + cc), sc = *(const f32x4*)(scale + cc), sh = *(const f32x4*)(shift + cc);
          hv[j] = hv[j] * rstd * gv * (sc + 1.0f) + sh;
          u32x2 o; o.x = cvt_pk_bf16(hv[j][0], hv[j][1]); o.y = cvt_pk_bf16(hv[j][2], hv[j][3]); *(u32x2*)(hrow + cc) = o; } }
    const LAS float* WT = (const LAS float*)c.lds; float lg[16];
#pragma unroll
    for (int e = 0; e < 16; ++e) { f32x2 a2 = {0.f, 0.f};
#pragma unroll
        for (int j = 0; j < 4; ++j) { const f32x4 wv = *(const LAS f32x4*)(WT + e * 1028 + 4 * lane + 256 * j); a2 += hv[j].lo * wv.lo; a2 += hv[j].hi * wv.hi; }
        lg[e] = a2[0] + a2[1]; if ((e & 3) == 3) __builtin_amdgcn_sched_barrier(0); }
    float a8[8], b4[4];
#pragma unroll
    for (int e = 0; e < 8; ++e) { auto r = __builtin_amdgcn_permlane32_swap(__float_as_uint(lg[e]), __float_as_uint(lg[e + 8]), false, false); a8[e] = __uint_as_float(r[0]) + __uint_as_float(r[1]); }
#pragma unroll
    for (int i = 0; i < 4; ++i) { auto r = __builtin_amdgcn_permlane16_swap(__float_as_uint(a8[i]), __float_as_uint(a8[i + 4]), false, false); float v = __uint_as_float(r[0]) + __uint_as_float(r[1]);
        v += __int_as_float(__builtin_amdgcn_update_dpp(0, __float_as_int(v), 0x128, 0xf, 0xf, true));
        v += __int_as_float(__builtin_amdgcn_update_dpp(0, __float_as_int(v), 0x124, 0xf, 0xf, true));
        v += __int_as_float(__builtin_amdgcn_update_dpp(0, __float_as_int(v), 0x4E, 0xf, 0xf, true));
        v += __int_as_float(__builtin_amdgcn_update_dpp(0, __float_as_int(v), 0xB1, 0xf, 0xf, true));
        b4[i] = v; }
    float mx = fmaxf(fmaxf(b4[0], b4[1]), fmaxf(b4[2], b4[3]));
    { auto r = __builtin_amdgcn_permlane16_swap(__float_as_uint(mx), __float_as_uint(mx), false, false); mx = fmaxf(__uint_as_float(r[0]), __uint_as_float(r[1])); }
    mx = max32(mx);
    float sum = 0.f;
#pragma unroll
    for (int i = 0; i < 4; ++i) { b4[i] = __expf(b4[i] - mx); sum += b4[i]; }
    { auto r = __builtin_amdgcn_permlane16_swap(__float_as_uint(sum), __float_as_uint(sum), false, false); sum = __uint_as_float(r[0]) + __uint_as_float(r[1]); }
    sum = sum32(sum);
    const float inv = 1.0f / sum; const int li = lane & 15, ex = li + 4 * ((lane >> 4) & 1) + 8 * (lane >> 5);
    const float mine = (li == 0 ? b4[0] : (li == 1 ? b4[1] : (li == 2 ? b4[2] : b4[3]))) * inv;
    float* AF = (float*)(c.ws + WS_AFFT);
    if (li < 4) { if (row < TL) AF[((size_t)(row >> 12) * 16 + ex) * SEQ + (row & 4095)] = mine; else AF[(size_t)NB * 16 * SEQ + ((size_t)((row - TL) >> 8) * 16 + ex) * CTXL + ((row - TL) & 255)] = mine; }
}
struct GuMap { int up; __device__ __forceinline__ int operator()(int n) const { return (n >> 7) * 256 + up * 128 + (n & 127); } };
struct IdMap { __device__ __forceinline__ int operator()(int n) const { return n; } };
__device__ __forceinline__ int wconv_queue(const Ctx& c, int l, int q, int maxu) {
    unsigned* ctr = (unsigned*)(c.ws + WS_CTL + 32768) + 64 * l + 16 * q; LAS int* ubox = (LAS int*)(c.lds + 4 * 64 * 65 * 4);
    const int nunits = (q == 0) ? GU_SPLIT * 256 : (q == 1 ? (NEXP - GU_SPLIT) * 256 : NEXP * 128);
    int n = 0;
    for (; n < maxu; ++n) { if (c.tid == 0) *ubox = (int)__hip_atomic_fetch_add(ctr, 1u, __ATOMIC_RELAXED, __HIP_MEMORY_SCOPE_AGENT);
        __syncthreads(); const int u = *ubox; __syncthreads(); if (u >= nunits) break;
        if (q == 2) { const int e = u >> 7, r = u & 127, nb = r >> 5, kb = r & 31;
            tconv_tile4(c, c.in[I_WED] + ((size_t)l * NEXP + e) * DEXP * D, D, kb * 64, nb * 256, (bf16_t*)(c.ws + WS_RB + RB_WD) + (size_t)e * D * DEXP, DEXP, kb * 64, IdMap{}); }
        else { const int e = (u >> 8) + (q == 1 ? GU_SPLIT : 0), r = u & 255, up = r >> 7, rr = r & 127, nb = rr >> 4, kb = rr & 15;
            const float* src = c.in[up ? I_WEU : I_WEG] + ((size_t)l * NEXP + e) * D * DEXP;
            bf16_t* dst = (q == 1) ? (bf16_t*)(c.ws + WS_RB + RB_WGU2) + (size_t)(e - GU_SPLIT) * 4096 * D : (bf16_t*)(c.ws + WS_RB + RB_WGU) + (size_t)e * 4096 * D;
            tconv_tile4(c, src, DEXP, kb * 64, nb * 256, dst, D, kb * 64, GuMap{up}); } }
    return n;
}
__device__ __forceinline__ void wconv_early(const Ctx& c, int l, int maxu) { const int n = wconv_queue(c, l, 2, maxu); if (n < maxu) (void)wconv_queue(c, l, 1, maxu - n); }
__device__ __forceinline__ void expert_wconv(const Ctx& c, int l) { (void)wconv_queue(c, l, 0, 1 << 30); (void)wconv_queue(c, l, 1, 1 << 30); (void)wconv_queue(c, l, 2, 1 << 30); }
__device__ __forceinline__ void topk_unit(const Ctx& c, int un, bool is_ctx) {
    const int tid = c.tid, lane = c.lane, w = c.wave;
    LAS unsigned* hist = (LAS unsigned*)c.lds;
    LAS unsigned* ctl = (LAS unsigned*)(c.lds + 1024);
    LAS unsigned* wsum = (LAS unsigned*)(c.lds + 1280);
    LAS int* list = (LAS int*)(c.lds + 2048);
    int b, e, ntok, cap; const float* src;
    if (!is_ctx) { b = un >> 4; e = un & 15; ntok = SEQ; cap = CAPL; src = (const float*)(c.ws + WS_AFFT) + ((size_t)b * 16 + e) * SEQ; }
    else { b = un >> 4; e = un & 15; ntok = CTXL; cap = CAPC; src = (const float*)(c.ws + WS_AFFT) + (size_t)NB * 16 * SEQ + ((size_t)b * 16 + e) * CTXL; }
    const bool have = 8 * tid < ntok; unsigned key[8];
    if (have) { const u32x4 k0 = *(const u32x4*)(src + 8 * tid), k1 = *(const u32x4*)(src + 8 * tid + 4); key[0] = k0.x; key[1] = k0.y; key[2] = k0.z; key[3] = k0.w; key[4] = k1.x; key[5] = k1.y; key[6] = k1.z; key[7] = k1.w; }
    else {
#pragma unroll
        for (int i = 0; i < 8; ++i) key[i] = 0u; }
    if (tid == 0) { unsigned z0 = 0u, c0 = (unsigned)cap; asm volatile("" : "+v"(z0), "+v"(c0)); ctl[0] = z0; ctl[1] = c0; }
#pragma unroll 1
    for (int pass = 0; pass < 4; ++pass) { const int shift = 24 - 8 * pass;
        if (tid < 256) hist[tid] = 0u;
        __syncthreads();
        const unsigned pref = ctl[0], need = ctl[1];
        if (have) {
#pragma unroll
            for (int i = 0; i < 8; ++i) { const bool m = (pass == 0) || ((key[i] >> (shift + 8)) == pref); if (m) atomicAdd((unsigned*)(hist + ((key[i] >> shift) & 255u)), 1u); } }
        __syncthreads();
        if (tid < 256) {
            const unsigned hv = hist[tid]; unsigned sfx = hv;
#pragma unroll
            for (int o = 1; o < 64; o <<= 1) { const unsigned tv = bperm(sfx, lane + o); if (lane + o < 64) sfx += tv; }
            if (lane == 0) wsum[w] = sfx;
            }
        __syncthreads();
        if (tid < 256) { const unsigned hv = hist[tid]; unsigned sfx = hv;
#pragma unroll
            for (int o = 1; o < 64; o <<= 1) { const unsigned tv = bperm(sfx, lane + o); if (lane + o < 64) sfx += tv; }
            unsigned gt = sfx - hv;
#pragma unroll
            for (int j = 1; j < 4; ++j) if (w + j < 4) gt += wsum[w + j];
            if (gt < need && need <= gt + hv) { ctl[2] = (pref << 8) | (unsigned)tid; ctl[3] = need - gt; } }
        __syncthreads();
        if (tid == 0) { ctl[0] = ctl[2]; ctl[1] = ctl[3]; }
        __syncthreads();
    }
    const unsigned thr = ctl[0], need = ctl[1];
    unsigned cg = 0u, ce = 0u;
#pragma unroll
    for (int i = 0; i < 8; ++i) { cg += (key[i] > thr) ? 1u : 0u; ce += (have && key[i] == thr) ? 1u : 0u; }
    unsigned sg = cg, se = ce;
#pragma unroll
    for (int o = 1; o < 64; o <<= 1) { const unsigned tg = bperm(sg, lane - o), te = bperm(se, lane - o); if (lane >= o) { sg += tg; se += te; } }
    if (lane == 63) { wsum[w] = sg; wsum[8 + w] = se; }
    __syncthreads();
    unsigned og = 0u, oe = 0u;
#pragma unroll
    for (int j = 0; j < 8; ++j) { if (j < w) { og += wsum[j]; oe += wsum[8 + j]; } }
    unsigned pg = og + sg - cg, pe = oe + se - ce;
    const int rowbase = is_ctx ? (TL + b * CTXL) : (b * SEQ);
    if (have) {
#pragma unroll
        for (int i = 0; i < 8; ++i) { const bool g = key[i] > thr, q = key[i] == thr; const bool sel = g || (q && pe < need);
            const int rank = (int)(pg + (pe < need ? pe : need)); const int row = rowbase + 8 * tid + i;
            ((int*)(c.ws + WS_SEL))[(size_t)row * 16 + e] = sel ? rank : -1;
            if (sel) { const int slot = is_ctx ? (2048 + b * CAPC + rank) : (b * CAPL + rank); ((float*)(c.ws + WS_GATEV))[e * ESLOTS + slot] = __uint_as_float(key[i]); list[2 * rank] = row; list[2 * rank + 1] = slot; }
            pg += g ? 1u : 0u; pe += q ? 1u : 0u; } }
    __syncthreads();
    const bf16_t* H = (const bf16_t*)(c.ws + WS_H); bf16_t* XS = (bf16_t*)(c.ws + WS_RA + RA_XS) + (size_t)e * ESLOTS * D;
    for (int i0 = w; i0 < cap; i0 += 8 * NWAVES) {
        u32x4 v0[8], v1[8];
#pragma unroll
        for (int k = 0; k < 8; ++k) { const int i = i0 + k * NWAVES; if (i < cap) { const u32x4* sp = (const u32x4*)(H + (size_t)list[2 * i] * D); v0[k] = sp[lane]; v1[k] = sp[64 + lane]; } }
#pragma unroll
        for (int k = 0; k < 8; ++k) { const int i = i0 + k * NWAVES; if (i < cap) { u32x4* dp = (u32x4*)(XS + (size_t)list[2 * i + 1] * D); dp[lane] = v0[k]; dp[64 + lane] = v1[k]; } }
    }
    __syncthreads();
}
struct CombRaw { int sel; f32x4 xv[4]; };
__device__ __forceinline__ void combine_load(const Ctx& c, int row, CombRaw& R) {
    const int lane = c.lane; const float* xr = xout_row(c, row);
    R.sel = ((const int*)(c.ws + WS_SEL))[(size_t)row * 16 + (lane & 15)];
#pragma unroll
    for (int j = 0; j < 4; ++j) R.xv[j] = *(const f32x4*)(xr + 4 * lane + 256 * j);
}
__device__ __forceinline__ void combine_row(const Ctx& c, int l, int row, bool next_mod, const CombRaw& R, float* dummy = nullptr) {
    const int lane = c.lane, bi = row_modidx(row); float* xr = xout_row(c, row); float* xw = dummy ? dummy + (size_t)row * D : xr;
    const bf16_t* YS = (const bf16_t*)(c.ws + WS_RA + RA_YS); const float* g5 = modp(c, l, bi, 5);
    f32x4 acc[4];
#pragma unroll
    for (int j = 0; j < 4; ++j) acc[j] = (f32x4){0.f, 0.f, 0.f, 0.f};
    const bool lat = row < TL; const int b = lat ? (row >> 12) : ((row - TL) >> 8);
    unsigned long long pick = __ballot(R.sel >= 0) & 0xffffull;
    while (pick) {
        if (!lat) {
            const int e = __builtin_ctzll(pick); pick &= pick - 1; const int r = __builtin_amdgcn_readlane(R.sel, e);
            const bf16_t* yc = (const bf16_t*)(c.ws + WS_RB + RB_YSC) + ((size_t)e * 128 + b * CAPC + r) * D + 4 * lane; u32x2 wc[4][4];
#pragma unroll
            for (int k = 0; k < 4; ++k)
#pragma unroll
                for (int j = 0; j < 4; ++j) wc[k][j] = *(const u32x2*)(yc + (size_t)k * (NEXP * 128 * D) + 256 * j);
#pragma unroll
            for (int k = 0; k < 4; ++k)
#pragma unroll
                for (int j = 0; j < 4; ++j) { acc[j][0] += bflo(wc[k][j].x); acc[j][1] += bfhi(wc[k][j].x); acc[j][2] += bflo(wc[k][j].y); acc[j][3] += bfhi(wc[k][j].y); }
            continue; }
        const bf16_t* yp[4]; bool on[4];
#pragma unroll
        for (int k = 0; k < 4; ++k) { on[k] = pick != 0; const int e = on[k] ? __builtin_ctzll(pick) : 0; if (on[k]) pick &= pick - 1;
            const int r = __builtin_amdgcn_readlane(R.sel, e); const int slot = lat ? (b * CAPL + r) : (2048 + b * CAPC + r);
            yp[k] = YS + ((size_t)e * ESLOTS + (on[k] ? slot : 0)) * D; }
        u32x2 wv[4][4];
#pragma unroll
        for (int k = 0; k < 4; ++k)
#pragma unroll
            for (int j = 0; j < 4; ++j) wv[k][j] = on[k] ? *(const u32x2*)(yp[k] + 4 * lane + 256 * j) : (u32x2){0u, 0u};
#pragma unroll
        for (int k = 0; k < 4; ++k)
#pragma unroll
            for (int j = 0; j < 4; ++j) { acc[j][0] += bflo(wv[k][j].x); acc[j][1] += bfhi(wv[k][j].x); acc[j][2] += bflo(wv[k][j].y); acc[j][3] += bfhi(wv[k][j].y); }
    }
    float ss = 0.f; f32x4 xv[4];
#pragma unroll
    for (int j = 0; j < 4; ++j) { const int cc = 4 * lane + 256 * j; xv[j] = R.xv[j] + *(const f32x4*)(g5 + cc) * acc[j]; *(f32x4*)(xw + cc) = xv[j];
        ss += (xv[j][0] * xv[j][0] + xv[j][1] * xv[j][1]) + (xv[j][2] * xv[j][2] + xv[j][3] * xv[j][3]); }
    if (!next_mod) return;
    const float rstd = 1.0f / sqrtf(wave_sum(ss) * (1.f / D) + EPS); const float* g = c.in[I_GMIX] + (l + 1) * D; const float* sh = modp(c, l + 1, bi, 0); const float* sc = modp(c, l + 1, bi, 1);
    bf16_t* hrow = (bf16_t*)(c.ws + WS_H) + (size_t)row * D;
#pragma unroll
    for (int j = 0; j < 4; ++j) { const int cc = 4 * lane + 256 * j; const f32x4 h = xv[j] * rstd * *(const f32x4*)(g + cc) * (*(const f32x4*)(sc + cc) + 1.0f) + *(const f32x4*)(sh + cc);
        u32x2 o; o.x = cvt_pk_bf16(h[0], h[1]); o.y = cvt_pk_bf16(h[2], h[3]); *(u32x2*)(hrow + cc) = o; }
}

#ifndef MK_FUSED
#define MK_FUSED 1
#endif
constexpr int NPH = 2 + 11 * 2;
#ifndef EARLY_WD_UNITS
#define EARLY_WD_UNITS 19
#endif
constexpr int CW_BAR = 4096;

__global__ void __launch_bounds__(NTHR, 2) fwd(Args args) {
    extern __shared__ __attribute__((aligned(16))) unsigned char lds_raw[];
    Ctx c; c.in = args.in; c.out = args.out; c.ws = args.ws; c.lds = (LAS unsigned char*)lds_raw;
    c.tid = threadIdx.x; c.lane = c.tid & 63; c.wave = __builtin_amdgcn_readfirstlane(c.tid >> 6); c.G = gridDim.x; c.bid = blockIdx.x;
    volatile LAS unsigned* misc = (volatile LAS unsigned*)(c.lds + LDS_MISC);
    if (c.tid < 8) misc[c.tid] = 0u;
    __syncthreads();
#if MK_FUSED
    XcdBarrier bar = xcd_barrier_post((unsigned*)(c.ws + WS_CTL) + CW_BAR, misc);
#define GRID_BAR() xcd_barrier(bar)
#else
#define GRID_BAR() do {} while (0)
#endif
    const int lo = args.ph_lo, hi = args.ph_hi;
#ifndef PHMASK
#define PHMASK 0xffffffffu
#endif
#define IN(k) (lo <= (k) && (k) < hi)
#define EN(j) ((PHMASK >> (j)) & 1u)
#ifndef REPEAT_ID
#define REPEAT_ID -1
#endif
#define REP(id) for (int rep_ = 0; rep_ < ((REPEAT_ID == (id)) ? 2 : 1); ++rep_)
#if defined(DEBUG_TS_A)
#ifndef DEBUG_TS_Q
#define DEBUG_TS_Q 4.0f
#endif
#ifndef DEBUG_TS_SHIFT
#define DEBUG_TS_SHIFT 0.0f
#endif
#define TS_STORE(k) do { if (c.bid == 0 && c.wave == 0) ((unsigned long long*)(c.ws + WS_CTL + 768 * 1024))[(k)] = __builtin_amdgcn_s_memrealtime(); } while (0)
#else
#define TS_STORE(k) do {} while (0)
#endif
#define SEAM(k) do { if (IN((k) + 1)) { GRID_BAR(); if (REPEAT_ID == 99) GRID_BAR(); } TS_STORE((k) + 1); } while (0)
#define PHASE_CTX() Ctx pc = c; { int z_ = 0, b_ = c.bid, g_ = c.G, w_ = c.wave; asm volatile("" : "+s"(z_), "+s"(b_), "+s"(g_), "+s"(w_)); \
        z_ = __builtin_amdgcn_readfirstlane(z_); b_ = __builtin_amdgcn_readfirstlane(b_); g_ = __builtin_amdgcn_readfirstlane(g_); w_ = __builtin_amdgcn_readfirstlane(w_); \
        pc.in = c.in + z_; pc.ws = c.ws + z_; pc.out = c.out + z_; pc.bid = b_; pc.G = g_; pc.wave = w_ & 7; \
        pc.lane = (int)(__builtin_amdgcn_mbcnt_hi(~0u, __builtin_amdgcn_mbcnt_lo(~0u, (unsigned)z_)) & 63u); pc.tid = pc.wave * 64 + pc.lane; } const int gw = pc.bid * NWAVES + pc.wave; const int NGW = pc.G * NWAVES; (void)gw; (void)NGW

    TS_STORE(0);
    if (EN(0) && IN(0)) { PHASE_CTX(); REP(0) phase_pre_a(pc); SEAM(0); }
    if (EN(1) && IN(1)) { PHASE_CTX(); REP(1) phase_modulate_mix(pc, 0); SEAM(1); }
#pragma unroll 1
    for (int l = 0; l < 2; ++l) {
        const int p0 = 2 + 11 * l; const bool first = (l == 0); const int nMa = first ? 68 : 64;
#define PHASE_PTRS() PHASE_CTX(); unsigned char* wt = pc.ws + WS_WT + (size_t)l * WT_LAYER; bf16_t* Z = (bf16_t*)(pc.ws + WS_RA); bf16_t* H = (bf16_t*)(pc.ws + WS_H); (void)wt; (void)Z; (void)H
        if (EN(2) && IN(p0 + 0)) { REP(20 + 0) { PHASE_PTRS();
            pg8::Gemm g{H, (const bf16_t*)(wt + WT_IN), D, D, D, 0, 0}; pg8::GOrder S; S.init(nMa, 35, 1, pc.G, pc.bid);
            EpiZ E{Z, pc.in[I_BGATE] + l * 3072};
            REP(2) pg8::gemm_phase<EpiZ, pg8::GOrder>(pc.lds, pc.tid, g, S, E);
            if (!first) {
                pg8::GOrderCtxCols S2; S2.o.init(4, 8, 1, pc.G, (pc.bid + pc.G - (64 * 35) % pc.G) % pc.G, 64);
                pg8::gemm_phase<EpiZ, pg8::GOrderCtxCols>(pc.lds, pc.tid, g, S2, E); }
            } SEAM(p0 + 0); }
        if (EN(3) && IN(p0 + 1)) { REP(20 + 1) { PHASE_PTRS();
#ifndef NO_G2G3
            REP(3) {
            { pg8::Gemm g{Z + ZCKV, (const bf16_t*)(wt + WT_UKV), NZ, 256, 256, 0, 0}; pg8::GOrder S; S.init(68, 8, 1, pc.G, pc.bid); EpiPlain E{(bf16_t*)(pc.ws + WS_RB + RB_KVRAW), 2048};
              pg8::gemm_phase<EpiPlain, pg8::GOrder>(pc.lds, pc.tid, g, S, E); }
            { pg8::Gemm g{Z + ZCQ, (const bf16_t*)(wt + WT_UQ), NZ, 384, 384, 0, 0}; pg8::GOrder S; S.init(nMa, 6, 1, pc.G, (pc.bid + pc.G - 32 % pc.G) % pc.G); EpiPlain E{(bf16_t*)(pc.ws + WS_RB + RB_QRAW), 1536};
              pg8::gemm_phase<EpiPlain, pg8::GOrder>(pc.lds, pc.tid, g, S, E); }
            }
#endif
#ifndef NO_MIXA
            REP(4) for (int u = (pc.bid + 8) % pc.G; u < nMa * 2 * 8; u += pc.G) mixA_unit(pc, l, u);
#endif
#ifndef NO_B1
            REP(5) for (int u = (pc.bid + pc.G - 184 % pc.G) % pc.G; u < 1088; u += pc.G) gla_b1_unit(pc, l, u);
#endif
            } SEAM(p0 + 1); }
        if (EN(4) && IN(p0 + 2)) { REP(20 + 2) { PHASE_PTRS();
            REP(6) {
                const bool b2wg = (pc.G >= 128) && pc.bid < 64;
                if (pc.tid < 32) *((volatile LAS unsigned*)(pc.lds + 3 * 33280 + 4 * 5120) + pc.tid) = 0u;
                __syncthreads();
                const bool role_b2 = (pc.G >= 128) ? b2wg : true;
                if (role_b2) {
#ifndef SKIP_B2
                    if (pc.G >= 128) gla_b2_unit(pc, pc.bid);
                    else { for (int u = pc.bid; u < 64; u += pc.G) { gla_b2_unit(pc, u); __syncthreads(); if (pc.tid < 32) *((volatile LAS unsigned*)(pc.lds + 3 * 33280 + 4 * 5120) + pc.tid) = 0u; __syncthreads(); } }
#endif
                }
                if (!role_b2 || pc.G < 128) {
#ifndef SKIP_C1
                  int wi, nwv;
                  if (pc.G >= 128) { nwv = (pc.G - 64) * NWAVES; wi = (pc.bid - 64) * NWAVES + pc.wave; }
                  else { nwv = pc.G * NWAVES; wi = pc.bid * NWAVES + pc.wave; }
                  if (wi < T) { C1Raw A = {}, B = {}; mla_c1_load(pc, wi, false, A);
                      for (int row = wi; row < T; row += 2 * nwv) { const int r1 = row + nwv, r2 = row + 2 * nwv;
                          if (r1 < T) mla_c1_load(pc, r1, false, B);
                          mla_c1_row(pc, l, row, false, A);
                          if (r2 < T) mla_c1_load(pc, r2, false, A);
                          if (r1 < T) mla_c1_row(pc, l, r1, false, B); } }
#endif
#ifndef NO_EARLY_WD
                  if (!role_b2) { __syncthreads(); wconv_early(pc, l, EARLY_WD_UNITS); }
#endif
                }
            }
            } SEAM(p0 + 2); }
        if (EN(5) && IN(p0 + 3)) { REP(20 + 3) { PHASE_PTRS();
#ifndef NO_FIN
            REP(7) { const int nrow = nMa * 256; if (gw < nrow) { FinRaw A = {}, B = {}; gla_finish_load(pc, gw, A);
                for (int row = gw; row < nrow; row += 2 * NGW) { const int r1 = row + NGW, r2 = row + 2 * NGW;
                    if (r1 < nrow) gla_finish_load(pc, r1, B);
                    gla_finish_row(pc, l, row, A);
                    if (r2 < nrow) gla_finish_load(pc, r2, A);
                    if (r1 < nrow) gla_finish_row(pc, l, r1, B); } } }
#endif
            bf16_t* Y = (bf16_t*)(pc.ws + WS_RB + RB_YCAT) + 2048;
            const bf16_t* KG = (const bf16_t*)(pc.ws + WS_RB + RB_KG); const bf16_t* VG = (const bf16_t*)(pc.ws + WS_RB + RB_VG);
            const int G8 = pc.G >> 3;
            REP(8) for (int i = 0;; ++i) {
                int un; if ((pc.G & 7) == 0 && (G8 & 15) == 0) { const int x = pc.bid & 7, s = pc.bid >> 3, ppx = G8 >> 4; un = ((i * 8 * ppx) + x * ppx + (s >> 4)) * 16 + (s & 15); } else un = i * pc.G + pc.bid;
                if (un >= 512) break;
                const int bh = un >> 4, qb = un & 15, b = bh >> 3, h = bh & 7;
                attn_unit(pc, l, (const bf16_t*)(pc.ws + WS_RB + RB_QRAW) + (size_t)(b * SEQ + qb * 256) * 1536 + h * 192, (const float*)(pc.ws + WS_RSQ) + b * SEQ + qb * 256, qb * 256, KG + ((size_t)b * NKEY * 8 + h) * 192, VG + ((size_t)b * NKEY * 8 + h) * 128, 68, Y + (size_t)(b * SEQ + qb * 256) * 3072 + h * 128); }
            if (first) for (int un = pc.bid; un < 32; un += pc.G) { const int b = un >> 3, h = un & 7;
                attn_unit(pc, l, (const bf16_t*)(pc.ws + WS_RB + RB_QRAW) + (size_t)(TL + b * CTXL) * 1536 + h * 192, (const float*)(pc.ws + WS_RSQ) + TL + b * CTXL, -1, KG + ((size_t)b * NKEY * 8 + h) * 192, VG + ((size_t)b * NKEY * 8 + h) * 128, 4, Y + (size_t)(TL + b * CTXL) * 3072 + h * 128); }
            } SEAM(p0 + 3); }
        if (EN(6) && IN(p0 + 4)) { REP(20 + 4) { PHASE_PTRS();
            pg8::Gemm g{(const bf16_t*)(pc.ws + WS_RB + RB_YCAT), (const bf16_t*)(wt + WT_M), 3072, 3072, 3072, 0, 0}; pg8::GOrder S; S.init(64, 4, 1, pc.G, pc.bid);
            EpiMerge E{(bf16_t*)(pc.ws + WS_RB + RB_MERGED), Z};
            REP(9) pg8::gemm_phase<EpiMerge, pg8::GOrder>(pc.lds, pc.tid, g, S, E);
            if (first) REP(31) for (int u = pc.bid; u < 256; u += pc.G) ctx_merge_unit(pc, l, u); } SEAM(p0 + 4); }
        if (EN(7) && IN(p0 + 5)) { REP(20 + 5) { PHASE_PTRS();
            pg8::Gemm g{(const bf16_t*)(pc.ws + WS_RB + RB_MERGED), (const bf16_t*)(wt + WT_OUT), D, D, D, 0, 0}; pg8::GOrder S; S.init(64, 4, 1, pc.G, pc.bid);
            EpiResid E{&pc, l, (REPEAT_ID == 25 && rep_ == 0) ? (float*)(pc.ws + WS_RA) : nullptr};
            pg8::gemm_phase<EpiResid, pg8::GOrder>(pc.lds, pc.tid, g, S, E);
            if (first) REP(32) for (int u = pc.bid; u < 256; u += pc.G) ctx_out_unit(pc, l, u); } SEAM(p0 + 5); }
        if (EN(8) && IN(p0 + 6)) { REP(20 + 6) { PHASE_PTRS();
            REP(11) { route_stage_w(pc, l); const int nrow = nMa * 256;
                if (gw < nrow) { RouteRaw A = {}, B = {}; route_load(pc, gw, A);
                    for (int row = gw; row < nrow; row += 2 * NGW) { const int r1 = row + NGW, r2 = row + 2 * NGW;
                        if (r1 < nrow) route_load(pc, r1, B);
                        route_row(pc, l, row, A);
                        if (r2 < nrow) route_load(pc, r2, A);
                        if (r1 < nrow) route_row(pc, l, r1, B); } }
                __syncthreads(); }
            } SEAM(p0 + 6); }
        if (EN(9) && IN(p0 + 7)) { REP(20 + 7) { PHASE_PTRS();
            REP(13) for (int u = pc.bid; u < 64; u += pc.G) topk_unit(pc, u, false);
            if (first) for (int u = pc.bid; u < 64; u += pc.G) topk_unit(pc, u, true);
            REP(12) expert_wconv(pc, l);
            } SEAM(p0 + 7); }
        if (EN(10) && IN(p0 + 8)) { REP(20 + 8) { PHASE_PTRS();
            pg8::Gemm g{(const bf16_t*)(pc.ws + WS_RA + RA_XS), (const bf16_t*)(pc.ws + WS_RB + RB_WGU), D, D, D, (size_t)ESLOTS * D, (size_t)4096 * D, (const bf16_t*)(pc.ws + WS_RB + RB_WGU2) - (size_t)GU_SPLIT * 4096 * D, GU_SPLIT}; pg8::GOrder S; S.init(first ? 9 : 8, 16, 16, pc.G, pc.bid);
            EpiSwiGLU E{(bf16_t*)(pc.ws + WS_RA + RA_HID)};
            REP(14) pg8::gemm_phase<EpiSwiGLU, pg8::GOrder>(pc.lds, pc.tid, g, S, E); } SEAM(p0 + 8); }
        if (EN(11) && IN(p0 + 9)) { REP(20 + 9) { PHASE_PTRS();
            pg8::Gemm g{(const bf16_t*)(pc.ws + WS_RA + RA_HID), (const bf16_t*)(pc.ws + WS_RB + RB_WD), DEXP, DEXP, DEXP, (size_t)ESLOTS * DEXP, (size_t)D * DEXP}; pg8::GOrder S; S.init(8, 4, 16, pc.G, pc.bid);
            EpiDown E{(bf16_t*)(pc.ws + WS_RA + RA_YS), (const float*)(pc.ws + WS_GATEV)};
            REP(15) pg8::gemm_phase<EpiDown, pg8::GOrder>(pc.lds, pc.tid, g, S, E);
            if (first) {
                pg8::Gemm g2 = g; g2.K = 512; pg8::KSplitOrder S2{pc.G, (pc.G == 256) ? ((pc.bid & 7) * 32 + (pc.bid >> 3)) : pc.bid};
                EpiDownPart E2{(bf16_t*)(pc.ws + WS_RB + RB_YSC), (const float*)(pc.ws + WS_GATEV)};
                pg8::gemm_phase<EpiDownPart, pg8::KSplitOrder>(pc.lds, pc.tid, g2, S2, E2); } } SEAM(p0 + 9); }
        if (EN(12) && IN(p0 + 10)) { REP(20 + 10) { PHASE_PTRS();
            { const int nrow = nMa * 256; float* dmy = (REPEAT_ID == 30 && rep_ == 0) ? (float*)(pc.ws + WS_RB) : nullptr;
              if (gw < nrow) { CombRaw A = {}, B = {}; combine_load(pc, gw, A);
                  for (int row = gw; row < nrow; row += 2 * NGW) { const int r1 = row + NGW, r2 = row + 2 * NGW;
                      if (r1 < nrow) combine_load(pc, r1, B);
                      combine_row(pc, l, row, first, A, dmy);
                      if (r2 < nrow) combine_load(pc, r2, A);
                      if (r1 < nrow) combine_row(pc, l, r1, first, B, dmy); } } }
            } SEAM(p0 + 10); }
    }
#if defined(DEBUG_TS_A)
    { GRID_BAR(); const unsigned long long* ts = (const unsigned long long*)(c.ws + WS_CTL + 768 * 1024);
      float a = (float)(__hip_atomic_load(ts + DEBUG_TS_A + 1, __ATOMIC_RELAXED, __HIP_MEMORY_SCOPE_AGENT) - __hip_atomic_load(ts + DEBUG_TS_A, __ATOMIC_RELAXED, __HIP_MEMORY_SCOPE_AGENT)) * 1e-2f;
      float b = (float)(__hip_atomic_load(ts + DEBUG_TS_B + 1, __ATOMIC_RELAXED, __HIP_MEMORY_SCOPE_AGENT) - __hip_atomic_load(ts + DEBUG_TS_B, __ATOMIC_RELAXED, __HIP_MEMORY_SCOPE_AGENT)) * 1e-2f;
      a = exp2f(rintf(log2f(fmaxf(a, 1.f)) * DEBUG_TS_Q + DEBUG_TS_SHIFT) / DEBUG_TS_Q) * 1e-2f; b = exp2f(rintf(log2f(fmaxf(b, 1.f)) * DEBUG_TS_Q + DEBUG_TS_SHIFT) / DEBUG_TS_Q) * 1e-2f;
      const int tid_ = c.wave * 64 + (int)__builtin_amdgcn_mbcnt_hi(~0u, __builtin_amdgcn_mbcnt_lo(~0u, 0u));
      for (long i = (long)c.bid * NTHR + tid_; i < (long)TL * D; i += (long)c.G * NTHR) c.out[i] = (i == 0) ? 131072.0f * b : 1024.0f * a; }
#endif
}

extern "C" void kernel_launch(void* const* d_in, const int* in_sizes, int n_in, void* d_out, int out_size, void* d_ws, size_t ws_size, hipStream_t stream) {
    static int grid = 0;
    if (!grid) {
        int dev = 0, cus = 0, per_cu = 0;
        (void)hipGetDevice(&dev); (void)hipDeviceGetAttribute(&cus, hipDeviceAttributeMultiprocessorCount, dev);
        (void)hipFuncSetAttribute((const void*)fwd, hipFuncAttributeMaxDynamicSharedMemorySize, LDS_BYTES);
        (void)hipOccupancyMaxActiveBlocksPerMultiprocessor(&per_cu, fwd, NTHR, LDS_BYTES);
        grid = cus * (per_cu < 1 ? per_cu : 1);
        if (grid <= 0) { fprintf(stderr, "occupancy query returned 0 blocks per CU\n"); grid = cus; }
        if (ws_size < WS_END) fprintf(stderr, "workspace too small: %zu < %zu\n", ws_size, (size_t)WS_END);
    }
    (void)hipMemsetAsync((unsigned char*)d_ws + WS_CTL, 0, CTL_BYTES, stream);
    Args a{}; for (int i = 0; i < N_INPUTS; ++i) a.in[i] = (const float*)d_in[i]; a.out = (float*)d_out; a.ws = (unsigned char*)d_ws;
#if MK_FUSED
    a.ph_lo = 0; a.ph_hi = NPH;
    hipLaunchKernelGGL(fwd, dim3(grid), dim3(NTHR), LDS_BYTES, stream, a);
#else
#if defined(DEBUG_SCAN)
    hipLaunchKernelGGL(k_seterr, dim3(1), dim3(1), 0, stream, (int*)((unsigned char*)d_ws + WS_CTL + 512 * 1024));
#endif
    for (int p = 0; p < NPH; ++p) { a.ph_lo = p; a.ph_hi = p + 1;
#if defined(DEBUG_SCAN)
        if (p == 3) (void)hipMemsetAsync((unsigned char*)d_ws + WS_RB + RB_OINTRA, 0xff, (size_t)T * D * 2, stream);
#endif
        hipLaunchKernelGGL(fwd, dim3(grid), dim3(NTHR), LDS_BYTES, stream, a);
#if defined(DEBUG_SCAN)
#if defined(DEBUG_HASH)
        if (p == DEBUG_HASH_PHASE) { (void)hipMemsetAsync((unsigned char*)d_ws + WS_CTL + 512 * 1024 + 256, 0, 4, stream);
            hipLaunchKernelGGL(k_hash, dim3(512), dim3(256), 0, stream, (const unsigned*)((unsigned char*)d_ws + DEBUG_HASH_OFF), (long)(DEBUG_HASH_BYTES / 4), (unsigned*)((unsigned char*)d_ws + WS_CTL + 512 * 1024 + 256)); }
#else
        debug_after_phase(p, (unsigned char*)d_ws, (float*)d_out, stream);
#endif
#endif
    }
#if defined(DEBUG_SCAN)
#if defined(DEBUG_HASH)
    hipLaunchKernelGGL(k_apply_hash, dim3(1024), dim3(256), 0, stream, (float*)d_out, (long)out_size, (const unsigned*)((unsigned char*)d_ws + WS_CTL + 512 * 1024 + 256));
#elif defined(DEBUG_STAT)
    hipLaunchKernelGGL(k_apply_stat, dim3(1024), dim3(256), 0, stream, (float*)d_out, (long)out_size, (const int*)((unsigned char*)d_ws + WS_CTL + 512 * 1024));
#else
    hipLaunchKernelGGL(k_apply, dim3(1024), dim3(256), 0, stream, (float*)d_out, (long)out_size, (const int*)((unsigned char*)d_ws + WS_CTL + 512 * 1024));
#endif
#endif
#endif
}
```

```cpp
#define MK_FUSED 1
#include <hip/hip_runtime.h>
#include <cstdint>
#include <cstdio>

#define LAS __attribute__((address_space(3)))
#define GAS __attribute__((address_space(1)))
typedef unsigned short bf16_t;
typedef short bf16x8 __attribute__((ext_vector_type(8)));
typedef short bf16x4 __attribute__((ext_vector_type(4)));
typedef float f32x4 __attribute__((ext_vector_type(4)));
typedef float f32x2 __attribute__((ext_vector_type(2)));
typedef float f32x16 __attribute__((ext_vector_type(16)));
typedef unsigned u32x4 __attribute__((ext_vector_type(4)));
typedef unsigned u32x2 __attribute__((ext_vector_type(2)));

typedef __bf16 bf16v2_t __attribute__((ext_vector_type(2)));
__device__ __forceinline__ unsigned cvt_pk_bf16(float lo, float hi) { bf16v2_t v; v[0] = (__bf16)lo; v[1] = (__bf16)hi; return __builtin_bit_cast(unsigned, v); }
__device__ __forceinline__ bf16_t f2bf(float f) { return (bf16_t)(cvt_pk_bf16(f, 0.f) & 0xffffu); }
__device__ __forceinline__ float bf2f(bf16_t b) { return __uint_as_float(((unsigned)b) << 16); }
__device__ __forceinline__ float bflo(unsigned w) { return __uint_as_float(w << 16); }
__device__ __forceinline__ float bfhi(unsigned w) { return __uint_as_float(w & 0xffff0000u); }
template <int K> __device__ __forceinline__ float sx(float v) { static_assert(K >= 1 && K < 32, "xor mask inside a 32-lane half"); return __int_as_float(__builtin_amdgcn_ds_swizzle(__float_as_int(v), (K << 10) | 0x1F)); }
__device__ __forceinline__ float sum32(float v) { auto rr = __builtin_amdgcn_permlane32_swap(__float_as_uint(v), __float_as_uint(v), false, false); return __uint_as_float(rr[0]) + __uint_as_float(rr[1]); }
__device__ __forceinline__ float max32(float v) { auto rr = __builtin_amdgcn_permlane32_swap(__float_as_uint(v), __float_as_uint(v), false, false); return fmaxf(__uint_as_float(rr[0]), __uint_as_float(rr[1])); }
__device__ __forceinline__ float half_sum(float v) { v += sx<1>(v); v += sx<2>(v); v += sx<4>(v); v += sx<8>(v); v += sx<16>(v); return v; }
__device__ __forceinline__ float wave_sum(float v) { return sum32(half_sum(v)); }
__device__ __forceinline__ float bperm(float v, int src) { return __int_as_float(__builtin_amdgcn_ds_bpermute(src << 2, __float_as_int(v))); }
__device__ __forceinline__ unsigned bperm(unsigned v, int src) { return (unsigned)__builtin_amdgcn_ds_bpermute(src << 2, (int)v); }
__device__ __forceinline__ float fast_rcp(float x) { return __builtin_amdgcn_rcpf(x); }
__device__ __forceinline__ float fast_exp(float x) { return __builtin_amdgcn_exp2f(x * 1.4426950408889634f); }
__device__ __forceinline__ float sigmoidf_(float x) { return fast_rcp(1.f + fast_exp(-x)); }
__device__ __forceinline__ float siluf_(float x) { return x * sigmoidf_(x); }

namespace pg8 {
constexpr int BM = 256, BK = 64, HALF = 128, HTB = HALF * BK * 2, STAGE_BYTES = 8 * HTB, NXCD = 8, WGM = 8;
__host__ __device__ __forceinline__ int lds_byte(int r, int c) { const int st = (r >> 4) * 2 + (c >> 5), rr = r & 15, cc = c & 31, ob = rr * 64 + cc * 2; return st * 1024 + (ob ^ (((ob >> 9) & 1) << 5)); }
__host__ __device__ __forceinline__ void stage_rc(int b, int& R, int& C) { const int st = b / 1024, sb = b % 1024, swz = sb ^ (((sb >> 9) & 1) << 5); R = (st >> 1) * 16 + swz / 64; C = (st & 1) * 32 + (swz % 64) / 2; }
__host__ __device__ __forceinline__ int perm32(int rho) { const int n = rho >> 4, i = rho & 15; return 8 * (i >> 2) + 4 * n + (i & 3); }

struct Unit { int pm, pn, g, ko; };
struct Gemm { const bf16_t* A; const bf16_t* Bt; int lda, ldb, K; size_t gstrideA, gstrideB; const bf16_t* Bt2 = nullptr; int gsplit = 1 << 30; };

struct GOrder {
    static constexpr bool KOFF = false;
    int nM, nN, nG, nwg, G, c, pm0;
    __device__ void init(int nM_, int nN_, int nG_, int G_, int c_, int pm0_ = 0) { nM = nM_; nN = nN_; nG = nG_; nwg = nM * nN * nG; G = G_; c = c_; pm0 = pm0_; }
    __device__ bool next(int i, Unit& u) const {
        const long L = (long)i * G + c; if (L >= nwg) return false;
        int wgid = (int)L; { const int q = nwg / NXCD, r = nwg % NXCD, xcd = wgid % NXCD, off = wgid / NXCD; wgid = (xcd < r ? xcd * (q + 1) : r * (q + 1) + (xcd - r) * q) + off; }
        const int per = nM * nN; u.g = wgid / per; wgid -= u.g * per;
        const int nig = WGM * nN, gid = wgid / nig, fm = gid * WGM, gsz = (nM - fm) < WGM ? (nM - fm) : WGM;
        u.pm = pm0 + fm + ((wgid % nig) % gsz); u.pn = (wgid % nig) / gsz; return true;
    }
};

struct GOrderCtxCols { static constexpr bool KOFF = false; GOrder o;
    __device__ bool next(int i, Unit& u) const { if (!o.next(i, u)) return false; u.pn = u.pn < 6 ? 10 + u.pn : 15 + u.pn; return true; } };

struct KSplitOrder { static constexpr bool KOFF = true; int G, c;
    __device__ bool next(int i, Unit& u) const { const int L = i * G + c; if (L >= 256) return false; u.g = L >> 4; u.pm = 8; u.pn = (L >> 2) & 3; u.ko = (L & 3) * 512; return true; } };

template <class Epi, class Sched>
__device__ __forceinline__ void gemm_phase(LAS unsigned char* lds, const int tid, const Gemm g, const Sched& S, const Epi& E) {
    const int wid = __builtin_amdgcn_readfirstlane(tid >> 6), lane = tid & 63, wr = wid >> 2, wc = wid & 3, fr = lane & 15, fq = lane >> 4;
    const int K = g.K, nt = K / BK;
    unsigned voffA[2], voffB[2];
#pragma unroll
    for (int i = 0; i < 2; ++i) { int R, C; stage_rc(tid * 16 + i * 8192, R, C); const int Rb = Epi::PERM ? ((R & ~31) + perm32(R & 31)) : R;
        voffA[i] = (unsigned)(R * g.lda + C) * 2u; voffB[i] = (unsigned)(Rb * g.ldb + C) * 2u; }
    const size_t kstep = (size_t)(BK * 2);
    const size_t hstepA = (size_t)HALF * g.lda * 2, hstepB = (size_t)HALF * g.ldb * 2;
    const size_t tstepA = 2 * hstepA, tstepB = 2 * hstepB;
    const unsigned ldsw = (unsigned)wid * 1024u;
    const int aoff = lds_byte(wr * 64 + fr, fq * 8), boff = lds_byte(wc * 32 + fr, fq * 8);
#define PG8_SA(b, h) (((b) * 2 + (h)) * HTB)
#define PG8_SB(b, h) ((4 + (b) * 2 + (h)) * HTB)
#define PG8_STAGE(bufoff, gbase, voff) do { _Pragma("unroll") for (int _i = 0; _i < 2; ++_i) \
        __builtin_amdgcn_global_load_lds((const unsigned*)((const char*)(gbase) + (voff)[_i]), (LAS unsigned*)(lds + (bufoff) + ldsw + _i * 8192), 16, 0, 0); } while (0)
#define PG8_LDA(dst, b, h) do { _Pragma("unroll") for (int m = 0; m < 4; ++m) _Pragma("unroll") for (int k = 0; k < 2; ++k) dst[m][k] = *(const LAS bf16x8*)(lds + PG8_SA(b, h) + aoff + m * 2048 + k * 1024); } while (0)
#define PG8_LDB(dst, b, h) do { _Pragma("unroll") for (int n = 0; n < 2; ++n) _Pragma("unroll") for (int k = 0; k < 2; ++k) dst[n][k] = *(const LAS bf16x8*)(lds + PG8_SB(b, h) + boff + n * 2048 + k * 1024); } while (0)
#define PG8_MMA(ai, bj, At, Bt) do { __builtin_amdgcn_s_setprio(1); _Pragma("unroll") for (int m = 0; m < 4; ++m) _Pragma("unroll") for (int n = 0; n < 2; ++n) _Pragma("unroll") for (int k = 0; k < 2; ++k) \
        acc[ai][bj][m][n] = __builtin_amdgcn_mfma_f32_16x16x32_bf16(Bt[n][k], At[m][k], acc[ai][bj][m][n], 0, 0, 0); __builtin_amdgcn_s_setprio(0); } while (0)
#define PG8_WAIT_V(n) asm volatile("s_waitcnt vmcnt(" #n ")" ::: "memory")
#define PG8_WAIT_L(n) asm volatile("s_waitcnt lgkmcnt(" #n ")" ::: "memory")
#define PG8_BAR __builtin_amdgcn_s_barrier()
#define PG8_SCHED __builtin_amdgcn_sched_barrier(0)
    Unit cur, nxt; int ui = 0;
    if (!S.next(0, cur)) return;
    f32x4 acc[2][2][4][2];
#pragma unroll
    for (int a = 0; a < 2; ++a)
#pragma unroll
        for (int b = 0; b < 2; ++b)
#pragma unroll
            for (int m = 0; m < 4; ++m)
#pragma unroll
                for (int n = 0; n < 2; ++n) acc[a][b][m][n] = (f32x4){0.f, 0.f, 0.f, 0.f};
    bf16x8 At[4][2], B0[2][2], B1[2][2];
    const char* cA = (const char*)(g.A + (size_t)cur.g * g.gstrideA) + (size_t)cur.pm * tstepA; const char* cB = (const char*)((cur.g < g.gsplit ? g.Bt : g.Bt2) + (size_t)cur.g * g.gstrideB) + (size_t)cur.pn * tstepB;
    if constexpr (Sched::KOFF) { cA += (size_t)cur.ko * 2; cB += (size_t)cur.ko * 2; }
    PG8_STAGE(PG8_SB(0, 0), cB, voffB); PG8_STAGE(PG8_SB(0, 1), cB + hstepB, voffB); PG8_STAGE(PG8_SA(0, 0), cA, voffA); PG8_STAGE(PG8_SA(0, 1), cA + hstepA, voffA);
    if (wr == 1) PG8_BAR;
    PG8_WAIT_V(2); PG8_BAR;
    PG8_STAGE(PG8_SB(1, 0), cB + kstep, voffB); PG8_STAGE(PG8_SA(1, 0), cA + kstep, voffA); PG8_STAGE(PG8_SB(1, 1), cB + hstepB + kstep, voffB);
    PG8_WAIT_V(6); PG8_BAR;
    for (;;) {
        const bool has_next = S.next(ui + 1, nxt);
        const char* nA = has_next ? (const char*)(g.A + (size_t)nxt.g * g.gstrideA) + (size_t)nxt.pm * tstepA + (Sched::KOFF ? (size_t)nxt.ko * 2 : (size_t)0) : cA; const char* nB = has_next ? (const char*)((nxt.g < g.gsplit ? g.Bt : g.Bt2) + (size_t)nxt.g * g.gstrideB) + (size_t)nxt.pn * tstepB + (Sched::KOFF ? (size_t)nxt.ko * 2 : (size_t)0) : cB;
        for (int t = 0; t < nt; t += 2) {
            const bool last = (t == nt - 2);
            const char* a1 = cA + (size_t)(t + 1) * kstep;
            const char* a2 = last ? nA : cA + (size_t)(t + 2) * kstep; const char* b2 = last ? nB : cB + (size_t)(t + 2) * kstep;
            const char* a3 = a2 + kstep; const char* b3 = b2 + kstep;
            if constexpr (Epi::MID) { if (t == 16 || t == 32) E.mid(acc, cur, t, wr, wc, fr, fq); }
            PG8_LDB(B0, 0, 0); PG8_LDB(B1, 0, 1); PG8_SCHED; PG8_LDA(At, 0, 0); PG8_STAGE(PG8_SA(1, 1), a1 + hstepA, voffA);
            PG8_WAIT_V(8); PG8_WAIT_L(0); PG8_BAR; PG8_MMA(0, 0, At, B0); PG8_MMA(0, 1, At, B1); PG8_BAR; PG8_SCHED;
            PG8_LDA(At, 0, 1); PG8_STAGE(PG8_SB(0, 0), b2, voffB); PG8_STAGE(PG8_SB(0, 1), b2 + hstepB, voffB); PG8_STAGE(PG8_SA(0, 0), a2, voffA);
            PG8_WAIT_V(8); PG8_WAIT_L(0); PG8_BAR; PG8_MMA(1, 0, At, B0); PG8_MMA(1, 1, At, B1); PG8_BAR; PG8_SCHED;
            PG8_LDB(B0, 1, 0); PG8_LDB(B1, 1, 1); PG8_SCHED; PG8_LDA(At, 1, 0); PG8_STAGE(PG8_SA(0, 1), a2 + hstepA, voffA);
            PG8_WAIT_V(8); PG8_WAIT_L(0); PG8_BAR; PG8_MMA(0, 0, At, B0); PG8_MMA(0, 1, At, B1); PG8_BAR; PG8_SCHED;
            PG8_LDA(At, 1, 1); PG8_STAGE(PG8_SB(1, 0), b3, voffB); PG8_STAGE(PG8_SB(1, 1), b3 + hstepB, voffB); PG8_STAGE(PG8_SA(1, 0), a3, voffA);
            PG8_WAIT_V(8); PG8_WAIT_L(0); PG8_BAR; PG8_MMA(1, 0, At, B0); PG8_MMA(1, 1, At, B1); PG8_BAR; PG8_SCHED;
        }
        if (wr == 0) PG8_BAR;
        E(acc, cur, wr, wc, fr, fq);
        if (!has_next) break;
#pragma unroll
        for (int a = 0; a < 2; ++a)
#pragma unroll
            for (int b = 0; b < 2; ++b)
#pragma unroll
                for (int m = 0; m < 4; ++m)
#pragma unroll
                    for (int n = 0; n < 2; ++n) acc[a][b][m][n] = (f32x4){0.f, 0.f, 0.f, 0.f};
        cur = nxt; cA = nA; cB = nB; ++ui;
        if (wr == 1) PG8_BAR;
    }
    PG8_WAIT_V(0);
    PG8_BAR;
#undef PG8_SA
#undef PG8_SB
#undef PG8_STAGE
#undef PG8_LDA
#undef PG8_LDB
#undef PG8_MMA
#undef PG8_WAIT_V
#undef PG8_WAIT_L
#undef PG8_BAR
#undef PG8_SCHED
}
}
#define XB_TMO      128
#define XB_XCNT(j)  (256  + 64 * (j))
#define XB_XSUB(j)  (1280 + 64 * (j))
#define XB_XGEN(j)  (2304 + 64 * (j))
#define XB_TOP      3328
#define XB_TOPGEN   3392
#define XCD_BAR_WORDS 3456
#define XB_SPIN_CAP (1u << 18)

__device__ __forceinline__ unsigned xb_ld(unsigned* p)              { return __hip_atomic_load(p, __ATOMIC_RELAXED, __HIP_MEMORY_SCOPE_AGENT); }
__device__ __forceinline__ unsigned xb_add(unsigned* p, unsigned v) { return __hip_atomic_fetch_add(p, v, __ATOMIC_RELAXED, __HIP_MEMORY_SCOPE_AGENT); }
__device__ __forceinline__ unsigned xb_xcc_id() { return (unsigned)__builtin_amdgcn_s_getreg((3 << 11) | 20) & 0xFu; }
#define XB_SPIN(cond, bar) do { unsigned _sp = 0; while (cond) { __builtin_amdgcn_s_sleep(1); \
    if ((++_sp & 255u) == 0u) { if (xb_ld(&(bar)[XB_TMO])) break; if (_sp > XB_SPIN_CAP) { atomicAdd(&(bar)[XB_TMO], 1u); break; } } } } while (0)

struct XcdBarrier {
    unsigned* bar; unsigned x;
    volatile LAS unsigned* st;
};

__device__ __forceinline__ XcdBarrier xcd_barrier_post(unsigned* bar, volatile LAS unsigned* st) {
    XcdBarrier b; b.bar = bar; b.x = xb_xcc_id(); b.st = st;
    if (threadIdx.x == 0) (void)xb_add(&bar[XB_XCNT(b.x)], 1u);
    return b;
}
__device__ __forceinline__ void xcd_barrier_complete(unsigned* bar, unsigned x, unsigned& nloc, unsigned& nx) {
    const unsigned G = gridDim.x * gridDim.y * gridDim.z;
    unsigned sum, cnt, mine, sp = 0u;
    for (;;) {
        sum = 0u; cnt = 0u; mine = 0u;
#pragma unroll
        for (unsigned j = 0; j < 16; ++j) { const unsigned c = xb_ld(&bar[XB_XCNT(j)]); sum += c; cnt += (c > 0u) ? 1u : 0u; mine = (j == x) ? c : mine; }
        if (sum == G) break;
        __builtin_amdgcn_s_sleep(1);
        if ((++sp & 255u) == 0u) { if (xb_ld(&bar[XB_TMO])) break; if (sp > XB_SPIN_CAP) { atomicAdd(&bar[XB_TMO], 1u); break; } }
    }
    nloc = mine > 0u ? mine : 1u; nx = cnt > 0u ? cnt : 1u;
}

__device__ __forceinline__ void xcd_barrier(const XcdBarrier& b) {
    asm volatile("s_waitcnt vmcnt(0)" ::: "memory");
    __syncthreads();
    unsigned long long bp_ = (unsigned long long)b.bar; unsigned bx_ = b.x; asm volatile("" : "+s"(bp_), "+s"(bx_)); bx_ = (unsigned)__builtin_amdgcn_readfirstlane((int)bx_); bp_ = ((unsigned long long)(unsigned)__builtin_amdgcn_readfirstlane((int)(bp_ >> 32)) << 32) | (unsigned)__builtin_amdgcn_readfirstlane((int)bp_);
    if (threadIdx.x == 0) {
        unsigned* bar = (unsigned*)bp_;
        __builtin_amdgcn_s_waitcnt(0);
        unsigned nloc = b.st[0], nx = b.st[1];
        if (nloc == 0u) { xcd_barrier_complete(bar, bx_, nloc, nx); b.st[0] = nloc; b.st[1] = nx; }
        const unsigned old = xb_add(&bar[XB_XSUB(bx_)], 1u);
        const unsigned gen = old / nloc;
        if (old + 1u == (gen + 1u) * nloc) {
            __builtin_amdgcn_fence(__ATOMIC_RELEASE, "agent");
            asm volatile("s_waitcnt vmcnt(0)" ::: "memory");
            const unsigned og = xb_add(&bar[XB_TOP], 1u);
            const unsigned tg = og / nx;
            if (og + 1u == (tg + 1u) * nx) xb_add(&bar[XB_TOPGEN], 1u);
            else XB_SPIN(xb_ld(&bar[XB_TOPGEN]) == tg, bar);
            __builtin_amdgcn_fence(__ATOMIC_ACQUIRE, "agent");
            xb_add(&bar[XB_XGEN(bx_)], 1u);
            asm volatile("s_waitcnt vmcnt(0)" ::: "memory");
        } else {
            XB_SPIN(xb_ld(&bar[XB_XGEN(bx_)]) == gen, bar);
            __builtin_amdgcn_fence(__ATOMIC_ACQUIRE, "agent");
            asm volatile("s_waitcnt vmcnt(0)" ::: "memory");
        }
    }
    __syncthreads();
}

namespace cfg {
constexpr int D = 1024, NB = 4, SEQ = 4096, CTXL = 256, TL = NB * SEQ, TC = NB * CTXL, T = TL + TC;
constexpr int NZ = 8960;
constexpr int ZU = 0, ZVA = 1024, ZQB = 2048, ZKB = 2560, ZVB = 3072, ZRB = 4096, ZCQ = 5120, ZKR = 5504, ZDEC = 5568, ZCKV = 5632, ZGT = 5888;
constexpr int NKEY = CTXL + SEQ;
constexpr int NEXP = 16, DEXP = 2048, CAPL = 512, CAPC = 32, ESLOTS = 2304;
constexpr float EPS = 1e-6f;
constexpr int NWAVES = 8, NTHR = 512;
constexpr size_t MiB = 1u << 20;
constexpr size_t WS_CTL = 0, CTL_BYTES = 1 * MiB;
constexpr size_t WS_MOD = 1 * MiB;
constexpr size_t WS_GATEV = WS_MOD + 512 * 1024;
constexpr size_t WS_AFFT = 2 * MiB;
constexpr size_t WS_SEL = 4 * MiB;
constexpr size_t WS_RSQ = 4 * MiB + 1536 * 1024;
constexpr size_t WS_XC = 6 * MiB;
constexpr size_t WS_H = 10 * MiB;
constexpr size_t WS_WT = 44 * MiB, WT_LAYER = 28 * MiB;
constexpr size_t WT_IN = 0, WT_UQ = 17 * MiB + 512 * 1024, WT_UKV = WT_UQ + 1152 * 1024, WT_M = WT_UKV + 1 * MiB, WT_OUT = WT_M + 6 * MiB, WT_S = WT_OUT + 2 * MiB;
static_assert(WT_S + 256 * 1024 <= WT_LAYER, "weights");
constexpr size_t WS_RA = 100 * MiB;
constexpr size_t RA_XS = 0, RA_HID = 72 * MiB, RA_YS = 216 * MiB;
constexpr size_t WS_RB = 398 * MiB;
constexpr size_t RB_YCAT = 0, RB_KVRAW = 102 * MiB, RB_MERGED = 102 * MiB, RB_QRAW = 170 * MiB, RB_KG = 221 * MiB, RB_VG = 272 * MiB, RB_QFL = 306 * MiB, RB_QFC = 354 * MiB,
                 RB_QDF = 306 * MiB, RB_KDT = 340 * MiB, RB_VTG = 374 * MiB, RB_DECAY = 408 * MiB, RB_OINTRA = 410 * MiB, RB_OF = 444 * MiB, RB_OB = 478 * MiB, RB_END = 512 * MiB;
constexpr size_t RB_WGU = 0, RB_WD = RB_END, RB_YSC = 200 * MiB;
constexpr int GU_SPLIT = 10;
constexpr size_t RB_WGU2 = RB_WD + 64 * MiB;
constexpr size_t WS_END = WS_RB + RB_WGU2 + (size_t)(NEXP - GU_SPLIT) * 8 * MiB;
static_assert(WS_END <= 1024 * MiB, "workspace");
constexpr int LDS_BYTES = 147456;
constexpr int LDS_MISC = 145408;
}
using namespace cfg;

enum { I_X = 0, I_C, I_CTX, I_CCTX, I_WMOD, I_BMOD, I_GMIX, I_GFFN, I_WIN, I_BGATE, I_WS, I_BS, I_WDEC, I_BDEC, I_GGLA, I_GCQ, I_GCKV, I_WUQ, I_WUKV,
       I_GQN, I_GQR, I_GKN, I_GKR, I_WPA, I_WPB, I_WPC, I_WOUT, I_WROUTER, I_WEG, I_WEU, I_WED, N_INPUTS };

struct Args { const float* in[N_INPUTS]; float* out; unsigned char* ws; int ph_lo, ph_hi; };

struct Ctx {
    const float* const* in; float* out; unsigned char* ws; LAS unsigned char* lds;
    int tid, lane, wave, G, bid;
};
__device__ __forceinline__ int row_modidx(int row) { return row < TL ? (row >> 12) : 4; }
__device__ __forceinline__ const float* modp(const Ctx& c, int l, int bi, int which) { return (const float*)(c.ws + WS_MOD) + ((size_t)(l * 5 + bi) * 6 + which) * D; }
__device__ __forceinline__ const float* xin_row(const Ctx& c, int l, int row) {
    if (row < TL) return (l == 0 ? c.in[I_X] : (const float*)c.out) + (size_t)row * D;
    return (l == 0 ? c.in[I_CTX] : (const float*)(c.ws + WS_XC)) + (size_t)(row - TL) * D;
}
__device__ __forceinline__ float* xout_row(const Ctx& c, int row) {
    if (row < TL) return c.out + (size_t)row * D;
    return (float*)(c.ws + WS_XC) + (size_t)(row - TL) * D;
}

#if defined(DEBUG_STAT)
__device__ __forceinline__ void dbg_max(const Ctx& c, int slot, float v) { v = fabsf(v); if (!(v < 1e30f)) v = 1e30f; atomicMax((unsigned*)(c.ws + WS_CTL + 512 * 1024) + 16 * slot, __float_as_uint(v)); }
#else
__device__ __forceinline__ void dbg_max(const Ctx&, int, float) {}
#endif
__device__ __forceinline__ void tconv_tile(const Ctx& c, const float* src, int ld_src, int k0, int c0, int nvalid, const float* kscale, bf16_t* dst, int ld_dst, int r0, int kd0) {
    LAS float* scr = (LAS float*)c.lds;
    const int tid = c.tid;
#pragma unroll
    for (int p = 0; p < 8; ++p) { const int k = p * 8 + (tid >> 6), n = tid & 63;
        float v = (n < nvalid) ? src[(size_t)(k0 + k) * ld_src + c0 + n] : 0.f; if (kscale) v *= kscale[k0 + k];
        scr[n * 65 + k] = v; }
    __syncthreads();
    { const int n = tid >> 3, kc = (tid & 7) * 8; const LAS float* s = scr + n * 65 + kc;
      u32x4 o; o.x = cvt_pk_bf16(s[0], s[1]); o.y = cvt_pk_bf16(s[2], s[3]); o.z = cvt_pk_bf16(s[4], s[5]); o.w = cvt_pk_bf16(s[6], s[7]);
      *(u32x4*)(dst + (size_t)(r0 + n) * ld_dst + kd0 + kc) = o; }
    __syncthreads();
}
template <int KQ>
__device__ __forceinline__ void tconv_kq(const Ctx& c, const float* src, int ld_src, int k0, int c0, int nvalid, const float* kscale, bf16_t* dst, int ld_dst, int r0, int kd0) {
    constexpr int LD = 64 * KQ + 1;
    LAS float* scr = (LAS float*)c.lds;
    const int tid = c.tid, n = tid & 63, kr = tid >> 6; float v[KQ][8];
    const bool ok = n < nvalid;
    const float* s0 = src + (size_t)(k0 + kr) * ld_src + c0 + n;
#pragma unroll
    for (int q = 0; q < KQ; ++q)
#pragma unroll
        for (int p = 0; p < 8; ++p) v[q][p] = ok ? s0[(size_t)(q * 64 + p * 8) * ld_src] : 0.f;
    if (kscale) {
#pragma unroll
        for (int q = 0; q < KQ; ++q)
#pragma unroll
            for (int p = 0; p < 8; ++p) v[q][p] *= kscale[k0 + q * 64 + p * 8 + kr]; }
#pragma unroll
    for (int q = 0; q < KQ; ++q)
#pragma unroll
        for (int p = 0; p < 8; ++p) scr[n * LD + q * 64 + p * 8 + kr] = v[q][p];
    __syncthreads();
    { const int nn = tid >> 3, kc = (tid & 7) * 8;
#pragma unroll
      for (int q = 0; q < KQ; ++q) { const LAS float* s = scr + nn * LD + q * 64 + kc;
          u32x4 o; o.x = cvt_pk_bf16(s[0], s[1]); o.y = cvt_pk_bf16(s[2], s[3]); o.z = cvt_pk_bf16(s[4], s[5]); o.w = cvt_pk_bf16(s[6], s[7]);
          *(u32x4*)(dst + (size_t)(r0 + nn) * ld_dst + kd0 + q * 64 + kc) = o; } }
    __syncthreads();
}
template <class RowMap>
__device__ __forceinline__ void tconv_tile4(const Ctx& c, const float* src, int ld_src, int k0, int n0, bf16_t* dst, int ld_dst, int kd0, const RowMap& rowmap) {
    LAS float* scr = (LAS float*)c.lds;
    const int tid = c.tid; float v[4][8];
#pragma unroll
    for (int q = 0; q < 4; ++q)
#pragma unroll
        for (int p = 0; p < 8; ++p) { const int k = p * 8 + (tid >> 6), n = tid & 63; v[q][p] = src[(size_t)(k0 + k) * ld_src + n0 + q * 64 + n]; }
#pragma unroll
    for (int q = 0; q < 4; ++q)
#pragma unroll
        for (int p = 0; p < 8; ++p) { const int k = p * 8 + (tid >> 6), n = tid & 63; scr[(q * 64 + n) * 65 + k] = v[q][p]; }
    __syncthreads();
#pragma unroll
    for (int q = 0; q < 4; ++q) { const int n = tid >> 3, kc = (tid & 7) * 8; const LAS float* s = scr + (q * 64 + n) * 65 + kc;
      u32x4 o; o.x = cvt_pk_bf16(s[0], s[1]); o.y = cvt_pk_bf16(s[2], s[3]); o.z = cvt_pk_bf16(s[4], s[5]); o.w = cvt_pk_bf16(s[6], s[7]);
      *(u32x4*)(dst + (size_t)rowmap(n0 + q * 64 + n) * ld_dst + kd0 + kc) = o; }
    __syncthreads();
}
__device__ __forceinline__ void win_map(int r0, int& src, int& nvalid) {
    nvalid = 64;
    if (r0 < 5120) src = r0; else if (r0 < 5504) src = 5152 + (r0 - 5120); else if (r0 == 5504) src = 5792;
    else if (r0 == 5568) { src = 5120; nvalid = 32; } else if (r0 < 5888) src = 5536 + (r0 - 5632); else src = 5856 + (r0 - 5888);
}
__device__ __forceinline__ void phase_pre_a(const Ctx& c) {
    constexpr int U_IN = 140 * 4, U_UQ = 24 * 2, U_UKV = 32, U_M = 3 * 16 * 4, U_OUT = 16 * 4, U_S = 32, U_LAYER = U_IN + U_UQ + U_UKV + U_M + U_OUT + U_S, U_MOD = 192;
    for (int u = c.bid; u < 2 * U_LAYER + U_MOD; u += c.G) {
        if (u < U_MOD) {
            const int cb = u, l = cb / 96, n = (cb % 96) * 64 + c.lane;
            LAS float* sl = (LAS float*)c.lds;
            LAS float* red = (LAS float*)(c.lds + 20480);
            for (int i = c.tid; i < 5 * D; i += NTHR) { const int vi = i >> 10, k = i & (D - 1); sl[i] = siluf_(vi < 4 ? c.in[I_C][vi * D + k] : c.in[I_CCTX][k]); }
            __syncthreads();
            const float* wp = c.in[I_WMOD] + (size_t)l * D * 6144 + (size_t)(c.wave * 128) * 6144 + n; const LAS float* sw = sl + c.wave * 128;
            float a[5] = {0.f, 0.f, 0.f, 0.f, 0.f};
#pragma unroll 1
            for (int kk = 0; kk < 128; kk += 16) { float w[16];
#pragma unroll
                for (int j = 0; j < 16; ++j) w[j] = wp[(size_t)(kk + j) * 6144];
#pragma unroll
                for (int j = 0; j < 16; ++j)
#pragma unroll
                    for (int i = 0; i < 5; ++i) a[i] += sw[i * D + kk + j] * w[j]; }
#pragma unroll
            for (int i = 0; i < 5; ++i) red[(c.wave * 5 + i) * 64 + c.lane] = a[i];
            __syncthreads();
            if (c.tid < 320) { const int i = c.tid >> 6, ln = c.tid & 63; float s = 0.f;
#pragma unroll
                for (int w = 0; w < 8; ++w) s += red[(w * 5 + i) * 64 + ln];
                const int nn = (cb % 96) * 64 + ln;
                ((float*)(c.ws + WS_MOD))[(size_t)(l * 5 + i) * 6144 + nn] = s + c.in[I_BMOD][l * 6144 + nn]; }
            __syncthreads();
            continue;
        }
        const int v = u - U_MOD, l = v / U_LAYER; int r = v % U_LAYER; unsigned char* wt = c.ws + WS_WT + (size_t)l * WT_LAYER;
        if (r < U_IN) { const int nb = r >> 2, kq = r & 3; int src, nv; win_map(nb * 64, src, nv);
            tconv_kq<4>(c, c.in[I_WIN] + (size_t)l * D * 8928, 8928, kq * 256, src, nv, nullptr, (bf16_t*)(wt + WT_IN), D, nb * 64, kq * 256); continue; } r -= U_IN;
        if (r < U_UQ) { const int nb = r >> 1, kh = r & 1;
            tconv_kq<3>(c, c.in[I_WUQ] + (size_t)l * 384 * 1536, 1536, kh * 192, nb * 64, 64, c.in[I_GCQ] + l * 384, (bf16_t*)(wt + WT_UQ), 384, nb * 64, kh * 192); continue; } r -= U_UQ;
        if (r < U_UKV) { const int nb = r;
            tconv_kq<4>(c, c.in[I_WUKV] + (size_t)l * 256 * 2048, 2048, 0, nb * 64, 64, c.in[I_GCKV] + l * 256, (bf16_t*)(wt + WT_UKV), 256, nb * 64, 0); continue; } r -= U_UKV;
        if (r < U_M) { const int which = r >> 6, rr = r & 63, nb = rr >> 2, kq = rr & 3;
            const float* src = c.in[which == 0 ? I_WPA : (which == 1 ? I_WPB : I_WPC)] + (size_t)l * D * D;
            tconv_kq<4>(c, src, D, kq * 256, nb * 64, 64, nullptr, (bf16_t*)(wt + WT_M), 3 * D, nb * 64, which * D + kq * 256); continue; } r -= U_M;
        if (r < U_OUT) { const int nb = r >> 2, kq = r & 3;
            tconv_kq<4>(c, c.in[I_WOUT] + (size_t)l * D * D, D, kq * 256, nb * 64, 64, nullptr, (bf16_t*)(wt + WT_OUT), D, nb * 64, kq * 256); continue; } r -= U_OUT;
        { const float* s = c.in[I_WS] + (size_t)l * 131072 + (size_t)r * 4096 + c.tid * 8; bf16_t* d = (bf16_t*)(wt + WT_S) + (size_t)r * 4096 + c.tid * 8;
          const f32x4 a = *(const f32x4*)s, b = *(const f32x4*)(s + 4); u32x4 o; o.x = cvt_pk_bf16(a[0], a[1]); o.y = cvt_pk_bf16(a[2], a[3]); o.z = cvt_pk_bf16(b[0], b[1]); o.w = cvt_pk_bf16(b[2], b[3]);
          *(u32x4*)d = o; }
    }
}
__device__ __forceinline__ void modulate_row(const float* xrow, const float* g, const float* shift, const float* scale, bf16_t* hrow, int lane, f32x4 (&hv)[4]) {
    float ss = 0.f;
#pragma unroll
    for (int j = 0; j < 4; ++j) { hv[j] = *(const f32x4*)(xrow + 4 * lane + 256 * j); ss += (hv[j][0] * hv[j][0] + hv[j][1] * hv[j][1]) + (hv[j][2] * hv[j][2] + hv[j][3] * hv[j][3]); }
    const float rstd = 1.0f / sqrtf(wave_sum(ss) * (1.f / D) + EPS);
#pragma unroll
    for (int j = 0; j < 4; ++j) { const int cc = 4 * lane + 256 * j; const f32x4 gv = *(const f32x4*)(g + cc), sc = *(const f32x4*)(scale + cc), sh = *(const f32x4*)(shift + cc);
        hv[j] = hv[j] * rstd * gv * (sc + 1.0f) + sh;
        u32x2 o; o.x = cvt_pk_bf16(hv[j][0], hv[j][1]); o.y = cvt_pk_bf16(hv[j][2], hv[j][3]); *(u32x2*)(hrow + cc) = o; }
}
__device__ __forceinline__ void phase_modulate_mix(const Ctx& c, int l) {
    const int gw = c.bid * NWAVES + c.wave, NGW = c.G * NWAVES;
    for (int row = gw; row < T; row += NGW) { const int bi = row_modidx(row); f32x4 hv[4];
        modulate_row(xin_row(c, l, row), c.in[I_GMIX] + l * D, modp(c, l, bi, 0), modp(c, l, bi, 1), (bf16_t*)(c.ws + WS_H) + (size_t)row * D, c.lane, hv); }
}
struct EpiZ { static constexpr bool PERM = true, MID = false; bf16_t* Z; const float* bgate;
    __device__ __forceinline__ void operator()(const f32x4 (&acc)[2][2][4][2], const pg8::Unit& u, int wr, int wc, int fr, int fq) const {
        int row0 = u.pm * 256 + wr * 64 + fr; asm volatile("" : "+v"(row0)); const int col0 = u.pn * 256 + wc * 32 + 8 * fq;
        const int mode = (u.pn >= 23) ? 3 : ((u.pn >= 16 && u.pn < 20) ? 2 : ((u.pn == 8 || u.pn == 9) ? 1 : 0));
        const int gcol = (mode == 3) ? (col0 - ZGT) : 0; const float bm = (mode == 3) ? 1.f : 0.f;
        f32x4 bv[2][2];
#pragma unroll
        for (int bj = 0; bj < 2; ++bj)
#pragma unroll
            for (int n = 0; n < 2; ++n) bv[bj][n] = *(const f32x4*)(bgate + (gcol + bj * 128 + 4 * n)) * bm;
#pragma unroll
        for (int ai = 0; ai < 2; ++ai)
#pragma unroll
            for (int m = 0; m < 4; ++m) { bf16_t* rowp = Z + (size_t)(row0 + ai * 128 + m * 16) * NZ + col0;
#pragma unroll
                for (int bj = 0; bj < 2; ++bj) { f32x4 v0 = acc[ai][bj][m][0] + bv[bj][0], v1 = acc[ai][bj][m][1] + bv[bj][1];
                    if (mode == 1) { v0 = v0 * 0.08838834764831845f; v1 = v1 * 0.08838834764831845f; }
                    else if (mode == 2) {
#pragma unroll
                        for (int e = 0; e < 4; ++e) { v0[e] = siluf_(v0[e]); v1[e] = siluf_(v1[e]); } }
                    else if (mode == 3) {
#pragma unroll
                        for (int e = 0; e < 4; ++e) { v0[e] = fmaxf(sigmoidf_(v0[e]), 1e-20f); v1[e] = fmaxf(sigmoidf_(v1[e]), 1e-20f); } }
                    u32x4 w; w.x = cvt_pk_bf16(v0[0], v0[1]); w.y = cvt_pk_bf16(v0[2], v0[3]); w.z = cvt_pk_bf16(v1[0], v1[1]); w.w = cvt_pk_bf16(v1[2], v1[3]);
                    *(u32x4*)(rowp + bj * 128) = w; } }
    }
};
struct EpiPlain { static constexpr bool PERM = true, MID = false; bf16_t* O; int ldc;
    __device__ __forceinline__ void operator()(const f32x4 (&acc)[2][2][4][2], const pg8::Unit& u, int wr, int wc, int fr, int fq) const {
        int row0 = u.pm * 256 + wr * 64 + fr; asm volatile("" : "+v"(row0)); const int col0 = u.pn * 256 + wc * 32 + 8 * fq;
#pragma unroll
        for (int ai = 0; ai < 2; ++ai)
#pragma unroll
            for (int m = 0; m < 4; ++m) { bf16_t* rowp = O + (size_t)(row0 + ai * 128 + m * 16) * ldc + col0;
#pragma unroll
                for (int bj = 0; bj < 2; ++bj) { const f32x4 v0 = acc[ai][bj][m][0], v1 = acc[ai][bj][m][1];
                    u32x4 w; w.x = cvt_pk_bf16(v0[0], v0[1]); w.y = cvt_pk_bf16(v0[2], v0[3]); w.z = cvt_pk_bf16(v1[0], v1[1]); w.w = cvt_pk_bf16(v1[2], v1[3]);
                    *(u32x4*)(rowp + bj * 128) = w; } }
    }
};
struct EpiMerge { static constexpr bool PERM = true, MID = true; bf16_t* O; const bf16_t* Z;
    __device__ __forceinline__ void ld8(const bf16_t* p, float (&g)[8]) const { const u32x4 w = *(const u32x4*)p; g[0] = bflo(w.x); g[1] = bfhi(w.x); g[2] = bflo(w.y); g[3] = bfhi(w.y); g[4] = bflo(w.z); g[5] = bfhi(w.z); g[6] = bflo(w.w); g[7] = bfhi(w.w); }
    __device__ __forceinline__ void mid(f32x4 (&acc)[2][2][4][2], const pg8::Unit& u, int t, int wr, int wc, int fr, int fq) const {
        int row0 = u.pm * 256 + wr * 64 + fr; asm volatile("" : "+v"(row0)); const int col0 = u.pn * 256 + wc * 32 + 8 * fq; const int seg = (t == 16) ? 0 : 1;
#pragma unroll
        for (int ai = 0; ai < 2; ++ai)
#pragma unroll
            for (int m = 0; m < 4; ++m) { const bf16_t* gp = Z + (size_t)(row0 + ai * 128 + m * 16) * NZ + ZGT + seg * D + col0;
#pragma unroll
                for (int bj = 0; bj < 2; ++bj) { float ga[8], gb[8]; ld8(gp + bj * 128, ga); ld8(gp + D + bj * 128, gb);
#pragma unroll
                    for (int e = 0; e < 4; ++e) { acc[ai][bj][m][0][e] *= ga[e] * fast_rcp(gb[e]); acc[ai][bj][m][1][e] *= ga[4 + e] * fast_rcp(gb[4 + e]); } }
                __builtin_amdgcn_sched_barrier(0); }
    }
    __device__ __forceinline__ void operator()(const f32x4 (&acc)[2][2][4][2], const pg8::Unit& u, int wr, int wc, int fr, int fq) const {
        int row0 = u.pm * 256 + wr * 64 + fr; asm volatile("" : "+v"(row0)); const int col0 = u.pn * 256 + wc * 32 + 8 * fq;
#pragma unroll
        for (int ai = 0; ai < 2; ++ai)
#pragma unroll
            for (int m = 0; m < 4; ++m) { const size_t r = (size_t)(row0 + ai * 128 + m * 16); const bf16_t* gp = Z + r * NZ + ZGT + 2 * D + col0; bf16_t* rowp = O + r * D + col0;
#pragma unroll
                for (int bj = 0; bj < 2; ++bj) { float gc[8]; ld8(gp + bj * 128, gc); const f32x4 v0 = acc[ai][bj][m][0], v1 = acc[ai][bj][m][1];
                    u32x4 w; w.x = cvt_pk_bf16(v0[0] * gc[0], v0[1] * gc[1]); w.y = cvt_pk_bf16(v0[2] * gc[2], v0[3] * gc[3]); w.z = cvt_pk_bf16(v1[0] * gc[4], v1[1] * gc[5]); w.w = cvt_pk_bf16(v1[2] * gc[6], v1[3] * gc[7]);
                    *(u32x4*)(rowp + bj * 128) = w; }
                __builtin_amdgcn_sched_barrier(0); }
    }
};
struct EpiResid { static constexpr bool PERM = false, MID = false; const Ctx* c; int l; float* dummy;
    __device__ __forceinline__ void operator()(const f32x4 (&acc)[2][2][4][2], const pg8::Unit& u, int wr, int wc, int fr, int fq) const {
        int row0 = u.pm * 256 + wr * 64 + fr; asm volatile("" : "+v"(row0)); const int col0 = u.pn * 256 + wc * 32 + 4 * fq; const float* gate = modp(*c, l, row_modidx(u.pm * 256), 2);
        f32x4 gv[2][2];
#pragma unroll
        for (int bj = 0; bj < 2; ++bj)
#pragma unroll
            for (int n = 0; n < 2; ++n) gv[bj][n] = *(const f32x4*)(gate + col0 + bj * 128 + 16 * n);
#pragma unroll
        for (int ai = 0; ai < 2; ++ai)
#pragma unroll
            for (int m = 0; m < 4; ++m) { const int row = row0 + ai * 128 + m * 16; const float* xi = xin_row(*c, l, row) + col0; float* xo = (dummy ? dummy + (size_t)row * D : xout_row(*c, row)) + col0;
#pragma unroll
                for (int bj = 0; bj < 2; ++bj)
#pragma unroll
                    for (int n = 0; n < 2; ++n) { const f32x4 xv = *(const f32x4*)(xi + bj * 128 + 16 * n); *(f32x4*)(xo + bj * 128 + 16 * n) = xv + gv[bj][n] * acc[ai][bj][m][n]; } }
    }
};
struct EpiSwiGLU { static constexpr bool PERM = true, MID = false; bf16_t* HID;
    __device__ __forceinline__ void operator()(const f32x4 (&acc)[2][2][4][2], const pg8::Unit& u, int wr, int wc, int fr, int fq) const {
        int row0 = u.pm * 256 + wr * 64 + fr; asm volatile("" : "+v"(row0)); const int col0 = u.pn * 128 + wc * 32 + 8 * fq; bf16_t* base = HID + (size_t)u.g * ESLOTS * DEXP;
#pragma unroll
        for (int ai = 0; ai < 2; ++ai)
#pragma unroll
            for (int m = 0; m < 4; ++m) { float h[8];
#pragma unroll
                for (int n = 0; n < 2; ++n)
#pragma unroll
                    for (int e = 0; e < 4; ++e) h[4 * n + e] = siluf_(acc[ai][0][m][n][e]) * acc[ai][1][m][n][e];
                u32x4 w; w.x = cvt_pk_bf16(h[0], h[1]); w.y = cvt_pk_bf16(h[2], h[3]); w.z = cvt_pk_bf16(h[4], h[5]); w.w = cvt_pk_bf16(h[6], h[7]);
                *(u32x4*)(base + (size_t)(row0 + ai * 128 + m * 16) * DEXP + col0) = w; }
    }
};
struct EpiDown { static constexpr bool PERM = true, MID = false; bf16_t* YS; const float* gatev;
    __device__ __forceinline__ void operator()(const f32x4 (&acc)[2][2][4][2], const pg8::Unit& u, int wr, int wc, int fr, int fq) const {
        int row0 = u.pm * 256 + wr * 64 + fr; asm volatile("" : "+v"(row0)); const int col0 = u.pn * 256 + wc * 32 + 8 * fq; bf16_t* base = YS + (size_t)u.g * ESLOTS * D; const float* gp = gatev + u.g * ESLOTS;
#pragma unroll
        for (int ai = 0; ai < 2; ++ai)
#pragma unroll
            for (int m = 0; m < 4; ++m) { const int row = row0 + ai * 128 + m * 16; const float gs = gp[row]; bf16_t* rowp = base + (size_t)row * D + col0;
#pragma unroll
                for (int bj = 0; bj < 2; ++bj) { const f32x4 v0 = acc[ai][bj][m][0] * gs, v1 = acc[ai][bj][m][1] * gs;
                    u32x4 w; w.x = cvt_pk_bf16(v0[0], v0[1]); w.y = cvt_pk_bf16(v0[2], v0[3]); w.z = cvt_pk_bf16(v1[0], v1[1]); w.w = cvt_pk_bf16(v1[2], v1[3]);
                    *(u32x4*)(rowp + bj * 128) = w; } }
    }
};

struct EpiDownPart { static constexpr bool PERM = true, MID = false; bf16_t* YSC; const float* gatev;
    __device__ __forceinline__ void operator()(const f32x4 (&acc)[2][2][4][2], const pg8::Unit& u, int wr, int wc, int fr, int fq) const {
        int r0 = wr * 64 + fr; asm volatile("" : "+v"(r0)); const int col0 = u.pn * 256 + wc * 32 + 8 * fq;
        bf16_t* base = YSC + ((size_t)((u.ko >> 9) * NEXP + u.g) * 128) * D; const float* gp = gatev + u.g * ESLOTS + 2048;
#pragma unroll
        for (int m = 0; m < 4; ++m) { const int r = r0 + m * 16; const float gs = gp[r]; bf16_t* rowp = base + (size_t)r * D + col0;
#pragma unroll
            for (int bj = 0; bj < 2; ++bj) { const f32x4 v0 = acc[0][bj][m][0] * gs, v1 = acc[0][bj][m][1] * gs;
                u32x4 w; w.x = cvt_pk_bf16(v0[0], v0[1]); w.y = cvt_pk_bf16(v0[2], v0[3]); w.z = cvt_pk_bf16(v1[0], v1[1]); w.w = cvt_pk_bf16(v1[2], v1[3]);
                *(u32x4*)(rowp + bj * 128) = w; } }
    }
};

__device__ __forceinline__ void sg_accum(const bf16_t* A, int lda, const bf16_t* Bt, int ldb, int K, int lane, f32x4 (&acc)[2]) {
    const int lr = lane & 15, lq = lane >> 4; const bf16_t* ap = A + (size_t)lr * lda + 8 * lq; const bf16_t* bp0 = Bt + (size_t)lr * ldb + 8 * lq; const bf16_t* bp1 = bp0 + (size_t)16 * ldb;
    bf16x8 a[2][4], b0[2][4], b1[2][4];
#pragma unroll
    for (int i = 0; i < 4; ++i) { a[0][i] = *(const bf16x8*)(ap + 32 * i); b0[0][i] = *(const bf16x8*)(bp0 + 32 * i); b1[0][i] = *(const bf16x8*)(bp1 + 32 * i); }
#pragma unroll 1
    for (int k = 0; k < K; k += 256) {
#pragma unroll
        for (int i = 0; i < 4; ++i) { a[1][i] = *(const bf16x8*)(ap + k + 128 + 32 * i); b0[1][i] = *(const bf16x8*)(bp0 + k + 128 + 32 * i); b1[1][i] = *(const bf16x8*)(bp1 + k + 128 + 32 * i); }
#pragma unroll
        for (int i = 0; i < 4; ++i) { acc[0] = __builtin_amdgcn_mfma_f32_16x16x32_bf16(a[0][i], b0[0][i], acc[0], 0, 0, 0); acc[1] = __builtin_amdgcn_mfma_f32_16x16x32_bf16(a[0][i], b1[0][i], acc[1], 0, 0, 0); }
        if (k + 256 < K) {
#pragma unroll
            for (int i = 0; i < 4; ++i) { a[0][i] = *(const bf16x8*)(ap + k + 256 + 32 * i); b0[0][i] = *(const bf16x8*)(bp0 + k + 256 + 32 * i); b1[0][i] = *(const bf16x8*)(bp1 + k + 256 + 32 * i); } }
#pragma unroll
        for (int i = 0; i < 4; ++i) { acc[0] = __builtin_amdgcn_mfma_f32_16x16x32_bf16(a[1][i], b0[1][i], acc[0], 0, 0, 0); acc[1] = __builtin_amdgcn_mfma_f32_16x16x32_bf16(a[1][i], b1[1][i], acc[1], 0, 0, 0); }
    }
}
__device__ __forceinline__ void ctx_merge_unit(const Ctx& c, int l, int u) {
    const int lane = c.lane, w = c.wave, lr = lane & 15, lq = lane >> 4, tid = c.tid; const int row0 = TL + 64 * (u >> 4), col0 = 64 * (u & 15); const int rh = w & 1, kw = w >> 1;
    const char* yb = (const char*)(c.ws + WS_RB + RB_YCAT) + ((size_t)(row0 + 32 * rh) * 3072 + 256 * kw) * 2;
    const char* wb = (const char*)(c.ws + WS_WT + (size_t)l * WT_LAYER + WT_M) + ((size_t)col0 * 3072 + 256 * kw) * 2;
    const __amdgpu_buffer_rsrc_t ra = __builtin_amdgcn_make_buffer_rsrc((void*)yb, 0, 1 << 30, 0x00020000), rb = __builtin_amdgcn_make_buffer_rsrc((void*)wb, 0, 1 << 30, 0x00020000);
    const int voff = (lr * 3072 + 8 * lq) * 2;
    LAS float* part = (LAS float*)c.lds;
    const int T = tid >> 5, lp = 2 * (tid & 31), RT = T >> 2, CT = T & 3; const int orow = row0 + 16 * RT + 4 * (lp >> 4), ocol = col0 + 16 * CT + (lp & 15);
    const bf16_t* Zg = (const bf16_t*)(c.ws + WS_RA) + ZGT + (size_t)orow * NZ + ocol;
    float out[8] = {0.f, 0.f, 0.f, 0.f, 0.f, 0.f, 0.f, 0.f};
    bf16x8 a[2][2][2], b[2][2][4];
#define CM_LOAD(slot, P) do { const int o_ = ((P) >> 2) * (D * 2) + ((P) & 3) * 128; \
        _Pragma("unroll") for (int t_ = 0; t_ < 2; ++t_) _Pragma("unroll") for (int h_ = 0; h_ < 2; ++h_) a[slot][h_][t_] = __builtin_bit_cast(bf16x8, __builtin_amdgcn_raw_buffer_load_b128(ra, voff, t_ * (16 * 3072 * 2) + o_ + h_ * 64, 0)); \
        _Pragma("unroll") for (int t_ = 0; t_ < 4; ++t_) _Pragma("unroll") for (int h_ = 0; h_ < 2; ++h_) b[slot][h_][t_] = __builtin_bit_cast(bf16x8, __builtin_amdgcn_raw_buffer_load_b128(rb, voff, t_ * (16 * 3072 * 2) + o_ + h_ * 64, 0)); } while (0)
#define CM_MMA(slot) do { _Pragma("unroll") for (int h_ = 0; h_ < 2; ++h_) _Pragma("unroll") for (int rt_ = 0; rt_ < 2; ++rt_) _Pragma("unroll") for (int ct_ = 0; ct_ < 4; ++ct_) \
        acc[rt_][ct_] = __builtin_amdgcn_mfma_f32_16x16x32_bf16(a[slot][h_][rt_], b[slot][h_][ct_], acc[rt_][ct_], 0, 0, 0); } while (0)
    CM_LOAD(0, 0); __builtin_amdgcn_sched_barrier(0);
#pragma unroll 1
    for (int seg = 0; seg < 3; ++seg) { f32x4 acc[2][4];
#pragma unroll
        for (int rt = 0; rt < 2; ++rt)
#pragma unroll
            for (int ct = 0; ct < 4; ++ct) acc[rt][ct] = (f32x4){0.f, 0.f, 0.f, 0.f};
#pragma unroll
        for (int jp = 0; jp < 4; ++jp) { const int P = seg * 4 + jp; __builtin_amdgcn_sched_barrier(0); if (P + 1 < 12) CM_LOAD((jp + 1) & 1, P + 1); __builtin_amdgcn_sched_barrier(0); CM_MMA(jp & 1); __builtin_amdgcn_sched_barrier(0); }
        unsigned gz[4];
#pragma unroll
        for (int e = 0; e < 4; ++e) gz[e] = *(const unsigned*)(Zg + (size_t)e * NZ + seg * D);
        { LAS float* wp = part + (size_t)(w * 8 * 64 + lane) * 4;
#pragma unroll
          for (int rt = 0; rt < 2; ++rt)
#pragma unroll
            for (int ct = 0; ct < 4; ++ct) *(LAS f32x4*)(wp + (rt * 4 + ct) * 256) = acc[rt][ct]; }
        __syncthreads();
        float s[8] = {0.f, 0.f, 0.f, 0.f, 0.f, 0.f, 0.f, 0.f};
        { const LAS float* pl = part + (size_t)((((RT >> 1) * 8 + (RT & 1) * 4 + CT) * 64) + lp) * 4;
#pragma unroll
          for (int p = 0; p < 4; ++p) { const f32x4 v0 = *(const LAS f32x4*)(pl + p * 4096), v1 = *(const LAS f32x4*)(pl + p * 4096 + 4);
#pragma unroll
              for (int e = 0; e < 4; ++e) { s[e] += v0[e]; s[4 + e] += v1[e]; } } }
#pragma unroll
        for (int e = 0; e < 4; ++e) { out[e] += s[e] * bflo(gz[e]); out[4 + e] += s[4 + e] * bfhi(gz[e]); }
        __syncthreads();
    }
#undef CM_LOAD
#undef CM_MMA
    bf16_t* O = (bf16_t*)(c.ws + WS_RB + RB_MERGED) + (size_t)orow * D + ocol;
#pragma unroll
    for (int e = 0; e < 4; ++e) *(unsigned*)(O + (size_t)e * D) = cvt_pk_bf16(out[e], out[4 + e]);
}
__device__ __forceinline__ void ctx_out_unit(const Ctx& c, int l, int u) {
    const int lane = c.lane, w = c.wave, lr = lane & 15, lq = lane >> 4; const int row0 = TL + 64 * (u >> 4) + 16 * (w >> 1), col0 = 64 * (u & 15) + 32 * (w & 1);
    const bf16_t* A = (const bf16_t*)(c.ws + WS_RB + RB_MERGED) + (size_t)row0 * D; const bf16_t* WO = (const bf16_t*)(c.ws + WS_WT + (size_t)l * WT_LAYER + WT_OUT) + (size_t)col0 * D;
    f32x4 acc[2] = {{0.f, 0.f, 0.f, 0.f}, {0.f, 0.f, 0.f, 0.f}};
    sg_accum(A, D, WO, D, D, lane, acc);
    const float* gate = modp(c, l, 4, 2);
#pragma unroll
    for (int t = 0; t < 2; ++t)
#pragma unroll
        for (int e = 0; e < 4; ++e) { const int row = row0 + 4 * lq + e, col = col0 + 16 * t + lr; xout_row(c, row)[col] = xin_row(c, l, row)[col] + gate[col] * acc[t][e]; }
}
__device__ __forceinline__ void mixA_unit(const Ctx& c, int l, int un) {
    const int cn = un >> 3, g = un & 7; const int row0 = cn * 128;
    const bf16_t* Z = (const bf16_t*)(c.ws + WS_RA); bf16_t* Y = (bf16_t*)(c.ws + WS_RB + RB_YCAT);
    const bf16_t* WSb = (const bf16_t*)(c.ws + WS_WT + (size_t)l * WT_LAYER + WT_S) + g * 16384;
    LAS bf16_t* VT = (LAS bf16_t*)c.lds;
    { const int s = c.tid >> 2, qd = c.tid & 3; const bf16_t* p = Z + (size_t)(row0 + s) * NZ + ZVA + g * 128 + qd * 32;
      float v[32];
#pragma unroll
      for (int i = 0; i < 4; ++i) { const u32x4 w = *(const u32x4*)(p + 8 * i); v[8 * i] = bflo(w.x); v[8 * i + 1] = bfhi(w.x); v[8 * i + 2] = bflo(w.y); v[8 * i + 3] = bfhi(w.y); v[8 * i + 4] = bflo(w.z); v[8 * i + 5] = bfhi(w.z); v[8 * i + 6] = bflo(w.w); v[8 * i + 7] = bfhi(w.w); }
      float sm = 0.f;
#pragma unroll
      for (int i = 0; i < 32; ++i) sm += v[i];
      sm += sx<1>(sm); sm += sx<2>(sm); const float mu = sm * (1.f / 128.f); float sq = 0.f;
#pragma unroll
      for (int i = 0; i < 32; ++i) { v[i] -= mu; sq += v[i] * v[i]; }
      sq += sx<1>(sq); sq += sx<2>(sq); const float rstd = 1.0f / sqrtf(sq * (1.f / 128.f) + EPS);
#pragma unroll
      for (int i = 0; i < 32; ++i) VT[(qd * 32 + i) * 136 + s] = f2bf(v[i] * rstd); }
    __syncthreads();
    const int w = c.wave, lr = c.lane & 15, lq = c.lane >> 4;
    bf16x8 bw[4];
#pragma unroll
    for (int ks = 0; ks < 4; ++ks) bw[ks] = *(const bf16x8*)(WSb + (16 * w + lr) * 128 + 32 * ks + 8 * lq);
    const int t = row0 + 16 * w + lr; const float bs = c.in[I_BS][(l * 8 + g) * 128 + 16 * w + lr];
#pragma unroll
    for (int ct = 0; ct < 8; ++ct) { f32x4 acc = {0.f, 0.f, 0.f, 0.f};
#pragma unroll
        for (int ks = 0; ks < 4; ++ks) { const bf16x8 a = *(const LAS bf16x8*)(VT + (16 * ct + lr) * 136 + 32 * ks + 8 * lq); acc = __builtin_amdgcn_mfma_f32_16x16x32_bf16(a, bw[ks], acc, 0, 0, 0); }
        const int cc = g * 128 + 16 * ct + 4 * lq; const u32x2 uw = *(const u32x2*)(Z + (size_t)t * NZ + ZU + cc);
        u32x2 o; o.x = cvt_pk_bf16(bflo(uw.x) * (acc[0] + bs), bfhi(uw.x) * (acc[1] + bs)); o.y = cvt_pk_bf16(bflo(uw.y) * (acc[2] + bs), bfhi(uw.y) * (acc[3] + bs));
        *(u32x2*)(Y + (size_t)t * 3072 + cc) = o; }
    __syncthreads();
}
__device__ __forceinline__ void gla_b1_unit(const Ctx& c, int l, int un) {
    const int n = un >> 2, h = un & 3, row0 = n * 64, tid = c.tid, lane = c.lane, w = c.wave, lr = lane & 15, lq = lane >> 4;
    const bf16_t* Z = (const bf16_t*)(c.ws + WS_RA);
    LAS bf16_t* VTs = (LAS bf16_t*)c.lds;
    LAS float* Ds = (LAS float*)(c.lds + 36864);
    LAS float* La = (LAS float*)(c.lds + 45056);
    LAS float* Tot = (LAS float*)(c.lds + 78080);
    LAS bf16_t* QD = (LAS bf16_t*)(c.lds + 80128);
    LAS bf16_t* KI = (LAS bf16_t*)(c.lds + 97536);
    LAS bf16_t* Ps = (LAS bf16_t*)(c.lds + 114944);
    LAS bf16_t* KdT = (LAS bf16_t*)(c.lds + 124160);
    { const int t = tid >> 3, cb = (tid & 7) * 32; const bf16_t* p = Z + (size_t)(row0 + t) * NZ + ZVB + h * 256 + cb;
#pragma unroll
      for (int i = 0; i < 4; ++i) { const u32x4 wv = *(const u32x4*)(p + 8 * i); LAS bf16_t* d = VTs + (cb + 8 * i) * 72 + t;
        d[0] = (bf16_t)wv.x; d[72] = (bf16_t)(wv.x >> 16); d[144] = (bf16_t)wv.y; d[216] = (bf16_t)(wv.y >> 16); d[288] = (bf16_t)wv.z; d[360] = (bf16_t)(wv.z >> 16); d[432] = (bf16_t)wv.w; d[504] = (bf16_t)(wv.w >> 16); }
      const int dt = tid >> 3, dc = (tid & 7) * 4; const u32x2 dv = *(const u32x2*)(Z + (size_t)(row0 + dt) * NZ + ZDEC + dc);
      Ds[dt * 32 + dc] = bflo(dv.x); Ds[dt * 32 + dc + 1] = bfhi(dv.x); Ds[dt * 32 + dc + 2] = bflo(dv.y); Ds[dt * 32 + dc + 3] = bfhi(dv.y); }
    __syncthreads();
    f32x4 pacc[2] = {{0.f, 0.f, 0.f, 0.f}, {0.f, 0.f, 0.f, 0.f}};
#pragma unroll 1
    for (int dir = 0; dir < 2; ++dir) {
        { const int cch = 16 * w + lr;
          bf16x8 bfr = {0, 0, 0, 0, 0, 0, 0, 0};
          if (lq < 2) { const float* wd = c.in[I_WDEC] + (size_t)(l * 2 + dir) * 16 * 512 + (size_t)(8 * lq) * 512 + h * 128 + cch; u32x4 pk;
              pk.x = cvt_pk_bf16(wd[0], wd[512]); pk.y = cvt_pk_bf16(wd[1024], wd[1536]); pk.z = cvt_pk_bf16(wd[2048], wd[2560]); pk.w = cvt_pk_bf16(wd[3072], wd[3584]); bfr = __builtin_bit_cast(bf16x8, pk); }
          const float bias = c.in[I_BDEC][(l * 2 + dir) * 512 + h * 128 + cch];
          f32x4 la[4];
#pragma unroll
          for (int tt = 0; tt < 4; ++tt) { bf16x8 afr = {0, 0, 0, 0, 0, 0, 0, 0};
              if (lq < 2) afr = *(const bf16x8*)(Z + (size_t)(row0 + 16 * tt + lr) * NZ + ZDEC + dir * 16 + 8 * lq);
              la[tt] = __builtin_amdgcn_mfma_f32_16x16x32_bf16(afr, bfr, (f32x4){0.f, 0.f, 0.f, 0.f}, 0, 0, 0); }
#pragma unroll
          for (int tt = 0; tt < 4; ++tt)
#pragma unroll
              for (int e = 0; e < 4; ++e) { const float pre = la[tt][e] + bias; la[tt][e] = (fminf(pre, 0.f) - __logf(1.f + __expf(-fabsf(pre)))) * 0.0625f; }
          float carry = 0.f;
          if (dir == 0) {
#pragma unroll
              for (int tt = 0; tt < 4; ++tt) { la[tt][1] += la[tt][0]; la[tt][2] += la[tt][1]; la[tt][3] += la[tt][2];
                  const float tot = la[tt][3]; float pre = 0.f; const float s16 = bperm(tot, lane - 16), s32 = bperm(tot, lane - 32), s48 = bperm(tot, lane - 48);
                  if (lq >= 1) pre += s16; if (lq >= 2) pre += s32; if (lq >= 3) pre += s48;
                  const float add = carry + pre;
#pragma unroll
                  for (int e = 0; e < 4; ++e) la[tt][e] += add;
                  carry = bperm(la[tt][3], 48 + lr); }
          } else {
#pragma unroll
              for (int tt = 3; tt >= 0; --tt) { la[tt][2] += la[tt][3]; la[tt][1] += la[tt][2]; la[tt][0] += la[tt][1];
                  const float tot = la[tt][0]; float pre = 0.f; const float s16 = bperm(tot, lane + 16), s32 = bperm(tot, lane + 32), s48 = bperm(tot, lane + 48);
                  if (lq <= 2) pre += s16; if (lq <= 1) pre += s32; if (lq <= 0) pre += s48;
                  const float add = carry + pre;
#pragma unroll
                  for (int e = 0; e < 4; ++e) la[tt][e] += add;
                  carry = bperm(la[tt][0], lr); }
          }
#pragma unroll
          for (int tt = 0; tt < 4; ++tt)
#pragma unroll
              for (int e = 0; e < 4; ++e) La[(16 * tt + 4 * lq + e) * 129 + cch] = la[tt][e]; }
        __syncthreads();
        { const int t = tid >> 3, cb = (tid & 7) * 16; const bf16_t* qp = Z + (size_t)(row0 + t) * NZ + ZQB + h * 128 + cb; const bf16_t* kp = Z + (size_t)(row0 + t) * NZ + ZKB + h * 128 + cb;
          float q[16], k[16];
#pragma unroll
          for (int i = 0; i < 2; ++i) { const u32x4 a = *(const u32x4*)(qp + 8 * i), b = *(const u32x4*)(kp + 8 * i);
              q[8 * i] = bflo(a.x); q[8 * i + 1] = bfhi(a.x); q[8 * i + 2] = bflo(a.y); q[8 * i + 3] = bfhi(a.y); q[8 * i + 4] = bflo(a.z); q[8 * i + 5] = bfhi(a.z); q[8 * i + 6] = bflo(a.w); q[8 * i + 7] = bfhi(a.w);
              k[8 * i] = bflo(b.x); k[8 * i + 1] = bfhi(b.x); k[8 * i + 2] = bflo(b.y); k[8 * i + 3] = bfhi(b.y); k[8 * i + 4] = bflo(b.z); k[8 * i + 5] = bfhi(b.z); k[8 * i + 6] = bflo(b.w); k[8 * i + 7] = bfhi(b.w); }
          const int tl = (dir == 0) ? 63 : 0; float qd[16], ki[16];
#pragma unroll
          for (int i = 0; i < 16; ++i) { const float b = La[t * 129 + cb + i], bl = La[tl * 129 + cb + i]; const float e = __expf(b);
              qd[i] = q[i] * e; ki[i] = k[i] * fast_rcp(e); KdT[(cb + i) * 72 + t] = f2bf(k[i] * __expf(bl - b)); }
          u32x4 o0, o1;
          o0.x = cvt_pk_bf16(qd[0], qd[1]); o0.y = cvt_pk_bf16(qd[2], qd[3]); o0.z = cvt_pk_bf16(qd[4], qd[5]); o0.w = cvt_pk_bf16(qd[6], qd[7]);
          o1.x = cvt_pk_bf16(qd[8], qd[9]); o1.y = cvt_pk_bf16(qd[10], qd[11]); o1.z = cvt_pk_bf16(qd[12], qd[13]); o1.w = cvt_pk_bf16(qd[14], qd[15]);
          *(LAS u32x4*)(QD + t * 136 + cb) = o0; *(LAS u32x4*)(QD + t * 136 + cb + 8) = o1;
          bf16_t* qg = (bf16_t*)(c.ws + WS_RB + RB_QDF) + (size_t)(dir * 1088 + un) * 8192 + (size_t)((((t >> 5) * 4 + (cb >> 5)) * 2 + ((cb >> 4) & 1)) * 512 + (t & 31) * 8);
          u32x4 p0, p1; p0.x = o0.x; p0.y = o0.y; p0.z = o1.x; p0.w = o1.y; p1.x = o0.z; p1.y = o0.w; p1.z = o1.z; p1.w = o1.w;
          *(u32x4*)qg = p0; *(u32x4*)(qg + 256) = p1;
          o0.x = cvt_pk_bf16(ki[0], ki[1]); o0.y = cvt_pk_bf16(ki[2], ki[3]); o0.z = cvt_pk_bf16(ki[4], ki[5]); o0.w = cvt_pk_bf16(ki[6], ki[7]);
          o1.x = cvt_pk_bf16(ki[8], ki[9]); o1.y = cvt_pk_bf16(ki[10], ki[11]); o1.z = cvt_pk_bf16(ki[12], ki[13]); o1.w = cvt_pk_bf16(ki[14], ki[15]);
          *(LAS u32x4*)(KI + t * 136 + cb) = o0; *(LAS u32x4*)(KI + t * 136 + cb + 8) = o1;
          if (tid < 128) ((float*)(c.ws + WS_RB + RB_DECAY))[(size_t)(dir * 1088 + un) * 128 + tid] = __expf(La[tl * 129 + tid]); }
        __syncthreads();
        { bf16_t* kg = (bf16_t*)(c.ws + WS_RB + RB_KDT) + (size_t)(dir * 1088 + un) * 8192;
#pragma unroll
          for (int i = 0; i < 2; ++i) { const int id = tid + 512 * i, ch = id >> 3, tc = id & 7;
              *(u32x4*)(kg + (((ch >> 5) * 4 + (tc >> 1)) * 64 + (tc & 1) * 32 + (ch & 31)) * 8) = *(const LAS u32x4*)(KdT + ch * 72 + tc * 8); } }
        { const int it = w >> 1; bf16x8 a[4];
#pragma unroll
          for (int ks = 0; ks < 4; ++ks) a[ks] = *(const LAS bf16x8*)(QD + (16 * it + lr) * 136 + 32 * ks + 8 * lq);
#pragma unroll
          for (int jj = 0; jj < 2; ++jj) { const int jt = 2 * (w & 1) + jj; f32x4 s = {0.f, 0.f, 0.f, 0.f};
#pragma unroll
              for (int ks = 0; ks < 4; ++ks) { const bf16x8 b = *(const LAS bf16x8*)(KI + (16 * jt + lr) * 136 + 32 * ks + 8 * lq); s = __builtin_amdgcn_mfma_f32_16x16x32_bf16(a[ks], b, s, 0, 0, 0); }
              const int j = 16 * jt + lr;
#pragma unroll
              for (int e = 0; e < 4; ++e) { const int i = 16 * it + 4 * lq + e; const bool keep = (dir == 0) ? (j <= i) : (j >= i); pacc[jj][e] += keep ? s[e] : 0.f; } } }
        __syncthreads();
    }
    { const int it = w >> 1;
#pragma unroll
      for (int jj = 0; jj < 2; ++jj) { const int j = 16 * (2 * (w & 1) + jj) + lr;
#pragma unroll
          for (int e = 0; e < 4; ++e) { Ps[(16 * it + 4 * lq + e) * 72 + j] = f2bf(pacc[jj][e]); } } }
    __syncthreads();
    { bf16_t* OI = (bf16_t*)(c.ws + WS_RB + RB_OINTRA);
#pragma unroll
      for (int dd = 0; dd < 2; ++dd) { const int dt = 2 * w + dd; bf16x8 a[2];
#pragma unroll
          for (int ks = 0; ks < 2; ++ks) a[ks] = *(const LAS bf16x8*)(VTs + (16 * dt + lr) * 72 + 32 * ks + 8 * lq);
#pragma unroll
          for (int it = 0; it < 4; ++it) { f32x4 o = {0.f, 0.f, 0.f, 0.f};
#pragma unroll
              for (int ks = 0; ks < 2; ++ks) { const bf16x8 b = *(const LAS bf16x8*)(Ps + (16 * it + lr) * 72 + 32 * ks + 8 * lq); o = __builtin_amdgcn_mfma_f32_16x16x32_bf16(a[ks], b, o, 0, 0, 0); }

              u32x2 ov; ov.x = cvt_pk_bf16(o[0], o[1]); ov.y = cvt_pk_bf16(o[2], o[3]);
              *(u32x2*)(OI + (size_t)(row0 + 16 * it + lr) * D + h * 256 + 16 * dt + 4 * lq) = ov; } } }
    { bf16_t* vg = (bf16_t*)(c.ws + WS_RB + RB_VTG) + (size_t)un * 16384;
#pragma unroll
      for (int i = 0; i < 4; ++i) { const int id = tid + 512 * i, dv = id >> 3, tc = id & 7;
          *(u32x4*)(vg + ((((dv >> 5) * 4 + (tc >> 1)) * 64) + (tc & 1) * 32 + (dv & 31)) * 8) = *(const LAS u32x4*)(VTs + dv * 72 + tc * 8); } }
    __syncthreads();
}
template <int N> __device__ __forceinline__ void vm_wait() { asm volatile("s_waitcnt vmcnt(%0)" :: "n"(N) : "memory"); }
__device__ __forceinline__ void gla_b2_unit(const Ctx& c, int un3) {
    const int lane = c.lane, lr = lane & 31, hi = lane >> 5, w = c.wave & 3, half = un3 & 1, un2 = un3 >> 1, dvs = half * 4 + w;
    const int h = un2 & 3, b = (un2 >> 2) & 3, dir = un2 >> 4;
    volatile LAS unsigned* cntF = (volatile LAS unsigned*)(c.lds + 3 * 33280 + 4 * 5120);
    volatile LAS unsigned* cntD = (volatile LAS unsigned*)(c.lds + 3 * 33280 + 4 * 5120 + 64);
    const char* QDF = (const char*)(c.ws + WS_RB + RB_QDF) + (size_t)dir * 1088 * 16384;
    const char* KDT = (const char*)(c.ws + WS_RB + RB_KDT) + (size_t)dir * 1088 * 16384;
    const char* VTG = (const char*)(c.ws + WS_RB + RB_VTG) + (size_t)dvs * 4096;
    const char* DEC = (const char*)(c.ws + WS_RB + RB_DECAY) + (size_t)dir * 1088 * 512;
    bf16_t* OUT = (bf16_t*)(c.ws + WS_RB + (dir == 0 ? RB_OF : RB_OB)) + (size_t)(((b * 4 + h) * 8 + dvs) * NKEY) * 32;
    constexpr int STG = 33280;
    LAS unsigned char* OT = c.lds + 3 * STG + w * 5120;
    const unsigned loff = (unsigned)lane * 16u;
#define B2_CHUNK(step) ((step) < 4 ? 256 + 4 * b + (dir == 0 ? (step) : 3 - (step)) : 64 * b + (dir == 0 ? (step) - 4 : 67 - (step)))
#define B2_ISSUE(step) do { const int un_ = B2_CHUNK(step) * 4 + h; LAS unsigned char* lb_ = c.lds + ((step) % 3) * STG; \
        const char* q_ = QDF + (size_t)un_ * 16384 + loff + w * 4096; const char* k_ = KDT + (size_t)un_ * 16384 + loff + w * 4096; \
        _Pragma("unroll") for (int i_ = 0; i_ < 4; ++i_) __builtin_amdgcn_global_load_lds((const unsigned*)(q_ + i_ * 1024), (LAS unsigned*)(lb_ + w * 4096 + i_ * 1024), 16, 0, 0); \
        _Pragma("unroll") for (int i_ = 0; i_ < 4; ++i_) __builtin_amdgcn_global_load_lds((const unsigned*)(k_ + i_ * 1024), (LAS unsigned*)(lb_ + 16384 + w * 4096 + i_ * 1024), 16, 0, 0); \
        if (lane < 8) __builtin_amdgcn_global_load_lds((const unsigned*)(DEC + (size_t)un_ * 512 + w * 128 + loff), (LAS unsigned*)(lb_ + 32768 + w * 128), 16, 0, 0); } while (0)
#define B2_SPIN(cnt, target) do { while (*(cnt) < (unsigned)(target)) __builtin_amdgcn_s_sleep(1); asm volatile("" ::: "memory"); } while (0)
#define B2_ARRIVE(cnt) do { if (lane == 0) { const unsigned one_ = 1u; asm volatile("ds_add_u32 %0, %1" :: "v"((unsigned)(size_t)(cnt)), "v"(one_) : "memory"); } } while (0)
    if (c.wave >= 4) {
#pragma unroll 1
        for (int t = 0; t < 68; ++t) {
            if (t >= 3) B2_SPIN(cntD, 4 * (t - 2));
            B2_ISSUE(t);
            if (t >= 1) { vm_wait<9>(); B2_ARRIVE(cntF); }
        }
        vm_wait<0>(); B2_ARRIVE(cntF);
        return;
    }
#define B2_VT(step, vt) do { const char* v_ = VTG + (size_t)(B2_CHUNK(step) * 4 + h) * 32768 + loff; \
        asm volatile("global_load_dwordx4 %0, %4, off\n\tglobal_load_dwordx4 %1, %4, off offset:1024\n\tglobal_load_dwordx4 %2, %4, off offset:2048\n\tglobal_load_dwordx4 %3, %4, off offset:3072" \
                     : "=&v"(vt[0]), "=&v"(vt[1]), "=&v"(vt[2]), "=&v"(vt[3]) : "v"(v_) : "memory"); } while (0)
#define B2_VT_WAIT(N, vt) asm volatile("s_waitcnt vmcnt(%4)" : "+v"(vt[0]), "+v"(vt[1]), "+v"(vt[2]), "+v"(vt[3]) : "n"(N) : "memory")
    f32x16 S[4];
#pragma unroll
    for (int ct = 0; ct < 4; ++ct)
#pragma unroll
        for (int r = 0; r < 16; ++r) S[ct][r] = 0.f;
    bf16x8 vtA[4], vtB[4];
    B2_VT(0, vtA);
#define B2_STEP(step, vt, vtn) do { \
        B2_SPIN(cntF, 4 * ((step) + 1));     \
        if ((step) + 1 < 68) B2_VT((step) + 1, vtn); \
        const int n_ = B2_CHUNK(step); const int key0 = (n_ < 256) ? CTXL + (n_ & 63) * 64 : (n_ - 256 - 4 * b) * 64; \
        const LAS unsigned char* lb = c.lds + ((step) % 3) * STG + loff; \
          \
        f32x16 o[2]; \
        _Pragma("unroll") for (int tt = 0; tt < 2; ++tt) { _Pragma("unroll") for (int r = 0; r < 16; ++r) o[tt][r] = 0.f; } \
        { u32x4 bw[8]; \
          _Pragma("unroll") for (int ct = 0; ct < 4; ++ct) { _Pragma("unroll") for (int s = 0; s < 2; ++s) { bw[ct * 2 + s].x = cvt_pk_bf16(S[ct][8 * s], S[ct][8 * s + 1]); bw[ct * 2 + s].y = cvt_pk_bf16(S[ct][8 * s + 2], S[ct][8 * s + 3]); bw[ct * 2 + s].z = cvt_pk_bf16(S[ct][8 * s + 4], S[ct][8 * s + 5]); bw[ct * 2 + s].w = cvt_pk_bf16(S[ct][8 * s + 6], S[ct][8 * s + 7]); } } \
          _Pragma("unroll") for (int tt = 0; tt < 2; ++tt) { bf16x8 qa[8]; \
            _Pragma("unroll") for (int i = 0; i < 8; ++i) qa[i] = *(const LAS bf16x8*)(lb + (tt * 8 + i) * 1024); \
            __builtin_amdgcn_sched_barrier(0); \
            _Pragma("unroll") for (int i = 0; i < 8; ++i) o[tt] = __builtin_amdgcn_mfma_f32_32x32x16_bf16(__builtin_bit_cast(bf16x8, bw[i]), qa[i], o[tt], 0, 0, 0); \
            __builtin_amdgcn_sched_barrier(0); } } \
          \
        _Pragma("unroll") for (int tt = 0; tt < 2; ++tt) { bf16_t* op = OUT + (size_t)(key0 + 32 * tt + lr) * 32 + 4 * hi; \
            _Pragma("unroll") for (int gq = 0; gq < 4; ++gq) { u32x2 ov; ov.x = cvt_pk_bf16(o[tt][4 * gq], o[tt][4 * gq + 1]); ov.y = cvt_pk_bf16(o[tt][4 * gq + 2], o[tt][4 * gq + 3]); *(u32x2*)(op + 8 * gq) = ov; } } \
          \
        if ((step) == 0) B2_VT_WAIT(12, vt); else if ((step) == 67) B2_VT_WAIT(16, vt); else B2_VT_WAIT(20, vt); \
        const LAS float* dcl = (const LAS float*)(c.lds + ((step) % 3) * STG + 32768); \
        _Pragma("unroll") for (int cp = 0; cp < 2; ++cp) { bf16x8 ka[8]; f32x4 dq[8]; \
          _Pragma("unroll") for (int i = 0; i < 8; ++i) ka[i] = *(const LAS bf16x8*)(lb + 16384 + (cp * 8 + i) * 1024); \
          _Pragma("unroll") for (int i = 0; i < 8; ++i) dq[i] = *(const LAS f32x4*)(dcl + 32 * (2 * cp + (i >> 2)) + 8 * (i & 3) + 4 * hi); \
          __builtin_amdgcn_sched_barrier(0); \
          _Pragma("unroll") for (int cc = 0; cc < 2; ++cc) { _Pragma("unroll") for (int gq = 0; gq < 4; ++gq) { _Pragma("unroll") for (int e = 0; e < 4; ++e) S[2 * cp + cc][4 * gq + e] *= dq[cc * 4 + gq][e]; } } \
          _Pragma("unroll") for (int ks = 0; ks < 4; ++ks) { _Pragma("unroll") for (int cc = 0; cc < 2; ++cc) S[2 * cp + cc] = __builtin_amdgcn_mfma_f32_32x32x16_bf16(ka[cc * 4 + ks], vt[ks], S[2 * cp + cc], 0, 0, 0); } \
          __builtin_amdgcn_sched_barrier(0); } \
        asm volatile("s_waitcnt lgkmcnt(0)" ::: "memory"); B2_ARRIVE(cntD);     \
    } while (0)
#pragma unroll 1
    for (int step = 0; step < 68; step += 2) { B2_STEP(step, vtA, vtB); B2_STEP(step + 1, vtB, vtA); }
    asm volatile("s_waitcnt vmcnt(0) lgkmcnt(0)" ::: "memory");
#undef B2_STEP
#undef B2_VT_WAIT
#undef B2_CHUNK
#undef B2_ISSUE
#undef B2_VT
#undef B2_SPIN
#undef B2_ARRIVE
}
struct FinRaw { u32x2 a[4], b[4], d[4], r[4]; };
__device__ __forceinline__ void gla_finish_load(const Ctx& c, int row, FinRaw& F) {
    const int lane = c.lane; const bf16_t* OI = (const bf16_t*)(c.ws + WS_RB + RB_OINTRA) + (size_t)row * D;
    const bool lat = row < TL; const int b = lat ? (row >> 12) : ((row - TL) >> 8), key = lat ? CTXL + (row & 4095) : ((row - TL) & 255);
    const bf16_t* OFp = (const bf16_t*)(c.ws + WS_RB + RB_OF) + ((size_t)((b * 4) * 8 + (lane >> 3)) * NKEY + key) * 32 + (lane & 7) * 4; const bf16_t* OBp = OFp + (size_t)(RB_OB - RB_OF) / 2;
    const bf16_t* R = (const bf16_t*)(c.ws + WS_RA) + (size_t)row * NZ + ZRB;
#pragma unroll
    for (int h = 0; h < 4; ++h) { const int cc = h * 256 + 4 * lane; const size_t ho = (size_t)h * 8 * NKEY * 32; F.a[h] = *(const u32x2*)(OI + cc); F.b[h] = *(const u32x2*)(OFp + ho); F.d[h] = *(const u32x2*)(OBp + ho); F.r[h] = *(const u32x2*)(R + cc); }
}
__device__ __forceinline__ void gla_finish_row(const Ctx& c, int l, int row, const FinRaw& F) {
    const int lane = c.lane; bf16_t* Y = (bf16_t*)(c.ws + WS_RB + RB_YCAT) + (size_t)row * 3072 + D;
    const f32x4 gv = *(const f32x4*)(c.in[I_GGLA] + l * 256 + 4 * lane);
    float o[4][4], ss[4];
#pragma unroll
    for (int h = 0; h < 4; ++h) { const u32x2 a = F.a[h], b = F.b[h], d = F.d[h];
        o[h][0] = bflo(a.x) + bflo(b.x) + bflo(d.x); o[h][1] = bfhi(a.x) + bfhi(b.x) + bfhi(d.x); o[h][2] = bflo(a.y) + bflo(b.y) + bflo(d.y); o[h][3] = bfhi(a.y) + bfhi(b.y) + bfhi(d.y);
        ss[h] = (o[h][0] * o[h][0] + o[h][1] * o[h][1]) + (o[h][2] * o[h][2] + o[h][3] * o[h][3]); }
#pragma unroll
    for (int h = 0; h < 4; ++h) ss[h] = wave_sum(ss[h]);
#pragma unroll
    for (int h = 0; h < 4; ++h) { const int cc = h * 256 + 4 * lane; const u32x2 r = F.r[h]; const float rstd = 1.0f / sqrtf(ss[h] * (1.f / 256.f) + EPS);
        u32x2 ov; ov.x = cvt_pk_bf16(o[h][0] * rstd * gv[0] * bflo(r.x), o[h][1] * rstd * gv[1] * bfhi(r.x)); ov.y = cvt_pk_bf16(o[h][2] * rstd * gv[2] * bflo(r.y), o[h][3] * rstd * gv[3] * bfhi(r.y));
        *(u32x2*)(Y + cc) = ov; }
}
__device__ __forceinline__ void rope_angle(int pos_row, int pos_col, int j, float& cs, float& sn) {
    const int axis = j >> 5, f = j & 15; const float inv = __expf(-(float)(2 * f) * (1.f / 32.f) * 9.210340371976184f);
    float rev = (float)(axis == 0 ? pos_row : pos_col) * inv * 0.15915494309189535f; rev -= floorf(rev); sn = __builtin_amdgcn_sinf(rev); cs = __builtin_amdgcn_cosf(rev);
}
struct C1Raw { u32x2 ckv; unsigned cq[3]; bf16_t kro; u32x2 kvw[8]; unsigned qnw[8]; bf16_t qrw[8]; };
__device__ __forceinline__ void mla_c1_load(const Ctx& c, int row, bool do_q, C1Raw& R) {
    const int lane = c.lane;
    const bf16_t* Zr = (const bf16_t*)(c.ws + WS_RA) + (size_t)row * NZ;
    const bf16_t* KV = (const bf16_t*)(c.ws + WS_RB + RB_KVRAW) + (size_t)row * 2048; const bf16_t* QR = (const bf16_t*)(c.ws + WS_RB + RB_QRAW) + (size_t)row * 1536;
    R.ckv = *(const u32x2*)(Zr + ZCKV + 4 * lane);
#pragma unroll
    for (int i = 0; i < 3; ++i) R.cq[i] = *(const unsigned*)(Zr + ZCQ + 128 * i + 2 * lane);
    R.kro = Zr[ZKR + lane];
#pragma unroll
    for (int h = 0; h < 8; ++h) R.kvw[h] = *(const u32x2*)(KV + h * 256 + 4 * lane);
    if (do_q) {
#pragma unroll
        for (int h = 0; h < 8; ++h) { R.qnw[h] = *(const unsigned*)(QR + h * 192 + 2 * lane); R.qrw[h] = QR[h * 192 + 128 + lane]; }
    }
}
__device__ __forceinline__ void mla_c1_row(const Ctx& c, int l, int row, bool do_q, const C1Raw& R) {
    const int lane = c.lane; const bool lat = row < TL; const int b = lat ? (row >> 12) : ((row - TL) >> 8), t = lat ? (row & 4095) : ((row - TL) & 255), key = lat ? (CTXL + t) : t;
    bf16_t* KG = (bf16_t*)(c.ws + WS_RB + RB_KG); bf16_t* VG = (bf16_t*)(c.ws + WS_RB + RB_VG);
    float rs_kv, rs_q;
    { const u32x2 w = R.ckv; const float a0 = bflo(w.x), a1 = bfhi(w.x), a2 = bflo(w.y), a3 = bfhi(w.y);
      rs_kv = 1.0f / sqrtf(wave_sum((a0 * a0 + a1 * a1) + (a2 * a2 + a3 * a3)) * (1.f / 256.f) + EPS);
      float s = 0.f;
#pragma unroll
      for (int i = 0; i < 3; ++i) { const unsigned w2 = R.cq[i]; const float q0 = bflo(w2), q1 = bfhi(w2); s += q0 * q0 + q1 * q1; }
      rs_q = 1.0f / sqrtf(wave_sum(s) * (1.f / 384.f) + EPS); }
    float cs = 1.f, sn = 0.f; if (lat) rope_angle(t >> 6, t & 63, lane, cs, sn);
    const bool second = (lane >> 4) & 1;
    float kr;
    { const float v = bf2f(R.kro); const float rr = 1.0f / sqrtf(wave_sum(v * v) * (1.f / 64.f) + EPS); float x = v * rr * c.in[I_GKR][l * 64 + lane];
      const float xp = sx<16>(x); kr = lat ? (second ? (x * cs + xp * sn) : (x * cs - xp * sn)) : x; }
    const bf16_t krb = f2bf(kr);
    const f32x4 gkn = *(const f32x4*)(c.in[I_GKN] + l * 128 + 4 * (lane & 31));
    float ssk[8]; float ak[8][4];
#pragma unroll
    for (int h = 0; h < 8; ++h) { ak[h][0] = bflo(R.kvw[h].x) * rs_kv; ak[h][1] = bfhi(R.kvw[h].x) * rs_kv; ak[h][2] = bflo(R.kvw[h].y) * rs_kv; ak[h][3] = bfhi(R.kvw[h].y) * rs_kv;
        ssk[h] = (ak[h][0] * ak[h][0] + ak[h][1] * ak[h][1]) + (ak[h][2] * ak[h][2] + ak[h][3] * ak[h][3]); }
#pragma unroll
    for (int h = 0; h < 8; ++h) ssk[h] = half_sum(ssk[h]);
    { bf16_t* kgp = KG + (size_t)(b * NKEY + key) * (8 * 192); bf16_t* vgp = VG + (size_t)(b * NKEY + key) * (8 * 128);
#pragma unroll
      for (int h = 0; h < 8; ++h) {
        if (lane < 32) { const float rn = 1.0f / sqrtf(ssk[h] * (1.f / 128.f) + EPS); u32x2 o; o.x = cvt_pk_bf16(ak[h][0] * rn * gkn[0], ak[h][1] * rn * gkn[1]); o.y = cvt_pk_bf16(ak[h][2] * rn * gkn[2], ak[h][3] * rn * gkn[3]);
            *(u32x2*)(kgp + h * 192 + 4 * lane) = o; }
        else { u32x2 o; o.x = cvt_pk_bf16(ak[h][0], ak[h][1]); o.y = cvt_pk_bf16(ak[h][2], ak[h][3]); *(u32x2*)(vgp + h * 128 + 4 * (lane - 32)) = o; }
        kgp[h * 192 + 128 + lane] = krb;
      } }
    __builtin_amdgcn_sched_barrier(0);
    if (lane == 0) ((float*)(c.ws + WS_RSQ))[row] = rs_q;
    if (!do_q) return;
    bf16_t* QF = lat ? (bf16_t*)(c.ws + WS_RB + RB_QFL) : (bf16_t*)(c.ws + WS_RB + RB_QFC); const int nq = lat ? SEQ : CTXL;
    const float QS = 0.07216878364870322f * 1.4426950408889634f;
    const f32x2 gqn = *(const f32x2*)(c.in[I_GQN] + l * 128 + 2 * lane); const float gqr = c.in[I_GQR][l * 64 + lane];
    float n0[8], n1[8], r0[8], sn_[8], sr_[8];
#pragma unroll
    for (int h = 0; h < 8; ++h) { n0[h] = bflo(R.qnw[h]) * rs_q; n1[h] = bfhi(R.qnw[h]) * rs_q; r0[h] = bf2f(R.qrw[h]) * rs_q; sn_[h] = n0[h] * n0[h] + n1[h] * n1[h]; sr_[h] = r0[h] * r0[h]; }
#pragma unroll
    for (int h = 0; h < 8; ++h) { sn_[h] = wave_sum(sn_[h]); sr_[h] = wave_sum(sr_[h]); }
#pragma unroll
    for (int h = 0; h < 8; ++h) {
        const float rn = 1.0f / sqrtf(sn_[h] * (1.f / 128.f) + EPS), rr = 1.0f / sqrtf(sr_[h] * (1.f / 64.f) + EPS);
        bf16_t* qp = QF + (size_t)(b * nq + t) * (8 * 192) + h * 192;
        *(unsigned*)(qp + 2 * lane) = cvt_pk_bf16(n0[h] * rn * gqn[0] * QS, n1[h] * rn * gqn[1] * QS);
        const float x = r0[h] * rr * gqr; const float xp = sx<16>(x); const float xr = lat ? (second ? (x * cs + xp * sn) : (x * cs - xp * sn)) : x;
        qp[128 + lane] = f2bf(xr * QS);
    }
}
__device__ __forceinline__ bf16x8 tr_pair(unsigned a0, unsigned a1) {
    bf16x4 x, y; asm volatile("ds_read_b64_tr_b16 %0, %2\n\tds_read_b64_tr_b16 %1, %3\n\ts_waitcnt lgkmcnt(0)" : "=&v"(x), "=&v"(y) : "v"(a0), "v"(a1) : "memory");
    return (bf16x8){x[0], x[1], x[2], x[3], y[0], y[1], y[2], y[3]};
}
__device__ __forceinline__ void k2_issue(bf16x8& a0, bf16x8& a1, unsigned addr) {
    asm volatile("ds_read_b128 %0, %2\n\tds_read_b128 %1, %2 offset:12288" : "=&v"(a0), "=&v"(a1) : "v"(addr) : "memory");
}
template <int N> __device__ __forceinline__ void k2_wait(bf16x8& a0, bf16x8& a1) { asm volatile("s_waitcnt lgkmcnt(%2)" : "+v"(a0), "+v"(a1) : "n"(N) : "memory"); }
template <int OFF>
__device__ __forceinline__ void tr8_issue(bf16x4 (&x)[8], unsigned a0, unsigned a1, unsigned a2, unsigned a3, unsigned d1) {
    asm volatile("ds_read_b64_tr_b16 %0, %8 offset:%13\n\tds_read_b64_tr_b16 %2, %9 offset:%13\n\tds_read_b64_tr_b16 %4, %10 offset:%13\n\tds_read_b64_tr_b16 %6, %11 offset:%13\n\t"
                 "v_add_u32 %8, %8, %12\n\tv_add_u32 %9, %9, %12\n\tv_add_u32 %10, %10, %12\n\tv_add_u32 %11, %11, %12\n\t"
                 "ds_read_b64_tr_b16 %1, %8 offset:%13\n\tds_read_b64_tr_b16 %3, %9 offset:%13\n\tds_read_b64_tr_b16 %5, %10 offset:%13\n\tds_read_b64_tr_b16 %7, %11 offset:%13"
                 : "=&v"(x[0]), "=&v"(x[1]), "=&v"(x[2]), "=&v"(x[3]), "=&v"(x[4]), "=&v"(x[5]), "=&v"(x[6]), "=&v"(x[7]), "+v"(a0), "+v"(a1), "+v"(a2), "+v"(a3)
                 : "v"(d1), "n"(OFF) : "memory");
}
__device__ __forceinline__ void tr8_wait(bf16x4 (&x)[8]) {
    asm volatile("s_waitcnt lgkmcnt(0)" : "+v"(x[0]), "+v"(x[1]), "+v"(x[2]), "+v"(x[3]), "+v"(x[4]), "+v"(x[5]), "+v"(x[6]), "+v"(x[7]) :: "memory");
}
__device__ __forceinline__ void attn_unit(const Ctx& c, int l, const bf16_t* Qraw  , const float* rsq  , int t0  ,
                                          const bf16_t* Kp  , const bf16_t* Vp  , int nt, bf16_t* Op  ) {
    constexpr int STG = 40960, KB = 24576;
    const int tid = c.tid, lane = c.lane, w = c.wave, lr = lane & 31, hi = lane >> 5;
    const unsigned lds0 = (unsigned)(size_t)c.lds;
    unsigned ksrc[3], vsrc[2];
#pragma unroll
    for (int i = 0; i < 3; ++i) { const int P = (w + 8 * i) * 64 + lane, row = P / 24, cp = P % 24, ch = (cp & ~7) | ((cp & 7) ^ ((row >> 1) & 7)); ksrc[i] = row * 3072 + ch * 16; }
#pragma unroll
    for (int i = 0; i < 2; ++i) { const int P = (w + 8 * i) * 64 + lane, row = P >> 4, cp = P & 15, ch = cp ^ (((row & 3) << 2) | ((row >> 2) & 3)); vsrc[i] = row * 2048 + ch * 16; }
#define ATT_ISSUE(tile, stg) do { const char* kt_ = (const char*)Kp + (size_t)(tile) * (64 * 3072); const char* vt_ = (const char*)Vp + (size_t)(tile) * (64 * 2048); \
        _Pragma("unroll") for (int i_ = 0; i_ < 3; ++i_) __builtin_amdgcn_global_load_lds((const unsigned*)(kt_ + ksrc[i_]), (LAS unsigned*)(c.lds + (stg) * STG + (w + 8 * i_) * 1024), 16, 0, 0); \
        _Pragma("unroll") for (int i_ = 0; i_ < 2; ++i_) __builtin_amdgcn_global_load_lds((const unsigned*)(vt_ + vsrc[i_]), (LAS unsigned*)(c.lds + (stg) * STG + KB + (w + 8 * i_) * 1024), 16, 0, 0); } while (0)
    bf16x8 qf[12];
    {
      const int qr = 32 * w + lr; const bf16_t* qrow = Qraw + (size_t)qr * 1536 + 8 * hi; const float rs = rsq[qr];
      u32x4 raw[12]; float sn = 0.f, sr = 0.f;
#pragma unroll
      for (int s = 0; s < 12; ++s) { raw[s] = *(const u32x4*)(qrow + 16 * s); const u32x4 wv = raw[s];
          const float q2 = (bflo(wv.x) * bflo(wv.x) + bfhi(wv.x) * bfhi(wv.x)) + (bflo(wv.y) * bflo(wv.y) + bfhi(wv.y) * bfhi(wv.y)) + (bflo(wv.z) * bflo(wv.z) + bfhi(wv.z) * bfhi(wv.z)) + (bflo(wv.w) * bflo(wv.w) + bfhi(wv.w) * bfhi(wv.w));
          if (s < 8) sn += q2; else sr += q2; }
      sn = sum32(sn) * rs * rs; sr = sum32(sr) * rs * rs;
      const float QS = 0.07216878364870322f * 1.4426950408889634f;
      const float rn = rs * QS / sqrtf(sn * (1.f / 128.f) + EPS), rr = rs * QS / sqrtf(sr * (1.f / 64.f) + EPS);
      const float* gqn = c.in[I_GQN] + l * 128 + 8 * hi; const float* gqr = c.in[I_GQR] + l * 64 + 8 * hi;
#pragma unroll
      for (int s = 0; s < 8; ++s) { const f32x4 g0 = *(const f32x4*)(gqn + 16 * s) * rn, g1 = *(const f32x4*)(gqn + 16 * s + 4) * rn; const u32x4 wv = raw[s]; u32x4 pk;
          pk.x = cvt_pk_bf16(bflo(wv.x) * g0[0], bfhi(wv.x) * g0[1]); pk.y = cvt_pk_bf16(bflo(wv.y) * g0[2], bfhi(wv.y) * g0[3]); pk.z = cvt_pk_bf16(bflo(wv.z) * g1[0], bfhi(wv.z) * g1[1]); pk.w = cvt_pk_bf16(bflo(wv.w) * g1[2], bfhi(wv.w) * g1[3]);
          qf[s] = __builtin_bit_cast(bf16x8, pk); }
      float x[4][8];
#pragma unroll
      for (int s = 0; s < 4; ++s) { const f32x4 g0 = *(const f32x4*)(gqr + 16 * s) * rr, g1 = *(const f32x4*)(gqr + 16 * s + 4) * rr; const u32x4 wv = raw[8 + s];
          x[s][0] = bflo(wv.x) * g0[0]; x[s][1] = bfhi(wv.x) * g0[1]; x[s][2] = bflo(wv.y) * g0[2]; x[s][3] = bfhi(wv.y) * g0[3]; x[s][4] = bflo(wv.z) * g1[0]; x[s][5] = bfhi(wv.z) * g1[1]; x[s][6] = bflo(wv.w) * g1[2]; x[s][7] = bfhi(wv.w) * g1[3]; }
      if (t0 >= 0) { const int t = t0 + qr; const float prow = (float)(t >> 6), pcol = (float)(t & 63);
#pragma unroll
          for (int i = 0; i < 8; ++i) { const float inv = __expf(-(float)(2 * (8 * hi + i)) * (1.f / 32.f) * 9.210340371976184f) * 0.15915494309189535f;
              float r0 = prow * inv; r0 -= floorf(r0); float r1 = pcol * inv; r1 -= floorf(r1);
              const float c0 = __builtin_amdgcn_cosf(r0), s0 = __builtin_amdgcn_sinf(r0), c1 = __builtin_amdgcn_cosf(r1), s1 = __builtin_amdgcn_sinf(r1);
              const float a0 = x[0][i], b0 = x[1][i], a1 = x[2][i], b1 = x[3][i];
              x[0][i] = a0 * c0 - b0 * s0; x[1][i] = b0 * c0 + a0 * s0; x[2][i] = a1 * c1 - b1 * s1; x[3][i] = b1 * c1 + a1 * s1; } }
#pragma unroll
      for (int s = 0; s < 4; ++s) { u32x4 pk; pk.x = cvt_pk_bf16(x[s][0], x[s][1]); pk.y = cvt_pk_bf16(x[s][2], x[s][3]); pk.z = cvt_pk_bf16(x[s][4], x[s][5]); pk.w = cvt_pk_bf16(x[s][6], x[s][7]); qf[8 + s] = __builtin_bit_cast(bf16x8, pk); }
      __builtin_amdgcn_sched_barrier(0); }
    unsigned kbase = lr * 384, y16 = (unsigned)((hi ^ ((lr >> 1) & 7)) << 4);
    unsigned vbase, q64, vd1;
    { const int blk = (lane >> 4) & 1, q = (lane & 15) >> 2, p = lane & 3; const int lb = (2 * blk + (p >> 1)) ^ hi;
      vbase = KB + 256 * (4 * hi + q) + 16 * lb + 8 * (p & 1); q64 = (unsigned)(q << 6); vd1 = 2048u + ((lb & 2) ? -32 : 32); }
    f32x16 o[4];
#pragma unroll
    for (int cc = 0; cc < 4; ++cc)
#pragma unroll
        for (int r = 0; r < 16; ++r) o[cc][r] = 0.f;
    float m = 0.f, lsum = 0.f;
    ATT_ISSUE(0, 0);
    if (nt > 1) ATT_ISSUE(1, 1);
    asm volatile("" :: "v"(qf[0]), "v"(qf[1]), "v"(qf[2]), "v"(qf[3]), "v"(qf[4]), "v"(qf[5]), "v"(qf[6]), "v"(qf[7]), "v"(qf[8]), "v"(qf[9]), "v"(qf[10]), "v"(qf[11]));
#pragma unroll 1
    for (int j = 0; j < nt; ++j) {
        if (j + 1 < nt) asm volatile("s_waitcnt vmcnt(5)" ::: "memory"); else asm volatile("s_waitcnt vmcnt(0)" ::: "memory");
        asm volatile("s_waitcnt lgkmcnt(0)" ::: "memory"); __builtin_amdgcn_s_barrier(); asm volatile("" ::: "memory");
        if (j + 2 < nt) ATT_ISSUE(j + 2, (j + 2) % 3);
        const unsigned sb = lds0 + (unsigned)((j % 3) * STG);
        asm volatile("" : "+v"(kbase), "+v"(y16), "+v"(vbase), "+v"(q64), "+v"(vd1));
        const unsigned kb_ = sb + kbase;
        f32x16 st[2];
        { const float nm = -m;
#pragma unroll
          for (int kt = 0; kt < 2; ++kt)
#pragma unroll
            for (int r = 0; r < 16; ++r) st[kt][r] = nm; }
        { bf16x8 ka[2][2];
#define KADDR(s_) (kb_ + (y16 ^ (unsigned)(((2 * (s_)) & 7) << 4)) + (unsigned)((((2 * (s_)) & ~7) << 4)))
          k2_issue(ka[0][0], ka[0][1], KADDR(0));
#pragma unroll
          for (int s = 0; s < 12; ++s) {
              if (s + 1 < 12) { k2_issue(ka[(s + 1) & 1][0], ka[(s + 1) & 1][1], KADDR(s + 1)); k2_wait<2>(ka[s & 1][0], ka[s & 1][1]); }
              else k2_wait<0>(ka[s & 1][0], ka[s & 1][1]);
              st[0] = __builtin_amdgcn_mfma_f32_32x32x16_bf16(ka[s & 1][0], qf[s], st[0], 0, 0, 0);
              st[1] = __builtin_amdgcn_mfma_f32_32x32x16_bf16(ka[s & 1][1], qf[s], st[1], 0, 0, 0); }
#undef KADDR
        }
        bf16x4 vx[8];
        tr8_issue<0>(vx, sb + vbase + (q64 ^ 0u), sb + vbase + (q64 ^ 64u), sb + vbase + (q64 ^ 128u), sb + vbase + (q64 ^ 192u), vd1);
        float mx = st[0][0];
#pragma unroll
        for (int r = 1; r < 16; ++r) mx = fmaxf(mx, st[0][r]);
#pragma unroll
        for (int r = 0; r < 16; ++r) mx = fmaxf(mx, st[1][r]);
        mx = max32(mx);
        const bool firstt = (j == 0);
        if (firstt || __any(mx > 8.0f)) {
            const float delta = firstt ? mx : fmaxf(mx, 0.f), alpha = firstt ? 0.f : __builtin_amdgcn_exp2f(-delta); m += delta; lsum *= alpha;
#pragma unroll
            for (int kt = 0; kt < 2; ++kt)
#pragma unroll
                for (int r = 0; r < 16; ++r) st[kt][r] -= delta;
#pragma unroll
            for (int cc = 0; cc < 4; ++cc)
#pragma unroll
                for (int r = 0; r < 16; ++r) o[cc][r] *= alpha; }
        f32x2 ps2 = {0.f, 0.f};
#pragma unroll
        for (int kt = 0; kt < 2; ++kt)
#pragma unroll
            for (int r = 0; r < 16; r += 2) { st[kt][r] = __builtin_amdgcn_exp2f(st[kt][r]); st[kt][r + 1] = __builtin_amdgcn_exp2f(st[kt][r + 1]); ps2 += (f32x2){st[kt][r], st[kt][r + 1]}; }
        lsum += ps2[0] + ps2[1];
#define ATT_PV(KT, S2, NEXT_OFF, HAS_NEXT) do { u32x4 pw; pw.x = cvt_pk_bf16(st[KT][8 * S2], st[KT][8 * S2 + 1]); pw.y = cvt_pk_bf16(st[KT][8 * S2 + 2], st[KT][8 * S2 + 3]); pw.z = cvt_pk_bf16(st[KT][8 * S2 + 4], st[KT][8 * S2 + 5]); pw.w = cvt_pk_bf16(st[KT][8 * S2 + 6], st[KT][8 * S2 + 7]); \
            const bf16x8 pb = __builtin_bit_cast(bf16x8, pw); tr8_wait(vx); bf16x8 af[4]; \
            _Pragma("unroll") for (int cc = 0; cc < 4; ++cc) af[cc] = (bf16x8){vx[2 * cc][0], vx[2 * cc][1], vx[2 * cc][2], vx[2 * cc][3], vx[2 * cc + 1][0], vx[2 * cc + 1][1], vx[2 * cc + 1][2], vx[2 * cc + 1][3]}; \
            if (HAS_NEXT) tr8_issue<NEXT_OFF>(vx, sb + vbase + (q64 ^ 0u), sb + vbase + (q64 ^ 64u), sb + vbase + (q64 ^ 128u), sb + vbase + (q64 ^ 192u), vd1); \
            _Pragma("unroll") for (int cc = 0; cc < 4; ++cc) o[cc] = __builtin_amdgcn_mfma_f32_32x32x16_bf16(af[cc], pb, o[cc], 0, 0, 0); } while (0)
        ATT_PV(0, 0, 4096, true); ATT_PV(0, 1, 8192, true); ATT_PV(1, 0, 12288, true); ATT_PV(1, 1, 0, false);
#undef ATT_PV
    }
    const float linv = 1.0f / sum32(lsum);
    bf16_t* orow = Op + (size_t)(32 * w + lr) * 3072;
#pragma unroll
    for (int cc = 0; cc < 4; ++cc)
#pragma unroll
        for (int g = 0; g < 4; ++g) { u32x2 ov; ov.x = cvt_pk_bf16(o[cc][4 * g] * linv, o[cc][4 * g + 1] * linv); ov.y = cvt_pk_bf16(o[cc][4 * g + 2] * linv, o[cc][4 * g + 3] * linv);
            *(u32x2*)(orow + 32 * cc + 8 * g + 4 * hi) = ov; }
    asm volatile("s_waitcnt vmcnt(0) lgkmcnt(0)" ::: "memory"); __builtin_amdgcn_s_barrier(); asm volatile("" ::: "memory");
#undef ATT_ISSUE
}
__device__ __forceinline__ void route_stage_w(const Ctx& c, int l) {
    LAS float* WT = (LAS float*)c.lds; const float* wr = c.in[I_WROUTER] + (size_t)l * D * NEXP;
    for (int i = c.tid; i < D * NEXP; i += NTHR) WT[(i & 15) * 1028 + (i >> 4)] = wr[i];
    __syncthreads();
}
struct RouteRaw { f32x4 xv[4]; };
__device__ __forceinline__ void route_load(const Ctx& c, int row, RouteRaw& R) { const float* xr = xout_row(c, row);
#pragma unroll
    for (int j = 0; j < 4; ++j) R.xv[j] = *(const f32x4*)(xr + 4 * c.lane + 256 * j); }
__device__ __forceinline__ void route_row(const Ctx& c, int l, int row, const RouteRaw& R) {
    const int lane = c.lane, bi = row_modidx(row); f32x4 hv[4];
    { const float* g = c.in[I_GFFN] + l * D; const float* shift = modp(c, l, bi, 3); const float* scale = modp(c, l, bi, 4); bf16_t* hrow = (bf16_t*)(c.ws + WS_H) + (size_t)row * D; float ss = 0.f;
#pragma unroll
      for (int j = 0; j < 4; ++j) { hv[j] = R.xv[j]; ss += (hv[j][0] * hv[j][0] + hv[j][1] * hv[j][1]) + (hv[j][2] * hv[j][2] + hv[j][3] * hv[j][3]); }
      const float rstd = 1.0f / sqrtf(wave_sum(ss) * (1.f / D) + EPS);
#pragma unroll
      for (int j = 0; j < 4; ++j) { const int cc = 4 * lane + 256 * j; const f32x4 gv = *(const f32x4*)(g + cc), sc = *(const f32x4*)(scale + cc), sh = *(const f32x4*)(shift + cc);
          hv[j] = hv[j] * rstd * gv * (sc + 1.0f) + sh;
          u32x2 o; o.x = cvt_pk_bf16(hv[j][0], hv[j][1]); o.y = cvt_pk_bf16(hv[j][2], hv[j][3]); *(u32x2*)(hrow + cc) = o; } }
    const LAS float* WT = (const LAS float*)c.lds; float lg[16];
#pragma unroll
    for (int e = 0; e < 16; ++e) { f32x2 a2 = {0.f, 0.f};
#pragma unroll
        for (int j = 0; j < 4; ++j) { const f32x4 wv = *(const LAS f32x4*)(WT + e * 1028 + 4 * lane + 256 * j); a2 += hv[j].lo * wv.lo; a2 += hv[j].hi * wv.hi; }
        lg[e] = a2[0] + a2[1]; if ((e & 3) == 3) __builtin_amdgcn_sched_barrier(0); }
    float a8[8], b4[4];
#pragma unroll
    for (int e = 0; e < 8; ++e) { auto r = __builtin_amdgcn_permlane32_swap(__float_as_uint(lg[e]), __float_as_uint(lg[e + 8]), false, false); a8[e] = __uint_as_float(r[0]) + __uint_as_float(r[1]); }
#pragma unroll
    for (int i = 0; i < 4; ++i) { auto r = __builtin_amdgcn_permlane16_swap(__float_as_uint(a8[i]), __float_as_uint(a8[i + 4]), false, false); float v = __uint_as_float(r[0]) + __uint_as_float(r[1]);
        v += __int_as_float(__builtin_amdgcn_update_dpp(0, __float_as_int(v), 0x128, 0xf, 0xf, true));
        v += __int_as_float(__builtin_amdgcn_update_dpp(0, __float_as_int(v), 0x124, 0xf, 0xf, true));
        v += __int_as_float(__builtin_amdgcn_update_dpp(0, __float_as_int(v), 0x4E, 0xf, 0xf, true));
        v += __int_as_float(__builtin_amdgcn_update_dpp(0, __float_as_int(v), 0xB1, 0xf, 0xf, true));
        b4[i] = v; }
    float mx = fmaxf(fmaxf(b4[0], b4[1]), fmaxf(b4[2], b4[3]));
    { auto r = __builtin_amdgcn_permlane16_swap(__float_as_uint(mx), __float_as_uint(mx), false, false); mx = fmaxf(__uint_as_float(r[0]), __uint_as_float(r[1])); }
    mx = max32(mx);
    float sum = 0.f;
#pragma unroll
    for (int i = 0; i < 4; ++i) { b4[i] = __expf(b4[i] - mx); sum += b4[i]; }
    { auto r = __builtin_amdgcn_permlane16_swap(__float_as_uint(sum), __float_as_uint(sum), false, false); sum = __uint_as_float(r[0]) + __uint_as_float(r[1]); }
    sum = sum32(sum);
    const float inv = 1.0f / sum; const int li = lane & 15, ex = li + 4 * ((lane >> 4) & 1) + 8 * (lane >> 5);
    const float mine = (li == 0 ? b4[0] : (li == 1 ? b4[1] : (li == 2 ? b4[2] : b4[3]))) * inv;
    float* AF = (float*)(c.ws + WS_AFFT);
    if (li < 4) { if (row < TL) AF[((size_t)(row >> 12) * 16 + ex) * SEQ + (row & 4095)] = mine; else AF[(size_t)NB * 16 * SEQ + ((size_t)((row - TL) >> 8) * 16 + ex) * CTXL + ((row - TL) & 255)] = mine; }
}
struct GuMap { int up; __device__ __forceinline__ int operator()(int n) const { return (n >> 7) * 256 + up * 128 + (n & 127); } };
struct IdMap { __device__ __forceinline__ int operator()(int n) const { return n; } };
__device__ __forceinline__ int wconv_queue(const Ctx& c, int l, int q, int maxu) {
    unsigned* ctr = (unsigned*)(c.ws + WS_CTL + 32768) + 64 * l + 16 * q; LAS int* ubox = (LAS int*)(c.lds + 4 * 64 * 65 * 4);
    const int nunits = (q == 0) ? GU_SPLIT * 256 : (q == 1 ? (NEXP - GU_SPLIT) * 256 : NEXP * 128);
    int n = 0;
    for (; n < maxu; ++n) { if (c.tid == 0) *ubox = (int)__hip_atomic_fetch_add(ctr, 1u, __ATOMIC_RELAXED, __HIP_MEMORY_SCOPE_AGENT);
        __syncthreads(); const int u = *ubox; __syncthreads(); if (u >= nunits) break;
        if (q == 2) { const int e = u >> 7, r = u & 127, nb = r >> 5, kb = r & 31;
            tconv_tile4(c, c.in[I_WED] + ((size_t)l * NEXP + e) * DEXP * D, D, kb * 64, nb * 256, (bf16_t*)(c.ws + WS_RB + RB_WD) + (size_t)e * D * DEXP, DEXP, kb * 64, IdMap{}); }
        else { const int e = (u >> 8) + (q == 1 ? GU_SPLIT : 0), r = u & 255, up = r >> 7, rr = r & 127, nb = rr >> 4, kb = rr & 15;
            const float* src = c.in[up ? I_WEU : I_WEG] + ((size_t)l * NEXP + e) * D * DEXP;
            bf16_t* dst = (q == 1) ? (bf16_t*)(c.ws + WS_RB + RB_WGU2) + (size_t)(e - GU_SPLIT) * 4096 * D : (bf16_t*)(c.ws + WS_RB + RB_WGU) + (size_t)e * 4096 * D;
            tconv_tile4(c, src, DEXP, kb * 64, nb * 256, dst, D, kb * 64, GuMap{up}); } }
    return n;
}
__device__ __forceinline__ void wconv_early(const Ctx& c, int l, int maxu) { const int n = wconv_queue(c, l, 2, maxu); if (n < maxu) (void)wconv_queue(c, l, 1, maxu - n); }
__device__ __forceinline__ void expert_wconv(const Ctx& c, int l) { (void)wconv_queue(c, l, 0, 1 << 30); (void)wconv_queue(c, l, 1, 1 << 30); (void)wconv_queue(c, l, 2, 1 << 30); }
__device__ __forceinline__ void topk_unit(const Ctx& c, int un, bool is_ctx) {
    const int tid = c.tid, lane = c.lane, w = c.wave;
    LAS unsigned* hist = (LAS unsigned*)c.lds;
    LAS unsigned* ctl = (LAS unsigned*)(c.lds + 1024);
    LAS unsigned* wsum = (LAS unsigned*)(c.lds + 1280);
    LAS int* list = (LAS int*)(c.lds + 2048);
    int b, e, ntok, cap; const float* src;
    if (!is_ctx) { b = un >> 4; e = un & 15; ntok = SEQ; cap = CAPL; src = (const float*)(c.ws + WS_AFFT) + ((size_t)b * 16 + e) * SEQ; }
    else { b = un >> 4; e = un & 15; ntok = CTXL; cap = CAPC; src = (const float*)(c.ws + WS_AFFT) + (size_t)NB * 16 * SEQ + ((size_t)b * 16 + e) * CTXL; }
    const bool have = 8 * tid < ntok; unsigned key[8];
    if (have) { const u32x4 k0 = *(const u32x4*)(src + 8 * tid), k1 = *(const u32x4*)(src + 8 * tid + 4); key[0] = k0.x; key[1] = k0.y; key[2] = k0.z; key[3] = k0.w; key[4] = k1.x; key[5] = k1.y; key[6] = k1.z; key[7] = k1.w; }
    else {
#pragma unroll
        for (int i = 0; i < 8; ++i) key[i] = 0u; }
    if (tid == 0) { unsigned z0 = 0u, c0 = (unsigned)cap; asm volatile("" : "+v"(z0), "+v"(c0)); ctl[0] = z0; ctl[1] = c0; }
#pragma unroll 1
    for (int pass = 0; pass < 4; ++pass) { const int shift = 24 - 8 * pass;
        if (tid < 256) hist[tid] = 0u;
        __syncthreads();
        const unsigned pref = ctl[0], need = ctl[1];
        if (have) {
#pragma unroll
            for (int i = 0; i < 8; ++i) { const bool m = (pass == 0) || ((key[i] >> (shift + 8)) == pref); if (m) atomicAdd((unsigned*)(hist + ((key[i] >> shift) & 255u)), 1u); } }
        __syncthreads();
        if (tid < 256) {
            const unsigned hv = hist[tid]; unsigned sfx = hv;
#pragma unroll
            for (int o = 1; o < 64; o <<= 1) { const unsigned tv = bperm(sfx, lane + o); if (lane + o < 64) sfx += tv; }
            if (lane == 0) wsum[w] = sfx;
            }
        __syncthreads();
        if (tid < 256) { const unsigned hv = hist[tid]; unsigned sfx = hv;
#pragma unroll
            for (int o = 1; o < 64; o <<= 1) { const unsigned tv = bperm(sfx, lane + o); if (lane + o < 64) sfx += tv; }
            unsigned gt = sfx - hv;
#pragma unroll
            for (int j = 1; j < 4; ++j) if (w + j < 4) gt += wsum[w + j];
            if (gt < need && need <= gt + hv) { ctl[2] = (pref << 8) | (unsigned)tid; ctl[3] = need - gt; } }
        __syncthreads();
        if (tid == 0) { ctl[0] = ctl[2]; ctl[1] = ctl[3]; }
        __syncthreads();
    }
    const unsigned thr = ctl[0], need = ctl[1];
    unsigned cg = 0u, ce = 0u;
#pragma unroll
    for (int i = 0; i < 8; ++i) { cg += (key[i] > thr) ? 1u : 0u; ce += (have && key[i] == thr) ? 1u : 0u; }
    unsigned sg = cg, se = ce;
#pragma unroll
    for (int o = 1; o < 64; o <<= 1) { const unsigned tg = bperm(sg, lane - o), te = bperm(se, lane - o); if (lane >= o) { sg += tg; se += te; } }
    if (lane == 63) { wsum[w] = sg; wsum[8 + w] = se; }
    __syncthreads();
    unsigned og = 0u, oe = 0u;
#pragma unroll
    for (int j = 0; j < 8; ++j) { if (j < w) { og += wsum[j]; oe += wsum[8 + j]; } }
    unsigned pg = og + sg - cg, pe = oe + se - ce;
    const int rowbase = is_ctx ? (TL + b * CTXL) : (b * SEQ);
    if (have) {
#pragma unroll
        for (int i = 0; i < 8; ++i) { const bool g = key[i] > thr, q = key[i] == thr; const bool sel = g || (q && pe < need);
            const int rank = (int)(pg + (pe < need ? pe : need)); const int row = rowbase + 8 * tid + i;
            ((int*)(c.ws + WS_SEL))[(size_t)row * 16 + e] = sel ? rank : -1;
            if (sel) { const int slot = is_ctx ? (2048 + b * CAPC + rank) : (b * CAPL + rank); ((float*)(c.ws + WS_GATEV))[e * ESLOTS + slot] = __uint_as_float(key[i]); list[2 * rank] = row; list[2 * rank + 1] = slot; }
            pg += g ? 1u : 0u; pe += q ? 1u : 0u; } }
    __syncthreads();
    const bf16_t* H = (const bf16_t*)(c.ws + WS_H); bf16_t* XS = (bf16_t*)(c.ws + WS_RA + RA_XS) + (size_t)e * ESLOTS * D;
    for (int i0 = w; i0 < cap; i0 += 8 * NWAVES) {
        u32x4 v0[8], v1[8];
#pragma unroll
        for (int k = 0; k < 8; ++k) { const int i = i0 + k * NWAVES; if (i < cap) { const u32x4* sp = (const u32x4*)(H + (size_t)list[2 * i] * D); v0[k] = sp[lane]; v1[k] = sp[64 + lane]; } }
#pragma unroll
        for (int k = 0; k < 8; ++k) { const int i = i0 + k * NWAVES; if (i < cap) { u32x4* dp = (u32x4*)(XS + (size_t)list[2 * i + 1] * D); dp[lane] = v0[k]; dp[64 + lane] = v1[k]; } }
    }
    __syncthreads();
}
struct CombRaw { int sel; f32x4 xv[4]; };
__device__ __forceinline__ void combine_load(const Ctx& c, int row, CombRaw& R) {
    const int lane = c.lane; const float* xr = xout_row(c, row);
    R.sel = ((const int*)(c.ws + WS_SEL))[(size_t)row * 16 + (lane & 15)];
#pragma unroll
    for (int j = 0; j < 4; ++j) R.xv[j] = *(const f32x4*)(xr + 4 * lane + 256 * j);
}
__device__ __forceinline__ void combine_row(const Ctx& c, int l, int row, bool next_mod, const CombRaw& R, float* dummy = nullptr) {
    const int lane = c.lane, bi = row_modidx(row); float* xr = xout_row(c, row); float* xw = dummy ? dummy + (size_t)row * D : xr;
    const bf16_t* YS = (const bf16_t*)(c.ws + WS_RA + RA_YS); const float* g5 = modp(c, l, bi, 5);
    f32x4 acc[4];
#pragma unroll
    for (int j = 0; j < 4; ++j) acc[j] = (f32x4){0.f, 0.f, 0.f, 0.f};
    const bool lat = row < TL; const int b = lat ? (row >> 12) : ((row - TL) >> 8);
    unsigned long long pick = __ballot(R.sel >= 0) & 0xffffull;
    while (pick) {
        if (!lat) {
            const int e = __builtin_ctzll(pick); pick &= pick - 1; const int r = __builtin_amdgcn_readlane(R.sel, e);
            const bf16_t* yc = (const bf16_t*)(c.ws + WS_RB + RB_YSC) + ((size_t)e * 128 + b * CAPC + r) * D + 4 * lane; u32x2 wc[4][4];
#pragma unroll
            for (int k = 0; k < 4; ++k)
#pragma unroll
                for (int j = 0; j < 4; ++j) wc[k][j] = *(const u32x2*)(yc + (size_t)k * (NEXP * 128 * D) + 256 * j);
#pragma unroll
            for (int k = 0; k < 4; ++k)
#pragma unroll
                for (int j = 0; j < 4; ++j) { acc[j][0] += bflo(wc[k][j].x); acc[j][1] += bfhi(wc[k][j].x); acc[j][2] += bflo(wc[k][j].y); acc[j][3] += bfhi(wc[k][j].y); }
            continue; }
        const bf16_t* yp[4]; bool on[4];
#pragma unroll
        for (int k = 0; k < 4; ++k) { on[k] = pick != 0; const int e = on[k] ? __builtin_ctzll(pick) : 0; if (on[k]) pick &= pick - 1;
            const int r = __builtin_amdgcn_readlane(R.sel, e); const int slot = lat ? (b * CAPL + r) : (2048 + b * CAPC + r);
            yp[k] = YS + ((size_t)e * ESLOTS + (on[k] ? slot : 0)) * D; }
        u32x2 wv[4][4];
#pragma unroll
        for (int k = 0; k < 4; ++k)
#pragma unroll
            for (int j = 0; j < 4; ++j) wv[k][j] = on[k] ? *(const u32x2*)(yp[k] + 4 * lane + 256 * j) : (u32x2){0u, 0u};
#pragma unroll
        for (int k = 0; k < 4; ++k)
#pragma unroll
            for (int j = 0; j < 4; ++j) { acc[j][0] += bflo(wv[k][j].x); acc[j][1] += bfhi(wv[k][j].x); acc[j][2] += bflo(wv[k][j].y); acc[j][3] += bfhi(wv[k][j].y); }
    }
    float ss = 0.f; f32x4 xv[4];
#pragma unroll
    for (int j = 0; j < 4; ++j) { const int cc = 4 * lane + 256 * j; xv[j] = R.xv[j] + *(const f32x4*)(g5 + cc) * acc[j]; *(f32x4*)(xw + cc) = xv[j];
        ss += (xv[j][0] * xv[j][0] + xv[j][1] * xv[j][1]) + (xv[j][2] * xv[j][2] + xv[j][3] * xv[j][3]); }
    if (!next_mod) return;
    const float rstd = 1.0f / sqrtf(wave_sum(ss) * (1.f / D) + EPS); const float* g = c.in[I_GMIX] + (l + 1) * D; const float* sh = modp(c, l + 1, bi, 0); const float* sc = modp(c, l + 1, bi, 1);
    bf16_t* hrow = (bf16_t*)(c.ws + WS_H) + (size_t)row * D;
#pragma unroll
    for (int j = 0; j < 4; ++j) { const int cc = 4 * lane + 256 * j; const f32x4 h = xv[j] * rstd * *(const f32x4*)(g + cc) * (*(const f32x4*)(sc + cc) + 1.0f) + *(const f32x4*)(sh + cc);
        u32x2 o; o.x = cvt_pk_bf16(h[0], h[1]); o.y = cvt_pk_bf16(h[2], h[3]); *(u32x2*)(hrow + cc) = o; }
}

#ifndef MK_FUSED
#define MK_FUSED 1
#endif
constexpr int NPH = 2 + 11 * 2;
#ifndef EARLY_WD_UNITS
#define EARLY_WD_UNITS 19
#endif
constexpr int CW_BAR = 4096;

__global__ void __launch_bounds__(NTHR, 2) fwd(Args args) {
    extern __shared__ __attribute__((aligned(16))) unsigned char lds_raw[];
    Ctx c; c.in = args.in; c.out = args.out; c.ws = args.ws; c.lds = (LAS unsigned char*)lds_raw;
    c.tid = threadIdx.x; c.lane = c.tid & 63; c.wave = __builtin_amdgcn_readfirstlane(c.tid >> 6); c.G = gridDim.x; c.bid = blockIdx.x;
    volatile LAS unsigned* misc = (volatile LAS unsigned*)(c.lds + LDS_MISC);
    if (c.tid < 8) misc[c.tid] = 0u;
    __syncthreads();
#if MK_FUSED
    XcdBarrier bar = xcd_barrier_post((unsigned*)(c.ws + WS_CTL) + CW_BAR, misc);
#define GRID_BAR() xcd_barrier(bar)
#else
#define GRID_BAR() do {} while (0)
#endif
    const int lo = args.ph_lo, hi = args.ph_hi;
#ifndef PHMASK
#define PHMASK 0xffffffffu
#endif
#define IN(k) (lo <= (k) && (k) < hi)
#define EN(j) ((PHMASK >> (j)) & 1u)
#ifndef REPEAT_ID
#define REPEAT_ID -1
#endif
#define REP(id) for (int rep_ = 0; rep_ < ((REPEAT_ID == (id)) ? 2 : 1); ++rep_)
#if defined(DEBUG_TS_A)
#ifndef DEBUG_TS_Q
#define DEBUG_TS_Q 4.0f
#endif
#ifndef DEBUG_TS_SHIFT
#define DEBUG_TS_SHIFT 0.0f
#endif
#define TS_STORE(k) do { if (c.bid == 0 && c.wave == 0) ((unsigned long long*)(c.ws + WS_CTL + 768 * 1024))[(k)] = __builtin_amdgcn_s_memrealtime(); } while (0)
#else
#define TS_STORE(k) do {} while (0)
#endif
#define SEAM(k) do { if (IN((k) + 1)) { GRID_BAR(); if (REPEAT_ID == 99) GRID_BAR(); } TS_STORE((k) + 1); } while (0)
#define PHASE_CTX() Ctx pc = c; { int z_ = 0, b_ = c.bid, g_ = c.G, w_ = c.wave; asm volatile("" : "+s"(z_), "+s"(b_), "+s"(g_), "+s"(w_)); \
        z_ = __builtin_amdgcn_readfirstlane(z_); b_ = __builtin_amdgcn_readfirstlane(b_); g_ = __builtin_amdgcn_readfirstlane(g_); w_ = __builtin_amdgcn_readfirstlane(w_); \
        pc.in = c.in + z_; pc.ws = c.ws + z_; pc.out = c.out + z_; pc.bid = b_; pc.G = g_; pc.wave = w_ & 7; \
        pc.lane = (int)(__builtin_amdgcn_mbcnt_hi(~0u, __builtin_amdgcn_mbcnt_lo(~0u, (unsigned)z_)) & 63u); pc.tid = pc.wave * 64 + pc.lane; } const int gw = pc.bid * NWAVES + pc.wave; const int NGW = pc.G * NWAVES; (void)gw; (void)NGW

    TS_STORE(0);
    if (EN(0) && IN(0)) { PHASE_CTX(); REP(0) phase_pre_a(pc); SEAM(0); }
    if (EN(1) && IN(1)) { PHASE_CTX(); REP(1) phase_modulate_mix(pc, 0); SEAM(1); }
#pragma unroll 1
    for (int l = 0; l < 2; ++l) {
        const int p0 = 2 + 11 * l; const bool first = (l == 0); const int nMa = first ? 68 : 64;
#define PHASE_PTRS() PHASE_CTX(); unsigned char* wt = pc.ws + WS_WT + (size_t)l * WT_LAYER; bf16_t* Z = (bf16_t*)(pc.ws + WS_RA); bf16_t* H = (bf16_t*)(pc.ws + WS_H); (void)wt; (void)Z; (void)H
        if (EN(2) && IN(p0 + 0)) { REP(20 + 0) { PHASE_PTRS();
            pg8::Gemm g{H, (const bf16_t*)(wt + WT_IN), D, D, D, 0, 0}; pg8::GOrder S; S.init(nMa, 35, 1, pc.G, pc.bid);
            EpiZ E{Z, pc.in[I_BGATE] + l * 3072};
            REP(2) pg8::gemm_phase<EpiZ, pg8::GOrder>(pc.lds, pc.tid, g, S, E);
            if (!first) {
                pg8::GOrderCtxCols S2; S2.o.init(4, 8, 1, pc.G, (pc.bid + pc.G - (64 * 35) % pc.G) % pc.G, 64);
                pg8::gemm_phase<EpiZ, pg8::GOrderCtxCols>(pc.lds, pc.tid, g, S2, E); }
            } SEAM(p0 + 0); }
        if (EN(3) && IN(p0 + 1)) { REP(20 + 1) { PHASE_PTRS();
#ifndef NO_G2G3
            REP(3) {
            { pg8::Gemm g{Z + ZCKV, (const bf16_t*)(wt + WT_UKV), NZ, 256, 256, 0, 0}; pg8::GOrder S; S.init(68, 8, 1, pc.G, pc.bid); EpiPlain E{(bf16_t*)(pc.ws + WS_RB + RB_KVRAW), 2048};
              pg8::gemm_phase<EpiPlain, pg8::GOrder>(pc.lds, pc.tid, g, S, E); }
            { pg8::Gemm g{Z + ZCQ, (const bf16_t*)(wt + WT_UQ), NZ, 384, 384, 0, 0}; pg8::GOrder S; S.init(nMa, 6, 1, pc.G, (pc.bid + pc.G - 32 % pc.G) % pc.G); EpiPlain E{(bf16_t*)(pc.ws + WS_RB + RB_QRAW), 1536};
              pg8::gemm_phase<EpiPlain, pg8::GOrder>(pc.lds, pc.tid, g, S, E); }
            }
#endif
#ifndef NO_MIXA
            REP(4) for (int u = (pc.bid + 8) % pc.G; u < nMa * 2 * 8; u += pc.G) mixA_unit(pc, l, u);
#endif
#ifndef NO_B1
            REP(5) for (int u = (pc.bid + pc.G - 184 % pc.G) % pc.G; u < 1088; u += pc.G) gla_b1_unit(pc, l, u);
#endif
            } SEAM(p0 + 1); }
        if (EN(4) && IN(p0 + 2)) { REP(20 + 2) { PHASE_PTRS();
            REP(6) {
                const bool b2wg = (pc.G >= 128) && pc.bid < 64;
                if (pc.tid < 32) *((volatile LAS unsigned*)(pc.lds + 3 * 33280 + 4 * 5120) + pc.tid) = 0u;
                __syncthreads();
                const bool role_b2 = (pc.G >= 128) ? b2wg : true;
                if (role_b2) {
#ifndef SKIP_B2
                    if (pc.G >= 128) gla_b2_unit(pc, pc.bid);
                    else { for (int u = pc.bid; u < 64; u += pc.G) { gla_b2_unit(pc, u); __syncthreads(); if (pc.tid < 32) *((volatile LAS unsigned*)(pc.lds + 3 * 33280 + 4 * 5120) + pc.tid) = 0u; __syncthreads(); } }
#endif
                }
                if (!role_b2 || pc.G < 128) {
#ifndef SKIP_C1
                  int wi, nwv;
                  if (pc.G >= 128) { nwv = (pc.G - 64) * NWAVES; wi = (pc.bid - 64) * NWAVES + pc.wave; }
                  else { nwv = pc.G * NWAVES; wi = pc.bid * NWAVES + pc.wave; }
                  if (wi < T) { C1Raw A = {}, B = {}; mla_c1_load(pc, wi, false, A);
                      for (int row = wi; row < T; row += 2 * nwv) { const int r1 = row + nwv, r2 = row + 2 * nwv;
                          if (r1 < T) mla_c1_load(pc, r1, false, B);
                          mla_c1_row(pc, l, row, false, A);
                          if (r2 < T) mla_c1_load(pc, r2, false, A);
                          if (r1 < T) mla_c1_row(pc, l, r1, false, B); } }
#endif
#ifndef NO_EARLY_WD
                  if (!role_b2) { __syncthreads(); wconv_early(pc, l, EARLY_WD_UNITS); }
#endif
                }
            }
            } SEAM(p0 + 2); }
        if (EN(5) && IN(p0 + 3)) { REP(20 + 3) { PHASE_PTRS();
#ifndef NO_FIN
            REP(7) { const int nrow = nMa * 256; if (gw < nrow) { FinRaw A = {}, B = {}; gla_finish_load(pc, gw, A);
                for (int row = gw; row < nrow; row += 2 * NGW) { const int r1 = row + NGW, r2 = row + 2 * NGW;
                    if (r1 < nrow) gla_finish_load(pc, r1, B);
                    gla_finish_row(pc, l, row, A);
                    if (r2 < nrow) gla_finish_load(pc, r2, A);
                    if (r1 < nrow) gla_finish_row(pc, l, r1, B); } } }
#endif
            bf16_t* Y = (bf16_t*)(pc.ws + WS_RB + RB_YCAT) + 2048;
            const bf16_t* KG = (const bf16_t*)(pc.ws + WS_RB + RB_KG); const bf16_t* VG = (const bf16_t*)(pc.ws + WS_RB + RB_VG);
            const int G8 = pc.G >> 3;
            REP(8) for (int i = 0;; ++i) {
                int un; if ((pc.G & 7) == 0 && (G8 & 15) == 0) { const int x = pc.bid & 7, s = pc.bid >> 3, ppx = G8 >> 4; un = ((i * 8 * ppx) + x * ppx + (s >> 4)) * 16 + (s & 15); } else un = i * pc.G + pc.bid;
                if (un >= 512) break;
                const int bh = un >> 4, qb = un & 15, b = bh >> 3, h = bh & 7;
                attn_unit(pc, l, (const bf16_t*)(pc.ws + WS_RB + RB_QRAW) + (size_t)(b * SEQ + qb * 256) * 1536 + h * 192, (const float*)(pc.ws + WS_RSQ) + b * SEQ + qb * 256, qb * 256, KG + ((size_t)b * NKEY * 8 + h) * 192, VG + ((size_t)b * NKEY * 8 + h) * 128, 68, Y + (size_t)(b * SEQ + qb * 256) * 3072 + h * 128); }
            if (first) for (int un = pc.bid; un < 32; un += pc.G) { const int b = un >> 3, h = un & 7;
                attn_unit(pc, l, (const bf16_t*)(pc.ws + WS_RB + RB_QRAW) + (size_t)(TL + b * CTXL) * 1536 + h * 192, (const float*)(pc.ws + WS_RSQ) + TL + b * CTXL, -1, KG + ((size_t)b * NKEY * 8 + h) * 192, VG + ((size_t)b * NKEY * 8 + h) * 128, 4, Y + (size_t)(TL + b * CTXL) * 3072 + h * 128); }
            } SEAM(p0 + 3); }
        if (EN(6) && IN(p0 + 4)) { REP(20 + 4) { PHASE_PTRS();
            pg8::Gemm g{(const bf16_t*)(pc.ws + WS_RB + RB_YCAT), (const bf16_t*)(wt + WT_M), 3072, 3072, 3072, 0, 0}; pg8::GOrder S; S.init(64, 4, 1, pc.G, pc.bid);
            EpiMerge E{(bf16_t*)(pc.ws + WS_RB + RB_MERGED), Z};
            REP(9) pg8::gemm_phase<EpiMerge, pg8::GOrder>(pc.lds, pc.tid, g, S, E);
            if (first) REP(31) for (int u = pc.bid; u < 256; u += pc.G) ctx_merge_unit(pc, l, u); } SEAM(p0 + 4); }
        if (EN(7) && IN(p0 + 5)) { REP(20 + 5) { PHASE_PTRS();
            pg8::Gemm g{(const bf16_t*)(pc.ws + WS_RB + RB_MERGED), (const bf16_t*)(wt + WT_OUT), D, D, D, 0, 0}; pg8::GOrder S; S.init(64, 4, 1, pc.G, pc.bid);
            EpiResid E{&pc, l, (REPEAT_ID == 25 && rep_ == 0) ? (float*)(pc.ws + WS_RA) : nullptr};
            pg8::gemm_phase<EpiResid, pg8::GOrder>(pc.lds, pc.tid, g, S, E);
            if (first) REP(32) for (int u = pc.bid; u < 256; u += pc.G) ctx_out_unit(pc, l, u); } SEAM(p0 + 5); }
        if (EN(8) && IN(p0 + 6)) { REP(20 + 6) { PHASE_PTRS();
            REP(11) { route_stage_w(pc, l); const int nrow = nMa * 256;
                if (gw < nrow) { RouteRaw A = {}, B = {}; route_load(pc, gw, A);
                    for (int row = gw; row < nrow; row += 2 * NGW) { const int r1 = row + NGW, r2 = row + 2 * NGW;
                        if (r1 < nrow) route_load(pc, r1, B);
                        route_row(pc, l, row, A);
                        if (r2 < nrow) route_load(pc, r2, A);
                        if (r1 < nrow) route_row(pc, l, r1, B); } }
                __syncthreads(); }
            } SEAM(p0 + 6); }
        if (EN(9) && IN(p0 + 7)) { REP(20 + 7) { PHASE_PTRS();
            REP(13) for (int u = pc.bid; u < 64; u += pc.G) topk_unit(pc, u, false);
            if (first) for (int u = pc.bid; u < 64; u += pc.G) topk_unit(pc, u, true);
            REP(12) expert_wconv(pc, l);
            } SEAM(p0 + 7); }
        if (EN(10) && IN(p0 + 8)) { REP(20 + 8) { PHASE_PTRS();
            pg8::Gemm g{(const bf16_t*)(pc.ws + WS_RA + RA_XS), (const bf16_t*)(pc.ws + WS_RB + RB_WGU), D, D, D, (size_t)ESLOTS * D, (size_t)4096 * D, (const bf16_t*)(pc.ws + WS_RB + RB_WGU2) - (size_t)GU_SPLIT * 4096 * D, GU_SPLIT}; pg8::GOrder S; S.init(first ? 9 : 8, 16, 16, pc.G, pc.bid);
            EpiSwiGLU E{(bf16_t*)(pc.ws + WS_RA + RA_HID)};
            REP(14) pg8::gemm_phase<EpiSwiGLU, pg8::GOrder>(pc.lds, pc.tid, g, S, E); } SEAM(p0 + 8); }
        if (EN(11) && IN(p0 + 9)) { REP(20 + 9) { PHASE_PTRS();
            pg8::Gemm g{(const bf16_t*)(pc.ws + WS_RA + RA_HID), (const bf16_t*)(pc.ws + WS_RB + RB_WD), DEXP, DEXP, DEXP, (size_t)ESLOTS * DEXP, (size_t)D * DEXP}; pg8::GOrder S; S.init(8, 4, 16, pc.G, pc.bid);
            EpiDown E{(bf16_t*)(pc.ws + WS_RA + RA_YS), (const float*)(pc.ws + WS_GATEV)};
            REP(15) pg8::gemm_phase<EpiDown, pg8::GOrder>(pc.lds, pc.tid, g, S, E);
            if (first) {
                pg8::Gemm g2 = g; g2.K = 512; pg8::KSplitOrder S2{pc.G, (pc.G == 256) ? ((pc.bid & 7) * 32 + (pc.bid >> 3)) : pc.bid};
                EpiDownPart E2{(bf16_t*)(pc.ws + WS_RB + RB_YSC), (const float*)(pc.ws + WS_GATEV)};
                pg8::gemm_phase<EpiDownPart, pg8::KSplitOrder>(pc.lds, pc.tid, g2, S2, E2); } } SEAM(p0 + 9); }
        if (EN(12) && IN(p0 + 10)) { REP(20 + 10) { PHASE_PTRS();
            { const int nrow = nMa * 256; float* dmy = (REPEAT_ID == 30 && rep_ == 0) ? (float*)(pc.ws + WS_RB) : nullptr;
              if (gw < nrow) { CombRaw A = {}, B = {}; combine_load(pc, gw, A);
                  for (int row = gw; row < nrow; row += 2 * NGW) { const int r1 = row + NGW, r2 = row + 2 * NGW;
                      if (r1 < nrow) combine_load(pc, r1, B);
                      combine_row(pc, l, row, first, A, dmy);
                      if (r2 < nrow) combine_load(pc, r2, A);
                      if (r1 < nrow) combine_row(pc, l, r1, first, B, dmy); } } }
            } SEAM(p0 + 10); }
    }
#if defined(DEBUG_TS_A)
    { GRID_BAR(); const unsigned long long* ts = (const unsigned long long*)(c.ws + WS_CTL + 768 * 1024);
      float a = (float)(__hip_atomic_load(ts + DEBUG_TS_A + 1, __ATOMIC_RELAXED, __HIP_MEMORY_SCOPE_AGENT) - __hip_atomic_load(ts + DEBUG_TS_A, __ATOMIC_RELAXED, __HIP_MEMORY_SCOPE_AGENT)) * 1e-2f;
      float b = (float)(__hip_atomic_load(ts + DEBUG_TS_B + 1, __ATOMIC_RELAXED, __HIP_MEMORY_SCOPE_AGENT) - __hip_atomic_load(ts + DEBUG_TS_B, __ATOMIC_RELAXED, __HIP_MEMORY_SCOPE_AGENT)) * 1e-2f;
      a = exp2f(rintf(log2f(fmaxf(a, 1.f)) * DEBUG_TS_Q + DEBUG_TS_SHIFT) / DEBUG_TS_Q) * 1e-2f; b = exp2f(rintf(log2f(fmaxf(b, 1.f)) * DEBUG_TS_Q + DEBUG_TS_SHIFT) / DEBUG_TS_Q) * 1e-2f;
      const int tid_ = c.wave * 64 + (int)__builtin_amdgcn_mbcnt_hi(~0u, __builtin_amdgcn_mbcnt_lo(~0u, 0u));
      for (long i = (long)c.bid * NTHR + tid_; i < (long)TL * D; i += (long)c.G * NTHR) c.out[i] = (i == 0) ? 131072.0f * b : 1024.0f * a; }
#endif
}

extern "C" void kernel_launch(void* const* d_in, const int* in_sizes, int n_in, void* d_out, int out_size, void* d_ws, size_t ws_size, hipStream_t stream) {
    static int grid = 0;
    if (!grid) {
        int dev = 0, cus = 0, per_cu = 0;
        (void)hipGetDevice(&dev); (void)hipDeviceGetAttribute(&cus, hipDeviceAttributeMultiprocessorCount, dev);
        (void)hipFuncSetAttribute((const void*)fwd, hipFuncAttributeMaxDynamicSharedMemorySize, LDS_BYTES);
        (void)hipOccupancyMaxActiveBlocksPerMultiprocessor(&per_cu, fwd, NTHR, LDS_BYTES);
        grid = cus * (per_cu < 1 ? per_cu : 1);
        if (grid <= 0) { fprintf(stderr, "occupancy query returned 0 blocks per CU\n"); grid = cus; }
        if (ws_size < WS_END) fprintf(stderr, "workspace too small: %zu < %zu\n", ws_size, (size_t)WS_END);
    }
    (void)hipMemsetAsync((unsigned char*)d_ws + WS_CTL, 0, CTL_BYTES, stream);
    Args a{}; for (int i = 0; i < N_INPUTS; ++i) a.in[i] = (const float*)d_in[i]; a.out = (float*)d_out; a.ws = (unsigned char*)d_ws;
#if MK_FUSED
    a.ph_lo = 0; a.ph_hi = NPH;
    hipLaunchKernelGGL(fwd, dim3(grid), dim3(NTHR), LDS_BYTES, stream, a);
#else
#if defined(DEBUG_SCAN)
    hipLaunchKernelGGL(k_seterr, dim3(1), dim3(1), 0, stream, (int*)((unsigned char*)d_ws + WS_CTL + 512 * 1024));
#endif
    for (int p = 0; p < NPH; ++p) { a.ph_lo = p; a.ph_hi = p + 1;
#if defined(DEBUG_SCAN)
        if (p == 3) (void)hipMemsetAsync((unsigned char*)d_ws + WS_RB + RB_OINTRA, 0xff, (size_t)T * D * 2, stream);
#endif
        hipLaunchKernelGGL(fwd, dim3(grid), dim3(NTHR), LDS_BYTES, stream, a);
#if defined(DEBUG_SCAN)
#if defined(DEBUG_HASH)
        if (p == DEBUG_HASH_PHASE) { (void)hipMemsetAsync((unsigned char*)d_ws + WS_CTL + 512 * 1024 + 256, 0, 4, stream);
            hipLaunchKernelGGL(k_hash, dim3(512), dim3(256), 0, stream, (const unsigned*)((unsigned char*)d_ws + DEBUG_HASH_OFF), (long)(DEBUG_HASH_BYTES / 4), (unsigned*)((unsigned char*)d_ws + WS_CTL + 512 * 1024 + 256)); }
#else
        debug_after_phase(p, (unsigned char*)d_ws, (float*)d_out, stream);
#endif
#endif
    }
#if defined(DEBUG_SCAN)
#if defined(DEBUG_HASH)
    hipLaunchKernelGGL(k_apply_hash, dim3(1024), dim3(256), 0, stream, (float*)d_out, (long)out_size, (const unsigned*)((unsigned char*)d_ws + WS_CTL + 512 * 1024 + 256));
#elif defined(DEBUG_STAT)
    hipLaunchKernelGGL(k_apply_stat, dim3(1024), dim3(256), 0, stream, (float*)d_out, (long)out_size, (const int*)((unsigned char*)d_ws + WS_CTL + 512 * 1024));
#else
    hipLaunchKernelGGL(k_apply, dim3(1024), dim3(256), 0, stream, (float*)d_out, (long)out_size, (const int*)((unsigned char*)d_ws + WS_CTL + 512 * 1024));
#endif
#endif
#endif
}
```

```cpp
#define MK_FUSED 1
#include <hip/hip_runtime.h>
#include <cstdint>
#include <cstdio>

#define LAS __attribute__((address_space(3)))
#define GAS __attribute__((address_space(1)))
typedef unsigned short bf16_t;
typedef short bf16x8 __attribute__((ext_vector_type(8)));
typedef short bf16x4 __attribute__((ext_vector_type(4)));
typedef float f32x4 __attribute__((ext_vector_type(4)));
typedef float f32x2 __attribute__((ext_vector_type(2)));
typedef float f32x16 __attribute__((ext_vector_type(16)));
typedef unsigned u32x4 __attribute__((ext_vector_type(4)));
typedef unsigned u32x2 __attribute__((ext_vector_type(2)));

typedef __bf16 bf16v2_t __attribute__((ext_vector_type(2)));
__device__ __forceinline__ unsigned cvt_pk_bf16(float lo, float hi) { bf16v2_t v; v[0] = (__bf16)lo; v[1] = (__bf16)hi; return __builtin_bit_cast(unsigned, v); }
__device__ __forceinline__ bf16_t f2bf(float f) { return (bf16_t)(cvt_pk_bf16(f, 0.f) & 0xffffu); }
__device__ __forceinline__ float bf2f(bf16_t b) { return __uint_as_float(((unsigned)b) << 16); }
__device__ __forceinline__ float bflo(unsigned w) { return __uint_as_float(w << 16); }
__device__ __forceinline__ float bfhi(unsigned w) { return __uint_as_float(w & 0xffff0000u); }
template <int K> __device__ __forceinline__ float sx(float v) { static_assert(K >= 1 && K < 32, "xor mask inside a 32-lane half"); return __int_as_float(__builtin_amdgcn_ds_swizzle(__float_as_int(v), (K << 10) | 0x1F)); }
__device__ __forceinline__ float sum32(float v) { auto rr = __builtin_amdgcn_permlane32_swap(__float_as_uint(v), __float_as_uint(v), false, false); return __uint_as_float(rr[0]) + __uint_as_float(rr[1]); }
__device__ __forceinline__ float max32(float v) { auto rr = __builtin_amdgcn_permlane32_swap(__float_as_uint(v), __float_as_uint(v), false, false); return fmaxf(__uint_as_float(rr[0]), __uint_as_float(rr[1])); }
__device__ __forceinline__ float half_sum(float v) { v += sx<1>(v); v += sx<2>(v); v += sx<4>(v); v += sx<8>(v); v += sx<16>(v); return v; }
__device__ __forceinline__ float wave_sum(float v) { return sum32(half_sum(v)); }
__device__ __forceinline__ float bperm(float v, int src) { return __int_as_float(__builtin_amdgcn_ds_bpermute(src << 2, __float_as_int(v))); }
__device__ __forceinline__ unsigned bperm(unsigned v, int src) { return (unsigned)__builtin_amdgcn_ds_bpermute(src << 2, (int)v); }
__device__ __forceinline__ float fast_rcp(float x) { return __builtin_amdgcn_rcpf(x); }
__device__ __forceinline__ float fast_exp(float x) { return __builtin_amdgcn_exp2f(x * 1.4426950408889634f); }
__device__ __forceinline__ float sigmoidf_(float x) { return fast_rcp(1.f + fast_exp(-x)); }
__device__ __forceinline__ float siluf_(float x) { return x * sigmoidf_(x); }

namespace pg8 {
constexpr int BM = 256, BK = 64, HALF = 128, HTB = HALF * BK * 2, STAGE_BYTES = 8 * HTB, NXCD = 8, WGM = 8;
__host__ __device__ __forceinline__ int lds_byte(int r, int c) { const int st = (r >> 4) * 2 + (c >> 5), rr = r & 15, cc = c & 31, ob = rr * 64 + cc * 2; return st * 1024 + (ob ^ (((ob >> 9) & 1) << 5)); }
__host__ __device__ __forceinline__ void stage_rc(int b, int& R, int& C) { const int st = b / 1024, sb = b % 1024, swz = sb ^ (((sb >> 9) & 1) << 5); R = (st >> 1) * 16 + swz / 64; C = (st & 1) * 32 + (swz % 64) / 2; }
__host__ __device__ __forceinline__ int perm32(int rho) { const int n = rho >> 4, i = rho & 15; return 8 * (i >> 2) + 4 * n + (i & 3); }

struct Unit { int pm, pn, g, ko; };
struct Gemm { const bf16_t* A; const bf16_t* Bt; int lda, ldb, K; size_t gstrideA, gstrideB; const bf16_t* Bt2 = nullptr; int gsplit = 1 << 30; };

struct GOrder {
    static constexpr bool KOFF = false;
    int nM, nN, nG, nwg, G, c, pm0;
    __device__ void init(int nM_, int nN_, int nG_, int G_, int c_, int pm0_ = 0) { nM = nM_; nN = nN_; nG = nG_; nwg = nM * nN * nG; G = G_; c = c_; pm0 = pm0_; }
    __device__ bool next(int i, Unit& u) const {
        const long L = (long)i * G + c; if (L >= nwg) return false;
        int wgid = (int)L; { const int q = nwg / NXCD, r = nwg % NXCD, xcd = wgid % NXCD, off = wgid / NXCD; wgid = (xcd < r ? xcd * (q + 1) : r * (q + 1) + (xcd - r) * q) + off; }
        const int per = nM * nN; u.g = wgid / per; wgid -= u.g * per;
        const int nig = WGM * nN, gid = wgid / nig, fm = gid * WGM, gsz = (nM - fm) < WGM ? (nM - fm) : WGM;
        u.pm = pm0 + fm + ((wgid % nig) % gsz); u.pn = (wgid % nig) / gsz; return true;
    }
};

struct GOrderCtxCols { static constexpr bool KOFF = false; GOrder o;
    __device__ bool next(int i, Unit& u) const { if (!o.next(i, u)) return false; u.pn = u.pn < 6 ? 10 + u.pn : 15 + u.pn; return true; } };

struct KSplitOrder { static constexpr bool KOFF = true; int G, c;
    __device__ bool next(int i, Unit& u) const { const int L = i * G + c; if (L >= 256) return false; u.g = L >> 4; u.pm = 8; u.pn = (L >> 2) & 3; u.ko = (L & 3) * 512; return true; } };

template <class Epi, class Sched>
__device__ __forceinline__ void gemm_phase(LAS unsigned char* lds, const int tid, const Gemm g, const Sched& S, const Epi& E) {
    const int wid = __builtin_amdgcn_readfirstlane(tid >> 6), lane = tid & 63, wr = wid >> 2, wc = wid & 3, fr = lane & 15, fq = lane >> 4;
    const int K = g.K, nt = K / BK;
    unsigned voffA[2], voffB[2];
#pragma unroll
    for (int i = 0; i < 2; ++i) { int R, C; stage_rc(tid * 16 + i * 8192, R, C); const int Rb = Epi::PERM ? ((R & ~31) + perm32(R & 31)) : R;
        voffA[i] = (unsigned)(R * g.lda + C) * 2u; voffB[i] = (unsigned)(Rb * g.ldb + C) * 2u; }
    const size_t kstep = (size_t)(BK * 2);
    const size_t hstepA = (size_t)HALF * g.lda * 2, hstepB = (size_t)HALF * g.ldb * 2;
    const size_t tstepA = 2 * hstepA, tstepB = 2 * hstepB;
    const unsigned ldsw = (unsigned)wid * 1024u;
    const int aoff = lds_byte(wr * 64 + fr, fq * 8), boff = lds_byte(wc * 32 + fr, fq * 8);
#define PG8_SA(b, h) (((b) * 2 + (h)) * HTB)
#define PG8_SB(b, h) ((4 + (b) * 2 + (h)) * HTB)
#define PG8_STAGE(bufoff, gbase, voff) do { _Pragma("unroll") for (int _i = 0; _i < 2; ++_i) \
        __builtin_amdgcn_global_load_lds((const unsigned*)((const char*)(gbase) + (voff)[_i]), (LAS unsigned*)(lds + (bufoff) + ldsw + _i * 8192), 16, 0, 0); } while (0)
#define PG8_LDA(dst, b, h) do { _Pragma("unroll") for (int m = 0; m < 4; ++m) _Pragma("unroll") for (int k = 0; k < 2; ++k) dst[m][k] = *(const LAS bf16x8*)(lds + PG8_SA(b, h) + aoff + m * 2048 + k * 1024); } while (0)
#define PG8_LDB(dst, b, h) do { _Pragma("unroll") for (int n = 0; n < 2; ++n) _Pragma("unroll") for (int k = 0; k < 2; ++k) dst[n][k] = *(const LAS bf16x8*)(lds + PG8_SB(b, h) + boff + n * 2048 + k * 1024); } while (0)
#define PG8_MMA(ai, bj, At, Bt) do { __builtin_amdgcn_s_setprio(1); _Pragma("unroll") for (int m = 0; m < 4; ++m) _Pragma("unroll") for (int n = 0; n < 2; ++n) _Pragma("unroll") for (int k = 0; k < 2; ++k) \
        acc[ai][bj][m][n] = __builtin_amdgcn_mfma_f32_16x16x32_bf16(Bt[n][k], At[m][k], acc[ai][bj][m][n], 0, 0, 0); __builtin_amdgcn_s_setprio(0); } while (0)
#define PG8_WAIT_V(n) asm volatile("s_waitcnt vmcnt(" #n ")" ::: "memory")
#define PG8_WAIT_L(n) asm volatile("s_waitcnt lgkmcnt(" #n ")" ::: "memory")
#define PG8_BAR __builtin_amdgcn_s_barrier()
#define PG8_SCHED __builtin_amdgcn_sched_barrier(0)
    Unit cur, nxt; int ui = 0;
    if (!S.next(0, cur)) return;
    f32x4 acc[2][2][4][2];
#pragma unroll
    for (int a = 0; a < 2; ++a)
#pragma unroll
        for (int b = 0; b < 2; ++b)
#pragma unroll
            for (int m = 0; m < 4; ++m)
#pragma unroll
                for (int n = 0; n < 2; ++n) acc[a][b][m][n] = (f32x4){0.f, 0.f, 0.f, 0.f};
    bf16x8 At[4][2], B0[2][2], B1[2][2];
    const char* cA = (const char*)(g.A + (size_t)cur.g * g.gstrideA) + (size_t)cur.pm * tstepA; const char* cB = (const char*)((cur.g < g.gsplit ? g.Bt : g.Bt2) + (size_t)cur.g * g.gstrideB) + (size_t)cur.pn * tstepB;
    if constexpr (Sched::KOFF) { cA += (size_t)cur.ko * 2; cB += (size_t)cur.ko * 2; }
    PG8_STAGE(PG8_SB(0, 0), cB, voffB); PG8_STAGE(PG8_SB(0, 1), cB + hstepB, voffB); PG8_STAGE(PG8_SA(0, 0), cA, voffA); PG8_STAGE(PG8_SA(0, 1), cA + hstepA, voffA);
    if (wr == 1) PG8_BAR;
    PG8_WAIT_V(2); PG8_BAR;
    PG8_STAGE(PG8_SB(1, 0), cB + kstep, voffB); PG8_STAGE(PG8_SA(1, 0), cA + kstep, voffA); PG8_STAGE(PG8_SB(1, 1), cB + hstepB + kstep, voffB);
    PG8_WAIT_V(6); PG8_BAR;
    for (;;) {
        const bool has_next = S.next(ui + 1, nxt);
        const char* nA = has_next ? (const char*)(g.A + (size_t)nxt.g * g.gstrideA) + (size_t)nxt.pm * tstepA + (Sched::KOFF ? (size_t)nxt.ko * 2 : (size_t)0) : cA; const char* nB = has_next ? (const char*)((nxt.g < g.gsplit ? g.Bt : g.Bt2) + (size_t)nxt.g * g.gstrideB) + (size_t)nxt.pn * tstepB + (Sched::KOFF ? (size_t)nxt.ko * 2 : (size_t)0) : cB;
        for (int t = 0; t < nt; t += 2) {
            const bool last = (t == nt - 2);
            const char* a1 = cA + (size_t)(t + 1) * kstep;
            const char* a2 = last ? nA : cA + (size_t)(t + 2) * kstep; const char* b2 = last ? nB : cB + (size_t)(t + 2) * kstep;
            const char* a3 = a2 + kstep; const char* b3 = b2 + kstep;
            if constexpr (Epi::MID) { if (t == 16 || t == 32) E.mid(acc, cur, t, wr, wc, fr, fq); }
            PG8_LDB(B0, 0, 0); PG8_LDB(B1, 0, 1); PG8_SCHED; PG8_LDA(At, 0, 0); PG8_STAGE(PG8_SA(1, 1), a1 + hstepA, voffA);
            PG8_WAIT_V(8); PG8_WAIT_L(0); PG8_BAR; PG8_MMA(0, 0, At, B0); PG8_MMA(0, 1, At, B1); PG8_BAR; PG8_SCHED;
            PG8_LDA(At, 0, 1); PG8_STAGE(PG8_SB(0, 0), b2, voffB); PG8_STAGE(PG8_SB(0, 1), b2 + hstepB, voffB); PG8_STAGE(PG8_SA(0, 0), a2, voffA);
            PG8_WAIT_V(8); PG8_WAIT_L(0); PG8_BAR; PG8_MMA(1, 0, At, B0); PG8_MMA(1, 1, At, B1); PG8_BAR; PG8_SCHED;
            PG8_LDB(B0, 1, 0); PG8_LDB(B1, 1, 1); PG8_SCHED; PG8_LDA(At, 1, 0); PG8_STAGE(PG8_SA(0, 1), a2 + hstepA, voffA);
            PG8_WAIT_V(8); PG8_WAIT_L(0); PG8_BAR; PG8_MMA(0, 0, At, B0); PG8_MMA(0, 1, At, B1); PG8_BAR; PG8_SCHED;
            PG8_LDA(At, 1, 1); PG8_STAGE(PG8_SB(1, 0), b3, voffB); PG8_STAGE(PG8_SB(1, 1), b3 + hstepB, voffB); PG8_STAGE(PG8_SA(1, 0), a3, voffA);
            PG8_WAIT_V(8); PG8_WAIT_L(0); PG8_BAR; PG8_MMA(1, 0, At, B0); PG8_MMA(1, 1, At, B1); PG8_BAR; PG8_SCHED;
        }
        if (wr == 0) PG8_BAR;
        E(acc, cur, wr, wc, fr, fq);
        if (!has_next) break;
#pragma unroll
        for (int a = 0; a < 2; ++a)
#pragma unroll
            for (int b = 0; b < 2; ++b)
#pragma unroll
                for (int m = 0; m < 4; ++m)
#pragma unroll
                    for (int n = 0; n < 2; ++n) acc[a][b][m][n] = (f32x4){0.f, 0.f, 0.f, 0.f};
        cur = nxt; cA = nA; cB = nB; ++ui;
        if (wr == 1) PG8_BAR;
    }
    PG8_WAIT_V(0);
    PG8_BAR;
#undef PG8_SA
#undef PG8_SB
#undef PG8_STAGE
#undef PG8_LDA
#undef PG8_LDB
#undef PG8_MMA
#undef PG8_WAIT_V
#undef PG8_WAIT_L
#undef PG8_BAR
#undef PG8_SCHED
}
}
#define XB_TMO      128
#define XB_XCNT(j)  (256  + 64 * (j))
#define XB_XSUB(j)  (1280 + 64 * (j))
#define XB_XGEN(j)  (2304 + 64 * (j))
#define XB_TOP      3328
#define XB_TOPGEN   3392
#define XCD_BAR_WORDS 3456
#define XB_SPIN_CAP (1u << 18)

__device__ __forceinline__ unsigned xb_ld(unsigned* p)              { return __hip_atomic_load(p, __ATOMIC_RELAXED, __HIP_MEMORY_SCOPE_AGENT); }
__device__ __forceinline__ unsigned xb_add(unsigned* p, unsigned v) { return __hip_atomic_fetch_add(p, v, __ATOMIC_RELAXED, __HIP_MEMORY_SCOPE_AGENT); }
__device__ __forceinline__ unsigned xb_xcc_id() { return (unsigned)__builtin_amdgcn_s_getreg((3 << 11) | 20) & 0xFu; }
#define XB_SPIN(cond, bar) do { unsigned _sp = 0; while (cond) { __builtin_amdgcn_s_sleep(1); \
    if ((++_sp & 255u) == 0u) { if (xb_ld(&(bar)[XB_TMO])) break; if (_sp > XB_SPIN_CAP) { atomicAdd(&(bar)[XB_TMO], 1u); break; } } } } while (0)

struct XcdBarrier {
    unsigned* bar; unsigned x;
    volatile LAS unsigned* st;
};

__device__ __forceinline__ XcdBarrier xcd_barrier_post(unsigned* bar, volatile LAS unsigned* st) {
    XcdBarrier b; b.bar = bar; b.x = xb_xcc_id(); b.st = st;
    if (threadIdx.x == 0) (void)xb_add(&bar[XB_XCNT(b.x)], 1u);
    return b;
}
__device__ __forceinline__ void xcd_barrier_complete(unsigned* bar, unsigned x, unsigned& nloc, unsigned& nx) {
    const unsigned G = gridDim.x * gridDim.y * gridDim.z;
    unsigned sum, cnt, mine, sp = 0u;
    for (;;) {
        sum = 0u; cnt = 0u; mine = 0u;
#pragma unroll
        for (unsigned j = 0; j < 16; ++j) { const unsigned c = xb_ld(&bar[XB_XCNT(j)]); sum += c; cnt += (c > 0u) ? 1u : 0u; mine = (j == x) ? c : mine; }
        if (sum == G) break;
        __builtin_amdgcn_s_sleep(1);
        if ((++sp & 255u) == 0u) { if (xb_ld(&bar[XB_TMO])) break; if (sp > XB_SPIN_CAP) { atomicAdd(&bar[XB_TMO], 1u); break; } }
    }
    nloc = mine > 0u ? mine : 1u; nx = cnt > 0u ? cnt : 1u;
}

__device__ __forceinline__ void xcd_barrier(const XcdBarrier& b) {
    asm volatile("s_waitcnt vmcnt(0)" ::: "memory");
    __syncthreads();
    unsigned long long bp_ = (unsigned long long)b.bar; unsigned bx_ = b.x; asm volatile("" : "+s"(bp_), "+s"(bx_)); bx_ = (unsigned)__builtin_amdgcn_readfirstlane((int)bx_); bp_ = ((unsigned long long)(unsigned)__builtin_amdgcn_readfirstlane((int)(bp_ >> 32)) << 32) | (unsigned)__builtin_amdgcn_readfirstlane((int)bp_);
    if (threadIdx.x == 0) {
        unsigned* bar = (unsigned*)bp_;
        __builtin_amdgcn_s_waitcnt(0);
        unsigned nloc = b.st[0], nx = b.st[1];
        if (nloc == 0u) { xcd_barrier_complete(bar, bx_, nloc, nx); b.st[0] = nloc; b.st[1] = nx; }
        const unsigned old = xb_add(&bar[XB_XSUB(bx_)], 1u);
        const unsigned gen = old / nloc;
        if (old + 1u == (gen + 1u) * nloc) {
            __builtin_amdgcn_fence(__ATOMIC_RELEASE, "agent");
            asm volatile("s_waitcnt vmcnt(0)" ::: "memory");
            const unsigned og = xb_add(&bar[XB_TOP], 1u);
            const unsigned tg = og / nx;
            if (og + 1u == (tg + 1u) * nx) xb_add(&bar[XB_TOPGEN], 1u);
            else XB_SPIN(xb_ld(&bar[XB_TOPGEN]) == tg, bar);
            __builtin_amdgcn_fence(__ATOMIC_ACQUIRE, "agent");
            xb_add(&bar[XB_XGEN(bx_)], 1u);
            asm volatile("s_waitcnt vmcnt(0)" ::: "memory");
        } else {
            XB_SPIN(xb_ld(&bar[XB_XGEN(bx_)]) == gen, bar);
            __builtin_amdgcn_fence(__ATOMIC_ACQUIRE, "agent");
            asm volatile("s_waitcnt vmcnt(0)" ::: "memory");
        }
    }
    __syncthreads();
}

namespace cfg {
constexpr int D = 1024, NB = 4, SEQ = 4096, CTXL = 256, TL = NB * SEQ, TC = NB * CTXL, T = TL + TC;
constexpr int NZ = 8960;
constexpr int ZU = 0, ZVA = 1024, ZQB = 2048, ZKB = 2560, ZVB = 3072, ZRB = 4096, ZCQ = 5120, ZKR = 5504, ZDEC = 5568, ZCKV = 5632, ZGT = 5888;
constexpr int NKEY = CTXL + SEQ;
constexpr int NEXP = 16, DEXP = 2048, CAPL = 512, CAPC = 32, ESLOTS = 2304;
constexpr float EPS = 1e-6f;
constexpr int NWAVES = 8, NTHR = 512;
constexpr size_t MiB = 1u << 20;
constexpr size_t WS_CTL = 0, CTL_BYTES = 1 * MiB;
constexpr size_t WS_MOD = 1 * MiB;
constexpr size_t WS_GATEV = WS_MOD + 512 * 1024;
constexpr size_t WS_AFFT = 2 * MiB;
constexpr size_t WS_SEL = 4 * MiB;
constexpr size_t WS_RSQ = 4 * MiB + 1536 * 1024;
constexpr size_t WS_XC = 6 * MiB;
constexpr size_t WS_H = 10 * MiB;
constexpr size_t WS_WT = 44 * MiB, WT_LAYER = 28 * MiB;
constexpr size_t WT_IN = 0, WT_UQ = 17 * MiB + 512 * 1024, WT_UKV = WT_UQ + 1152 * 1024, WT_M = WT_UKV + 1 * MiB, WT_OUT = WT_M + 6 * MiB, WT_S = WT_OUT + 2 * MiB;
static_assert(WT_S + 256 * 1024 <= WT_LAYER, "weights");
constexpr size_t WS_RA = 100 * MiB;
constexpr size_t RA_XS = 0, RA_HID = 72 * MiB, RA_YS = 216 * MiB;
constexpr size_t WS_RB = 398 * MiB;
constexpr size_t RB_YCAT = 0, RB_KVRAW = 102 * MiB, RB_MERGED = 102 * MiB, RB_QRAW = 170 * MiB, RB_KG = 221 * MiB, RB_VG = 272 * MiB, RB_QFL = 306 * MiB, RB_QFC = 354 * MiB,
                 RB_QDF = 306 * MiB, RB_KDT = 340 * MiB, RB_VTG = 374 * MiB, RB_DECAY = 408 * MiB, RB_OINTRA = 410 * MiB, RB_OF = 444 * MiB, RB_OB = 478 * MiB, RB_END = 512 * MiB;
constexpr size_t RB_WGU = 0, RB_WD = RB_END, RB_YSC = 200 * MiB;
constexpr int GU_SPLIT = 10;
constexpr size_t RB_WGU2 = RB_WD + 64 * MiB;
constexpr size_t WS_END = WS_RB + RB_WGU2 + (size_t)(NEXP - GU_SPLIT) * 8 * MiB;
static_assert(WS_END <= 1024 * MiB, "workspace");
constexpr int LDS_BYTES = 147456;
constexpr int LDS_MISC = 145408;
}
using namespace cfg;

enum { I_X = 0, I_C, I_CTX, I_CCTX, I_WMOD, I_BMOD, I_GMIX, I_GFFN, I_WIN, I_BGATE, I_WS, I_BS, I_WDEC, I_BDEC, I_GGLA, I_GCQ, I_GCKV, I_WUQ, I_WUKV,
       I_GQN, I_GQR, I_GKN, I_GKR, I_WPA, I_WPB, I_WPC, I_WOUT, I_WROUTER, I_WEG, I_WEU, I_WED, N_INPUTS };

struct Args { const float* in[N_INPUTS]; float* out; unsigned char* ws; int ph_lo, ph_hi; };

struct Ctx {
    const float* const* in; float* out; unsigned char* ws; LAS unsigned char* lds;
    int tid, lane, wave, G, bid;
};
__device__ __forceinline__ int row_modidx(int row) { return row < TL ? (row >> 12) : 4; }
__device__ __forceinline__ const float* modp(const Ctx& c, int l, int bi, int which) { return (const float*)(c.ws + WS_MOD) + ((size_t)(l * 5 + bi) * 6 + which) * D; }
__device__ __forceinline__ const float* xin_row(const Ctx& c, int l, int row) {
    if (row < TL) return (l == 0 ? c.in[I_X] : (const float*)c.out) + (size_t)row * D;
    return (l == 0 ? c.in[I_CTX] : (const float*)(c.ws + WS_XC)) + (size_t)(row - TL) * D;
}
__device__ __forceinline__ float* xout_row(const Ctx& c, int row) {
    if (row < TL) return c.out + (size_t)row * D;
    return (float*)(c.ws + WS_XC) + (size_t)(row - TL) * D;
}

#if defined(DEBUG_STAT)
__device__ __forceinline__ void dbg_max(const Ctx& c, int slot, float v) { v = fabsf(v); if (!(v < 1e30f)) v = 1e30f; atomicMax((unsigned*)(c.ws + WS_CTL + 512 * 1024) + 16 * slot, __float_as_uint(v)); }
#else
__device__ __forceinline__ void dbg_max(const Ctx&, int, float) {}
#endif
__device__ __forceinline__ void tconv_tile(const Ctx& c, const float* src, int ld_src, int k0, int c0, int nvalid, const float* kscale, bf16_t* dst, int ld_dst, int r0, int kd0) {
    LAS float* scr = (LAS float*)c.lds;
    const int tid = c.tid;
#pragma unroll
    for (int p = 0; p < 8; ++p) { const int k = p * 8 + (tid >> 6), n = tid & 63;
        float v = (n < nvalid) ? src[(size_t)(k0 + k) * ld_src + c0 + n] : 0.f; if (kscale) v *= kscale[k0 + k];
        scr[n * 65 + k] = v; }
    __syncthreads();
    { const int n = tid >> 3, kc = (tid & 7) * 8; const LAS float* s = scr + n * 65 + kc;
      u32x4 o; o.x = cvt_pk_bf16(s[0], s[1]); o.y = cvt_pk_bf16(s[2], s[3]); o.z = cvt_pk_bf16(s[4], s[5]); o.w = cvt_pk_bf16(s[6], s[7]);
      *(u32x4*)(dst + (size_t)(r0 + n) * ld_dst + kd0 + kc) = o; }
    __syncthreads();
}
template <int KQ>
__device__ __forceinline__ void tconv_kq(const Ctx& c, const float* src, int ld_src, int k0, int c0, int nvalid, const float* kscale, bf16_t* dst, int ld_dst, int r0, int kd0) {
    constexpr int LD = 64 * KQ + 1;
    LAS float* scr = (LAS float*)c.lds;
    const int tid = c.tid, n = tid & 63, kr = tid >> 6; float v[KQ][8];
    const bool ok = n < nvalid;
    const float* s0 = src + (size_t)(k0 + kr) * ld_src + c0 + n;
#pragma unroll
    for (int q = 0; q < KQ; ++q)
#pragma unroll
        for (int p = 0; p < 8; ++p) v[q][p] = ok ? s0[(size_t)(q * 64 + p * 8) * ld_src] : 0.f;
    if (kscale) {
#pragma unroll
        for (int q = 0; q < KQ; ++q)
#pragma unroll
            for (int p = 0; p < 8; ++p) v[q][p] *= kscale[k0 + q * 64 + p * 8 + kr]; }
#pragma unroll
    for (int q = 0; q < KQ; ++q)
#pragma unroll
        for (int p = 0; p < 8; ++p) scr[n * LD + q * 64 + p * 8 + kr] = v[q][p];
    __syncthreads();
    { const int nn = tid >> 3, kc = (tid & 7) * 8;
#pragma unroll
      for (int q = 0; q < KQ; ++q) { const LAS float* s = scr + nn * LD + q * 64 + kc;
          u32x4 o; o.x = cvt_pk_bf16(s[0], s[1]); o.y = cvt_pk_bf16(s[2], s[3]); o.z = cvt_pk_bf16(s[4], s[5]); o.w = cvt_pk_bf16(s[6], s[7]);
          *(u32x4*)(dst + (size_t)(r0 + nn) * ld_dst + kd0 + q * 64 + kc) = o; } }
    __syncthreads();
}
template <class RowMap>
__device__ __forceinline__ void tconv_tile4(const Ctx& c, const float* src, int ld_src, int k0, int n0, bf16_t* dst, int ld_dst, int kd0, const RowMap& rowmap) {
    LAS float* scr = (LAS float*)c.lds;
    const int tid = c.tid; float v[4][8];
#pragma unroll
    for (int q = 0; q < 4; ++q)
#pragma unroll
        for (int p = 0; p < 8; ++p) { const int k = p * 8 + (tid >> 6), n = tid & 63; v[q][p] = src[(size_t)(k0 + k) * ld_src + n0 + q * 64 + n]; }
#pragma unroll
    for (int q = 0; q < 4; ++q)
#pragma unroll
        for (int p = 0; p < 8; ++p) { const int k = p * 8 + (tid >> 6), n = tid & 63; scr[(q * 64 + n) * 65 + k] = v[q][p]; }
    __syncthreads();
#pragma unroll
    for (int q = 0; q < 4; ++q) { const int n = tid >> 3, kc = (tid & 7) * 8; const LAS float* s = scr + (q * 64 + n) * 65 + kc;
      u32x4 o; o.x = cvt_pk_bf16(s[0], s[1]); o.y = cvt_pk_bf16(s[2], s[3]); o.z = cvt_pk_bf16(s[4], s[5]); o.w = cvt_pk_bf16(s[6], s[7]);
      *(u32x4*)(dst + (size_t)rowmap(n0 + q * 64 + n) * ld_dst + kd0 + kc) = o; }
    __syncthreads();
}
__device__ __forceinline__ void win_map(int r0, int& src, int& nvalid) {
    nvalid = 64;
    if (r0 < 5120) src = r0; else if (r0 < 5504) src = 5152 + (r0 - 5120); else if (r0 == 5504) src = 5792;
    else if (r0 == 5568) { src = 5120; nvalid = 32; } else if (r0 < 5888) src = 5536 + (r0 - 5632); else src = 5856 + (r0 - 5888);
}
__device__ __forceinline__ void phase_pre_a(const Ctx& c) {
    constexpr int U_IN = 140 * 4, U_UQ = 24 * 2, U_UKV = 32, U_M = 3 * 16 * 4, U_OUT = 16 * 4, U_S = 32, U_LAYER = U_IN + U_UQ + U_UKV + U_M + U_OUT + U_S, U_MOD = 192;
    for (int u = c.bid; u < 2 * U_LAYER + U_MOD; u += c.G) {
        if (u < U_MOD) {
            const int cb = u, l = cb / 96, n = (cb % 96) * 64 + c.lane;
            LAS float* sl = (LAS float*)c.lds;
            LAS float* red = (LAS float*)(c.lds + 20480);
            for (int i = c.tid; i < 5 * D; i += NTHR) { const int vi = i >> 10, k = i & (D - 1); sl[i] = siluf_(vi < 4 ? c.in[I_C][vi * D + k] : c.in[I_CCTX][k]); }
            __syncthreads();
            const float* wp = c.in[I_WMOD] + (size_t)l * D * 6144 + (size_t)(c.wave * 128) * 6144 + n; const LAS float* sw = sl + c.wave * 128;
            float a[5] = {0.f, 0.f, 0.f, 0.f, 0.f};
#pragma unroll 1
            for (int kk = 0; kk < 128; kk += 16) { float w[16];
#pragma unroll
                for (int j = 0; j < 16; ++j) w[j] = wp[(size_t)(kk + j) * 6144];
#pragma unroll
                for (int j = 0; j < 16; ++j)
#pragma unroll
                    for (int i = 0; i < 5; ++i) a[i] += sw[i * D + kk + j] * w[j]; }
#pragma unroll
            for (int i = 0; i < 5; ++i) red[(c.wave * 5 + i) * 64 + c.lane] = a[i];
            __syncthreads();
            if (c.tid < 320) { const int i = c.tid >> 6, ln = c.tid & 63; float s = 0.f;
#pragma unroll
                for (int w = 0; w < 8; ++w) s += red[(w * 5 + i) * 64 + ln];
                const int nn = (cb % 96) * 64 + ln;
                ((float*)(c.ws + WS_MOD))[(size_t)(l * 5 + i) * 6144 + nn] = s + c.in[I_BMOD][l * 6144 + nn]; }
            __syncthreads();
            continue;
        }
        const int v = u - U_MOD, l = v / U_LAYER; int r = v % U_LAYER; unsigned char* wt = c.ws + WS_WT + (size_t)l * WT_LAYER;
        if (r < U_IN) { const int nb = r >> 2, kq = r & 3; int src, nv; win_map(nb * 64, src, nv);
            tconv_kq<4>(c, c.in[I_WIN] + (size_t)l * D * 8928, 8928, kq * 256, src, nv, nullptr, (bf16_t*)(wt + WT_IN), D, nb * 64, kq * 256); continue; } r -= U_IN;
        if (r < U_UQ) { const int nb = r >> 1, kh = r & 1;
            tconv_kq<3>(c, c.in[I_WUQ] + (size_t)l * 384 * 1536, 1536, kh * 192, nb * 64, 64, c.in[I_GCQ] + l * 384, (bf16_t*)(wt + WT_UQ), 384, nb * 64, kh * 192); continue; } r -= U_UQ;
        if (r < U_UKV) { const int nb = r;
            tconv_kq<4>(c, c.in[I_WUKV] + (size_t)l * 256 * 2048, 2048, 0, nb * 64, 64, c.in[I_GCKV] + l * 256, (bf16_t*)(wt + WT_UKV), 256, nb * 64, 0); continue; } r -= U_UKV;
        if (r < U_M) { const int which = r >> 6, rr = r & 63, nb = rr >> 2, kq = rr & 3;
            const float* src = c.in[which == 0 ? I_WPA : (which == 1 ? I_WPB : I_WPC)] + (size_t)l * D * D;
            tconv_kq<4>(c, src, D, kq * 256, nb * 64, 64, nullptr, (bf16_t*)(wt + WT_M), 3 * D, nb * 64, which * D + kq * 256); continue; } r -= U_M;
        if (r < U_OUT) { const int nb = r >> 2, kq = r & 3;
            tconv_kq<4>(c, c.in[I_WOUT] + (size_t)l * D * D, D, kq * 256, nb * 64, 64, nullptr, (bf16_t*)(wt + WT_OUT), D, nb * 64, kq * 256); continue; } r -= U_OUT;
        { const float* s = c.in[I_WS] + (size_t)l * 131072 + (size_t)r * 4096 + c.tid * 8; bf16_t* d = (bf16_t*)(wt + WT_S) + (size_t)r * 4096 + c.tid * 8;
          const f32x4 a = *(const f32x4*)s, b = *(const f32x4*)(s + 4); u32x4 o; o.x = cvt_pk_bf16(a[0], a[1]); o.y = cvt_pk_bf16(a[2], a[3]); o.z = cvt_pk_bf16(b[0], b[1]); o.w = cvt_pk_bf16(b[2], b[3]);
          *(u32x4*)d = o; }
    }
}
__device__ __forceinline__ void modulate_row(const float* xrow, const float* g, const float* shift, const float* scale, bf16_t* hrow, int lane, f32x4 (&hv)[4]) {
    float ss = 0.f;
#pragma unroll
    for (int j = 0; j < 4; ++j) { hv[j] = *(const f32x4*)(xrow + 4 * lane + 256 * j); ss += (hv[j][0] * hv[j][0] + hv[j][1] * hv[j][1]) + (hv[j][2] * hv[j][2] + hv[j][3] * hv[j][3]); }
    const float rstd = 1.0f / sqrtf(wave_sum(ss) * (1.f / D) + EPS);
#pragma unroll
    for (int j = 0; j < 4; ++j) { const int cc = 4 * lane + 256 * j; const f32x4 gv = *(const f32x4*)(g + cc), sc = *(const f32x4*)(scale + cc), sh = *(const f32x4*)(shift + cc);
        hv[j] = hv[j] * rstd * gv * (sc + 1.0f) + sh;
        u32x2 o; o.x = cvt_pk_bf16(hv[j][0], hv[j][1]); o.y = cvt_pk_bf16(hv[j][2], hv[j][3]); *(u32x2*)(hrow + cc) = o; }
}
__device__ __forceinline__ void phase_modulate_mix(const Ctx& c, int l) {
    const int gw = c.bid * NWAVES + c.wave, NGW = c.G * NWAVES;
    for (int row = gw; row < T; row += NGW) { const int bi = row_modidx(row); f32x4 hv[4];
        modulate_row(xin_row(c, l, row), c.in[I_GMIX] + l * D, modp(c, l, bi, 0), modp(c, l, bi, 1), (bf16_t*)(c.ws + WS_H) + (size_t)row * D, c.lane, hv); }
}
struct EpiZ { static constexpr bool PERM = true, MID = false; bf16_t* Z; const float* bgate;
    __device__ __forceinline__ void operator()(const f32x4 (&acc)[2][2][4][2], const pg8::Unit& u, int wr, int wc, int fr, int fq) const {
        int row0 = u.pm * 256 + wr * 64 + fr; asm volatile("" : "+v"(row0)); const int col0 = u.pn * 256 + wc * 32 + 8 * fq;
        const int mode = (u.pn >= 23) ? 3 : ((u.pn >= 16 && u.pn < 20) ? 2 : ((u.pn == 8 || u.pn == 9) ? 1 : 0));
        const int gcol = (mode == 3) ? (col0 - ZGT) : 0; const float bm = (mode == 3) ? 1.f : 0.f;
        f32x4 bv[2][2];
#pragma unroll
        for (int bj = 0; bj < 2; ++bj)
#pragma unroll
            for (int n = 0; n < 2; ++n) bv[bj][n] = *(const f32x4*)(bgate + (gcol + bj * 128 + 4 * n)) * bm;
#pragma unroll
        for (int ai = 0; ai < 2; ++ai)
#pragma unroll
            for (int m = 0; m < 4; ++m) { bf16_t* rowp = Z + (size_t)(row0 + ai * 128 + m * 16) * NZ + col0;
#pragma unroll
                for (int bj = 0; bj < 2; ++bj) { f32x4 v0 = acc[ai][bj][m][0] + bv[bj][0], v1 = acc[ai][bj][m][1] + bv[bj][1];
                    if (mode == 1) { v0 = v0 * 0.08838834764831845f; v1 = v1 * 0.08838834764831845f; }
                    else if (mode == 2) {
#pragma unroll
                        for (int e = 0; e < 4; ++e) { v0[e] = siluf_(v0[e]); v1[e] = siluf_(v1[e]); } }
                    else if (mode == 3) {
#pragma unroll
                        for (int e = 0; e < 4; ++e) { v0[e] = fmaxf(sigmoidf_(v0[e]), 1e-20f); v1[e] = fmaxf(sigmoidf_(v1[e]), 1e-20f); } }
                    u32x4 w; w.x = cvt_pk_bf16(v0[0], v0[1]); w.y = cvt_pk_bf16(v0[2], v0[3]); w.z = cvt_pk_bf16(v1[0], v1[1]); w.w = cvt_pk_bf16(v1[2], v1[3]);
                    *(u32x4*)(rowp + bj * 128) = w; } }
    }
};
struct EpiPlain { static constexpr bool PERM = true, MID = false; bf16_t* O; int ldc;
    __device__ __forceinline__ void operator()(const f32x4 (&acc)[2][2][4][2], const pg8::Unit& u, int wr, int wc, int fr, int fq) const {
        int row0 = u.pm * 256 + wr * 64 + fr; asm volatile("" : "+v"(row0)); const int col0 = u.pn * 256 + wc * 32 + 8 * fq;
#pragma unroll
        for (int ai = 0; ai < 2; ++ai)
#pragma unroll
            for (int m = 0; m < 4; ++m) { bf16_t* rowp = O + (size_t)(row0 + ai * 128 + m * 16) * ldc + col0;
#pragma unroll
                for (int bj = 0; bj < 2; ++bj) { const f32x4 v0 = acc[ai][bj][m][0], v1 = acc[ai][bj][m][1];
                    u32x4 w; w.x = cvt_pk_bf16(v0[0], v0[1]); w.y = cvt_pk_bf16(v0[2], v0[3]); w.z = cvt_pk_bf16(v1[0], v1[1]); w.w = cvt_pk_bf16(v1[2], v1[3]);
                    *(u32x4*)(rowp + bj * 128) = w; } }
    }
};
struct EpiMerge { static constexpr bool PERM = true, MID = true; bf16_t* O; const bf16_t* Z;
    __device__ __forceinline__ void ld8(const bf16_t* p, float (&g)[8]) const { const u32x4 w = *(const u32x4*)p; g[0] = bflo(w.x); g[1] = bfhi(w.x); g[2] = bflo(w.y); g[3] = bfhi(w.y); g[4] = bflo(w.z); g[5] = bfhi(w.z); g[6] = bflo(w.w); g[7] = bfhi(w.w); }
    __device__ __forceinline__ void mid(f32x4 (&acc)[2][2][4][2], const pg8::Unit& u, int t, int wr, int wc, int fr, int fq) const {
        int row0 = u.pm * 256 + wr * 64 + fr; asm volatile("" : "+v"(row0)); const int col0 = u.pn * 256 + wc * 32 + 8 * fq; const int seg = (t == 16) ? 0 : 1;
#pragma unroll
        for (int ai = 0; ai < 2; ++ai)
#pragma unroll
            for (int m = 0; m < 4; ++m) { const bf16_t* gp = Z + (size_t)(row0 + ai * 128 + m * 16) * NZ + ZGT + seg * D + col0;
#pragma unroll
                for (int bj = 0; bj < 2; ++bj) { float ga[8], gb[8]; ld8(gp + bj * 128, ga); ld8(gp + D + bj * 128, gb);
#pragma unroll
                    for (int e = 0; e < 4; ++e) { acc[ai][bj][m][0][e] *= ga[e] * fast_rcp(gb[e]); acc[ai][bj][m][1][e] *= ga[4 + e] * fast_rcp(gb[4 + e]); } }
                __builtin_amdgcn_sched_barrier(0); }
    }
    __device__ __forceinline__ void operator()(const f32x4 (&acc)[2][2][4][2], const pg8::Unit& u, int wr, int wc, int fr, int fq) const {
        int row0 = u.pm * 256 + wr * 64 + fr; asm volatile("" : "+v"(row0)); const int col0 = u.pn * 256 + wc * 32 + 8 * fq;
#pragma unroll
        for (int ai = 0; ai < 2; ++ai)
#pragma unroll
            for (int m = 0; m < 4; ++m) { const size_t r = (size_t)(row0 + ai * 128 + m * 16); const bf16_t* gp = Z + r * NZ + ZGT + 2 * D + col0; bf16_t* rowp = O + r * D + col0;
#pragma unroll
                for (int bj = 0; bj < 2; ++bj) { float gc[8]; ld8(gp + bj * 128, gc); const f32x4 v0 = acc[ai][bj][m][0], v1 = acc[ai][bj][m][1];
                    u32x4 w; w.x = cvt_pk_bf16(v0[0] * gc[0], v0[1] * gc[1]); w.y = cvt_pk_bf16(v0[2] * gc[2], v0[3] * gc[3]); w.z = cvt_pk_bf16(v1[0] * gc[4], v1[1] * gc[5]); w.w = cvt_pk_bf16(v1[2] * gc[6], v1[3] * gc[7]);
                    *(u32x4*)(rowp + bj * 128) = w; }
                __builtin_amdgcn_sched_barrier(0); }
    }
};
struct EpiResid { static constexpr bool PERM = false, MID = false; const Ctx* c; int l; float* dummy;
    __device__ __forceinline__ void operator()(const f32x4 (&acc)[2][2][4][2], const pg8::Unit& u, int wr, int wc, int fr, int fq) const {
        int row0 = u.pm * 256 + wr * 64 + fr; asm volatile("" : "+v"(row0)); const int col0 = u.pn * 256 + wc * 32 + 4 * fq; const float* gate = modp(*c, l, row_modidx(u.pm * 256), 2);
        f32x4 gv[2][2];
#pragma unroll
        for (int bj = 0; bj < 2; ++bj)
#pragma unroll
            for (int n = 0; n < 2; ++n) gv[bj][n] = *(const f32x4*)(gate + col0 + bj * 128 + 16 * n);
#pragma unroll
        for (int ai = 0; ai < 2; ++ai)
#pragma unroll
            for (int m = 0; m < 4; ++m) { const int row = row0 + ai * 128 + m * 16; const float* xi = xin_row(*c, l, row) + col0; float* xo = (dummy ? dummy + (size_t)row * D : xout_row(*c, row)) + col0;
#pragma unroll
                for (int bj = 0; bj < 2; ++bj)
#pragma unroll
                    for (int n = 0; n < 2; ++n) { const f32x4 xv = *(const f32x4*)(xi + bj * 128 + 16 * n); *(f32x4*)(xo + bj * 128 + 16 * n) = xv + gv[bj][n] * acc[ai][bj][m][n]; } }
    }
};
struct EpiSwiGLU { static constexpr bool PERM = true, MID = false; bf16_t* HID;
    __device__ __forceinline__ void operator()(const f32x4 (&acc)[2][2][4][2], const pg8::Unit& u, int wr, int wc, int fr, int fq) const {
        int row0 = u.pm * 256 + wr * 64 + fr; asm volatile("" : "+v"(row0)); const int col0 = u.pn * 128 + wc * 32 + 8 * fq; bf16_t* base = HID + (size_t)u.g * ESLOTS * DEXP;
#pragma unroll
        for (int ai = 0; ai < 2; ++ai)
#pragma unroll
            for (int m = 0; m < 4; ++m) { float h[8];
#pragma unroll
                for (int n = 0; n < 2; ++n)
#pragma unroll
                    for (int e = 0; e < 4; ++e) h[4 * n + e] = siluf_(acc[ai][0][m][n][e]) * acc[ai][1][m][n][e];
                u32x4 w; w.x = cvt_pk_bf16(h[0], h[1]); w.y = cvt_pk_bf16(h[2], h[3]); w.z = cvt_pk_bf16(h[4], h[5]); w.w = cvt_pk_bf16(h[6], h[7]);
                *(u32x4*)(base + (size_t)(row0 + ai * 128 + m * 16) * DEXP + col0) = w; }
    }
};
struct EpiDown { static constexpr bool PERM = true, MID = false; bf16_t* YS; const float* gatev;
    __device__ __forceinline__ void operator()(const f32x4 (&acc)[2][2][4][2], const pg8::Unit& u, int wr, int wc, int fr, int fq) const {
        int row0 = u.pm * 256 + wr * 64 + fr; asm volatile("" : "+v"(row0)); const int col0 = u.pn * 256 + wc * 32 + 8 * fq; bf16_t* base = YS + (size_t)u.g * ESLOTS * D; const float* gp = gatev + u.g * ESLOTS;
#pragma unroll
        for (int ai = 0; ai < 2; ++ai)
#pragma unroll
            for (int m = 0; m < 4; ++m) { const int row = row0 + ai * 128 + m * 16; const float gs = gp[row]; bf16_t* rowp = base + (size_t)row * D + col0;
#pragma unroll
                for (int bj = 0; bj < 2; ++bj) { const f32x4 v0 = acc[ai][bj][m][0] * gs, v1 = acc[ai][bj][m][1] * gs;
                    u32x4 w; w.x = cvt_pk_bf16(v0[0], v0[1]); w.y = cvt_pk_bf16(v0[2], v0[3]); w.z = cvt_pk_bf16(v1[0], v1[1]); w.w = cvt_pk_bf16(v1[2], v1[3]);
                    *(u32x4*)(rowp + bj * 128) = w; } }
    }
};

struct EpiDownPart { static constexpr bool PERM = true, MID = false; bf16_t* YSC; const float* gatev;
    __device__ __forceinline__ void operator()(const f32x4 (&acc)[2][2][4][2], const pg8::Unit& u, int wr, int wc, int fr, int fq) const {
        int r0 = wr * 64 + fr; asm volatile("" : "+v"(r0)); const int col0 = u.pn * 256 + wc * 32 + 8 * fq;
        bf16_t* base = YSC + ((size_t)((u.ko >> 9) * NEXP + u.g) * 128) * D; const float* gp = gatev + u.g * ESLOTS + 2048;
#pragma unroll
        for (int m = 0; m < 4; ++m) { const int r = r0 + m * 16; const float gs = gp[r]; bf16_t* rowp = base + (size_t)r * D + col0;
#pragma unroll
            for (int bj = 0; bj < 2; ++bj) { const f32x4 v0 = acc[0][bj][m][0] * gs, v1 = acc[0][bj][m][1] * gs;
                u32x4 w; w.x = cvt_pk_bf16(v0[0], v0[1]); w.y = cvt_pk_bf16(v0[2], v0[3]); w.z = cvt_pk_bf16(v1[0], v1[1]); w.w = cvt_pk_bf16(v1[2], v1[3]);
                *(u32x4*)(rowp + bj * 128) = w; } }
    }
};

__device__ __forceinline__ void sg_accum(const bf16_t* A, int lda, const bf16_t* Bt, int ldb, int K, int lane, f32x4 (&acc)[2]) {
    const int lr = lane & 15, lq = lane >> 4; const bf16_t* ap = A + (size_t)lr * lda + 8 * lq; const bf16_t* bp0 = Bt + (size_t)lr * ldb + 8 * lq; const bf16_t* bp1 = bp0 + (size_t)16 * ldb;
    bf16x8 a[2][4], b0[2][4], b1[2][4];
#pragma unroll
    for (int i = 0; i < 4; ++i) { a[0][i] = *(const bf16x8*)(ap + 32 * i); b0[0][i] = *(const bf16x8*)(bp0 + 32 * i); b1[0][i] = *(const bf16x8*)(bp1 + 32 * i); }
#pragma unroll 1
    for (int k = 0; k < K; k += 256) {
#pragma unroll
        for (int i = 0; i < 4; ++i) { a[1][i] = *(const bf16x8*)(ap + k + 128 + 32 * i); b0[1][i] = *(const bf16x8*)(bp0 + k + 128 + 32 * i); b1[1][i] = *(const bf16x8*)(bp1 + k + 128 + 32 * i); }
#pragma unroll
        for (int i = 0; i < 4; ++i) { acc[0] = __builtin_amdgcn_mfma_f32_16x16x32_bf16(a[0][i], b0[0][i], acc[0], 0, 0, 0); acc[1] = __builtin_amdgcn_mfma_f32_16x16x32_bf16(a[0][i], b1[0][i], acc[1], 0, 0, 0); }
        if (k + 256 < K) {
#pragma unroll
            for (int i = 0; i < 4; ++i) { a[0][i] = *(const bf16x8*)(ap + k + 256 + 32 * i); b0[0][i] = *(const bf16x8*)(bp0 + k + 256 + 32 * i); b1[0][i] = *(const bf16x8*)(bp1 + k + 256 + 32 * i); } }
#pragma unroll
        for (int i = 0; i < 4; ++i) { acc[0] = __builtin_amdgcn_mfma_f32_16x16x32_bf16(a[1][i], b0[1][i], acc[0], 0, 0, 0); acc[1] = __builtin_amdgcn_mfma_f32_16x16x32_bf16(a[1][i], b1[1][i], acc[1], 0, 0, 0); }
    }
}
__device__ __forceinline__ void ctx_merge_unit(const Ctx& c, int l, int u) {
    const int lane = c.lane, w = c.wave, lr = lane & 15, lq = lane >> 4, tid = c.tid; const int row0 = TL + 64 * (u >> 4), col0 = 64 * (u & 15); const int rh = w & 1, kw = w >> 1;
    const char* yb = (const char*)(c.ws + WS_RB + RB_YCAT) + ((size_t)(row0 + 32 * rh) * 3072 + 256 * kw) * 2;
    const char* wb = (const char*)(c.ws + WS_WT + (size_t)l * WT_LAYER + WT_M) + ((size_t)col0 * 3072 + 256 * kw) * 2;
    const __amdgpu_buffer_rsrc_t ra = __builtin_amdgcn_make_buffer_rsrc((void*)yb, 0, 1 << 30, 0x00020000), rb = __builtin_amdgcn_make_buffer_rsrc((void*)wb, 0, 1 << 30, 0x00020000);
    const int voff = (lr * 3072 + 8 * lq) * 2;
    LAS float* part = (LAS float*)c.lds;
    const int T = tid >> 5, lp = 2 * (tid & 31), RT = T >> 2, CT = T & 3; const int orow = row0 + 16 * RT + 4 * (lp >> 4), ocol = col0 + 16 * CT + (lp & 15);
    const bf16_t* Zg = (const bf16_t*)(c.ws + WS_RA) + ZGT + (size_t)orow * NZ + ocol;
    float out[8] = {0.f, 0.f, 0.f, 0.f, 0.f, 0.f, 0.f, 0.f};
    bf16x8 a[2][2][2], b[2][2][4];
#define CM_LOAD(slot, P) do { const int o_ = ((P) >> 2) * (D * 2) + ((P) & 3) * 128; \
        _Pragma("unroll") for (int t_ = 0; t_ < 2; ++t_) _Pragma("unroll") for (int h_ = 0; h_ < 2; ++h_) a[slot][h_][t_] = __builtin_bit_cast(bf16x8, __builtin_amdgcn_raw_buffer_load_b128(ra, voff, t_ * (16 * 3072 * 2) + o_ + h_ * 64, 0)); \
        _Pragma("unroll") for (int t_ = 0; t_ < 4; ++t_) _Pragma("unroll") for (int h_ = 0; h_ < 2; ++h_) b[slot][h_][t_] = __builtin_bit_cast(bf16x8, __builtin_amdgcn_raw_buffer_load_b128(rb, voff, t_ * (16 * 3072 * 2) + o_ + h_ * 64, 0)); } while (0)
#define CM_MMA(slot) do { _Pragma("unroll") for (int h_ = 0; h_ < 2; ++h_) _Pragma("unroll") for (int rt_ = 0; rt_ < 2; ++rt_) _Pragma("unroll") for (int ct_ = 0; ct_ < 4; ++ct_) \
        acc[rt_][ct_] = __builtin_amdgcn_mfma_f32_16x16x32_bf16(a[slot][h_][rt_], b[slot][h_][ct_], acc[rt_][ct_], 0, 0, 0); } while (0)
    CM_LOAD(0, 0); __builtin_amdgcn_sched_barrier(0);
#pragma unroll 1
    for (int seg = 0; seg < 3; ++seg) { f32x4 acc[2][4];
#pragma unroll
        for (int rt = 0; rt < 2; ++rt)
#pragma unroll
            for (int ct = 0; ct < 4; ++ct) acc[rt][ct] = (f32x4){0.f, 0.f, 0.f, 0.f};
#pragma unroll
        for (int jp = 0; jp < 4; ++jp) { const int P = seg * 4 + jp; __builtin_amdgcn_sched_barrier(0); if (P + 1 < 12) CM_LOAD((jp + 1) & 1, P + 1); __builtin_amdgcn_sched_barrier(0); CM_MMA(jp & 1); __builtin_amdgcn_sched_barrier(0); }
        unsigned gz[4];
#pragma unroll
        for (int e = 0; e < 4; ++e) gz[e] = *(const unsigned*)(Zg + (size_t)e * NZ + seg * D);
        { LAS float* wp = part + (size_t)(w * 8 * 64 + lane) * 4;
#pragma unroll
          for (int rt = 0; rt < 2; ++rt)
#pragma unroll
            for (int ct = 0; ct < 4; ++ct) *(LAS f32x4*)(wp + (rt * 4 + ct) * 256) = acc[rt][ct]; }
        __syncthreads();
        float s[8] = {0.f, 0.f, 0.f, 0.f, 0.f, 0.f, 0.f, 0.f};
        { const LAS float* pl = part + (size_t)((((RT >> 1) * 8 + (RT & 1) * 4 + CT) * 64) + lp) * 4;
#pragma unroll
          for (int p = 0; p < 4; ++p) { const f32x4 v0 = *(const LAS f32x4*)(pl + p * 4096), v1 = *(const LAS f32x4*)(pl + p * 4096 + 4);
#pragma unroll
              for (int e = 0; e < 4; ++e) { s[e] += v0[e]; s[4 + e] += v1[e]; } } }
#pragma unroll
        for (int e = 0; e < 4; ++e) { out[e] += s[e] * bflo(gz[e]); out[4 + e] += s[4 + e] * bfhi(gz[e]); }
        __syncthreads();
    }
#undef CM_LOAD
#undef CM_MMA
    bf16_t* O = (bf16_t*)(c.ws + WS_RB + RB_MERGED) + (size_t)orow * D + ocol;
#pragma unroll
    for (int e = 0; e < 4; ++e) *(unsigned*)(O + (size_t)e * D) = cvt_pk_bf16(out[e], out[4 + e]);
}
__device__ __forceinline__ void ctx_out_unit(const Ctx& c, int l, int u) {
    const int lane = c.lane, w = c.wave, lr = lane & 15, lq = lane >> 4; const int row0 = TL + 64 * (u >> 4) + 16 * (w >> 1), col0 = 64 * (u & 15) + 32 * (w & 1);
    const bf16_t* A = (const bf16_t*)(c.ws + WS_RB + RB_MERGED) + (size_t)row0 * D; const bf16_t* WO = (const bf16_t*)(c.ws + WS_WT + (size_t)l * WT_LAYER + WT_OUT) + (size_t)col0 * D;
    f32x4 acc[2] = {{0.f, 0.f, 0.f, 0.f}, {0.f, 0.f, 0.f, 0.f}};
    sg_accum(A, D, WO, D, D, lane, acc);
    const float* gate = modp(c, l, 4, 2);
#pragma unroll
    for (int t = 0; t < 2; ++t)
#pragma unroll
        for (int e = 0; e < 4; ++e) { const int row = row0 + 4 * lq + e, col = col0 + 16 * t + lr; xout_row(c, row)[col] = xin_row(c, l, row)[col] + gate[col] * acc[t][e]; }
}
__device__ __forceinline__ void mixA_unit(const Ctx& c, int l, int un) {
    const int cn = un >> 3, g = un & 7; const int row0 = cn * 128;
    const bf16_t* Z = (const bf16_t*)(c.ws + WS_RA); bf16_t* Y = (bf16_t*)(c.ws + WS_RB + RB_YCAT);
    const bf16_t* WSb = (const bf16_t*)(c.ws + WS_WT + (size_t)l * WT_LAYER + WT_S) + g * 16384;
    LAS bf16_t* VT = (LAS bf16_t*)c.lds;
    { const int s = c.tid >> 2, qd = c.tid & 3; const bf16_t* p = Z + (size_t)(row0 + s) * NZ + ZVA + g * 128 + qd * 32;
      float v[32];
#pragma unroll
      for (int i = 0; i < 4; ++i) { const u32x4 w = *(const u32x4*)(p + 8 * i); v[8 * i] = bflo(w.x); v[8 * i + 1] = bfhi(w.x); v[8 * i + 2] = bflo(w.y); v[8 * i + 3] = bfhi(w.y); v[8 * i + 4] = bflo(w.z); v[8 * i + 5] = bfhi(w.z); v[8 * i + 6] = bflo(w.w); v[8 * i + 7] = bfhi(w.w); }
      float sm = 0.f;
#pragma unroll
      for (int i = 0; i < 32; ++i) sm += v[i];
      sm += sx<1>(sm); sm += sx<2>(sm); const float mu = sm * (1.f / 128.f); float sq = 0.f;
#pragma unroll
      for (int i = 0; i < 32; ++i) { v[i] -= mu; sq += v[i] * v[i]; }
      sq += sx<1>(sq); sq += sx<2>(sq); const float rstd = 1.0f / sqrtf(sq * (1.f / 128.f) + EPS);
#pragma unroll
      for (int i = 0; i < 32; ++i) VT[(qd * 32 + i) * 136 + s] = f2bf(v[i] * rstd); }
    __syncthreads();
    const int w = c.wave, lr = c.lane & 15, lq = c.lane >> 4;
    bf16x8 bw[4];
#pragma unroll
    for (int ks = 0; ks < 4; ++ks) bw[ks] = *(const bf16x8*)(WSb + (16 * w + lr) * 128 + 32 * ks + 8 * lq);
    const int t = row0 + 16 * w + lr; const float bs = c.in[I_BS][(l * 8 + g) * 128 + 16 * w + lr];
#pragma unroll
    for (int ct = 0; ct < 8; ++ct) { f32x4 acc = {0.f, 0.f, 0.f, 0.f};
#pragma unroll
        for (int ks = 0; ks < 4; ++ks) { const bf16x8 a = *(const LAS bf16x8*)(VT + (16 * ct + lr) * 136 + 32 * ks + 8 * lq); acc = __builtin_amdgcn_mfma_f32_16x16x32_bf16(a, bw[ks], acc, 0, 0, 0); }
        const int cc = g * 128 + 16 * ct + 4 * lq; const u32x2 uw = *(const u32x2*)(Z + (size_t)t * NZ + ZU + cc);
        u32x2 o; o.x = cvt_pk_bf16(bflo(uw.x) * (acc[0] + bs), bfhi(uw.x) * (acc[1] + bs)); o.y = cvt_pk_bf16(bflo(uw.y) * (acc[2] + bs), bfhi(uw.y) * (acc[3] + bs));
        *(u32x2*)(Y + (size_t)t * 3072 + cc) = o; }
    __syncthreads();
}
__device__ __forceinline__ void gla_b1_unit(const Ctx& c, int l, int un) {
    const int n = un >> 2, h = un & 3, row0 = n * 64, tid = c.tid, lane = c.lane, w = c.wave, lr = lane & 15, lq = lane >> 4;
    const bf16_t* Z = (const bf16_t*)(c.ws + WS_RA);
    LAS bf16_t* VTs = (LAS bf16_t*)c.lds;
    LAS float* Ds = (LAS float*)(c.lds + 36864);
    LAS float* La = (LAS float*)(c.lds + 45056);
    LAS float* Tot = (LAS float*)(c.lds + 78080);
    LAS bf16_t* QD = (LAS bf16_t*)(c.lds + 80128);
    LAS bf16_t* KI = (LAS bf16_t*)(c.lds + 97536);
    LAS bf16_t* Ps = (LAS bf16_t*)(c.lds + 114944);
    LAS bf16_t* KdT = (LAS bf16_t*)(c.lds + 124160);
    { const int t = tid >> 3, cb = (tid & 7) * 32; const bf16_t* p = Z + (size_t)(row0 + t) * NZ + ZVB + h * 256 + cb;
#pragma unroll
      for (int i = 0; i < 4; ++i) { const u32x4 wv = *(const u32x4*)(p + 8 * i); LAS bf16_t* d = VTs + (cb + 8 * i) * 72 + t;
        d[0] = (bf16_t)wv.x; d[72] = (bf16_t)(wv.x >> 16); d[144] = (bf16_t)wv.y; d[216] = (bf16_t)(wv.y >> 16); d[288] = (bf16_t)wv.z; d[360] = (bf16_t)(wv.z >> 16); d[432] = (bf16_t)wv.w; d[504] = (bf16_t)(wv.w >> 16); }
      const int dt = tid >> 3, dc = (tid & 7) * 4; const u32x2 dv = *(const u32x2*)(Z + (size_t)(row0 + dt) * NZ + ZDEC + dc);
      Ds[dt * 32 + dc] = bflo(dv.x); Ds[dt * 32 + dc + 1] = bfhi(dv.x); Ds[dt * 32 + dc + 2] = bflo(dv.y); Ds[dt * 32 + dc + 3] = bfhi(dv.y); }
    __syncthreads();
    f32x4 pacc[2] = {{0.f, 0.f, 0.f, 0.f}, {0.f, 0.f, 0.f, 0.f}};
#pragma unroll 1
    for (int dir = 0; dir < 2; ++dir) {
        { const int cch = 16 * w + lr;
          bf16x8 bfr = {0, 0, 0, 0, 0, 0, 0, 0};
          if (lq < 2) { const float* wd = c.in[I_WDEC] + (size_t)(l * 2 + dir) * 16 * 512 + (size_t)(8 * lq) * 512 + h * 128 + cch; u32x4 pk;
              pk.x = cvt_pk_bf16(wd[0], wd[512]); pk.y = cvt_pk_bf16(wd[1024], wd[1536]); pk.z = cvt_pk_bf16(wd[2048], wd[2560]); pk.w = cvt_pk_bf16(wd[3072], wd[3584]); bfr = __builtin_bit_cast(bf16x8, pk); }
          const float bias = c.in[I_BDEC][(l * 2 + dir) * 512 + h * 128 + cch];
          f32x4 la[4];
#pragma unroll
          for (int tt = 0; tt < 4; ++tt) { bf16x8 afr = {0, 0, 0, 0, 0, 0, 0, 0};
              if (lq < 2) afr = *(const bf16x8*)(Z + (size_t)(row0 + 16 * tt + lr) * NZ + ZDEC + dir * 16 + 8 * lq);
              la[tt] = __builtin_amdgcn_mfma_f32_16x16x32_bf16(afr, bfr, (f32x4){0.f, 0.f, 0.f, 0.f}, 0, 0, 0); }
#pragma unroll
          for (int tt = 0; tt < 4; ++tt)
#pragma unroll
              for (int e = 0; e < 4; ++e) { const float pre = la[tt][e] + bias; la[tt][e] = (fminf(pre, 0.f) - __logf(1.f + __expf(-fabsf(pre)))) * 0.0625f; }
          float carry = 0.f;
          if (dir == 0) {
#pragma unroll
              for (int tt = 0; tt < 4; ++tt) { la[tt][1] += la[tt][0]; la[tt][2] += la[tt][1]; la[tt][3] += la[tt][2];
                  const float tot = la[tt][3]; float pre = 0.f; const float s16 = bperm(tot, lane - 16), s32 = bperm(tot, lane - 32), s48 = bperm(tot, lane - 48);
                  if (lq >= 1) pre += s16; if (lq >= 2) pre += s32; if (lq >= 3) pre += s48;
                  const float add = carry + pre;
#pragma unroll
                  for (int e = 0; e < 4; ++e) la[tt][e] += add;
                  carry = bperm(la[tt][3], 48 + lr); }
          } else {
#pragma unroll
              for (int tt = 3; tt >= 0; --tt) { la[tt][2] += la[tt][3]; la[tt][1] += la[tt][2]; la[tt][0] += la[tt][1];
                  const float tot = la[tt][0]; float pre = 0.f; const float s16 = bperm(tot, lane + 16), s32 = bperm(tot, lane + 32), s48 = bperm(tot, lane + 48);
                  if (lq <= 2) pre += s16; if (lq <= 1) pre += s32; if (lq <= 0) pre += s48;
                  const float add = carry + pre;
#pragma unroll
                  for (int e = 0; e < 4; ++e) la[tt][e] += add;
                  carry = bperm(la[tt][0], lr); }
          }
#pragma unroll
          for (int tt = 0; tt < 4; ++tt)
#pragma unroll
              for (int e = 0; e < 4; ++e) La[(16 * tt + 4 * lq + e) * 129 + cch] = la[tt][e]; }
        __syncthreads();
        { const int t = tid >> 3, cb = (tid & 7) * 16; const bf16_t* qp = Z + (size_t)(row0 + t) * NZ + ZQB + h * 128 + cb; const bf16_t* kp = Z + (size_t)(row0 + t) * NZ + ZKB + h * 128 + cb;
          float q[16], k[16];
#pragma unroll
          for (int i = 0; i < 2; ++i) { const u32x4 a = *(const u32x4*)(qp + 8 * i), b = *(const u32x4*)(kp + 8 * i);
              q[8 * i] = bflo(a.x); q[8 * i + 1] = bfhi(a.x); q[8 * i + 2] = bflo(a.y); q[8 * i + 3] = bfhi(a.y); q[8 * i + 4] = bflo(a.z); q[8 * i + 5] = bfhi(a.z); q[8 * i + 6] = bflo(a.w); q[8 * i + 7] = bfhi(a.w);
              k[8 * i] = bflo(b.x); k[8 * i + 1] = bfhi(b.x); k[8 * i + 2] = bflo(b.y); k[8 * i + 3] = bfhi(b.y); k[8 * i + 4] = bflo(b.z); k[8 * i + 5] = bfhi(b.z); k[8 * i + 6] = bflo(b.w); k[8 * i + 7] = bfhi(b.w); }
          const int tl = (dir == 0) ? 63 : 0; float qd[16], ki[16];
#pragma unroll
          for (int i = 0; i < 16; ++i) { const float b = La[t * 129 + cb + i], bl = La[tl * 129 + cb + i]; const float e = __expf(b);
              qd[i] = q[i] * e; ki[i] = k[i] * fast_rcp(e); KdT[(cb + i) * 72 + t] = f2bf(k[i] * __expf(bl - b)); }
          u32x4 o0, o1;
          o0.x = cvt_pk_bf16(qd[0], qd[1]); o0.y = cvt_pk_bf16(qd[2], qd[3]); o0.z = cvt_pk_bf16(qd[4], qd[5]); o0.w = cvt_pk_bf16(qd[6], qd[7]);
          o1.x = cvt_pk_bf16(qd[8], qd[9]); o1.y = cvt_pk_bf16(qd[10], qd[11]); o1.z = cvt_pk_bf16(qd[12], qd[13]); o1.w = cvt_pk_bf16(qd[14], qd[15]);
          *(LAS u32x4*)(QD + t * 136 + cb) = o0; *(LAS u32x4*)(QD + t * 136 + cb + 8) = o1;
          bf16_t* qg = (bf16_t*)(c.ws + WS_RB + RB_QDF) + (size_t)(dir * 1088 + un) * 8192 + (size_t)((((t >> 5) * 4 + (cb >> 5)) * 2 + ((cb >> 4) & 1)) * 512 + (t & 31) * 8);
          u32x4 p0, p1; p0.x = o0.x; p0.y = o0.y; p0.z = o1.x; p0.w = o1.y; p1.x = o0.z; p1.y = o0.w; p1.z = o1.z; p1.w = o1.w;
          *(u32x4*)qg = p0; *(u32x4*)(qg + 256) = p1;
          o0.x = cvt_pk_bf16(ki[0], ki[1]); o0.y = cvt_pk_bf16(ki[2], ki[3]); o0.z = cvt_pk_bf16(ki[4], ki[5]); o0.w = cvt_pk_bf16(ki[6], ki[7]);
          o1.x = cvt_pk_bf16(ki[8], ki[9]); o1.y = cvt_pk_bf16(ki[10], ki[11]); o1.z = cvt_pk_bf16(ki[12], ki[13]); o1.w = cvt_pk_bf16(ki[14], ki[15]);
          *(LAS u32x4*)(KI + t * 136 + cb) = o0; *(LAS u32x4*)(KI + t * 136 + cb + 8) = o1;
          if (tid < 128) ((float*)(c.ws + WS_RB + RB_DECAY))[(size_t)(dir * 1088 + un) * 128 + tid] = __expf(La[tl * 129 + tid]); }
        __syncthreads();
        { bf16_t* kg = (bf16_t*)(c.ws + WS_RB + RB_KDT) + (size_t)(dir * 1088 + un) * 8192;
#pragma unroll
          for (int i = 0; i < 2; ++i) { const int id = tid + 512 * i, ch = id >> 3, tc = id & 7;
              *(u32x4*)(kg + (((ch >> 5) * 4 + (tc >> 1)) * 64 + (tc & 1) * 32 + (ch & 31)) * 8) = *(const LAS u32x4*)(KdT + ch * 72 + tc * 8); } }
        { const int it = w >> 1; bf16x8 a[4];
#pragma unroll
          for (int ks = 0; ks < 4; ++ks) a[ks] = *(const LAS bf16x8*)(QD + (16 * it + lr) * 136 + 32 * ks + 8 * lq);
#pragma unroll
          for (int jj = 0; jj < 2; ++jj) { const int jt = 2 * (w & 1) + jj; f32x4 s = {0.f, 0.f, 0.f, 0.f};
#pragma unroll
              for (int ks = 0; ks < 4; ++ks) { const bf16x8 b = *(const LAS bf16x8*)(KI + (16 * jt + lr) * 136 + 32 * ks + 8 * lq); s = __builtin_amdgcn_mfma_f32_16x16x32_bf16(a[ks], b, s, 0, 0, 0); }
              const int j = 16 * jt + lr;
#pragma unroll
              for (int e = 0; e < 4; ++e) { const int i = 16 * it + 4 * lq + e; const bool keep = (dir == 0) ? (j <= i) : (j >= i); pacc[jj][e] += keep ? s[e] : 0.f; } } }
        __syncthreads();
    }
    { const int it = w >> 1;
#pragma unroll
      for (int jj = 0; jj < 2; ++jj) { const int j = 16 * (2 * (w & 1) + jj) + lr;
#pragma unroll
          for (int e = 0; e < 4; ++e) { Ps[(16 * it + 4 * lq + e) * 72 + j] = f2bf(pacc[jj][e]); } } }
    __syncthreads();
    { bf16_t* OI = (bf16_t*)(c.ws + WS_RB + RB_OINTRA);
#pragma unroll
      for (int dd = 0; dd < 2; ++dd) { const int dt = 2 * w + dd; bf16x8 a[2];
#pragma unroll
          for (int ks = 0; ks < 2; ++ks) a[ks] = *(const LAS bf16x8*)(VTs + (16 * dt + lr) * 72 + 32 * ks + 8 * lq);
#pragma unroll
          for (int it = 0; it < 4; ++it) { f32x4 o = {0.f, 0.f, 0.f, 0.f};
#pragma unroll
              for (int ks = 0; ks < 2; ++ks) { const bf16x8 b = *(const LAS bf16x8*)(Ps + (16 * it + lr) * 72 + 32 * ks + 8 * lq); o = __builtin_amdgcn_mfma_f32_16x16x32_bf16(a[ks], b, o, 0, 0, 0); }

              u32x2 ov; ov.x = cvt_pk_bf16(o[0], o[1]); ov.y = cvt_pk_bf16(o[2], o[3]);
              *(u32x2*)(OI + (size_t)(row0 + 16 * it + lr) * D + h * 256 + 16 * dt + 4 * lq) = ov; } } }
    { bf16_t* vg = (bf16_t*)(c.ws + WS_RB + RB_VTG) + (size_t)un * 16384;
#pragma unroll
      for (int i = 0; i < 4; ++i) { const int id = tid + 512 * i, dv = id >> 3, tc = id & 7;
          *(u32x4*)(vg + ((((dv >> 5) * 4 + (tc >> 1)) * 64) + (tc & 1) * 32 + (dv & 31)) * 8) = *(const LAS u32x4*)(VTs + dv * 72 + tc * 8); } }
    __syncthreads();
}
template <int N> __device__ __forceinline__ void vm_wait() { asm volatile("s_waitcnt vmcnt(%0)" :: "n"(N) : "memory"); }
__device__ __forceinline__ void gla_b2_unit(const Ctx& c, int un3) {
    const int lane = c.lane, lr = lane & 31, hi = lane >> 5, w = c.wave & 3, half = un3 & 1, un2 = un3 >> 1, dvs = half * 4 + w;
    const int h = un2 & 3, b = (un2 >> 2) & 3, dir = un2 >> 4;
    volatile LAS unsigned* cntF = (volatile LAS unsigned*)(c.lds + 3 * 33280 + 4 * 5120);
    volatile LAS unsigned* cntD = (volatile LAS unsigned*)(c.lds + 3 * 33280 + 4 * 5120 + 64);
    const char* QDF = (const char*)(c.ws + WS_RB + RB_QDF) + (size_t)dir * 1088 * 16384;
    const char* KDT = (const char*)(c.ws + WS_RB + RB_KDT) + (size_t)dir * 1088 * 16384;
    const char* VTG = (const char*)(c.ws + WS_RB + RB_VTG) + (size_t)dvs * 4096;
    const char* DEC = (const char*)(c.ws + WS_RB + RB_DECAY) + (size_t)dir * 1088 * 512;
    bf16_t* OUT = (bf16_t*)(c.ws + WS_RB + (dir == 0 ? RB_OF : RB_OB)) + (size_t)(((b * 4 + h) * 8 + dvs) * NKEY) * 32;
    constexpr int STG = 33280;
    LAS unsigned char* OT = c.lds + 3 * STG + w * 5120;
    const unsigned loff = (unsigned)lane * 16u;
#define B2_CHUNK(step) ((step) < 4 ? 256 + 4 * b + (dir == 0 ? (step) : 3 - (step)) : 64 * b + (dir == 0 ? (step) - 4 : 67 - (step)))
#define B2_ISSUE(step) do { const int un_ = B2_CHUNK(step) * 4 + h; LAS unsigned char* lb_ = c.lds + ((step) % 3) * STG; \
        const char* q_ = QDF + (size_t)un_ * 16384 + loff + w * 4096; const char* k_ = KDT + (size_t)un_ * 16384 + loff + w * 4096; \
        _Pragma("unroll") for (int i_ = 0; i_ < 4; ++i_) __builtin_amdgcn_global_load_lds((const unsigned*)(q_ + i_ * 1024), (LAS unsigned*)(lb_ + w * 4096 + i_ * 1024), 16, 0, 0); \
        _Pragma("unroll") for (int i_ = 0; i_ < 4; ++i_) __builtin_amdgcn_global_load_lds((const unsigned*)(k_ + i_ * 1024), (LAS unsigned*)(lb_ + 16384 + w * 4096 + i_ * 1024), 16, 0, 0); \
        if (lane < 8) __builtin_amdgcn_global_load_lds((const unsigned*)(DEC + (size_t)un_ * 512 + w * 128 + loff), (LAS unsigned*)(lb_ + 32768 + w * 128), 16, 0, 0); } while (0)
#define B2_SPIN(cnt, target) do { while (*(cnt) < (unsigned)(target)) __builtin_amdgcn_s_sleep(1); asm volatile("" ::: "memory"); } while (0)
#define B2_ARRIVE(cnt) do { if (lane == 0) { const unsigned one_ = 1u; asm volatile("ds_add_u32 %0, %1" :: "v"((unsigned)(size_t)(cnt)), "v"(one_) : "memory"); } } while (0)
    if (c.wave >= 4) {
#pragma unroll 1
        for (int t = 0; t < 68; ++t) {
            if (t >= 3) B2_SPIN(cntD, 4 * (t - 2));
            B2_ISSUE(t);
            if (t >= 1) { vm_wait<9>(); B2_ARRIVE(cntF); }
        }
        vm_wait<0>(); B2_ARRIVE(cntF);
        return;
    }
#define B2_VT(step, vt) do { const char* v_ = VTG + (size_t)(B2_CHUNK(step) * 4 + h) * 32768 + loff; \
        asm volatile("global_load_dwordx4 %0, %4, off\n\tglobal_load_dwordx4 %1, %4, off offset:1024\n\tglobal_load_dwordx4 %2, %4, off offset:2048\n\tglobal_load_dwordx4 %3, %4, off offset:3072" \
                     : "=&v"(vt[0]), "=&v"(vt[1]), "=&v"(vt[2]), "=&v"(vt[3]) : "v"(v_) : "memory"); } while (0)
#define B2_VT_WAIT(N, vt) asm volatile("s_waitcnt vmcnt(%4)" : "+v"(vt[0]), "+v"(vt[1]), "+v"(vt[2]), "+v"(vt[3]) : "n"(N) : "memory")
    f32x16 S[4];
#pragma unroll
    for (int ct = 0; ct < 4; ++ct)
#pragma unroll
        for (int r = 0; r < 16; ++r) S[ct][r] = 0.f;
    bf16x8 vtA[4], vtB[4];
    B2_VT(0, vtA);
#define B2_STEP(step, vt, vtn) do { \
        B2_SPIN(cntF, 4 * ((step) + 1));     \
        if ((step) + 1 < 68) B2_VT((step) + 1, vtn); \
        const int n_ = B2_CHUNK(step); const int key0 = (n_ < 256) ? CTXL + (n_ & 63) * 64 : (n_ - 256 - 4 * b) * 64; \
        const LAS unsigned char* lb = c.lds + ((step) % 3) * STG + loff; \
          \
        f32x16 o[2]; \
        _Pragma("unroll") for (int tt = 0; tt < 2; ++tt) { _Pragma("unroll") for (int r = 0; r < 16; ++r) o[tt][r] = 0.f; } \
        { u32x4 bw[8]; \
          _Pragma("unroll") for (int ct = 0; ct < 4; ++ct) { _Pragma("unroll") for (int s = 0; s < 2; ++s) { bw[ct * 2 + s].x = cvt_pk_bf16(S[ct][8 * s], S[ct][8 * s + 1]); bw[ct * 2 + s].y = cvt_pk_bf16(S[ct][8 * s + 2], S[ct][8 * s + 3]); bw[ct * 2 + s].z = cvt_pk_bf16(S[ct][8 * s + 4], S[ct][8 * s + 5]); bw[ct * 2 + s].w = cvt_pk_bf16(S[ct][8 * s + 6], S[ct][8 * s + 7]); } } \
          _Pragma("unroll") for (int tt = 0; tt < 2; ++tt) { bf16x8 qa[8]; \
            _Pragma("unroll") for (int i = 0; i < 8; ++i) qa[i] = *(const LAS bf16x8*)(lb + (tt * 8 + i) * 1024); \
            __builtin_amdgcn_sched_barrier(0); \
            _Pragma("unroll") for (int i = 0; i < 8; ++i) o[tt] = __builtin_amdgcn_mfma_f32_32x32x16_bf16(__builtin_bit_cast(bf16x8, bw[i]), qa[i], o[tt], 0, 0, 0); \
            __builtin_amdgcn_sched_barrier(0); } } \
          \
        _Pragma("unroll") for (int tt = 0; tt < 2; ++tt) { bf16_t* op = OUT + (size_t)(key0 + 32 * tt + lr) * 32 + 4 * hi; \
            _Pragma("unroll") for (int gq = 0; gq < 4; ++gq) { u32x2 ov; ov.x = cvt_pk_bf16(o[tt][4 * gq], o[tt][4 * gq + 1]); ov.y = cvt_pk_bf16(o[tt][4 * gq + 2], o[tt][4 * gq + 3]); *(u32x2*)(op + 8 * gq) = ov; } } \
          \
        if ((step) == 0) B2_VT_WAIT(12, vt); else if ((step) == 67) B2_VT_WAIT(16, vt); else B2_VT_WAIT(20, vt); \
        const LAS float* dcl = (const LAS float*)(c.lds + ((step) % 3) * STG + 32768); \
        _Pragma("unroll") for (int cp = 0; cp < 2; ++cp) { bf16x8 ka[8]; f32x4 dq[8]; \
          _Pragma("unroll") for (int i = 0; i < 8; ++i) ka[i] = *(const LAS bf16x8*)(lb + 16384 + (cp * 8 + i) * 1024); \
          _Pragma("unroll") for (int i = 0; i < 8; ++i) dq[i] = *(const LAS f32x4*)(dcl + 32 * (2 * cp + (i >> 2)) + 8 * (i & 3) + 4 * hi); \
          __builtin_amdgcn_sched_barrier(0); \
          _Pragma("unroll") for (int cc = 0; cc < 2; ++cc) { _Pragma("unroll") for (int gq = 0; gq < 4; ++gq) { _Pragma("unroll") for (int e = 0; e < 4; ++e) S[2 * cp + cc][4 * gq + e] *= dq[cc * 4 + gq][e]; } } \
          _Pragma("unroll") for (int ks = 0; ks < 4; ++ks) { _Pragma("unroll") for (int cc = 0; cc < 2; ++cc) S[2 * cp + cc] = __builtin_amdgcn_mfma_f32_32x32x16_bf16(ka[cc * 4 + ks], vt[ks], S[2 * cp + cc], 0, 0, 0); } \
          __builtin_amdgcn_sched_barrier(0); } \
        asm volatile("s_waitcnt lgkmcnt(0)" ::: "memory"); B2_ARRIVE(cntD);     \
    } while (0)
#pragma unroll 1
    for (int step = 0; step < 68; step += 2) { B2_STEP(step, vtA, vtB); B2_STEP(step + 1, vtB, vtA); }
    asm volatile("s_waitcnt vmcnt(0) lgkmcnt(0)" ::: "memory");
#undef B2_STEP
#undef B2_VT_WAIT
#undef B2_CHUNK
#undef B2_ISSUE
#undef B2_VT
#undef B2_SPIN
#undef B2_ARRIVE
}
struct FinRaw { u32x2 a[4], b[4], d[4], r[4]; };
__device__ __forceinline__ void gla_finish_load(const Ctx& c, int row, FinRaw& F) {
    const int lane = c.lane; const bf16_t* OI = (const bf16_t*)(c.ws + WS_RB + RB_OINTRA) + (size_t)row * D;
    const bool lat = row < TL; const int b = lat ? (row >> 12) : ((row - TL) >> 8), key = lat ? CTXL + (row & 4095) : ((row - TL) & 255);
    const bf16_t* OFp = (const bf16_t*)(c.ws + WS_RB + RB_OF) + ((size_t)((b * 4) * 8 + (lane >> 3)) * NKEY + key) * 32 + (lane & 7) * 4; const bf16_t* OBp = OFp + (size_t)(RB_OB - RB_OF) / 2;
    const bf16_t* R = (const bf16_t*)(c.ws + WS_RA) + (size_t)row * NZ + ZRB;
#pragma unroll
    for (int h = 0; h < 4; ++h) { const int cc = h * 256 + 4 * lane; const size_t ho = (size_t)h * 8 * NKEY * 32; F.a[h] = *(const u32x2*)(OI + cc); F.b[h] = *(const u32x2*)(OFp + ho); F.d[h] = *(const u32x2*)(OBp + ho); F.r[h] = *(const u32x2*)(R + cc); }
}
__device__ __forceinline__ void gla_finish_row(const Ctx& c, int l, int row, const FinRaw& F) {
    const int lane = c.lane; bf16_t* Y = (bf16_t*)(c.ws + WS_RB + RB_YCAT) + (size_t)row * 3072 + D;
    const f32x4 gv = *(const f32x4*)(c.in[I_GGLA] + l * 256 + 4 * lane);
    float o[4][4], ss[4];
#pragma unroll
    for (int h = 0; h < 4; ++h) { const u32x2 a = F.a[h], b = F.b[h], d = F.d[h];
        o[h][0] = bflo(a.x) + bflo(b.x) + bflo(d.x); o[h][1] = bfhi(a.x) + bfhi(b.x) + bfhi(d.x); o[h][2] = bflo(a.y) + bflo(b.y) + bflo(d.y); o[h][3] = bfhi(a.y) + bfhi(b.y) + bfhi(d.y);
        ss[h] = (o[h][0] * o[h][0] + o[h][1] * o[h][1]) + (o[h][2] * o[h][2] + o[h][3] * o[h][3]); }
#pragma unroll
    for (int h = 0; h < 4; ++h) ss[h] = wave_sum(ss[h]);
#pragma unroll
    for (int h = 0; h < 4; ++h) { const int cc = h * 256 + 4 * lane; const u32x2 r = F.r[h]; const float rstd = 1.0f / sqrtf(ss[h] * (1.f / 256.f) + EPS);
        u32x2 ov; ov.x = cvt_pk_bf16(o[h][0] * rstd * gv[0] * bflo(r.x), o[h][1] * rstd * gv[1] * bfhi(r.x)); ov.y = cvt_pk_bf16(o[h][2] * rstd * gv[2] * bflo(r.y), o[h][3] * rstd * gv[3] * bfhi(r.y));
        *(u32x2*)(Y + cc) = ov; }
}
__device__ __forceinline__ void rope_angle(int pos_row, int pos_col, int j, float& cs, float& sn) {
    const int axis = j >> 5, f = j & 15; const float inv = __expf(-(float)(2 * f) * (1.f / 32.f) * 9.210340371976184f);
    float rev = (float)(axis == 0 ? pos_row : pos_col) * inv * 0.15915494309189535f; rev -= floorf(rev); sn = __builtin_amdgcn_sinf(rev); cs = __builtin_amdgcn_cosf(rev);
}
struct C1Raw { u32x2 ckv; unsigned cq[3]; bf16_t kro; u32x2 kvw[8]; unsigned qnw[8]; bf16_t qrw[8]; };
__device__ __forceinline__ void mla_c1_load(const Ctx& c, int row, bool do_q, C1Raw& R) {
    const int lane = c.lane;
    const bf16_t* Zr = (const bf16_t*)(c.ws + WS_RA) + (size_t)row * NZ;
    const bf16_t* KV = (const bf16_t*)(c.ws + WS_RB + RB_KVRAW) + (size_t)row * 2048; const bf16_t* QR = (const bf16_t*)(c.ws + WS_RB + RB_QRAW) + (size_t)row * 1536;
    R.ckv = *(const u32x2*)(Zr + ZCKV + 4 * lane);
#pragma unroll
    for (int i = 0; i < 3; ++i) R.cq[i] = *(const unsigned*)(Zr + ZCQ + 128 * i + 2 * lane);
    R.kro = Zr[ZKR + lane];
#pragma unroll
    for (int h = 0; h < 8; ++h) R.kvw[h] = *(const u32x2*)(KV + h * 256 + 4 * lane);
    if (do_q) {
#pragma unroll
        for (int h = 0; h < 8; ++h) { R.qnw[h] = *(const unsigned*)(QR + h * 192 + 2 * lane); R.qrw[h] = QR[h * 192 + 128 + lane]; }
    }
}
__device__ __forceinline__ void mla_c1_row(const Ctx& c, int l, int row, bool do_q, const C1Raw& R) {
    const int lane = c.lane; const bool lat = row < TL; const int b = lat ? (row >> 12) : ((row - TL) >> 8), t = lat ? (row & 4095) : ((row - TL) & 255), key = lat ? (CTXL + t) : t;
    bf16_t* KG = (bf16_t*)(c.ws + WS_RB + RB_KG); bf16_t* VG = (bf16_t*)(c.ws + WS_RB + RB_VG);
    float rs_kv, rs_q;
    { const u32x2 w = R.ckv; const float a0 = bflo(w.x), a1 = bfhi(w.x), a2 = bflo(w.y), a3 = bfhi(w.y);
      rs_kv = 1.0f / sqrtf(wave_sum((a0 * a0 + a1 * a1) + (a2 * a2 + a3 * a3)) * (1.f / 256.f) + EPS);
      float s = 0.f;
#pragma unroll
      for (int i = 0; i < 3; ++i) { const unsigned w2 = R.cq[i]; const float q0 = bflo(w2), q1 = bfhi(w2); s += q0 * q0 + q1 * q1; }
      rs_q = 1.0f / sqrtf(wave_sum(s) * (1.f / 384.f) + EPS); }
    float cs = 1.f, sn = 0.f; if (lat) rope_angle(t >> 6, t & 63, lane, cs, sn);
    const bool second = (lane >> 4) & 1;
    float kr;
    { const float v = bf2f(R.kro); const float rr = 1.0f / sqrtf(wave_sum(v * v) * (1.f / 64.f) + EPS); float x = v * rr * c.in[I_GKR][l * 64 + lane];
      const float xp = sx<16>(x); kr = lat ? (second ? (x * cs + xp * sn) : (x * cs - xp * sn)) : x; }
    const bf16_t krb = f2bf(kr);
    const f32x4 gkn = *(const f32x4*)(c.in[I_GKN] + l * 128 + 4 * (lane & 31));
    float ssk[8]; float ak[8][4];
#pragma unroll
    for (int h = 0; h < 8; ++h) { ak[h][0] = bflo(R.kvw[h].x) * rs_kv; ak[h][1] = bfhi(R.kvw[h].x) * rs_kv; ak[h][2] = bflo(R.kvw[h].y) * rs_kv; ak[h][3] = bfhi(R.kvw[h].y) * rs_kv;
        ssk[h] = (ak[h][0] * ak[h][0] + ak[h][1] * ak[h][1]) + (ak[h][2] * ak[h][2] + ak[h][3] * ak[h][3]); }
#pragma unroll
    for (int h = 0; h < 8; ++h) ssk[h] = half_sum(ssk[h]);
    { bf16_t* kgp = KG + (size_t)(b * NKEY + key) * (8 * 192); bf16_t* vgp = VG + (size_t)(b * NKEY + key) * (8 * 128);
#pragma unroll
      for (int h = 0; h < 8; ++h) {
        if (lane < 32) { const float rn = 1.0f / sqrtf(ssk[h] * (1.f / 128.f) + EPS); u32x2 o; o.x = cvt_pk_bf16(ak[h][0] * rn * gkn[0], ak[h][1] * rn * gkn[1]); o.y = cvt_pk_bf16(ak[h][2] * rn * gkn[2], ak[h][3] * rn * gkn[3]);
            *(u32x2*)(kgp + h * 192 + 4 * lane) = o; }
        else { u32x2 o; o.x = cvt_pk_bf16(ak[h][0], ak[h][1]); o.y = cvt_pk_bf16(ak[h][2], ak[h][3]); *(u32x2*)(vgp + h * 128 + 4 * (lane - 32)) = o; }
        kgp[h * 192 + 128 + lane] = krb;
      } }
    __builtin_amdgcn_sched_barrier(0);
    if (lane == 0) ((float*)(c.ws + WS_RSQ))[row] = rs_q;
    if (!do_q) return;
    bf16_t* QF = lat ? (bf16_t*)(c.ws + WS_RB + RB_QFL) : (bf16_t*)(c.ws + WS_RB + RB_QFC); const int nq = lat ? SEQ : CTXL;
    const float QS = 0.07216878364870322f * 1.4426950408889634f;
    const f32x2 gqn = *(const f32x2*)(c.in[I_GQN] + l * 128 + 2 * lane); const float gqr = c.in[I_GQR][l * 64 + lane];
    float n0[8], n1[8], r0[8], sn_[8], sr_[8];
#pragma unroll
    for (int h = 0; h < 8; ++h) { n0[h] = bflo(R.qnw[h]) * rs_q; n1[h] = bfhi(R.qnw[h]) * rs_q; r0[h] = bf2f(R.qrw[h]) * rs_q; sn_[h] = n0[h] * n0[h] + n1[h] * n1[h]; sr_[h] = r0[h] * r0[h]; }
#pragma unroll
    for (int h = 0; h < 8; ++h) { sn_[h] = wave_sum(sn_[h]); sr_[h] = wave_sum(sr_[h]); }
#pragma unroll
    for (int h = 0; h < 8; ++h) {
        const float rn = 1.0f / sqrtf(sn_[h] * (1.f / 128.f) + EPS), rr = 1.0f / sqrtf(sr_[h] * (1.f / 64.f) + EPS);
        bf16_t* qp = QF + (size_t)(b * nq + t) * (8 * 192) + h * 192;
        *(unsigned*)(qp + 2 * lane) = cvt_pk_bf16(n0[h] * rn * gqn[0] * QS, n1[h] * rn * gqn[1] * QS);
        const float x = r0[h] * rr * gqr; const float xp = sx<16>(x); const float xr = lat ? (second ? (x * cs + xp * sn) : (x * cs - xp * sn)) : x;
        qp[128 + lane] = f2bf(xr * QS);
    }
}
__device__ __forceinline__ bf16x8 tr_pair(unsigned a0, unsigned a1) {
    bf16x4 x, y; asm volatile("ds_read_b64_tr_b16 %0, %2\n\tds_read_b64_tr_b16 %1, %3\n\ts_waitcnt lgkmcnt(0)" : "=&v"(x), "=&v"(y) : "v"(a0), "v"(a1) : "memory");
    return (bf16x8){x[0], x[1], x[2], x[3], y[0], y[1], y[2], y[3]};
}
template <int OFF> __device__ __forceinline__ void k2_issue(bf16x8& a0, bf16x8& a1, unsigned addr) {
    asm volatile("ds_read_b128 %0, %2 offset:%3\n\tds_read_b128 %1, %2 offset:%4" : "=&v"(a0), "=&v"(a1) : "v"(addr), "n"(OFF), "n"(OFF + 12288) : "memory");
}
template <int N> __device__ __forceinline__ void k2_wait(bf16x8& a0, bf16x8& a1) { asm volatile("s_waitcnt lgkmcnt(%2)" : "+v"(a0), "+v"(a1) : "n"(N) : "memory"); }
template <int OFF>
__device__ __forceinline__ void tr8_issue(bf16x4 (&x)[8], const unsigned (&a)[4], const unsigned (&b)[4]) {
    asm volatile("ds_read_b64_tr_b16 %0, %8 offset:%16\n\tds_read_b64_tr_b16 %2, %9 offset:%16\n\tds_read_b64_tr_b16 %4, %10 offset:%16\n\tds_read_b64_tr_b16 %6, %11 offset:%16\n\t"
                 "ds_read_b64_tr_b16 %1, %12 offset:%16\n\tds_read_b64_tr_b16 %3, %13 offset:%16\n\tds_read_b64_tr_b16 %5, %14 offset:%16\n\tds_read_b64_tr_b16 %7, %15 offset:%16"
                 : "=&v"(x[0]), "=&v"(x[1]), "=&v"(x[2]), "=&v"(x[3]), "=&v"(x[4]), "=&v"(x[5]), "=&v"(x[6]), "=&v"(x[7])
                 : "v"(a[0]), "v"(a[1]), "v"(a[2]), "v"(a[3]), "v"(b[0]), "v"(b[1]), "v"(b[2]), "v"(b[3]), "n"(OFF) : "memory");
}
__device__ __forceinline__ void tr8_wait(bf16x4 (&x)[8]) {
    asm volatile("s_waitcnt lgkmcnt(0)" : "+v"(x[0]), "+v"(x[1]), "+v"(x[2]), "+v"(x[3]), "+v"(x[4]), "+v"(x[5]), "+v"(x[6]), "+v"(x[7]) :: "memory");
}
__device__ __forceinline__ void attn_unit(const Ctx& c, int l, const bf16_t* Qraw  , const float* rsq  , int t0  ,
                                          const bf16_t* Kp  , const bf16_t* Vp  , int nt, bf16_t* Op  ) {
    constexpr int STG = 40960, KB = 24576;
    const int tid = c.tid, lane = c.lane, w = c.wave, lr = lane & 31, hi = lane >> 5;
    const unsigned lds0 = (unsigned)(size_t)c.lds;
    unsigned ksrc[3], vsrc[2];
#pragma unroll
    for (int i = 0; i < 3; ++i) { const int P = (w + 8 * i) * 64 + lane, row = P / 24, cp = P % 24, ch = (cp & ~7) | ((cp & 7) ^ ((row >> 1) & 7)); ksrc[i] = row * 3072 + ch * 16; }
#pragma unroll
    for (int i = 0; i < 2; ++i) { const int P = (w + 8 * i) * 64 + lane, row = P >> 4, cp = P & 15, ch = cp ^ (((row & 3) << 2) | ((row >> 2) & 3)); vsrc[i] = row * 2048 + ch * 16; }
#define ATT_ISSUE(tile, stg) do { const char* kt_ = (const char*)Kp + (size_t)(tile) * (64 * 3072); const char* vt_ = (const char*)Vp + (size_t)(tile) * (64 * 2048); \
        _Pragma("unroll") for (int i_ = 0; i_ < 3; ++i_) __builtin_amdgcn_global_load_lds((const unsigned*)(kt_ + ksrc[i_]), (LAS unsigned*)(c.lds + (stg) * STG + (w + 8 * i_) * 1024), 16, 0, 0); \
        _Pragma("unroll") for (int i_ = 0; i_ < 2; ++i_) __builtin_amdgcn_global_load_lds((const unsigned*)(vt_ + vsrc[i_]), (LAS unsigned*)(c.lds + (stg) * STG + KB + (w + 8 * i_) * 1024), 16, 0, 0); } while (0)
    bf16x8 qf[12];
    {
      const int qr = 32 * w + lr; const bf16_t* qrow = Qraw + (size_t)qr * 1536 + 8 * hi; const float rs = rsq[qr];
      u32x4 raw[12]; float sn = 0.f, sr = 0.f;
#pragma unroll
      for (int s = 0; s < 12; ++s) { raw[s] = *(const u32x4*)(qrow + 16 * s); const u32x4 wv = raw[s];
          const float q2 = (bflo(wv.x) * bflo(wv.x) + bfhi(wv.x) * bfhi(wv.x)) + (bflo(wv.y) * bflo(wv.y) + bfhi(wv.y) * bfhi(wv.y)) + (bflo(wv.z) * bflo(wv.z) + bfhi(wv.z) * bfhi(wv.z)) + (bflo(wv.w) * bflo(wv.w) + bfhi(wv.w) * bfhi(wv.w));
          if (s < 8) sn += q2; else sr += q2; }
      sn = sum32(sn) * rs * rs; sr = sum32(sr) * rs * rs;
      const float QS = 0.07216878364870322f * 1.4426950408889634f;
      const float rn = rs * QS / sqrtf(sn * (1.f / 128.f) + EPS), rr = rs * QS / sqrtf(sr * (1.f / 64.f) + EPS);
      const float* gqn = c.in[I_GQN] + l * 128 + 8 * hi; const float* gqr = c.in[I_GQR] + l * 64 + 8 * hi;
#pragma unroll
      for (int s = 0; s < 8; ++s) { const f32x4 g0 = *(const f32x4*)(gqn + 16 * s) * rn, g1 = *(const f32x4*)(gqn + 16 * s + 4) * rn; const u32x4 wv = raw[s]; u32x4 pk;
          pk.x = cvt_pk_bf16(bflo(wv.x) * g0[0], bfhi(wv.x) * g0[1]); pk.y = cvt_pk_bf16(bflo(wv.y) * g0[2], bfhi(wv.y) * g0[3]); pk.z = cvt_pk_bf16(bflo(wv.z) * g1[0], bfhi(wv.z) * g1[1]); pk.w = cvt_pk_bf16(bflo(wv.w) * g1[2], bfhi(wv.w) * g1[3]);
          qf[s] = __builtin_bit_cast(bf16x8, pk); }
      float x[4][8];
#pragma unroll
      for (int s = 0; s < 4; ++s) { const f32x4 g0 = *(const f32x4*)(gqr + 16 * s) * rr, g1 = *(const f32x4*)(gqr + 16 * s + 4) * rr; const u32x4 wv = raw[8 + s];
          x[s][0] = bflo(wv.x) * g0[0]; x[s][1] = bfhi(wv.x) * g0[1]; x[s][2] = bflo(wv.y) * g0[2]; x[s][3] = bfhi(wv.y) * g0[3]; x[s][4] = bflo(wv.z) * g1[0]; x[s][5] = bfhi(wv.z) * g1[1]; x[s][6] = bflo(wv.w) * g1[2]; x[s][7] = bfhi(wv.w) * g1[3]; }
      if (t0 >= 0) { const int t = t0 + qr; const float prow = (float)(t >> 6), pcol = (float)(t & 63);
#pragma unroll
          for (int i = 0; i < 8; ++i) { const float inv = __expf(-(float)(2 * (8 * hi + i)) * (1.f / 32.f) * 9.210340371976184f) * 0.15915494309189535f;
              float r0 = prow * inv; r0 -= floorf(r0); float r1 = pcol * inv; r1 -= floorf(r1);
              const float c0 = __builtin_amdgcn_cosf(r0), s0 = __builtin_amdgcn_sinf(r0), c1 = __builtin_amdgcn_cosf(r1), s1 = __builtin_amdgcn_sinf(r1);
              const float a0 = x[0][i], b0 = x[1][i], a1 = x[2][i], b1 = x[3][i];
              x[0][i] = a0 * c0 - b0 * s0; x[1][i] = b0 * c0 + a0 * s0; x[2][i] = a1 * c1 - b1 * s1; x[3][i] = b1 * c1 + a1 * s1; } }
#pragma unroll
      for (int s = 0; s < 4; ++s) { u32x4 pk; pk.x = cvt_pk_bf16(x[s][0], x[s][1]); pk.y = cvt_pk_bf16(x[s][2], x[s][3]); pk.z = cvt_pk_bf16(x[s][4], x[s][5]); pk.w = cvt_pk_bf16(x[s][6], x[s][7]); qf[8 + s] = __builtin_bit_cast(bf16x8, pk); }
      __builtin_amdgcn_sched_barrier(0); }
    unsigned kbase = lr * 384, y16 = (unsigned)((hi ^ ((lr >> 1) & 7)) << 4);
    unsigned vbase, q64, vd1;
    { const int blk = (lane >> 4) & 1, q = (lane & 15) >> 2, p = lane & 3; const int lb = (2 * blk + (p >> 1)) ^ hi;
      vbase = KB + 256 * (4 * hi + q) + 16 * lb + 8 * (p & 1); q64 = (unsigned)(q << 6); vd1 = 2048u + ((lb & 2) ? -32 : 32); }
    f32x16 o[4];
#pragma unroll
    for (int cc = 0; cc < 4; ++cc)
#pragma unroll
        for (int r = 0; r < 16; ++r) o[cc][r] = 0.f;
    float m = 0.f, lsum = 0.f;
    ATT_ISSUE(0, 0);
    if (nt > 1) ATT_ISSUE(1, 1);
    asm volatile("" :: "v"(qf[0]), "v"(qf[1]), "v"(qf[2]), "v"(qf[3]), "v"(qf[4]), "v"(qf[5]), "v"(qf[6]), "v"(qf[7]), "v"(qf[8]), "v"(qf[9]), "v"(qf[10]), "v"(qf[11]));
#pragma unroll 1
    for (int j = 0; j < nt; ++j) {
        if (j + 1 < nt) asm volatile("s_waitcnt vmcnt(5)" ::: "memory"); else asm volatile("s_waitcnt vmcnt(0)" ::: "memory");
        asm volatile("s_waitcnt lgkmcnt(0)" ::: "memory"); __builtin_amdgcn_s_barrier(); asm volatile("" ::: "memory");
        if (j + 2 < nt) ATT_ISSUE(j + 2, (j + 2) % 3);
        const unsigned sb = lds0 + (unsigned)((j % 3) * STG);
        asm volatile("" : "+v"(kbase), "+v"(y16), "+v"(vbase), "+v"(q64), "+v"(vd1));
        const unsigned kb_ = sb + kbase;
        f32x16 st[2];
        { const float nm = -m;
#pragma unroll
          for (int kt = 0; kt < 2; ++kt)
#pragma unroll
            for (int r = 0; r < 16; ++r) st[kt][r] = nm; }
        { bf16x8 ka[2][2];
          unsigned kx[4];
#pragma unroll
          for (int x = 0; x < 4; ++x) kx[x] = kb_ + (y16 ^ (unsigned)(x << 5));
#define K2I(s_) do { constexpr int s__ = (s_); if constexpr ((s__ >> 2) == 0) k2_issue<0>(ka[s__ & 1][0], ka[s__ & 1][1], kx[s__ & 3]); else if constexpr ((s__ >> 2) == 1) k2_issue<128>(ka[s__ & 1][0], ka[s__ & 1][1], kx[s__ & 3]); else k2_issue<256>(ka[s__ & 1][0], ka[s__ & 1][1], kx[s__ & 3]); } while (0)
          K2I(0);
#define K2STEP(s_) do { if constexpr ((s_) + 1 < 12) { K2I((s_) + 1); k2_wait<2>(ka[(s_) & 1][0], ka[(s_) & 1][1]); } else k2_wait<0>(ka[(s_) & 1][0], ka[(s_) & 1][1]); \
              st[0] = __builtin_amdgcn_mfma_f32_32x32x16_bf16(ka[(s_) & 1][0], qf[(s_)], st[0], 0, 0, 0); st[1] = __builtin_amdgcn_mfma_f32_32x32x16_bf16(ka[(s_) & 1][1], qf[(s_)], st[1], 0, 0, 0); } while (0)
          K2STEP(0); K2STEP(1); K2STEP(2); K2STEP(3); K2STEP(4); K2STEP(5); K2STEP(6); K2STEP(7); K2STEP(8); K2STEP(9); K2STEP(10); K2STEP(11);
#undef K2STEP
#undef K2I
        }
        bf16x4 vx[8];
        unsigned va[4], vb[4];
#pragma unroll
        for (int i = 0; i < 4; ++i) { va[i] = sb + vbase + (q64 ^ (unsigned)(64 * i)); vb[i] = va[i] + vd1; }
        tr8_issue<0>(vx, va, vb);
        float mx = st[0][0];
#pragma unroll
        for (int r = 1; r < 16; ++r) mx = fmaxf(mx, st[0][r]);
#pragma unroll
        for (int r = 0; r < 16; ++r) mx = fmaxf(mx, st[1][r]);
        mx = max32(mx);
        const bool firstt = (j == 0);
        if (firstt || __any(mx > 8.0f)) {
            const float delta = firstt ? mx : fmaxf(mx, 0.f), alpha = firstt ? 0.f : __builtin_amdgcn_exp2f(-delta); m += delta; lsum *= alpha;
#pragma unroll
            for (int kt = 0; kt < 2; ++kt)
#pragma unroll
                for (int r = 0; r < 16; ++r) st[kt][r] -= delta;
#pragma unroll
            for (int cc = 0; cc < 4; ++cc)
#pragma unroll
                for (int r = 0; r < 16; ++r) o[cc][r] *= alpha; }
        f32x2 ps2 = {0.f, 0.f};
#pragma unroll
        for (int kt = 0; kt < 2; ++kt)
#pragma unroll
            for (int r = 0; r < 16; r += 2) { st[kt][r] = __builtin_amdgcn_exp2f(st[kt][r]); st[kt][r + 1] = __builtin_amdgcn_exp2f(st[kt][r + 1]); ps2 += (f32x2){st[kt][r], st[kt][r + 1]}; }
        lsum += ps2[0] + ps2[1];
#define ATT_PV(KT, S2, NEXT_OFF, HAS_NEXT) do { u32x4 pw; pw.x = cvt_pk_bf16(st[KT][8 * S2], st[KT][8 * S2 + 1]); pw.y = cvt_pk_bf16(st[KT][8 * S2 + 2], st[KT][8 * S2 + 3]); pw.z = cvt_pk_bf16(st[KT][8 * S2 + 4], st[KT][8 * S2 + 5]); pw.w = cvt_pk_bf16(st[KT][8 * S2 + 6], st[KT][8 * S2 + 7]); \
            const bf16x8 pb = __builtin_bit_cast(bf16x8, pw); tr8_wait(vx); bf16x8 af[4]; \
            _Pragma("unroll") for (int cc = 0; cc < 4; ++cc) af[cc] = (bf16x8){vx[2 * cc][0], vx[2 * cc][1], vx[2 * cc][2], vx[2 * cc][3], vx[2 * cc + 1][0], vx[2 * cc + 1][1], vx[2 * cc + 1][2], vx[2 * cc + 1][3]}; \
            if (HAS_NEXT) tr8_issue<NEXT_OFF>(vx, va, vb); \
            _Pragma("unroll") for (int cc = 0; cc < 4; ++cc) o[cc] = __builtin_amdgcn_mfma_f32_32x32x16_bf16(af[cc], pb, o[cc], 0, 0, 0); } while (0)
        ATT_PV(0, 0, 4096, true); ATT_PV(0, 1, 8192, true); ATT_PV(1, 0, 12288, true); ATT_PV(1, 1, 0, false);
#undef ATT_PV
    }
    const float linv = 1.0f / sum32(lsum);
    bf16_t* orow = Op + (size_t)(32 * w + lr) * 3072;
#pragma unroll
    for (int cc = 0; cc < 4; ++cc)
#pragma unroll
        for (int g = 0; g < 4; ++g) { u32x2 ov; ov.x = cvt_pk_bf16(o[cc][4 * g] * linv, o[cc][4 * g + 1] * linv); ov.y = cvt_pk_bf16(o[cc][4 * g + 2] * linv, o[cc][4 * g + 3] * linv);
            *(u32x2*)(orow + 32 * cc + 8 * g + 4 * hi) = ov; }
    asm volatile("s_waitcnt vmcnt(0) lgkmcnt(0)" ::: "memory"); __builtin_amdgcn_s_barrier(); asm volatile("" ::: "memory");
#undef ATT_ISSUE
}
__device__ __forceinline__ void route_stage_w(const Ctx& c, int l) {
    LAS float* WT = (LAS float*)c.lds; const float* wr = c.in[I_WROUTER] + (size_t)l * D * NEXP;
    for (int i = c.tid; i < D * NEXP; i += NTHR) WT[(i & 15) * 1028 + (i >> 4)] = wr[i];
    __syncthreads();
}
struct RouteRaw { f32x4 xv[4]; };
__device__ __forceinline__ void route_load(const Ctx& c, int row, RouteRaw& R) { const float* xr = xout_row(c, row);
#pragma unroll
    for (int j = 0; j < 4; ++j) R.xv[j] = *(const f32x4*)(xr + 4 * c.lane + 256 * j); }
__device__ __forceinline__ void route_row(const Ctx& c, int l, int row, const RouteRaw& R) {
    const int lane = c.lane, bi = row_modidx(row); f32x4 hv[4];
    { const float* g = c.in[I_GFFN] + l * D; const float* shift = modp(c, l, bi, 3); const float* scale = modp(c, l, bi, 4); bf16_t* hrow = (bf16_t*)(c.ws + WS_H) + (size_t)row * D; float ss = 0.f;
#pragma unroll
      for (int j = 0; j < 4; ++j) { hv[j] = R.xv[j]; ss += (hv[j][0] * hv[j][0] + hv[j][1] * hv[j][1]) + (hv[j][2] * hv[j][2] + hv[j][3] * hv[j][3]); }
      const float rstd = 1.0f / sqrtf(wave_sum(ss) * (1.f / D) + EPS);
#pragma unroll
      for (int j = 0; j < 4; ++j) { const int cc = 4 * lane + 256 * j; const f32x4 gv = *(const f32x4*)(g + cc), sc = *(const f32x4*)(scale + cc), sh = *(const f32x4*)(shift + cc);
          hv[j] = hv[j] * rstd * gv * (sc + 1.0f) + sh;
          u32x2 o; o.x = cvt_pk_bf16(hv[j][0], hv[j][1]); o.y = cvt_pk_bf16(hv[j][2], hv[j][3]); *(u32x2*)(hrow + cc) = o; } }
    const LAS float* WT = (const LAS float*)c.lds; float lg[16];
#pragma unroll
    for (int e = 0; e < 16; ++e) { f32x2 a2 = {0.f, 0.f};
#pragma unroll
        for (int j = 0; j < 4; ++j) { const f32x4 wv = *(const LAS f32x4*)(WT + e * 1028 + 4 * lane + 256 * j); a2 += hv[j].lo * wv.lo; a2 += hv[j].hi * wv.hi; }
        lg[e] = a2[0] + a2[1]; if ((e & 3) == 3) __builtin_amdgcn_sched_barrier(0); }
    float a8[8], b4[4];
#pragma unroll
    for (int e = 0; e < 8; ++e) { auto r = __builtin_amdgcn_permlane32_swap(__float_as_uint(lg[e]), __float_as_uint(lg[e + 8]), false, false); a8[e] = __uint_as_float(r[0]) + __uint_as_float(r[1]); }
#pragma unroll
    for (int i = 0; i < 4; ++i) { auto r = __builtin_amdgcn_permlane16_swap(__float_as_uint(a8[i]), __float_as_uint(a8[i + 4]), false, false); float v = __uint_as_float(r[0]) + __uint_as_float(r[1]);
        v += __int_as_float(__builtin_amdgcn_update_dpp(0, __float_as_int(v), 0x128, 0xf, 0xf, true));
        v += __int_as_float(__builtin_amdgcn_update_dpp(0, __float_as_int(v), 0x124, 0xf, 0xf, true));
        v += __int_as_float(__builtin_amdgcn_update_dpp(0, __float_as_int(v), 0x4E, 0xf, 0xf, true));
        v += __int_as_float(__builtin_amdgcn_update_dpp(0, __float_as_int(v), 0xB1, 0xf, 0xf, true));
        b4[i] = v; }
    float mx = fmaxf(fmaxf(b4[0], b4[1]), fmaxf(b4[2], b4[3]));
    { auto r = __builtin_amdgcn_permlane16_swap(__float_as_uint(mx), __float_as_uint(mx), false, false); mx = fmaxf(__uint_as_float(r[0]), __uint_as_float(r[1])); }
    mx = max32(mx);
    float sum = 0.f;
#pragma unroll
    for (int i = 0; i < 4; ++i) { b4[i] = __expf(b4[i] - mx); sum += b4[i]; }
    { auto r = __builtin_amdgcn_permlane16_swap(__float_as_uint(sum), __float_as_uint(sum), false, false); sum = __uint_as_float(r[0]) + __uint_as_float(r[1]); }
    sum = sum32(sum);
    const float inv = 1.0f / sum; const int li = lane & 15, ex = li + 4 * ((lane >> 4) & 1) + 8 * (lane >> 5);
    const float mine = (li == 0 ? b4[0] : (li == 1 ? b4[1] : (li == 2 ? b4[2] : b4[3]))) * inv;
    float* AF = (float*)(c.ws + WS_AFFT);
    if (li < 4) { if (row < TL) AF[((size_t)(row >> 12) * 16 + ex) * SEQ + (row & 4095)] = mine; else AF[(size_t)NB * 16 * SEQ + ((size_t)((row - TL) >> 8) * 16 + ex) * CTXL + ((row - TL) & 255)] = mine; }
}
struct GuMap { int up; __device__ __forceinline__ int operator()(int n) const { return (n >> 7) * 256 + up * 128 + (n & 127); } };
struct IdMap { __device__ __forceinline__ int operator()(int n) const { return n; } };
__device__ __forceinline__ int wconv_queue(const Ctx& c, int l, int q, int maxu) {
    unsigned* ctr = (unsigned*)(c.ws + WS_CTL + 32768) + 64 * l + 16 * q; LAS int* ubox = (LAS int*)(c.lds + 4 * 64 * 65 * 4);
    const int nunits = (q == 0) ? GU_SPLIT * 256 : (q == 1 ? (NEXP - GU_SPLIT) * 256 : NEXP * 128);
    int n = 0;
    for (; n < maxu; ++n) { if (c.tid == 0) *ubox = (int)__hip_atomic_fetch_add(ctr, 1u, __ATOMIC_RELAXED, __HIP_MEMORY_SCOPE_AGENT);
        __syncthreads(); const int u = *ubox; __syncthreads(); if (u >= nunits) break;
        if (q == 2) { const int e = u >> 7, r = u & 127, nb = r >> 5, kb = r & 31;
            tconv_tile4(c, c.in[I_WED] + ((size_t)l * NEXP + e) * DEXP * D, D, kb * 64, nb * 256, (bf16_t*)(c.ws + WS_RB + RB_WD) + (size_t)e * D * DEXP, DEXP, kb * 64, IdMap{}); }
        else { const int e = (u >> 8) + (q == 1 ? GU_SPLIT : 0), r = u & 255, up = r >> 7, rr = r & 127, nb = rr >> 4, kb = rr & 15;
            const float* src = c.in[up ? I_WEU : I_WEG] + ((size_t)l * NEXP + e) * D * DEXP;
            bf16_t* dst = (q == 1) ? (bf16_t*)(c.ws + WS_RB + RB_WGU2) + (size_t)(e - GU_SPLIT) * 4096 * D : (bf16_t*)(c.ws + WS_RB + RB_WGU) + (size_t)e * 4096 * D;
            tconv_tile4(c, src, DEXP, kb * 64, nb * 256, dst, D, kb * 64, GuMap{up}); } }
    return n;
}
__device__ __forceinline__ void wconv_early(const Ctx& c, int l, int maxu) { const int n = wconv_queue(c, l, 2, maxu); if (n < maxu) (void)wconv_queue(c, l, 1, maxu - n); }
__device__ __forceinline__ void expert_wconv(const Ctx& c, int l) { (void)wconv_queue(c, l, 0, 1 << 30); (void)wconv_queue(c, l, 1, 1 << 30); (void)wconv_queue(c, l, 2, 1 << 30); }
__device__ __forceinline__ void topk_unit(const Ctx& c, int un, bool is_ctx) {
    const int tid = c.tid, lane = c.lane, w = c.wave;
    LAS unsigned* hist = (LAS unsigned*)c.lds;
    LAS unsigned* ctl = (LAS unsigned*)(c.lds + 1024);
    LAS unsigned* wsum = (LAS unsigned*)(c.lds + 1280);
    LAS int* list = (LAS int*)(c.lds + 2048);
    int b, e, ntok, cap; const float* src;
    if (!is_ctx) { b = un >> 4; e = un & 15; ntok = SEQ; cap = CAPL; src = (const float*)(c.ws + WS_AFFT) + ((size_t)b * 16 + e) * SEQ; }
    else { b = un >> 4; e = un & 15; ntok = CTXL; cap = CAPC; src = (const float*)(c.ws + WS_AFFT) + (size_t)NB * 16 * SEQ + ((size_t)b * 16 + e) * CTXL; }
    const bool have = 8 * tid < ntok; unsigned key[8];
    if (have) { const u32x4 k0 = *(const u32x4*)(src + 8 * tid), k1 = *(const u32x4*)(src + 8 * tid + 4); key[0] = k0.x; key[1] = k0.y; key[2] = k0.z; key[3] = k0.w; key[4] = k1.x; key[5] = k1.y; key[6] = k1.z; key[7] = k1.w; }
    else {
#pragma unroll
        for (int i = 0; i < 8; ++i) key[i] = 0u; }
    if (tid == 0) { unsigned z0 = 0u, c0 = (unsigned)cap; asm volatile("" : "+v"(z0), "+v"(c0)); ctl[0] = z0; ctl[1] = c0; }
#pragma unroll 1
    for (int pass = 0; pass < 4; ++pass) { const int shift = 24 - 8 * pass;
        if (tid < 256) hist[tid] = 0u;
        __syncthreads();
        const unsigned pref = ctl[0], need = ctl[1];
        if (have) {
#pragma unroll
            for (int i = 0; i < 8; ++i) { const bool m = (pass == 0) || ((key[i] >> (shift + 8)) == pref); if (m) atomicAdd((unsigned*)(hist + ((key[i] >> shift) & 255u)), 1u); } }
        __syncthreads();
        if (tid < 256) {
            const unsigned hv = hist[tid]; unsigned sfx = hv;
#pragma unroll
            for (int o = 1; o < 64; o <<= 1) { const unsigned tv = bperm(sfx, lane + o); if (lane + o < 64) sfx += tv; }
            if (lane == 0) wsum[w] = sfx;
            }
        __syncthreads();
        if (tid < 256) { const unsigned hv = hist[tid]; unsigned sfx = hv;
#pragma unroll
            for (int o = 1; o < 64; o <<= 1) { const unsigned tv = bperm(sfx, lane + o); if (lane + o < 64) sfx += tv; }
            unsigned gt = sfx - hv;
#pragma unroll
            for (int j = 1; j < 4; ++j) if (w + j < 4) gt += wsum[w + j];
            if (gt < need && need <= gt + hv) { ctl[2] = (pref << 8) | (unsigned)tid; ctl[3] = need - gt; } }
        __syncthreads();
        if (tid == 0) { ctl[0] = ctl[2]; ctl[1] = ctl[3]; }
        __syncthreads();
    }
    const unsigned thr = ctl[0], need = ctl[1];
    unsigned cg = 0u, ce = 0u;
#pragma unroll
    for (int i = 0; i < 8; ++i) { cg += (key[i] > thr) ? 1u : 0u; ce += (have && key[i] == thr) ? 1u : 0u; }
    unsigned sg = cg, se = ce;
#pragma unroll
    for (int o = 1; o < 64; o <<= 1) { const unsigned tg = bperm(sg, lane - o), te = bperm(se, lane - o); if (lane >= o) { sg += tg; se += te; } }
    if (lane == 63) { wsum[w] = sg; wsum[8 + w] = se; }
    __syncthreads();
    unsigned og = 0u, oe = 0u;
#pragma unroll
    for (int j = 0; j < 8; ++j) { if (j < w) { og += wsum[j]; oe += wsum[8 + j]; } }
    unsigned pg = og + sg - cg, pe = oe + se - ce;
    const int rowbase = is_ctx ? (TL + b * CTXL) : (b * SEQ);
    if (have) {
#pragma unroll
        for (int i = 0; i < 8; ++i) { const bool g = key[i] > thr, q = key[i] == thr; const bool sel = g || (q && pe < need);
            const int rank = (int)(pg + (pe < need ? pe : need)); const int row = rowbase + 8 * tid + i;
            ((int*)(c.ws + WS_SEL))[(size_t)row * 16 + e] = sel ? rank : -1;
            if (sel) { const int slot = is_ctx ? (2048 + b * CAPC + rank) : (b * CAPL + rank); ((float*)(c.ws + WS_GATEV))[e * ESLOTS + slot] = __uint_as_float(key[i]); list[2 * rank] = row; list[2 * rank + 1] = slot; }
            pg += g ? 1u : 0u; pe += q ? 1u : 0u; } }
    __syncthreads();
    const bf16_t* H = (const bf16_t*)(c.ws + WS_H); bf16_t* XS = (bf16_t*)(c.ws + WS_RA + RA_XS) + (size_t)e * ESLOTS * D;
    for (int i0 = w; i0 < cap; i0 += 8 * NWAVES) {
        u32x4 v0[8], v1[8];
#pragma unroll
        for (int k = 0; k < 8; ++k) { const int i = i0 + k * NWAVES; if (i < cap) { const u32x4* sp = (const u32x4*)(H + (size_t)list[2 * i] * D); v0[k] = sp[lane]; v1[k] = sp[64 + lane]; } }
#pragma unroll
        for (int k = 0; k < 8; ++k) { const int i = i0 + k * NWAVES; if (i < cap) { u32x4* dp = (u32x4*)(XS + (size_t)list[2 * i + 1] * D); dp[lane] = v0[k]; dp[64 + lane] = v1[k]; } }
    }
    __syncthreads();
}
struct CombRaw { int sel; f32x4 xv[4]; };
__device__ __forceinline__ void combine_load(const Ctx& c, int row, CombRaw& R) {
    const int lane = c.lane; const float* xr = xout_row(c, row);
    R.sel = ((const int*)(c.ws + WS_SEL))[(size_t)row * 16 + (lane & 15)];
#pragma unroll
    for (int j = 0; j < 4; ++j) R.xv[j] = *(const f32x4*)(xr + 4 * lane + 256 * j);
}
__device__ __forceinline__ void combine_row(const Ctx& c, int l, int row, bool next_mod, const CombRaw& R, float* dummy = nullptr) {
    const int lane = c.lane, bi = row_modidx(row); float* xr = xout_row(c, row); float* xw = dummy ? dummy + (size_t)row * D : xr;
    const bf16_t* YS = (const bf16_t*)(c.ws + WS_RA + RA_YS); const float* g5 = modp(c, l, bi, 5);
    f32x4 acc[4];
#pragma unroll
    for (int j = 0; j < 4; ++j) acc[j] = (f32x4){0.f, 0.f, 0.f, 0.f};
    const bool lat = row < TL; const int b = lat ? (row >> 12) : ((row - TL) >> 8);
    unsigned long long pick = __ballot(R.sel >= 0) & 0xffffull;
    while (pick) {
        if (!lat) {
            const int e = __builtin_ctzll(pick); pick &= pick - 1; const int r = __builtin_amdgcn_readlane(R.sel, e);
            const bf16_t* yc = (const bf16_t*)(c.ws + WS_RB + RB_YSC) + ((size_t)e * 128 + b * CAPC + r) * D + 4 * lane; u32x2 wc[4][4];
#pragma unroll
            for (int k = 0; k < 4; ++k)
#pragma unroll
                for (int j = 0; j < 4; ++j) wc[k][j] = *(const u32x2*)(yc + (size_t)k * (NEXP * 128 * D) + 256 * j);
#pragma unroll
            for (int k = 0; k < 4; ++k)
#pragma unroll
                for (int j = 0; j < 4; ++j) { acc[j][0] += bflo(wc[k][j].x); acc[j][1] += bfhi(wc[k][j].x); acc[j][2] += bflo(wc[k][j].y); acc[j][3] += bfhi(wc[k][j].y); }
            continue; }
        const bf16_t* yp[4]; bool on[4];
#pragma unroll
        for (int k = 0; k < 4; ++k) { on[k] = pick != 0; const int e = on[k] ? __builtin_ctzll(pick) : 0; if (on[k]) pick &= pick - 1;
            const int r = __builtin_amdgcn_readlane(R.sel, e); const int slot = lat ? (b * CAPL + r) : (2048 + b * CAPC + r);
            yp[k] = YS + ((size_t)e * ESLOTS + (on[k] ? slot : 0)) * D; }
        u32x2 wv[4][4];
#pragma unroll
        for (int k = 0; k < 4; ++k)
#pragma unroll
            for (int j = 0; j < 4; ++j) wv[k][j] = on[k] ? *(const u32x2*)(yp[k] + 4 * lane + 256 * j) : (u32x2){0u, 0u};
#pragma unroll
        for (int k = 0; k < 4; ++k)
#pragma unroll
            for (int j = 0; j < 4; ++j) { acc[j][0] += bflo(wv[k][j].x); acc[j][1] += bfhi(wv[k][j].x); acc[j][2] += bflo(wv[k][j].y); acc[j][3] += bfhi(wv[k][j].y); }
    }
    float ss = 0.f; f32x4 xv[4];
#pragma unroll
    for (int j = 0; j < 4; ++j) { const int cc = 4 * lane + 256 * j; xv[j] = R.xv[j] + *(const f32x4*)(g5 + cc) * acc[j]; *(f32x4*)(xw + cc) = xv[j];
        ss += (xv[j][0] * xv[j][0] + xv[j][1] * xv[j][1]) + (xv[j][2] * xv[j][2] + xv[j][3] * xv[j][3]); }
    if (!next_mod) return;
    const float rstd = 1.0f / sqrtf(wave_sum(ss) * (1.f / D) + EPS); const float* g = c.in[I_GMIX] + (l + 1) * D; const float* sh = modp(c, l + 1, bi, 0); const float* sc = modp(c, l + 1, bi, 1);
    bf16_t* hrow = (bf16_t*)(c.ws + WS_H) + (size_t)row * D;
#pragma unroll
    for (int j = 0; j < 4; ++j) { const int cc = 4 * lane + 256 * j; const f32x4 h = xv[j] * rstd * *(const f32x4*)(g + cc) * (*(const f32x4*)(sc + cc) + 1.0f) + *(const f32x4*)(sh + cc);
        u32x2 o; o.x = cvt_pk_bf16(h[0], h[1]); o.y = cvt_pk_bf16(h[2], h[3]); *(u32x2*)(hrow + cc) = o; }
}

#ifndef MK_FUSED
#define MK_FUSED 1
#endif
constexpr int NPH = 2 + 11 * 2;
#ifndef EARLY_WD_UNITS
#define EARLY_WD_UNITS 19
#endif
constexpr int CW_BAR = 4096;

__global__ void __launch_bounds__(NTHR, 2) fwd(Args args) {
    extern __shared__ __attribute__((aligned(16))) unsigned char lds_raw[];
    Ctx c; c.in = args.in; c.out = args.out; c.ws = args.ws; c.lds = (LAS unsigned char*)lds_raw;
    c.tid = threadIdx.x; c.lane = c.tid & 63; c.wave = __builtin_amdgcn_readfirstlane(c.tid >> 6); c.G = gridDim.x; c.bid = blockIdx.x;
    volatile LAS unsigned* misc = (volatile LAS unsigned*)(c.lds + LDS_MISC);
    if (c.tid < 8) misc[c.tid] = 0u;
    __syncthreads();
#if MK_FUSED
    XcdBarrier bar = xcd_barrier_post((unsigned*)(c.ws + WS_CTL) + CW_BAR, misc);
#define GRID_BAR() xcd_barrier(bar)
#else
#define GRID_BAR() do {} while (0)
#endif
    const int lo = args.ph_lo, hi = args.ph_hi;
#ifndef PHMASK
#define PHMASK 0xffffffffu
#endif
#define IN(k) (lo <= (k) && (k) < hi)
#define EN(j) ((PHMASK >> (j)) & 1u)
#ifndef REPEAT_ID
#define REPEAT_ID -1
#endif
#define REP(id) for (int rep_ = 0; rep_ < ((REPEAT_ID == (id)) ? 2 : 1); ++rep_)
#if defined(DEBUG_TS_A)
#ifndef DEBUG_TS_Q
#define DEBUG_TS_Q 4.0f
#endif
#ifndef DEBUG_TS_SHIFT
#define DEBUG_TS_SHIFT 0.0f
#endif
#define TS_STORE(k) do { if (c.bid == 0 && c.wave == 0) ((unsigned long long*)(c.ws + WS_CTL + 768 * 1024))[(k)] = __builtin_amdgcn_s_memrealtime(); } while (0)
#else
#define TS_STORE(k) do {} while (0)
#endif
#define SEAM(k) do { if (IN((k) + 1)) { GRID_BAR(); if (REPEAT_ID == 99) GRID_BAR(); } TS_STORE((k) + 1); } while (0)
#define PHASE_CTX() Ctx pc = c; { int z_ = 0, b_ = c.bid, g_ = c.G, w_ = c.wave; asm volatile("" : "+s"(z_), "+s"(b_), "+s"(g_), "+s"(w_)); \
        z_ = __builtin_amdgcn_readfirstlane(z_); b_ = __builtin_amdgcn_readfirstlane(b_); g_ = __builtin_amdgcn_readfirstlane(g_); w_ = __builtin_amdgcn_readfirstlane(w_); \
        pc.in = c.in + z_; pc.ws = c.ws + z_; pc.out = c.out + z_; pc.bid = b_; pc.G = g_; pc.wave = w_ & 7; \
        pc.lane = (int)(__builtin_amdgcn_mbcnt_hi(~0u, __builtin_amdgcn_mbcnt_lo(~0u, (unsigned)z_)) & 63u); pc.tid = pc.wave * 64 + pc.lane; } const int gw = pc.bid * NWAVES + pc.wave; const int NGW = pc.G * NWAVES; (void)gw; (void)NGW

    TS_STORE(0);
    if (EN(0) && IN(0)) { PHASE_CTX(); REP(0) phase_pre_a(pc); SEAM(0); }
    if (EN(1) && IN(1)) { PHASE_CTX(); REP(1) phase_modulate_mix(pc, 0); SEAM(1); }
#pragma unroll 1
    for (int l = 0; l < 2; ++l) {
        const int p0 = 2 + 11 * l; const bool first = (l == 0); const int nMa = first ? 68 : 64;
#define PHASE_PTRS() PHASE_CTX(); unsigned char* wt = pc.ws + WS_WT + (size_t)l * WT_LAYER; bf16_t* Z = (bf16_t*)(pc.ws + WS_RA); bf16_t* H = (bf16_t*)(pc.ws + WS_H); (void)wt; (void)Z; (void)H
        if (EN(2) && IN(p0 + 0)) { REP(20 + 0) { PHASE_PTRS();
            pg8::Gemm g{H, (const bf16_t*)(wt + WT_IN), D, D, D, 0, 0}; pg8::GOrder S; S.init(nMa, 35, 1, pc.G, pc.bid);
            EpiZ E{Z, pc.in[I_BGATE] + l * 3072};
            REP(2) pg8::gemm_phase<EpiZ, pg8::GOrder>(pc.lds, pc.tid, g, S, E);
            if (!first) {
                pg8::GOrderCtxCols S2; S2.o.init(4, 8, 1, pc.G, (pc.bid + pc.G - (64 * 35) % pc.G) % pc.G, 64);
                pg8::gemm_phase<EpiZ, pg8::GOrderCtxCols>(pc.lds, pc.tid, g, S2, E); }
            } SEAM(p0 + 0); }
        if (EN(3) && IN(p0 + 1)) { REP(20 + 1) { PHASE_PTRS();
#ifndef NO_G2G3
            REP(3) {
            { pg8::Gemm g{Z + ZCKV, (const bf16_t*)(wt + WT_UKV), NZ, 256, 256, 0, 0}; pg8::GOrder S; S.init(68, 8, 1, pc.G, pc.bid); EpiPlain E{(bf16_t*)(pc.ws + WS_RB + RB_KVRAW), 2048};
              pg8::gemm_phase<EpiPlain, pg8::GOrder>(pc.lds, pc.tid, g, S, E); }
            { pg8::Gemm g{Z + ZCQ, (const bf16_t*)(wt + WT_UQ), NZ, 384, 384, 0, 0}; pg8::GOrder S; S.init(nMa, 6, 1, pc.G, (pc.bid + pc.G - 32 % pc.G) % pc.G); EpiPlain E{(bf16_t*)(pc.ws + WS_RB + RB_QRAW), 1536};
              pg8::gemm_phase<EpiPlain, pg8::GOrder>(pc.lds, pc.tid, g, S, E); }
            }
#endif
#ifndef NO_MIXA
            REP(4) for (int u = (pc.bid + 8) % pc.G; u < nMa * 2 * 8; u += pc.G) mixA_unit(pc, l, u);
#endif
#ifndef NO_B1
            REP(5) for (int u = (pc.bid + pc.G - 184 % pc.G) % pc.G; u < 1088; u += pc.G) gla_b1_unit(pc, l, u);
#endif
            } SEAM(p0 + 1); }
        if (EN(4) && IN(p0 + 2)) { REP(20 + 2) { PHASE_PTRS();
            REP(6) {
                const bool b2wg = (pc.G >= 128) && pc.bid < 64;
                if (pc.tid < 32) *((volatile LAS unsigned*)(pc.lds + 3 * 33280 + 4 * 5120) + pc.tid) = 0u;
                __syncthreads();
                const bool role_b2 = (pc.G >= 128) ? b2wg : true;
                if (role_b2) {
#ifndef SKIP_B2
                    if (pc.G >= 128) gla_b2_unit(pc, pc.bid);
                    else { for (int u = pc.bid; u < 64; u += pc.G) { gla_b2_unit(pc, u); __syncthreads(); if (pc.tid < 32) *((volatile LAS unsigned*)(pc.lds + 3 * 33280 + 4 * 5120) + pc.tid) = 0u; __syncthreads(); } }
#endif
                }
                if (!role_b2 || pc.G < 128) {
#ifndef SKIP_C1
                  int wi, nwv;
                  if (pc.G >= 128) { nwv = (pc.G - 64) * NWAVES; wi = (pc.bid - 64) * NWAVES + pc.wave; }
                  else { nwv = pc.G * NWAVES; wi = pc.bid * NWAVES + pc.wave; }
                  if (wi < T) { C1Raw A = {}, B = {}; mla_c1_load(pc, wi, false, A);
                      for (int row = wi; row < T; row += 2 * nwv) { const int r1 = row + nwv, r2 = row + 2 * nwv;
                          if (r1 < T) mla_c1_load(pc, r1, false, B);
                          mla_c1_row(pc, l, row, false, A);
                          if (r2 < T) mla_c1_load(pc, r2, false, A);
                          if (r1 < T) mla_c1_row(pc, l, r1, false, B); } }
#endif
#ifndef NO_EARLY_WD
                  if (!role_b2) { __syncthreads(); wconv_early(pc, l, EARLY_WD_UNITS); }
#endif
                }
            }
            } SEAM(p0 + 2); }
        if (EN(5) && IN(p0 + 3)) { REP(20 + 3) { PHASE_PTRS();
#ifndef NO_FIN
            REP(7) { const int nrow = nMa * 256; if (gw < nrow) { FinRaw A = {}, B = {}; gla_finish_load(pc, gw, A);
                for (int row = gw; row < nrow; row += 2 * NGW) { const int r1 = row + NGW, r2 = row + 2 * NGW;
                    if (r1 < nrow) gla_finish_load(pc, r1, B);
                    gla_finish_row(pc, l, row, A);
                    if (r2 < nrow) gla_finish_load(pc, r2, A);
                    if (r1 < nrow) gla_finish_row(pc, l, r1, B); } } }
#endif
            bf16_t* Y = (bf16_t*)(pc.ws + WS_RB + RB_YCAT) + 2048;
            const bf16_t* KG = (const bf16_t*)(pc.ws + WS_RB + RB_KG); const bf16_t* VG = (const bf16_t*)(pc.ws + WS_RB + RB_VG);
            const int G8 = pc.G >> 3;
            REP(8) for (int i = 0;; ++i) {
                int un; if ((pc.G & 7) == 0 && (G8 & 15) == 0) { const int x = pc.bid & 7, s = pc.bid >> 3, ppx = G8 >> 4; un = ((i * 8 * ppx) + x * ppx + (s >> 4)) * 16 + (s & 15); } else un = i * pc.G + pc.bid;
                if (un >= 512) break;
                const int bh = un >> 4, qb = un & 15, b = bh >> 3, h = bh & 7;
                attn_unit(pc, l, (const bf16_t*)(pc.ws + WS_RB + RB_QRAW) + (size_t)(b * SEQ + qb * 256) * 1536 + h * 192, (const float*)(pc.ws + WS_RSQ) + b * SEQ + qb * 256, qb * 256, KG + ((size_t)b * NKEY * 8 + h) * 192, VG + ((size_t)b * NKEY * 8 + h) * 128, 68, Y + (size_t)(b * SEQ + qb * 256) * 3072 + h * 128); }
            if (first) for (int un = pc.bid; un < 32; un += pc.G) { const int b = un >> 3, h = un & 7;
                attn_unit(pc, l, (const bf16_t*)(pc.ws + WS_RB + RB_QRAW) + (size_t)(TL + b * CTXL) * 1536 + h * 192, (const float*)(pc.ws + WS_RSQ) + TL + b * CTXL, -1, KG + ((size_t)b * NKEY * 8 + h) * 192, VG + ((size_t)b * NKEY * 8 + h) * 128, 4, Y + (size_t)(TL + b * CTXL) * 3072 + h * 128); }
            } SEAM(p0 + 3); }
        if (EN(6) && IN(p0 + 4)) { REP(20 + 4) { PHASE_PTRS();
            pg8::Gemm g{(const bf16_t*)(pc.ws + WS_RB + RB_YCAT), (const bf16_t*)(wt + WT_M), 3072, 3072, 3072, 0, 0}; pg8::GOrder S; S.init(64, 4, 1, pc.G, pc.bid);
            EpiMerge E{(bf16_t*)(pc.ws + WS_RB + RB_MERGED), Z};
            REP(9) pg8::gemm_phase<EpiMerge, pg8::GOrder>(pc.lds, pc.tid, g, S, E);
            if (first) REP(31) for (int u = pc.bid; u < 256; u += pc.G) ctx_merge_unit(pc, l, u); } SEAM(p0 + 4); }
        if (EN(7) && IN(p0 + 5)) { REP(20 + 5) { PHASE_PTRS();
            pg8::Gemm g{(const bf16_t*)(pc.ws + WS_RB + RB_MERGED), (const bf16_t*)(wt + WT_OUT), D, D, D, 0, 0}; pg8::GOrder S; S.init(64, 4, 1, pc.G, pc.bid);
            EpiResid E{&pc, l, (REPEAT_ID == 25 && rep_ == 0) ? (float*)(pc.ws + WS_RA) : nullptr};
            pg8::gemm_phase<EpiResid, pg8::GOrder>(pc.lds, pc.tid, g, S, E);
            if (first) REP(32) for (int u = pc.bid; u < 256; u += pc.G) ctx_out_unit(pc, l, u); } SEAM(p0 + 5); }
        if (EN(8) && IN(p0 + 6)) { REP(20 + 6) { PHASE_PTRS();
            REP(11) { route_stage_w(pc, l); const int nrow = nMa * 256;
                if (gw < nrow) { RouteRaw A = {}, B = {}; route_load(pc, gw, A);
                    for (int row = gw; row < nrow; row += 2 * NGW) { const int r1 = row + NGW, r2 = row + 2 * NGW;
                        if (r1 < nrow) route_load(pc, r1, B);
                        route_row(pc, l, row, A);
                        if (r2 < nrow) route_load(pc, r2, A);
                        if (r1 < nrow) route_row(pc, l, r1, B); } }
                __syncthreads(); }
            } SEAM(p0 + 6); }
        if (EN(9) && IN(p0 + 7)) { REP(20 + 7) { PHASE_PTRS();
            REP(13) for (int u = pc.bid; u < 64; u += pc.G) topk_unit(pc, u, false);
            if (first) for (int u = (pc.bid + pc.G - 64 % pc.G) % pc.G; u < 64; u += pc.G) topk_unit(pc, u, true);
            REP(12) expert_wconv(pc, l);
            } SEAM(p0 + 7); }
        if (EN(10) && IN(p0 + 8)) { REP(20 + 8) { PHASE_PTRS();
            pg8::Gemm g{(const bf16_t*)(pc.ws + WS_RA + RA_XS), (const bf16_t*)(pc.ws + WS_RB + RB_WGU), D, D, D, (size_t)ESLOTS * D, (size_t)4096 * D, (const bf16_t*)(pc.ws + WS_RB + RB_WGU2) - (size_t)GU_SPLIT * 4096 * D, GU_SPLIT}; pg8::GOrder S; S.init(first ? 9 : 8, 16, 16, pc.G, pc.bid);
            EpiSwiGLU E{(bf16_t*)(pc.ws + WS_RA + RA_HID)};
            REP(14) pg8::gemm_phase<EpiSwiGLU, pg8::GOrder>(pc.lds, pc.tid, g, S, E); } SEAM(p0 + 8); }
        if (EN(11) && IN(p0 + 9)) { REP(20 + 9) { PHASE_PTRS();
            pg8::Gemm g{(const bf16_t*)(pc.ws + WS_RA + RA_HID), (const bf16_t*)(pc.ws + WS_RB + RB_WD), DEXP, DEXP, DEXP, (size_t)ESLOTS * DEXP, (size_t)D * DEXP}; pg8::GOrder S; S.init(8, 4, 16, pc.G, pc.bid);
            EpiDown E{(bf16_t*)(pc.ws + WS_RA + RA_YS), (const float*)(pc.ws + WS_GATEV)};
            REP(15) pg8::gemm_phase<EpiDown, pg8::GOrder>(pc.lds, pc.tid, g, S, E);
            if (first) {
                pg8::Gemm g2 = g; g2.K = 512; pg8::KSplitOrder S2{pc.G, (pc.G == 256) ? ((pc.bid & 7) * 32 + (pc.bid >> 3)) : pc.bid};
                EpiDownPart E2{(bf16_t*)(pc.ws + WS_RB + RB_YSC), (const float*)(pc.ws + WS_GATEV)};
                pg8::gemm_phase<EpiDownPart, pg8::KSplitOrder>(pc.lds, pc.tid, g2, S2, E2); } } SEAM(p0 + 9); }
        if (EN(12) && IN(p0 + 10)) { REP(20 + 10) { PHASE_PTRS();
            { const int nrow = nMa * 256; float* dmy = (REPEAT_ID == 30 && rep_ == 0) ? (float*)(pc.ws + WS_RB) : nullptr;
              if (gw < nrow) { CombRaw A = {}, B = {}; combine_load(pc, gw, A);
                  for (int row = gw; row < nrow; row += 2 * NGW) { const int r1 = row + NGW, r2 = row + 2 * NGW;
                      if (r1 < nrow) combine_load(pc, r1, B);
                      combine_row(pc, l, row, first, A, dmy);
                      if (r2 < nrow) combine_load(pc, r2, A);
                      if (r1 < nrow) combine_row(pc, l, r1, first, B, dmy); } } }
            } SEAM(p0 + 10); }
    }
#if defined(DEBUG_TS_A)
    { GRID_BAR(); const unsigned long long* ts = (const unsigned long long*)(c.ws + WS_CTL + 768 * 1024);
      float a = (float)(__hip_atomic_load(ts + DEBUG_TS_A + 1, __ATOMIC_RELAXED, __HIP_MEMORY_SCOPE_AGENT) - __hip_atomic_load(ts + DEBUG_TS_A, __ATOMIC_RELAXED, __HIP_MEMORY_SCOPE_AGENT)) * 1e-2f;
      float b = (float)(__hip_atomic_load(ts + DEBUG_TS_B + 1, __ATOMIC_RELAXED, __HIP_MEMORY_SCOPE_AGENT) - __hip_atomic_load(ts + DEBUG_TS_B, __ATOMIC_RELAXED, __HIP_MEMORY_SCOPE_AGENT)) * 1e-2f;
      a = exp2f(rintf(log2f(fmaxf(a, 1.f)) * DEBUG_TS_Q + DEBUG_TS_SHIFT) / DEBUG_TS_Q) * 1e-2f; b = exp2f(rintf(log2f(fmaxf(b, 1.f)) * DEBUG_TS_Q + DEBUG_TS_SHIFT) / DEBUG_TS_Q) * 1e-2f;
      const int tid_ = c.wave * 64 + (int)__builtin_amdgcn_mbcnt_hi(~0u, __builtin_amdgcn_mbcnt_lo(~0u, 0u));
      for (long i = (long)c.bid * NTHR + tid_; i < (long)TL * D; i += (long)c.G * NTHR) c.out[i] = (i == 0) ? 131072.0f * b : 1024.0f * a; }
#endif
}

extern "C" void kernel_launch(void* const* d_in, const int* in_sizes, int n_in, void* d_out, int out_size, void* d_ws, size_t ws_size, hipStream_t stream) {
    static int grid = 0;
    if (!grid) {
        int dev = 0, cus = 0, per_cu = 0;
        (void)hipGetDevice(&dev); (void)hipDeviceGetAttribute(&cus, hipDeviceAttributeMultiprocessorCount, dev);
        (void)hipFuncSetAttribute((const void*)fwd, hipFuncAttributeMaxDynamicSharedMemorySize, LDS_BYTES);
        (void)hipOccupancyMaxActiveBlocksPerMultiprocessor(&per_cu, fwd, NTHR, LDS_BYTES);
        grid = cus * (per_cu < 1 ? per_cu : 1);
        if (grid <= 0) { fprintf(stderr, "occupancy query returned 0 blocks per CU\n"); grid = cus; }
        if (ws_size < WS_END) fprintf(stderr, "workspace too small: %zu < %zu\n", ws_size, (size_t)WS_END);
    }
    (void)hipMemsetAsync((unsigned char*)d_ws + WS_CTL, 0, CTL_BYTES, stream);
    Args a{}; for (int i = 0; i < N_INPUTS; ++i) a.in[i] = (const float*)d_in[i]; a.out = (float*)d_out; a.ws = (unsigned char*)d_ws;
#if MK_FUSED
    a.ph_lo = 0; a.ph_hi = NPH;
    hipLaunchKernelGGL(fwd, dim3(grid), dim3(NTHR), LDS_BYTES, stream, a);
#else
#if defined(DEBUG_SCAN)
    hipLaunchKernelGGL(k_seterr, dim3(1), dim3(1), 0, stream, (int*)((unsigned char*)d_ws + WS_CTL + 512 * 1024));
#endif
    for (int p = 0; p < NPH; ++p) { a.ph_lo = p; a.ph_hi = p + 1;
#if defined(DEBUG_SCAN)
        if (p == 3) (void)hipMemsetAsync((unsigned char*)d_ws + WS_RB + RB_OINTRA, 0xff, (size_t)T * D * 2, stream);
#endif
        hipLaunchKernelGGL(fwd, dim3(grid), dim3(NTHR), LDS_BYTES, stream, a);
#if defined(DEBUG_SCAN)
#if defined(DEBUG_HASH)
        if (p == DEBUG_HASH_PHASE) { (void)hipMemsetAsync((unsigned char*)d_ws + WS_CTL + 512 * 1024 + 256, 0, 4, stream);
            hipLaunchKernelGGL(k_hash, dim3(512), dim3(256), 0, stream, (const unsigned*)((unsigned char*)d_ws + DEBUG_HASH_OFF), (long)(DEBUG_HASH_BYTES / 4), (unsigned*)((unsigned char*)d_ws + WS_CTL + 512 * 1024 + 256)); }
#else
        debug_after_phase(p, (unsigned char*)d_ws, (float*)d_out, stream);
#endif
#endif
    }
#if defined(DEBUG_SCAN)
#if defined(DEBUG_HASH)
    hipLaunchKernelGGL(k_apply_hash, dim3(1024), dim3(256), 0, stream, (float*)d_out, (long)out_size, (const unsigned*)((unsigned char*)d_ws + WS_CTL + 512 * 1024 + 256));
#elif defined(DEBUG_STAT)
    hipLaunchKernelGGL(k_apply_stat, dim3(1024), dim3(256), 0, stream, (float*)d_out, (long)out_size, (const int*)((unsigned char*)d_ws + WS_CTL + 512 * 1024));
#else
    hipLaunchKernelGGL(k_apply, dim3(1024), dim3(256), 0, stream, (float*)d_out, (long)out_size, (const int*)((unsigned char*)d_ws + WS_CTL + 512 * 1024));
#endif
#endif
#endif
}
```
